# Optimizing an MI355X kernel written in HIP

```python
import math
import jax, jax.numpy as jnp
from jax import lax
import numpy as np

D_MODEL = 1024
BATCH = 32
SEQ = 2048
DEPTH = 4

HEAD_DIM = 64
N_BRANCHES = 4
BRANCH_WIDTH = D_MODEL // 4

A_HEADS = BRANCH_WIDTH // HEAD_DIM
A_PATTERNS = ((128, 1), (512, 4), (2048, 16))
A_BLOCK = 128
B_HEADS = BRANCH_WIDTH // HEAD_DIM
B_LATENT = D_MODEL // 16
IDX_HEADS = 8
IDX_DIM = 32
TOPK_MAX = 256
TOPK_DIV = 4
Q_BLOCK = 128
C_HEADS = 4
C_KEY_DIM = 32
C_VAL_DIM = BRANCH_WIDTH // C_HEADS
C_GATE_RANK = 16
C_GATE_TAU = 16.0
C_CHUNK = 64
D_HEADS = 4
D_HEAD_SIZE = BRANCH_WIDTH // D_HEADS
D_DECAY_RANK = 16
D_ICLR_RANK = 16
D_GATE_RANK = 32
D_GN_EPS = 64e-5
D_IN_WIDTH = 3 * BRANCH_WIDTH + D_DECAY_RANK + D_ICLR_RANK + D_GATE_RANK
RPB_BUCKETS = 32
RPB_MAX_DIST = 2048
RPB_HEADS = A_HEADS + B_HEADS
MOE_GROUPS = 4
MOE_PER_GROUP = 8
MOE_EXPERTS = MOE_GROUPS * MOE_PER_GROUP
MOE_TOPK = 2
MOE_HIDDEN = 256
DN_ALPHA = (2 * DEPTH) ** 0.25
DN_BETA = (8 * DEPTH) ** -0.25
LN_EPS = 1e-5

IN_SPLITS = (
    ("a_q", A_HEADS * HEAD_DIM), ("a_k", A_HEADS * HEAD_DIM), ("a_v", A_HEADS * HEAD_DIM),
    ("b_q", B_HEADS * B_LATENT), ("b_ckv", B_LATENT), ("b_iq", IDX_HEADS * IDX_DIM),
    ("b_ik", IDX_DIM), ("b_iw", IDX_HEADS),
    ("c_q", C_HEADS * C_KEY_DIM), ("c_k", C_HEADS * C_KEY_DIM), ("c_v", C_HEADS * C_VAL_DIM),
    ("c_a", C_GATE_RANK), ("c_g", BRANCH_WIDTH),
    ("d", D_IN_WIDTH),
    ("gate", N_BRANCHES * D_MODEL),
)
IN_WIDTH = sum(w for _, w in IN_SPLITS)

kernel_name = "hybrid_gated_four_mixer_hmoe_deepnorm"


def _split_in(h):
    out = {}
    off = 0
    for name, w in IN_SPLITS:
        out[name] = h[..., off:off + w]
        off += w
    return out


def _layer_norm(x, g, b):
    xf = x.astype(jnp.float32)
    mu = jnp.mean(xf, -1, keepdims=True)
    var = jnp.mean(jnp.square(xf - mu), -1, keepdims=True)
    return ((xf - mu) * lax.rsqrt(var + LN_EPS) * g + b).astype(x.dtype)


def _rms_norm(x, g, eps=1e-6):
    xf = x.astype(jnp.float32)
    return (xf * lax.rsqrt(jnp.mean(xf * xf, -1, keepdims=True) + eps) * g).astype(x.dtype)


def _t5_bucket(dist):
    exact = RPB_BUCKETS // 2
    d = jnp.maximum(dist, 0)
    df = jnp.maximum(d, 1).astype(jnp.float32)
    large = exact + (jnp.log(df / exact) / math.log(RPB_MAX_DIST / exact)
                     * (RPB_BUCKETS - exact)).astype(jnp.int32)
    large = jnp.minimum(large, RPB_BUCKETS - 1)
    return jnp.where(d < exact, d, large)


def _dilated_pattern(q, k, v, bias_tab, window, dilation):
    bsz, seq, nh, dh = q.shape
    lr = seq // dilation
    span = window // dilation
    nb = -(-lr // A_BLOCK)
    lp = nb * A_BLOCK
    bd = bsz * dilation

    def regroup(z):
        z = z.reshape(bsz, lr, dilation, nh, dh).transpose(0, 2, 1, 3, 4)
        return z.reshape(bd, lr, nh, dh)

    qr, kr, vr = regroup(q), regroup(k), regroup(v)
    qb = jnp.pad(qr, ((0, 0), (0, lp - lr), (0, 0), (0, 0))).reshape(bd, nb, A_BLOCK, nh, dh)

    def band(z):
        zp = jnp.pad(z, ((0, 0), (A_BLOCK, lp - lr), (0, 0), (0, 0)))
        prev = zp[:, :lp].reshape(bd, nb, A_BLOCK, nh, dh)
        cur = zp[:, A_BLOCK:].reshape(bd, nb, A_BLOCK, nh, dh)
        return jnp.concatenate([prev, cur], axis=2)

    kb, vb = band(kr), band(vr)
    qi = jnp.arange(A_BLOCK)[:, None]
    kj = jnp.arange(2 * A_BLOCK)[None, :]
    rdist = qi + A_BLOCK - kj
    in_band = (rdist >= 0) & (rdist <= span)
    bias = jnp.transpose(bias_tab[_t5_bucket(rdist * dilation)], (2, 0, 1))
    kpos = jnp.arange(nb)[:, None] * A_BLOCK - A_BLOCK + kj
    mask = in_band[None] & (kpos >= 0)[:, None, :]

    s = jnp.einsum('bnqhd,bnkhd->bnhqk', qb, kb).astype(jnp.float32) * dh ** -0.5 + bias
    s = jnp.where(mask[None, :, None], s, -jnp.inf)
    m = jnp.max(s, -1, keepdims=True)
    p = jnp.exp(s - m)
    den = jnp.sum(p, -1)
    o = jnp.einsum('bnhqk,bnkhd->bnqhd', p, vb.astype(jnp.float32))
    o = o / jnp.swapaxes(den, 2, 3)[..., None]
    lse = jnp.swapaxes(m[..., 0] + jnp.log(den), 2, 3)
    o = o.reshape(bd, lp, nh, dh)
    lse = lse.reshape(bd, lp, nh)

    def ungroup(z):
        z = z[:, :lr].reshape((bsz, dilation, lr) + z.shape[2:])
        z = jnp.moveaxis(z, 1, 2)
        return z.reshape((bsz, seq) + z.shape[3:])

    return ungroup(o), ungroup(lse)


def _mixer_a(q, k, v, bias_tab):
    bsz, seq, _ = q.shape
    shp = (bsz, seq, A_HEADS, HEAD_DIM)
    q, k, v = q.reshape(shp), k.reshape(shp), v.reshape(shp)
    outs, lses = [], []
    for window, dilation in A_PATTERNS:
        o, lse = _dilated_pattern(q, k, v, bias_tab, window, dilation)
        outs.append(o)
        lses.append(lse)
    wts = jax.nn.softmax(jnp.stack(lses), axis=0)
    o = jnp.sum(jnp.stack(outs) * wts[..., None], axis=0)
    return o.reshape(bsz, seq, A_HEADS * HEAD_DIM).astype(q.dtype)


def _mixer_b(q, ckv, iq, ik, iw, kv_gain, w_uv, bias_tab):
    bsz, seq, _ = q.shape
    keep = min(TOPK_MAX, seq // TOPK_DIV)
    nblk = seq // Q_BLOCK
    q = q.reshape(bsz, seq, B_HEADS, B_LATENT)
    ckv = _rms_norm(ckv, kv_gain)
    iq = iq.reshape(bsz, seq, IDX_HEADS, IDX_DIM)

    def to_blocks(z):
        return jnp.moveaxis(z.reshape((bsz, nblk, Q_BLOCK) + z.shape[2:]), 1, 0)

    def one_block(args):
        bi, qb, iqb, iwb = args
        tpos = bi * Q_BLOCK + jnp.arange(Q_BLOCK)
        rel = jax.nn.relu(jnp.einsum('bqhd,bsd->bqhs', iqb, ik).astype(jnp.float32) * IDX_DIM ** -0.5)
        score = jnp.einsum('bqhs,bqh->bqs', rel, iwb.astype(jnp.float32)) * IDX_HEADS ** -0.5
        admissible = jnp.arange(seq)[None, :] <= tpos[:, None]
        score = jnp.where(admissible[None], score, -jnp.inf)
        _, idx = lax.top_k(score, keep)
        sel = jax.vmap(lambda c, i: c[i])(ckv, idx)
        logits = jnp.einsum('bqhc,bqkc->bqhk', qb, sel).astype(jnp.float32) * B_LATENT ** -0.5
        dist = tpos[None, :, None] - idx
        bias = jnp.moveaxis(bias_tab[_t5_bucket(dist)], -1, 2)
        logits = jnp.where((dist >= 0)[:, :, None, :], logits + bias, -jnp.inf)
        p = jax.nn.softmax(logits, axis=-1)
        return jnp.einsum('bqhk,bqkc->bqhc', p.astype(sel.dtype), sel)

    ob = lax.map(one_block, (jnp.arange(nblk), to_blocks(q), to_blocks(iq), to_blocks(iw)))
    o = jnp.moveaxis(ob, 0, 1).reshape(bsz, seq, B_HEADS, B_LATENT)
    o = jnp.einsum('bshc,hcd->bshd', o, w_uv)
    return o.reshape(bsz, seq, B_HEADS * HEAD_DIM).astype(q.dtype)


def _mixer_c(q, k, v, a_low, og, a_up, a_bias, norm_gain):
    f32 = jnp.float32
    bsz, seq, _ = q.shape
    nc = seq // C_CHUNK
    log_a = jax.nn.log_sigmoid((a_low @ a_up + a_bias).astype(f32)) / C_GATE_TAU

    def chunks(z, dim):
        return z.astype(f32).reshape(bsz, nc, C_CHUNK, C_HEADS, dim)

    qc = chunks(q, C_KEY_DIM) * C_KEY_DIM ** -0.5
    kc = chunks(k, C_KEY_DIM)
    vc = chunks(v, C_VAL_DIM)
    cum = jnp.cumsum(chunks(log_a, C_KEY_DIM), axis=2)
    last = cum[:, :, -1]
    q_dec = qc * jnp.exp(cum)
    k_inv = kc * jnp.exp(-cum)
    causal = jnp.tril(jnp.ones((C_CHUNK, C_CHUNK), bool))
    att = jnp.where(causal, jnp.einsum('bnihd,bnjhd->bnhij', q_dec, k_inv), 0.0)
    o_intra = jnp.einsum('bnhij,bnjhv->bnihv', att, vc)
    upd = jnp.einsum('bnjhd,bnjhv->bnhdv', kc * jnp.exp(last[:, :, None] - cum), vc)
    dec = jnp.exp(last)

    def step(state, inp):
        d, u = inp
        return d[..., None] * state + u, state

    init = jnp.zeros((bsz, C_HEADS, C_KEY_DIM, C_VAL_DIM), f32)
    _, before = lax.scan(step, init, (jnp.moveaxis(dec, 1, 0), jnp.moveaxis(upd, 1, 0)))
    before = jnp.moveaxis(before, 0, 1)
    o = o_intra + jnp.einsum('bnihd,bnhdv->bnihv', q_dec, before)
    o = o.reshape(bsz, seq, C_HEADS, C_VAL_DIM)
    o = o * lax.rsqrt(jnp.mean(o * o, -1, keepdims=True) + 1e-6)
    o = o.reshape(bsz, seq, BRANCH_WIDTH) * norm_gain
    return (jax.nn.silu(og.astype(f32)) * o).astype(q.dtype)


def _token_shift(z, mu):
    prev = jnp.pad(z, ((0, 0), (1, 0), (0, 0)))[:, :-1]
    return z + (prev - z) * mu


def _mixer_d(seg, mu, w0, w2, a0, a2, g2, k_k, k_a, r_k, gn_w, gn_b):
    f32 = jnp.float32
    out_dtype = seg.dtype
    bsz, seq, _ = seg.shape
    bw = BRANCH_WIDTH
    seg = _token_shift(seg, mu).astype(f32)
    r, k, v = seg[..., :bw], seg[..., bw:2 * bw], seg[..., 2 * bw:3 * bw]
    o1 = 3 * bw
    o2 = o1 + D_DECAY_RANK
    o3 = o2 + D_ICLR_RANK
    wl, al, gl = seg[..., o1:o2], seg[..., o2:o3], seg[..., o3:o3 + D_GATE_RANK]
    w_raw = -jax.nn.softplus(-(w0 + jnp.tanh(wl) @ w2)) - 0.5
    w = jnp.exp(-jnp.exp(w_raw))
    a = jax.nn.sigmoid(a0 + al @ a2)
    g = jax.nn.sigmoid(gl) @ g2

    def heads(z):
        return z.astype(f32).reshape(bsz, seq, D_HEADS, D_HEAD_SIZE)

    kk = heads(k * k_k)
    kk = kk / jnp.maximum(jnp.sqrt(jnp.sum(kk * kk, -1, keepdims=True)), 1e-12)
    k = k * (1.0 + (a - 1.0) * k_a)
    rh, kh, vh, wh, ah = heads(r), heads(k), heads(v), heads(w), heads(a)
    a_vec = -kk
    b_vec = kk * ah

    def step(state, inp):
        rt, wt, kt, vt, at, bt = inp
        sa = jnp.einsum('bhvk,bhk->bhv', state, at)
        state = (state * wt[:, :, None, :] + sa[..., None] * bt[:, :, None, :]
                 + vt[..., None] * kt[:, :, None, :])
        return state, jnp.einsum('bhvk,bhk->bhv', state, rt)

    init = jnp.zeros((bsz, D_HEADS, D_HEAD_SIZE, D_HEAD_SIZE), f32)
    xs = tuple(jnp.moveaxis(z, 1, 0) for z in (rh, wh, kh, vh, a_vec, b_vec))
    _, y = lax.scan(step, init, xs)
    y = jnp.moveaxis(y, 0, 1)
    mu_y = jnp.mean(y, -1, keepdims=True)
    var_y = jnp.mean(jnp.square(y - mu_y), -1, keepdims=True)
    y = ((y - mu_y) * lax.rsqrt(var_y + D_GN_EPS)).reshape(bsz, seq, bw) * gn_w + gn_b
    bonus = jnp.sum(rh * kh * r_k.reshape(D_HEADS, D_HEAD_SIZE), -1, keepdims=True) * vh
    y = (y + bonus.reshape(bsz, seq, bw)) * g
    return y.astype(out_dtype)


def _moe(x, wr_g, br_g, wr_e, br_e, w_gate, w_up, w_down):
    f32 = jnp.float32

    def one_seq(xs):
        lg = (xs @ wr_g).astype(f32) + br_g
        pg = jax.nn.softmax(lg, axis=-1)
        ptop, gsel = lax.top_k(pg, 1)
        le = ((xs @ wr_e).astype(f32) + br_e).reshape(-1, MOE_GROUPS, MOE_PER_GROUP)
        le = jnp.take_along_axis(le, gsel[:, :, None], axis=1)[:, 0]
        lv, esel = lax.top_k(le, MOE_TOPK)
        we = jax.nn.softmax(lv, axis=-1) * ptop
        local = jnp.einsum('sk,ske->se', we, jax.nn.one_hot(esel, MOE_PER_GROUP, dtype=f32))
        gate = (jax.nn.one_hot(gsel[:, 0], MOE_GROUPS, dtype=f32)[:, :, None]
                * local[:, None, :]).reshape(-1, MOE_EXPERTS)
        hg = jnp.einsum('sd,edh->seh', xs, w_gate)
        hu = jnp.einsum('sd,edh->seh', xs, w_up)
        h = jax.nn.silu(hg) * hu * gate[..., None].astype(xs.dtype)
        return jnp.einsum('seh,ehd->sd', h, w_down)

    return lax.map(one_seq, x).astype(x.dtype)


def setup_inputs(seed: int = 0) -> dict:
    key = jax.random.key(seed)
    ks = jax.random.split(key, 32)
    f32 = jnp.float32

    def nrm(k, shape, scale):
        return jax.random.normal(k, shape, f32) * scale

    L = DEPTH
    bw = BRANCH_WIDTH
    return {
        "x": nrm(ks[0], (BATCH, SEQ, D_MODEL), 1.0),
        "rpb_table": nrm(ks[1], (RPB_BUCKETS, RPB_HEADS), 0.5),
        "w_in": nrm(ks[2], (L, D_MODEL, IN_WIDTH), D_MODEL ** -0.5),
        "b_kv_gain": 1.0 + nrm(ks[3], (L, B_LATENT), 0.05),
        "b_w_uv": nrm(ks[4], (L, B_HEADS, B_LATENT, HEAD_DIM), B_LATENT ** -0.5),
        "c_a_up": nrm(ks[5], (L, C_GATE_RANK, C_HEADS * C_KEY_DIM), C_GATE_RANK ** -0.5),
        "c_a_bias": nrm(ks[6], (L, C_HEADS * C_KEY_DIM), 0.5),
        "c_norm_gain": 1.0 + nrm(ks[7], (L, bw), 0.05),
        "d_mu": jax.random.uniform(ks[8], (L, D_IN_WIDTH), f32),
        "d_w0": nrm(ks[9], (L, bw), 0.5),
        "d_w2": nrm(ks[10], (L, D_DECAY_RANK, bw), 0.5 * D_DECAY_RANK ** -0.5),
        "d_a0": nrm(ks[11], (L, bw), 0.1),
        "d_a2": nrm(ks[12], (L, D_ICLR_RANK, bw), 0.5 * D_ICLR_RANK ** -0.5),
        "d_g2": nrm(ks[13], (L, D_GATE_RANK, bw), D_GATE_RANK ** -0.5),
        "d_k_k": 0.85 + nrm(ks[14], (L, bw), 0.05),
        "d_k_a": 1.0 + nrm(ks[15], (L, bw), 0.05),
        "d_r_k": nrm(ks[16], (L, bw), 0.1),
        "d_gn_w": 1.0 + nrm(ks[17], (L, bw), 0.05),
        "d_gn_b": nrm(ks[18], (L, bw), 0.01),
        "w_branch": nrm(ks[19], (L, N_BRANCHES, bw, D_MODEL), bw ** -0.5),
        "w_out": nrm(ks[20], (L, D_MODEL, D_MODEL), D_MODEL ** -0.5 * DN_BETA),
        "ln_g": 1.0 + nrm(ks[21], (L, 2, D_MODEL), 0.05),
        "ln_b": nrm(ks[22], (L, 2, D_MODEL), 0.01),
        "router_g": nrm(ks[23], (L, D_MODEL, MOE_GROUPS), D_MODEL ** -0.5),
        "router_g_bias": nrm(ks[24], (L, MOE_GROUPS), 0.01),
        "router_e": nrm(ks[25], (L, D_MODEL, MOE_EXPERTS), D_MODEL ** -0.5),
        "router_e_bias": nrm(ks[26], (L, MOE_EXPERTS), 0.01),
        "moe_w_gate": nrm(ks[27], (L, MOE_EXPERTS, D_MODEL, MOE_HIDDEN), D_MODEL ** -0.5),
        "moe_w_up": nrm(ks[28], (L, MOE_EXPERTS, D_MODEL, MOE_HIDDEN), D_MODEL ** -0.5),
        "moe_w_down": nrm(ks[29], (L, MOE_EXPERTS, MOE_HIDDEN, D_MODEL), MOE_HIDDEN ** -0.5 * DN_BETA),
    }


def reference(x, rpb_table, w_in, b_kv_gain, b_w_uv, c_a_up, c_a_bias, c_norm_gain,
              d_mu, d_w0, d_w2, d_a0, d_a2, d_g2, d_k_k, d_k_a, d_r_k, d_gn_w, d_gn_b,
              w_branch, w_out, ln_g, ln_b, router_g, router_g_bias, router_e, router_e_bias,
              moe_w_gate, moe_w_up, moe_w_down):
    bsz, seq, _ = x.shape
    for l in range(DEPTH):
        p = _split_in(x @ w_in[l])
        ya = _mixer_a(p["a_q"], p["a_k"], p["a_v"], rpb_table[:, :A_HEADS])
        yb = _mixer_b(p["b_q"], p["b_ckv"], p["b_iq"], p["b_ik"], p["b_iw"],
                      b_kv_gain[l], b_w_uv[l], rpb_table[:, A_HEADS:])
        yc = _mixer_c(p["c_q"], p["c_k"], p["c_v"], p["c_a"], p["c_g"],
                      c_a_up[l], c_a_bias[l], c_norm_gain[l])
        yd = _mixer_d(p["d"], d_mu[l], d_w0[l], d_w2[l], d_a0[l], d_a2[l], d_g2[l],
                      d_k_k[l], d_k_a[l], d_r_k[l], d_gn_w[l], d_gn_b[l])
        ys = jnp.stack([ya.astype(x.dtype), yb.astype(x.dtype), yc.astype(x.dtype), yd.astype(x.dtype)], axis=2)
        gates = jax.nn.sigmoid(p["gate"].reshape(bsz, seq, N_BRANCHES, D_MODEL))
        merged = jnp.sum(gates * jnp.einsum('bsnc,ncd->bsnd', ys, w_branch[l]), axis=2)
        x = _layer_norm(DN_ALPHA * x + merged @ w_out[l], ln_g[l, 0], ln_b[l, 0])
        y = _moe(x, router_g[l], router_g_bias[l], router_e[l], router_e_bias[l],
                 moe_w_gate[l], moe_w_up[l], moe_w_down[l])
        x = _layer_norm(DN_ALPHA * x + y, ln_g[l, 1], ln_b[l, 1])
    return x
```

```cpp
#include <hip/hip_runtime.h>
#include <cstdio>
#include <cstdint>

#define LAS __attribute__((address_space(3)))
#define GAS __attribute__((address_space(1)))
typedef unsigned short bf16;
typedef short bf16x8 __attribute__((ext_vector_type(8)));
typedef float f32x4 __attribute__((ext_vector_type(4)));
typedef float f32x2 __attribute__((ext_vector_type(2)));
typedef unsigned u32x4 __attribute__((ext_vector_type(4)));
typedef unsigned u32x2 __attribute__((ext_vector_type(2)));

namespace pg8 {
constexpr int BM = 256, BK = 64, HALF = 128, HTB = HALF * BK * 2  , STAGE_BYTES = 8 * HTB, NXCD = 8, WGM = 8;

__host__ __device__ __forceinline__ int lds_byte(int r, int c) { const int st = (r >> 4) * 2 + (c >> 5), rr = r & 15, cc = c & 31, ob = rr * 64 + cc * 2; return st * 1024 + (ob ^ (((ob >> 9) & 1) << 5)); }
__host__ __device__ __forceinline__ void stage_rc(int b, int& R, int& C) { const int st = b / 1024, sb = b % 1024, swz = sb ^ (((sb >> 9) & 1) << 5); R = (st >> 1) * 16 + swz / 64; C = (st & 1) * 32 + (swz % 64) / 2; }
__host__ __device__ __forceinline__ int perm32(int rho) { const int n = rho >> 4, i = rho & 15; return 8 * (i >> 2) + 4 * n + (i & 3); }

struct Unit { int pm, pn, pb; unsigned aoff; };
struct Gemm { const bf16* A; const bf16* Bt; int lda, ldb, K; };

struct GridOrder {
    int nM, nN, nwg, G, c, a_grp, a_grp_bytes;
    __device__ void init(int nM_, int nN_, int G_, int c_, int a_grp_ = 0, int a_grp_bytes_ = 0) { nM = nM_; nN = nN_; nwg = nM * nN; G = G_; c = c_; a_grp = a_grp_; a_grp_bytes = a_grp_bytes_; }
    __device__ bool next(int i, Unit& u) const {
        const long L = (long)i * G + c; if (L >= nwg) return false;
        int wgid = (int)L; { const int q = nwg / NXCD, r = nwg % NXCD, xcd = wgid % NXCD, off = wgid / NXCD; wgid = (xcd < r ? xcd * (q + 1) : r * (q + 1) + (xcd - r) * q) + off; }
        const int nig = WGM * nN, gid = wgid / nig, fm = gid * WGM, gsz = (nM - fm) < WGM ? (nM - fm) : WGM;
        u.pm = fm + ((wgid % nig) % gsz); u.pn = (wgid % nig) / gsz; u.pb = u.pn; u.aoff = a_grp ? (unsigned)((u.pn / a_grp) * a_grp_bytes) : 0u; return true;
    }
};
struct MoeOrder {
    const LAS int* tstart; int nsl, G, c;
    __device__ bool next(int i, Unit& u) const {
        const int L = i * G + c, total = tstart[32] << nsl; if (L >= total) return false;
        const int rt = L >> nsl, pn = L & ((1 << nsl) - 1); int e = 0;
#pragma unroll 1
        for (int k = 1; k < 32; ++k) e += (rt >= tstart[k]) ? 1 : 0;
        u.pm = rt; u.pn = pn; u.pb = (e << nsl) + pn; u.aoff = 0u; return true;
    }
};

__device__ __forceinline__ unsigned cvt_pk_bf16(float lo, float hi) { unsigned r; asm volatile("v_cvt_pk_bf16_f32 %0, %1, %2" : "=v"(r) : "v"(lo), "v"(hi)); return r; }

template <class Epi, class Sched>
__device__ __forceinline__ void gemm_phase(LAS unsigned char* lds, const Gemm g, const Sched& S, const Epi& E, const int tid) {
    const int wid = __builtin_amdgcn_readfirstlane(tid >> 6), lane = tid & 63, wr = wid >> 2, wc = wid & 3, fr = lane & 15, fq = lane >> 4;
    const int K = g.K, nt = K / BK;
    unsigned voffA[2], voffB[2];
#pragma unroll
    for (int i = 0; i < 2; ++i) { int R, C; stage_rc(tid * 16 + i * 8192, R, C); const int Rb = Epi::PERM ? ((R & ~31) + perm32(R & 31)) : R;
        voffA[i] = (unsigned)(R * g.lda + C) * 2u; voffB[i] = (unsigned)(Rb * g.ldb + C) * 2u; }
    const size_t kstep = (size_t)(BK * 2);
    const size_t hstepA = (size_t)HALF * g.lda * 2, hstepB = (size_t)HALF * g.ldb * 2;
    const size_t tstepA = 2 * hstepA, tstepB = 2 * hstepB;
    const unsigned ldsw = (unsigned)wid * 1024u;
    const int aoff = lds_byte(wr * 64 + fr, fq * 8), boff = lds_byte(wc * 32 + fr, fq * 8);
#define PG8_SA(b, h) (((b) * 2 + (h)) * HTB)
#define PG8_SB(b, h) ((4 + (b) * 2 + (h)) * HTB)
#define PG8_STAGE(bufoff, gbase, voff) do { _Pragma("unroll") for (int _i = 0; _i < 2; ++_i) \
        __builtin_amdgcn_global_load_lds((const unsigned*)((const char*)(gbase) + (voff)[_i]), (LAS unsigned*)(lds + (bufoff) + ldsw + _i * 8192), 16, 0, 0); } while (0)
#define PG8_LDA(dst, b, h) do { _Pragma("unroll") for (int m = 0; m < 4; ++m) _Pragma("unroll") for (int k = 0; k < 2; ++k) dst[m][k] = *(const LAS bf16x8*)(lds + PG8_SA(b, h) + aoff + m * 2048 + k * 1024); } while (0)
#define PG8_LDB(dst, b, h) do { _Pragma("unroll") for (int n = 0; n < 2; ++n) _Pragma("unroll") for (int k = 0; k < 2; ++k) dst[n][k] = *(const LAS bf16x8*)(lds + PG8_SB(b, h) + boff + n * 2048 + k * 1024); } while (0)
#define PG8_MMA(ai, bj, At, Bt) do { __builtin_amdgcn_s_setprio(1); _Pragma("unroll") for (int m = 0; m < 4; ++m) _Pragma("unroll") for (int n = 0; n < 2; ++n) _Pragma("unroll") for (int k = 0; k < 2; ++k) \
        acc[ai][bj][m][n] = __builtin_amdgcn_mfma_f32_16x16x32_bf16(Bt[n][k], At[m][k], acc[ai][bj][m][n], 0, 0, 0); __builtin_amdgcn_s_setprio(0); } while (0)
#define PG8_WAIT_V(n) asm volatile("s_waitcnt vmcnt(" #n ")" ::: "memory")
#define PG8_WAIT_L(n) asm volatile("s_waitcnt lgkmcnt(" #n ")" ::: "memory")
#define PG8_BAR __builtin_amdgcn_s_barrier()
#define PG8_SCHED __builtin_amdgcn_sched_barrier(0)
    Unit cur, nxt; int ui = 0;
    if (!S.next(0, cur)) return;
    f32x4 acc[2][2][4][2];
#pragma unroll
    for (int a = 0; a < 2; ++a)
#pragma unroll
        for (int b = 0; b < 2; ++b)
#pragma unroll
            for (int m = 0; m < 4; ++m)
#pragma unroll
                for (int n = 0; n < 2; ++n) acc[a][b][m][n] = (f32x4){0.f, 0.f, 0.f, 0.f};
    bf16x8 At[4][2], B0[2][2], B1[2][2];
    const char* cA = (const char*)g.A + (size_t)cur.pm * tstepA + cur.aoff; const char* cB = (const char*)g.Bt + (size_t)cur.pb * tstepB;
    PG8_STAGE(PG8_SB(0, 0), cB, voffB); PG8_STAGE(PG8_SB(0, 1), cB + hstepB, voffB); PG8_STAGE(PG8_SA(0, 0), cA, voffA); PG8_STAGE(PG8_SA(0, 1), cA + hstepA, voffA);
    if (wr == 1) PG8_BAR;
    PG8_WAIT_V(2); PG8_BAR;
    PG8_STAGE(PG8_SB(1, 0), cB + kstep, voffB); PG8_STAGE(PG8_SA(1, 0), cA + kstep, voffA); PG8_STAGE(PG8_SB(1, 1), cB + hstepB + kstep, voffB);
    PG8_WAIT_V(6); PG8_BAR;
    for (;;) {
        const bool has_next = S.next(ui + 1, nxt);
        const char* nA = has_next ? (const char*)g.A + (size_t)nxt.pm * tstepA + nxt.aoff : cA; const char* nB = has_next ? (const char*)g.Bt + (size_t)nxt.pb * tstepB : cB;
        for (int t = 0; t < nt; t += 2) {
            const bool last = (t == nt - 2);
            const char* a1 = cA + (size_t)(t + 1) * kstep;
            const char* a2 = last ? nA : cA + (size_t)(t + 2) * kstep; const char* b2 = last ? nB : cB + (size_t)(t + 2) * kstep;
            const char* a3 = a2 + kstep; const char* b3 = b2 + kstep;
            PG8_LDB(B0, 0, 0); PG8_LDB(B1, 0, 1); PG8_SCHED; PG8_LDA(At, 0, 0); PG8_STAGE(PG8_SA(1, 1), a1 + hstepA, voffA);
            PG8_WAIT_V(8); PG8_WAIT_L(0); PG8_BAR; PG8_MMA(0, 0, At, B0); PG8_MMA(0, 1, At, B1); PG8_BAR; PG8_SCHED;
            PG8_LDA(At, 0, 1); PG8_STAGE(PG8_SB(0, 0), b2, voffB); PG8_STAGE(PG8_SB(0, 1), b2 + hstepB, voffB); PG8_STAGE(PG8_SA(0, 0), a2, voffA);
            PG8_WAIT_V(8); PG8_WAIT_L(0); PG8_BAR; PG8_MMA(1, 0, At, B0); PG8_MMA(1, 1, At, B1); PG8_BAR; PG8_SCHED;
            PG8_LDB(B0, 1, 0); PG8_LDB(B1, 1, 1); PG8_SCHED; PG8_LDA(At, 1, 0); PG8_STAGE(PG8_SA(0, 1), a2 + hstepA, voffA);
            PG8_WAIT_V(8); PG8_WAIT_L(0); PG8_BAR; PG8_MMA(0, 0, At, B0); PG8_MMA(0, 1, At, B1); PG8_BAR; PG8_SCHED;
            PG8_LDA(At, 1, 1); PG8_STAGE(PG8_SB(1, 0), b3, voffB); PG8_STAGE(PG8_SB(1, 1), b3 + hstepB, voffB); PG8_STAGE(PG8_SA(1, 0), a3, voffA);
            PG8_WAIT_V(8); PG8_WAIT_L(0); PG8_BAR; PG8_MMA(1, 0, At, B0); PG8_MMA(1, 1, At, B1); PG8_BAR; PG8_SCHED;
        }
        if (wr == 0) PG8_BAR;
        { unsigned on_ = ~0u; asm volatile("" : "+s"(on_)); const int lz_ = (int)__builtin_amdgcn_mbcnt_hi(on_, __builtin_amdgcn_mbcnt_lo(on_, 0u));
          E(acc, cur, wr, wc, lz_ & 15, lz_ >> 4); }
        if (!has_next) break;
#pragma unroll
        for (int a = 0; a < 2; ++a)
#pragma unroll
            for (int b = 0; b < 2; ++b)
#pragma unroll
                for (int m = 0; m < 4; ++m)
#pragma unroll
                    for (int n = 0; n < 2; ++n) acc[a][b][m][n] = (f32x4){0.f, 0.f, 0.f, 0.f};
        cur = nxt; cA = nA; cB = nB; ++ui;
        if (wr == 1) PG8_BAR;
    }
    PG8_WAIT_V(0);
    PG8_BAR;
#undef PG8_SA
#undef PG8_SB
#undef PG8_STAGE
#undef PG8_LDA
#undef PG8_LDB
#undef PG8_MMA
#undef PG8_WAIT_V
#undef PG8_WAIT_L
#undef PG8_BAR
#undef PG8_SCHED
}
}

constexpr int NTOK = 65536, DM = 1024, SEQ = 2048, NBATCH = 32, NLAYER = 4;
constexpr int PW = 3072;
constexpr int PC_AQ = 0, PC_AK = 256, PC_AV = 512, PC_BQ = 768, PC_CKV = 1024, PC_IQ = 1088, PC_IK = 1344, PC_IW = 1376,
              PC_CQ = 1384, PC_CK = 1512, PC_CV = 1640, PC_CA = 1896, PC_CG = 1912, PC_D = 2168;
constexpr int IN_W = 7096;
constexpr float LN_EPS = 1e-5f;
constexpr float DN_ALPHA = 1.6817928305074292f;
constexpr int NWAVES = 8, NTHR = 512;
constexpr int MOE_ROWS = 2 * NTOK + 32 * 256;

constexpr size_t MiB = 1u << 20;
constexpr size_t WS_CTL = 0, CTL_ZERO_BYTES = 1 * MiB;
constexpr size_t WS_TOK = 1 * MiB;
constexpr size_t WS_ROW = 3 * MiB;
constexpr size_t WS_BON = 5 * MiB;
constexpr size_t WS_RT = 6 * MiB;
constexpr size_t WS_CKVN = 8 * MiB;
constexpr size_t WS_CA = 16 * MiB;
constexpr size_t WS_W = 48 * MiB;
constexpr size_t WL_IN = 0, WL_BR = 14 * MiB, WL_OUT = 16 * MiB, WL_GU = 18 * MiB, WL_DN = 50 * MiB, WL_SIZE = 66 * MiB;
constexpr size_t WS_XB = 312 * MiB;
constexpr size_t WS_BIG = 440 * MiB;
constexpr size_t BIG_DW = 384 * MiB, BIG_DAI = 448 * MiB, BIG_DG = 480 * MiB;
constexpr size_t BIG_H = 272 * MiB;
constexpr size_t WS_END = 952 * MiB;
constexpr size_t DO_YS = 0, DO_MG = 128 * MiB, DO_DR = 128 * MiB, DO_DKP = 160 * MiB, DO_DV = 192 * MiB, DO_DKK = 224 * MiB;

constexpr int CW_TMO = 0, CW_CODE = 1;
constexpr int CW_BAR = 4096;
constexpr int CW_Q = 8192;
constexpr int CW_CNT = 16384;

constexpr int RING_BYTES = 131072;
constexpr int MISC_OFF = RING_BYTES;
constexpr int TST_OFF = MISC_OFF + 512;
constexpr int BKT_OFF = MISC_OFF + 1024;
constexpr int RPB_OFF = MISC_OFF + 3072;
constexpr int LDS_BYTES = 147456;

#define LDS_WAIT() asm volatile("s_waitcnt lgkmcnt(0)" ::: "memory")
#define VM_WAIT() asm volatile("s_waitcnt vmcnt(0)" ::: "memory")
__device__ __forceinline__ float bf2f(unsigned b) { return __uint_as_float(b << 16); }
__device__ __forceinline__ unsigned f2bf(float f) { unsigned u = __float_as_uint(f); return (u + 0x7fffu + ((u >> 16) & 1u)) >> 16; }
__device__ __forceinline__ unsigned pk2(float lo, float hi) { return f2bf(lo) | (f2bf(hi) << 16); }
__device__ __forceinline__ float bflo(unsigned w) { return __uint_as_float(w << 16); }
__device__ __forceinline__ float bfhi(unsigned w) { return __uint_as_float(w & 0xffff0000u); }
__device__ __forceinline__ float wave_sum(float v) {
#pragma unroll
    for (int o = 1; o < 64; o <<= 1) v += __shfl_xor(v, o);
    return v;
}
__device__ __forceinline__ float wave_max(float v) {
#pragma unroll
    for (int o = 1; o < 64; o <<= 1) v = fmaxf(v, __shfl_xor(v, o));
    return v;
}
template <int CTRL> __device__ __forceinline__ float dppf(float v) {
    return __builtin_bit_cast(float, __builtin_amdgcn_update_dpp(0, __builtin_bit_cast(int, v), CTRL, 0xf, 0xf, true));
}
__device__ __forceinline__ float sum8(float v) { v += dppf<0xB1>(v); v += dppf<0x4E>(v); v += dppf<0x141>(v); return v; }
__device__ __forceinline__ float sigmoidf_(float x) { return 1.f / (1.f + __expf(-x)); }
__device__ __forceinline__ float log_sigmoidf_(float z) { return fminf(z, 0.f) - log1pf(__expf(-fabsf(z))); }

#define XB_TMO      128
#define XB_XCNT(j)  (256  + 64 * (j))
#define XB_XSUB(j)  (1280 + 64 * (j))
#define XB_XGEN(j)  (2304 + 64 * (j))
#define XB_TOP      3328
#define XB_TOPGEN   3392
#define XCD_BAR_WORDS 3456
#define XB_SPIN_CAP (1u << 22)

__device__ __forceinline__ unsigned xb_ld(unsigned* p)              { return __hip_atomic_load(p, __ATOMIC_RELAXED, __HIP_MEMORY_SCOPE_AGENT); }
__device__ __forceinline__ unsigned xb_add(unsigned* p, unsigned v) { return __hip_atomic_fetch_add(p, v, __ATOMIC_RELAXED, __HIP_MEMORY_SCOPE_AGENT); }
__device__ __forceinline__ unsigned xb_xcc_id() { return (unsigned)__builtin_amdgcn_s_getreg((3 << 11) | 20) & 0xFu; }
#define XB_SPIN(cond, bar) do { unsigned _sp = 0; while (cond) { __builtin_amdgcn_s_sleep(1); \
    if ((++_sp & 255u) == 0u) { if (xb_ld(&(bar)[XB_TMO])) break; if (_sp > XB_SPIN_CAP) { atomicAdd(&(bar)[XB_TMO], 1u); break; } } } } while (0)

struct XcdBarrier { unsigned* bar; unsigned x; volatile LAS unsigned* st; };

__device__ __forceinline__ XcdBarrier xcd_barrier_post(unsigned* bar, volatile LAS unsigned* st) {
    XcdBarrier b; b.bar = bar; b.x = xb_xcc_id(); b.st = st;
    if (threadIdx.x == 0) (void)xb_add(&bar[XB_XCNT(b.x)], 1u);
    return b;
}
__device__ __forceinline__ void xcd_barrier_complete(unsigned* bar, unsigned x, unsigned& nloc, unsigned& nx) {
    const unsigned G = gridDim.x * gridDim.y * gridDim.z;
    unsigned sum, cnt, mine, sp = 0u;
    for (;;) {
        sum = 0u; cnt = 0u; mine = 0u;
#pragma unroll
        for (unsigned j = 0; j < 16; ++j) { const unsigned c = xb_ld(&bar[XB_XCNT(j)]); sum += c; cnt += (c > 0u) ? 1u : 0u; mine = (j == x) ? c : mine; }
        if (sum == G) break;
        __builtin_amdgcn_s_sleep(1);
        if ((++sp & 255u) == 0u) { if (xb_ld(&bar[XB_TMO])) break; if (sp > XB_SPIN_CAP) { atomicAdd(&bar[XB_TMO], 1u); break; } }
    }
    nloc = mine > 0u ? mine : 1u; nx = cnt > 0u ? cnt : 1u;
}
__device__ __forceinline__ void xcd_barrier(const XcdBarrier& b) {
    asm volatile("s_waitcnt vmcnt(0)" ::: "memory");
    __syncthreads();
    if (threadIdx.x == 0) {
        unsigned* bar = b.bar;
        __builtin_amdgcn_s_waitcnt(0);
        unsigned nloc = b.st[0], nx = b.st[1];
        if (nloc == 0u) { xcd_barrier_complete(bar, b.x, nloc, nx); b.st[0] = nloc; b.st[1] = nx; }
        const unsigned old = xb_add(&bar[XB_XSUB(b.x)], 1u);
        const unsigned gen = old / nloc;
        if (old + 1u == (gen + 1u) * nloc) {
            __builtin_amdgcn_fence(__ATOMIC_RELEASE, "agent");
            asm volatile("s_waitcnt vmcnt(0)" ::: "memory");
            const unsigned og = xb_add(&bar[XB_TOP], 1u);
            const unsigned tg = og / nx;
            if (og + 1u == (tg + 1u) * nx) xb_add(&bar[XB_TOPGEN], 1u);
            else XB_SPIN(xb_ld(&bar[XB_TOPGEN]) == tg, bar);
            __builtin_amdgcn_fence(__ATOMIC_ACQUIRE, "agent");
            xb_add(&bar[XB_XGEN(b.x)], 1u);
            asm volatile("s_waitcnt vmcnt(0)" ::: "memory");
        } else {
            XB_SPIN(xb_ld(&bar[XB_XGEN(b.x)]) == gen, bar);
            __builtin_amdgcn_fence(__ATOMIC_ACQUIRE, "agent");
            asm volatile("s_waitcnt vmcnt(0)" ::: "memory");
        }
    }
    __syncthreads();
}

struct Args { const float* in[30]; float* out; unsigned char* ws; int l_lo, l_hi, ph_lo, ph_hi, use_bar, pad; };

namespace pg8 {
struct EpiStoreBf16 {
    static constexpr bool PERM = true;
    bf16* O; int ldc;
    __device__ __forceinline__ void operator()(const f32x4 (&acc)[2][2][4][2], const Unit& u, int wr, int wc, int fr, int fq) const {
        const int row0 = u.pm * BM + wr * 64 + fr, col0 = u.pn * BM + wc * 32 + 8 * fq;
#pragma unroll
        for (int ai = 0; ai < 2; ++ai)
#pragma unroll
            for (int m = 0; m < 4; ++m) { bf16* rowp = O + (size_t)(row0 + ai * HALF + m * 16) * ldc + col0;
#pragma unroll
                for (int bj = 0; bj < 2; ++bj) { const f32x4 v0 = acc[ai][bj][m][0], v1 = acc[ai][bj][m][1];
                    u32x4 w; w.x = cvt_pk_bf16(v0[0], v0[1]); w.y = cvt_pk_bf16(v0[2], v0[3]); w.z = cvt_pk_bf16(v1[0], v1[1]); w.w = cvt_pk_bf16(v1[2], v1[3]);
                    *(u32x4*)(rowp + bj * HALF) = w; } }
    }
};
struct EpiGate {
    static constexpr bool PERM = false;
    const bf16* BR; bf16* MG;
    __device__ __forceinline__ void operator()(const f32x4 (&acc)[2][2][4][2], const Unit& u, int wr, int wc, int fr, int fq) const {
        const int row0 = u.pm * BM + wr * 64 + fr, j0 = u.pn * 64 + wc * 16 + 4 * fq;
#pragma unroll
        for (int ai = 0; ai < 2; ++ai)
#pragma unroll
            for (int m = 0; m < 4; ++m) { const size_t r = (size_t)(row0 + ai * HALF + m * 16);
                float mg0 = 0.f, mg1 = 0.f, mg2 = 0.f, mg3 = 0.f;
#pragma unroll
                for (int bj = 0; bj < 2; ++bj)
#pragma unroll
                    for (int n = 0; n < 2; ++n) { const int g = 2 * bj + n; const u32x2 b = *(const u32x2*)(BR + r * 4096 + g * 1024 + j0); const f32x4 a = acc[ai][bj][m][n];
                        mg0 += sigmoidf_(a[0]) * bflo(b.x); mg1 += sigmoidf_(a[1]) * bfhi(b.x); mg2 += sigmoidf_(a[2]) * bflo(b.y); mg3 += sigmoidf_(a[3]) * bfhi(b.y); }
                u32x2 w; w.x = cvt_pk_bf16(mg0, mg1); w.y = cvt_pk_bf16(mg2, mg3);
                *(u32x2*)(MG + r * 1024 + j0) = w; }
    }
};
struct EpiOut {
    static constexpr bool PERM = true;
    bf16* XB;
    __device__ __forceinline__ void operator()(const f32x4 (&acc)[2][2][4][2], const Unit& u, int wr, int wc, int fr, int fq) const {
        const int row0 = u.pm * BM + wr * 64 + fr, col0 = u.pn * BM + wc * 32 + 8 * fq;
#pragma unroll
        for (int ai = 0; ai < 2; ++ai)
#pragma unroll
            for (int m = 0; m < 4; ++m) { bf16* rowp = XB + (size_t)(row0 + ai * HALF + m * 16) * 1024 + col0;
#pragma unroll
                for (int bj = 0; bj < 2; ++bj) { const f32x4 v0 = acc[ai][bj][m][0], v1 = acc[ai][bj][m][1]; const u32x4 x = *(const u32x4*)(rowp + bj * HALF);
                    u32x4 w; w.x = cvt_pk_bf16(DN_ALPHA * bflo(x.x) + v0[0], DN_ALPHA * bfhi(x.x) + v0[1]); w.y = cvt_pk_bf16(DN_ALPHA * bflo(x.y) + v0[2], DN_ALPHA * bfhi(x.y) + v0[3]);
                    w.z = cvt_pk_bf16(DN_ALPHA * bflo(x.z) + v1[0], DN_ALPHA * bfhi(x.z) + v1[1]); w.w = cvt_pk_bf16(DN_ALPHA * bflo(x.w) + v1[2], DN_ALPHA * bfhi(x.w) + v1[3]);
                    *(u32x4*)(rowp + bj * HALF) = w; } }
    }
};
struct EpiUp {
    static constexpr bool PERM = true;
    const unsigned* rowinfo; bf16* H;
    __device__ __forceinline__ void operator()(const f32x4 (&acc)[2][2][4][2], const Unit& u, int wr, int wc, int fr, int fq) const {
        const int row0 = u.pm * BM + wr * 64 + fr, col0 = u.pn * 128 + wc * 32 + 8 * fq;
#pragma unroll
        for (int ai = 0; ai < 2; ++ai)
#pragma unroll
            for (int m = 0; m < 4; ++m) { const size_t r = (size_t)(row0 + ai * HALF + m * 16); const float w = __uint_as_float(rowinfo[2 * r + 1]);
                const f32x4 g0 = acc[ai][0][m][0], g1 = acc[ai][0][m][1], u0 = acc[ai][1][m][0], u1 = acc[ai][1][m][1];
                float h[8];
#pragma unroll
                for (int e = 0; e < 4; ++e) { h[e] = g0[e] * sigmoidf_(g0[e]) * u0[e] * w; h[4 + e] = g1[e] * sigmoidf_(g1[e]) * u1[e] * w; }
                u32x4 o; o.x = cvt_pk_bf16(h[0], h[1]); o.y = cvt_pk_bf16(h[2], h[3]); o.z = cvt_pk_bf16(h[4], h[5]); o.w = cvt_pk_bf16(h[6], h[7]);
                *(u32x4*)(H + r * 256 + col0) = o; }
    }
};
struct EpiDown {
    static constexpr bool PERM = true;
    const unsigned* rowinfo; bf16* Y;
    __device__ __forceinline__ void operator()(const f32x4 (&acc)[2][2][4][2], const Unit& u, int wr, int wc, int fr, int fq) const {
        const int row0 = u.pm * BM + wr * 64 + fr, col0 = u.pn * BM + wc * 32 + 8 * fq;
#pragma unroll
        for (int ai = 0; ai < 2; ++ai)
#pragma unroll
            for (int m = 0; m < 4; ++m) { const size_t r = (size_t)(row0 + ai * HALF + m * 16); const int ri = (int)rowinfo[2 * r];
                if (ri >= 0) { bf16* rowp = Y + ((size_t)(ri & 1) * NTOK + (size_t)(ri >> 1)) * 1024 + col0;
#pragma unroll
                    for (int bj = 0; bj < 2; ++bj) { const f32x4 v0 = acc[ai][bj][m][0], v1 = acc[ai][bj][m][1];
                        u32x4 w; w.x = cvt_pk_bf16(v0[0], v0[1]); w.y = cvt_pk_bf16(v0[2], v0[3]); w.z = cvt_pk_bf16(v1[0], v1[1]); w.w = cvt_pk_bf16(v1[2], v1[3]);
                        *(u32x4*)(rowp + bj * HALF) = w; } } }
    }
};
}

struct RowMap { int kind, base, g, off;
    __device__ __forceinline__ int operator()(int n) const {
        if (kind == 0) return base + n;
        if (kind == 1) { const int j = base + n, jj = j & 63, pn = j >> 6; return 3072 + pn * 256 + 128 * (g >> 1) + 32 * (jj >> 4) + 16 * (g & 1) + 4 * ((jj >> 2) & 3) + (jj & 3); }
        const int h = base + n; return (h >> 7) * 256 + off + (h & 127);
    }
};
__device__ __forceinline__ void transpose_item(const float* W, int ldw, int k0, int scol0, int nvalid, bf16* WT, int ldk, const RowMap& rm, LAS float* scr, int lane) {
    const int nn = lane & 31;
#pragma unroll 8
    for (int i = 0; i < 32; ++i) { const int kk = 2 * i + (lane >> 5); scr[kk * 33 + nn] = (nn < nvalid) ? W[(size_t)(k0 + kk) * ldw + scol0 + nn] : 0.f; }
    LDS_WAIT(); asm volatile("" ::: "memory");
    const int c = lane & 7;
#pragma unroll
    for (int j = 0; j < 4; ++j) { const int n = (lane >> 3) + 8 * j; const LAS float* s = scr + (8 * c) * 33 + n;
        u32x4 o; o.x = pk2(s[0 * 33], s[1 * 33]); o.y = pk2(s[2 * 33], s[3 * 33]); o.z = pk2(s[4 * 33], s[5 * 33]); o.w = pk2(s[6 * 33], s[7 * 33]);
        *(u32x4*)(WT + (size_t)rm(n) * ldk + k0 + 8 * c) = o; }
    LDS_WAIT(); asm volatile("" ::: "memory");
}
__device__ __forceinline__ void p0_prologue(const Args& a, LAS unsigned char* lds, int gw, int NGW, int wave, int lane) {
    LAS float* scr = (LAS float*)(lds + wave * 16384);
    constexpr int IPL = 16896;
    for (int it = gw; it < NLAYER * IPL; it += NGW) {
        const int l = it / IPL; int r = it - l * IPL;
        unsigned char* wl = a.ws + WS_W + (size_t)l * WL_SIZE;
        RowMap rm; rm.kind = 0; rm.base = 0; rm.g = 0; rm.off = 0;
        if (r < 1536) { const int nt = r % 96, kt = r / 96, n0 = 32 * nt; int nv = 3000 - n0; nv = nv < 0 ? 0 : (nv > 32 ? 32 : nv); rm.base = n0;
            transpose_item(a.in[2] + (size_t)l * 1024 * IN_W, IN_W, 64 * kt, n0, nv, (bf16*)(wl + WL_IN), 1024, rm, scr, lane); continue; }
        r -= 1536;
        if (r < 2048) { const int nt = r % 128, kt = r / 128, gc0 = 32 * nt; rm.kind = 1; rm.g = gc0 >> 10; rm.base = gc0 & 1023;
            transpose_item(a.in[2] + (size_t)l * 1024 * IN_W, IN_W, 64 * kt, 3000 + gc0, 32, (bf16*)(wl + WL_IN), 1024, rm, scr, lane); continue; }
        r -= 2048;
        if (r < 512) { const int nb = r / 128, rr = r % 128, nt = rr % 32, kt = rr / 32; rm.base = nb * 1024 + 32 * nt;
            transpose_item(a.in[19] + (size_t)(l * 4 + nb) * 256 * 1024, 1024, 64 * kt, 32 * nt, 32, (bf16*)(wl + WL_BR), 256, rm, scr, lane); continue; }
        r -= 512;
        if (r < 512) { const int nt = r % 32, kt = r / 32; rm.base = 32 * nt;
            transpose_item(a.in[20] + (size_t)l * 1024 * 1024, 1024, 64 * kt, 32 * nt, 32, (bf16*)(wl + WL_OUT), 1024, rm, scr, lane); continue; }
        r -= 512;
        if (r < 8192) { const int up = r >= 4096; if (up) r -= 4096; const int e = r / 128, rr = r % 128, nt = rr % 8, kt = rr / 8; rm.kind = 2; rm.base = 32 * nt; rm.off = up ? 128 : 0;
            transpose_item(a.in[up ? 28 : 27] + (size_t)(l * 32 + e) * 1024 * 256, 256, 64 * kt, 32 * nt, 32, (bf16*)(wl + WL_GU) + (size_t)e * 512 * 1024, 1024, rm, scr, lane); continue; }
        r -= 8192;
        { const int e = r / 128, rr = r % 128, nt = rr % 32, kt = rr / 32; rm.base = 32 * nt;
            transpose_item(a.in[29] + (size_t)(l * 32 + e) * 256 * 1024, 1024, 64 * kt, 32 * nt, 32, (bf16*)(wl + WL_DN) + (size_t)e * 1024 * 256, 256, rm, scr, lane); }
    }
    { float* WRT = (float*)(a.ws + WS_RT); const int gt = gw * 64 + lane, NT = NGW * 64;
      for (int i = gt; i < NLAYER * 36 * 1024; i += NT) { const int k = i & 1023, e = (i >> 10) % 36, l = i / (36 * 1024);
          WRT[i] = e < 4 ? a.in[23][((size_t)l * 1024 + k) * 4 + e] : a.in[25][((size_t)l * 1024 + k) * 32 + (e - 4)]; }
      const f32x4* xs = (const f32x4*)a.in[0]; u32x4* xd = (u32x4*)(a.ws + WS_XB);
      for (int i = gt; i < NTOK * DM / 8; i += NT) { const f32x4 v0 = xs[2 * i], v1 = xs[2 * i + 1]; u32x4 o; o.x = pk2(v0[0], v0[1]); o.y = pk2(v0[2], v0[3]); o.z = pk2(v1[0], v1[1]); o.w = pk2(v1[2], v1[3]); xd[i] = o; } }
}

__device__ __forceinline__ float softplusf_(float x) { return fmaxf(x, 0.f) + log1pf(__expf(-fabsf(x))); }
__device__ __forceinline__ void prep_phase(const Args& a, int l, LAS unsigned char* lds, int tid, int gw, int NGW, int lane) {
    const bf16* P = (const bf16*)(a.ws + WS_BIG);
    bf16* CKVN = (bf16*)(a.ws + WS_CKVN); float* CA = (float*)(a.ws + WS_CA); float* BON = (float*)(a.ws + WS_BON);
    bf16* DR = (bf16*)((unsigned char*)a.out + DO_DR); bf16* DKP = (bf16*)((unsigned char*)a.out + DO_DKP); bf16* DV = (bf16*)((unsigned char*)a.out + DO_DV); bf16* DKK = (bf16*)((unsigned char*)a.out + DO_DKK);
    float* DW = (float*)(a.ws + WS_BIG + BIG_DW); bf16* DAI = (bf16*)(a.ws + WS_BIG + BIG_DAI); bf16* DG = (bf16*)(a.ws + WS_BIG + BIG_DG);
    const float* kvg = a.in[3] + l * 64; const float* aup = a.in[5] + l * 16 * 128; const float* abias = a.in[6] + l * 128;
    const float* mu = a.in[8] + l * 832; const float* w0 = a.in[9] + l * 256; const float* w2 = a.in[10] + l * 16 * 256; const float* a0 = a.in[11] + l * 256;
    const float* a2 = a.in[12] + l * 16 * 256; const float* g2 = a.in[13] + l * 32 * 256; const float* kkw = a.in[14] + l * 256; const float* kaw = a.in[15] + l * 256; const float* rkw = a.in[16] + l * 256;
    LAS float* sW2 = (LAS float*)lds; LAS float* sA2 = (LAS float*)(lds + 16384); LAS float* sG2 = (LAS float*)(lds + 32768); LAS float* sUP = (LAS float*)(lds + 65536);
    for (int i = tid; i < 4096; i += NTHR) { sW2[i] = w2[i]; sA2[i] = a2[i]; }
    for (int i = tid; i < 8192; i += NTHR) sG2[i] = g2[i];
    for (int i = tid; i < 2048; i += NTHR) sUP[i] = aup[i];
    __syncthreads();
    float mu_r[13], w0_r[4], a0_r[4], kk_r[4], ka_r[4], rk_r[4];
#pragma unroll
    for (int i = 0; i < 13; ++i) mu_r[i] = mu[64 * i + lane];
#pragma unroll
    for (int i = 0; i < 4; ++i) { const int c = 64 * i + lane; w0_r[i] = w0[c]; a0_r[i] = a0[c]; kk_r[i] = kkw[c]; ka_r[i] = kaw[c]; rk_r[i] = rkw[c]; }
    const float kvg_r = kvg[lane], ab0 = abias[lane], ab1 = abias[64 + lane];
    for (int m = gw; m < NTOK; m += NGW) {
        const bf16* prow = P + (size_t)m * PW; const int t = m & (SEQ - 1);
        { const float x = bf2f(prow[PC_CKV + lane]); const float ss = wave_sum(x * x); const float rn = rsqrtf(ss * (1.f / 64.f) + 1e-6f); CKVN[(size_t)m * 64 + lane] = (bf16)f2bf(x * rn * kvg_r); }
        { const float cav = (lane < 16) ? bf2f(prow[PC_CA + lane]) : 0.f; float z0 = ab0, z1 = ab1;
#pragma unroll
          for (int i = 0; i < 16; ++i) { const float cv = __shfl(cav, i); z0 += cv * sUP[i * 128 + lane]; z1 += cv * sUP[i * 128 + 64 + lane]; }
          CA[(size_t)m * 128 + lane] = __expf(log_sigmoidf_(z0) * (1.f / 16.f)); CA[(size_t)m * 128 + 64 + lane] = __expf(log_sigmoidf_(z1) * (1.f / 16.f)); }
        float xs[13];
#pragma unroll
        for (int i = 0; i < 13; ++i) { const int c = 64 * i + lane; const float cur = bf2f(prow[PC_D + c]); const float prev = (t > 0) ? bf2f(prow[PC_D + c - PW]) : 0.f; xs[i] = cur + (prev - cur) * mu_r[i]; }
        const float low = xs[12], tw = tanhf(low), sg = sigmoidf_(low);
        float wr_[4], ar_[4], gv_[4];
#pragma unroll
        for (int i = 0; i < 4; ++i) { wr_[i] = w0_r[i]; ar_[i] = a0_r[i]; gv_[i] = 0.f; }
#pragma unroll 4
        for (int j = 0; j < 16; ++j) { const float tj = __shfl(tw, j), aj = __shfl(low, 16 + j);
#pragma unroll
            for (int i = 0; i < 4; ++i) { wr_[i] += tj * sW2[j * 256 + 64 * i + lane]; ar_[i] += aj * sA2[j * 256 + 64 * i + lane]; } }
#pragma unroll 4
        for (int j = 0; j < 32; ++j) { const float sj = __shfl(sg, 32 + j);
#pragma unroll
            for (int i = 0; i < 4; ++i) gv_[i] += sj * sG2[j * 256 + 64 * i + lane]; }
#pragma unroll
        for (int i = 0; i < 4; ++i) { const int c = 64 * i + lane;
            const float w_raw = -softplusf_(-wr_[i]) - 0.5f, wdec = __expf(-__expf(w_raw));
            const float av = sigmoidf_(ar_[i]);
            const float kx = xs[4 + i]; float kkv = kx * kk_r[i]; const float nrm = sqrtf(wave_sum(kkv * kkv)); kkv = kkv / fmaxf(nrm, 1e-12f);
            const float kp = kx * (1.f + (av - 1.f) * ka_r[i]);
            const float rx = xs[i], vx = xs[8 + i];
            const float bon = wave_sum(rx * kp * rk_r[i]);
            const size_t o = (size_t)m * 256 + c;
            DR[o] = (bf16)f2bf(rx); DKP[o] = (bf16)f2bf(kp); DV[o] = (bf16)f2bf(vx); DKK[o] = (bf16)f2bf(kkv); DW[o] = wdec; DAI[o] = (bf16)f2bf(av); DG[o] = (bf16)f2bf(gv_[i]);
            if (lane == 0) BON[(size_t)m * 4 + i] = bon; }
    }
    __syncthreads();
}

__device__ __forceinline__ void dscan_item(const Args& a, int l, int bh, LAS unsigned char* lds, int tid) {
    const int b = bh >> 2, h = bh & 3, wv = tid >> 6, lane = tid & 63, row = wv * 8 + (lane >> 3), part = lane & 7;
    LAS bf16* sKK = (LAS bf16*)(lds); LAS bf16* sAI = (LAS bf16*)(lds + 8192); LAS bf16* sKP = (LAS bf16*)(lds + 16384); LAS bf16* sR = (LAS bf16*)(lds + 24576); LAS bf16* sV = (LAS bf16*)(lds + 32768);
    LAS float* sW = (LAS float*)(lds + 40960); LAS float* sY = (LAS float*)(lds + 57344);
    const bf16* DR = (const bf16*)((unsigned char*)a.out + DO_DR); const bf16* DKP = (const bf16*)((unsigned char*)a.out + DO_DKP); const bf16* DV = (const bf16*)((unsigned char*)a.out + DO_DV); const bf16* DKK = (const bf16*)((unsigned char*)a.out + DO_DKK);
    const float* DW = (const float*)(a.ws + WS_BIG + BIG_DW); const bf16* DAI = (const bf16*)(a.ws + WS_BIG + BIG_DAI); const bf16* DG = (const bf16*)(a.ws + WS_BIG + BIG_DG);
    const float* BON = (const float*)(a.ws + WS_BON); bf16* YS = (bf16*)((unsigned char*)a.out + DO_YS);
    const float* gnw = a.in[17] + l * 256 + h * 64; const float* gnb = a.in[18] + l * 256 + h * 64;
    const int ls = tid >> 3, lseg = tid & 7;
    const size_t gbase = ((size_t)b * SEQ) * 256 + h * 64 + 8 * lseg;
    float S[8];
#pragma unroll
    for (int j = 0; j < 8; ++j) S[j] = 0.f;
    u32x4 rKK, rAI, rKP, rR, rV; f32x4 rW0, rW1;
#define DS_LOAD(ch) do { const size_t gi = gbase + (size_t)((ch) * 64 + ls) * 256; rKK = *(const u32x4*)(DKK + gi); rAI = *(const u32x4*)(DAI + gi); rKP = *(const u32x4*)(DKP + gi); \
        rR = *(const u32x4*)(DR + gi); rV = *(const u32x4*)(DV + gi); rW0 = *(const f32x4*)(DW + gi); rW1 = *(const f32x4*)(DW + gi + 4); } while (0)
#define DS_STORE() do { const int li = ls * 64 + 8 * lseg; *(LAS u32x4*)(sKK + li) = rKK; *(LAS u32x4*)(sAI + li) = rAI; *(LAS u32x4*)(sKP + li) = rKP; *(LAS u32x4*)(sR + li) = rR; *(LAS u32x4*)(sV + li) = rV; \
        *(LAS f32x4*)(sW + li) = rW0; *(LAS f32x4*)(sW + li + 4) = rW1; } while (0)
    DS_LOAD(0); DS_STORE(); __syncthreads();
    for (int ch = 0; ch < SEQ / 64; ++ch) {
        if (ch + 1 < SEQ / 64) DS_LOAD(ch + 1);
#pragma unroll 2
        for (int s = 0; s < 64; ++s) {
            const int li = s * 64 + 8 * part;
            const u32x4 kk4 = *(const LAS u32x4*)(sKK + li), ai4 = *(const LAS u32x4*)(sAI + li), kp4 = *(const LAS u32x4*)(sKP + li), r4 = *(const LAS u32x4*)(sR + li);
            const f32x4 w0 = *(const LAS f32x4*)(sW + li), w1 = *(const LAS f32x4*)(sW + li + 4);
            const float vrow = bf2f(sV[s * 64 + row]);
            const float kk[8] = {bflo(kk4.x), bfhi(kk4.x), bflo(kk4.y), bfhi(kk4.y), bflo(kk4.z), bfhi(kk4.z), bflo(kk4.w), bfhi(kk4.w)};
            const float ai[8] = {bflo(ai4.x), bfhi(ai4.x), bflo(ai4.y), bfhi(ai4.y), bflo(ai4.z), bfhi(ai4.z), bflo(ai4.w), bfhi(ai4.w)};
            const float kp[8] = {bflo(kp4.x), bfhi(kp4.x), bflo(kp4.y), bfhi(kp4.y), bflo(kp4.z), bfhi(kp4.z), bflo(kp4.w), bfhi(kp4.w)};
            const float rr[8] = {bflo(r4.x), bfhi(r4.x), bflo(r4.y), bfhi(r4.y), bflo(r4.z), bfhi(r4.z), bflo(r4.w), bfhi(r4.w)};
            const float ww[8] = {w0[0], w0[1], w0[2], w0[3], w1[0], w1[1], w1[2], w1[3]};
            float sa = 0.f;
#pragma unroll
            for (int j = 0; j < 8; ++j) sa += S[j] * kk[j];
            sa = -sum8(sa);
            float y = 0.f;
#pragma unroll
            for (int j = 0; j < 8; ++j) { S[j] = S[j] * ww[j] + sa * (kk[j] * ai[j]) + vrow * kp[j]; y += S[j] * rr[j]; }
            y = sum8(y);
            if (part == 0) sY[s * 64 + row] = y;
        }
        __syncthreads();
        {
            const int li = ls * 64 + 8 * lseg; const f32x4 y0 = *(const LAS f32x4*)(sY + li), y1 = *(const LAS f32x4*)(sY + li + 4); const u32x4 v4 = *(const LAS u32x4*)(sV + li);
            const float yv[8] = {y0[0], y0[1], y0[2], y0[3], y1[0], y1[1], y1[2], y1[3]};
            const float vv[8] = {bflo(v4.x), bfhi(v4.x), bflo(v4.y), bfhi(v4.y), bflo(v4.z), bfhi(v4.z), bflo(v4.w), bfhi(v4.w)};
            float sm = 0.f;
#pragma unroll
            for (int j = 0; j < 8; ++j) sm += yv[j];
            const float mean = sum8(sm) * (1.f / 64.f); float sq = 0.f;
#pragma unroll
            for (int j = 0; j < 8; ++j) { const float d = yv[j] - mean; sq += d * d; }
            const float rstd = rsqrtf(sum8(sq) * (1.f / 64.f) + 64e-5f);
            const size_t m = (size_t)b * SEQ + ch * 64 + ls; const float bon = BON[m * 4 + h];
            const u32x4 g4 = *(const u32x4*)(DG + m * 256 + h * 64 + 8 * lseg);
            const float gg[8] = {bflo(g4.x), bfhi(g4.x), bflo(g4.y), bfhi(g4.y), bflo(g4.z), bfhi(g4.z), bflo(g4.w), bfhi(g4.w)};
            float o[8];
#pragma unroll
            for (int j = 0; j < 8; ++j) o[j] = ((yv[j] - mean) * rstd * gnw[8 * lseg + j] + gnb[8 * lseg + j] + bon * vv[j]) * gg[j];
            u32x4 w; w.x = pk2(o[0], o[1]); w.y = pk2(o[2], o[3]); w.z = pk2(o[4], o[5]); w.w = pk2(o[6], o[7]);
            *(u32x4*)(YS + m * 1024 + 768 + h * 64 + 8 * lseg) = w;
        }
        __syncthreads();
        if (ch + 1 < SEQ / 64) DS_STORE();
        __syncthreads();
    }
#undef DS_LOAD
#undef DS_STORE
}
__device__ __forceinline__ void cscan_item(const Args& a, int l, int bh, LAS unsigned char* lds, int tid) {
    const int b = bh >> 2, h = bh & 3, wv = tid >> 6, lane = tid & 63, row = wv * 8 + (lane >> 3), part = lane & 7;
    LAS bf16* sQ = (LAS bf16*)(lds); LAS bf16* sK = (LAS bf16*)(lds + 4096); LAS bf16* sV = (LAS bf16*)(lds + 8192); LAS float* sA = (LAS float*)(lds + 16384); LAS float* sY = (LAS float*)(lds + 24576);
    const bf16* P = (const bf16*)(a.ws + WS_BIG); const float* CA = (const float*)(a.ws + WS_CA); bf16* YS = (bf16*)((unsigned char*)a.out + DO_YS);
    const float* ng = a.in[7] + l * 256 + h * 64;
    const int ls = tid >> 3, lseg = tid & 7;
    const size_t tok0 = (size_t)b * SEQ;
    float S[4] = {0.f, 0.f, 0.f, 0.f};
    u32x4 rQK, rV; f32x4 rA;
    const int qs = (tid & 255) >> 2, qseg = tid & 3, isk = tid >> 8;
#define CS_LOAD(ch) do { const size_t tq = tok0 + (ch) * 64 + qs; rQK = *(const u32x4*)(P + tq * PW + (isk ? PC_CK : PC_CQ) + h * 32 + 8 * qseg); \
        const size_t tv = tok0 + (ch) * 64 + ls; rV = *(const u32x4*)(P + tv * PW + PC_CV + h * 64 + 8 * lseg); rA = *(const f32x4*)(CA + tv * 128 + h * 32 + 4 * lseg); } while (0)
#define CS_STORE() do { *(LAS u32x4*)((isk ? sK : sQ) + qs * 32 + 8 * qseg) = rQK; *(LAS u32x4*)(sV + ls * 64 + 8 * lseg) = rV; *(LAS f32x4*)(sA + ls * 32 + 4 * lseg) = rA; } while (0)
    CS_LOAD(0); CS_STORE(); __syncthreads();
    for (int ch = 0; ch < SEQ / 64; ++ch) {
        if (ch + 1 < SEQ / 64) CS_LOAD(ch + 1);
#pragma unroll 2
        for (int s = 0; s < 64; ++s) {
            const u32x2 q2 = *(const LAS u32x2*)(sQ + s * 32 + 4 * part), k2 = *(const LAS u32x2*)(sK + s * 32 + 4 * part); const f32x4 a4 = *(const LAS f32x4*)(sA + s * 32 + 4 * part);
            const float vrow = bf2f(sV[s * 64 + row]);
            const float qq[4] = {bflo(q2.x), bfhi(q2.x), bflo(q2.y), bfhi(q2.y)}; const float kk[4] = {bflo(k2.x), bfhi(k2.x), bflo(k2.y), bfhi(k2.y)};
            float o = 0.f;
#pragma unroll
            for (int j = 0; j < 4; ++j) { S[j] = a4[j] * S[j] + kk[j] * vrow; o += qq[j] * S[j]; }
            o = sum8(o) * 0.17677669529663687f;
            if (part == 0) sY[s * 64 + row] = o;
        }
        __syncthreads();
        { const int li = ls * 64 + 8 * lseg; const f32x4 y0 = *(const LAS f32x4*)(sY + li), y1 = *(const LAS f32x4*)(sY + li + 4);
            const float yv[8] = {y0[0], y0[1], y0[2], y0[3], y1[0], y1[1], y1[2], y1[3]};
            float sq = 0.f;
#pragma unroll
            for (int j = 0; j < 8; ++j) sq += yv[j] * yv[j];
            const float rn = rsqrtf(sum8(sq) * (1.f / 64.f) + 1e-6f);
            const size_t m = tok0 + ch * 64 + ls; const u32x4 g4 = *(const u32x4*)(P + m * PW + PC_CG + h * 64 + 8 * lseg);
            const float gg[8] = {bflo(g4.x), bfhi(g4.x), bflo(g4.y), bfhi(g4.y), bflo(g4.z), bfhi(g4.z), bflo(g4.w), bfhi(g4.w)};
            float o[8];
#pragma unroll
            for (int j = 0; j < 8; ++j) o[j] = gg[j] * sigmoidf_(gg[j]) * (yv[j] * rn * ng[8 * lseg + j]);
            u32x4 w; w.x = pk2(o[0], o[1]); w.y = pk2(o[2], o[3]); w.z = pk2(o[4], o[5]); w.w = pk2(o[6], o[7]);
            *(u32x4*)(YS + m * 1024 + 512 + h * 64 + 8 * lseg) = w; }
        __syncthreads();
        if (ch + 1 < SEQ / 64) CS_STORE();
        __syncthreads();
    }
#undef CS_LOAD
#undef CS_STORE
}
__device__ __forceinline__ void mixA_item(const Args& a, int m, LAS unsigned char* lds, int lane_in) {
    int lane = lane_in; asm volatile("" : "+v"(lane));
    const bf16* P = (const bf16*)(a.ws + WS_BIG); bf16* YS = (bf16*)((unsigned char*)a.out + DO_YS);
    const LAS unsigned char* bkt = lds + BKT_OFF; const LAS float* rpb = (const LAS float*)(lds + RPB_OFF);
    const int t = m & (SEQ - 1); const size_t rowb = (size_t)(m - t); const int hh = lane & 3;
    float q[64];
    { const u32x4* qp = (const u32x4*)(P + (size_t)m * PW + PC_AQ + hh * 64);
#pragma unroll
      for (int i = 0; i < 8; ++i) { const u32x4 w = qp[i]; q[8 * i + 0] = bflo(w.x) * 0.125f; q[8 * i + 1] = bfhi(w.x) * 0.125f; q[8 * i + 2] = bflo(w.y) * 0.125f; q[8 * i + 3] = bfhi(w.y) * 0.125f;
          q[8 * i + 4] = bflo(w.z) * 0.125f; q[8 * i + 5] = bfhi(w.z) * 0.125f; q[8 * i + 6] = bflo(w.w) * 0.125f; q[8 * i + 7] = bfhi(w.w) * 0.125f; } }
    float sc[25]; float mx = -INFINITY;
#pragma unroll
    for (int i = 0; i < 25; ++i) { const int e = (lane >> 2) + 16 * i; const int p = (e >= 258) ? 2 : (e >= 129 ? 1 : 0); const int j = e - 129 * p; const int s = t - (j << (2 * p));
        float v = -INFINITY;
        if (e < 387 && s >= 0) { const u32x4* kp = (const u32x4*)(P + (rowb + s) * PW + PC_AK + hh * 64); float d = 0.f;
#pragma unroll
            for (int c = 0; c < 8; ++c) { const u32x4 w = kp[c]; d += q[8 * c] * bflo(w.x) + q[8 * c + 1] * bfhi(w.x) + q[8 * c + 2] * bflo(w.y) + q[8 * c + 3] * bfhi(w.y) + q[8 * c + 4] * bflo(w.z) + q[8 * c + 5] * bfhi(w.z) + q[8 * c + 6] * bflo(w.w) + q[8 * c + 7] * bfhi(w.w); }
            v = d + rpb[bkt[t - s] * 8 + hh]; }
        sc[i] = v; mx = fmaxf(mx, v); }
    mx = fmaxf(mx, __shfl_xor(mx, 4)); mx = fmaxf(mx, __shfl_xor(mx, 8)); mx = fmaxf(mx, __shfl_xor(mx, 16)); mx = fmaxf(mx, __shfl_xor(mx, 32));
    float den = 0.f;
#pragma unroll
    for (int i = 0; i < 25; ++i) { sc[i] = __expf(sc[i] - mx); den += sc[i]; }
    den += __shfl_xor(den, 4); den += __shfl_xor(den, 8); den += __shfl_xor(den, 16); den += __shfl_xor(den, 32);
    const int h2 = lane >> 4, cq = lane & 15;
    float acc0 = 0.f, acc1 = 0.f, acc2 = 0.f, acc3 = 0.f;
#pragma unroll
    for (int i = 0; i < 25; ++i) {
#pragma unroll 1
        for (int el = 0; el < 16; ++el) { const int e = 16 * i + el; const int p = (e >= 258) ? 2 : (e >= 129 ? 1 : 0); const int j = e - 129 * p; const int s = t - (j << (2 * p));
            if (e < 387 && s >= 0) { const float pe = __shfl(sc[i], 4 * el + h2); const u32x2 w = *(const u32x2*)(P + (rowb + s) * PW + PC_AV + h2 * 64 + 4 * cq);
                acc0 += pe * bflo(w.x); acc1 += pe * bfhi(w.x); acc2 += pe * bflo(w.y); acc3 += pe * bfhi(w.y); } } }
    const float rd = 1.f / __shfl(den, h2);
    u32x2 o; o.x = pk2(acc0 * rd, acc1 * rd); o.y = pk2(acc2 * rd, acc3 * rd);
    *(u32x2*)(YS + (size_t)m * 1024 + h2 * 64 + 4 * cq) = o;
}
__device__ __forceinline__ unsigned fkey(float f) { const unsigned u = __float_as_uint(f); return (u & 0x80000000u) ? ~u : (u | 0x80000000u); }
__device__ __forceinline__ void mixB_item(const Args& a, int l, int m, LAS unsigned char* lds, LAS unsigned char* wscr, int lane_in) {
    int lane = lane_in; asm volatile("" : "+v"(lane));
    const bf16* P = (const bf16*)(a.ws + WS_BIG); const bf16* CKVN = (const bf16*)(a.ws + WS_CKVN); bf16* YS = (bf16*)((unsigned char*)a.out + DO_YS);
    const LAS unsigned char* bkt = lds + BKT_OFF; const LAS float* rpb = (const LAS float*)(lds + RPB_OFF);
    LAS float* siq = (LAS float*)wscr; LAS float* sq = (LAS float*)(wscr + 1024); LAS unsigned short* sidx = (LAS unsigned short*)(wscr + 2048);
    const int t = m & (SEQ - 1); const size_t rowb = (size_t)(m - t); const bf16* prow = P + (size_t)m * PW;
    { const u32x2 w = *(const u32x2*)(prow + PC_IQ + 4 * lane); const float s = 0.17677669529663687f;
      *(LAS f32x4*)(siq + 4 * lane) = (f32x4){bflo(w.x) * s, bfhi(w.x) * s, bflo(w.y) * s, bfhi(w.y) * s};
      const u32x2 v = *(const u32x2*)(prow + PC_BQ + 4 * lane);
      *(LAS f32x4*)(sq + 4 * lane) = (f32x4){bflo(v.x) * 0.125f, bfhi(v.x) * 0.125f, bflo(v.y) * 0.125f, bfhi(v.y) * 0.125f}; }
    LAS float* siw = (LAS float*)(wscr + 2560);
    if (lane < 8) siw[lane] = bf2f(prow[PC_IW + lane]) * 0.35355339059327373f;
    LDS_WAIT(); asm volatile("" ::: "memory");
    float sc[32];
    const int nblk = (t >> 6) + 1;
#pragma unroll
    for (int i = 0; i < 32; ++i) {
        float v = -INFINITY; asm volatile("" ::: "memory");
        if (i < nblk) { const int s = lane + 64 * i; const u32x4* kp = (const u32x4*)(P + (rowb + s) * PW + PC_IK);
            float kf[32];
#pragma unroll
            for (int c = 0; c < 4; ++c) { const u32x4 w = kp[c]; kf[8 * c] = bflo(w.x); kf[8 * c + 1] = bfhi(w.x); kf[8 * c + 2] = bflo(w.y); kf[8 * c + 3] = bfhi(w.y); kf[8 * c + 4] = bflo(w.z); kf[8 * c + 5] = bfhi(w.z); kf[8 * c + 6] = bflo(w.w); kf[8 * c + 7] = bfhi(w.w); }
            float score = 0.f;
#pragma unroll 1
            for (int h = 0; h < 8; ++h) { float d = 0.f;
#pragma unroll
                for (int c = 0; c < 8; ++c) { const f32x4 qv = *(const LAS f32x4*)(siq + h * 32 + 4 * c); d += qv[0] * kf[4 * c] + qv[1] * kf[4 * c + 1] + qv[2] * kf[4 * c + 2] + qv[3] * kf[4 * c + 3]; }
                score += fmaxf(d, 0.f) * siw[h]; }
            v = (s <= t) ? score : -INFINITY; }
        sc[i] = v; }
    unsigned Kth = 0u; bool exact = false; int need = 0;
    if (t + 1 > 256) {
#pragma unroll 1
        for (int bit = 31; bit >= 0; --bit) { const unsigned cand = Kth | (1u << bit); int cnt = 0;
#pragma unroll
            for (int i = 0; i < 32; ++i) cnt += __popcll(__ballot(fkey(sc[i]) >= cand));
            if (cnt >= 256) { Kth = cand; if (cnt == 256) { exact = true; break; } } }
        if (!exact) { int cgt = 0;
#pragma unroll
            for (int i = 0; i < 32; ++i) cgt += __popcll(__ballot(fkey(sc[i]) > Kth));
            need = 256 - cgt; }
    }
    const unsigned long long ltm = (1ull << lane) - 1ull;
    int base = 0, tie_taken = 0;
#pragma unroll
    for (int i = 0; i < 32; ++i) { const int s = lane + 64 * i; const unsigned k = fkey(sc[i]); bool take;
        if (t + 1 <= 256) take = (s <= t);
        else { const bool s1 = exact ? (k >= Kth) : (k > Kth); const bool tie = (!exact) && (k == Kth); const unsigned long long mt = __ballot(tie);
            take = s1 || (tie && (tie_taken + __popcll(mt & ltm)) < need); tie_taken += __popcll(mt); }
        const unsigned long long ms = __ballot(take);
        if (take) sidx[base + __popcll(ms & ltm)] = (unsigned short)s;
        base += __popcll(ms); }
    const int nsel = base;
    LDS_WAIT(); asm volatile("" ::: "memory");
    float lg[4][4]; int idxs[4];
#pragma unroll
    for (int j = 0; j < 4; ++j)
#pragma unroll
        for (int h = 0; h < 4; ++h) lg[j][h] = -INFINITY;
#pragma unroll
    for (int j = 0; j < 4; ++j) { asm volatile("" ::: "memory"); const int kk = lane + 64 * j; const bool valid = kk < nsel; const int idx = valid ? (int)sidx[kk] : 0; idxs[j] = idx;
        const u32x4* cp = (const u32x4*)(CKVN + (rowb + idx) * 64); float cf[64];
#pragma unroll
        for (int c = 0; c < 8; ++c) { const u32x4 w = cp[c]; cf[8 * c] = bflo(w.x); cf[8 * c + 1] = bfhi(w.x); cf[8 * c + 2] = bflo(w.y); cf[8 * c + 3] = bfhi(w.y); cf[8 * c + 4] = bflo(w.z); cf[8 * c + 5] = bfhi(w.z); cf[8 * c + 6] = bflo(w.w); cf[8 * c + 7] = bfhi(w.w); }
#pragma unroll 1
        for (int h = 0; h < 4; ++h) { float d = 0.f;
#pragma unroll
            for (int c = 0; c < 16; ++c) { const f32x4 qv = *(const LAS f32x4*)(sq + h * 64 + 4 * c); d += qv[0] * cf[4 * c] + qv[1] * cf[4 * c + 1] + qv[2] * cf[4 * c + 2] + qv[3] * cf[4 * c + 3]; }
            const float val = valid ? d + rpb[bkt[t - idx] * 8 + 4 + h] : -INFINITY;
#pragma unroll
            for (int hh = 0; hh < 4; ++hh) lg[j][hh] = (h == hh) ? val : lg[j][hh]; } }
    float den[4];
#pragma unroll
    for (int h = 0; h < 4; ++h) { float mx = fmaxf(fmaxf(lg[0][h], lg[1][h]), fmaxf(lg[2][h], lg[3][h])); mx = wave_max(mx); float s = 0.f;
#pragma unroll
        for (int j = 0; j < 4; ++j) { lg[j][h] = __expf(lg[j][h] - mx); s += lg[j][h]; }
        den[h] = wave_sum(s); }
    float o0 = 0.f, o1 = 0.f, o2 = 0.f, o3 = 0.f;
#pragma unroll
    for (int j = 0; j < 4; ++j) {
#pragma unroll 1
        for (int kl = 0; kl < 64; ++kl) { if (64 * j + kl >= nsel) break; const int idx = __shfl(idxs[j], kl); const float val = bf2f(CKVN[(rowb + idx) * 64 + lane]);
            o0 += __shfl(lg[j][0], kl) * val; o1 += __shfl(lg[j][1], kl) * val; o2 += __shfl(lg[j][2], kl) * val; o3 += __shfl(lg[j][3], kl) * val; } }
    o0 /= den[0]; o1 /= den[1]; o2 /= den[2]; o3 /= den[3];
    const float* wuv = a.in[4] + (size_t)l * 4 * 64 * 64;
    float y0 = 0.f, y1 = 0.f, y2 = 0.f, y3 = 0.f;
#pragma unroll 4
    for (int c = 0; c < 64; ++c) { y0 += __shfl(o0, c) * wuv[(0 * 64 + c) * 64 + lane]; y1 += __shfl(o1, c) * wuv[(1 * 64 + c) * 64 + lane]; y2 += __shfl(o2, c) * wuv[(2 * 64 + c) * 64 + lane]; y3 += __shfl(o3, c) * wuv[(3 * 64 + c) * 64 + lane]; }
    bf16* yr = YS + (size_t)m * 1024 + 256;
    yr[lane] = (bf16)f2bf(y0); yr[64 + lane] = (bf16)f2bf(y1); yr[128 + lane] = (bf16)f2bf(y2); yr[192 + lane] = (bf16)f2bf(y3);
}
__device__ __forceinline__ void mixers_phase(const Args& a, int l, LAS unsigned char* lds, int bid, int G, int tid, int wave, int lane) {
    for (int it = bid; it < 256; it += G) {
#ifndef MIX_NO_D
        if (it < 128) dscan_item(a, l, it, lds, tid);
#endif
#ifndef MIX_NO_C
        if (it >= 128) cscan_item(a, l, it - 128, lds, tid);
#endif
 __syncthreads(); }
    unsigned* qh = (unsigned*)(a.ws + WS_CTL) + CW_Q + 64 * l;
    LAS unsigned char* wscr = lds + wave * 4096;
    for (;;) {
        unsigned cq = 0; if (lane == 0) cq = __hip_atomic_fetch_add(qh, 1u, __ATOMIC_RELAXED, __HIP_MEMORY_SCOPE_AGENT);
        cq = (unsigned)__builtin_amdgcn_readfirstlane((int)cq);
        if (cq >= 16384u) break;
        if (cq < 8192u) { const int tb = 255 - (int)(cq >> 5), b = (int)(cq & 31u); const int m0 = b * SEQ + tb * 8;
#pragma unroll 1
            for (int k = 0; k < 8; ++k) {
#ifndef MIX_NO_B
                mixB_item(a, l, m0 + k, lds, wscr, lane);
#endif
            } }
        else { const int m0 = (int)(cq - 8192u) * 8;
#pragma unroll 1
            for (int k = 0; k < 8; ++k) {
#ifndef MIX_NO_A
                mixA_item(a, m0 + k, lds, lane);
#endif
            } }
    }
}

constexpr int RREC_OFF = MISC_OFF + 4096, LCNT_OFF = MISC_OFF + 10240, LBASE_OFF = MISC_OFF + 10368;
__device__ __forceinline__ void ln1_route_phase(const Args& a, int l, LAS unsigned char* lds, int bid, int G, int tid, int wave, int lane) {
    bf16* XB = (bf16*)(a.ws + WS_XB); const float* WRT = (const float*)(a.ws + WS_RT) + (size_t)l * 36 * 1024;
    unsigned* tokinfo = (unsigned*)(a.ws + WS_TOK); unsigned* cntg = (unsigned*)(a.ws + WS_CTL) + CW_CNT + (l * 32) * 64;
    const float* lng = a.in[21] + (l * 2 + 0) * 1024; const float* lnb = a.in[22] + (l * 2 + 0) * 1024;
    const float* brg = a.in[24] + l * 4; const float* bre = a.in[26] + l * 32;
    LAS float* sW = (LAS float*)lds;
    LAS unsigned* rrec = (LAS unsigned*)(lds + RREC_OFF); LAS int* lcnt = (LAS int*)(lds + LCNT_OFF); LAS unsigned* lbase = (LAS unsigned*)(lds + LBASE_OFF);
    for (int i = tid; i < 32 * 1024 / 4; i += NTHR) *(LAS f32x4*)(sW + 4 * i) = *(const f32x4*)(WRT + 4 * 1024 + 4 * i);
    f32x4 gam[4], bet[4], wg[4][4];
#pragma unroll
    for (int j = 0; j < 4; ++j) { gam[j] = *(const f32x4*)(lng + 4 * lane + 256 * j); bet[j] = *(const f32x4*)(lnb + 4 * lane + 256 * j);
#pragma unroll
        for (int e = 0; e < 4; ++e) wg[e][j] = *(const f32x4*)(WRT + e * 1024 + 4 * lane + 256 * j); }
    for (int blk = bid; blk < NTOK / 256; blk += G) {
        if (tid < 32) lcnt[tid] = 0;
        __syncthreads();
#pragma unroll 1
        for (int rg = 0; rg < 8; ++rg) {
            const int rl0 = wave * 32 + rg * 4; f32x4 x[4][4]; float mylog[4];
#pragma unroll
            for (int r = 0; r < 4; ++r) { bf16* xr = XB + (size_t)(blk * 256 + rl0 + r) * 1024; float s = 0.f;
#pragma unroll
                for (int j = 0; j < 4; ++j) { const u32x2 w = *(const u32x2*)(xr + 4 * lane + 256 * j); x[r][j] = (f32x4){bflo(w.x), bfhi(w.x), bflo(w.y), bfhi(w.y)}; s += (x[r][j][0] + x[r][j][1]) + (x[r][j][2] + x[r][j][3]); }
                const float mean = wave_sum(s) * (1.f / 1024.f); float q = 0.f;
#pragma unroll
                for (int j = 0; j < 4; ++j) { x[r][j] = x[r][j] - mean; q += (x[r][j][0] * x[r][j][0] + x[r][j][1] * x[r][j][1]) + (x[r][j][2] * x[r][j][2] + x[r][j][3] * x[r][j][3]); }
                const float rstd = rsqrtf(wave_sum(q) * (1.f / 1024.f) + LN_EPS);
#pragma unroll
                for (int j = 0; j < 4; ++j) { x[r][j] = x[r][j] * rstd * gam[j] + bet[j]; u32x2 w; w.x = pk2(x[r][j][0], x[r][j][1]); w.y = pk2(x[r][j][2], x[r][j][3]); *(u32x2*)(xr + 4 * lane + 256 * j) = w; }
                mylog[r] = 0.f; }
#pragma unroll
            for (int e = 0; e < 4; ++e)
#pragma unroll
                for (int r = 0; r < 4; ++r) { float d = 0.f;
#pragma unroll
                    for (int j = 0; j < 4; ++j) d += (x[r][j][0] * wg[e][j][0] + x[r][j][1] * wg[e][j][1]) + (x[r][j][2] * wg[e][j][2] + x[r][j][3] * wg[e][j][3]);
                    d = wave_sum(d) + brg[e]; if (lane == e) mylog[r] = d; }
#pragma unroll 1
            for (int e = 0; e < 32; ++e) { f32x4 w4[4];
#pragma unroll
                for (int j = 0; j < 4; ++j) w4[j] = *(const LAS f32x4*)(sW + e * 1024 + 4 * lane + 256 * j);
                const float be = bre[e];
#pragma unroll
                for (int r = 0; r < 4; ++r) { float d = 0.f;
#pragma unroll
                    for (int j = 0; j < 4; ++j) d += (x[r][j][0] * w4[j][0] + x[r][j][1] * w4[j][1]) + (x[r][j][2] * w4[j][2] + x[r][j][3] * w4[j][3]);
                    d = wave_sum(d) + be; if (lane == 4 + e) mylog[r] = d; } }
#pragma unroll
            for (int r = 0; r < 4; ++r) {
                const float g0 = __shfl(mylog[r], 0), g1 = __shfl(mylog[r], 1), g2 = __shfl(mylog[r], 2), g3 = __shfl(mylog[r], 3);
                int gs = 0; float gm = g0; if (g1 > gm) { gm = g1; gs = 1; } if (g2 > gm) { gm = g2; gs = 2; } if (g3 > gm) { gm = g3; gs = 3; }
                const float ptop = 1.f / (__expf(g0 - gm) + __expf(g1 - gm) + __expf(g2 - gm) + __expf(g3 - gm));
                float v0 = -INFINITY, v1 = -INFINITY; int i0 = 0, i1 = 0;
#pragma unroll
                for (int j = 0; j < 8; ++j) { const float le = __shfl(mylog[r], 4 + gs * 8 + j);
                    if (le > v0) { v1 = v0; i1 = i0; v0 = le; i0 = j; } else if (le > v1) { v1 = le; i1 = j; } }
                const float ex = __expf(v1 - v0), w0 = ptop / (1.f + ex), w1 = ptop * ex / (1.f + ex);
                if (lane == 0) { const int e0 = gs * 8 + i0, e1 = gs * 8 + i1; const int rl = rl0 + r;
                    const int p0 = atomicAdd((int*)&lcnt[e0], 1), p1 = atomicAdd((int*)&lcnt[e1], 1);
                    rrec[rl * 6 + 0] = (unsigned)e0; rrec[rl * 6 + 1] = (unsigned)p0; rrec[rl * 6 + 2] = __float_as_uint(w0); rrec[rl * 6 + 3] = (unsigned)e1; rrec[rl * 6 + 4] = (unsigned)p1; rrec[rl * 6 + 5] = __float_as_uint(w1); } }
        }
        __syncthreads();
        if (tid < 32) lbase[tid] = __hip_atomic_fetch_add(cntg + tid * 64, (unsigned)lcnt[tid], __ATOMIC_RELAXED, __HIP_MEMORY_SCOPE_AGENT);
        __syncthreads();
        if (tid < 256) { const unsigned e0 = rrec[tid * 6 + 0], e1 = rrec[tid * 6 + 3]; unsigned* ti = tokinfo + (size_t)(blk * 256 + tid) * 8;
            u32x4 o0, o1; o0.x = e0; o0.y = lbase[e0] + rrec[tid * 6 + 1]; o0.z = rrec[tid * 6 + 2]; o0.w = e1; o1.x = lbase[e1] + rrec[tid * 6 + 4]; o1.y = rrec[tid * 6 + 5]; o1.z = 0u; o1.w = 0u;
            *(u32x4*)ti = o0; *(u32x4*)(ti + 4) = o1; }
        __syncthreads();
    }
}
__device__ __forceinline__ void moe_table(const Args& a, int l, LAS unsigned char* lds, int tid) {
    LAS int* tstart = (LAS int*)(lds + TST_OFF);
    if (tid == 0) { const unsigned* cntg = (const unsigned*)(a.ws + WS_CTL) + CW_CNT + (l * 32) * 64; int acc = 0;
        for (int e = 0; e < 32; ++e) { tstart[e] = acc; acc += (int)((__hip_atomic_load(cntg + e * 64, __ATOMIC_RELAXED, __HIP_MEMORY_SCOPE_AGENT) + 255u) >> 8); }
        tstart[32] = acc; }
    __syncthreads();
}
__device__ __forceinline__ void scatter_phase(const Args& a, int l, LAS unsigned char* lds, int bid, int G, int tid, int gw, int NGW, int lane) {
    const LAS int* tstart = (const LAS int*)(lds + TST_OFF);
    const bf16* XB = (const bf16*)(a.ws + WS_XB); bf16* XS = (bf16*)(a.ws + WS_BIG); unsigned* rowinfo = (unsigned*)(a.ws + WS_ROW); const unsigned* tokinfo = (const unsigned*)(a.ws + WS_TOK);
    const unsigned* cntg = (const unsigned*)(a.ws + WS_CTL) + CW_CNT + (l * 32) * 64;
    for (int e = bid; e < 32; e += G) { const int c = (int)__hip_atomic_load(cntg + e * 64, __ATOMIC_RELAXED, __HIP_MEMORY_SCOPE_AGENT); const int r0 = tstart[e] * 256, r1 = tstart[e + 1] * 256;
        unsigned neg_ = 0xffffffffu, zer_ = 0u; asm volatile("" : "+v"(neg_), "+v"(zer_));
        for (int r = r0 + c + tid; r < r1; r += NTHR) { rowinfo[2 * (size_t)r] = neg_; rowinfo[2 * (size_t)r + 1] = zer_; } }
    for (int m = gw; m < NTOK; m += NGW) {
        const u32x4 t0 = *(const u32x4*)(tokinfo + (size_t)m * 8); const u32x2 t1 = *(const u32x2*)(tokinfo + (size_t)m * 8 + 4);
        const size_t r0 = (size_t)tstart[t0.x] * 256 + t0.y, r1 = (size_t)tstart[t0.w] * 256 + t1.x;
        const u32x4* src = (const u32x4*)(XB + (size_t)m * 1024); const u32x4 v0 = src[lane], v1 = src[64 + lane];
        u32x4* d0 = (u32x4*)(XS + r0 * 1024); u32x4* d1 = (u32x4*)(XS + r1 * 1024);
        d0[lane] = v0; d0[64 + lane] = v1; d1[lane] = v0; d1[64 + lane] = v1;
        if (lane == 0) { rowinfo[2 * r0] = (unsigned)(m * 2); rowinfo[2 * r0 + 1] = t0.z; rowinfo[2 * r1] = (unsigned)(m * 2 + 1); rowinfo[2 * r1 + 1] = t1.y; }
    }
}
__device__ __forceinline__ void ln2_phase(const Args& a, int l, int gw, int NGW, int lane) {
    bf16* XB = (bf16*)(a.ws + WS_XB); const bf16* Y = (const bf16*)(a.ws + WS_BIG);
    const float* lng = a.in[21] + (l * 2 + 1) * 1024; const float* lnb = a.in[22] + (l * 2 + 1) * 1024;
    f32x4 gam[4], bet[4];
#pragma unroll
    for (int j = 0; j < 4; ++j) { gam[j] = *(const f32x4*)(lng + 4 * lane + 256 * j); bet[j] = *(const f32x4*)(lnb + 4 * lane + 256 * j); }
    for (int m = gw; m < NTOK; m += NGW) {
        bf16* xr = XB + (size_t)m * 1024; const bf16* y0 = Y + (size_t)m * 1024; const bf16* y1 = Y + ((size_t)NTOK + m) * 1024;
        f32x4 x[4]; float s = 0.f;
#pragma unroll
        for (int j = 0; j < 4; ++j) { const u32x2 w = *(const u32x2*)(xr + 4 * lane + 256 * j), p = *(const u32x2*)(y0 + 4 * lane + 256 * j), q = *(const u32x2*)(y1 + 4 * lane + 256 * j);
            x[j] = (f32x4){DN_ALPHA * bflo(w.x) + (bflo(p.x) + bflo(q.x)), DN_ALPHA * bfhi(w.x) + (bfhi(p.x) + bfhi(q.x)), DN_ALPHA * bflo(w.y) + (bflo(p.y) + bflo(q.y)), DN_ALPHA * bfhi(w.y) + (bfhi(p.y) + bfhi(q.y))};
            s += (x[j][0] + x[j][1]) + (x[j][2] + x[j][3]); }
        const float mean = wave_sum(s) * (1.f / 1024.f); float q = 0.f;
#pragma unroll
        for (int j = 0; j < 4; ++j) { x[j] = x[j] - mean; q += (x[j][0] * x[j][0] + x[j][1] * x[j][1]) + (x[j][2] * x[j][2] + x[j][3] * x[j][3]); }
        const float rstd = rsqrtf(wave_sum(q) * (1.f / 1024.f) + LN_EPS);
#pragma unroll
        for (int j = 0; j < 4; ++j) { x[j] = x[j] * rstd * gam[j] + bet[j];
            if (l == NLAYER - 1) *(f32x4*)(a.out + (size_t)m * 1024 + 4 * lane + 256 * j) = x[j];
            else { u32x2 w; w.x = pk2(x[j][0], x[j][1]); w.y = pk2(x[j][2], x[j][3]); *(u32x2*)(xr + 4 * lane + 256 * j) = w; } }
    }
}

#ifndef MK_MULTI
#define MK_MULTI 1
#endif
constexpr int NPHASE = 12;
__device__ __forceinline__ int t5_bucket(int d) {
    if (d < 16) return d;
    int b = 16;
    b += (d >= 22) + (d >= 30) + (d >= 40) + (d >= 54) + (d >= 73) + (d >= 99) + (d >= 134) + (d >= 182) + (d >= 246) + (d >= 332) + (d >= 450) + (d >= 609) + (d >= 825) + (d >= 1117) + (d >= 1513);
    return b;
}
__global__ void __launch_bounds__(NTHR, 2) fwd(Args a) {
    extern __shared__ __attribute__((aligned(16))) unsigned char lds_raw[];
    LAS unsigned char* lds = (LAS unsigned char*)lds_raw;
    const int G0 = gridDim.x, bid0 = blockIdx.x, wave0 = __builtin_amdgcn_readfirstlane((int)(threadIdx.x >> 6));
#define PH_IDS unsigned on_ = ~0u; asm volatile("" : "+s"(on_)); int lz_ = (int)__builtin_amdgcn_mbcnt_hi(on_, __builtin_amdgcn_mbcnt_lo(on_, 0u)); int wz_ = wave0, bz_ = bid0, gz_ = G0; asm volatile("" : "+s"(wz_), "+s"(bz_), "+s"(gz_)); \
    const int lane = lz_, wave = wz_, tid = wz_ * 64 + lz_, bid = bz_, G = gz_, NGW = gz_ * NWAVES, gw = bid * NWAVES + wave; (void)lane; (void)gw; (void)wave; (void)tid; (void)NGW;
#define PH_ARGS(LV) const __attribute__((address_space(4))) Args* kp_ = (const __attribute__((address_space(4))) Args*)__builtin_amdgcn_kernarg_segment_ptr(); asm volatile("" : "+s"(kp_)); const Args& b = *(const Args*)kp_; int lq = (LV); asm volatile("" : "+s"(lq)); (void)lq; \
    bf16* XB = (bf16*)(b.ws + WS_XB); bf16* PB = (bf16*)(b.ws + WS_BIG); bf16* YS = (bf16*)((unsigned char*)b.out + DO_YS); bf16* MG = (bf16*)((unsigned char*)b.out + DO_MG); \
    unsigned* rowinfo = (unsigned*)(b.ws + WS_ROW); unsigned char* wl = b.ws + WS_W + (size_t)lq * WL_SIZE; (void)XB; (void)PB; (void)YS; (void)MG; (void)rowinfo; (void)wl;
    unsigned* ctl = (unsigned*)(a.ws + WS_CTL);
    { PH_IDS
    for (int u = tid; u < (LDS_BYTES - MISC_OFF) / 4; u += NTHR) ((LAS unsigned*)(lds + MISC_OFF))[u] = 0u;
    __syncthreads();
    for (int d = tid; d < 2048; d += NTHR) ((LAS unsigned char*)(lds + BKT_OFF))[d] = (unsigned char)t5_bucket(d);
    if (tid < 256) ((LAS float*)(lds + RPB_OFF))[tid] = a.in[1][tid];
    __syncthreads(); }
    XcdBarrier bar; bar.bar = ctl + CW_BAR; bar.x = 0; bar.st = nullptr;
    if (a.use_bar) bar = xcd_barrier_post(ctl + CW_BAR, (volatile LAS unsigned*)(lds + MISC_OFF) + 8);
#define GRID_BAR() do { if (a.use_bar) { const __attribute__((address_space(4))) Args* kq_ = (const __attribute__((address_space(4))) Args*)__builtin_amdgcn_kernarg_segment_ptr(); asm volatile("" : "+s"(kq_)); \
        XcdBarrier bb_ = bar; bb_.bar = (unsigned*)(kq_->ws + WS_CTL) + CW_BAR; xcd_barrier(bb_); } } while (0)
#ifndef PHMASK
#define PHMASK 0xFFF
#endif
#define IN(k) (((PHMASK >> (k)) & 1) && ((phm >> (k)) & 1u))

    unsigned phm = ((1u << a.ph_hi) - 1u) & ~((1u << a.ph_lo) - 1u);
    if (a.l_lo == 0 && IN(0)) { PH_IDS PH_ARGS(0) p0_prologue(b, lds, gw, NGW, wave, lane); GRID_BAR(); }
    for (int l = a.l_lo; l < a.l_hi; ++l) {
        asm volatile("" : "+s"(phm));
        if (IN(1)) { PH_IDS PH_ARGS(l) pg8::Gemm g{XB, (const bf16*)(wl + WL_IN), 1024, 1024, 1024}; pg8::GridOrder S; S.init(NTOK / 256, PW / 256, G, bid);
            pg8::EpiStoreBf16 E{PB, PW}; pg8::gemm_phase(lds, g, S, E, tid); GRID_BAR(); }
        if (IN(2)) { PH_IDS PH_ARGS(l) prep_phase(b, lq, lds, tid, gw, NGW, lane); GRID_BAR(); }
        if (IN(3)) { PH_IDS PH_ARGS(l) mixers_phase(b, lq, lds, bid, G, tid, wave, lane); GRID_BAR(); }
        if (IN(4)) { PH_IDS PH_ARGS(l) pg8::Gemm g{YS, (const bf16*)(wl + WL_BR), 1024, 256, 256}; pg8::GridOrder S; S.init(NTOK / 256, 16, G, bid, 4, 512);
            pg8::EpiStoreBf16 E{PB, 4096}; pg8::gemm_phase(lds, g, S, E, tid); GRID_BAR(); }
        if (IN(5)) { PH_IDS PH_ARGS(l) pg8::Gemm g{XB, (const bf16*)(wl + WL_IN) + (size_t)3072 * 1024, 1024, 1024, 1024}; pg8::GridOrder S; S.init(NTOK / 256, 16, G, bid);
            pg8::EpiGate E{PB, MG}; pg8::gemm_phase(lds, g, S, E, tid); GRID_BAR(); }
        if (IN(6)) { PH_IDS PH_ARGS(l) pg8::Gemm g{MG, (const bf16*)(wl + WL_OUT), 1024, 1024, 1024}; pg8::GridOrder S; S.init(NTOK / 256, 4, G, bid);
            pg8::EpiOut E{XB}; pg8::gemm_phase(lds, g, S, E, tid); GRID_BAR(); }
        if (IN(7)) { PH_IDS PH_ARGS(l) ln1_route_phase(b, lq, lds, bid, G, tid, wave, lane); GRID_BAR(); }
        if (IN(8)) { PH_IDS PH_ARGS(l) moe_table(b, lq, lds, tid); scatter_phase(b, lq, lds, bid, G, tid, gw, NGW, lane); GRID_BAR(); }
        if (IN(9)) { PH_IDS PH_ARGS(l) moe_table(b, lq, lds, tid); pg8::Gemm g{PB, (const bf16*)(wl + WL_GU), 1024, 1024, 1024}; pg8::MoeOrder S{(const LAS int*)(lds + TST_OFF), 1, G, bid};
            pg8::EpiUp E{rowinfo, (bf16*)(b.ws + WS_BIG + BIG_H)}; pg8::gemm_phase(lds, g, S, E, tid); GRID_BAR(); }
        if (IN(10)) { PH_IDS PH_ARGS(l) moe_table(b, lq, lds, tid); pg8::Gemm g{(const bf16*)(b.ws + WS_BIG + BIG_H), (const bf16*)(wl + WL_DN), 256, 256, 256}; pg8::MoeOrder S{(const LAS int*)(lds + TST_OFF), 2, G, bid};
            pg8::EpiDown E{rowinfo, PB}; pg8::gemm_phase(lds, g, S, E, tid); GRID_BAR(); }
        if (IN(11)) { PH_IDS PH_ARGS(l) ln2_phase(b, lq, gw, NGW, lane); if (l + 1 < a.l_hi) GRID_BAR(); }
    }
#undef IN
#undef GRID_BAR
}

extern "C" void kernel_launch(void* const* d_in, const int* in_sizes, int n_in, void* d_out, int out_size, void* d_ws, size_t ws_size, hipStream_t stream) {
    static int grid = 0;
    if (grid == 0) {
        if (n_in != 30 || out_size != NTOK * DM || ws_size < WS_END) { fprintf(stderr, "kernel_launch: unexpected shapes (n_in %d out %d ws %zu)\n", n_in, out_size, ws_size); grid = -1; return; }
        int dev = 0, cus = 0, per_cu = 0;
        if (hipGetDevice(&dev) != hipSuccess || hipDeviceGetAttribute(&cus, hipDeviceAttributeMultiprocessorCount, dev) != hipSuccess) { grid = -1; return; }
        if (hipFuncSetAttribute((const void*)fwd, hipFuncAttributeMaxDynamicSharedMemorySize, LDS_BYTES) != hipSuccess) { fprintf(stderr, "kernel_launch: hipFuncSetAttribute failed\n"); grid = -1; return; }
        if (hipOccupancyMaxActiveBlocksPerMultiprocessor(&per_cu, (const void*)fwd, NTHR, LDS_BYTES) != hipSuccess || per_cu < 1) fprintf(stderr, "kernel_launch: occupancy query says %d\n", per_cu);
        (void)hipGetLastError();
        grid = cus;
    }
    if (grid < 0) return;
    (void)hipMemsetAsync((char*)d_ws + WS_CTL, 0, CTL_ZERO_BYTES, stream);
    Args a{};
    for (int i = 0; i < 30; ++i) a.in[i] = (const float*)d_in[i];
    a.out = (float*)d_out; a.ws = (unsigned char*)d_ws; a.pad = 0;
#if MK_MULTI
    a.use_bar = 0;
    for (int l = 0; l < NLAYER; ++l)
        for (int ph = (l == 0 ? 0 : 1); ph < NPHASE; ++ph) { a.l_lo = l; a.l_hi = l + 1; a.ph_lo = ph; a.ph_hi = ph + 1;
            hipLaunchKernelGGL(fwd, dim3(grid), dim3(NTHR), LDS_BYTES, stream, a); }
#else
    a.use_bar = 1; a.l_lo = 0; a.l_hi = NLAYER; a.ph_lo = 0; a.ph_hi = NPHASE;
    hipLaunchKernelGGL(fwd, dim3(grid), dim3(NTHR), LDS_BYTES, stream, a);
#endif
    const hipError_t le = hipPeekAtLastError();
    if (le != hipSuccess) fprintf(stderr, "kernel_launch: launch failed: %s\n", hipGetErrorName(le));
}
```

```cpp
#include <hip/hip_runtime.h>
#include <cstdio>
#include <cstdint>

#define LAS __attribute__((address_space(3)))
#define GAS __attribute__((address_space(1)))
typedef unsigned short bf16;
typedef short bf16x8 __attribute__((ext_vector_type(8)));
typedef float f32x4 __attribute__((ext_vector_type(4)));
typedef float f32x2 __attribute__((ext_vector_type(2)));
typedef unsigned u32x4 __attribute__((ext_vector_type(4)));
typedef unsigned u32x2 __attribute__((ext_vector_type(2)));

namespace pg8 {
constexpr int BM = 256, BK = 64, HALF = 128, HTB = HALF * BK * 2  , STAGE_BYTES = 8 * HTB, NXCD = 8, WGM = 8;

__host__ __device__ __forceinline__ int lds_byte(int r, int c) { const int st = (r >> 4) * 2 + (c >> 5), rr = r & 15, cc = c & 31, ob = rr * 64 + cc * 2; return st * 1024 + (ob ^ (((ob >> 9) & 1) << 5)); }
__host__ __device__ __forceinline__ void stage_rc(int b, int& R, int& C) { const int st = b / 1024, sb = b % 1024, swz = sb ^ (((sb >> 9) & 1) << 5); R = (st >> 1) * 16 + swz / 64; C = (st & 1) * 32 + (swz % 64) / 2; }
__host__ __device__ __forceinline__ int perm32(int rho) { const int n = rho >> 4, i = rho & 15; return 8 * (i >> 2) + 4 * n + (i & 3); }

struct Unit { int pm, pn, pb; unsigned aoff; };
struct Gemm { const bf16* A; const bf16* Bt; int lda, ldb, K; };

struct GridOrder {
    int nM, nN, nwg, G, c, a_grp, a_grp_bytes;
    __device__ void init(int nM_, int nN_, int G_, int c_, int a_grp_ = 0, int a_grp_bytes_ = 0) { nM = nM_; nN = nN_; nwg = nM * nN; G = G_; c = c_; a_grp = a_grp_; a_grp_bytes = a_grp_bytes_; }
    __device__ bool next(int i, Unit& u) const {
        const long L = (long)i * G + c; if (L >= nwg) return false;
        int wgid = (int)L; { const int q = nwg / NXCD, r = nwg % NXCD, xcd = wgid % NXCD, off = wgid / NXCD; wgid = (xcd < r ? xcd * (q + 1) : r * (q + 1) + (xcd - r) * q) + off; }
        const int nig = WGM * nN, gid = wgid / nig, fm = gid * WGM, gsz = (nM - fm) < WGM ? (nM - fm) : WGM;
        u.pm = fm + ((wgid % nig) % gsz); u.pn = (wgid % nig) / gsz; u.pb = u.pn; u.aoff = a_grp ? (unsigned)((u.pn / a_grp) * a_grp_bytes) : 0u; return true;
    }
};
struct MoeOrder {
    const LAS int* tstart; int nsl, G, c;
    __device__ bool next(int i, Unit& u) const {
        const int L = i * G + c, total = tstart[32] << nsl; if (L >= total) return false;
        const int rt = L >> nsl, pn = L & ((1 << nsl) - 1); int e = 0;
#pragma unroll 1
        for (int k = 1; k < 32; ++k) e += (rt >= tstart[k]) ? 1 : 0;
        u.pm = rt; u.pn = pn; u.pb = (e << nsl) + pn; u.aoff = 0u; return true;
    }
};

__device__ __forceinline__ unsigned cvt_pk_bf16(float lo, float hi) { unsigned r; asm volatile("v_cvt_pk_bf16_f32 %0, %1, %2" : "=v"(r) : "v"(lo), "v"(hi)); return r; }

template <class Epi, class Sched>
__device__ __forceinline__ void gemm_phase(LAS unsigned char* lds, const Gemm g, const Sched& S, const Epi& E, const int tid) {
    const int wid = __builtin_amdgcn_readfirstlane(tid >> 6), lane = tid & 63, wr = wid >> 2, wc = wid & 3, fr = lane & 15, fq = lane >> 4;
    const int K = g.K, nt = K / BK;
    unsigned voffA[2], voffB[2];
#pragma unroll
    for (int i = 0; i < 2; ++i) { int R, C; stage_rc(tid * 16 + i * 8192, R, C); const int Rb = Epi::PERM ? ((R & ~31) + perm32(R & 31)) : R;
        voffA[i] = (unsigned)(R * g.lda + C) * 2u; voffB[i] = (unsigned)(Rb * g.ldb + C) * 2u; }
    const size_t kstep = (size_t)(BK * 2);
    const size_t hstepA = (size_t)HALF * g.lda * 2, hstepB = (size_t)HALF * g.ldb * 2;
    const size_t tstepA = 2 * hstepA, tstepB = 2 * hstepB;
    const unsigned ldsw = (unsigned)wid * 1024u;
    const int aoff = lds_byte(wr * 64 + fr, fq * 8), boff = lds_byte(wc * 32 + fr, fq * 8);
#define PG8_SA(b, h) (((b) * 2 + (h)) * HTB)
#define PG8_SB(b, h) ((4 + (b) * 2 + (h)) * HTB)
#define PG8_STAGE(bufoff, gbase, voff) do { _Pragma("unroll") for (int _i = 0; _i < 2; ++_i) \
        __builtin_amdgcn_global_load_lds((const unsigned*)((const char*)(gbase) + (voff)[_i]), (LAS unsigned*)(lds + (bufoff) + ldsw + _i * 8192), 16, 0, 0); } while (0)
#define PG8_LDA(dst, b, h) do { _Pragma("unroll") for (int m = 0; m < 4; ++m) _Pragma("unroll") for (int k = 0; k < 2; ++k) dst[m][k] = *(const LAS bf16x8*)(lds + PG8_SA(b, h) + aoff + m * 2048 + k * 1024); } while (0)
#define PG8_LDB(dst, b, h) do { _Pragma("unroll") for (int n = 0; n < 2; ++n) _Pragma("unroll") for (int k = 0; k < 2; ++k) dst[n][k] = *(const LAS bf16x8*)(lds + PG8_SB(b, h) + boff + n * 2048 + k * 1024); } while (0)
#define PG8_MMA(ai, bj, At, Bt) do { __builtin_amdgcn_s_setprio(1); _Pragma("unroll") for (int m = 0; m < 4; ++m) _Pragma("unroll") for (int n = 0; n < 2; ++n) _Pragma("unroll") for (int k = 0; k < 2; ++k) \
        acc[ai][bj][m][n] = __builtin_amdgcn_mfma_f32_16x16x32_bf16(Bt[n][k], At[m][k], acc[ai][bj][m][n], 0, 0, 0); __builtin_amdgcn_s_setprio(0); } while (0)
#define PG8_WAIT_V(n) asm volatile("s_waitcnt vmcnt(" #n ")" ::: "memory")
#define PG8_WAIT_L(n) asm volatile("s_waitcnt lgkmcnt(" #n ")" ::: "memory")
#define PG8_BAR __builtin_amdgcn_s_barrier()
#define PG8_SCHED __builtin_amdgcn_sched_barrier(0)
    Unit cur, nxt; int ui = 0;
    if (!S.next(0, cur)) return;
    f32x4 acc[2][2][4][2];
#pragma unroll
    for (int a = 0; a < 2; ++a)
#pragma unroll
        for (int b = 0; b < 2; ++b)
#pragma unroll
            for (int m = 0; m < 4; ++m)
#pragma unroll
                for (int n = 0; n < 2; ++n) acc[a][b][m][n] = (f32x4){0.f, 0.f, 0.f, 0.f};
    bf16x8 At[4][2], B0[2][2], B1[2][2];
    const char* cA = (const char*)g.A + (size_t)cur.pm * tstepA + cur.aoff; const char* cB = (const char*)g.Bt + (size_t)cur.pb * tstepB;
    PG8_STAGE(PG8_SB(0, 0), cB, voffB); PG8_STAGE(PG8_SB(0, 1), cB + hstepB, voffB); PG8_STAGE(PG8_SA(0, 0), cA, voffA); PG8_STAGE(PG8_SA(0, 1), cA + hstepA, voffA);
    if (wr == 1) PG8_BAR;
    PG8_WAIT_V(2); PG8_BAR;
    PG8_STAGE(PG8_SB(1, 0), cB + kstep, voffB); PG8_STAGE(PG8_SA(1, 0), cA + kstep, voffA); PG8_STAGE(PG8_SB(1, 1), cB + hstepB + kstep, voffB);
    PG8_WAIT_V(6); PG8_BAR;
    for (;;) {
        const bool has_next = S.next(ui + 1, nxt);
        const char* nA = has_next ? (const char*)g.A + (size_t)nxt.pm * tstepA + nxt.aoff : cA; const char* nB = has_next ? (const char*)g.Bt + (size_t)nxt.pb * tstepB : cB;
        for (int t = 0; t < nt; t += 2) {
            const bool last = (t == nt - 2);
            const char* a1 = cA + (size_t)(t + 1) * kstep;
            const char* a2 = last ? nA : cA + (size_t)(t + 2) * kstep; const char* b2 = last ? nB : cB + (size_t)(t + 2) * kstep;
            const char* a3 = a2 + kstep; const char* b3 = b2 + kstep;
            PG8_LDB(B0, 0, 0); PG8_LDB(B1, 0, 1); PG8_SCHED; PG8_LDA(At, 0, 0); PG8_STAGE(PG8_SA(1, 1), a1 + hstepA, voffA);
            PG8_WAIT_V(8); PG8_WAIT_L(0); PG8_BAR; PG8_MMA(0, 0, At, B0); PG8_MMA(0, 1, At, B1); PG8_BAR; PG8_SCHED;
            PG8_LDA(At, 0, 1); PG8_STAGE(PG8_SB(0, 0), b2, voffB); PG8_STAGE(PG8_SB(0, 1), b2 + hstepB, voffB); PG8_STAGE(PG8_SA(0, 0), a2, voffA);
            PG8_WAIT_V(8); PG8_WAIT_L(0); PG8_BAR; PG8_MMA(1, 0, At, B0); PG8_MMA(1, 1, At, B1); PG8_BAR; PG8_SCHED;
            PG8_LDB(B0, 1, 0); PG8_LDB(B1, 1, 1); PG8_SCHED; PG8_LDA(At, 1, 0); PG8_STAGE(PG8_SA(0, 1), a2 + hstepA, voffA);
            PG8_WAIT_V(8); PG8_WAIT_L(0); PG8_BAR; PG8_MMA(0, 0, At, B0); PG8_MMA(0, 1, At, B1); PG8_BAR; PG8_SCHED;
            PG8_LDA(At, 1, 1); PG8_STAGE(PG8_SB(1, 0), b3, voffB); PG8_STAGE(PG8_SB(1, 1), b3 + hstepB, voffB); PG8_STAGE(PG8_SA(1, 0), a3, voffA);
            PG8_WAIT_V(8); PG8_WAIT_L(0); PG8_BAR; PG8_MMA(1, 0, At, B0); PG8_MMA(1, 1, At, B1); PG8_BAR; PG8_SCHED;
        }
        if (wr == 0) PG8_BAR;
        { unsigned on_ = ~0u; asm volatile("" : "+s"(on_)); const int lz_ = (int)__builtin_amdgcn_mbcnt_hi(on_, __builtin_amdgcn_mbcnt_lo(on_, 0u));
          E(acc, cur, wr, wc, lz_ & 15, lz_ >> 4); }
        if (!has_next) break;
#pragma unroll
        for (int a = 0; a < 2; ++a)
#pragma unroll
            for (int b = 0; b < 2; ++b)
#pragma unroll
                for (int m = 0; m < 4; ++m)
#pragma unroll
                    for (int n = 0; n < 2; ++n) acc[a][b][m][n] = (f32x4){0.f, 0.f, 0.f, 0.f};
        cur = nxt; cA = nA; cB = nB; ++ui;
        if (wr == 1) PG8_BAR;
    }
    PG8_WAIT_V(0);
    PG8_BAR;
#undef PG8_SA
#undef PG8_SB
#undef PG8_STAGE
#undef PG8_LDA
#undef PG8_LDB
#undef PG8_MMA
#undef PG8_WAIT_V
#undef PG8_WAIT_L
#undef PG8_BAR
#undef PG8_SCHED
}
}

constexpr int NTOK = 65536, DM = 1024, SEQ = 2048, NBATCH = 32, NLAYER = 4;
constexpr int PW = 3072;
constexpr int PC_AQ = 0, PC_AK = 256, PC_AV = 512, PC_BQ = 768, PC_CKV = 1024, PC_IQ = 1088, PC_IK = 1344, PC_IW = 1376,
              PC_CQ = 1384, PC_CK = 1512, PC_CV = 1640, PC_CA = 1896, PC_CG = 1912, PC_D = 2168;
constexpr int IN_W = 7096;
constexpr float LN_EPS = 1e-5f;
constexpr float DN_ALPHA = 1.6817928305074292f;
constexpr int NWAVES = 8, NTHR = 512;
constexpr int MOE_ROWS = 2 * NTOK + 32 * 256;

constexpr size_t MiB = 1u << 20;
constexpr size_t WS_CTL = 0, CTL_ZERO_BYTES = 1 * MiB;
constexpr size_t WS_TOK = 1 * MiB;
constexpr size_t WS_ROW = 3 * MiB;
constexpr size_t WS_BON = 5 * MiB;
constexpr size_t WS_RT = 6 * MiB;
constexpr size_t WS_CKVN = 8 * MiB;
constexpr size_t WS_CA = 16 * MiB;
constexpr size_t WS_W = 48 * MiB;
constexpr size_t WL_IN = 0, WL_BR = 14 * MiB, WL_OUT = 16 * MiB, WL_GU = 18 * MiB, WL_DN = 50 * MiB, WL_SIZE = 66 * MiB;
constexpr size_t WS_XB = 312 * MiB;
constexpr size_t WS_BIG = 440 * MiB;
constexpr size_t BIG_DW = 384 * MiB, BIG_DAI = 448 * MiB, BIG_DG = 480 * MiB;
constexpr size_t BIG_H = 272 * MiB;
constexpr size_t WS_END = 952 * MiB;
constexpr size_t DO_YS = 0, DO_MG = 128 * MiB, DO_DR = 128 * MiB, DO_DKP = 160 * MiB, DO_DV = 192 * MiB, DO_DKK = 224 * MiB;

constexpr int CW_TMO = 0, CW_CODE = 1;
constexpr int CW_BAR = 4096;
constexpr int CW_Q = 8192;
constexpr int CW_CNT = 16384;

constexpr int RING_BYTES = 131072;
constexpr int MISC_OFF = RING_BYTES;
constexpr int TST_OFF = MISC_OFF + 512;
constexpr int BKT_OFF = MISC_OFF + 1024;
constexpr int RPB_OFF = MISC_OFF + 3072;
constexpr int LDS_BYTES = 147456;

#define LDS_WAIT() asm volatile("s_waitcnt lgkmcnt(0)" ::: "memory")
#define VM_WAIT() asm volatile("s_waitcnt vmcnt(0)" ::: "memory")
__device__ __forceinline__ float bf2f(unsigned b) { return __uint_as_float(b << 16); }
__device__ __forceinline__ unsigned f2bf(float f) { unsigned u = __float_as_uint(f); return (u + 0x7fffu + ((u >> 16) & 1u)) >> 16; }
__device__ __forceinline__ unsigned pk2(float lo, float hi) { return f2bf(lo) | (f2bf(hi) << 16); }
__device__ __forceinline__ float bflo(unsigned w) { return __uint_as_float(w << 16); }
__device__ __forceinline__ float bfhi(unsigned w) { return __uint_as_float(w & 0xffff0000u); }
__device__ __forceinline__ float wave_sum(float v) {
#pragma unroll
    for (int o = 1; o < 64; o <<= 1) v += __shfl_xor(v, o);
    return v;
}
__device__ __forceinline__ float wave_max(float v) {
#pragma unroll
    for (int o = 1; o < 64; o <<= 1) v = fmaxf(v, __shfl_xor(v, o));
    return v;
}
template <int CTRL> __device__ __forceinline__ float dppf(float v) {
    return __builtin_bit_cast(float, __builtin_amdgcn_update_dpp(0, __builtin_bit_cast(int, v), CTRL, 0xf, 0xf, true));
}
__device__ __forceinline__ float sum8(float v) { v += dppf<0xB1>(v); v += dppf<0x4E>(v); v += dppf<0x141>(v); return v; }
__device__ __forceinline__ float sigmoidf_(float x) { return 1.f / (1.f + __expf(-x)); }
__device__ __forceinline__ float log_sigmoidf_(float z) { return fminf(z, 0.f) - log1pf(__expf(-fabsf(z))); }

#define XB_TMO      128
#define XB_XCNT(j)  (256  + 64 * (j))
#define XB_XSUB(j)  (1280 + 64 * (j))
#define XB_XGEN(j)  (2304 + 64 * (j))
#define XB_TOP      3328
#define XB_TOPGEN   3392
#define XCD_BAR_WORDS 3456
#define XB_SPIN_CAP (1u << 22)

__device__ __forceinline__ unsigned xb_ld(unsigned* p)              { return __hip_atomic_load(p, __ATOMIC_RELAXED, __HIP_MEMORY_SCOPE_AGENT); }
__device__ __forceinline__ unsigned xb_add(unsigned* p, unsigned v) { return __hip_atomic_fetch_add(p, v, __ATOMIC_RELAXED, __HIP_MEMORY_SCOPE_AGENT); }
__device__ __forceinline__ unsigned xb_xcc_id() { return (unsigned)__builtin_amdgcn_s_getreg((3 << 11) | 20) & 0xFu; }
#define XB_SPIN(cond, bar) do { unsigned _sp = 0; while (cond) { __builtin_amdgcn_s_sleep(1); \
    if ((++_sp & 255u) == 0u) { if (xb_ld(&(bar)[XB_TMO])) break; if (_sp > XB_SPIN_CAP) { atomicAdd(&(bar)[XB_TMO], 1u); break; } } } } while (0)

struct XcdBarrier { unsigned* bar; unsigned x; volatile LAS unsigned* st; };

__device__ __forceinline__ XcdBarrier xcd_barrier_post(unsigned* bar, volatile LAS unsigned* st) {
    XcdBarrier b; b.bar = bar; b.x = xb_xcc_id(); b.st = st;
    if (threadIdx.x == 0) (void)xb_add(&bar[XB_XCNT(b.x)], 1u);
    return b;
}
__device__ __forceinline__ void xcd_barrier_complete(unsigned* bar, unsigned x, unsigned& nloc, unsigned& nx) {
    const unsigned G = gridDim.x * gridDim.y * gridDim.z;
    unsigned sum, cnt, mine, sp = 0u;
    for (;;) {
        sum = 0u; cnt = 0u; mine = 0u;
#pragma unroll
        for (unsigned j = 0; j < 16; ++j) { const unsigned c = xb_ld(&bar[XB_XCNT(j)]); sum += c; cnt += (c > 0u) ? 1u : 0u; mine = (j == x) ? c : mine; }
        if (sum == G) break;
        __builtin_amdgcn_s_sleep(1);
        if ((++sp & 255u) == 0u) { if (xb_ld(&bar[XB_TMO])) break; if (sp > XB_SPIN_CAP) { atomicAdd(&bar[XB_TMO], 1u); break; } }
    }
    nloc = mine > 0u ? mine : 1u; nx = cnt > 0u ? cnt : 1u;
}
__device__ __forceinline__ void xcd_barrier(const XcdBarrier& b) {
    asm volatile("s_waitcnt vmcnt(0)" ::: "memory");
    __syncthreads();
    if (threadIdx.x == 0) {
        unsigned* bar = b.bar;
        __builtin_amdgcn_s_waitcnt(0);
        unsigned nloc = b.st[0], nx = b.st[1];
        if (nloc == 0u) { xcd_barrier_complete(bar, b.x, nloc, nx); b.st[0] = nloc; b.st[1] = nx; }
        const unsigned old = xb_add(&bar[XB_XSUB(b.x)], 1u);
        const unsigned gen = old / nloc;
        if (old + 1u == (gen + 1u) * nloc) {
            __builtin_amdgcn_fence(__ATOMIC_RELEASE, "agent");
            asm volatile("s_waitcnt vmcnt(0)" ::: "memory");
            const unsigned og = xb_add(&bar[XB_TOP], 1u);
            const unsigned tg = og / nx;
            if (og + 1u == (tg + 1u) * nx) xb_add(&bar[XB_TOPGEN], 1u);
            else XB_SPIN(xb_ld(&bar[XB_TOPGEN]) == tg, bar);
            __builtin_amdgcn_fence(__ATOMIC_ACQUIRE, "agent");
            xb_add(&bar[XB_XGEN(b.x)], 1u);
            asm volatile("s_waitcnt vmcnt(0)" ::: "memory");
        } else {
            XB_SPIN(xb_ld(&bar[XB_XGEN(b.x)]) == gen, bar);
            __builtin_amdgcn_fence(__ATOMIC_ACQUIRE, "agent");
            asm volatile("s_waitcnt vmcnt(0)" ::: "memory");
        }
    }
    __syncthreads();
}

struct Args { const float* in[30]; float* out; unsigned char* ws; int l_lo, l_hi, ph_lo, ph_hi, use_bar, pad; };

namespace pg8 {
struct EpiStoreBf16 {
    static constexpr bool PERM = true;
    bf16* O; int ldc;
    __device__ __forceinline__ void operator()(const f32x4 (&acc)[2][2][4][2], const Unit& u, int wr, int wc, int fr, int fq) const {
        const int row0 = u.pm * BM + wr * 64 + fr, col0 = u.pn * BM + wc * 32 + 8 * fq;
#pragma unroll
        for (int ai = 0; ai < 2; ++ai)
#pragma unroll
            for (int m = 0; m < 4; ++m) { bf16* rowp = O + (size_t)(row0 + ai * HALF + m * 16) * ldc + col0;
#pragma unroll
                for (int bj = 0; bj < 2; ++bj) { const f32x4 v0 = acc[ai][bj][m][0], v1 = acc[ai][bj][m][1];
                    u32x4 w; w.x = cvt_pk_bf16(v0[0], v0[1]); w.y = cvt_pk_bf16(v0[2], v0[3]); w.z = cvt_pk_bf16(v1[0], v1[1]); w.w = cvt_pk_bf16(v1[2], v1[3]);
                    *(u32x4*)(rowp + bj * HALF) = w; } }
    }
};
struct EpiGate {
    static constexpr bool PERM = false;
    const bf16* BR; bf16* MG;
    __device__ __forceinline__ void operator()(const f32x4 (&acc)[2][2][4][2], const Unit& u, int wr, int wc, int fr, int fq) const {
        const int row0 = u.pm * BM + wr * 64 + fr, j0 = u.pn * 64 + wc * 16 + 4 * fq;
#pragma unroll
        for (int ai = 0; ai < 2; ++ai)
#pragma unroll
            for (int m = 0; m < 4; ++m) { const size_t r = (size_t)(row0 + ai * HALF + m * 16);
                float mg0 = 0.f, mg1 = 0.f, mg2 = 0.f, mg3 = 0.f;
#pragma unroll
                for (int bj = 0; bj < 2; ++bj)
#pragma unroll
                    for (int n = 0; n < 2; ++n) { const int g = 2 * bj + n; const u32x2 b = *(const u32x2*)(BR + r * 4096 + g * 1024 + j0); const f32x4 a = acc[ai][bj][m][n];
                        mg0 += sigmoidf_(a[0]) * bflo(b.x); mg1 += sigmoidf_(a[1]) * bfhi(b.x); mg2 += sigmoidf_(a[2]) * bflo(b.y); mg3 += sigmoidf_(a[3]) * bfhi(b.y); }
                u32x2 w; w.x = cvt_pk_bf16(mg0, mg1); w.y = cvt_pk_bf16(mg2, mg3);
                *(u32x2*)(MG + r * 1024 + j0) = w; }
    }
};
struct EpiOut {
    static constexpr bool PERM = true;
    bf16* XB;
    __device__ __forceinline__ void operator()(const f32x4 (&acc)[2][2][4][2], const Unit& u, int wr, int wc, int fr, int fq) const {
        const int row0 = u.pm * BM + wr * 64 + fr, col0 = u.pn * BM + wc * 32 + 8 * fq;
#pragma unroll
        for (int ai = 0; ai < 2; ++ai)
#pragma unroll
            for (int m = 0; m < 4; ++m) { bf16* rowp = XB + (size_t)(row0 + ai * HALF + m * 16) * 1024 + col0;
#pragma unroll
                for (int bj = 0; bj < 2; ++bj) { const f32x4 v0 = acc[ai][bj][m][0], v1 = acc[ai][bj][m][1]; const u32x4 x = *(const u32x4*)(rowp + bj * HALF);
                    u32x4 w; w.x = cvt_pk_bf16(DN_ALPHA * bflo(x.x) + v0[0], DN_ALPHA * bfhi(x.x) + v0[1]); w.y = cvt_pk_bf16(DN_ALPHA * bflo(x.y) + v0[2], DN_ALPHA * bfhi(x.y) + v0[3]);
                    w.z = cvt_pk_bf16(DN_ALPHA * bflo(x.z) + v1[0], DN_ALPHA * bfhi(x.z) + v1[1]); w.w = cvt_pk_bf16(DN_ALPHA * bflo(x.w) + v1[2], DN_ALPHA * bfhi(x.w) + v1[3]);
                    *(u32x4*)(rowp + bj * HALF) = w; } }
    }
};
struct EpiUp {
    static constexpr bool PERM = true;
    const unsigned* rowinfo; bf16* H;
    __device__ __forceinline__ void operator()(const f32x4 (&acc)[2][2][4][2], const Unit& u, int wr, int wc, int fr, int fq) const {
        const int row0 = u.pm * BM + wr * 64 + fr, col0 = u.pn * 128 + wc * 32 + 8 * fq;
#pragma unroll
        for (int ai = 0; ai < 2; ++ai)
#pragma unroll
            for (int m = 0; m < 4; ++m) { const size_t r = (size_t)(row0 + ai * HALF + m * 16); const float w = __uint_as_float(rowinfo[2 * r + 1]);
                const f32x4 g0 = acc[ai][0][m][0], g1 = acc[ai][0][m][1], u0 = acc[ai][1][m][0], u1 = acc[ai][1][m][1];
                float h[8];
#pragma unroll
                for (int e = 0; e < 4; ++e) { h[e] = g0[e] * sigmoidf_(g0[e]) * u0[e] * w; h[4 + e] = g1[e] * sigmoidf_(g1[e]) * u1[e] * w; }
                u32x4 o; o.x = cvt_pk_bf16(h[0], h[1]); o.y = cvt_pk_bf16(h[2], h[3]); o.z = cvt_pk_bf16(h[4], h[5]); o.w = cvt_pk_bf16(h[6], h[7]);
                *(u32x4*)(H + r * 256 + col0) = o; }
    }
};
struct EpiDown {
    static constexpr bool PERM = true;
    const unsigned* rowinfo; bf16* Y;
    __device__ __forceinline__ void operator()(const f32x4 (&acc)[2][2][4][2], const Unit& u, int wr, int wc, int fr, int fq) const {
        const int row0 = u.pm * BM + wr * 64 + fr, col0 = u.pn * BM + wc * 32 + 8 * fq;
#pragma unroll
        for (int ai = 0; ai < 2; ++ai)
#pragma unroll
            for (int m = 0; m < 4; ++m) { const size_t r = (size_t)(row0 + ai * HALF + m * 16); const int ri = (int)rowinfo[2 * r];
                if (ri >= 0) { bf16* rowp = Y + ((size_t)(ri & 1) * NTOK + (size_t)(ri >> 1)) * 1024 + col0;
#pragma unroll
                    for (int bj = 0; bj < 2; ++bj) { const f32x4 v0 = acc[ai][bj][m][0], v1 = acc[ai][bj][m][1];
                        u32x4 w; w.x = cvt_pk_bf16(v0[0], v0[1]); w.y = cvt_pk_bf16(v0[2], v0[3]); w.z = cvt_pk_bf16(v1[0], v1[1]); w.w = cvt_pk_bf16(v1[2], v1[3]);
                        *(u32x4*)(rowp + bj * HALF) = w; } } }
    }
};
}

struct RowMap { int kind, base, g, off;
    __device__ __forceinline__ int operator()(int n) const {
        if (kind == 0) return base + n;
        if (kind == 1) { const int j = base + n, jj = j & 63, pn = j >> 6; return 3072 + pn * 256 + 128 * (g >> 1) + 32 * (jj >> 4) + 16 * (g & 1) + 4 * ((jj >> 2) & 3) + (jj & 3); }
        const int h = base + n; return (h >> 7) * 256 + off + (h & 127);
    }
};
__device__ __forceinline__ void transpose_item(const float* W, int ldw, int k0, int scol0, int nvalid, bf16* WT, int ldk, const RowMap& rm, LAS float* scr, int lane) {
    const int nn = lane & 31;
#pragma unroll 8
    for (int i = 0; i < 32; ++i) { const int kk = 2 * i + (lane >> 5); scr[kk * 33 + nn] = (nn < nvalid) ? W[(size_t)(k0 + kk) * ldw + scol0 + nn] : 0.f; }
    LDS_WAIT(); asm volatile("" ::: "memory");
    const int c = lane & 7;
#pragma unroll
    for (int j = 0; j < 4; ++j) { const int n = (lane >> 3) + 8 * j; const LAS float* s = scr + (8 * c) * 33 + n;
        u32x4 o; o.x = pk2(s[0 * 33], s[1 * 33]); o.y = pk2(s[2 * 33], s[3 * 33]); o.z = pk2(s[4 * 33], s[5 * 33]); o.w = pk2(s[6 * 33], s[7 * 33]);
        *(u32x4*)(WT + (size_t)rm(n) * ldk + k0 + 8 * c) = o; }
    LDS_WAIT(); asm volatile("" ::: "memory");
}
__device__ __forceinline__ void p0_prologue(const Args& a, LAS unsigned char* lds, int gw, int NGW, int wave, int lane) {
    LAS float* scr = (LAS float*)(lds + wave * 16384);
    constexpr int IPL = 16896;
    for (int it = gw; it < NLAYER * IPL; it += NGW) {
        const int l = it / IPL; int r = it - l * IPL;
        unsigned char* wl = a.ws + WS_W + (size_t)l * WL_SIZE;
        RowMap rm; rm.kind = 0; rm.base = 0; rm.g = 0; rm.off = 0;
        if (r < 1536) { const int nt = r % 96, kt = r / 96, n0 = 32 * nt; int nv = 3000 - n0; nv = nv < 0 ? 0 : (nv > 32 ? 32 : nv); rm.base = n0;
            transpose_item(a.in[2] + (size_t)l * 1024 * IN_W, IN_W, 64 * kt, n0, nv, (bf16*)(wl + WL_IN), 1024, rm, scr, lane); continue; }
        r -= 1536;
        if (r < 2048) { const int nt = r % 128, kt = r / 128, gc0 = 32 * nt; rm.kind = 1; rm.g = gc0 >> 10; rm.base = gc0 & 1023;
            transpose_item(a.in[2] + (size_t)l * 1024 * IN_W, IN_W, 64 * kt, 3000 + gc0, 32, (bf16*)(wl + WL_IN), 1024, rm, scr, lane); continue; }
        r -= 2048;
        if (r < 512) { const int nb = r / 128, rr = r % 128, nt = rr % 32, kt = rr / 32; rm.base = nb * 1024 + 32 * nt;
            transpose_item(a.in[19] + (size_t)(l * 4 + nb) * 256 * 1024, 1024, 64 * kt, 32 * nt, 32, (bf16*)(wl + WL_BR), 256, rm, scr, lane); continue; }
        r -= 512;
        if (r < 512) { const int nt = r % 32, kt = r / 32; rm.base = 32 * nt;
            transpose_item(a.in[20] + (size_t)l * 1024 * 1024, 1024, 64 * kt, 32 * nt, 32, (bf16*)(wl + WL_OUT), 1024, rm, scr, lane); continue; }
        r -= 512;
        if (r < 8192) { const int up = r >= 4096; if (up) r -= 4096; const int e = r / 128, rr = r % 128, nt = rr % 8, kt = rr / 8; rm.kind = 2; rm.base = 32 * nt; rm.off = up ? 128 : 0;
            transpose_item(a.in[up ? 28 : 27] + (size_t)(l * 32 + e) * 1024 * 256, 256, 64 * kt, 32 * nt, 32, (bf16*)(wl + WL_GU) + (size_t)e * 512 * 1024, 1024, rm, scr, lane); continue; }
        r -= 8192;
        { const int e = r / 128, rr = r % 128, nt = rr % 32, kt = rr / 32; rm.base = 32 * nt;
            transpose_item(a.in[29] + (size_t)(l * 32 + e) * 256 * 1024, 1024, 64 * kt, 32 * nt, 32, (bf16*)(wl + WL_DN) + (size_t)e * 1024 * 256, 256, rm, scr, lane); }
    }
    { float* WRT = (float*)(a.ws + WS_RT); const int gt = gw * 64 + lane, NT = NGW * 64;
      for (int i = gt; i < NLAYER * 36 * 1024; i += NT) { const int k = i & 1023, e = (i >> 10) % 36, l = i / (36 * 1024);
          WRT[i] = e < 4 ? a.in[23][((size_t)l * 1024 + k) * 4 + e] : a.in[25][((size_t)l * 1024 + k) * 32 + (e - 4)]; }
      const f32x4* xs = (const f32x4*)a.in[0]; u32x4* xd = (u32x4*)(a.ws + WS_XB);
      for (int i = gt; i < NTOK * DM / 8; i += NT) { const f32x4 v0 = xs[2 * i], v1 = xs[2 * i + 1]; u32x4 o; o.x = pk2(v0[0], v0[1]); o.y = pk2(v0[2], v0[3]); o.z = pk2(v1[0], v1[1]); o.w = pk2(v1[2], v1[3]); xd[i] = o; } }
}

__device__ __forceinline__ float softplusf_(float x) { return fmaxf(x, 0.f) + log1pf(__expf(-fabsf(x))); }
__device__ __forceinline__ void prep_phase(const Args& a, int l, LAS unsigned char* lds, int tid, int gw, int NGW, int lane) {
    const bf16* P = (const bf16*)(a.ws + WS_BIG);
    bf16* CKVN = (bf16*)(a.ws + WS_CKVN); float* CA = (float*)(a.ws + WS_CA); float* BON = (float*)(a.ws + WS_BON);
    bf16* DR = (bf16*)((unsigned char*)a.out + DO_DR); bf16* DKP = (bf16*)((unsigned char*)a.out + DO_DKP); bf16* DV = (bf16*)((unsigned char*)a.out + DO_DV); bf16* DKK = (bf16*)((unsigned char*)a.out + DO_DKK);
    float* DW = (float*)(a.ws + WS_BIG + BIG_DW); bf16* DAI = (bf16*)(a.ws + WS_BIG + BIG_DAI); bf16* DG = (bf16*)(a.ws + WS_BIG + BIG_DG);
    const float* kvg = a.in[3] + l * 64; const float* aup = a.in[5] + l * 16 * 128; const float* abias = a.in[6] + l * 128;
    const float* mu = a.in[8] + l * 832; const float* w0 = a.in[9] + l * 256; const float* w2 = a.in[10] + l * 16 * 256; const float* a0 = a.in[11] + l * 256;
    const float* a2 = a.in[12] + l * 16 * 256; const float* g2 = a.in[13] + l * 32 * 256; const float* kkw = a.in[14] + l * 256; const float* kaw = a.in[15] + l * 256; const float* rkw = a.in[16] + l * 256;
    LAS float* sW2 = (LAS float*)lds; LAS float* sA2 = (LAS float*)(lds + 16384); LAS float* sG2 = (LAS float*)(lds + 32768); LAS float* sUP = (LAS float*)(lds + 65536);
    for (int i = tid; i < 4096; i += NTHR) { sW2[i] = w2[i]; sA2[i] = a2[i]; }
    for (int i = tid; i < 8192; i += NTHR) sG2[i] = g2[i];
    for (int i = tid; i < 2048; i += NTHR) sUP[i] = aup[i];
    __syncthreads();
    float mu_r[13], w0_r[4], a0_r[4], kk_r[4], ka_r[4], rk_r[4];
#pragma unroll
    for (int i = 0; i < 13; ++i) mu_r[i] = mu[64 * i + lane];
#pragma unroll
    for (int i = 0; i < 4; ++i) { const int c = 64 * i + lane; w0_r[i] = w0[c]; a0_r[i] = a0[c]; kk_r[i] = kkw[c]; ka_r[i] = kaw[c]; rk_r[i] = rkw[c]; }
    const float kvg_r = kvg[lane], ab0 = abias[lane], ab1 = abias[64 + lane];
    for (int m = gw; m < NTOK; m += NGW) {
        const bf16* prow = P + (size_t)m * PW; const int t = m & (SEQ - 1);
        { const float x = bf2f(prow[PC_CKV + lane]); const float ss = wave_sum(x * x); const float rn = rsqrtf(ss * (1.f / 64.f) + 1e-6f); CKVN[(size_t)m * 64 + lane] = (bf16)f2bf(x * rn * kvg_r); }
        { const float cav = (lane < 16) ? bf2f(prow[PC_CA + lane]) : 0.f; float z0 = ab0, z1 = ab1;
#pragma unroll
          for (int i = 0; i < 16; ++i) { const float cv = __shfl(cav, i); z0 += cv * sUP[i * 128 + lane]; z1 += cv * sUP[i * 128 + 64 + lane]; }
          CA[(size_t)m * 128 + lane] = __expf(log_sigmoidf_(z0) * (1.f / 16.f)); CA[(size_t)m * 128 + 64 + lane] = __expf(log_sigmoidf_(z1) * (1.f / 16.f)); }
        float xs[13];
#pragma unroll
        for (int i = 0; i < 13; ++i) { const int c = 64 * i + lane; const float cur = bf2f(prow[PC_D + c]); const float prev = (t > 0) ? bf2f(prow[PC_D + c - PW]) : 0.f; xs[i] = cur + (prev - cur) * mu_r[i]; }
        const float low = xs[12], tw = tanhf(low), sg = sigmoidf_(low);
        float wr_[4], ar_[4], gv_[4];
#pragma unroll
        for (int i = 0; i < 4; ++i) { wr_[i] = w0_r[i]; ar_[i] = a0_r[i]; gv_[i] = 0.f; }
#pragma unroll 4
        for (int j = 0; j < 16; ++j) { const float tj = __shfl(tw, j), aj = __shfl(low, 16 + j);
#pragma unroll
            for (int i = 0; i < 4; ++i) { wr_[i] += tj * sW2[j * 256 + 64 * i + lane]; ar_[i] += aj * sA2[j * 256 + 64 * i + lane]; } }
#pragma unroll 4
        for (int j = 0; j < 32; ++j) { const float sj = __shfl(sg, 32 + j);
#pragma unroll
            for (int i = 0; i < 4; ++i) gv_[i] += sj * sG2[j * 256 + 64 * i + lane]; }
#pragma unroll
        for (int i = 0; i < 4; ++i) { const int c = 64 * i + lane;
            const float w_raw = -softplusf_(-wr_[i]) - 0.5f, wdec = __expf(-__expf(w_raw));
            const float av = sigmoidf_(ar_[i]);
            const float kx = xs[4 + i]; float kkv = kx * kk_r[i]; const float nrm = sqrtf(wave_sum(kkv * kkv)); kkv = kkv / fmaxf(nrm, 1e-12f);
            const float kp = kx * (1.f + (av - 1.f) * ka_r[i]);
            const float rx = xs[i], vx = xs[8 + i];
            const float bon = wave_sum(rx * kp * rk_r[i]);
            const size_t o = (size_t)m * 256 + c;
            DR[o] = (bf16)f2bf(rx); DKP[o] = (bf16)f2bf(kp); DV[o] = (bf16)f2bf(vx); DKK[o] = (bf16)f2bf(kkv); DW[o] = wdec; DAI[o] = (bf16)f2bf(av); DG[o] = (bf16)f2bf(gv_[i]);
            if (lane == 0) BON[(size_t)m * 4 + i] = bon; }
    }
    __syncthreads();
}

__device__ __forceinline__ void dscan_item(const Args& a, int l, int bh, LAS unsigned char* lds, int tid) {
    const int b = bh >> 2, h = bh & 3, wv = tid >> 6, lane = tid & 63, row = wv * 8 + (lane >> 3), part = lane & 7;
    LAS bf16* sKK = (LAS bf16*)(lds); LAS bf16* sAI = (LAS bf16*)(lds + 8192); LAS bf16* sKP = (LAS bf16*)(lds + 16384); LAS bf16* sR = (LAS bf16*)(lds + 24576); LAS bf16* sV = (LAS bf16*)(lds + 32768);
    LAS float* sW = (LAS float*)(lds + 40960); LAS float* sY = (LAS float*)(lds + 57344);
    const bf16* DR = (const bf16*)((unsigned char*)a.out + DO_DR); const bf16* DKP = (const bf16*)((unsigned char*)a.out + DO_DKP); const bf16* DV = (const bf16*)((unsigned char*)a.out + DO_DV); const bf16* DKK = (const bf16*)((unsigned char*)a.out + DO_DKK);
    const float* DW = (const float*)(a.ws + WS_BIG + BIG_DW); const bf16* DAI = (const bf16*)(a.ws + WS_BIG + BIG_DAI); const bf16* DG = (const bf16*)(a.ws + WS_BIG + BIG_DG);
    const float* BON = (const float*)(a.ws + WS_BON); bf16* YS = (bf16*)((unsigned char*)a.out + DO_YS);
    const float* gnw = a.in[17] + l * 256 + h * 64; const float* gnb = a.in[18] + l * 256 + h * 64;
    const int ls = tid >> 3, lseg = tid & 7;
    const size_t gbase = ((size_t)b * SEQ) * 256 + h * 64 + 8 * lseg;
    float S[8];
#pragma unroll
    for (int j = 0; j < 8; ++j) S[j] = 0.f;
    u32x4 rKK, rAI, rKP, rR, rV; f32x4 rW0, rW1;
#define DS_LOAD(ch) do { const size_t gi = gbase + (size_t)((ch) * 64 + ls) * 256; rKK = *(const u32x4*)(DKK + gi); rAI = *(const u32x4*)(DAI + gi); rKP = *(const u32x4*)(DKP + gi); \
        rR = *(const u32x4*)(DR + gi); rV = *(const u32x4*)(DV + gi); rW0 = *(const f32x4*)(DW + gi); rW1 = *(const f32x4*)(DW + gi + 4); } while (0)
#define DS_STORE() do { const int li = ls * 64 + 8 * lseg; *(LAS u32x4*)(sKK + li) = rKK; *(LAS u32x4*)(sAI + li) = rAI; *(LAS u32x4*)(sKP + li) = rKP; *(LAS u32x4*)(sR + li) = rR; *(LAS u32x4*)(sV + li) = rV; \
        *(LAS f32x4*)(sW + li) = rW0; *(LAS f32x4*)(sW + li + 4) = rW1; } while (0)
    DS_LOAD(0); DS_STORE(); __syncthreads();
    for (int ch = 0; ch < SEQ / 64; ++ch) {
        if (ch + 1 < SEQ / 64) DS_LOAD(ch + 1);
#pragma unroll 2
        for (int s = 0; s < 64; ++s) {
            const int li = s * 64 + 8 * part;
            const u32x4 kk4 = *(const LAS u32x4*)(sKK + li), ai4 = *(const LAS u32x4*)(sAI + li), kp4 = *(const LAS u32x4*)(sKP + li), r4 = *(const LAS u32x4*)(sR + li);
            const f32x4 w0 = *(const LAS f32x4*)(sW + li), w1 = *(const LAS f32x4*)(sW + li + 4);
            const float vrow = bf2f(sV[s * 64 + row]);
            const float kk[8] = {bflo(kk4.x), bfhi(kk4.x), bflo(kk4.y), bfhi(kk4.y), bflo(kk4.z), bfhi(kk4.z), bflo(kk4.w), bfhi(kk4.w)};
            const float ai[8] = {bflo(ai4.x), bfhi(ai4.x), bflo(ai4.y), bfhi(ai4.y), bflo(ai4.z), bfhi(ai4.z), bflo(ai4.w), bfhi(ai4.w)};
            const float kp[8] = {bflo(kp4.x), bfhi(kp4.x), bflo(kp4.y), bfhi(kp4.y), bflo(kp4.z), bfhi(kp4.z), bflo(kp4.w), bfhi(kp4.w)};
            const float rr[8] = {bflo(r4.x), bfhi(r4.x), bflo(r4.y), bfhi(r4.y), bflo(r4.z), bfhi(r4.z), bflo(r4.w), bfhi(r4.w)};
            const float ww[8] = {w0[0], w0[1], w0[2], w0[3], w1[0], w1[1], w1[2], w1[3]};
            float sa = 0.f;
#pragma unroll
            for (int j = 0; j < 8; ++j) sa += S[j] * kk[j];
            sa = -sum8(sa);
            float y = 0.f;
#pragma unroll
            for (int j = 0; j < 8; ++j) { S[j] = S[j] * ww[j] + sa * (kk[j] * ai[j]) + vrow * kp[j]; y += S[j] * rr[j]; }
            y = sum8(y);
            if (part == 0) sY[s * 64 + row] = y;
        }
        __syncthreads();
        {
            const int li = ls * 64 + 8 * lseg; const f32x4 y0 = *(const LAS f32x4*)(sY + li), y1 = *(const LAS f32x4*)(sY + li + 4); const u32x4 v4 = *(const LAS u32x4*)(sV + li);
            const float yv[8] = {y0[0], y0[1], y0[2], y0[3], y1[0], y1[1], y1[2], y1[3]};
            const float vv[8] = {bflo(v4.x), bfhi(v4.x), bflo(v4.y), bfhi(v4.y), bflo(v4.z), bfhi(v4.z), bflo(v4.w), bfhi(v4.w)};
            float sm = 0.f;
#pragma unroll
            for (int j = 0; j < 8; ++j) sm += yv[j];
            const float mean = sum8(sm) * (1.f / 64.f); float sq = 0.f;
#pragma unroll
            for (int j = 0; j < 8; ++j) { const float d = yv[j] - mean; sq += d * d; }
            const float rstd = rsqrtf(sum8(sq) * (1.f / 64.f) + 64e-5f);
            const size_t m = (size_t)b * SEQ + ch * 64 + ls; const float bon = BON[m * 4 + h];
            const u32x4 g4 = *(const u32x4*)(DG + m * 256 + h * 64 + 8 * lseg);
            const float gg[8] = {bflo(g4.x), bfhi(g4.x), bflo(g4.y), bfhi(g4.y), bflo(g4.z), bfhi(g4.z), bflo(g4.w), bfhi(g4.w)};
            float o[8];
#pragma unroll
            for (int j = 0; j < 8; ++j) o[j] = ((yv[j] - mean) * rstd * gnw[8 * lseg + j] + gnb[8 * lseg + j] + bon * vv[j]) * gg[j];
            u32x4 w; w.x = pk2(o[0], o[1]); w.y = pk2(o[2], o[3]); w.z = pk2(o[4], o[5]); w.w = pk2(o[6], o[7]);
            *(u32x4*)(YS + m * 1024 + 768 + h * 64 + 8 * lseg) = w;
        }
        __syncthreads();
        if (ch + 1 < SEQ / 64) DS_STORE();
        __syncthreads();
    }
#undef DS_LOAD
#undef DS_STORE
}
__device__ __forceinline__ void cscan_item(const Args& a, int l, int bh, LAS unsigned char* lds, int tid) {
    const int b = bh >> 2, h = bh & 3, wv = tid >> 6, lane = tid & 63, row = wv * 8 + (lane >> 3), part = lane & 7;
    LAS bf16* sQ = (LAS bf16*)(lds); LAS bf16* sK = (LAS bf16*)(lds + 4096); LAS bf16* sV = (LAS bf16*)(lds + 8192); LAS float* sA = (LAS float*)(lds + 16384); LAS float* sY = (LAS float*)(lds + 24576);
    const bf16* P = (const bf16*)(a.ws + WS_BIG); const float* CA = (const float*)(a.ws + WS_CA); bf16* YS = (bf16*)((unsigned char*)a.out + DO_YS);
    const float* ng = a.in[7] + l * 256 + h * 64;
    const int ls = tid >> 3, lseg = tid & 7;
    const size_t tok0 = (size_t)b * SEQ;
    float S[4] = {0.f, 0.f, 0.f, 0.f};
    u32x4 rQK, rV; f32x4 rA;
    const int qs = (tid & 255) >> 2, qseg = tid & 3, isk = tid >> 8;
#define CS_LOAD(ch) do { const size_t tq = tok0 + (ch) * 64 + qs; rQK = *(const u32x4*)(P + tq * PW + (isk ? PC_CK : PC_CQ) + h * 32 + 8 * qseg); \
        const size_t tv = tok0 + (ch) * 64 + ls; rV = *(const u32x4*)(P + tv * PW + PC_CV + h * 64 + 8 * lseg); rA = *(const f32x4*)(CA + tv * 128 + h * 32 + 4 * lseg); } while (0)
#define CS_STORE() do { *(LAS u32x4*)((isk ? sK : sQ) + qs * 32 + 8 * qseg) = rQK; *(LAS u32x4*)(sV + ls * 64 + 8 * lseg) = rV; *(LAS f32x4*)(sA + ls * 32 + 4 * lseg) = rA; } while (0)
    CS_LOAD(0); CS_STORE(); __syncthreads();
    for (int ch = 0; ch < SEQ / 64; ++ch) {
        if (ch + 1 < SEQ / 64) CS_LOAD(ch + 1);
#pragma unroll 2
        for (int s = 0; s < 64; ++s) {
            const u32x2 q2 = *(const LAS u32x2*)(sQ + s * 32 + 4 * part), k2 = *(const LAS u32x2*)(sK + s * 32 + 4 * part); const f32x4 a4 = *(const LAS f32x4*)(sA + s * 32 + 4 * part);
            const float vrow = bf2f(sV[s * 64 + row]);
            const float qq[4] = {bflo(q2.x), bfhi(q2.x), bflo(q2.y), bfhi(q2.y)}; const float kk[4] = {bflo(k2.x), bfhi(k2.x), bflo(k2.y), bfhi(k2.y)};
            float o = 0.f;
#pragma unroll
            for (int j = 0; j < 4; ++j) { S[j] = a4[j] * S[j] + kk[j] * vrow; o += qq[j] * S[j]; }
            o = sum8(o) * 0.17677669529663687f;
            if (part == 0) sY[s * 64 + row] = o;
        }
        __syncthreads();
        { const int li = ls * 64 + 8 * lseg; const f32x4 y0 = *(const LAS f32x4*)(sY + li), y1 = *(const LAS f32x4*)(sY + li + 4);
            const float yv[8] = {y0[0], y0[1], y0[2], y0[3], y1[0], y1[1], y1[2], y1[3]};
            float sq = 0.f;
#pragma unroll
            for (int j = 0; j < 8; ++j) sq += yv[j] * yv[j];
            const float rn = rsqrtf(sum8(sq) * (1.f / 64.f) + 1e-6f);
            const size_t m = tok0 + ch * 64 + ls; const u32x4 g4 = *(const u32x4*)(P + m * PW + PC_CG + h * 64 + 8 * lseg);
            const float gg[8] = {bflo(g4.x), bfhi(g4.x), bflo(g4.y), bfhi(g4.y), bflo(g4.z), bfhi(g4.z), bflo(g4.w), bfhi(g4.w)};
            float o[8];
#pragma unroll
            for (int j = 0; j < 8; ++j) o[j] = gg[j] * sigmoidf_(gg[j]) * (yv[j] * rn * ng[8 * lseg + j]);
            u32x4 w; w.x = pk2(o[0], o[1]); w.y = pk2(o[2], o[3]); w.z = pk2(o[4], o[5]); w.w = pk2(o[6], o[7]);
            *(u32x4*)(YS + m * 1024 + 512 + h * 64 + 8 * lseg) = w; }
        __syncthreads();
        if (ch + 1 < SEQ / 64) CS_STORE();
        __syncthreads();
    }
#undef CS_LOAD
#undef CS_STORE
}
__device__ __forceinline__ void mixA_item(const Args& a, int m, LAS unsigned char* lds, int lane_in) {
    int lane = lane_in; asm volatile("" : "+v"(lane));
    const bf16* P = (const bf16*)(a.ws + WS_BIG); bf16* YS = (bf16*)((unsigned char*)a.out + DO_YS);
    const LAS unsigned char* bkt = lds + BKT_OFF; const LAS float* rpb = (const LAS float*)(lds + RPB_OFF);
    const int t = m & (SEQ - 1); const size_t rowb = (size_t)(m - t); const int hh = lane & 3;
    float q[64];
    { const u32x4* qp = (const u32x4*)(P + (size_t)m * PW + PC_AQ + hh * 64);
#pragma unroll
      for (int i = 0; i < 8; ++i) { const u32x4 w = qp[i]; q[8 * i + 0] = bflo(w.x) * 0.125f; q[8 * i + 1] = bfhi(w.x) * 0.125f; q[8 * i + 2] = bflo(w.y) * 0.125f; q[8 * i + 3] = bfhi(w.y) * 0.125f;
          q[8 * i + 4] = bflo(w.z) * 0.125f; q[8 * i + 5] = bfhi(w.z) * 0.125f; q[8 * i + 6] = bflo(w.w) * 0.125f; q[8 * i + 7] = bfhi(w.w) * 0.125f; } }
    float sc[25]; float mx = -INFINITY;
#pragma unroll
    for (int i = 0; i < 25; ++i) { const int e = (lane >> 2) + 16 * i; const int p = (e >= 258) ? 2 : (e >= 129 ? 1 : 0); const int j = e - 129 * p; const int s = t - (j << (2 * p));
        float v = -INFINITY;
        if (e < 387 && s >= 0) { const u32x4* kp = (const u32x4*)(P + (rowb + s) * PW + PC_AK + hh * 64); float d = 0.f;
#pragma unroll
            for (int c = 0; c < 8; ++c) { const u32x4 w = kp[c]; d += q[8 * c] * bflo(w.x) + q[8 * c + 1] * bfhi(w.x) + q[8 * c + 2] * bflo(w.y) + q[8 * c + 3] * bfhi(w.y) + q[8 * c + 4] * bflo(w.z) + q[8 * c + 5] * bfhi(w.z) + q[8 * c + 6] * bflo(w.w) + q[8 * c + 7] * bfhi(w.w); }
            v = d + rpb[bkt[t - s] * 8 + hh]; }
        sc[i] = v; mx = fmaxf(mx, v); }
    mx = fmaxf(mx, __shfl_xor(mx, 4)); mx = fmaxf(mx, __shfl_xor(mx, 8)); mx = fmaxf(mx, __shfl_xor(mx, 16)); mx = fmaxf(mx, __shfl_xor(mx, 32));
    float den = 0.f;
#pragma unroll
    for (int i = 0; i < 25; ++i) { sc[i] = __expf(sc[i] - mx); den += sc[i]; }
    den += __shfl_xor(den, 4); den += __shfl_xor(den, 8); den += __shfl_xor(den, 16); den += __shfl_xor(den, 32);
    const int h2 = lane >> 4, cq = lane & 15;
    float acc0 = 0.f, acc1 = 0.f, acc2 = 0.f, acc3 = 0.f;
#pragma unroll
    for (int i = 0; i < 25; ++i) {
#pragma unroll 1
        for (int el = 0; el < 16; ++el) { const int e = 16 * i + el; const int p = (e >= 258) ? 2 : (e >= 129 ? 1 : 0); const int j = e - 129 * p; const int s = t - (j << (2 * p));
            if (e < 387 && s >= 0) { const float pe = __shfl(sc[i], 4 * el + h2); const u32x2 w = *(const u32x2*)(P + (rowb + s) * PW + PC_AV + h2 * 64 + 4 * cq);
                acc0 += pe * bflo(w.x); acc1 += pe * bfhi(w.x); acc2 += pe * bflo(w.y); acc3 += pe * bfhi(w.y); } } }
    const float rd = 1.f / __shfl(den, h2);
    u32x2 o; o.x = pk2(acc0 * rd, acc1 * rd); o.y = pk2(acc2 * rd, acc3 * rd);
    *(u32x2*)(YS + (size_t)m * 1024 + h2 * 64 + 4 * cq) = o;
}
__device__ __forceinline__ unsigned fkey(float f) { const unsigned u = __float_as_uint(f); return (u & 0x80000000u) ? ~u : (u | 0x80000000u); }
__device__ __forceinline__ void mixB_item(const Args& a, int l, int m, LAS unsigned char* lds, LAS unsigned char* wscr, int lane_in) {
    int lane = lane_in; asm volatile("" : "+v"(lane));
    const bf16* P = (const bf16*)(a.ws + WS_BIG); const bf16* CKVN = (const bf16*)(a.ws + WS_CKVN); bf16* YS = (bf16*)((unsigned char*)a.out + DO_YS);
    const LAS unsigned char* bkt = lds + BKT_OFF; const LAS float* rpb = (const LAS float*)(lds + RPB_OFF);
    LAS float* siq = (LAS float*)wscr; LAS float* sq = (LAS float*)(wscr + 1024); LAS unsigned short* sidx = (LAS unsigned short*)(wscr + 2048);
    const int t = m & (SEQ - 1); const size_t rowb = (size_t)(m - t); const bf16* prow = P + (size_t)m * PW;
    { const u32x2 w = *(const u32x2*)(prow + PC_IQ + 4 * lane); const float s = 0.17677669529663687f;
      *(LAS f32x4*)(siq + 4 * lane) = (f32x4){bflo(w.x) * s, bfhi(w.x) * s, bflo(w.y) * s, bfhi(w.y) * s};
      const u32x2 v = *(const u32x2*)(prow + PC_BQ + 4 * lane);
      *(LAS f32x4*)(sq + 4 * lane) = (f32x4){bflo(v.x) * 0.125f, bfhi(v.x) * 0.125f, bflo(v.y) * 0.125f, bfhi(v.y) * 0.125f}; }
    LAS float* siw = (LAS float*)(wscr + 2560);
    if (lane < 8) siw[lane] = bf2f(prow[PC_IW + lane]) * 0.35355339059327373f;
    LDS_WAIT(); asm volatile("" ::: "memory");
    float sc[32];
    const int nblk = (t >> 6) + 1;
#pragma unroll
    for (int i = 0; i < 32; ++i) {
        float v = -INFINITY; asm volatile("" ::: "memory");
        if (i < nblk) { const int s = lane + 64 * i; const u32x4* kp = (const u32x4*)(P + (rowb + s) * PW + PC_IK);
            float kf[32];
#pragma unroll
            for (int c = 0; c < 4; ++c) { const u32x4 w = kp[c]; kf[8 * c] = bflo(w.x); kf[8 * c + 1] = bfhi(w.x); kf[8 * c + 2] = bflo(w.y); kf[8 * c + 3] = bfhi(w.y); kf[8 * c + 4] = bflo(w.z); kf[8 * c + 5] = bfhi(w.z); kf[8 * c + 6] = bflo(w.w); kf[8 * c + 7] = bfhi(w.w); }
            float score = 0.f;
#pragma unroll 1
            for (int h = 0; h < 8; ++h) { float d = 0.f;
#pragma unroll
                for (int c = 0; c < 8; ++c) { const f32x4 qv = *(const LAS f32x4*)(siq + h * 32 + 4 * c); d += qv[0] * kf[4 * c] + qv[1] * kf[4 * c + 1] + qv[2] * kf[4 * c + 2] + qv[3] * kf[4 * c + 3]; }
                score += fmaxf(d, 0.f) * siw[h]; }
            v = (s <= t) ? score : -INFINITY; }
        sc[i] = v; }
    unsigned Kth = 0u; bool exact = false; int need = 0;
    if (t + 1 > 256) {
#pragma unroll 1
        for (int bit = 31; bit >= 0; --bit) { const unsigned cand = Kth | (1u << bit); int cnt = 0;
#pragma unroll
            for (int i = 0; i < 32; ++i) cnt += __popcll(__ballot(fkey(sc[i]) >= cand));
            if (cnt >= 256) { Kth = cand; if (cnt == 256) { exact = true; break; } } }
        if (!exact) { int cgt = 0;
#pragma unroll
            for (int i = 0; i < 32; ++i) cgt += __popcll(__ballot(fkey(sc[i]) > Kth));
            need = 256 - cgt; }
    }
    const unsigned long long ltm = (1ull << lane) - 1ull;
    int base = 0, tie_taken = 0;
#pragma unroll
    for (int i = 0; i < 32; ++i) { const int s = lane + 64 * i; const unsigned k = fkey(sc[i]); bool take;
        if (t + 1 <= 256) take = (s <= t);
        else { const bool s1 = exact ? (k >= Kth) : (k > Kth); const bool tie = (!exact) && (k == Kth); const unsigned long long mt = __ballot(tie);
            take = s1 || (tie && (tie_taken + __popcll(mt & ltm)) < need); tie_taken += __popcll(mt); }
        const unsigned long long ms = __ballot(take);
        if (take) sidx[base + __popcll(ms & ltm)] = (unsigned short)s;
        base += __popcll(ms); }
    const int nsel = base;
    LDS_WAIT(); asm volatile("" ::: "memory");
    float lg[4][4]; int idxs[4];
#pragma unroll
    for (int j = 0; j < 4; ++j)
#pragma unroll
        for (int h = 0; h < 4; ++h) lg[j][h] = -INFINITY;
#pragma unroll
    for (int j = 0; j < 4; ++j) { asm volatile("" ::: "memory"); const int kk = lane + 64 * j; const bool valid = kk < nsel; const int idx = valid ? (int)sidx[kk] : 0; idxs[j] = idx;
        const u32x4* cp = (const u32x4*)(CKVN + (rowb + idx) * 64); float cf[64];
#pragma unroll
        for (int c = 0; c < 8; ++c) { const u32x4 w = cp[c]; cf[8 * c] = bflo(w.x); cf[8 * c + 1] = bfhi(w.x); cf[8 * c + 2] = bflo(w.y); cf[8 * c + 3] = bfhi(w.y); cf[8 * c + 4] = bflo(w.z); cf[8 * c + 5] = bfhi(w.z); cf[8 * c + 6] = bflo(w.w); cf[8 * c + 7] = bfhi(w.w); }
#pragma unroll 1
        for (int h = 0; h < 4; ++h) { float d = 0.f;
#pragma unroll
            for (int c = 0; c < 16; ++c) { const f32x4 qv = *(const LAS f32x4*)(sq + h * 64 + 4 * c); d += qv[0] * cf[4 * c] + qv[1] * cf[4 * c + 1] + qv[2] * cf[4 * c + 2] + qv[3] * cf[4 * c + 3]; }
            const float val = valid ? d + rpb[bkt[t - idx] * 8 + 4 + h] : -INFINITY;
#pragma unroll
            for (int hh = 0; hh < 4; ++hh) lg[j][hh] = (h == hh) ? val : lg[j][hh]; } }
    float den[4];
#pragma unroll
    for (int h = 0; h < 4; ++h) { float mx = fmaxf(fmaxf(lg[0][h], lg[1][h]), fmaxf(lg[2][h], lg[3][h])); mx = wave_max(mx); float s = 0.f;
#pragma unroll
        for (int j = 0; j < 4; ++j) { lg[j][h] = __expf(lg[j][h] - mx); s += lg[j][h]; }
        den[h] = wave_sum(s); }
    float o0 = 0.f, o1 = 0.f, o2 = 0.f, o3 = 0.f;
#pragma unroll
    for (int j = 0; j < 4; ++j) {
#pragma unroll 1
        for (int kl = 0; kl < 64; ++kl) { if (64 * j + kl >= nsel) break; const int idx = __shfl(idxs[j], kl); const float val = bf2f(CKVN[(rowb + idx) * 64 + lane]);
            o0 += __shfl(lg[j][0], kl) * val; o1 += __shfl(lg[j][1], kl) * val; o2 += __shfl(lg[j][2], kl) * val; o3 += __shfl(lg[j][3], kl) * val; } }
    o0 /= den[0]; o1 /= den[1]; o2 /= den[2]; o3 /= den[3];
    const float* wuv = a.in[4] + (size_t)l * 4 * 64 * 64;
    float y0 = 0.f, y1 = 0.f, y2 = 0.f, y3 = 0.f;
#pragma unroll 4
    for (int c = 0; c < 64; ++c) { y0 += __shfl(o0, c) * wuv[(0 * 64 + c) * 64 + lane]; y1 += __shfl(o1, c) * wuv[(1 * 64 + c) * 64 + lane]; y2 += __shfl(o2, c) * wuv[(2 * 64 + c) * 64 + lane]; y3 += __shfl(o3, c) * wuv[(3 * 64 + c) * 64 + lane]; }
    bf16* yr = YS + (size_t)m * 1024 + 256;
    yr[lane] = (bf16)f2bf(y0); yr[64 + lane] = (bf16)f2bf(y1); yr[128 + lane] = (bf16)f2bf(y2); yr[192 + lane] = (bf16)f2bf(y3);
}
__device__ __forceinline__ void mixers_phase(const Args& a, int l, LAS unsigned char* lds, int bid, int G, int tid, int wave, int lane) {
    for (int it = bid; it < 256; it += G) {
#ifndef MIX_NO_D
        if (it < 128) dscan_item(a, l, it, lds, tid);
#endif
#ifndef MIX_NO_C
        if (it >= 128) cscan_item(a, l, it - 128, lds, tid);
#endif
 __syncthreads(); }
    unsigned* qh = (unsigned*)(a.ws + WS_CTL) + CW_Q + 64 * l;
    LAS unsigned char* wscr = lds + wave * 4096;
    for (;;) {
        unsigned cq = 0; if (lane == 0) cq = __hip_atomic_fetch_add(qh, 1u, __ATOMIC_RELAXED, __HIP_MEMORY_SCOPE_AGENT);
        cq = (unsigned)__builtin_amdgcn_readfirstlane((int)cq);
        if (cq >= 16384u) break;
        if (cq < 8192u) { const int tb = 255 - (int)(cq >> 5), b = (int)(cq & 31u); const int m0 = b * SEQ + tb * 8;
#pragma unroll 1
            for (int k = 0; k < 8; ++k) {
#ifndef MIX_NO_B
                mixB_item(a, l, m0 + k, lds, wscr, lane);
#endif
            } }
        else { const int m0 = (int)(cq - 8192u) * 8;
#pragma unroll 1
            for (int k = 0; k < 8; ++k) {
#ifndef MIX_NO_A
                mixA_item(a, m0 + k, lds, lane);
#endif
            } }
    }
}

constexpr int RREC_OFF = MISC_OFF + 4096, LCNT_OFF = MISC_OFF + 10240, LBASE_OFF = MISC_OFF + 10368;
__device__ __forceinline__ void ln1_route_phase(const Args& a, int l, LAS unsigned char* lds, int bid, int G, int tid, int wave, int lane) {
    bf16* XB = (bf16*)(a.ws + WS_XB); const float* WRT = (const float*)(a.ws + WS_RT) + (size_t)l * 36 * 1024;
    unsigned* tokinfo = (unsigned*)(a.ws + WS_TOK); unsigned* cntg = (unsigned*)(a.ws + WS_CTL) + CW_CNT + (l * 32) * 64;
    const float* lng = a.in[21] + (l * 2 + 0) * 1024; const float* lnb = a.in[22] + (l * 2 + 0) * 1024;
    const float* brg = a.in[24] + l * 4; const float* bre = a.in[26] + l * 32;
    LAS float* sW = (LAS float*)lds;
    LAS unsigned* rrec = (LAS unsigned*)(lds + RREC_OFF); LAS int* lcnt = (LAS int*)(lds + LCNT_OFF); LAS unsigned* lbase = (LAS unsigned*)(lds + LBASE_OFF);
    for (int i = tid; i < 32 * 1024 / 4; i += NTHR) *(LAS f32x4*)(sW + 4 * i) = *(const f32x4*)(WRT + 4 * 1024 + 4 * i);
    f32x4 gam[4], bet[4], wg[4][4];
#pragma unroll
    for (int j = 0; j < 4; ++j) { gam[j] = *(const f32x4*)(lng + 4 * lane + 256 * j); bet[j] = *(const f32x4*)(lnb + 4 * lane + 256 * j);
#pragma unroll
        for (int e = 0; e < 4; ++e) wg[e][j] = *(const f32x4*)(WRT + e * 1024 + 4 * lane + 256 * j); }
    for (int blk = bid; blk < NTOK / 256; blk += G) {
        if (tid < 32) lcnt[tid] = 0;
        __syncthreads();
#pragma unroll 1
        for (int rg = 0; rg < 8; ++rg) {
            const int rl0 = wave * 32 + rg * 4; f32x4 x[4][4]; float mylog[4];
#pragma unroll
            for (int r = 0; r < 4; ++r) { bf16* xr = XB + (size_t)(blk * 256 + rl0 + r) * 1024; float s = 0.f;
#pragma unroll
                for (int j = 0; j < 4; ++j) { const u32x2 w = *(const u32x2*)(xr + 4 * lane + 256 * j); x[r][j] = (f32x4){bflo(w.x), bfhi(w.x), bflo(w.y), bfhi(w.y)}; s += (x[r][j][0] + x[r][j][1]) + (x[r][j][2] + x[r][j][3]); }
                const float mean = wave_sum(s) * (1.f / 1024.f); float q = 0.f;
#pragma unroll
                for (int j = 0; j < 4; ++j) { x[r][j] = x[r][j] - mean; q += (x[r][j][0] * x[r][j][0] + x[r][j][1] * x[r][j][1]) + (x[r][j][2] * x[r][j][2] + x[r][j][3] * x[r][j][3]); }
                const float rstd = rsqrtf(wave_sum(q) * (1.f / 1024.f) + LN_EPS);
#pragma unroll
                for (int j = 0; j < 4; ++j) { x[r][j] = x[r][j] * rstd * gam[j] + bet[j]; u32x2 w; w.x = pk2(x[r][j][0], x[r][j][1]); w.y = pk2(x[r][j][2], x[r][j][3]); *(u32x2*)(xr + 4 * lane + 256 * j) = w; }
                mylog[r] = 0.f; }
#pragma unroll
            for (int e = 0; e < 4; ++e)
#pragma unroll
                for (int r = 0; r < 4; ++r) { float d = 0.f;
#pragma unroll
                    for (int j = 0; j < 4; ++j) d += (x[r][j][0] * wg[e][j][0] + x[r][j][1] * wg[e][j][1]) + (x[r][j][2] * wg[e][j][2] + x[r][j][3] * wg[e][j][3]);
                    d = wave_sum(d) + brg[e]; if (lane == e) mylog[r] = d; }
#pragma unroll 1
            for (int e = 0; e < 32; ++e) { f32x4 w4[4];
#pragma unroll
                for (int j = 0; j < 4; ++j) w4[j] = *(const LAS f32x4*)(sW + e * 1024 + 4 * lane + 256 * j);
                const float be = bre[e];
#pragma unroll
                for (int r = 0; r < 4; ++r) { float d = 0.f;
#pragma unroll
                    for (int j = 0; j < 4; ++j) d += (x[r][j][0] * w4[j][0] + x[r][j][1] * w4[j][1]) + (x[r][j][2] * w4[j][2] + x[r][j][3] * w4[j][3]);
                    d = wave_sum(d) + be; if (lane == 4 + e) mylog[r] = d; } }
#pragma unroll
            for (int r = 0; r < 4; ++r) {
                const float g0 = __shfl(mylog[r], 0), g1 = __shfl(mylog[r], 1), g2 = __shfl(mylog[r], 2), g3 = __shfl(mylog[r], 3);
                int gs = 0; float gm = g0; if (g1 > gm) { gm = g1; gs = 1; } if (g2 > gm) { gm = g2; gs = 2; } if (g3 > gm) { gm = g3; gs = 3; }
                const float ptop = 1.f / (__expf(g0 - gm) + __expf(g1 - gm) + __expf(g2 - gm) + __expf(g3 - gm));
                float v0 = -INFINITY, v1 = -INFINITY; int i0 = 0, i1 = 0;
#pragma unroll
                for (int j = 0; j < 8; ++j) { const float le = __shfl(mylog[r], 4 + gs * 8 + j);
                    if (le > v0) { v1 = v0; i1 = i0; v0 = le; i0 = j; } else if (le > v1) { v1 = le; i1 = j; } }
                const float ex = __expf(v1 - v0), w0 = ptop / (1.f + ex), w1 = ptop * ex / (1.f + ex);
                if (lane == 0) { const int e0 = gs * 8 + i0, e1 = gs * 8 + i1; const int rl = rl0 + r;
                    const int p0 = atomicAdd((int*)&lcnt[e0], 1), p1 = atomicAdd((int*)&lcnt[e1], 1);
                    rrec[rl * 6 + 0] = (unsigned)e0; rrec[rl * 6 + 1] = (unsigned)p0; rrec[rl * 6 + 2] = __float_as_uint(w0); rrec[rl * 6 + 3] = (unsigned)e1; rrec[rl * 6 + 4] = (unsigned)p1; rrec[rl * 6 + 5] = __float_as_uint(w1); } }
        }
        __syncthreads();
        if (tid < 32) lbase[tid] = __hip_atomic_fetch_add(cntg + tid * 64, (unsigned)lcnt[tid], __ATOMIC_RELAXED, __HIP_MEMORY_SCOPE_AGENT);
        __syncthreads();
        if (tid < 256) { const unsigned e0 = rrec[tid * 6 + 0], e1 = rrec[tid * 6 + 3]; unsigned* ti = tokinfo + (size_t)(blk * 256 + tid) * 8;
            u32x4 o0, o1; o0.x = e0; o0.y = lbase[e0] + rrec[tid * 6 + 1]; o0.z = rrec[tid * 6 + 2]; o0.w = e1; o1.x = lbase[e1] + rrec[tid * 6 + 4]; o1.y = rrec[tid * 6 + 5]; o1.z = 0u; o1.w = 0u;
            *(u32x4*)ti = o0; *(u32x4*)(ti + 4) = o1; }
        __syncthreads();
    }
}
__device__ __forceinline__ void moe_table(const Args& a, int l, LAS unsigned char* lds, int tid) {
    LAS int* tstart = (LAS int*)(lds + TST_OFF);
    if (tid == 0) { const unsigned* cntg = (const unsigned*)(a.ws + WS_CTL) + CW_CNT + (l * 32) * 64; int acc = 0;
        for (int e = 0; e < 32; ++e) { tstart[e] = acc; acc += (int)((__hip_atomic_load(cntg + e * 64, __ATOMIC_RELAXED, __HIP_MEMORY_SCOPE_AGENT) + 255u) >> 8); }
        tstart[32] = acc; }
    __syncthreads();
}
__device__ __forceinline__ void scatter_phase(const Args& a, int l, LAS unsigned char* lds, int bid, int G, int tid, int gw, int NGW, int lane) {
    const LAS int* tstart = (const LAS int*)(lds + TST_OFF);
    const bf16* XB = (const bf16*)(a.ws + WS_XB); bf16* XS = (bf16*)(a.ws + WS_BIG); unsigned* rowinfo = (unsigned*)(a.ws + WS_ROW); const unsigned* tokinfo = (const unsigned*)(a.ws + WS_TOK);
    const unsigned* cntg = (const unsigned*)(a.ws + WS_CTL) + CW_CNT + (l * 32) * 64;
    for (int e = bid; e < 32; e += G) { const int c = (int)__hip_atomic_load(cntg + e * 64, __ATOMIC_RELAXED, __HIP_MEMORY_SCOPE_AGENT); const int r0 = tstart[e] * 256, r1 = tstart[e + 1] * 256;
        unsigned neg_ = 0xffffffffu, zer_ = 0u; asm volatile("" : "+v"(neg_), "+v"(zer_));
        for (int r = r0 + c + tid; r < r1; r += NTHR) { rowinfo[2 * (size_t)r] = neg_; rowinfo[2 * (size_t)r + 1] = zer_; } }
    for (int m = gw; m < NTOK; m += NGW) {
        const u32x4 t0 = *(const u32x4*)(tokinfo + (size_t)m * 8); const u32x2 t1 = *(const u32x2*)(tokinfo + (size_t)m * 8 + 4);
        const size_t r0 = (size_t)tstart[t0.x] * 256 + t0.y, r1 = (size_t)tstart[t0.w] * 256 + t1.x;
        const u32x4* src = (const u32x4*)(XB + (size_t)m * 1024); const u32x4 v0 = src[lane], v1 = src[64 + lane];
        u32x4* d0 = (u32x4*)(XS + r0 * 1024); u32x4* d1 = (u32x4*)(XS + r1 * 1024);
        d0[lane] = v0; d0[64 + lane] = v1; d1[lane] = v0; d1[64 + lane] = v1;
        if (lane == 0) { rowinfo[2 * r0] = (unsigned)(m * 2); rowinfo[2 * r0 + 1] = t0.z; rowinfo[2 * r1] = (unsigned)(m * 2 + 1); rowinfo[2 * r1 + 1] = t1.y; }
    }
}
__device__ __forceinline__ void ln2_phase(const Args& a, int l, int gw, int NGW, int lane) {
    bf16* XB = (bf16*)(a.ws + WS_XB); const bf16* Y = (const bf16*)(a.ws + WS_BIG);
    const float* lng = a.in[21] + (l * 2 + 1) * 1024; const float* lnb = a.in[22] + (l * 2 + 1) * 1024;
    f32x4 gam[4], bet[4];
#pragma unroll
    for (int j = 0; j < 4; ++j) { gam[j] = *(const f32x4*)(lng + 4 * lane + 256 * j); bet[j] = *(const f32x4*)(lnb + 4 * lane + 256 * j); }
    for (int m = gw; m < NTOK; m += NGW) {
        bf16* xr = XB + (size_t)m * 1024; const bf16* y0 = Y + (size_t)m * 1024; const bf16* y1 = Y + ((size_t)NTOK + m) * 1024;
        f32x4 x[4]; float s = 0.f;
#pragma unroll
        for (int j = 0; j < 4; ++j) { const u32x2 w = *(const u32x2*)(xr + 4 * lane + 256 * j), p = *(const u32x2*)(y0 + 4 * lane + 256 * j), q = *(const u32x2*)(y1 + 4 * lane + 256 * j);
            x[j] = (f32x4){DN_ALPHA * bflo(w.x) + (bflo(p.x) + bflo(q.x)), DN_ALPHA * bfhi(w.x) + (bfhi(p.x) + bfhi(q.x)), DN_ALPHA * bflo(w.y) + (bflo(p.y) + bflo(q.y)), DN_ALPHA * bfhi(w.y) + (bfhi(p.y) + bfhi(q.y))};
            s += (x[j][0] + x[j][1]) + (x[j][2] + x[j][3]); }
        const float mean = wave_sum(s) * (1.f / 1024.f); float q = 0.f;
#pragma unroll
        for (int j = 0; j < 4; ++j) { x[j] = x[j] - mean; q += (x[j][0] * x[j][0] + x[j][1] * x[j][1]) + (x[j][2] * x[j][2] + x[j][3] * x[j][3]); }
        const float rstd = rsqrtf(wave_sum(q) * (1.f / 1024.f) + LN_EPS);
#pragma unroll
        for (int j = 0; j < 4; ++j) { x[j] = x[j] * rstd * gam[j] + bet[j];
            if (l == NLAYER - 1) *(f32x4*)(a.out + (size_t)m * 1024 + 4 * lane + 256 * j) = x[j];
            else { u32x2 w; w.x = pk2(x[j][0], x[j][1]); w.y = pk2(x[j][2], x[j][3]); *(u32x2*)(xr + 4 * lane + 256 * j) = w; } }
    }
}

#ifndef MK_MULTI
#define MK_MULTI 0
#endif
constexpr int NPHASE = 12;
__device__ __forceinline__ int t5_bucket(int d) {
    if (d < 16) return d;
    int b = 16;
    b += (d >= 22) + (d >= 30) + (d >= 40) + (d >= 54) + (d >= 73) + (d >= 99) + (d >= 134) + (d >= 182) + (d >= 246) + (d >= 332) + (d >= 450) + (d >= 609) + (d >= 825) + (d >= 1117) + (d >= 1513);
    return b;
}
__global__ void __launch_bounds__(NTHR, 2) fwd(Args a) {
    extern __shared__ __attribute__((aligned(16))) unsigned char lds_raw[];
    LAS unsigned char* lds = (LAS unsigned char*)lds_raw;
    const int G0 = gridDim.x, bid0 = blockIdx.x, wave0 = __builtin_amdgcn_readfirstlane((int)(threadIdx.x >> 6));
#define PH_IDS unsigned on_ = ~0u; asm volatile("" : "+s"(on_)); int lz_ = (int)__builtin_amdgcn_mbcnt_hi(on_, __builtin_amdgcn_mbcnt_lo(on_, 0u)); int wz_ = wave0, bz_ = bid0, gz_ = G0; asm volatile("" : "+s"(wz_), "+s"(bz_), "+s"(gz_)); \
    const int lane = lz_, wave = wz_, tid = wz_ * 64 + lz_, bid = bz_, G = gz_, NGW = gz_ * NWAVES, gw = bid * NWAVES + wave; (void)lane; (void)gw; (void)wave; (void)tid; (void)NGW;
#define PH_ARGS(LV) const __attribute__((address_space(4))) Args* kp_ = (const __attribute__((address_space(4))) Args*)__builtin_amdgcn_kernarg_segment_ptr(); asm volatile("" : "+s"(kp_)); const Args& b = *(const Args*)kp_; int lq = (LV); asm volatile("" : "+s"(lq)); (void)lq; \
    bf16* XB = (bf16*)(b.ws + WS_XB); bf16* PB = (bf16*)(b.ws + WS_BIG); bf16* YS = (bf16*)((unsigned char*)b.out + DO_YS); bf16* MG = (bf16*)((unsigned char*)b.out + DO_MG); \
    unsigned* rowinfo = (unsigned*)(b.ws + WS_ROW); unsigned char* wl = b.ws + WS_W + (size_t)lq * WL_SIZE; (void)XB; (void)PB; (void)YS; (void)MG; (void)rowinfo; (void)wl;
    unsigned* ctl = (unsigned*)(a.ws + WS_CTL);
    { PH_IDS
    for (int u = tid; u < (LDS_BYTES - MISC_OFF) / 4; u += NTHR) ((LAS unsigned*)(lds + MISC_OFF))[u] = 0u;
    __syncthreads();
    for (int d = tid; d < 2048; d += NTHR) ((LAS unsigned char*)(lds + BKT_OFF))[d] = (unsigned char)t5_bucket(d);
    if (tid < 256) ((LAS float*)(lds + RPB_OFF))[tid] = a.in[1][tid];
    __syncthreads(); }
    XcdBarrier bar; bar.bar = ctl + CW_BAR; bar.x = 0; bar.st = nullptr;
    if (a.use_bar) bar = xcd_barrier_post(ctl + CW_BAR, (volatile LAS unsigned*)(lds + MISC_OFF) + 8);
#define GRID_BAR() do { if (a.use_bar) { const __attribute__((address_space(4))) Args* kq_ = (const __attribute__((address_space(4))) Args*)__builtin_amdgcn_kernarg_segment_ptr(); asm volatile("" : "+s"(kq_)); \
        XcdBarrier bb_ = bar; bb_.bar = (unsigned*)(kq_->ws + WS_CTL) + CW_BAR; xcd_barrier(bb_); } } while (0)
#ifndef PHMASK
#define PHMASK 0xFFF
#endif
#define IN(k) (((PHMASK >> (k)) & 1) && ((phm >> (k)) & 1u))

    unsigned phm = ((1u << a.ph_hi) - 1u) & ~((1u << a.ph_lo) - 1u);
    if (a.l_lo == 0 && IN(0)) { PH_IDS PH_ARGS(0) p0_prologue(b, lds, gw, NGW, wave, lane); GRID_BAR(); }
    for (int l = a.l_lo; l < a.l_hi; ++l) {
        asm volatile("" : "+s"(phm));
        if (IN(1)) { PH_IDS PH_ARGS(l) pg8::Gemm g{XB, (const bf16*)(wl + WL_IN), 1024, 1024, 1024}; pg8::GridOrder S; S.init(NTOK / 256, PW / 256, G, bid);
            pg8::EpiStoreBf16 E{PB, PW}; pg8::gemm_phase(lds, g, S, E, tid); GRID_BAR(); }
        if (IN(2)) { PH_IDS PH_ARGS(l) prep_phase(b, lq, lds, tid, gw, NGW, lane); GRID_BAR(); }
        if (IN(3)) { PH_IDS PH_ARGS(l) mixers_phase(b, lq, lds, bid, G, tid, wave, lane); GRID_BAR(); }
        if (IN(4)) { PH_IDS PH_ARGS(l) pg8::Gemm g{YS, (const bf16*)(wl + WL_BR), 1024, 256, 256}; pg8::GridOrder S; S.init(NTOK / 256, 16, G, bid, 4, 512);
            pg8::EpiStoreBf16 E{PB, 4096}; pg8::gemm_phase(lds, g, S, E, tid); GRID_BAR(); }
        if (IN(5)) { PH_IDS PH_ARGS(l) pg8::Gemm g{XB, (const bf16*)(wl + WL_IN) + (size_t)3072 * 1024, 1024, 1024, 1024}; pg8::GridOrder S; S.init(NTOK / 256, 16, G, bid);
            pg8::EpiGate E{PB, MG}; pg8::gemm_phase(lds, g, S, E, tid); GRID_BAR(); }
        if (IN(6)) { PH_IDS PH_ARGS(l) pg8::Gemm g{MG, (const bf16*)(wl + WL_OUT), 1024, 1024, 1024}; pg8::GridOrder S; S.init(NTOK / 256, 4, G, bid);
            pg8::EpiOut E{XB}; pg8::gemm_phase(lds, g, S, E, tid); GRID_BAR(); }
        if (IN(7)) { PH_IDS PH_ARGS(l) ln1_route_phase(b, lq, lds, bid, G, tid, wave, lane); GRID_BAR(); }
        if (IN(8)) { PH_IDS PH_ARGS(l) moe_table(b, lq, lds, tid); scatter_phase(b, lq, lds, bid, G, tid, gw, NGW, lane); GRID_BAR(); }
        if (IN(9)) { PH_IDS PH_ARGS(l) moe_table(b, lq, lds, tid); pg8::Gemm g{PB, (const bf16*)(wl + WL_GU), 1024, 1024, 1024}; pg8::MoeOrder S{(const LAS int*)(lds + TST_OFF), 1, G, bid};
            pg8::EpiUp E{rowinfo, (bf16*)(b.ws + WS_BIG + BIG_H)}; pg8::gemm_phase(lds, g, S, E, tid); GRID_BAR(); }
        if (IN(10)) { PH_IDS PH_ARGS(l) moe_table(b, lq, lds, tid); pg8::Gemm g{(const bf16*)(b.ws + WS_BIG + BIG_H), (const bf16*)(wl + WL_DN), 256, 256, 256}; pg8::MoeOrder S{(const LAS int*)(lds + TST_OFF), 2, G, bid};
            pg8::EpiDown E{rowinfo, PB}; pg8::gemm_phase(lds, g, S, E, tid); GRID_BAR(); }
        if (IN(11)) { PH_IDS PH_ARGS(l) ln2_phase(b, lq, gw, NGW, lane); if (l + 1 < a.l_hi) GRID_BAR(); }
    }
#undef IN
#undef GRID_BAR
}

extern "C" void kernel_launch(void* const* d_in, const int* in_sizes, int n_in, void* d_out, int out_size, void* d_ws, size_t ws_size, hipStream_t stream) {
    static int grid = 0;
    if (grid == 0) {
        if (n_in != 30 || out_size != NTOK * DM || ws_size < WS_END) { fprintf(stderr, "kernel_launch: unexpected shapes (n_in %d out %d ws %zu)\n", n_in, out_size, ws_size); grid = -1; return; }
        int dev = 0, cus = 0, per_cu = 0;
        if (hipGetDevice(&dev) != hipSuccess || hipDeviceGetAttribute(&cus, hipDeviceAttributeMultiprocessorCount, dev) != hipSuccess) { grid = -1; return; }
        if (hipFuncSetAttribute((const void*)fwd, hipFuncAttributeMaxDynamicSharedMemorySize, LDS_BYTES) != hipSuccess) { fprintf(stderr, "kernel_launch: hipFuncSetAttribute failed\n"); grid = -1; return; }
        if (hipOccupancyMaxActiveBlocksPerMultiprocessor(&per_cu, (const void*)fwd, NTHR, LDS_BYTES) != hipSuccess || per_cu < 1) fprintf(stderr, "kernel_launch: occupancy query says %d\n", per_cu);
        (void)hipGetLastError();
        grid = cus;
    }
    if (grid < 0) return;
    (void)hipMemsetAsync((char*)d_ws + WS_CTL, 0, CTL_ZERO_BYTES, stream);
    Args a{};
    for (int i = 0; i < 30; ++i) a.in[i] = (const float*)d_in[i];
    a.out = (float*)d_out; a.ws = (unsigned char*)d_ws; a.pad = 0;
#if MK_MULTI
    a.use_bar = 0;
    for (int l = 0; l < NLAYER; ++l)
        for (int ph = (l == 0 ? 0 : 1); ph < NPHASE; ++ph) { a.l_lo = l; a.l_hi = l + 1; a.ph_lo = ph; a.ph_hi = ph + 1;
            hipLaunchKernelGGL(fwd, dim3(grid), dim3(NTHR), LDS_BYTES, stream, a); }
#else
    a.use_bar = 1; a.l_lo = 0; a.l_hi = NLAYER; a.ph_lo = 0; a.ph_hi = NPHASE;
    hipLaunchKernelGGL(fwd, dim3(grid), dim3(NTHR), LDS_BYTES, stream, a);
#endif
    const hipError_t le = hipPeekAtLastError();
    if (le != hipSuccess) fprintf(stderr, "kernel_launch: launch failed: %s\n", hipGetErrorName(le));
}
```

```cpp
#include <hip/hip_runtime.h>
#include <cstdio>
#include <cstdint>

#define LAS __attribute__((address_space(3)))
#define GAS __attribute__((address_space(1)))
typedef unsigned short bf16;
typedef short bf16x8 __attribute__((ext_vector_type(8)));
typedef float f32x4 __attribute__((ext_vector_type(4)));
typedef float f32x2 __attribute__((ext_vector_type(2)));
typedef unsigned u32x4 __attribute__((ext_vector_type(4)));
typedef unsigned u32x2 __attribute__((ext_vector_type(2)));

namespace pg8 {
constexpr int BM = 256, BK = 64, HALF = 128, HTB = HALF * BK * 2  , STAGE_BYTES = 8 * HTB, NXCD = 8, WGM = 8;

__host__ __device__ __forceinline__ int lds_byte(int r, int c) { const int st = (r >> 4) * 2 + (c >> 5), rr = r & 15, cc = c & 31, ob = rr * 64 + cc * 2; return st * 1024 + (ob ^ (((ob >> 9) & 1) << 5)); }
__host__ __device__ __forceinline__ void stage_rc(int b, int& R, int& C) { const int st = b / 1024, sb = b % 1024, swz = sb ^ (((sb >> 9) & 1) << 5); R = (st >> 1) * 16 + swz / 64; C = (st & 1) * 32 + (swz % 64) / 2; }
__host__ __device__ __forceinline__ int perm32(int rho) { const int n = rho >> 4, i = rho & 15; return 8 * (i >> 2) + 4 * n + (i & 3); }

struct Unit { int pm, pn, pb; unsigned aoff; };
struct Gemm { const bf16* A; const bf16* Bt; int lda, ldb, K; };

struct GridOrder {
    int nM, nN, nwg, G, c, a_grp, a_grp_bytes;
    __device__ void init(int nM_, int nN_, int G_, int c_, int a_grp_ = 0, int a_grp_bytes_ = 0) { nM = nM_; nN = nN_; nwg = nM * nN; G = G_; c = c_; a_grp = a_grp_; a_grp_bytes = a_grp_bytes_; }
    __device__ bool next(int i, Unit& u) const {
        const long L = (long)i * G + c; if (L >= nwg) return false;
        int wgid = (int)L; { const int q = nwg / NXCD, r = nwg % NXCD, xcd = wgid % NXCD, off = wgid / NXCD; wgid = (xcd < r ? xcd * (q + 1) : r * (q + 1) + (xcd - r) * q) + off; }
        const int nig = WGM * nN, gid = wgid / nig, fm = gid * WGM, gsz = (nM - fm) < WGM ? (nM - fm) : WGM;
        u.pm = fm + ((wgid % nig) % gsz); u.pn = (wgid % nig) / gsz; u.pb = u.pn; u.aoff = a_grp ? (unsigned)((u.pn / a_grp) * a_grp_bytes) : 0u; return true;
    }
};
struct MoeOrder {
    const LAS int* tstart; int nsl, G, c;
    __device__ bool next(int i, Unit& u) const {
        const int L = i * G + c, total = tstart[32] << nsl; if (L >= total) return false;
        const int rt = L >> nsl, pn = L & ((1 << nsl) - 1); int e = 0;
        while (e < 31 && rt >= tstart[e + 1]) ++e;
        u.pm = rt; u.pn = pn; u.pb = (e << nsl) + pn; u.aoff = 0u; return true;
    }
};

__device__ __forceinline__ unsigned cvt_pk_bf16(float lo, float hi) { unsigned r; asm volatile("v_cvt_pk_bf16_f32 %0, %1, %2" : "=v"(r) : "v"(lo), "v"(hi)); return r; }

template <class Epi, class Sched>
__device__ __forceinline__ void gemm_phase(LAS unsigned char* lds, const Gemm g, const Sched& S, const Epi& E, const int tid) {
    const int wid = __builtin_amdgcn_readfirstlane(tid >> 6), lane = tid & 63, wr = wid >> 2, wc = wid & 3, fr = lane & 15, fq = lane >> 4;
    const int K = g.K, nt = K / BK;
    unsigned voffA[2], voffB[2];
#pragma unroll
    for (int i = 0; i < 2; ++i) { int R, C; stage_rc(tid * 16 + i * 8192, R, C); const int Rb = Epi::PERM ? ((R & ~31) + perm32(R & 31)) : R;
        voffA[i] = (unsigned)(R * g.lda + C) * 2u; voffB[i] = (unsigned)(Rb * g.ldb + C) * 2u; }
    const size_t kstep = (size_t)(BK * 2);
    const size_t hstepA = (size_t)HALF * g.lda * 2, hstepB = (size_t)HALF * g.ldb * 2;
    const size_t tstepA = 2 * hstepA, tstepB = 2 * hstepB;
    const unsigned ldsw = (unsigned)wid * 1024u;
    const int aoff = lds_byte(wr * 64 + fr, fq * 8), boff = lds_byte(wc * 32 + fr, fq * 8);
#define PG8_SA(b, h) (((b) * 2 + (h)) * HTB)
#define PG8_SB(b, h) ((4 + (b) * 2 + (h)) * HTB)
#define PG8_STAGE(bufoff, gbase, voff) do { _Pragma("unroll") for (int _i = 0; _i < 2; ++_i) \
        __builtin_amdgcn_global_load_lds((const unsigned*)((const char*)(gbase) + (voff)[_i]), (LAS unsigned*)(lds + (bufoff) + ldsw + _i * 8192), 16, 0, 0); } while (0)
#define PG8_LDA(dst, b, h) do { _Pragma("unroll") for (int m = 0; m < 4; ++m) _Pragma("unroll") for (int k = 0; k < 2; ++k) dst[m][k] = *(const LAS bf16x8*)(lds + PG8_SA(b, h) + aoff + m * 2048 + k * 1024); } while (0)
#define PG8_LDB(dst, b, h) do { _Pragma("unroll") for (int n = 0; n < 2; ++n) _Pragma("unroll") for (int k = 0; k < 2; ++k) dst[n][k] = *(const LAS bf16x8*)(lds + PG8_SB(b, h) + boff + n * 2048 + k * 1024); } while (0)
#define PG8_MMA(ai, bj, At, Bt) do { __builtin_amdgcn_s_setprio(1); _Pragma("unroll") for (int m = 0; m < 4; ++m) _Pragma("unroll") for (int n = 0; n < 2; ++n) _Pragma("unroll") for (int k = 0; k < 2; ++k) \
        acc[ai][bj][m][n] = __builtin_amdgcn_mfma_f32_16x16x32_bf16(Bt[n][k], At[m][k], acc[ai][bj][m][n], 0, 0, 0); __builtin_amdgcn_s_setprio(0); } while (0)
#define PG8_WAIT_V(n) asm volatile("s_waitcnt vmcnt(" #n ")" ::: "memory")
#define PG8_WAIT_L(n) asm volatile("s_waitcnt lgkmcnt(" #n ")" ::: "memory")
#define PG8_BAR __builtin_amdgcn_s_barrier()
#define PG8_SCHED __builtin_amdgcn_sched_barrier(0)
    Unit cur, nxt; int ui = 0;
    if (!S.next(0, cur)) return;
    f32x4 acc[2][2][4][2];
#pragma unroll
    for (int a = 0; a < 2; ++a)
#pragma unroll
        for (int b = 0; b < 2; ++b)
#pragma unroll
            for (int m = 0; m < 4; ++m)
#pragma unroll
                for (int n = 0; n < 2; ++n) acc[a][b][m][n] = (f32x4){0.f, 0.f, 0.f, 0.f};
    bf16x8 At[4][2], B0[2][2], B1[2][2];
    const char* cA = (const char*)g.A + (size_t)cur.pm * tstepA + cur.aoff; const char* cB = (const char*)g.Bt + (size_t)cur.pb * tstepB;
    PG8_STAGE(PG8_SB(0, 0), cB, voffB); PG8_STAGE(PG8_SB(0, 1), cB + hstepB, voffB); PG8_STAGE(PG8_SA(0, 0), cA, voffA); PG8_STAGE(PG8_SA(0, 1), cA + hstepA, voffA);
    if (wr == 1) PG8_BAR;
    PG8_WAIT_V(2); PG8_BAR;
    PG8_STAGE(PG8_SB(1, 0), cB + kstep, voffB); PG8_STAGE(PG8_SA(1, 0), cA + kstep, voffA); PG8_STAGE(PG8_SB(1, 1), cB + hstepB + kstep, voffB);
    PG8_WAIT_V(6); PG8_BAR;
    for (;;) {
        const bool has_next = S.next(ui + 1, nxt);
        const char* nA = has_next ? (const char*)g.A + (size_t)nxt.pm * tstepA + nxt.aoff : cA; const char* nB = has_next ? (const char*)g.Bt + (size_t)nxt.pb * tstepB : cB;
        for (int t = 0; t < nt; t += 2) {
            const bool last = (t == nt - 2);
            const char* a1 = cA + (size_t)(t + 1) * kstep;
            const char* a2 = last ? nA : cA + (size_t)(t + 2) * kstep; const char* b2 = last ? nB : cB + (size_t)(t + 2) * kstep;
            const char* a3 = a2 + kstep; const char* b3 = b2 + kstep;
            PG8_LDB(B0, 0, 0); PG8_LDB(B1, 0, 1); PG8_SCHED; PG8_LDA(At, 0, 0); PG8_STAGE(PG8_SA(1, 1), a1 + hstepA, voffA);
            PG8_WAIT_V(8); PG8_WAIT_L(0); PG8_BAR; PG8_MMA(0, 0, At, B0); PG8_MMA(0, 1, At, B1); PG8_BAR; PG8_SCHED;
            PG8_LDA(At, 0, 1); PG8_STAGE(PG8_SB(0, 0), b2, voffB); PG8_STAGE(PG8_SB(0, 1), b2 + hstepB, voffB); PG8_STAGE(PG8_SA(0, 0), a2, voffA);
            PG8_WAIT_V(8); PG8_WAIT_L(0); PG8_BAR; PG8_MMA(1, 0, At, B0); PG8_MMA(1, 1, At, B1); PG8_BAR; PG8_SCHED;
            PG8_LDB(B0, 1, 0); PG8_LDB(B1, 1, 1); PG8_SCHED; PG8_LDA(At, 1, 0); PG8_STAGE(PG8_SA(0, 1), a2 + hstepA, voffA);
            PG8_WAIT_V(8); PG8_WAIT_L(0); PG8_BAR; PG8_MMA(0, 0, At, B0); PG8_MMA(0, 1, At, B1); PG8_BAR; PG8_SCHED;
            PG8_LDA(At, 1, 1); PG8_STAGE(PG8_SB(1, 0), b3, voffB); PG8_STAGE(PG8_SB(1, 1), b3 + hstepB, voffB); PG8_STAGE(PG8_SA(1, 0), a3, voffA);
            PG8_WAIT_V(8); PG8_WAIT_L(0); PG8_BAR; PG8_MMA(1, 0, At, B0); PG8_MMA(1, 1, At, B1); PG8_BAR; PG8_SCHED;
        }
        if (wr == 0) PG8_BAR;
        { unsigned on_ = ~0u; asm volatile("" : "+s"(on_)); const int lz_ = (int)__builtin_amdgcn_mbcnt_hi(on_, __builtin_amdgcn_mbcnt_lo(on_, 0u));
          E(acc, cur, wr, wc, lz_ & 15, lz_ >> 4); }
        if (!has_next) break;
#pragma unroll
        for (int a = 0; a < 2; ++a)
#pragma unroll
            for (int b = 0; b < 2; ++b)
#pragma unroll
                for (int m = 0; m < 4; ++m)
#pragma unroll
                    for (int n = 0; n < 2; ++n) acc[a][b][m][n] = (f32x4){0.f, 0.f, 0.f, 0.f};
        cur = nxt; cA = nA; cB = nB; ++ui;
        if (wr == 1) PG8_BAR;
    }
    PG8_WAIT_V(0);
    PG8_BAR;
#undef PG8_SA
#undef PG8_SB
#undef PG8_STAGE
#undef PG8_LDA
#undef PG8_LDB
#undef PG8_MMA
#undef PG8_WAIT_V
#undef PG8_WAIT_L
#undef PG8_BAR
#undef PG8_SCHED
}
}

constexpr int NTOK = 65536, DM = 1024, SEQ = 2048, NBATCH = 32, NLAYER = 4;
constexpr int PW = 3072;
constexpr int PC_AQ = 0, PC_AK = 256, PC_AV = 512, PC_BQ = 768, PC_CKV = 1024, PC_IQ = 1088, PC_IK = 1344, PC_IW = 1376,
              PC_CQ = 1384, PC_CK = 1512, PC_CV = 1640, PC_CA = 1896, PC_CG = 1912, PC_D = 2168;
constexpr int IN_W = 7096;
constexpr float LN_EPS = 1e-5f;
constexpr float DN_ALPHA = 1.6817928305074292f;
constexpr int NWAVES = 8, NTHR = 512;
constexpr int MOE_ROWS = 2 * NTOK + 32 * 256;

constexpr size_t MiB = 1u << 20;
constexpr size_t WS_CTL = 0, CTL_ZERO_BYTES = 1 * MiB;
constexpr size_t WS_TOK = 1 * MiB;
constexpr size_t WS_ROW = 3 * MiB;
constexpr size_t WS_BON = 5 * MiB;
constexpr size_t WS_RT = 6 * MiB;
constexpr size_t WS_CKVN = 8 * MiB;
constexpr size_t WS_CA = 16 * MiB;
constexpr size_t WS_W = 48 * MiB;
constexpr size_t WL_IN = 0, WL_BR = 14 * MiB, WL_OUT = 16 * MiB, WL_GU = 18 * MiB, WL_DN = 50 * MiB, WL_SIZE = 66 * MiB;
constexpr size_t WS_XB = 312 * MiB;
constexpr size_t WS_BIG = 440 * MiB;
constexpr size_t BIG_DW = 384 * MiB, BIG_DAI = 448 * MiB, BIG_DG = 480 * MiB;
constexpr size_t BIG_H = 272 * MiB;
constexpr size_t WS_END = 952 * MiB;
constexpr size_t DO_YS = 0, DO_MG = 128 * MiB, DO_DR = 128 * MiB, DO_DKP = 160 * MiB, DO_DV = 192 * MiB, DO_DKK = 224 * MiB;

constexpr int CW_TMO = 0, CW_CODE = 1;
constexpr int CW_BAR = 4096;
constexpr int CW_Q = 8192;
constexpr int CW_CNT = 16384;

constexpr int RING_BYTES = 131072;
constexpr int MISC_OFF = RING_BYTES;
constexpr int TST_OFF = MISC_OFF + 512;
constexpr int BKT_OFF = MISC_OFF + 1024;
constexpr int RPB_OFF = MISC_OFF + 3072;
constexpr int LDS_BYTES = 147456;

#define LDS_WAIT() asm volatile("s_waitcnt lgkmcnt(0)" ::: "memory")
#define VM_WAIT() asm volatile("s_waitcnt vmcnt(0)" ::: "memory")
__device__ __forceinline__ float bf2f(unsigned b) { return __uint_as_float(b << 16); }
__device__ __forceinline__ unsigned f2bf(float f) { unsigned u = __float_as_uint(f); return (u + 0x7fffu + ((u >> 16) & 1u)) >> 16; }
__device__ __forceinline__ unsigned pk2(float lo, float hi) { return f2bf(lo) | (f2bf(hi) << 16); }
__device__ __forceinline__ float bflo(unsigned w) { return __uint_as_float(w << 16); }
__device__ __forceinline__ float bfhi(unsigned w) { return __uint_as_float(w & 0xffff0000u); }
__device__ __forceinline__ float wave_sum(float v) {
#pragma unroll
    for (int o = 1; o < 64; o <<= 1) v += __shfl_xor(v, o);
    return v;
}
__device__ __forceinline__ float wave_max(float v) {
#pragma unroll
    for (int o = 1; o < 64; o <<= 1) v = fmaxf(v, __shfl_xor(v, o));
    return v;
}
template <int CTRL> __device__ __forceinline__ float dppf(float v) {
    return __builtin_bit_cast(float, __builtin_amdgcn_update_dpp(0, __builtin_bit_cast(int, v), CTRL, 0xf, 0xf, true));
}
__device__ __forceinline__ float sum8(float v) { v += dppf<0xB1>(v); v += dppf<0x4E>(v); v += dppf<0x141>(v); return v; }
__device__ __forceinline__ float sigmoidf_(float x) { return 1.f / (1.f + __expf(-x)); }
__device__ __forceinline__ float log_sigmoidf_(float z) { return fminf(z, 0.f) - log1pf(__expf(-fabsf(z))); }

#define XB_TMO      128
#define XB_XCNT(j)  (256  + 64 * (j))
#define XB_XSUB(j)  (1280 + 64 * (j))
#define XB_XGEN(j)  (2304 + 64 * (j))
#define XB_TOP      3328
#define XB_TOPGEN   3392
#define XCD_BAR_WORDS 3456
#define XB_SPIN_CAP (1u << 22)

__device__ __forceinline__ unsigned xb_ld(unsigned* p)              { return __hip_atomic_load(p, __ATOMIC_RELAXED, __HIP_MEMORY_SCOPE_AGENT); }
__device__ __forceinline__ unsigned xb_add(unsigned* p, unsigned v) { return __hip_atomic_fetch_add(p, v, __ATOMIC_RELAXED, __HIP_MEMORY_SCOPE_AGENT); }
__device__ __forceinline__ unsigned xb_xcc_id() { return (unsigned)__builtin_amdgcn_s_getreg((3 << 11) | 20) & 0xFu; }
#define XB_SPIN(cond, bar) do { unsigned _sp = 0; while (cond) { __builtin_amdgcn_s_sleep(1); \
    if ((++_sp & 255u) == 0u) { if (xb_ld(&(bar)[XB_TMO])) break; if (_sp > XB_SPIN_CAP) { atomicAdd(&(bar)[XB_TMO], 1u); break; } } } } while (0)

struct XcdBarrier { unsigned* bar; unsigned x; volatile LAS unsigned* st; };

__device__ __forceinline__ XcdBarrier xcd_barrier_post(unsigned* bar, volatile LAS unsigned* st) {
    XcdBarrier b; b.bar = bar; b.x = xb_xcc_id(); b.st = st;
    if (threadIdx.x == 0) (void)xb_add(&bar[XB_XCNT(b.x)], 1u);
    return b;
}
__device__ __forceinline__ void xcd_barrier_complete(unsigned* bar, unsigned x, unsigned& nloc, unsigned& nx) {
    const unsigned G = gridDim.x * gridDim.y * gridDim.z;
    unsigned sum, cnt, mine, sp = 0u;
    for (;;) {
        sum = 0u; cnt = 0u; mine = 0u;
#pragma unroll
        for (unsigned j = 0; j < 16; ++j) { const unsigned c = xb_ld(&bar[XB_XCNT(j)]); sum += c; cnt += (c > 0u) ? 1u : 0u; mine = (j == x) ? c : mine; }
        if (sum == G) break;
        __builtin_amdgcn_s_sleep(1);
        if ((++sp & 255u) == 0u) { if (xb_ld(&bar[XB_TMO])) break; if (sp > XB_SPIN_CAP) { atomicAdd(&bar[XB_TMO], 1u); break; } }
    }
    nloc = mine > 0u ? mine : 1u; nx = cnt > 0u ? cnt : 1u;
}
__device__ __forceinline__ void xcd_barrier(const XcdBarrier& b) {
    asm volatile("s_waitcnt vmcnt(0)" ::: "memory");
    __syncthreads();
    if (threadIdx.x == 0) {
        unsigned* bar = b.bar;
        __builtin_amdgcn_s_waitcnt(0);
        unsigned nloc = b.st[0], nx = b.st[1];
        if (nloc == 0u) { xcd_barrier_complete(bar, b.x, nloc, nx); b.st[0] = nloc; b.st[1] = nx; }
        const unsigned old = xb_add(&bar[XB_XSUB(b.x)], 1u);
        const unsigned gen = old / nloc;
        if (old + 1u == (gen + 1u) * nloc) {
            __builtin_amdgcn_fence(__ATOMIC_RELEASE, "agent");
            asm volatile("s_waitcnt vmcnt(0)" ::: "memory");
            const unsigned og = xb_add(&bar[XB_TOP], 1u);
            const unsigned tg = og / nx;
            if (og + 1u == (tg + 1u) * nx) xb_add(&bar[XB_TOPGEN], 1u);
            else XB_SPIN(xb_ld(&bar[XB_TOPGEN]) == tg, bar);
            __builtin_amdgcn_fence(__ATOMIC_ACQUIRE, "agent");
            xb_add(&bar[XB_XGEN(b.x)], 1u);
            asm volatile("s_waitcnt vmcnt(0)" ::: "memory");
        } else {
            XB_SPIN(xb_ld(&bar[XB_XGEN(b.x)]) == gen, bar);
            __builtin_amdgcn_fence(__ATOMIC_ACQUIRE, "agent");
            asm volatile("s_waitcnt vmcnt(0)" ::: "memory");
        }
    }
    __syncthreads();
}

__device__ __forceinline__ int t5_bucket(int d) {
    if (d < 16) return d;
    int b = 16;
    b += (d >= 22) + (d >= 30) + (d >= 40) + (d >= 54) + (d >= 73) + (d >= 99) + (d >= 134) + (d >= 182) + (d >= 246) + (d >= 332) + (d >= 450) + (d >= 609) + (d >= 825) + (d >= 1117) + (d >= 1513);
    return b;
}
struct Args { const float* in[30]; float* out; unsigned char* ws; int l_lo, l_hi, ph_lo, ph_hi, use_bar, pad; };

namespace pg8 {
struct EpiStoreBf16 {
    static constexpr bool PERM = true;
    bf16* O; int ldc;
    __device__ __forceinline__ void operator()(const f32x4 (&acc)[2][2][4][2], const Unit& u, int wr, int wc, int fr, int fq) const {
        const int row0 = u.pm * BM + wr * 64 + fr, col0 = u.pn * BM + wc * 32 + 8 * fq;
#pragma unroll
        for (int ai = 0; ai < 2; ++ai)
#pragma unroll
            for (int m = 0; m < 4; ++m) { bf16* rowp = O + (size_t)(row0 + ai * HALF + m * 16) * ldc + col0;
#pragma unroll
                for (int bj = 0; bj < 2; ++bj) { const f32x4 v0 = acc[ai][bj][m][0], v1 = acc[ai][bj][m][1];
                    u32x4 w; w.x = cvt_pk_bf16(v0[0], v0[1]); w.y = cvt_pk_bf16(v0[2], v0[3]); w.z = cvt_pk_bf16(v1[0], v1[1]); w.w = cvt_pk_bf16(v1[2], v1[3]);
                    *(u32x4*)(rowp + bj * HALF) = w; } }
    }
};
struct EpiGate {
    static constexpr bool PERM = false;
    const bf16* BR; bf16* MG;
    __device__ __forceinline__ void operator()(const f32x4 (&acc)[2][2][4][2], const Unit& u, int wr, int wc, int fr, int fq) const {
        const int row0 = u.pm * BM + wr * 64 + fr, j0 = u.pn * 64 + wc * 16 + 4 * fq;
#pragma unroll
        for (int ai = 0; ai < 2; ++ai)
#pragma unroll
            for (int m = 0; m < 4; ++m) { const size_t r = (size_t)(row0 + ai * HALF + m * 16);
                float mg0 = 0.f, mg1 = 0.f, mg2 = 0.f, mg3 = 0.f;
#pragma unroll
                for (int bj = 0; bj < 2; ++bj)
#pragma unroll
                    for (int n = 0; n < 2; ++n) { const int g = 2 * bj + n; const u32x2 b = *(const u32x2*)(BR + r * 4096 + g * 1024 + j0); const f32x4 a = acc[ai][bj][m][n];
                        mg0 += sigmoidf_(a[0]) * bflo(b.x); mg1 += sigmoidf_(a[1]) * bfhi(b.x); mg2 += sigmoidf_(a[2]) * bflo(b.y); mg3 += sigmoidf_(a[3]) * bfhi(b.y); }
                u32x2 w; w.x = cvt_pk_bf16(mg0, mg1); w.y = cvt_pk_bf16(mg2, mg3);
                *(u32x2*)(MG + r * 1024 + j0) = w; }
    }
};
struct EpiOut {
    static constexpr bool PERM = true;
    bf16* XB;
    __device__ __forceinline__ void operator()(const f32x4 (&acc)[2][2][4][2], const Unit& u, int wr, int wc, int fr, int fq) const {
        const int row0 = u.pm * BM + wr * 64 + fr, col0 = u.pn * BM + wc * 32 + 8 * fq;
#pragma unroll
        for (int ai = 0; ai < 2; ++ai)
#pragma unroll
            for (int m = 0; m < 4; ++m) { bf16* rowp = XB + (size_t)(row0 + ai * HALF + m * 16) * 1024 + col0;
#pragma unroll
                for (int bj = 0; bj < 2; ++bj) { const f32x4 v0 = acc[ai][bj][m][0], v1 = acc[ai][bj][m][1]; const u32x4 x = *(const u32x4*)(rowp + bj * HALF);
                    u32x4 w; w.x = cvt_pk_bf16(DN_ALPHA * bflo(x.x) + v0[0], DN_ALPHA * bfhi(x.x) + v0[1]); w.y = cvt_pk_bf16(DN_ALPHA * bflo(x.y) + v0[2], DN_ALPHA * bfhi(x.y) + v0[3]);
                    w.z = cvt_pk_bf16(DN_ALPHA * bflo(x.z) + v1[0], DN_ALPHA * bfhi(x.z) + v1[1]); w.w = cvt_pk_bf16(DN_ALPHA * bflo(x.w) + v1[2], DN_ALPHA * bfhi(x.w) + v1[3]);
                    *(u32x4*)(rowp + bj * HALF) = w; } }
    }
};
struct EpiUp {
    static constexpr bool PERM = true;
    const unsigned* rowinfo; bf16* H;
    __device__ __forceinline__ void operator()(const f32x4 (&acc)[2][2][4][2], const Unit& u, int wr, int wc, int fr, int fq) const {
        const int row0 = u.pm * BM + wr * 64 + fr, col0 = u.pn * 128 + wc * 32 + 8 * fq;
#pragma unroll
        for (int ai = 0; ai < 2; ++ai)
#pragma unroll
            for (int m = 0; m < 4; ++m) { const size_t r = (size_t)(row0 + ai * HALF + m * 16); const float w = __uint_as_float(rowinfo[2 * r + 1]);
                const f32x4 g0 = acc[ai][0][m][0], g1 = acc[ai][0][m][1], u0 = acc[ai][1][m][0], u1 = acc[ai][1][m][1];
                float h[8];
#pragma unroll
                for (int e = 0; e < 4; ++e) { h[e] = g0[e] * sigmoidf_(g0[e]) * u0[e] * w; h[4 + e] = g1[e] * sigmoidf_(g1[e]) * u1[e] * w; }
                u32x4 o; o.x = cvt_pk_bf16(h[0], h[1]); o.y = cvt_pk_bf16(h[2], h[3]); o.z = cvt_pk_bf16(h[4], h[5]); o.w = cvt_pk_bf16(h[6], h[7]);
                *(u32x4*)(H + r * 256 + col0) = o; }
    }
};
struct EpiDown {
    static constexpr bool PERM = true;
    const unsigned* rowinfo; bf16* Y;
    __device__ __forceinline__ void operator()(const f32x4 (&acc)[2][2][4][2], const Unit& u, int wr, int wc, int fr, int fq) const {
        const int row0 = u.pm * BM + wr * 64 + fr, col0 = u.pn * BM + wc * 32 + 8 * fq;
#pragma unroll
        for (int ai = 0; ai < 2; ++ai)
#pragma unroll
            for (int m = 0; m < 4; ++m) { const size_t r = (size_t)(row0 + ai * HALF + m * 16); const int ri = (int)rowinfo[2 * r];
                if (ri >= 0) { bf16* rowp = Y + ((size_t)(ri & 1) * NTOK + (size_t)(ri >> 1)) * 1024 + col0;
#pragma unroll
                    for (int bj = 0; bj < 2; ++bj) { const f32x4 v0 = acc[ai][bj][m][0], v1 = acc[ai][bj][m][1];
                        u32x4 w; w.x = cvt_pk_bf16(v0[0], v0[1]); w.y = cvt_pk_bf16(v0[2], v0[3]); w.z = cvt_pk_bf16(v1[0], v1[1]); w.w = cvt_pk_bf16(v1[2], v1[3]);
                        *(u32x4*)(rowp + bj * HALF) = w; } } }
    }
};
}

struct RowMap { int kind, base, g, off;
    __device__ __forceinline__ int operator()(int n) const {
        if (kind == 0) return base + n;
        if (kind == 1) { const int j = base + n, jj = j & 63, pn = j >> 6; return 3072 + pn * 256 + 128 * (g >> 1) + 32 * (jj >> 4) + 16 * (g & 1) + 4 * ((jj >> 2) & 3) + (jj & 3); }
        const int h = base + n; return (h >> 7) * 256 + off + (h & 127);
    }
};
__device__ __forceinline__ void transpose_item(const float* W, int ldw, int k0, int scol0, int nvalid, bf16* WT, int ldk, const RowMap& rm, LAS float* scr, int lane) {
    const int nn = lane & 31;
#pragma unroll 8
    for (int i = 0; i < 32; ++i) { const int kk = 2 * i + (lane >> 5); scr[kk * 33 + nn] = (nn < nvalid) ? W[(size_t)(k0 + kk) * ldw + scol0 + nn] : 0.f; }
    LDS_WAIT(); asm volatile("" ::: "memory");
    const int c = lane & 7;
#pragma unroll
    for (int j = 0; j < 4; ++j) { const int n = (lane >> 3) + 8 * j; const LAS float* s = scr + (8 * c) * 33 + n;
        u32x4 o; o.x = pk2(s[0 * 33], s[1 * 33]); o.y = pk2(s[2 * 33], s[3 * 33]); o.z = pk2(s[4 * 33], s[5 * 33]); o.w = pk2(s[6 * 33], s[7 * 33]);
        *(u32x4*)(WT + (size_t)rm(n) * ldk + k0 + 8 * c) = o; }
    LDS_WAIT(); asm volatile("" ::: "memory");
}
__device__ __forceinline__ void p0_prologue(const Args& a, LAS unsigned char* lds, int gw, int NGW, int wave, int lane) {
    LAS float* scr = (LAS float*)(lds + wave * 16384);
    constexpr int IPL = 16896;
    for (int it = gw; it < NLAYER * IPL; it += NGW) {
        const int l = it / IPL; int r = it - l * IPL;
        unsigned char* wl = a.ws + WS_W + (size_t)l * WL_SIZE;
        RowMap rm; rm.kind = 0; rm.base = 0; rm.g = 0; rm.off = 0;
        if (r < 1536) { const int nt = r % 96, kt = r / 96, n0 = 32 * nt; int nv = 3000 - n0; nv = nv < 0 ? 0 : (nv > 32 ? 32 : nv); rm.base = n0;
            transpose_item(a.in[2] + (size_t)l * 1024 * IN_W, IN_W, 64 * kt, n0, nv, (bf16*)(wl + WL_IN), 1024, rm, scr, lane); continue; }
        r -= 1536;
        if (r < 2048) { const int nt = r % 128, kt = r / 128, gc0 = 32 * nt; rm.kind = 1; rm.g = gc0 >> 10; rm.base = gc0 & 1023;
            transpose_item(a.in[2] + (size_t)l * 1024 * IN_W, IN_W, 64 * kt, 3000 + gc0, 32, (bf16*)(wl + WL_IN), 1024, rm, scr, lane); continue; }
        r -= 2048;
        if (r < 512) { const int nb = r / 128, rr = r % 128, nt = rr % 32, kt = rr / 32; rm.base = nb * 1024 + 32 * nt;
            if (nb != 1) transpose_item(a.in[19] + (size_t)(l * 4 + nb) * 256 * 1024, 1024, 64 * kt, 32 * nt, 32, (bf16*)(wl + WL_BR), 256, rm, scr, lane); continue; }
        r -= 512;
        if (r < 512) { const int nt = r % 32, kt = r / 32; rm.base = 32 * nt;
            transpose_item(a.in[20] + (size_t)l * 1024 * 1024, 1024, 64 * kt, 32 * nt, 32, (bf16*)(wl + WL_OUT), 1024, rm, scr, lane); continue; }
        r -= 512;
        if (r < 8192) { const int up = r >= 4096; if (up) r -= 4096; const int e = r / 128, rr = r % 128, nt = rr % 8, kt = rr / 8; rm.kind = 2; rm.base = 32 * nt; rm.off = up ? 128 : 0;
            transpose_item(a.in[up ? 28 : 27] + (size_t)(l * 32 + e) * 1024 * 256, 256, 64 * kt, 32 * nt, 32, (bf16*)(wl + WL_GU) + (size_t)e * 512 * 1024, 1024, rm, scr, lane); continue; }
        r -= 8192;
        { const int e = r / 128, rr = r % 128, nt = rr % 32, kt = rr / 32; rm.base = 32 * nt;
            transpose_item(a.in[29] + (size_t)(l * 32 + e) * 256 * 1024, 1024, 64 * kt, 32 * nt, 32, (bf16*)(wl + WL_DN) + (size_t)e * 1024 * 256, 256, rm, scr, lane); }
    }
    { float* WRT = (float*)(a.ws + WS_RT); const int gt = gw * 64 + lane, NT = NGW * 64;
      for (int i = gt; i < NLAYER * 4 * 64 * 1024; i += NT) { const int j = i & 1023, c = (i >> 10) & 63, h = (i >> 16) & 3, l = i >> 18;
          const float* wu = a.in[4] + ((size_t)(l * 4 + h) * 64 + c) * 64; const float* wb = a.in[19] + ((size_t)(l * 4 + 1) * 256 + h * 64) * 1024 + j; float acc = 0.f;
#pragma unroll 8
          for (int d = 0; d < 64; ++d) acc += wu[d] * wb[(size_t)d * 1024];
          ((bf16*)(a.ws + WS_W + (size_t)l * WL_SIZE + WL_BR))[(size_t)(1024 + j) * 256 + h * 64 + c] = (bf16)f2bf(acc); }
      for (int i = gt; i < NLAYER * 36 * 1024; i += NT) { const int k = i & 1023, e = (i >> 10) % 36, l = i / (36 * 1024);
          WRT[i] = e < 4 ? a.in[23][((size_t)l * 1024 + k) * 4 + e] : a.in[25][((size_t)l * 1024 + k) * 32 + (e - 4)]; }
      const f32x4* xs = (const f32x4*)a.in[0]; u32x4* xd = (u32x4*)(a.ws + WS_XB);
      for (int i = gt; i < NTOK * DM / 8; i += NT) { const f32x4 v0 = xs[2 * i], v1 = xs[2 * i + 1]; u32x4 o; o.x = pk2(v0[0], v0[1]); o.y = pk2(v0[2], v0[3]); o.z = pk2(v1[0], v1[1]); o.w = pk2(v1[2], v1[3]); xd[i] = o; } }
}

__device__ __forceinline__ float softplusf_(float x) { return fmaxf(x, 0.f) + log1pf(__expf(-fabsf(x))); }
__device__ __forceinline__ void prep_phase(const Args& a, int l, LAS unsigned char* lds, int tid, int gw, int NGW, int lane) {
    const bf16* P = (const bf16*)(a.ws + WS_BIG);
    bf16* CKVN = (bf16*)(a.ws + WS_CKVN); float* CA = (float*)(a.ws + WS_CA); float* BON = (float*)(a.ws + WS_BON);
    bf16* DR = (bf16*)((unsigned char*)a.out + DO_DR); bf16* DKP = (bf16*)((unsigned char*)a.out + DO_DKP); bf16* DV = (bf16*)((unsigned char*)a.out + DO_DV); bf16* DKK = (bf16*)((unsigned char*)a.out + DO_DKK);
    float* DW = (float*)(a.ws + WS_BIG + BIG_DW); bf16* DAI = (bf16*)(a.ws + WS_BIG + BIG_DAI); bf16* DG = (bf16*)(a.ws + WS_BIG + BIG_DG);
    const float* kvg = a.in[3] + l * 64; const float* aup = a.in[5] + l * 16 * 128; const float* abias = a.in[6] + l * 128;
    const float* mu = a.in[8] + l * 832; const float* w0 = a.in[9] + l * 256; const float* w2 = a.in[10] + l * 16 * 256; const float* a0 = a.in[11] + l * 256;
    const float* a2 = a.in[12] + l * 16 * 256; const float* g2 = a.in[13] + l * 32 * 256; const float* kkw = a.in[14] + l * 256; const float* kaw = a.in[15] + l * 256; const float* rkw = a.in[16] + l * 256;
    LAS float* sW2 = (LAS float*)lds; LAS float* sA2 = (LAS float*)(lds + 16384); LAS float* sG2 = (LAS float*)(lds + 32768); LAS float* sUP = (LAS float*)(lds + 65536);
    for (int i = tid; i < 4096; i += NTHR) { sW2[i] = w2[i]; sA2[i] = a2[i]; }
    for (int i = tid; i < 8192; i += NTHR) sG2[i] = g2[i];
    for (int i = tid; i < 2048; i += NTHR) sUP[i] = aup[i];
    __syncthreads();
    float mu_r[13], w0_r[4], a0_r[4], kk_r[4], ka_r[4], rk_r[4];
#pragma unroll
    for (int i = 0; i < 13; ++i) mu_r[i] = mu[64 * i + lane];
#pragma unroll
    for (int i = 0; i < 4; ++i) { const int c = 64 * i + lane; w0_r[i] = w0[c]; a0_r[i] = a0[c]; kk_r[i] = kkw[c]; ka_r[i] = kaw[c]; rk_r[i] = rkw[c]; }
    const float kvg_r = kvg[lane], ab0 = abias[lane], ab1 = abias[64 + lane];
    for (int m = gw; m < NTOK; m += NGW) {
        const bf16* prow = P + (size_t)m * PW; const int t = m & (SEQ - 1);
        { const float x = bf2f(prow[PC_CKV + lane]); const float ss = wave_sum(x * x); const float rn = rsqrtf(ss * (1.f / 64.f) + 1e-6f); CKVN[(size_t)m * 64 + lane] = (bf16)f2bf(x * rn * kvg_r); }
        { const float cav = (lane < 16) ? bf2f(prow[PC_CA + lane]) : 0.f; float z0 = ab0, z1 = ab1;
#pragma unroll
          for (int i = 0; i < 16; ++i) { const float cv = __shfl(cav, i); z0 += cv * sUP[i * 128 + lane]; z1 += cv * sUP[i * 128 + 64 + lane]; }
          CA[(size_t)m * 128 + lane] = __expf(log_sigmoidf_(z0) * (1.f / 16.f)); CA[(size_t)m * 128 + 64 + lane] = __expf(log_sigmoidf_(z1) * (1.f / 16.f)); }
        float xs[13];
#pragma unroll
        for (int i = 0; i < 13; ++i) { const int c = 64 * i + lane; const float cur = bf2f(prow[PC_D + c]); const float prev = (t > 0) ? bf2f(prow[PC_D + c - PW]) : 0.f; xs[i] = cur + (prev - cur) * mu_r[i]; }
        const float low = xs[12], tw = tanhf(low), sg = sigmoidf_(low);
        float wr_[4], ar_[4], gv_[4];
#pragma unroll
        for (int i = 0; i < 4; ++i) { wr_[i] = w0_r[i]; ar_[i] = a0_r[i]; gv_[i] = 0.f; }
#pragma unroll 4
        for (int j = 0; j < 16; ++j) { const float tj = __shfl(tw, j), aj = __shfl(low, 16 + j);
#pragma unroll
            for (int i = 0; i < 4; ++i) { wr_[i] += tj * sW2[j * 256 + 64 * i + lane]; ar_[i] += aj * sA2[j * 256 + 64 * i + lane]; } }
#pragma unroll 4
        for (int j = 0; j < 32; ++j) { const float sj = __shfl(sg, 32 + j);
#pragma unroll
            for (int i = 0; i < 4; ++i) gv_[i] += sj * sG2[j * 256 + 64 * i + lane]; }
#pragma unroll
        for (int i = 0; i < 4; ++i) { const int c = 64 * i + lane;
            const float w_raw = -softplusf_(-wr_[i]) - 0.5f, wdec = __expf(-__expf(w_raw));
            const float av = sigmoidf_(ar_[i]);
            const float kx = xs[4 + i]; float kkv = kx * kk_r[i]; const float nrm = sqrtf(wave_sum(kkv * kkv)); kkv = kkv / fmaxf(nrm, 1e-12f);
            const float kp = kx * (1.f + (av - 1.f) * ka_r[i]);
            const float rx = xs[i], vx = xs[8 + i];
            const float bon = wave_sum(rx * kp * rk_r[i]);
            const size_t o = (size_t)m * 256 + c;
            DR[o] = (bf16)f2bf(rx); DKP[o] = (bf16)f2bf(kp); DV[o] = (bf16)f2bf(vx); DKK[o] = (bf16)f2bf(kkv); DW[o] = wdec; DAI[o] = (bf16)f2bf(av); DG[o] = (bf16)f2bf(gv_[i]);
            if (lane == 0) BON[(size_t)m * 4 + i] = bon; }
    }
    __syncthreads();
}

__device__ __forceinline__ void dscan_item(const Args& a, int l, int bh, LAS unsigned char* lds, int tid) {
    const int b = bh >> 2, h = bh & 3, wv = tid >> 6, lane = tid & 63, row = wv * 8 + (lane >> 3), part = lane & 7;
    LAS bf16* sKK = (LAS bf16*)(lds); LAS bf16* sAI = (LAS bf16*)(lds + 8192); LAS bf16* sKP = (LAS bf16*)(lds + 16384); LAS bf16* sR = (LAS bf16*)(lds + 24576); LAS bf16* sV = (LAS bf16*)(lds + 32768);
    LAS float* sW = (LAS float*)(lds + 40960); LAS float* sY = (LAS float*)(lds + 57344);
    const bf16* DR = (const bf16*)((unsigned char*)a.out + DO_DR); const bf16* DKP = (const bf16*)((unsigned char*)a.out + DO_DKP); const bf16* DV = (const bf16*)((unsigned char*)a.out + DO_DV); const bf16* DKK = (const bf16*)((unsigned char*)a.out + DO_DKK);
    const float* DW = (const float*)(a.ws + WS_BIG + BIG_DW); const bf16* DAI = (const bf16*)(a.ws + WS_BIG + BIG_DAI); const bf16* DG = (const bf16*)(a.ws + WS_BIG + BIG_DG);
    const float* BON = (const float*)(a.ws + WS_BON); bf16* YS = (bf16*)((unsigned char*)a.out + DO_YS);
    const float* gnw = a.in[17] + l * 256 + h * 64; const float* gnb = a.in[18] + l * 256 + h * 64;
    const int ls = tid >> 3, lseg = tid & 7;
    const size_t gbase = ((size_t)b * SEQ) * 256 + h * 64 + 8 * lseg;
    float S[8];
#pragma unroll
    for (int j = 0; j < 8; ++j) S[j] = 0.f;
    u32x4 rKK, rAI, rKP, rR, rV; f32x4 rW0, rW1;
#define DS_LOAD(ch) do { const size_t gi = gbase + (size_t)((ch) * 64 + ls) * 256; rKK = *(const u32x4*)(DKK + gi); rAI = *(const u32x4*)(DAI + gi); rKP = *(const u32x4*)(DKP + gi); \
        rR = *(const u32x4*)(DR + gi); rV = *(const u32x4*)(DV + gi); rW0 = *(const f32x4*)(DW + gi); rW1 = *(const f32x4*)(DW + gi + 4); } while (0)
#define DS_STORE() do { const int li = ls * 64 + 8 * lseg; *(LAS u32x4*)(sKK + li) = rKK; *(LAS u32x4*)(sAI + li) = rAI; *(LAS u32x4*)(sKP + li) = rKP; *(LAS u32x4*)(sR + li) = rR; *(LAS u32x4*)(sV + li) = rV; \
        *(LAS f32x4*)(sW + li) = rW0; *(LAS f32x4*)(sW + li + 4) = rW1; } while (0)
    DS_LOAD(0); DS_STORE(); __syncthreads();
    for (int ch = 0; ch < SEQ / 64; ++ch) {
        if (ch + 1 < SEQ / 64) DS_LOAD(ch + 1);
#pragma unroll 2
        for (int s = 0; s < 64; ++s) {
            const int li = s * 64 + 8 * part;
            const u32x4 kk4 = *(const LAS u32x4*)(sKK + li), ai4 = *(const LAS u32x4*)(sAI + li), kp4 = *(const LAS u32x4*)(sKP + li), r4 = *(const LAS u32x4*)(sR + li);
            const f32x4 w0 = *(const LAS f32x4*)(sW + li), w1 = *(const LAS f32x4*)(sW + li + 4);
            const float vrow = bf2f(sV[s * 64 + row]);
            const float kk[8] = {bflo(kk4.x), bfhi(kk4.x), bflo(kk4.y), bfhi(kk4.y), bflo(kk4.z), bfhi(kk4.z), bflo(kk4.w), bfhi(kk4.w)};
            const float ai[8] = {bflo(ai4.x), bfhi(ai4.x), bflo(ai4.y), bfhi(ai4.y), bflo(ai4.z), bfhi(ai4.z), bflo(ai4.w), bfhi(ai4.w)};
            const float kp[8] = {bflo(kp4.x), bfhi(kp4.x), bflo(kp4.y), bfhi(kp4.y), bflo(kp4.z), bfhi(kp4.z), bflo(kp4.w), bfhi(kp4.w)};
            const float rr[8] = {bflo(r4.x), bfhi(r4.x), bflo(r4.y), bfhi(r4.y), bflo(r4.z), bfhi(r4.z), bflo(r4.w), bfhi(r4.w)};
            const float ww[8] = {w0[0], w0[1], w0[2], w0[3], w1[0], w1[1], w1[2], w1[3]};
            float sa = 0.f;
#pragma unroll
            for (int j = 0; j < 8; ++j) sa += S[j] * kk[j];
            sa = -sum8(sa);
            float y = 0.f;
#pragma unroll
            for (int j = 0; j < 8; ++j) { S[j] = S[j] * ww[j] + sa * (kk[j] * ai[j]) + vrow * kp[j]; y += S[j] * rr[j]; }
            y = sum8(y);
            if (part == 0) sY[s * 64 + row] = y;
        }
        __syncthreads();
        {
            const int li = ls * 64 + 8 * lseg; const f32x4 y0 = *(const LAS f32x4*)(sY + li), y1 = *(const LAS f32x4*)(sY + li + 4); const u32x4 v4 = *(const LAS u32x4*)(sV + li);
            const float yv[8] = {y0[0], y0[1], y0[2], y0[3], y1[0], y1[1], y1[2], y1[3]};
            const float vv[8] = {bflo(v4.x), bfhi(v4.x), bflo(v4.y), bfhi(v4.y), bflo(v4.z), bfhi(v4.z), bflo(v4.w), bfhi(v4.w)};
            float sm = 0.f;
#pragma unroll
            for (int j = 0; j < 8; ++j) sm += yv[j];
            const float mean = sum8(sm) * (1.f / 64.f); float sq = 0.f;
#pragma unroll
            for (int j = 0; j < 8; ++j) { const float d = yv[j] - mean; sq += d * d; }
            const float rstd = rsqrtf(sum8(sq) * (1.f / 64.f) + 64e-5f);
            const size_t m = (size_t)b * SEQ + ch * 64 + ls; const float bon = BON[m * 4 + h];
            const u32x4 g4 = *(const u32x4*)(DG + m * 256 + h * 64 + 8 * lseg);
            const float gg[8] = {bflo(g4.x), bfhi(g4.x), bflo(g4.y), bfhi(g4.y), bflo(g4.z), bfhi(g4.z), bflo(g4.w), bfhi(g4.w)};
            float o[8];
#pragma unroll
            for (int j = 0; j < 8; ++j) o[j] = ((yv[j] - mean) * rstd * gnw[8 * lseg + j] + gnb[8 * lseg + j] + bon * vv[j]) * gg[j];
            u32x4 w; w.x = pk2(o[0], o[1]); w.y = pk2(o[2], o[3]); w.z = pk2(o[4], o[5]); w.w = pk2(o[6], o[7]);
            *(u32x4*)(YS + m * 1024 + 768 + h * 64 + 8 * lseg) = w;
        }
        __syncthreads();
        if (ch + 1 < SEQ / 64) DS_STORE();
        __syncthreads();
    }
#undef DS_LOAD
#undef DS_STORE
}
__device__ __forceinline__ void cscan_item(const Args& a, int l, int bh, LAS unsigned char* lds, int tid) {
    const int b = bh >> 2, h = bh & 3, wv = tid >> 6, lane = tid & 63, row = wv * 8 + (lane >> 3), part = lane & 7;
    LAS bf16* sQ = (LAS bf16*)(lds); LAS bf16* sK = (LAS bf16*)(lds + 4096); LAS bf16* sV = (LAS bf16*)(lds + 8192); LAS float* sA = (LAS float*)(lds + 16384); LAS float* sY = (LAS float*)(lds + 24576);
    const bf16* P = (const bf16*)(a.ws + WS_BIG); const float* CA = (const float*)(a.ws + WS_CA); bf16* YS = (bf16*)((unsigned char*)a.out + DO_YS);
    const float* ng = a.in[7] + l * 256 + h * 64;
    const int ls = tid >> 3, lseg = tid & 7;
    const size_t tok0 = (size_t)b * SEQ;
    float S[4] = {0.f, 0.f, 0.f, 0.f};
    u32x4 rQK, rV; f32x4 rA;
    const int qs = (tid & 255) >> 2, qseg = tid & 3, isk = tid >> 8;
#define CS_LOAD(ch) do { const size_t tq = tok0 + (ch) * 64 + qs; rQK = *(const u32x4*)(P + tq * PW + (isk ? PC_CK : PC_CQ) + h * 32 + 8 * qseg); \
        const size_t tv = tok0 + (ch) * 64 + ls; rV = *(const u32x4*)(P + tv * PW + PC_CV + h * 64 + 8 * lseg); rA = *(const f32x4*)(CA + tv * 128 + h * 32 + 4 * lseg); } while (0)
#define CS_STORE() do { *(LAS u32x4*)((isk ? sK : sQ) + qs * 32 + 8 * qseg) = rQK; *(LAS u32x4*)(sV + ls * 64 + 8 * lseg) = rV; *(LAS f32x4*)(sA + ls * 32 + 4 * lseg) = rA; } while (0)
    CS_LOAD(0); CS_STORE(); __syncthreads();
    for (int ch = 0; ch < SEQ / 64; ++ch) {
        if (ch + 1 < SEQ / 64) CS_LOAD(ch + 1);
#pragma unroll 2
        for (int s = 0; s < 64; ++s) {
            const u32x2 q2 = *(const LAS u32x2*)(sQ + s * 32 + 4 * part), k2 = *(const LAS u32x2*)(sK + s * 32 + 4 * part); const f32x4 a4 = *(const LAS f32x4*)(sA + s * 32 + 4 * part);
            const float vrow = bf2f(sV[s * 64 + row]);
            const float qq[4] = {bflo(q2.x), bfhi(q2.x), bflo(q2.y), bfhi(q2.y)}; const float kk[4] = {bflo(k2.x), bfhi(k2.x), bflo(k2.y), bfhi(k2.y)};
            float o = 0.f;
#pragma unroll
            for (int j = 0; j < 4; ++j) { S[j] = a4[j] * S[j] + kk[j] * vrow; o += qq[j] * S[j]; }
            o = sum8(o) * 0.17677669529663687f;
            if (part == 0) sY[s * 64 + row] = o;
        }
        __syncthreads();
        { const int li = ls * 64 + 8 * lseg; const f32x4 y0 = *(const LAS f32x4*)(sY + li), y1 = *(const LAS f32x4*)(sY + li + 4);
            const float yv[8] = {y0[0], y0[1], y0[2], y0[3], y1[0], y1[1], y1[2], y1[3]};
            float sq = 0.f;
#pragma unroll
            for (int j = 0; j < 8; ++j) sq += yv[j] * yv[j];
            const float rn = rsqrtf(sum8(sq) * (1.f / 64.f) + 1e-6f);
            const size_t m = tok0 + ch * 64 + ls; const u32x4 g4 = *(const u32x4*)(P + m * PW + PC_CG + h * 64 + 8 * lseg);
            const float gg[8] = {bflo(g4.x), bfhi(g4.x), bflo(g4.y), bfhi(g4.y), bflo(g4.z), bfhi(g4.z), bflo(g4.w), bfhi(g4.w)};
            float o[8];
#pragma unroll
            for (int j = 0; j < 8; ++j) o[j] = gg[j] * sigmoidf_(gg[j]) * (yv[j] * rn * ng[8 * lseg + j]);
            u32x4 w; w.x = pk2(o[0], o[1]); w.y = pk2(o[2], o[3]); w.z = pk2(o[4], o[5]); w.w = pk2(o[6], o[7]);
            *(u32x4*)(YS + m * 1024 + 512 + h * 64 + 8 * lseg) = w; }
        __syncthreads();
        if (ch + 1 < SEQ / 64) CS_STORE();
        __syncthreads();
    }
#undef CS_LOAD
#undef CS_STORE
}
__device__ __forceinline__ void mixA_item(const Args& a, int m, LAS unsigned char* lds, int lane_in) {
    int lane = lane_in; asm volatile("" : "+v"(lane));
    const bf16* P = (const bf16*)(a.ws + WS_BIG); bf16* YS = (bf16*)((unsigned char*)a.out + DO_YS);
    const LAS unsigned char* bkt = lds + BKT_OFF; const LAS float* rpb = (const LAS float*)(lds + RPB_OFF);
    const int t = m & (SEQ - 1); const size_t rowb = (size_t)(m - t); const int hh = lane & 3;
    float q[64];
    { const u32x4* qp = (const u32x4*)(P + (size_t)m * PW + PC_AQ + hh * 64);
#pragma unroll
      for (int i = 0; i < 8; ++i) { const u32x4 w = qp[i]; q[8 * i + 0] = bflo(w.x) * 0.125f; q[8 * i + 1] = bfhi(w.x) * 0.125f; q[8 * i + 2] = bflo(w.y) * 0.125f; q[8 * i + 3] = bfhi(w.y) * 0.125f;
          q[8 * i + 4] = bflo(w.z) * 0.125f; q[8 * i + 5] = bfhi(w.z) * 0.125f; q[8 * i + 6] = bflo(w.w) * 0.125f; q[8 * i + 7] = bfhi(w.w) * 0.125f; } }
    float sc[25]; float mx = -INFINITY;
#pragma unroll
    for (int i = 0; i < 25; ++i) { const int e = (lane >> 2) + 16 * i; const int p = (e >= 258) ? 2 : (e >= 129 ? 1 : 0); const int j = e - 129 * p; const int s = t - (j << (2 * p));
        float v = -INFINITY;
        if (e < 387 && s >= 0) { const u32x4* kp = (const u32x4*)(P + (rowb + s) * PW + PC_AK + hh * 64); float d = 0.f;
#pragma unroll
            for (int c = 0; c < 8; ++c) { const u32x4 w = kp[c]; d += q[8 * c] * bflo(w.x) + q[8 * c + 1] * bfhi(w.x) + q[8 * c + 2] * bflo(w.y) + q[8 * c + 3] * bfhi(w.y) + q[8 * c + 4] * bflo(w.z) + q[8 * c + 5] * bfhi(w.z) + q[8 * c + 6] * bflo(w.w) + q[8 * c + 7] * bfhi(w.w); }
            v = d + rpb[bkt[t - s] * 8 + hh]; }
        sc[i] = v; mx = fmaxf(mx, v); }
    mx = fmaxf(mx, __shfl_xor(mx, 4)); mx = fmaxf(mx, __shfl_xor(mx, 8)); mx = fmaxf(mx, __shfl_xor(mx, 16)); mx = fmaxf(mx, __shfl_xor(mx, 32));
    float den = 0.f;
#pragma unroll
    for (int i = 0; i < 25; ++i) { sc[i] = __expf(sc[i] - mx); den += sc[i]; }
    den += __shfl_xor(den, 4); den += __shfl_xor(den, 8); den += __shfl_xor(den, 16); den += __shfl_xor(den, 32);
    const int h2 = lane >> 4, cq = lane & 15;
    float acc0 = 0.f, acc1 = 0.f, acc2 = 0.f, acc3 = 0.f;
#pragma unroll
    for (int i = 0; i < 25; ++i) {
#pragma unroll 1
        for (int el = 0; el < 16; ++el) { const int e = 16 * i + el; const int p = (e >= 258) ? 2 : (e >= 129 ? 1 : 0); const int j = e - 129 * p; const int s = t - (j << (2 * p));
            if (e < 387 && s >= 0) { const float pe = __shfl(sc[i], 4 * el + h2); const u32x2 w = *(const u32x2*)(P + (rowb + s) * PW + PC_AV + h2 * 64 + 4 * cq);
                acc0 += pe * bflo(w.x); acc1 += pe * bfhi(w.x); acc2 += pe * bflo(w.y); acc3 += pe * bfhi(w.y); } } }
    const float rd = 1.f / __shfl(den, h2);
    u32x2 o; o.x = pk2(acc0 * rd, acc1 * rd); o.y = pk2(acc2 * rd, acc3 * rd);
    *(u32x2*)(YS + (size_t)m * 1024 + h2 * 64 + 4 * cq) = o;
}
typedef float f32x16 __attribute__((ext_vector_type(16)));
typedef short s16x4 __attribute__((ext_vector_type(4)));
typedef short v4i16_t __attribute__((ext_vector_type(4)));
typedef float f32x2_t __attribute__((ext_vector_type(2))); typedef __bf16 bf16x2_t __attribute__((ext_vector_type(2)));
__device__ __forceinline__ unsigned cvtpk_s(float lo, float hi) { f32x2_t v = {lo, hi}; bf16x2_t b = __builtin_convertvector(v, bf16x2_t); return __builtin_bit_cast(unsigned, b); }
__device__ __forceinline__ s16x4 vtr(const LAS unsigned char* p) { return __builtin_bit_cast(s16x4, __builtin_amdgcn_ds_read_tr16_b64_v4i16((LAS v4i16_t*)p)); }
constexpr int ATB_OFF = 102400;
constexpr int AVI_OFF = 3584;
constexpr float LOG2E = 1.4426950408889634f;
__device__ __forceinline__ void mixA_tables(const Args& a, LAS unsigned char* lds, int tid) {
    LAS float* tb = (LAS float*)(lds + ATB_OFF);
    for (int i = tid; i < 3 * 4 * 192; i += NTHR) { const int e = i % 192, h = (i / 192) & 3, f = i / 768; const int dist = 159 - e; const int dl = f == 0 ? 16 : (f == 1 ? 4 : 1);
        float v = -INFINITY;
        if (dist >= 0 && dist <= 128) { int dd = dist * dl; dd = dd > 2047 ? 2047 : dd; v = a.in[1][t5_bucket(dd) * 8 + h] * LOG2E; }
        tb[i] = v; }
}
__device__ __forceinline__ void mixA_task(const Args& a, int task, LAS unsigned char* lds, int wave, int lane_in) {
    int lane = lane_in; asm volatile("" : "+v"(lane));
    const bf16* P = (const bf16*)(a.ws + WS_BIG); bf16* YS = (bf16*)((unsigned char*)a.out + DO_YS);
    const int cc = 3 - (task & 3), r = (task >> 2) & 15, h = (task >> 6) & 3, b = task >> 8;
    const int ql = lane & 31, hh = lane >> 5, n0 = 32 * cc;
    const size_t rowb = (size_t)b * SEQ; const int tq = 16 * (n0 + ql) + r;
    const LAS float* tball = (const LAS float*)(lds + ATB_OFF) + h * 192;
    LAS unsigned char* vimg = lds + AVI_OFF + wave * 12800;
    bf16x8 qf[4];
    { const bf16* qp = P + (rowb + tq) * PW + PC_AQ + h * 64 + 8 * hh;
#pragma unroll
      for (int ks = 0; ks < 4; ++ks) qf[ks] = *(const bf16x8*)(qp + 16 * ks); }
    f32x16 o0, o1;
#pragma unroll
    for (int i = 0; i < 16; ++i) { o0[i] = 0.f; o1[i] = 0.f; }
    float m = -INFINITY, lsum = 0.f;
    const float SC = 0.125f * LOG2E;
    const int vst = (lane >> 1) * 144 + (lane & 1) * 64;
    const int i16 = lane & 15, tq4 = i16 >> 2, tp = i16 & 3, g16 = (lane >> 4) & 1;
    const int vrd = (4 * hh + tq4) * 144 + 32 * g16 + 8 * tp;
#pragma unroll 1
    for (int f = 0; f < 3; ++f) {
        const int dsh = f == 0 ? 4 : (f == 1 ? 2 : 0);
        const int rho = r & ((1 << dsh) - 1);
        const int qpos = (tq - rho) >> dsh;
        const int qmin = (16 * n0 + r - rho) >> dsh, qmax = (16 * (n0 + 31) + r - rho) >> dsh;
        int klo = qmin - 128; klo = klo < 0 ? 0 : klo; klo &= ~31;
        const LAS float* tbf = tball + f * 768;
#pragma unroll 1
        for (int k0 = qmax & ~31; k0 >= klo; k0 -= 32) {
            const size_t tk = rowb + (((size_t)(k0 + ql)) << dsh) + rho;
            const bf16* kp = P + tk * PW + PC_AK + h * 64 + 8 * hh;
            bf16x8 kf[4];
#pragma unroll
            for (int ks = 0; ks < 4; ++ks) kf[ks] = *(const bf16x8*)(kp + 16 * ks);
            const size_t tv = rowb + (((size_t)(k0 + (lane >> 1))) << dsh) + rho;
            const u32x4* vp = (const u32x4*)(P + tv * PW + PC_AV + h * 64 + 32 * (lane & 1));
            const u32x4 v0 = vp[0], v1 = vp[1], v2 = vp[2], v3 = vp[3];
            f32x16 st;
#pragma unroll
            for (int i = 0; i < 16; ++i) st[i] = 0.f;
#pragma unroll
            for (int ks = 0; ks < 4; ++ks) st = __builtin_amdgcn_mfma_f32_32x32x16_bf16(kf[ks], qf[ks], st, 0, 0, 0);
            *(LAS u32x4*)(vimg + vst) = v0; *(LAS u32x4*)(vimg + vst + 16) = v1; *(LAS u32x4*)(vimg + vst + 32) = v2; *(LAS u32x4*)(vimg + vst + 48) = v3;
            const int D0 = qpos - k0 - 4 * hh; const int e0 = (D0 >= 0 && D0 <= 159) ? 159 - D0 : 0;
            const LAS float* tp_ = tbf + e0;
            float mx = -INFINITY;
#pragma unroll
            for (int i = 0; i < 16; ++i) { st[i] = st[i] * SC + tp_[(i & 3) + 8 * (i >> 2)]; mx = fmaxf(mx, st[i]); }
            mx = fmaxf(mx, __shfl_xor(mx, 32));
            const float mn = fmaxf(m, mx), alpha = __builtin_amdgcn_exp2f(m - mn);
            m = mn; float ps = 0.f;
#pragma unroll
            for (int i = 0; i < 16; ++i) { st[i] = __builtin_amdgcn_exp2f(st[i] - mn); ps += st[i]; }
            lsum = lsum * alpha + ps;
#pragma unroll
            for (int i = 0; i < 16; ++i) { o0[i] *= alpha; o1[i] *= alpha; }
            bf16x8 pf[2];
#pragma unroll
            for (int s = 0; s < 2; ++s) { u32x4 w; w.x = cvtpk_s(st[8 * s], st[8 * s + 1]); w.y = cvtpk_s(st[8 * s + 2], st[8 * s + 3]); w.z = cvtpk_s(st[8 * s + 4], st[8 * s + 5]); w.w = cvtpk_s(st[8 * s + 6], st[8 * s + 7]); pf[s] = __builtin_bit_cast(bf16x8, w); }
            asm volatile("s_waitcnt lgkmcnt(0)" ::: "memory");
#pragma unroll
            for (int s = 0; s < 2; ++s) {
                const s16x4 a00 = vtr(vimg + vrd + (16 * s) * 144), a01 = vtr(vimg + vrd + (16 * s + 8) * 144);
                const s16x4 a10 = vtr(vimg + vrd + (16 * s) * 144 + 64), a11 = vtr(vimg + vrd + (16 * s + 8) * 144 + 64);
                const bf16x8 A0 = (bf16x8){a00[0], a00[1], a00[2], a00[3], a01[0], a01[1], a01[2], a01[3]};
                const bf16x8 A1 = (bf16x8){a10[0], a10[1], a10[2], a10[3], a11[0], a11[1], a11[2], a11[3]};
                o0 = __builtin_amdgcn_mfma_f32_32x32x16_bf16(A0, pf[s], o0, 0, 0, 0);
                o1 = __builtin_amdgcn_mfma_f32_32x32x16_bf16(A1, pf[s], o1, 0, 0, 0);
            }
            asm volatile("s_waitcnt lgkmcnt(0)" ::: "memory");
        }
    }
    const float lt = lsum + __shfl_xor(lsum, 32); const float inv = 1.f / lt;
    bf16* yo = YS + (rowb + tq) * 1024 + h * 64 + 4 * hh;
#pragma unroll
    for (int g = 0; g < 4; ++g) {
        u32x2 w; w.x = cvtpk_s(o0[4 * g] * inv, o0[4 * g + 1] * inv); w.y = cvtpk_s(o0[4 * g + 2] * inv, o0[4 * g + 3] * inv); *(u32x2*)(yo + 8 * g) = w;
        u32x2 x; x.x = cvtpk_s(o1[4 * g] * inv, o1[4 * g + 1] * inv); x.y = cvtpk_s(o1[4 * g + 2] * inv, o1[4 * g + 3] * inv); *(u32x2*)(yo + 32 + 8 * g) = x; }
}

__device__ __forceinline__ unsigned fkey(float f) { const unsigned u = __float_as_uint(f); return (u & 0x80000000u) ? ~u : (u | 0x80000000u); }
typedef float f32x4v __attribute__((ext_vector_type(4)));
__device__ __forceinline__ void mixB_attend(const Args& a, int m, const LAS unsigned short* sidx, const LAS unsigned char* sbk, int nsel, LAS unsigned char* lds, LAS unsigned char* img, int lane) {
    const bf16* P = (const bf16*)(a.ws + WS_BIG); const bf16* CKVN = (const bf16*)(a.ws + WS_CKVN); bf16* YS = (bf16*)((unsigned char*)a.out + DO_YS);
    const LAS float* rpb = (const LAS float*)(lds + RPB_OFF);
    const int t = m & (SEQ - 1); const size_t rowb = (size_t)(m - t); const bf16* prow = P + (size_t)m * PW;
    const int hc = lane & 15, g = lane >> 4, hd = lane & 3;
    bf16x8 qB[2];
    { const bf16x8 z = (bf16x8){0, 0, 0, 0, 0, 0, 0, 0}; const bf16* qp = prow + PC_BQ + hd * 64 + 8 * g;
      const bf16x8 q0 = *(const bf16x8*)(qp), q1 = *(const bf16x8*)(qp + 32); qB[0] = hc < 4 ? q0 : z; qB[1] = hc < 4 ? q1 : z; }
    f32x4v oT[4];
#pragma unroll
    for (int mt = 0; mt < 4; ++mt) oT[mt] = (f32x4v){0.f, 0.f, 0.f, 0.f};
    float mrun = -INFINITY, lsum = 0.f;
    const float SC = 0.125f * LOG2E;
    const int i16 = lane & 15, tq4 = i16 >> 2, tp = i16 & 3;
    const int rd_row = (lane & 15) * 144 + 16 * g;
    const int rd_tr = (4 * g + tq4) * 144 + 8 * tp;
#pragma unroll 1
    for (int ch = 0; ch < 4; ++ch) {
        if (64 * ch >= nsel) break;
        { const int kk = 64 * ch + lane; const int idx = (int)sidx[kk < nsel ? kk : 0];
          const u32x4* cp = (const u32x4*)(CKVN + (rowb + idx) * 64); LAS u32x4* ip = (LAS u32x4*)(img + lane * 144);
          const u32x4 r0 = cp[0], r1 = cp[1], r2 = cp[2], r3 = cp[3], r4 = cp[4], r5 = cp[5], r6 = cp[6], r7 = cp[7];
          ip[0] = r0; ip[1] = r1; ip[2] = r2; ip[3] = r3; ip[4] = r4; ip[5] = r5; ip[6] = r6; ip[7] = r7; }
        asm volatile("s_waitcnt lgkmcnt(0)" ::: "memory");
        f32x4v st[4];
        float mx = -INFINITY;
#pragma unroll
        for (int kt = 0; kt < 4; ++kt) {
            const bf16x8 a0 = *(const LAS bf16x8*)(img + rd_row + (16 * kt) * 144), a1 = *(const LAS bf16x8*)(img + rd_row + (16 * kt) * 144 + 64);
            f32x4v acc = (f32x4v){0.f, 0.f, 0.f, 0.f};
            acc = __builtin_amdgcn_mfma_f32_16x16x32_bf16(a0, qB[0], acc, 0, 0, 0);
            acc = __builtin_amdgcn_mfma_f32_16x16x32_bf16(a1, qB[1], acc, 0, 0, 0);
            const int kb = 64 * ch + 16 * kt + 4 * g;
            const unsigned bk4 = *(const LAS unsigned*)(sbk + kb);
#pragma unroll
            for (int i = 0; i < 4; ++i) { const int bk = (bk4 >> (8 * i)) & 0xff; const float bias = rpb[bk * 8 + 4 + hd] * LOG2E;
                const float v = (kb + i < nsel) ? acc[i] * SC + bias : -INFINITY; acc[i] = v; mx = fmaxf(mx, v); }
            st[kt] = acc; }
        mx = fmaxf(mx, __shfl_xor(mx, 16)); mx = fmaxf(mx, __shfl_xor(mx, 32));
        const float mn = fmaxf(mrun, mx), alpha = __builtin_amdgcn_exp2f(mrun - mn); mrun = mn;
        float ps = 0.f;
#pragma unroll
        for (int kt = 0; kt < 4; ++kt)
#pragma unroll
            for (int i = 0; i < 4; ++i) { st[kt][i] = __builtin_amdgcn_exp2f(st[kt][i] - mn); ps += st[kt][i]; }
        lsum = lsum * alpha + ps;
#pragma unroll
        for (int mt = 0; mt < 4; ++mt) oT[mt] = oT[mt] * alpha;
#pragma unroll
        for (int ks2 = 0; ks2 < 2; ++ks2) {
            u32x4 w; w.x = cvtpk_s(st[2 * ks2][0], st[2 * ks2][1]); w.y = cvtpk_s(st[2 * ks2][2], st[2 * ks2][3]); w.z = cvtpk_s(st[2 * ks2 + 1][0], st[2 * ks2 + 1][1]); w.w = cvtpk_s(st[2 * ks2 + 1][2], st[2 * ks2 + 1][3]);
            const bf16x8 pB = __builtin_bit_cast(bf16x8, w);
#pragma unroll
            for (int mt = 0; mt < 4; ++mt) {
                const s16x4 lo = vtr(img + rd_tr + (32 * ks2) * 144 + 32 * mt), hi = vtr(img + rd_tr + (32 * ks2 + 16) * 144 + 32 * mt);
                const bf16x8 A = (bf16x8){lo[0], lo[1], lo[2], lo[3], hi[0], hi[1], hi[2], hi[3]};
                oT[mt] = __builtin_amdgcn_mfma_f32_16x16x32_bf16(A, pB, oT[mt], 0, 0, 0); } }
        asm volatile("s_waitcnt lgkmcnt(0)" ::: "memory");
    }
    float lt = lsum; lt += __shfl_xor(lt, 16); lt += __shfl_xor(lt, 32);
    const float inv = 1.f / lt;
    if (hc < 4) { bf16* yo = YS + (size_t)m * 1024 + 256 + hc * 64 + 4 * g;
#pragma unroll
        for (int mt = 0; mt < 4; ++mt) { u32x2 w; w.x = cvtpk_s(oT[mt][0] * inv, oT[mt][1] * inv); w.y = cvtpk_s(oT[mt][2] * inv, oT[mt][3] * inv); *(u32x2*)(yo + 16 * mt) = w; } }
}
__device__ __forceinline__ void mixB_group(const Args& a, int l, int m0, LAS unsigned char* lds, LAS unsigned char* wscr, int lane_in) {
    int lane = lane_in; asm volatile("" : "+v"(lane));
    const bf16* P = (const bf16*)(a.ws + WS_BIG);
    const int t0 = m0 & (SEQ - 1); const size_t rowb = (size_t)(m0 - t0);
    const int ql = lane & 31, hh = lane >> 5;
    LAS unsigned short* sidx = (LAS unsigned short*)wscr;
    LAS unsigned char* sbk = wscr + 2048;
    LAS unsigned char* img = wscr + 3584;
    const LAS unsigned char* bkt = lds + BKT_OFF;
    bf16x8 qf[2];
    { const int rho = ql, qi = 2 * ((rho >> 2) & 1) + (rho >> 4), hd = 4 * ((rho >> 3) & 1) + (rho & 3);
      const bf16* ip = P + (size_t)(m0 + qi) * PW + PC_IQ + hd * 32 + 8 * hh;
      qf[0] = *(const bf16x8*)(ip); qf[1] = *(const bf16x8*)(ip + 16); }
    float iw[2][8];
#pragma unroll
    for (int qq = 0; qq < 2; ++qq) { const u32x4 w = *(const u32x4*)(P + (size_t)(m0 + 2 * hh + qq) * PW + PC_IW); const float s = 0.0625f;
        iw[qq][0] = bflo(w.x) * s; iw[qq][1] = bfhi(w.x) * s; iw[qq][2] = bflo(w.y) * s; iw[qq][3] = bfhi(w.y) * s; iw[qq][4] = bflo(w.z) * s; iw[qq][5] = bfhi(w.z) * s; iw[qq][6] = bflo(w.w) * s; iw[qq][7] = bfhi(w.w) * s; }
    const int tq0 = t0 + 2 * hh;
    const int ntile = ((t0 + 3) >> 5) + 1;
    unsigned sk[2][64];
#pragma unroll
    for (int kt = 0; kt < 64; ++kt) {
        unsigned k0 = 0x007fffffu, k1 = 0x007fffffu;
        if (kt < ntile) { const int s = 32 * kt + ql; const bf16* kp = P + (rowb + s) * PW + PC_IK + 8 * hh;
            const bf16x8 kf0 = *(const bf16x8*)(kp), kf1 = *(const bf16x8*)(kp + 16);
            f32x16 acc;
#pragma unroll
            for (int i = 0; i < 16; ++i) acc[i] = 0.f;
            acc = __builtin_amdgcn_mfma_f32_32x32x16_bf16(qf[0], kf0, acc, 0, 0, 0);
            acc = __builtin_amdgcn_mfma_f32_32x32x16_bf16(qf[1], kf1, acc, 0, 0, 0);
            float s0 = 0.f, s1 = 0.f;
#pragma unroll
            for (int i = 0; i < 8; ++i) { s0 += fmaxf(acc[i], 0.f) * iw[0][i]; s1 += fmaxf(acc[8 + i], 0.f) * iw[1][i]; }
            k0 = (s <= tq0) ? fkey(s0) : 0x007fffffu; k1 = (s <= tq0 + 1) ? fkey(s1) : 0x007fffffu; }
        sk[0][kt] = k0; sk[1][kt] = k1; }
    const unsigned ltm = (1u << ql) - 1u;
#pragma unroll
    for (int qq = 0; qq < 2; ++qq) {
        const int tq = tq0 + qq;
        unsigned Kth = 0u; int need = 0; bool big = (tq + 1 > 256);
        if (__any(big)) {
#pragma unroll 1
            for (int bit = 31; bit >= 0; --bit) { const unsigned cand = Kth | (1u << bit); int cnt = 0;
#pragma unroll
                for (int kt = 0; kt < 64; ++kt) cnt += (sk[qq][kt] >= cand) ? 1 : 0;
                cnt += __shfl_xor(cnt, 1); cnt += __shfl_xor(cnt, 2); cnt += __shfl_xor(cnt, 4); cnt += __shfl_xor(cnt, 8); cnt += __shfl_xor(cnt, 16);
                if (cnt >= 256) Kth = cand;
                if (__all(cnt == 256 || cnt < 256 - 2048)) { }
            }
            int cgt = 0;
#pragma unroll
            for (int kt = 0; kt < 64; ++kt) cgt += (sk[qq][kt] > Kth) ? 1 : 0;
            cgt += __shfl_xor(cgt, 1); cgt += __shfl_xor(cgt, 2); cgt += __shfl_xor(cgt, 4); cgt += __shfl_xor(cgt, 8); cgt += __shfl_xor(cgt, 16);
            need = 256 - cgt;
        }
        LAS unsigned short* sx = sidx + (2 * hh + qq) * 256; LAS unsigned char* sb = sbk + (2 * hh + qq) * 256;
        int base = 0, tie_taken = 0; int ql2 = ql; asm volatile("" : "+v"(ql2));
#pragma unroll
        for (int kt = 0; kt < 64; ++kt) { const int s = 32 * kt + ql2; const unsigned k = sk[qq][kt]; bool take;
            if (!big) take = (s <= tq);
            else { const bool tie = (k == Kth); const unsigned long long mt = __ballot(tie); const unsigned mt32 = hh ? (unsigned)(mt >> 32) : (unsigned)mt;
                take = (k > Kth) || (tie && (tie_taken + __popc(mt32 & ltm)) < need); tie_taken += __popc(mt32); }
            const unsigned long long ms = __ballot(take); const unsigned ms32 = hh ? (unsigned)(ms >> 32) : (unsigned)ms;
            if (take) { const int pos = base + __popc(ms32 & ltm); sx[pos] = (unsigned short)s; sb[pos] = bkt[tq - s]; }
            base += __popc(ms32); }
    }
    LDS_WAIT(); asm volatile("" ::: "memory");
#pragma unroll 1
    for (int qi = 0; qi < 4; ++qi) { const int tq = t0 + qi; const int nsel = (tq + 1 < 256) ? tq + 1 : 256;
        mixB_attend(a, m0 + qi, sidx + qi * 256, sbk + qi * 256, nsel, lds, img, lane); asm volatile("" ::: "memory"); }
}
__device__ __forceinline__ void mixers_phase(const Args& a, int l, LAS unsigned char* lds, int bid, int G, int tid, int wave, int lane, int qsel = 0, int mixmask = 15) {
    for (int it = bid; it < 256; it += G) {
#ifndef MIX_NO_D
        if (it < 128 && (mixmask & 1)) dscan_item(a, l, it, lds, tid);
#endif
#ifndef MIX_NO_C
        if (it >= 128 && (mixmask & 2)) cscan_item(a, l, it - 128, lds, tid);
#endif
 __syncthreads(); }
    mixA_tables(a, lds, tid); __syncthreads();
    unsigned* qh = (unsigned*)(a.ws + WS_CTL) + CW_Q + 64 * l + 16 * qsel;
    LAS unsigned char* wscr = lds + wave * 12800;
    for (;;) {
        unsigned cq = 0; if (lane == 0) cq = __hip_atomic_fetch_add(qh, 1u, __ATOMIC_RELAXED, __HIP_MEMORY_SCOPE_AGENT);
        cq = (unsigned)__builtin_amdgcn_readfirstlane((int)cq);
        if (cq >= 16384u) break;
        if (cq < 8192u) { if (!(mixmask & 8)) continue; const int tb = 255 - (int)(cq >> 5), b = (int)(cq & 31u); const int m0 = b * SEQ + tb * 8;
#pragma unroll 1
            for (int k = 0; k < 2; ++k) {
#ifndef MIX_NO_B
                mixB_group(a, l, m0 + 4 * k, lds, wscr, lane);
#endif
            } }
        else { if (!(mixmask & 4)) continue;
#ifndef MIX_NO_A
            mixA_task(a, (int)(cq - 8192u), lds, wave, lane);
#endif
        }
    }
}

constexpr int RREC_OFF = MISC_OFF + 4096, LCNT_OFF = MISC_OFF + 10240, LBASE_OFF = MISC_OFF + 10368;
__device__ __forceinline__ void ln1_route_phase(const Args& a, int l, LAS unsigned char* lds, int bid, int G, int tid, int wave, int lane) {
    bf16* XB = (bf16*)(a.ws + WS_XB); const float* WRT = (const float*)(a.ws + WS_RT) + (size_t)l * 36 * 1024;
    unsigned* tokinfo = (unsigned*)(a.ws + WS_TOK); unsigned* cntg = (unsigned*)(a.ws + WS_CTL) + CW_CNT + (l * 32) * 64;
    const float* lng = a.in[21] + (l * 2 + 0) * 1024; const float* lnb = a.in[22] + (l * 2 + 0) * 1024;
    const float* brg = a.in[24] + l * 4; const float* bre = a.in[26] + l * 32;
    LAS float* sW = (LAS float*)lds;
    LAS unsigned* rrec = (LAS unsigned*)(lds + RREC_OFF); LAS int* lcnt = (LAS int*)(lds + LCNT_OFF); LAS unsigned* lbase = (LAS unsigned*)(lds + LBASE_OFF);
    for (int i = tid; i < 32 * 1024 / 4; i += NTHR) *(LAS f32x4*)(sW + 4 * i) = *(const f32x4*)(WRT + 4 * 1024 + 4 * i);
    f32x4 gam[4], bet[4], wg[4][4];
#pragma unroll
    for (int j = 0; j < 4; ++j) { gam[j] = *(const f32x4*)(lng + 4 * lane + 256 * j); bet[j] = *(const f32x4*)(lnb + 4 * lane + 256 * j);
#pragma unroll
        for (int e = 0; e < 4; ++e) wg[e][j] = *(const f32x4*)(WRT + e * 1024 + 4 * lane + 256 * j); }
    for (int blk = bid; blk < NTOK / 256; blk += G) {
        if (tid < 32) lcnt[tid] = 0;
        __syncthreads();
#pragma unroll 1
        for (int rg = 0; rg < 8; ++rg) {
            const int rl0 = wave * 32 + rg * 4; f32x4 x[4][4]; float mylog[4];
#pragma unroll
            for (int r = 0; r < 4; ++r) { bf16* xr = XB + (size_t)(blk * 256 + rl0 + r) * 1024; float s = 0.f;
#pragma unroll
                for (int j = 0; j < 4; ++j) { const u32x2 w = *(const u32x2*)(xr + 4 * lane + 256 * j); x[r][j] = (f32x4){bflo(w.x), bfhi(w.x), bflo(w.y), bfhi(w.y)}; s += (x[r][j][0] + x[r][j][1]) + (x[r][j][2] + x[r][j][3]); }
                const float mean = wave_sum(s) * (1.f / 1024.f); float q = 0.f;
#pragma unroll
                for (int j = 0; j < 4; ++j) { x[r][j] = x[r][j] - mean; q += (x[r][j][0] * x[r][j][0] + x[r][j][1] * x[r][j][1]) + (x[r][j][2] * x[r][j][2] + x[r][j][3] * x[r][j][3]); }
                const float rstd = rsqrtf(wave_sum(q) * (1.f / 1024.f) + LN_EPS);
#pragma unroll
                for (int j = 0; j < 4; ++j) { x[r][j] = x[r][j] * rstd * gam[j] + bet[j]; u32x2 w; w.x = pk2(x[r][j][0], x[r][j][1]); w.y = pk2(x[r][j][2], x[r][j][3]); *(u32x2*)(xr + 4 * lane + 256 * j) = w; }
                mylog[r] = 0.f; }
#pragma unroll
            for (int e = 0; e < 4; ++e)
#pragma unroll
                for (int r = 0; r < 4; ++r) { float d = 0.f;
#pragma unroll
                    for (int j = 0; j < 4; ++j) d += (x[r][j][0] * wg[e][j][0] + x[r][j][1] * wg[e][j][1]) + (x[r][j][2] * wg[e][j][2] + x[r][j][3] * wg[e][j][3]);
                    d = wave_sum(d) + brg[e]; if (lane == e) mylog[r] = d; }
#pragma unroll 1
            for (int e = 0; e < 32; ++e) { f32x4 w4[4];
#pragma unroll
                for (int j = 0; j < 4; ++j) w4[j] = *(const LAS f32x4*)(sW + e * 1024 + 4 * lane + 256 * j);
                const float be = bre[e];
#pragma unroll
                for (int r = 0; r < 4; ++r) { float d = 0.f;
#pragma unroll
                    for (int j = 0; j < 4; ++j) d += (x[r][j][0] * w4[j][0] + x[r][j][1] * w4[j][1]) + (x[r][j][2] * w4[j][2] + x[r][j][3] * w4[j][3]);
                    d = wave_sum(d) + be; if (lane == 4 + e) mylog[r] = d; } }
#pragma unroll
            for (int r = 0; r < 4; ++r) {
                const float g0 = __shfl(mylog[r], 0), g1 = __shfl(mylog[r], 1), g2 = __shfl(mylog[r], 2), g3 = __shfl(mylog[r], 3);
                int gs = 0; float gm = g0; if (g1 > gm) { gm = g1; gs = 1; } if (g2 > gm) { gm = g2; gs = 2; } if (g3 > gm) { gm = g3; gs = 3; }
                const float ptop = 1.f / (__expf(g0 - gm) + __expf(g1 - gm) + __expf(g2 - gm) + __expf(g3 - gm));
                float v0 = -INFINITY, v1 = -INFINITY; int i0 = 0, i1 = 0;
#pragma unroll
                for (int j = 0; j < 8; ++j) { const float le = __shfl(mylog[r], 4 + gs * 8 + j);
                    if (le > v0) { v1 = v0; i1 = i0; v0 = le; i0 = j; } else if (le > v1) { v1 = le; i1 = j; } }
                const float ex = __expf(v1 - v0), w0 = ptop / (1.f + ex), w1 = ptop * ex / (1.f + ex);
                if (lane == 0) { const int e0 = gs * 8 + i0, e1 = gs * 8 + i1; const int rl = rl0 + r;
                    const int p0 = atomicAdd((int*)&lcnt[e0], 1), p1 = atomicAdd((int*)&lcnt[e1], 1);
                    rrec[rl * 6 + 0] = (unsigned)e0; rrec[rl * 6 + 1] = (unsigned)p0; rrec[rl * 6 + 2] = __float_as_uint(w0); rrec[rl * 6 + 3] = (unsigned)e1; rrec[rl * 6 + 4] = (unsigned)p1; rrec[rl * 6 + 5] = __float_as_uint(w1); } }
        }
        __syncthreads();
        if (tid < 32) lbase[tid] = __hip_atomic_fetch_add(cntg + tid * 64, (unsigned)lcnt[tid], __ATOMIC_RELAXED, __HIP_MEMORY_SCOPE_AGENT);
        __syncthreads();
        if (tid < 256) { const unsigned e0 = rrec[tid * 6 + 0], e1 = rrec[tid * 6 + 3]; unsigned* ti = tokinfo + (size_t)(blk * 256 + tid) * 8;
            u32x4 o0, o1; o0.x = e0; o0.y = lbase[e0] + rrec[tid * 6 + 1]; o0.z = rrec[tid * 6 + 2]; o0.w = e1; o1.x = lbase[e1] + rrec[tid * 6 + 4]; o1.y = rrec[tid * 6 + 5]; o1.z = 0u; o1.w = 0u;
            *(u32x4*)ti = o0; *(u32x4*)(ti + 4) = o1; }
        __syncthreads();
    }
}
__device__ __forceinline__ void moe_table(const Args& a, int l, LAS unsigned char* lds, int tid) {
    LAS int* tstart = (LAS int*)(lds + TST_OFF);
    if (tid == 0) { const unsigned* cntg = (const unsigned*)(a.ws + WS_CTL) + CW_CNT + (l * 32) * 64; int acc = 0;
        for (int e = 0; e < 32; ++e) { tstart[e] = acc; acc += (int)((__hip_atomic_load(cntg + e * 64, __ATOMIC_RELAXED, __HIP_MEMORY_SCOPE_AGENT) + 255u) >> 8); }
        tstart[32] = acc; }
    __syncthreads();
}
__device__ __forceinline__ void scatter_phase(const Args& a, int l, LAS unsigned char* lds, int bid, int G, int tid, int gw, int NGW, int lane) {
    const LAS int* tstart = (const LAS int*)(lds + TST_OFF);
    const bf16* XB = (const bf16*)(a.ws + WS_XB); bf16* XS = (bf16*)(a.ws + WS_BIG); unsigned* rowinfo = (unsigned*)(a.ws + WS_ROW); const unsigned* tokinfo = (const unsigned*)(a.ws + WS_TOK);
    const unsigned* cntg = (const unsigned*)(a.ws + WS_CTL) + CW_CNT + (l * 32) * 64;
    for (int e = bid; e < 32; e += G) { const int c = (int)__hip_atomic_load(cntg + e * 64, __ATOMIC_RELAXED, __HIP_MEMORY_SCOPE_AGENT); const int r0 = tstart[e] * 256, r1 = tstart[e + 1] * 256;
        unsigned neg_ = 0xffffffffu, zer_ = 0u; asm volatile("" : "+v"(neg_), "+v"(zer_));
        for (int r = r0 + c + tid; r < r1; r += NTHR) { rowinfo[2 * (size_t)r] = neg_; rowinfo[2 * (size_t)r + 1] = zer_; } }
    for (int m = gw; m < NTOK; m += NGW) {
        const u32x4 t0 = *(const u32x4*)(tokinfo + (size_t)m * 8); const u32x2 t1 = *(const u32x2*)(tokinfo + (size_t)m * 8 + 4);
        const size_t r0 = (size_t)tstart[t0.x] * 256 + t0.y, r1 = (size_t)tstart[t0.w] * 256 + t1.x;
        const u32x4* src = (const u32x4*)(XB + (size_t)m * 1024); const u32x4 v0 = src[lane], v1 = src[64 + lane];
        u32x4* d0 = (u32x4*)(XS + r0 * 1024); u32x4* d1 = (u32x4*)(XS + r1 * 1024);
        d0[lane] = v0; d0[64 + lane] = v1; d1[lane] = v0; d1[64 + lane] = v1;
        if (lane == 0) { rowinfo[2 * r0] = (unsigned)(m * 2); rowinfo[2 * r0 + 1] = t0.z; rowinfo[2 * r1] = (unsigned)(m * 2 + 1); rowinfo[2 * r1 + 1] = t1.y; }
    }
}
__device__ __forceinline__ void ln2_phase(const Args& a, int l, int gw, int NGW, int lane) {
    bf16* XB = (bf16*)(a.ws + WS_XB); const bf16* Y = (const bf16*)(a.ws + WS_BIG);
    const float* lng = a.in[21] + (l * 2 + 1) * 1024; const float* lnb = a.in[22] + (l * 2 + 1) * 1024;
    f32x4 gam[4], bet[4];
#pragma unroll
    for (int j = 0; j < 4; ++j) { gam[j] = *(const f32x4*)(lng + 4 * lane + 256 * j); bet[j] = *(const f32x4*)(lnb + 4 * lane + 256 * j); }
    for (int m = gw; m < NTOK; m += NGW) {
        bf16* xr = XB + (size_t)m * 1024; const bf16* y0 = Y + (size_t)m * 1024; const bf16* y1 = Y + ((size_t)NTOK + m) * 1024;
        f32x4 x[4]; float s = 0.f;
#pragma unroll
        for (int j = 0; j < 4; ++j) { const u32x2 w = *(const u32x2*)(xr + 4 * lane + 256 * j), p = *(const u32x2*)(y0 + 4 * lane + 256 * j), q = *(const u32x2*)(y1 + 4 * lane + 256 * j);
            x[j] = (f32x4){DN_ALPHA * bflo(w.x) + (bflo(p.x) + bflo(q.x)), DN_ALPHA * bfhi(w.x) + (bfhi(p.x) + bfhi(q.x)), DN_ALPHA * bflo(w.y) + (bflo(p.y) + bflo(q.y)), DN_ALPHA * bfhi(w.y) + (bfhi(p.y) + bfhi(q.y))};
            s += (x[j][0] + x[j][1]) + (x[j][2] + x[j][3]); }
        const float mean = wave_sum(s) * (1.f / 1024.f); float q = 0.f;
#pragma unroll
        for (int j = 0; j < 4; ++j) { x[j] = x[j] - mean; q += (x[j][0] * x[j][0] + x[j][1] * x[j][1]) + (x[j][2] * x[j][2] + x[j][3] * x[j][3]); }
        const float rstd = rsqrtf(wave_sum(q) * (1.f / 1024.f) + LN_EPS);
#pragma unroll
        for (int j = 0; j < 4; ++j) { x[j] = x[j] * rstd * gam[j] + bet[j];
            if (l == NLAYER - 1) *(f32x4*)(a.out + (size_t)m * 1024 + 4 * lane + 256 * j) = x[j];
            else { u32x2 w; w.x = pk2(x[j][0], x[j][1]); w.y = pk2(x[j][2], x[j][3]); *(u32x2*)(xr + 4 * lane + 256 * j) = w; } }
    }
}

#ifndef MK_MULTI
#define MK_MULTI 0
#endif
constexpr int NPHASE = 12;
__global__ void __launch_bounds__(NTHR, 2) fwd(Args a) {
    extern __shared__ __attribute__((aligned(16))) unsigned char lds_raw[];
    LAS unsigned char* lds = (LAS unsigned char*)lds_raw;
    const int G0 = gridDim.x, bid0 = blockIdx.x, wave0 = __builtin_amdgcn_readfirstlane((int)(threadIdx.x >> 6));
#define PH_IDS unsigned on_ = ~0u; asm volatile("" : "+s"(on_)); int lz_ = (int)__builtin_amdgcn_mbcnt_hi(on_, __builtin_amdgcn_mbcnt_lo(on_, 0u)); int wz_ = wave0, bz_ = bid0, gz_ = G0; asm volatile("" : "+s"(wz_), "+s"(bz_), "+s"(gz_)); \
    const int lane = lz_, wave = wz_, tid = wz_ * 64 + lz_, bid = bz_, G = gz_, NGW = gz_ * NWAVES, gw = bid * NWAVES + wave; (void)lane; (void)gw; (void)wave; (void)tid; (void)NGW;
#define PH_ARGS(LV) const __attribute__((address_space(4))) Args* kp_ = (const __attribute__((address_space(4))) Args*)__builtin_amdgcn_kernarg_segment_ptr(); asm volatile("" : "+s"(kp_)); const Args& b = *(const Args*)kp_; int lq = (LV); asm volatile("" : "+s"(lq)); (void)lq; \
    bf16* XB = (bf16*)(b.ws + WS_XB); bf16* PB = (bf16*)(b.ws + WS_BIG); bf16* YS = (bf16*)((unsigned char*)b.out + DO_YS); bf16* MG = (bf16*)((unsigned char*)b.out + DO_MG); \
    unsigned* rowinfo = (unsigned*)(b.ws + WS_ROW); unsigned char* wl = b.ws + WS_W + (size_t)lq * WL_SIZE; (void)XB; (void)PB; (void)YS; (void)MG; (void)rowinfo; (void)wl;
    unsigned* ctl = (unsigned*)(a.ws + WS_CTL);
    { PH_IDS
    for (int u = tid; u < (LDS_BYTES - MISC_OFF) / 4; u += NTHR) ((LAS unsigned*)(lds + MISC_OFF))[u] = 0u;
    __syncthreads();
    for (int d = tid; d < 2048; d += NTHR) ((LAS unsigned char*)(lds + BKT_OFF))[d] = (unsigned char)t5_bucket(d);
    if (tid < 256) ((LAS float*)(lds + RPB_OFF))[tid] = a.in[1][tid];
    __syncthreads(); }
    XcdBarrier bar; bar.bar = ctl + CW_BAR; bar.x = 0; bar.st = nullptr;
    if (a.use_bar) bar = xcd_barrier_post(ctl + CW_BAR, (volatile LAS unsigned*)(lds + MISC_OFF) + 8);
#define GRID_BAR() do { if (a.use_bar) { const __attribute__((address_space(4))) Args* kq_ = (const __attribute__((address_space(4))) Args*)__builtin_amdgcn_kernarg_segment_ptr(); asm volatile("" : "+s"(kq_)); \
        XcdBarrier bb_ = bar; bb_.bar = (unsigned*)(kq_->ws + WS_CTL) + CW_BAR; xcd_barrier(bb_); } } while (0)
#ifndef PHMASK
#define PHMASK 0xFFF
#endif
#define IN(k) (((PHMASK >> (k)) & 1) && ((phm >> (k)) & 1u))

    unsigned phm = ((1u << a.ph_hi) - 1u) & ~((1u << a.ph_lo) - 1u);
    if (a.l_lo == 0 && IN(0)) { PH_IDS PH_ARGS(0) p0_prologue(b, lds, gw, NGW, wave, lane); GRID_BAR(); }
    for (int l = a.l_lo; l < a.l_hi; ++l) {
        asm volatile("" : "+s"(phm));
        if (IN(1)) { PH_IDS PH_ARGS(l) pg8::Gemm g{XB, (const bf16*)(wl + WL_IN), 1024, 1024, 1024}; pg8::GridOrder S; S.init(NTOK / 256, PW / 256, G, bid);
            pg8::EpiStoreBf16 E{PB, PW}; pg8::gemm_phase(lds, g, S, E, tid); GRID_BAR(); }
        if (IN(2)) { PH_IDS PH_ARGS(l) prep_phase(b, lq, lds, tid, gw, NGW, lane); GRID_BAR(); }
        if (IN(3)) { PH_IDS PH_ARGS(l) mixers_phase(b, lq, lds, bid, G, tid, wave, lane); GRID_BAR(); }
        if (IN(4)) { PH_IDS PH_ARGS(l) pg8::Gemm g{YS, (const bf16*)(wl + WL_BR), 1024, 256, 256}; pg8::GridOrder S; S.init(NTOK / 256, 16, G, bid, 4, 512);
            pg8::EpiStoreBf16 E{PB, 4096}; pg8::gemm_phase(lds, g, S, E, tid); GRID_BAR(); }
        if (IN(5)) { PH_IDS PH_ARGS(l) pg8::Gemm g{XB, (const bf16*)(wl + WL_IN) + (size_t)3072 * 1024, 1024, 1024, 1024}; pg8::GridOrder S; S.init(NTOK / 256, 16, G, bid);
            pg8::EpiGate E{PB, MG}; pg8::gemm_phase(lds, g, S, E, tid); GRID_BAR(); }
        if (IN(6)) { PH_IDS PH_ARGS(l) pg8::Gemm g{MG, (const bf16*)(wl + WL_OUT), 1024, 1024, 1024}; pg8::GridOrder S; S.init(NTOK / 256, 4, G, bid);
            pg8::EpiOut E{XB}; pg8::gemm_phase(lds, g, S, E, tid); GRID_BAR(); }
        if (IN(7)) { PH_IDS PH_ARGS(l) ln1_route_phase(b, lq, lds, bid, G, tid, wave, lane); GRID_BAR(); }
        if (IN(8)) { PH_IDS PH_ARGS(l) moe_table(b, lq, lds, tid); scatter_phase(b, lq, lds, bid, G, tid, gw, NGW, lane); GRID_BAR(); }
        if (IN(9)) { PH_IDS PH_ARGS(l) moe_table(b, lq, lds, tid); pg8::Gemm g{PB, (const bf16*)(wl + WL_GU), 1024, 1024, 1024}; pg8::MoeOrder S{(const LAS int*)(lds + TST_OFF), 1, G, bid};
            pg8::EpiUp E{rowinfo, (bf16*)(b.ws + WS_BIG + BIG_H)}; pg8::gemm_phase(lds, g, S, E, tid); GRID_BAR(); }
        if (IN(10)) { PH_IDS PH_ARGS(l) moe_table(b, lq, lds, tid); pg8::Gemm g{(const bf16*)(b.ws + WS_BIG + BIG_H), (const bf16*)(wl + WL_DN), 256, 256, 256}; pg8::MoeOrder S{(const LAS int*)(lds + TST_OFF), 2, G, bid};
            pg8::EpiDown E{rowinfo, PB}; pg8::gemm_phase(lds, g, S, E, tid); GRID_BAR(); }
        if (IN(11)) { PH_IDS PH_ARGS(l) ln2_phase(b, lq, gw, NGW, lane); if (l + 1 < a.l_hi) GRID_BAR(); }
    }
#undef IN
#undef GRID_BAR
}

extern "C" void kernel_launch(void* const* d_in, const int* in_sizes, int n_in, void* d_out, int out_size, void* d_ws, size_t ws_size, hipStream_t stream) {
    static int grid = 0;
    if (grid == 0) {
        if (n_in != 30 || out_size != NTOK * DM || ws_size < WS_END) { fprintf(stderr, "kernel_launch: unexpected shapes (n_in %d out %d ws %zu)\n", n_in, out_size, ws_size); grid = -1; return; }
        int dev = 0, cus = 0, per_cu = 0;
        if (hipGetDevice(&dev) != hipSuccess || hipDeviceGetAttribute(&cus, hipDeviceAttributeMultiprocessorCount, dev) != hipSuccess) { grid = -1; return; }
        if (hipFuncSetAttribute((const void*)fwd, hipFuncAttributeMaxDynamicSharedMemorySize, LDS_BYTES) != hipSuccess) { fprintf(stderr, "kernel_launch: hipFuncSetAttribute failed\n"); grid = -1; return; }
        if (hipOccupancyMaxActiveBlocksPerMultiprocessor(&per_cu, (const void*)fwd, NTHR, LDS_BYTES) != hipSuccess || per_cu < 1) fprintf(stderr, "kernel_launch: occupancy query says %d\n", per_cu);
        (void)hipGetLastError();
        grid = cus;
    }
    if (grid < 0) return;
    (void)hipMemsetAsync((char*)d_ws + WS_CTL, 0, CTL_ZERO_BYTES, stream);
    Args a{};
    for (int i = 0; i < 30; ++i) a.in[i] = (const float*)d_in[i];
    a.out = (float*)d_out; a.ws = (unsigned char*)d_ws; a.pad = 0;
#if MK_MULTI
    a.use_bar = 0;
    for (int l = 0; l < NLAYER; ++l)
        for (int ph = (l == 0 ? 0 : 1); ph < NPHASE; ++ph) { a.l_lo = l; a.l_hi = l + 1; a.ph_lo = ph; a.ph_hi = ph + 1;
            hipLaunchKernelGGL(fwd, dim3(grid), dim3(NTHR), LDS_BYTES, stream, a); }
#else
    a.use_bar = 1; a.l_lo = 0; a.l_hi = NLAYER; a.ph_lo = 0; a.ph_hi = NPHASE;
    hipLaunchKernelGGL(fwd, dim3(grid), dim3(NTHR), LDS_BYTES, stream, a);
#endif
    const hipError_t le = hipPeekAtLastError();
    if (le != hipSuccess) fprintf(stderr, "kernel_launch: launch failed: %s\n", hipGetErrorName(le));
}
```

```cpp
#include <hip/hip_runtime.h>
#include <cstdio>
#include <cstdint>

#define LAS __attribute__((address_space(3)))
#define GAS __attribute__((address_space(1)))
typedef unsigned short bf16;
typedef short bf16x8 __attribute__((ext_vector_type(8)));
typedef float f32x4 __attribute__((ext_vector_type(4)));
typedef float f32x2 __attribute__((ext_vector_type(2)));
typedef unsigned u32x4 __attribute__((ext_vector_type(4)));
typedef unsigned u32x2 __attribute__((ext_vector_type(2)));

namespace pg8 {
constexpr int BM = 256, BK = 64, HALF = 128, HTB = HALF * BK * 2  , STAGE_BYTES = 8 * HTB, NXCD = 8, WGM = 8;

__host__ __device__ __forceinline__ int lds_byte(int r, int c) { const int st = (r >> 4) * 2 + (c >> 5), rr = r & 15, cc = c & 31, ob = rr * 64 + cc * 2; return st * 1024 + (ob ^ (((ob >> 9) & 1) << 5)); }
__host__ __device__ __forceinline__ void stage_rc(int b, int& R, int& C) { const int st = b / 1024, sb = b % 1024, swz = sb ^ (((sb >> 9) & 1) << 5); R = (st >> 1) * 16 + swz / 64; C = (st & 1) * 32 + (swz % 64) / 2; }
__host__ __device__ __forceinline__ int perm32(int rho) { const int n = rho >> 4, i = rho & 15; return 8 * (i >> 2) + 4 * n + (i & 3); }

struct Unit { int pm, pn, pb; unsigned aoff; };
struct Gemm { const bf16* A; const bf16* Bt; int lda, ldb, K; };

struct GridOrder {
    int nM, nN, nwg, G, c, a_grp, a_grp_bytes;
    __device__ void init(int nM_, int nN_, int G_, int c_, int a_grp_ = 0, int a_grp_bytes_ = 0) { nM = nM_; nN = nN_; nwg = nM * nN; G = G_; c = c_; a_grp = a_grp_; a_grp_bytes = a_grp_bytes_; }
    __device__ bool next(int i, Unit& u) const {
        const long L = (long)i * G + c; if (L >= nwg) return false;
        int wgid = (int)L; { const int q = nwg / NXCD, r = nwg % NXCD, xcd = wgid % NXCD, off = wgid / NXCD; wgid = (xcd < r ? xcd * (q + 1) : r * (q + 1) + (xcd - r) * q) + off; }
        const int nig = WGM * nN, gid = wgid / nig, fm = gid * WGM, gsz = (nM - fm) < WGM ? (nM - fm) : WGM;
        u.pm = fm + ((wgid % nig) % gsz); u.pn = (wgid % nig) / gsz; u.pb = u.pn; u.aoff = a_grp ? (unsigned)((u.pn / a_grp) * a_grp_bytes) : 0u; return true;
    }
};
struct MoeOrder {
    const LAS int* tstart; int nsl, G, c;
    __device__ bool next(int i, Unit& u) const {
        const int L = i * G + c, total = tstart[32] << nsl; if (L >= total) return false;
        const int rt = L >> nsl, pn = L & ((1 << nsl) - 1); int e = 0;
        while (e < 31 && rt >= tstart[e + 1]) ++e;
        u.pm = rt; u.pn = pn; u.pb = (e << nsl) + pn; u.aoff = 0u; return true;
    }
};

__device__ __forceinline__ unsigned cvt_pk_bf16(float lo, float hi) { unsigned r; asm volatile("v_cvt_pk_bf16_f32 %0, %1, %2" : "=v"(r) : "v"(lo), "v"(hi)); return r; }

template <class Epi, class Sched>
__device__ __forceinline__ void gemm_phase(LAS unsigned char* lds, const Gemm g, const Sched& S, const Epi& E, const int tid) {
    const int wid = __builtin_amdgcn_readfirstlane(tid >> 6), lane = tid & 63, wr = wid >> 2, wc = wid & 3, fr = lane & 15, fq = lane >> 4;
    const int K = g.K, nt = K / BK;
    unsigned voffA[2], voffB[2];
#pragma unroll
    for (int i = 0; i < 2; ++i) { int R, C; stage_rc(tid * 16 + i * 8192, R, C); const int Rb = Epi::PERM ? ((R & ~31) + perm32(R & 31)) : R;
        voffA[i] = (unsigned)(R * g.lda + C) * 2u; voffB[i] = (unsigned)(Rb * g.ldb + C) * 2u; }
    const size_t kstep = (size_t)(BK * 2);
    const size_t hstepA = (size_t)HALF * g.lda * 2, hstepB = (size_t)HALF * g.ldb * 2;
    const size_t tstepA = 2 * hstepA, tstepB = 2 * hstepB;
    const unsigned ldsw = (unsigned)wid * 1024u;
    const int aoff = lds_byte(wr * 64 + fr, fq * 8), boff = lds_byte(wc * 32 + fr, fq * 8);
#define PG8_SA(b, h) (((b) * 2 + (h)) * HTB)
#define PG8_SB(b, h) ((4 + (b) * 2 + (h)) * HTB)
#define PG8_STAGE(bufoff, gbase, voff) do { _Pragma("unroll") for (int _i = 0; _i < 2; ++_i) \
        __builtin_amdgcn_global_load_lds((const unsigned*)((const char*)(gbase) + (voff)[_i]), (LAS unsigned*)(lds + (bufoff) + ldsw + _i * 8192), 16, 0, 0); } while (0)
#define PG8_LDA(dst, b, h) do { _Pragma("unroll") for (int m = 0; m < 4; ++m) _Pragma("unroll") for (int k = 0; k < 2; ++k) dst[m][k] = *(const LAS bf16x8*)(lds + PG8_SA(b, h) + aoff + m * 2048 + k * 1024); } while (0)
#define PG8_LDB(dst, b, h) do { _Pragma("unroll") for (int n = 0; n < 2; ++n) _Pragma("unroll") for (int k = 0; k < 2; ++k) dst[n][k] = *(const LAS bf16x8*)(lds + PG8_SB(b, h) + boff + n * 2048 + k * 1024); } while (0)
#define PG8_MMA(ai, bj, At, Bt) do { __builtin_amdgcn_s_setprio(1); _Pragma("unroll") for (int m = 0; m < 4; ++m) _Pragma("unroll") for (int n = 0; n < 2; ++n) _Pragma("unroll") for (int k = 0; k < 2; ++k) \
        acc[ai][bj][m][n] = __builtin_amdgcn_mfma_f32_16x16x32_bf16(Bt[n][k], At[m][k], acc[ai][bj][m][n], 0, 0, 0); __builtin_amdgcn_s_setprio(0); } while (0)
#define PG8_WAIT_V(n) asm volatile("s_waitcnt vmcnt(" #n ")" ::: "memory")
#define PG8_WAIT_L(n) asm volatile("s_waitcnt lgkmcnt(" #n ")" ::: "memory")
#define PG8_BAR __builtin_amdgcn_s_barrier()
#define PG8_SCHED __builtin_amdgcn_sched_barrier(0)
    Unit cur, nxt; int ui = 0;
    if (!S.next(0, cur)) return;
    f32x4 acc[2][2][4][2];
#pragma unroll
    for (int a = 0; a < 2; ++a)
#pragma unroll
        for (int b = 0; b < 2; ++b)
#pragma unroll
            for (int m = 0; m < 4; ++m)
#pragma unroll
                for (int n = 0; n < 2; ++n) acc[a][b][m][n] = (f32x4){0.f, 0.f, 0.f, 0.f};
    bf16x8 At[4][2], B0[2][2], B1[2][2];
    const char* cA = (const char*)g.A + (size_t)cur.pm * tstepA + cur.aoff; const char* cB = (const char*)g.Bt + (size_t)cur.pb * tstepB;
    PG8_STAGE(PG8_SB(0, 0), cB, voffB); PG8_STAGE(PG8_SB(0, 1), cB + hstepB, voffB); PG8_STAGE(PG8_SA(0, 0), cA, voffA); PG8_STAGE(PG8_SA(0, 1), cA + hstepA, voffA);
    if (wr == 1) PG8_BAR;
    PG8_WAIT_V(2); PG8_BAR;
    PG8_STAGE(PG8_SB(1, 0), cB + kstep, voffB); PG8_STAGE(PG8_SA(1, 0), cA + kstep, voffA); PG8_STAGE(PG8_SB(1, 1), cB + hstepB + kstep, voffB);
    PG8_WAIT_V(6); PG8_BAR;
    for (;;) {
        const bool has_next = S.next(ui + 1, nxt);
        const char* nA = has_next ? (const char*)g.A + (size_t)nxt.pm * tstepA + nxt.aoff : cA; const char* nB = has_next ? (const char*)g.Bt + (size_t)nxt.pb * tstepB : cB;
        for (int t = 0; t < nt; t += 2) {
            const bool last = (t == nt - 2);
            const char* a1 = cA + (size_t)(t + 1) * kstep;
            const char* a2 = last ? nA : cA + (size_t)(t + 2) * kstep; const char* b2 = last ? nB : cB + (size_t)(t + 2) * kstep;
            const char* a3 = a2 + kstep; const char* b3 = b2 + kstep;
            PG8_LDB(B0, 0, 0); PG8_LDB(B1, 0, 1); PG8_SCHED; PG8_LDA(At, 0, 0); PG8_STAGE(PG8_SA(1, 1), a1 + hstepA, voffA);
            PG8_WAIT_V(8); PG8_WAIT_L(0); PG8_BAR; PG8_MMA(0, 0, At, B0); PG8_MMA(0, 1, At, B1); PG8_BAR; PG8_SCHED;
            PG8_LDA(At, 0, 1); PG8_STAGE(PG8_SB(0, 0), b2, voffB); PG8_STAGE(PG8_SB(0, 1), b2 + hstepB, voffB); PG8_STAGE(PG8_SA(0, 0), a2, voffA);
            PG8_WAIT_V(8); PG8_WAIT_L(0); PG8_BAR; PG8_MMA(1, 0, At, B0); PG8_MMA(1, 1, At, B1); PG8_BAR; PG8_SCHED;
            PG8_LDB(B0, 1, 0); PG8_LDB(B1, 1, 1); PG8_SCHED; PG8_LDA(At, 1, 0); PG8_STAGE(PG8_SA(0, 1), a2 + hstepA, voffA);
            PG8_WAIT_V(8); PG8_WAIT_L(0); PG8_BAR; PG8_MMA(0, 0, At, B0); PG8_MMA(0, 1, At, B1); PG8_BAR; PG8_SCHED;
            PG8_LDA(At, 1, 1); PG8_STAGE(PG8_SB(1, 0), b3, voffB); PG8_STAGE(PG8_SB(1, 1), b3 + hstepB, voffB); PG8_STAGE(PG8_SA(1, 0), a3, voffA);
            PG8_WAIT_V(8); PG8_WAIT_L(0); PG8_BAR; PG8_MMA(1, 0, At, B0); PG8_MMA(1, 1, At, B1); PG8_BAR; PG8_SCHED;
        }
        if (wr == 0) PG8_BAR;
        { unsigned on_ = ~0u; asm volatile("" : "+s"(on_)); const int lz_ = (int)__builtin_amdgcn_mbcnt_hi(on_, __builtin_amdgcn_mbcnt_lo(on_, 0u));
          E(acc, cur, wr, wc, lz_ & 15, lz_ >> 4); }
        if (!has_next) break;
#pragma unroll
        for (int a = 0; a < 2; ++a)
#pragma unroll
            for (int b = 0; b < 2; ++b)
#pragma unroll
                for (int m = 0; m < 4; ++m)
#pragma unroll
                    for (int n = 0; n < 2; ++n) acc[a][b][m][n] = (f32x4){0.f, 0.f, 0.f, 0.f};
        cur = nxt; cA = nA; cB = nB; ++ui;
        if (wr == 1) PG8_BAR;
    }
    PG8_WAIT_V(0);
    PG8_BAR;
#undef PG8_SA
#undef PG8_SB
#undef PG8_STAGE
#undef PG8_LDA
#undef PG8_LDB
#undef PG8_MMA
#undef PG8_WAIT_V
#undef PG8_WAIT_L
#undef PG8_BAR
#undef PG8_SCHED
}
}

constexpr int NTOK = 65536, DM = 1024, SEQ = 2048, NBATCH = 32, NLAYER = 4;
constexpr int PW = 3072;
constexpr int PC_AQ = 0, PC_AK = 256, PC_AV = 512, PC_BQ = 768, PC_CKV = 1024, PC_IQ = 1088, PC_IK = 1344, PC_IW = 1376,
              PC_CQ = 1384, PC_CK = 1512, PC_CV = 1640, PC_CA = 1896, PC_CG = 1912, PC_D = 2168;
constexpr int IN_W = 7096;
constexpr float LN_EPS = 1e-5f;
constexpr float DN_ALPHA = 1.6817928305074292f;
constexpr int NWAVES = 8, NTHR = 512;
constexpr int MOE_ROWS = 2 * NTOK + 32 * 256;

constexpr size_t MiB = 1u << 20;
constexpr size_t WS_CTL = 0, CTL_ZERO_BYTES = 1 * MiB;
constexpr size_t WS_TOK = 1 * MiB;
constexpr size_t WS_ROW = 3 * MiB;
constexpr size_t WS_BON = 5 * MiB;
constexpr size_t WS_RT = 6 * MiB;
constexpr size_t WS_CKVN = 8 * MiB;
constexpr size_t WS_CA = 16 * MiB;
constexpr size_t WS_W = 48 * MiB;
constexpr size_t WL_IN = 0, WL_BR = 14 * MiB, WL_OUT = 16 * MiB, WL_GU = 18 * MiB, WL_DN = 50 * MiB, WL_SIZE = 66 * MiB;
constexpr size_t WS_XB = 312 * MiB;
constexpr size_t WS_BIG = 440 * MiB;
constexpr size_t BIG_DW = 384 * MiB, BIG_DAI = 448 * MiB, BIG_DG = 480 * MiB;
constexpr size_t BIG_H = 272 * MiB;
constexpr size_t WS_END = 952 * MiB;
constexpr size_t DO_YS = 0, DO_MG = 128 * MiB, DO_DR = 128 * MiB, DO_DKP = 160 * MiB, DO_DV = 192 * MiB, DO_DKK = 224 * MiB;

constexpr int CW_TMO = 0, CW_CODE = 1;
constexpr int CW_BAR = 4096;
constexpr int CW_Q = 8192;
constexpr int CW_CNT = 16384;

constexpr int RING_BYTES = 131072;
constexpr int MISC_OFF = RING_BYTES;
constexpr int TST_OFF = MISC_OFF + 512;
constexpr int BKT_OFF = MISC_OFF + 1024;
constexpr int RPB_OFF = MISC_OFF + 3072;
constexpr int LDS_BYTES = 147456;

#define LDS_WAIT() asm volatile("s_waitcnt lgkmcnt(0)" ::: "memory")
#define VM_WAIT() asm volatile("s_waitcnt vmcnt(0)" ::: "memory")
__device__ __forceinline__ float bf2f(unsigned b) { return __uint_as_float(b << 16); }
__device__ __forceinline__ unsigned f2bf(float f) { unsigned u = __float_as_uint(f); return (u + 0x7fffu + ((u >> 16) & 1u)) >> 16; }
__device__ __forceinline__ unsigned pk2(float lo, float hi) { return f2bf(lo) | (f2bf(hi) << 16); }
__device__ __forceinline__ float bflo(unsigned w) { return __uint_as_float(w << 16); }
__device__ __forceinline__ float bfhi(unsigned w) { return __uint_as_float(w & 0xffff0000u); }
template <int CTRL> __device__ __forceinline__ float dppf(float v) {
    return __builtin_bit_cast(float, __builtin_amdgcn_update_dpp(0, __builtin_bit_cast(int, v), CTRL, 0xf, 0xf, true));
}
__device__ __forceinline__ float wave_sum(float v) {
    v += dppf<0x128>(v); v += dppf<0x124>(v); v += dppf<0x122>(v); v += dppf<0x121>(v);
    v += __shfl_xor(v, 16); v += __shfl_xor(v, 32); return v;
}
__device__ __forceinline__ float wave_max(float v) {
#pragma unroll
    for (int o = 1; o < 64; o <<= 1) v = fmaxf(v, __shfl_xor(v, o));
    return v;
}
__device__ __forceinline__ float sum8(float v) { v += dppf<0xB1>(v); v += dppf<0x4E>(v); v += dppf<0x141>(v); return v; }
__device__ __forceinline__ float sigmoidf_(float x) { return 1.f / (1.f + __expf(-x)); }
__device__ __forceinline__ float log_sigmoidf_(float z) { return fminf(z, 0.f) - log1pf(__expf(-fabsf(z))); }

#define XB_TMO      128
#define XB_XCNT(j)  (256  + 64 * (j))
#define XB_XSUB(j)  (1280 + 64 * (j))
#define XB_XGEN(j)  (2304 + 64 * (j))
#define XB_TOP      3328
#define XB_TOPGEN   3392
#define XCD_BAR_WORDS 3456
#define XB_SPIN_CAP (1u << 22)

__device__ __forceinline__ unsigned xb_ld(unsigned* p)              { return __hip_atomic_load(p, __ATOMIC_RELAXED, __HIP_MEMORY_SCOPE_AGENT); }
__device__ __forceinline__ unsigned xb_add(unsigned* p, unsigned v) { return __hip_atomic_fetch_add(p, v, __ATOMIC_RELAXED, __HIP_MEMORY_SCOPE_AGENT); }
__device__ __forceinline__ unsigned xb_xcc_id() { return (unsigned)__builtin_amdgcn_s_getreg((3 << 11) | 20) & 0xFu; }
#define XB_SPIN(cond, bar) do { unsigned _sp = 0; while (cond) { __builtin_amdgcn_s_sleep(1); \
    if ((++_sp & 255u) == 0u) { if (xb_ld(&(bar)[XB_TMO])) break; if (_sp > XB_SPIN_CAP) { atomicAdd(&(bar)[XB_TMO], 1u); break; } } } } while (0)

struct XcdBarrier { unsigned* bar; unsigned x; volatile LAS unsigned* st; };

__device__ __forceinline__ XcdBarrier xcd_barrier_post(unsigned* bar, volatile LAS unsigned* st) {
    XcdBarrier b; b.bar = bar; b.x = xb_xcc_id(); b.st = st;
    if (threadIdx.x == 0) (void)xb_add(&bar[XB_XCNT(b.x)], 1u);
    return b;
}
__device__ __forceinline__ void xcd_barrier_complete(unsigned* bar, unsigned x, unsigned& nloc, unsigned& nx) {
    const unsigned G = gridDim.x * gridDim.y * gridDim.z;
    unsigned sum, cnt, mine, sp = 0u;
    for (;;) {
        sum = 0u; cnt = 0u; mine = 0u;
#pragma unroll
        for (unsigned j = 0; j < 16; ++j) { const unsigned c = xb_ld(&bar[XB_XCNT(j)]); sum += c; cnt += (c > 0u) ? 1u : 0u; mine = (j == x) ? c : mine; }
        if (sum == G) break;
        __builtin_amdgcn_s_sleep(1);
        if ((++sp & 255u) == 0u) { if (xb_ld(&bar[XB_TMO])) break; if (sp > XB_SPIN_CAP) { atomicAdd(&bar[XB_TMO], 1u); break; } }
    }
    nloc = mine > 0u ? mine : 1u; nx = cnt > 0u ? cnt : 1u;
}
__device__ __forceinline__ void xcd_barrier(const XcdBarrier& b) {
    asm volatile("s_waitcnt vmcnt(0)" ::: "memory");
    __syncthreads();
    if (threadIdx.x == 0) {
        unsigned* bar = b.bar;
        __builtin_amdgcn_s_waitcnt(0);
        unsigned nloc = b.st[0], nx = b.st[1];
        if (nloc == 0u) { xcd_barrier_complete(bar, b.x, nloc, nx); b.st[0] = nloc; b.st[1] = nx; }
        const unsigned old = xb_add(&bar[XB_XSUB(b.x)], 1u);
        const unsigned gen = old / nloc;
        if (old + 1u == (gen + 1u) * nloc) {
            __builtin_amdgcn_fence(__ATOMIC_RELEASE, "agent");
            asm volatile("s_waitcnt vmcnt(0)" ::: "memory");
            const unsigned og = xb_add(&bar[XB_TOP], 1u);
            const unsigned tg = og / nx;
            if (og + 1u == (tg + 1u) * nx) xb_add(&bar[XB_TOPGEN], 1u);
            else XB_SPIN(xb_ld(&bar[XB_TOPGEN]) == tg, bar);
            __builtin_amdgcn_fence(__ATOMIC_ACQUIRE, "agent");
            xb_add(&bar[XB_XGEN(b.x)], 1u);
            asm volatile("s_waitcnt vmcnt(0)" ::: "memory");
        } else {
            XB_SPIN(xb_ld(&bar[XB_XGEN(b.x)]) == gen, bar);
            __builtin_amdgcn_fence(__ATOMIC_ACQUIRE, "agent");
            asm volatile("s_waitcnt vmcnt(0)" ::: "memory");
        }
    }
    __syncthreads();
}

__device__ __forceinline__ int t5_bucket(int d) {
    if (d < 16) return d;
    int b = 16;
    b += (d >= 22) + (d >= 30) + (d >= 40) + (d >= 54) + (d >= 73) + (d >= 99) + (d >= 134) + (d >= 182) + (d >= 246) + (d >= 332) + (d >= 450) + (d >= 609) + (d >= 825) + (d >= 1117) + (d >= 1513);
    return b;
}
struct Args { const float* in[30]; float* out; unsigned char* ws; int l_lo, l_hi, ph_lo, ph_hi, use_bar, pad; };

namespace pg8 {
struct EpiStoreBf16 {
    static constexpr bool PERM = true;
    bf16* O; int ldc;
    __device__ __forceinline__ void operator()(const f32x4 (&acc)[2][2][4][2], const Unit& u, int wr, int wc, int fr, int fq) const {
        const int row0 = u.pm * BM + wr * 64 + fr, col0 = u.pn * BM + wc * 32 + 8 * fq;
#pragma unroll
        for (int ai = 0; ai < 2; ++ai)
#pragma unroll
            for (int m = 0; m < 4; ++m) { bf16* rowp = O + (size_t)(row0 + ai * HALF + m * 16) * ldc + col0;
#pragma unroll
                for (int bj = 0; bj < 2; ++bj) { const f32x4 v0 = acc[ai][bj][m][0], v1 = acc[ai][bj][m][1];
                    u32x4 w; w.x = cvt_pk_bf16(v0[0], v0[1]); w.y = cvt_pk_bf16(v0[2], v0[3]); w.z = cvt_pk_bf16(v1[0], v1[1]); w.w = cvt_pk_bf16(v1[2], v1[3]);
                    *(u32x4*)(rowp + bj * HALF) = w; } }
    }
};
struct EpiGate {
    static constexpr bool PERM = false;
    const bf16* BR; bf16* MG;
    __device__ __forceinline__ void operator()(const f32x4 (&acc)[2][2][4][2], const Unit& u, int wr, int wc, int fr, int fq) const {
        const int row0 = u.pm * BM + wr * 64 + fr, j0 = u.pn * 64 + wc * 16 + 4 * fq;
#pragma unroll
        for (int ai = 0; ai < 2; ++ai)
#pragma unroll
            for (int m = 0; m < 4; ++m) { const size_t r = (size_t)(row0 + ai * HALF + m * 16);
                float mg0 = 0.f, mg1 = 0.f, mg2 = 0.f, mg3 = 0.f;
#pragma unroll
                for (int bj = 0; bj < 2; ++bj)
#pragma unroll
                    for (int n = 0; n < 2; ++n) { const int g = 2 * bj + n; const u32x2 b = *(const u32x2*)(BR + r * 4096 + g * 1024 + j0); const f32x4 a = acc[ai][bj][m][n];
                        mg0 += sigmoidf_(a[0]) * bflo(b.x); mg1 += sigmoidf_(a[1]) * bfhi(b.x); mg2 += sigmoidf_(a[2]) * bflo(b.y); mg3 += sigmoidf_(a[3]) * bfhi(b.y); }
                u32x2 w; w.x = cvt_pk_bf16(mg0, mg1); w.y = cvt_pk_bf16(mg2, mg3);
                *(u32x2*)(MG + r * 1024 + j0) = w; }
    }
};
struct EpiOut {
    static constexpr bool PERM = true;
    bf16* XB;
    __device__ __forceinline__ void operator()(const f32x4 (&acc)[2][2][4][2], const Unit& u, int wr, int wc, int fr, int fq) const {
        const int row0 = u.pm * BM + wr * 64 + fr, col0 = u.pn * BM + wc * 32 + 8 * fq;
#pragma unroll
        for (int ai = 0; ai < 2; ++ai)
#pragma unroll
            for (int m = 0; m < 4; ++m) { bf16* rowp = XB + (size_t)(row0 + ai * HALF + m * 16) * 1024 + col0;
#pragma unroll
                for (int bj = 0; bj < 2; ++bj) { const f32x4 v0 = acc[ai][bj][m][0], v1 = acc[ai][bj][m][1]; const u32x4 x = *(const u32x4*)(rowp + bj * HALF);
                    u32x4 w; w.x = cvt_pk_bf16(DN_ALPHA * bflo(x.x) + v0[0], DN_ALPHA * bfhi(x.x) + v0[1]); w.y = cvt_pk_bf16(DN_ALPHA * bflo(x.y) + v0[2], DN_ALPHA * bfhi(x.y) + v0[3]);
                    w.z = cvt_pk_bf16(DN_ALPHA * bflo(x.z) + v1[0], DN_ALPHA * bfhi(x.z) + v1[1]); w.w = cvt_pk_bf16(DN_ALPHA * bflo(x.w) + v1[2], DN_ALPHA * bfhi(x.w) + v1[3]);
                    *(u32x4*)(rowp + bj * HALF) = w; } }
    }
};
struct EpiUp {
    static constexpr bool PERM = true;
    const unsigned* rowinfo; bf16* H;
    __device__ __forceinline__ void operator()(const f32x4 (&acc)[2][2][4][2], const Unit& u, int wr, int wc, int fr, int fq) const {
        const int row0 = u.pm * BM + wr * 64 + fr, col0 = u.pn * 128 + wc * 32 + 8 * fq;
#pragma unroll
        for (int ai = 0; ai < 2; ++ai)
#pragma unroll
            for (int m = 0; m < 4; ++m) { const size_t r = (size_t)(row0 + ai * HALF + m * 16); const float w = __uint_as_float(rowinfo[2 * r + 1]);
                const f32x4 g0 = acc[ai][0][m][0], g1 = acc[ai][0][m][1], u0 = acc[ai][1][m][0], u1 = acc[ai][1][m][1];
                float h[8];
#pragma unroll
                for (int e = 0; e < 4; ++e) { h[e] = g0[e] * sigmoidf_(g0[e]) * u0[e] * w; h[4 + e] = g1[e] * sigmoidf_(g1[e]) * u1[e] * w; }
                u32x4 o; o.x = cvt_pk_bf16(h[0], h[1]); o.y = cvt_pk_bf16(h[2], h[3]); o.z = cvt_pk_bf16(h[4], h[5]); o.w = cvt_pk_bf16(h[6], h[7]);
                *(u32x4*)(H + r * 256 + col0) = o; }
    }
};
struct EpiDown {
    static constexpr bool PERM = true;
    const unsigned* rowinfo; bf16* Y;
    __device__ __forceinline__ void operator()(const f32x4 (&acc)[2][2][4][2], const Unit& u, int wr, int wc, int fr, int fq) const {
        const int row0 = u.pm * BM + wr * 64 + fr, col0 = u.pn * BM + wc * 32 + 8 * fq;
#pragma unroll
        for (int ai = 0; ai < 2; ++ai)
#pragma unroll
            for (int m = 0; m < 4; ++m) { const size_t r = (size_t)(row0 + ai * HALF + m * 16); const int ri = (int)rowinfo[2 * r];
                if (ri >= 0) { bf16* rowp = Y + ((size_t)(ri & 1) * NTOK + (size_t)(ri >> 1)) * 1024 + col0;
#pragma unroll
                    for (int bj = 0; bj < 2; ++bj) { const f32x4 v0 = acc[ai][bj][m][0], v1 = acc[ai][bj][m][1];
                        u32x4 w; w.x = cvt_pk_bf16(v0[0], v0[1]); w.y = cvt_pk_bf16(v0[2], v0[3]); w.z = cvt_pk_bf16(v1[0], v1[1]); w.w = cvt_pk_bf16(v1[2], v1[3]);
                        *(u32x4*)(rowp + bj * HALF) = w; } } }
    }
};
}

struct RowMap { int kind, base, g, off;
    __device__ __forceinline__ int operator()(int n) const {
        if (kind == 0) return base + n;
        if (kind == 1) { const int j = base + n, jj = j & 63, pn = j >> 6; return 3072 + pn * 256 + 128 * (g >> 1) + 32 * (jj >> 4) + 16 * (g & 1) + 4 * ((jj >> 2) & 3) + (jj & 3); }
        const int h = base + n; return (h >> 7) * 256 + off + (h & 127);
    }
};
__device__ __forceinline__ void transpose_item(const float* W, int ldw, int k0, int scol0, int nvalid, bf16* WT, int ldk, const RowMap& rm, LAS float* scr, int lane) {
    const int nn = lane & 31;
#pragma unroll 8
    for (int i = 0; i < 32; ++i) { const int kk = 2 * i + (lane >> 5); scr[kk * 33 + nn] = (nn < nvalid) ? W[(size_t)(k0 + kk) * ldw + scol0 + nn] : 0.f; }
    LDS_WAIT(); asm volatile("" ::: "memory");
    const int c = lane & 7;
#pragma unroll
    for (int j = 0; j < 4; ++j) { const int n = (lane >> 3) + 8 * j; const LAS float* s = scr + (8 * c) * 33 + n;
        u32x4 o; o.x = pk2(s[0 * 33], s[1 * 33]); o.y = pk2(s[2 * 33], s[3 * 33]); o.z = pk2(s[4 * 33], s[5 * 33]); o.w = pk2(s[6 * 33], s[7 * 33]);
        *(u32x4*)(WT + (size_t)rm(n) * ldk + k0 + 8 * c) = o; }
    LDS_WAIT(); asm volatile("" ::: "memory");
}
__device__ __forceinline__ void p0_prologue(const Args& a, LAS unsigned char* lds, int gw, int NGW, int wave, int lane) {
    LAS float* scr = (LAS float*)(lds + wave * 16384);
    constexpr int IPL = 16896;
    for (int it = gw; it < NLAYER * IPL; it += NGW) {
        const int l = it / IPL; int r = it - l * IPL;
        unsigned char* wl = a.ws + WS_W + (size_t)l * WL_SIZE;
        RowMap rm; rm.kind = 0; rm.base = 0; rm.g = 0; rm.off = 0;
        if (r < 1536) { const int nt = r % 96, kt = r / 96, n0 = 32 * nt; int nv = 3000 - n0; nv = nv < 0 ? 0 : (nv > 32 ? 32 : nv); rm.base = n0;
            transpose_item(a.in[2] + (size_t)l * 1024 * IN_W, IN_W, 64 * kt, n0, nv, (bf16*)(wl + WL_IN), 1024, rm, scr, lane); continue; }
        r -= 1536;
        if (r < 2048) { const int nt = r % 128, kt = r / 128, gc0 = 32 * nt; rm.kind = 1; rm.g = gc0 >> 10; rm.base = gc0 & 1023;
            transpose_item(a.in[2] + (size_t)l * 1024 * IN_W, IN_W, 64 * kt, 3000 + gc0, 32, (bf16*)(wl + WL_IN), 1024, rm, scr, lane); continue; }
        r -= 2048;
        if (r < 512) { const int nb = r / 128, rr = r % 128, nt = rr % 32, kt = rr / 32; rm.base = nb * 1024 + 32 * nt;
            if (nb != 1) transpose_item(a.in[19] + (size_t)(l * 4 + nb) * 256 * 1024, 1024, 64 * kt, 32 * nt, 32, (bf16*)(wl + WL_BR), 256, rm, scr, lane); continue; }
        r -= 512;
        if (r < 512) { const int nt = r % 32, kt = r / 32; rm.base = 32 * nt;
            transpose_item(a.in[20] + (size_t)l * 1024 * 1024, 1024, 64 * kt, 32 * nt, 32, (bf16*)(wl + WL_OUT), 1024, rm, scr, lane); continue; }
        r -= 512;
        if (r < 8192) { const int up = r >= 4096; if (up) r -= 4096; const int e = r / 128, rr = r % 128, nt = rr % 8, kt = rr / 8; rm.kind = 2; rm.base = 32 * nt; rm.off = up ? 128 : 0;
            transpose_item(a.in[up ? 28 : 27] + (size_t)(l * 32 + e) * 1024 * 256, 256, 64 * kt, 32 * nt, 32, (bf16*)(wl + WL_GU) + (size_t)e * 512 * 1024, 1024, rm, scr, lane); continue; }
        r -= 8192;
        { const int e = r / 128, rr = r % 128, nt = rr % 32, kt = rr / 32; rm.base = 32 * nt;
            transpose_item(a.in[29] + (size_t)(l * 32 + e) * 256 * 1024, 1024, 64 * kt, 32 * nt, 32, (bf16*)(wl + WL_DN) + (size_t)e * 1024 * 256, 256, rm, scr, lane); }
    }
    { float* WRT = (float*)(a.ws + WS_RT); const int gt = gw * 64 + lane, NT = NGW * 64;
      for (int i = gt; i < NLAYER * 4 * 64 * 1024; i += NT) { const int j = i & 1023, c = (i >> 10) & 63, h = (i >> 16) & 3, l = i >> 18;
          const float* wu = a.in[4] + ((size_t)(l * 4 + h) * 64 + c) * 64; const float* wb = a.in[19] + ((size_t)(l * 4 + 1) * 256 + h * 64) * 1024 + j; float acc = 0.f;
#pragma unroll 8
          for (int d = 0; d < 64; ++d) acc += wu[d] * wb[(size_t)d * 1024];
          ((bf16*)(a.ws + WS_W + (size_t)l * WL_SIZE + WL_BR))[(size_t)(1024 + j) * 256 + h * 64 + c] = (bf16)f2bf(acc); }
      for (int i = gt; i < NLAYER * 36 * 1024; i += NT) { const int k = i & 1023, e = (i >> 10) % 36, l = i / (36 * 1024);
          WRT[i] = e < 4 ? a.in[23][((size_t)l * 1024 + k) * 4 + e] : a.in[25][((size_t)l * 1024 + k) * 32 + (e - 4)]; }
      const f32x4* xs = (const f32x4*)a.in[0]; u32x4* xd = (u32x4*)(a.ws + WS_XB);
      for (int i = gt; i < NTOK * DM / 8; i += NT) { const f32x4 v0 = xs[2 * i], v1 = xs[2 * i + 1]; u32x4 o; o.x = pk2(v0[0], v0[1]); o.y = pk2(v0[2], v0[3]); o.z = pk2(v1[0], v1[1]); o.w = pk2(v1[2], v1[3]); xd[i] = o; } }
}

__device__ __forceinline__ float softplusf_(float x) { return fmaxf(x, 0.f) + log1pf(__expf(-fabsf(x))); }
__device__ __forceinline__ void prep_phase(const Args& a, int l, LAS unsigned char* lds, int tid, int gw, int NGW, int lane) {
    const bf16* P = (const bf16*)(a.ws + WS_BIG);
    bf16* CKVN = (bf16*)(a.ws + WS_CKVN); float* CA = (float*)(a.ws + WS_CA); float* BON = (float*)(a.ws + WS_BON);
    bf16* DR = (bf16*)((unsigned char*)a.out + DO_DR); bf16* DKP = (bf16*)((unsigned char*)a.out + DO_DKP); bf16* DV = (bf16*)((unsigned char*)a.out + DO_DV); bf16* DKK = (bf16*)((unsigned char*)a.out + DO_DKK);
    float* DW = (float*)(a.ws + WS_BIG + BIG_DW); bf16* DAI = (bf16*)(a.ws + WS_BIG + BIG_DAI); bf16* DG = (bf16*)(a.ws + WS_BIG + BIG_DG);
    const float* kvg = a.in[3] + l * 64; const float* aup = a.in[5] + l * 16 * 128; const float* abias = a.in[6] + l * 128;
    const float* mu = a.in[8] + l * 832; const float* w0 = a.in[9] + l * 256; const float* w2 = a.in[10] + l * 16 * 256; const float* a0 = a.in[11] + l * 256;
    const float* a2 = a.in[12] + l * 16 * 256; const float* g2 = a.in[13] + l * 32 * 256; const float* kkw = a.in[14] + l * 256; const float* kaw = a.in[15] + l * 256; const float* rkw = a.in[16] + l * 256;
    LAS float* sW2 = (LAS float*)lds; LAS float* sA2 = (LAS float*)(lds + 16384); LAS float* sG2 = (LAS float*)(lds + 32768); LAS float* sUP = (LAS float*)(lds + 65536);
    for (int i = tid; i < 4096; i += NTHR) { sW2[i] = w2[i]; sA2[i] = a2[i]; }
    for (int i = tid; i < 8192; i += NTHR) sG2[i] = g2[i];
    for (int i = tid; i < 2048; i += NTHR) sUP[i] = aup[i];
    __syncthreads();
    float mu_r[13], w0_r[4], a0_r[4], kk_r[4], ka_r[4], rk_r[4];
#pragma unroll
    for (int i = 0; i < 13; ++i) mu_r[i] = mu[64 * i + lane];
#pragma unroll
    for (int i = 0; i < 4; ++i) { const int c = 64 * i + lane; w0_r[i] = w0[c]; a0_r[i] = a0[c]; kk_r[i] = kkw[c]; ka_r[i] = kaw[c]; rk_r[i] = rkw[c]; }
    const float kvg_r = kvg[lane], ab0 = abias[lane], ab1 = abias[64 + lane];
    unsigned short nc[13], np_[13], nckv, nca;
#define PREP_LOAD(mm) do { const int tt_ = (mm) & (SEQ - 1); const bf16* pr_ = P + (size_t)(mm) * PW; const bf16* pp_ = pr_ - (tt_ > 0 ? PW : 0); \
        _Pragma("unroll") for (int i = 0; i < 13; ++i) { nc[i] = pr_[PC_D + 64 * i + lane]; np_[i] = pp_[PC_D + 64 * i + lane]; } nckv = pr_[PC_CKV + lane]; nca = pr_[PC_CA + (lane & 15)]; } while (0)
    if (gw < NTOK) PREP_LOAD(gw);
    for (int m = gw; m < NTOK; m += NGW) {
        const int t = m & (SEQ - 1);
        unsigned short cc_[13], cp_[13];
#pragma unroll
        for (int i = 0; i < 13; ++i) { cc_[i] = nc[i]; cp_[i] = np_[i]; }
        const unsigned short cckv = nckv, cca = nca;
        if (m + NGW < NTOK) PREP_LOAD(m + NGW);
        { const float x = bf2f(cckv); const float ss = wave_sum(x * x); const float rn = rsqrtf(ss * (1.f / 64.f) + 1e-6f); CKVN[(size_t)m * 64 + lane] = (bf16)f2bf(x * rn * kvg_r); }
        { const float cav = (lane < 16) ? bf2f(cca) : 0.f; float z0 = ab0, z1 = ab1;
#pragma unroll
          for (int i = 0; i < 16; ++i) { const float cv = __shfl(cav, i); z0 += cv * sUP[i * 128 + lane]; z1 += cv * sUP[i * 128 + 64 + lane]; }
          CA[(size_t)m * 128 + lane] = __expf(log_sigmoidf_(z0) * (1.f / 16.f)); CA[(size_t)m * 128 + 64 + lane] = __expf(log_sigmoidf_(z1) * (1.f / 16.f)); }
        float xs[13];
#pragma unroll
        for (int i = 0; i < 13; ++i) { const float cur = bf2f(cc_[i]); const float prev = (t > 0) ? bf2f(cp_[i]) : 0.f; xs[i] = cur + (prev - cur) * mu_r[i]; }
        const float low = xs[12], tw = tanhf(low), sg = sigmoidf_(low);
        float wr_[4], ar_[4], gv_[4];
#pragma unroll
        for (int i = 0; i < 4; ++i) { wr_[i] = w0_r[i]; ar_[i] = a0_r[i]; gv_[i] = 0.f; }
#pragma unroll 4
        for (int j = 0; j < 16; ++j) { const float tj = __shfl(tw, j), aj = __shfl(low, 16 + j);
#pragma unroll
            for (int i = 0; i < 4; ++i) { wr_[i] += tj * sW2[j * 256 + 64 * i + lane]; ar_[i] += aj * sA2[j * 256 + 64 * i + lane]; } }
#pragma unroll 4
        for (int j = 0; j < 32; ++j) { const float sj = __shfl(sg, 32 + j);
#pragma unroll
            for (int i = 0; i < 4; ++i) gv_[i] += sj * sG2[j * 256 + 64 * i + lane]; }
#pragma unroll
        for (int i = 0; i < 4; ++i) { const int c = 64 * i + lane;
            const float w_raw = -softplusf_(-wr_[i]) - 0.5f, wdec = __expf(-__expf(w_raw));
            const float av = sigmoidf_(ar_[i]);
            const float kx = xs[4 + i]; float kkv = kx * kk_r[i]; const float nrm = sqrtf(wave_sum(kkv * kkv)); kkv = kkv / fmaxf(nrm, 1e-12f);
            const float kp = kx * (1.f + (av - 1.f) * ka_r[i]);
            const float rx = xs[i], vx = xs[8 + i];
            const float bon = wave_sum(rx * kp * rk_r[i]);
            const size_t o = (size_t)m * 256 + c;
            DR[o] = (bf16)f2bf(rx); DKP[o] = (bf16)f2bf(kp); DV[o] = (bf16)f2bf(vx); DKK[o] = (bf16)f2bf(kkv); DW[o] = wdec; DAI[o] = (bf16)f2bf(kkv * av);     DG[o] = (bf16)f2bf(gv_[i]);
            if (lane == 0) BON[(size_t)m * 4 + i] = bon; }
    }
#undef PREP_LOAD
    __syncthreads();
}

__device__ __forceinline__ void dscan_item(const Args& a, int l, int bh, LAS unsigned char* lds, int tid) {
    const int b = bh >> 2, h = bh & 3, wv = tid >> 6, lane = tid & 63, row = wv * 8 + (lane >> 3), part = lane & 7;
    LAS bf16* sKK = (LAS bf16*)(lds); LAS bf16* sAI = (LAS bf16*)(lds + 8192); LAS bf16* sKP = (LAS bf16*)(lds + 16384); LAS bf16* sR = (LAS bf16*)(lds + 24576); LAS bf16* sV = (LAS bf16*)(lds + 32768);
    LAS float* sW = (LAS float*)(lds + 40960); LAS float* sY = (LAS float*)(lds + 57344);
    const bf16* DR = (const bf16*)((unsigned char*)a.out + DO_DR); const bf16* DKP = (const bf16*)((unsigned char*)a.out + DO_DKP); const bf16* DV = (const bf16*)((unsigned char*)a.out + DO_DV); const bf16* DKK = (const bf16*)((unsigned char*)a.out + DO_DKK);
    const float* DW = (const float*)(a.ws + WS_BIG + BIG_DW); const bf16* DAI = (const bf16*)(a.ws + WS_BIG + BIG_DAI); const bf16* DG = (const bf16*)(a.ws + WS_BIG + BIG_DG);
    const float* BON = (const float*)(a.ws + WS_BON); bf16* YS = (bf16*)((unsigned char*)a.out + DO_YS);
    const float* gnw = a.in[17] + l * 256 + h * 64; const float* gnb = a.in[18] + l * 256 + h * 64;
    const int ls = tid >> 3, lseg = tid & 7;
    const size_t gbase = ((size_t)b * SEQ) * 256 + h * 64 + 8 * lseg;
    f32x2 S2[4];
#pragma unroll
    for (int j = 0; j < 4; ++j) S2[j] = (f32x2){0.f, 0.f};
    u32x4 rKK, rAI, rKP, rR, rV; f32x4 rW0, rW1;
#define DS_LOAD(ch) do { const size_t gi = gbase + (size_t)((ch) * 64 + ls) * 256; rKK = *(const u32x4*)(DKK + gi); rAI = *(const u32x4*)(DAI + gi); rKP = *(const u32x4*)(DKP + gi); \
        rR = *(const u32x4*)(DR + gi); rV = *(const u32x4*)(DV + gi); rW0 = *(const f32x4*)(DW + gi); rW1 = *(const f32x4*)(DW + gi + 4); } while (0)
#define DS_STORE() do { const int li = ls * 64 + 8 * lseg; *(LAS u32x4*)(sKK + li) = rKK; *(LAS u32x4*)(sAI + li) = rAI; *(LAS u32x4*)(sKP + li) = rKP; *(LAS u32x4*)(sR + li) = rR; *(LAS u32x4*)(sV + li) = rV; \
        *(LAS f32x4*)(sW + li) = rW0; *(LAS f32x4*)(sW + li + 4) = rW1; } while (0)
    DS_LOAD(0); DS_STORE(); __syncthreads();
    for (int ch = 0; ch < SEQ / 64; ++ch) {
        if (ch + 1 < SEQ / 64) DS_LOAD(ch + 1);
#pragma unroll 2
        for (int s = 0; s < 64; ++s) {
            const int li = s * 64 + 8 * part;
            const u32x4 kk4 = *(const LAS u32x4*)(sKK + li), ai4 = *(const LAS u32x4*)(sAI + li), kp4 = *(const LAS u32x4*)(sKP + li), r4 = *(const LAS u32x4*)(sR + li);
            const f32x4 w0 = *(const LAS f32x4*)(sW + li), w1 = *(const LAS f32x4*)(sW + li + 4);
            const float vrow = bf2f(sV[s * 64 + row]);
#define UNPK(W) ((f32x2){bflo(W), bfhi(W)})
            const f32x2 kk2[4] = {UNPK(kk4.x), UNPK(kk4.y), UNPK(kk4.z), UNPK(kk4.w)}, bb2[4] = {UNPK(ai4.x), UNPK(ai4.y), UNPK(ai4.z), UNPK(ai4.w)};
            const f32x2 kp2[4] = {UNPK(kp4.x), UNPK(kp4.y), UNPK(kp4.z), UNPK(kp4.w)}, rr2[4] = {UNPK(r4.x), UNPK(r4.y), UNPK(r4.z), UNPK(r4.w)};
            const f32x2 ww2[4] = {__builtin_shufflevector(w0, w0, 0, 1), __builtin_shufflevector(w0, w0, 2, 3), __builtin_shufflevector(w1, w1, 0, 1), __builtin_shufflevector(w1, w1, 2, 3)};
#undef UNPK
            f32x2 sacc = S2[0] * kk2[0]; sacc += S2[1] * kk2[1]; sacc += S2[2] * kk2[2]; sacc += S2[3] * kk2[3];
            const float sa = -sum8(sacc[0] + sacc[1]);
            const f32x2 sa2 = (f32x2){sa, sa}, v2 = (f32x2){vrow, vrow};
            f32x2 yacc = (f32x2){0.f, 0.f};
#pragma unroll
            for (int j = 0; j < 4; ++j) { S2[j] = S2[j] * ww2[j] + (sa2 * bb2[j] + v2 * kp2[j]); yacc += S2[j] * rr2[j]; }
            float y = yacc[0] + yacc[1];
            y = sum8(y);
            if (part == 0) sY[s * 64 + row] = y;
        }
        __syncthreads();
        {
            const int li = ls * 64 + 8 * lseg; const f32x4 y0 = *(const LAS f32x4*)(sY + li), y1 = *(const LAS f32x4*)(sY + li + 4); const u32x4 v4 = *(const LAS u32x4*)(sV + li);
            const float yv[8] = {y0[0], y0[1], y0[2], y0[3], y1[0], y1[1], y1[2], y1[3]};
            const float vv[8] = {bflo(v4.x), bfhi(v4.x), bflo(v4.y), bfhi(v4.y), bflo(v4.z), bfhi(v4.z), bflo(v4.w), bfhi(v4.w)};
            float sm = 0.f;
#pragma unroll
            for (int j = 0; j < 8; ++j) sm += yv[j];
            const float mean = sum8(sm) * (1.f / 64.f); float sq = 0.f;
#pragma unroll
            for (int j = 0; j < 8; ++j) { const float d = yv[j] - mean; sq += d * d; }
            const float rstd = rsqrtf(sum8(sq) * (1.f / 64.f) + 64e-5f);
            const size_t m = (size_t)b * SEQ + ch * 64 + ls; const float bon = BON[m * 4 + h];
            const u32x4 g4 = *(const u32x4*)(DG + m * 256 + h * 64 + 8 * lseg);
            const float gg[8] = {bflo(g4.x), bfhi(g4.x), bflo(g4.y), bfhi(g4.y), bflo(g4.z), bfhi(g4.z), bflo(g4.w), bfhi(g4.w)};
            float o[8];
#pragma unroll
            for (int j = 0; j < 8; ++j) o[j] = ((yv[j] - mean) * rstd * gnw[8 * lseg + j] + gnb[8 * lseg + j] + bon * vv[j]) * gg[j];
            u32x4 w; w.x = pk2(o[0], o[1]); w.y = pk2(o[2], o[3]); w.z = pk2(o[4], o[5]); w.w = pk2(o[6], o[7]);
            *(u32x4*)(YS + m * 1024 + 768 + h * 64 + 8 * lseg) = w;
        }
        __syncthreads();
        if (ch + 1 < SEQ / 64) DS_STORE();
        __syncthreads();
    }
#undef DS_LOAD
#undef DS_STORE
}
__device__ __forceinline__ void cscan_item(const Args& a, int l, int bh, LAS unsigned char* lds, int tid) {
    const int b = bh >> 2, h = bh & 3, wv = tid >> 6, lane = tid & 63, row = wv * 8 + (lane >> 3), part = lane & 7;
    LAS bf16* sQ = (LAS bf16*)(lds); LAS bf16* sK = (LAS bf16*)(lds + 4096); LAS bf16* sV = (LAS bf16*)(lds + 8192); LAS float* sA = (LAS float*)(lds + 16384); LAS float* sY = (LAS float*)(lds + 24576);
    const bf16* P = (const bf16*)(a.ws + WS_BIG); const float* CA = (const float*)(a.ws + WS_CA); bf16* YS = (bf16*)((unsigned char*)a.out + DO_YS);
    const float* ng = a.in[7] + l * 256 + h * 64;
    const int ls = tid >> 3, lseg = tid & 7;
    const size_t tok0 = (size_t)b * SEQ;
    float S[4] = {0.f, 0.f, 0.f, 0.f};
    u32x4 rQK, rV; f32x4 rA;
    const int qs = (tid & 255) >> 2, qseg = tid & 3, isk = tid >> 8;
#define CS_LOAD(ch) do { const size_t tq = tok0 + (ch) * 64 + qs; rQK = *(const u32x4*)(P + tq * PW + (isk ? PC_CK : PC_CQ) + h * 32 + 8 * qseg); \
        const size_t tv = tok0 + (ch) * 64 + ls; rV = *(const u32x4*)(P + tv * PW + PC_CV + h * 64 + 8 * lseg); rA = *(const f32x4*)(CA + tv * 128 + h * 32 + 4 * lseg); } while (0)
#define CS_STORE() do { *(LAS u32x4*)((isk ? sK : sQ) + qs * 32 + 8 * qseg) = rQK; *(LAS u32x4*)(sV + ls * 64 + 8 * lseg) = rV; *(LAS f32x4*)(sA + ls * 32 + 4 * lseg) = rA; } while (0)
    CS_LOAD(0); CS_STORE(); __syncthreads();
    for (int ch = 0; ch < SEQ / 64; ++ch) {
        if (ch + 1 < SEQ / 64) CS_LOAD(ch + 1);
#pragma unroll 2
        for (int s = 0; s < 64; ++s) {
            const u32x2 q2 = *(const LAS u32x2*)(sQ + s * 32 + 4 * part), k2 = *(const LAS u32x2*)(sK + s * 32 + 4 * part); const f32x4 a4 = *(const LAS f32x4*)(sA + s * 32 + 4 * part);
            const float vrow = bf2f(sV[s * 64 + row]);
            const float qq[4] = {bflo(q2.x), bfhi(q2.x), bflo(q2.y), bfhi(q2.y)}; const float kk[4] = {bflo(k2.x), bfhi(k2.x), bflo(k2.y), bfhi(k2.y)};
            float o = 0.f;
#pragma unroll
            for (int j = 0; j < 4; ++j) { S[j] = a4[j] * S[j] + kk[j] * vrow; o += qq[j] * S[j]; }
            o = sum8(o) * 0.17677669529663687f;
            if (part == 0) sY[s * 64 + row] = o;
        }
        __syncthreads();
        { const int li = ls * 64 + 8 * lseg; const f32x4 y0 = *(const LAS f32x4*)(sY + li), y1 = *(const LAS f32x4*)(sY + li + 4);
            const float yv[8] = {y0[0], y0[1], y0[2], y0[3], y1[0], y1[1], y1[2], y1[3]};
            float sq = 0.f;
#pragma unroll
            for (int j = 0; j < 8; ++j) sq += yv[j] * yv[j];
            const float rn = rsqrtf(sum8(sq) * (1.f / 64.f) + 1e-6f);
            const size_t m = tok0 + ch * 64 + ls; const u32x4 g4 = *(const u32x4*)(P + m * PW + PC_CG + h * 64 + 8 * lseg);
            const float gg[8] = {bflo(g4.x), bfhi(g4.x), bflo(g4.y), bfhi(g4.y), bflo(g4.z), bfhi(g4.z), bflo(g4.w), bfhi(g4.w)};
            float o[8];
#pragma unroll
            for (int j = 0; j < 8; ++j) o[j] = gg[j] * sigmoidf_(gg[j]) * (yv[j] * rn * ng[8 * lseg + j]);
            u32x4 w; w.x = pk2(o[0], o[1]); w.y = pk2(o[2], o[3]); w.z = pk2(o[4], o[5]); w.w = pk2(o[6], o[7]);
            *(u32x4*)(YS + m * 1024 + 512 + h * 64 + 8 * lseg) = w; }
        __syncthreads();
        if (ch + 1 < SEQ / 64) CS_STORE();
        __syncthreads();
    }
#undef CS_LOAD
#undef CS_STORE
}
__device__ __forceinline__ void mixA_item(const Args& a, int m, LAS unsigned char* lds, int lane_in) {
    int lane = lane_in; asm volatile("" : "+v"(lane));
    const bf16* P = (const bf16*)(a.ws + WS_BIG); bf16* YS = (bf16*)((unsigned char*)a.out + DO_YS);
    const LAS unsigned char* bkt = lds + BKT_OFF; const LAS float* rpb = (const LAS float*)(lds + RPB_OFF);
    const int t = m & (SEQ - 1); const size_t rowb = (size_t)(m - t); const int hh = lane & 3;
    float q[64];
    { const u32x4* qp = (const u32x4*)(P + (size_t)m * PW + PC_AQ + hh * 64);
#pragma unroll
      for (int i = 0; i < 8; ++i) { const u32x4 w = qp[i]; q[8 * i + 0] = bflo(w.x) * 0.125f; q[8 * i + 1] = bfhi(w.x) * 0.125f; q[8 * i + 2] = bflo(w.y) * 0.125f; q[8 * i + 3] = bfhi(w.y) * 0.125f;
          q[8 * i + 4] = bflo(w.z) * 0.125f; q[8 * i + 5] = bfhi(w.z) * 0.125f; q[8 * i + 6] = bflo(w.w) * 0.125f; q[8 * i + 7] = bfhi(w.w) * 0.125f; } }
    float sc[25]; float mx = -INFINITY;
#pragma unroll
    for (int i = 0; i < 25; ++i) { const int e = (lane >> 2) + 16 * i; const int p = (e >= 258) ? 2 : (e >= 129 ? 1 : 0); const int j = e - 129 * p; const int s = t - (j << (2 * p));
        float v = -INFINITY;
        if (e < 387 && s >= 0) { const u32x4* kp = (const u32x4*)(P + (rowb + s) * PW + PC_AK + hh * 64); float d = 0.f;
#pragma unroll
            for (int c = 0; c < 8; ++c) { const u32x4 w = kp[c]; d += q[8 * c] * bflo(w.x) + q[8 * c + 1] * bfhi(w.x) + q[8 * c + 2] * bflo(w.y) + q[8 * c + 3] * bfhi(w.y) + q[8 * c + 4] * bflo(w.z) + q[8 * c + 5] * bfhi(w.z) + q[8 * c + 6] * bflo(w.w) + q[8 * c + 7] * bfhi(w.w); }
            v = d + rpb[bkt[t - s] * 8 + hh]; }
        sc[i] = v; mx = fmaxf(mx, v); }
    mx = fmaxf(mx, __shfl_xor(mx, 4)); mx = fmaxf(mx, __shfl_xor(mx, 8)); mx = fmaxf(mx, __shfl_xor(mx, 16)); mx = fmaxf(mx, __shfl_xor(mx, 32));
    float den = 0.f;
#pragma unroll
    for (int i = 0; i < 25; ++i) { sc[i] = __expf(sc[i] - mx); den += sc[i]; }
    den += __shfl_xor(den, 4); den += __shfl_xor(den, 8); den += __shfl_xor(den, 16); den += __shfl_xor(den, 32);
    const int h2 = lane >> 4, cq = lane & 15;
    float acc0 = 0.f, acc1 = 0.f, acc2 = 0.f, acc3 = 0.f;
#pragma unroll
    for (int i = 0; i < 25; ++i) {
#pragma unroll 1
        for (int el = 0; el < 16; ++el) { const int e = 16 * i + el; const int p = (e >= 258) ? 2 : (e >= 129 ? 1 : 0); const int j = e - 129 * p; const int s = t - (j << (2 * p));
            if (e < 387 && s >= 0) { const float pe = __shfl(sc[i], 4 * el + h2); const u32x2 w = *(const u32x2*)(P + (rowb + s) * PW + PC_AV + h2 * 64 + 4 * cq);
                acc0 += pe * bflo(w.x); acc1 += pe * bfhi(w.x); acc2 += pe * bflo(w.y); acc3 += pe * bfhi(w.y); } } }
    const float rd = 1.f / __shfl(den, h2);
    u32x2 o; o.x = pk2(acc0 * rd, acc1 * rd); o.y = pk2(acc2 * rd, acc3 * rd);
    *(u32x2*)(YS + (size_t)m * 1024 + h2 * 64 + 4 * cq) = o;
}
__device__ __forceinline__ float wsum_dpp(float v) {
    v += dppf<0x128>(v); v += dppf<0x124>(v); v += dppf<0x122>(v); v += dppf<0x121>(v);
    v += __shfl_xor(v, 16); v += __shfl_xor(v, 32); return v;
}
__device__ __forceinline__ void dscan_wave(const Args& a, int l, int bh, LAS unsigned char* wscr, int lane_in) {
    int lane = lane_in; asm volatile("" : "+v"(lane));
    const int b = bh >> 2, h = bh & 3;
    LAS float* sA = (LAS float*)wscr; LAS float* sW = (LAS float*)(wscr + 2048); LAS float* sB = (LAS float*)(wscr + 4096); LAS float* sKP = (LAS float*)(wscr + 6144); LAS float* sR = (LAS float*)(wscr + 8192);
    LAS bf16* sV = (LAS bf16*)(wscr + 10240); LAS bf16* sG = (LAS bf16*)(wscr + 11264); LAS float* sBon = (LAS float*)(wscr + 12288);
    const bf16* DR = (const bf16*)((unsigned char*)a.out + DO_DR); const bf16* DKP = (const bf16*)((unsigned char*)a.out + DO_DKP); const bf16* DV = (const bf16*)((unsigned char*)a.out + DO_DV); const bf16* DKK = (const bf16*)((unsigned char*)a.out + DO_DKK);
    const float* DW = (const float*)(a.ws + WS_BIG + BIG_DW); const bf16* DAI = (const bf16*)(a.ws + WS_BIG + BIG_DAI); const bf16* DG = (const bf16*)(a.ws + WS_BIG + BIG_DG);
    const float* BON = (const float*)(a.ws + WS_BON); bf16* YS = (bf16*)((unsigned char*)a.out + DO_YS);
    const float gnw = a.in[17][l * 256 + h * 64 + lane], gnb = a.in[18][l * 256 + h * 64 + lane];
    const size_t tok0 = (size_t)b * SEQ; const size_t g0 = tok0 * 256 + h * 64 + lane;
    f32x2 S2[32];
#pragma unroll
    for (int k = 0; k < 32; ++k) S2[k] = (f32x2){0.f, 0.f};
    __builtin_amdgcn_s_setprio(3);
    unsigned short rk[8], ra[8], rp[8], rr[8], rv[8], rg[8]; float rw[8]; float rbon;
#define DW_LOAD(ch) do { _Pragma("unroll") for (int j = 0; j < 8; ++j) { const size_t gi = g0 + (size_t)((ch) * 8 + j) * 256; rk[j] = DKK[gi]; ra[j] = DAI[gi]; rp[j] = DKP[gi]; rr[j] = DR[gi]; rw[j] = DW[gi]; rv[j] = DV[gi]; rg[j] = DG[gi]; } \
        rbon = BON[(tok0 + (ch) * 8 + (lane & 7)) * 4 + h]; } while (0)
#define DW_STORE() do { _Pragma("unroll") for (int j = 0; j < 8; ++j) { const float kkf = bf2f(rk[j]); sA[j * 64 + lane] = -kkf; sW[j * 64 + lane] = rw[j]; sB[j * 64 + lane] = kkf * bf2f(ra[j]); sKP[j * 64 + lane] = bf2f(rp[j]); \
        sR[j * 64 + lane] = bf2f(rr[j]); sV[j * 64 + lane] = rv[j]; sG[j * 64 + lane] = rg[j]; } if (lane < 8) sBon[lane] = rbon; } while (0)
    DW_LOAD(0);
#pragma unroll 1
    for (int ch = 0; ch < SEQ / 8; ++ch) {
        asm volatile("s_waitcnt lgkmcnt(0)" ::: "memory");
        DW_STORE();
        if (ch + 1 < SEQ / 8) DW_LOAD(ch + 1);
        asm volatile("s_waitcnt lgkmcnt(0)" ::: "memory");
        float y8[8], v8[8];
#pragma unroll
        for (int j = 0; j < 8; ++j) {
            const float vrow = bf2f(sV[j * 64 + lane]); v8[j] = vrow;
            f32x4 bufA[4], bufB[4];
#define RD_SA(DST, QB) do { _Pragma("unroll") for (int i = 0; i < 4; ++i) DST[i] = *(const LAS f32x4*)(sA + j * 64 + 4 * (4 * (QB) + i)); } while (0)
#define RD_UP(DST, QB) do { DST[0] = *(const LAS f32x4*)(sW + j * 64 + 4 * (QB)); DST[1] = *(const LAS f32x4*)(sB + j * 64 + 4 * (QB)); DST[2] = *(const LAS f32x4*)(sKP + j * 64 + 4 * (QB)); DST[3] = *(const LAS f32x4*)(sR + j * 64 + 4 * (QB)); } while (0)
#define DO_SA(SRC, QB) do { _Pragma("unroll") for (int i = 0; i < 4; ++i) { const int q_ = 4 * (QB) + i; sc0 += S2[2 * q_] * __builtin_shufflevector(SRC[i], SRC[i], 0, 1); sc1 += S2[2 * q_ + 1] * __builtin_shufflevector(SRC[i], SRC[i], 2, 3); } } while (0)
#define DO_UP(SRC, QB) do { const int q_ = (QB); const f32x4 w_ = SRC[0], b_ = SRC[1], p_ = SRC[2], r_ = SRC[3]; \
                S2[2 * q_] = S2[2 * q_] * __builtin_shufflevector(w_, w_, 0, 1) + (sa2 * __builtin_shufflevector(b_, b_, 0, 1) + v2 * __builtin_shufflevector(p_, p_, 0, 1)); \
                S2[2 * q_ + 1] = S2[2 * q_ + 1] * __builtin_shufflevector(w_, w_, 2, 3) + (sa2 * __builtin_shufflevector(b_, b_, 2, 3) + v2 * __builtin_shufflevector(p_, p_, 2, 3)); \
                yc0 += S2[2 * q_] * __builtin_shufflevector(r_, r_, 0, 1); yc1 += S2[2 * q_ + 1] * __builtin_shufflevector(r_, r_, 2, 3); } while (0)
#define SB_ __builtin_amdgcn_sched_barrier(0)
            f32x2 sc0 = (f32x2){0.f, 0.f}, sc1 = (f32x2){0.f, 0.f};
            RD_SA(bufA, 0); SB_; RD_SA(bufB, 1); SB_; DO_SA(bufA, 0); SB_; RD_SA(bufA, 2); SB_; DO_SA(bufB, 1); SB_; RD_SA(bufB, 3); SB_; DO_SA(bufA, 2); SB_; RD_UP(bufA, 0); SB_; DO_SA(bufB, 3); SB_;
            const float sa = (sc0[0] + sc0[1]) + (sc1[0] + sc1[1]);
            const f32x2 sa2 = (f32x2){sa, sa}, v2 = (f32x2){vrow, vrow};
            f32x2 yc0 = (f32x2){0.f, 0.f}, yc1 = (f32x2){0.f, 0.f};
#pragma unroll
            for (int qq = 0; qq < 16; qq += 2) { RD_UP(bufB, qq + 1); SB_; DO_UP(bufA, qq); SB_; if (qq + 2 < 16) RD_UP(bufA, qq + 2); SB_; DO_UP(bufB, qq + 1); SB_; }
#undef RD_SA
#undef RD_UP
#undef DO_SA
#undef DO_UP
#undef SB_
            y8[j] = (yc0[0] + yc0[1]) + (yc1[0] + yc1[1]);
        }
        float mean8[8], d8[8], var8[8];
#pragma unroll
        for (int j = 0; j < 8; ++j) mean8[j] = wsum_dpp(y8[j]) * (1.f / 64.f);
#pragma unroll
        for (int j = 0; j < 8; ++j) { d8[j] = y8[j] - mean8[j]; var8[j] = wsum_dpp(d8[j] * d8[j]) * (1.f / 64.f); }
#pragma unroll
        for (int j = 0; j < 8; ++j) { const float rstd = rsqrtf(var8[j] + 64e-5f); const float o = (d8[j] * rstd * gnw + gnb + sBon[j] * v8[j]) * bf2f(sG[j * 64 + lane]);
            YS[(tok0 + ch * 8 + j) * 1024 + 768 + h * 64 + lane] = (bf16)f2bf(o); }
    }
    __builtin_amdgcn_s_setprio(0);
#undef DW_LOAD
#undef DW_STORE
}
__device__ __forceinline__ void cscan_wave(const Args& a, int l, int bh, LAS unsigned char* wscr, int lane_in) {
    int lane = lane_in; asm volatile("" : "+v"(lane));
    const int b = bh >> 2, h = bh & 3;
    LAS float* sQ = (LAS float*)wscr; LAS float* sK = (LAS float*)(wscr + 1024); LAS float* sAd = (LAS float*)(wscr + 2048);
    LAS bf16* sV = (LAS bf16*)(wscr + 3072); LAS bf16* sOG = (LAS bf16*)(wscr + 4096);
    const bf16* P = (const bf16*)(a.ws + WS_BIG); const float* CA = (const float*)(a.ws + WS_CA); bf16* YS = (bf16*)((unsigned char*)a.out + DO_YS);
    const float ng = a.in[7][l * 256 + h * 64 + lane];
    const size_t tok0 = (size_t)b * SEQ; const int l31 = lane & 31; const int qkcol = (lane < 32 ? PC_CQ : PC_CK) + h * 32 + l31;
    f32x2 S2[16];
#pragma unroll
    for (int k = 0; k < 16; ++k) S2[k] = (f32x2){0.f, 0.f};
    __builtin_amdgcn_s_setprio(3);
    unsigned short rqk[8], rv[8], rog[8]; float ra[8];
#define CW_LOAD(ch) do { _Pragma("unroll") for (int j = 0; j < 8; ++j) { const size_t tk = tok0 + (ch) * 8 + j; const bf16* pr = P + tk * PW; rqk[j] = pr[qkcol]; rv[j] = pr[PC_CV + h * 64 + lane]; rog[j] = pr[PC_CG + h * 64 + lane]; \
        ra[j] = CA[tk * 128 + h * 32 + l31]; } } while (0)
#define CW_STORE() do { _Pragma("unroll") for (int j = 0; j < 8; ++j) { (lane < 32 ? sQ : sK)[j * 32 + l31] = bf2f(rqk[j]); if (lane < 32) sAd[j * 32 + l31] = ra[j]; sV[j * 64 + lane] = rv[j]; sOG[j * 64 + lane] = rog[j]; } } while (0)
    CW_LOAD(0);
#pragma unroll 1
    for (int ch = 0; ch < SEQ / 8; ++ch) {
        asm volatile("s_waitcnt lgkmcnt(0)" ::: "memory");
        CW_STORE();
        if (ch + 1 < SEQ / 8) CW_LOAD(ch + 1);
        asm volatile("s_waitcnt lgkmcnt(0)" ::: "memory");
#pragma unroll 1
        for (int j = 0; j < 8; ++j) {
            const float vrow = bf2f(sV[j * 64 + lane]);
            const f32x2 v2 = (f32x2){vrow, vrow}; f32x2 oc0 = (f32x2){0.f, 0.f}, oc1 = (f32x2){0.f, 0.f};
#pragma unroll
            for (int q = 0; q < 8; ++q) { const f32x4 a4 = *(const LAS f32x4*)(sAd + j * 32 + 4 * q), k4 = *(const LAS f32x4*)(sK + j * 32 + 4 * q), q4 = *(const LAS f32x4*)(sQ + j * 32 + 4 * q);
                S2[2 * q] = __builtin_shufflevector(a4, a4, 0, 1) * S2[2 * q] + __builtin_shufflevector(k4, k4, 0, 1) * v2; S2[2 * q + 1] = __builtin_shufflevector(a4, a4, 2, 3) * S2[2 * q + 1] + __builtin_shufflevector(k4, k4, 2, 3) * v2;
                oc0 += __builtin_shufflevector(q4, q4, 0, 1) * S2[2 * q]; oc1 += __builtin_shufflevector(q4, q4, 2, 3) * S2[2 * q + 1]; }
            const float o = ((oc0[0] + oc0[1]) + (oc1[0] + oc1[1])) * 0.17677669529663687f;
            const float rn = rsqrtf(wsum_dpp(o * o) * (1.f / 64.f) + 1e-6f); const float gg = bf2f(sOG[j * 64 + lane]);
            YS[(tok0 + ch * 8 + j) * 1024 + 512 + h * 64 + lane] = (bf16)f2bf(gg * sigmoidf_(gg) * (o * rn * ng));
        }
    }
    __builtin_amdgcn_s_setprio(0);
#undef CW_LOAD
#undef CW_STORE
}
typedef float f32x16 __attribute__((ext_vector_type(16)));
typedef short s16x4 __attribute__((ext_vector_type(4)));
typedef short v4i16_t __attribute__((ext_vector_type(4)));
typedef float f32x2_t __attribute__((ext_vector_type(2))); typedef __bf16 bf16x2_t __attribute__((ext_vector_type(2)));
__device__ __forceinline__ unsigned cvtpk_s(float lo, float hi) { f32x2_t v = {lo, hi}; bf16x2_t b = __builtin_convertvector(v, bf16x2_t); return __builtin_bit_cast(unsigned, b); }
__device__ __forceinline__ s16x4 vtr(const LAS unsigned char* p) { return __builtin_bit_cast(s16x4, __builtin_amdgcn_ds_read_tr16_b64_v4i16((LAS v4i16_t*)p)); }
constexpr int ATB_OFF = 102400;
constexpr int AVI_OFF = 3584;
constexpr float LOG2E = 1.4426950408889634f;
__device__ __forceinline__ void mixA_tables(const Args& a, LAS unsigned char* lds, int tid) {
    LAS float* tb = (LAS float*)(lds + ATB_OFF);
    for (int i = tid; i < 3 * 4 * 192; i += NTHR) { const int e = i % 192, h = (i / 192) & 3, f = i / 768; const int dist = 159 - e; const int dl = f == 0 ? 16 : (f == 1 ? 4 : 1);
        float v = -INFINITY;
        if (dist >= 0 && dist <= 128) { int dd = dist * dl; dd = dd > 2047 ? 2047 : dd; v = a.in[1][t5_bucket(dd) * 8 + h] * LOG2E; }
        tb[i] = v; }
}
__device__ __forceinline__ void mixA_task(const Args& a, int task, LAS unsigned char* lds, int wave, int lane_in) {
    int lane = lane_in; asm volatile("" : "+v"(lane));
    const bf16* P = (const bf16*)(a.ws + WS_BIG); bf16* YS = (bf16*)((unsigned char*)a.out + DO_YS);
    const int cc = 3 - (task & 3), r = (task >> 2) & 15, h = (task >> 6) & 3, b = task >> 8;
    const int ql = lane & 31, hh = lane >> 5, n0 = 32 * cc;
    const size_t rowb = (size_t)b * SEQ; const int tq = 16 * (n0 + ql) + r;
    const LAS float* tball = (const LAS float*)(lds + ATB_OFF) + h * 192;
    LAS unsigned char* vimg = lds + AVI_OFF + wave * 12800;
    bf16x8 qf[4];
    { const bf16* qp = P + (rowb + tq) * PW + PC_AQ + h * 64 + 8 * hh;
#pragma unroll
      for (int ks = 0; ks < 4; ++ks) qf[ks] = *(const bf16x8*)(qp + 16 * ks); }
    f32x16 o0, o1;
#pragma unroll
    for (int i = 0; i < 16; ++i) { o0[i] = 0.f; o1[i] = 0.f; }
    float m = -INFINITY, lsum = 0.f;
    const float SC = 0.125f * LOG2E;
    const int vst = (lane >> 1) * 144 + (lane & 1) * 64;
    const int i16 = lane & 15, tq4 = i16 >> 2, tp = i16 & 3, g16 = (lane >> 4) & 1;
    const int vrd = (4 * hh + tq4) * 144 + 32 * g16 + 8 * tp;
#pragma unroll 1
    for (int f = 0; f < 3; ++f) {
        const int dsh = f == 0 ? 4 : (f == 1 ? 2 : 0);
        const int rho = r & ((1 << dsh) - 1);
        const int qpos = (tq - rho) >> dsh;
        const int qmin = (16 * n0 + r - rho) >> dsh, qmax = (16 * (n0 + 31) + r - rho) >> dsh;
        int klo = qmin - 128; klo = klo < 0 ? 0 : klo; klo &= ~31;
        const LAS float* tbf = tball + f * 768;
        bf16x8 nk[4]; u32x4 nv0, nv1, nv2, nv3;
#define A_LOAD(KK0) do { const size_t tk_ = rowb + (((size_t)((KK0) + ql)) << dsh) + rho; const bf16* kp_ = P + tk_ * PW + PC_AK + h * 64 + 8 * hh; \
            _Pragma("unroll") for (int ks = 0; ks < 4; ++ks) nk[ks] = *(const bf16x8*)(kp_ + 16 * ks); \
            const size_t tv_ = rowb + (((size_t)((KK0) + (lane >> 1))) << dsh) + rho; const u32x4* vp_ = (const u32x4*)(P + tv_ * PW + PC_AV + h * 64 + 32 * (lane & 1)); \
            nv0 = vp_[0]; nv1 = vp_[1]; nv2 = vp_[2]; nv3 = vp_[3]; } while (0)
        A_LOAD(qmax & ~31);
#pragma unroll 1
        for (int k0 = qmax & ~31; k0 >= klo; k0 -= 32) {
            bf16x8 kf[4];
#pragma unroll
            for (int ks = 0; ks < 4; ++ks) kf[ks] = nk[ks];
            const u32x4 v0 = nv0, v1 = nv1, v2 = nv2, v3 = nv3;
            if (k0 - 32 >= klo) A_LOAD(k0 - 32);
            f32x16 st;
#pragma unroll
            for (int i = 0; i < 16; ++i) st[i] = 0.f;
#pragma unroll
            for (int ks = 0; ks < 4; ++ks) st = __builtin_amdgcn_mfma_f32_32x32x16_bf16(kf[ks], qf[ks], st, 0, 0, 0);
            *(LAS u32x4*)(vimg + vst) = v0; *(LAS u32x4*)(vimg + vst + 16) = v1; *(LAS u32x4*)(vimg + vst + 32) = v2; *(LAS u32x4*)(vimg + vst + 48) = v3;
            const int D0 = qpos - k0 - 4 * hh; const int e0 = (D0 >= 0 && D0 <= 159) ? 159 - D0 : 0;
            const LAS float* tp_ = tbf + e0;
            float mx = -INFINITY;
#pragma unroll
            for (int i = 0; i < 16; ++i) { st[i] = st[i] * SC + tp_[(i & 3) + 8 * (i >> 2)]; mx = fmaxf(mx, st[i]); }
            mx = fmaxf(mx, __shfl_xor(mx, 32));
            const float mn = fmaxf(m, mx), alpha = __builtin_amdgcn_exp2f(m - mn);
            m = mn; float ps = 0.f;
#pragma unroll
            for (int i = 0; i < 16; ++i) { st[i] = __builtin_amdgcn_exp2f(st[i] - mn); ps += st[i]; }
            lsum = lsum * alpha + ps;
#pragma unroll
            for (int i = 0; i < 16; ++i) { o0[i] *= alpha; o1[i] *= alpha; }
            bf16x8 pf[2];
#pragma unroll
            for (int s = 0; s < 2; ++s) { u32x4 w; w.x = cvtpk_s(st[8 * s], st[8 * s + 1]); w.y = cvtpk_s(st[8 * s + 2], st[8 * s + 3]); w.z = cvtpk_s(st[8 * s + 4], st[8 * s + 5]); w.w = cvtpk_s(st[8 * s + 6], st[8 * s + 7]); pf[s] = __builtin_bit_cast(bf16x8, w); }
            asm volatile("s_waitcnt lgkmcnt(0)" ::: "memory");
#pragma unroll
            for (int s = 0; s < 2; ++s) {
                const s16x4 a00 = vtr(vimg + vrd + (16 * s) * 144), a01 = vtr(vimg + vrd + (16 * s + 8) * 144);
                const s16x4 a10 = vtr(vimg + vrd + (16 * s) * 144 + 64), a11 = vtr(vimg + vrd + (16 * s + 8) * 144 + 64);
                const bf16x8 A0 = (bf16x8){a00[0], a00[1], a00[2], a00[3], a01[0], a01[1], a01[2], a01[3]};
                const bf16x8 A1 = (bf16x8){a10[0], a10[1], a10[2], a10[3], a11[0], a11[1], a11[2], a11[3]};
                o0 = __builtin_amdgcn_mfma_f32_32x32x16_bf16(A0, pf[s], o0, 0, 0, 0);
                o1 = __builtin_amdgcn_mfma_f32_32x32x16_bf16(A1, pf[s], o1, 0, 0, 0);
            }
            asm volatile("s_waitcnt lgkmcnt(0)" ::: "memory");
        }
#undef A_LOAD
    }
    const float lt = lsum + __shfl_xor(lsum, 32); const float inv = 1.f / lt;
    bf16* yo = YS + (rowb + tq) * 1024 + h * 64 + 4 * hh;
#pragma unroll
    for (int g = 0; g < 4; ++g) {
        u32x2 w; w.x = cvtpk_s(o0[4 * g] * inv, o0[4 * g + 1] * inv); w.y = cvtpk_s(o0[4 * g + 2] * inv, o0[4 * g + 3] * inv); *(u32x2*)(yo + 8 * g) = w;
        u32x2 x; x.x = cvtpk_s(o1[4 * g] * inv, o1[4 * g + 1] * inv); x.y = cvtpk_s(o1[4 * g + 2] * inv, o1[4 * g + 3] * inv); *(u32x2*)(yo + 32 + 8 * g) = x; }
}

__device__ __forceinline__ unsigned fkey(float f) { const unsigned u = __float_as_uint(f); return (u & 0x80000000u) ? ~u : (u | 0x80000000u); }
typedef float f32x4v __attribute__((ext_vector_type(4)));
__device__ __forceinline__ void mixB_attend(const Args& a, int m, const LAS unsigned short* sidx, const LAS unsigned char* sbk, int nsel, LAS unsigned char* lds, LAS unsigned char* img, int lane) {
    const bf16* P = (const bf16*)(a.ws + WS_BIG); const bf16* CKVN = (const bf16*)(a.ws + WS_CKVN); bf16* YS = (bf16*)((unsigned char*)a.out + DO_YS);
    const LAS float* rpb = (const LAS float*)(lds + RPB_OFF);
    const int t = m & (SEQ - 1); const size_t rowb = (size_t)(m - t); const bf16* prow = P + (size_t)m * PW;
    const int hc = lane & 15, g = lane >> 4, hd = lane & 3;
    bf16x8 qB[2];
    { const bf16x8 z = (bf16x8){0, 0, 0, 0, 0, 0, 0, 0}; const bf16* qp = prow + PC_BQ + hd * 64 + 8 * g;
      const bf16x8 q0 = *(const bf16x8*)(qp), q1 = *(const bf16x8*)(qp + 32); qB[0] = hc < 4 ? q0 : z; qB[1] = hc < 4 ? q1 : z; }
    f32x4v oT[4];
#pragma unroll
    for (int mt = 0; mt < 4; ++mt) oT[mt] = (f32x4v){0.f, 0.f, 0.f, 0.f};
    float mrun = -INFINITY, lsum = 0.f;
    const float SC = 0.125f * LOG2E;
    const int i16 = lane & 15, tq4 = i16 >> 2, tp = i16 & 3;
    const int rd_row = (lane & 15) * 144 + 16 * g;
    const int rd_tr = (4 * g + tq4) * 144 + 8 * tp;
    u32x4 g0, g1, g2, g3, g4, g5, g6, g7;
#define BG_LOAD(CH) do { const int kk_ = 64 * (CH) + lane; const int idx_ = (int)sidx[kk_ < nsel ? kk_ : 0] & (SEQ - 1); const u32x4* cp_ = (const u32x4*)(CKVN + (rowb + idx_) * 64); \
        g0 = cp_[0]; g1 = cp_[1]; g2 = cp_[2]; g3 = cp_[3]; g4 = cp_[4]; g5 = cp_[5]; g6 = cp_[6]; g7 = cp_[7]; } while (0)
    BG_LOAD(0);
#pragma unroll 1
    for (int ch = 0; ch < 4; ++ch) {
        if (64 * ch >= nsel) break;
        { LAS u32x4* ip = (LAS u32x4*)(img + lane * 144); ip[0] = g0; ip[1] = g1; ip[2] = g2; ip[3] = g3; ip[4] = g4; ip[5] = g5; ip[6] = g6; ip[7] = g7; }
        if (64 * (ch + 1) < nsel) BG_LOAD(ch + 1);
        asm volatile("s_waitcnt lgkmcnt(0)" ::: "memory");
        f32x4v st[4];
        float mx = -INFINITY;
#pragma unroll
        for (int kt = 0; kt < 4; ++kt) {
            const bf16x8 a0 = *(const LAS bf16x8*)(img + rd_row + (16 * kt) * 144), a1 = *(const LAS bf16x8*)(img + rd_row + (16 * kt) * 144 + 64);
            f32x4v acc = (f32x4v){0.f, 0.f, 0.f, 0.f};
            acc = __builtin_amdgcn_mfma_f32_16x16x32_bf16(a0, qB[0], acc, 0, 0, 0);
            acc = __builtin_amdgcn_mfma_f32_16x16x32_bf16(a1, qB[1], acc, 0, 0, 0);
            const int kb = 64 * ch + 16 * kt + 4 * g;
            const unsigned bk4 = *(const LAS unsigned*)(sbk + kb);
#pragma unroll
            for (int i = 0; i < 4; ++i) { const int bk = (bk4 >> (8 * i)) & 0xff; const float bias = rpb[bk * 8 + 4 + hd] * LOG2E;
                const float v = (kb + i < nsel) ? acc[i] * SC + bias : -INFINITY; acc[i] = v; mx = fmaxf(mx, v); }
            st[kt] = acc; }
        mx = fmaxf(mx, __shfl_xor(mx, 16)); mx = fmaxf(mx, __shfl_xor(mx, 32));
        const float mn = fmaxf(mrun, mx), alpha = __builtin_amdgcn_exp2f(mrun - mn); mrun = mn;
        float ps = 0.f;
#pragma unroll
        for (int kt = 0; kt < 4; ++kt)
#pragma unroll
            for (int i = 0; i < 4; ++i) { st[kt][i] = __builtin_amdgcn_exp2f(st[kt][i] - mn); ps += st[kt][i]; }
        lsum = lsum * alpha + ps;
#pragma unroll
        for (int mt = 0; mt < 4; ++mt) oT[mt] = oT[mt] * alpha;
#pragma unroll
        for (int ks2 = 0; ks2 < 2; ++ks2) {
            u32x4 w; w.x = cvtpk_s(st[2 * ks2][0], st[2 * ks2][1]); w.y = cvtpk_s(st[2 * ks2][2], st[2 * ks2][3]); w.z = cvtpk_s(st[2 * ks2 + 1][0], st[2 * ks2 + 1][1]); w.w = cvtpk_s(st[2 * ks2 + 1][2], st[2 * ks2 + 1][3]);
            const bf16x8 pB = __builtin_bit_cast(bf16x8, w);
#pragma unroll
            for (int mt = 0; mt < 4; ++mt) {
                const s16x4 lo = vtr(img + rd_tr + (32 * ks2) * 144 + 32 * mt), hi = vtr(img + rd_tr + (32 * ks2 + 16) * 144 + 32 * mt);
                const bf16x8 A = (bf16x8){lo[0], lo[1], lo[2], lo[3], hi[0], hi[1], hi[2], hi[3]};
                oT[mt] = __builtin_amdgcn_mfma_f32_16x16x32_bf16(A, pB, oT[mt], 0, 0, 0); } }
        asm volatile("s_waitcnt lgkmcnt(0)" ::: "memory");
    }
#undef BG_LOAD
    float lt = lsum; lt += __shfl_xor(lt, 16); lt += __shfl_xor(lt, 32);
    const float inv = 1.f / lt;
    if (hc < 4) { bf16* yo = YS + (size_t)m * 1024 + 256 + hc * 64 + 4 * g;
#pragma unroll
        for (int mt = 0; mt < 4; ++mt) { u32x2 w; w.x = cvtpk_s(oT[mt][0] * inv, oT[mt][1] * inv); w.y = cvtpk_s(oT[mt][2] * inv, oT[mt][3] * inv); *(u32x2*)(yo + 16 * mt) = w; } }
}
__device__ __forceinline__ void mixB_group(const Args& a, int l, int m0, LAS unsigned char* lds, LAS unsigned char* wscr, int lane_in, const int bmode = 15) {
    int lane = lane_in; asm volatile("" : "+v"(lane));
    const bf16* P = (const bf16*)(a.ws + WS_BIG);
    const int t0 = m0 & (SEQ - 1); const size_t rowb = (size_t)(m0 - t0);
    const int ql = lane & 31, hh = lane >> 5;
    LAS unsigned short* sidx = (LAS unsigned short*)wscr;
    LAS unsigned char* sbk = wscr + 2048;
    LAS unsigned char* img = wscr + 3584;
    const LAS unsigned char* bkt = lds + BKT_OFF;
    bf16x8 qf[2];
    { const int rho = ql, qi = 2 * ((rho >> 2) & 1) + (rho >> 4), hd = 4 * ((rho >> 3) & 1) + (rho & 3);
      const bf16* ip = P + (size_t)(m0 + qi) * PW + PC_IQ + hd * 32 + 8 * hh;
      qf[0] = *(const bf16x8*)(ip); qf[1] = *(const bf16x8*)(ip + 16); }
    float iw[2][8];
#pragma unroll
    for (int qq = 0; qq < 2; ++qq) { const u32x4 w = *(const u32x4*)(P + (size_t)(m0 + 2 * hh + qq) * PW + PC_IW); const float s = 0.0625f;
        iw[qq][0] = bflo(w.x) * s; iw[qq][1] = bfhi(w.x) * s; iw[qq][2] = bflo(w.y) * s; iw[qq][3] = bfhi(w.y) * s; iw[qq][4] = bflo(w.z) * s; iw[qq][5] = bfhi(w.z) * s; iw[qq][6] = bflo(w.w) * s; iw[qq][7] = bfhi(w.w) * s; }
    const int tq0 = t0 + 2 * hh;
    const int ntile = ((t0 + 3) >> 5) + 1;
    unsigned sk[2][64];
#pragma unroll
    for (int kb4 = 0; kb4 < 32; ++kb4) {
        if (2 * kb4 < ntile && (bmode & 1)) {
            bf16x8 kf0[2], kf1[2];
#pragma unroll
            for (int k4 = 0; k4 < 2; ++k4) { const int s = 32 * (2 * kb4 + k4) + ql; const bf16* kp = P + (rowb + s) * PW + PC_IK + 8 * hh; kf0[k4] = *(const bf16x8*)(kp); kf1[k4] = *(const bf16x8*)(kp + 16); }
#pragma unroll
            for (int k4 = 0; k4 < 2; ++k4) { const int kt = 2 * kb4 + k4; const int s = 32 * kt + ql;
                f32x16 acc;
#pragma unroll
                for (int i = 0; i < 16; ++i) acc[i] = 0.f;
                acc = __builtin_amdgcn_mfma_f32_32x32x16_bf16(qf[0], kf0[k4], acc, 0, 0, 0);
                acc = __builtin_amdgcn_mfma_f32_32x32x16_bf16(qf[1], kf1[k4], acc, 0, 0, 0);
                float s0 = 0.f, s1 = 0.f;
#pragma unroll
                for (int i = 0; i < 8; ++i) { s0 += fmaxf(acc[i], 0.f) * iw[0][i]; s1 += fmaxf(acc[8 + i], 0.f) * iw[1][i]; }
                sk[0][kt] = (s <= tq0) ? fkey(s0) : 0x007fffffu; sk[1][kt] = (s <= tq0 + 1) ? fkey(s1) : 0x007fffffu; }
        } else {
#pragma unroll
            for (int k4 = 0; k4 < 2; ++k4) { sk[0][2 * kb4 + k4] = 0x007fffffu; sk[1][2 * kb4 + k4] = 0x007fffffu; }
        }
    }
    const unsigned ltm = (1u << ql) - 1u;
    const int nblk8 = (ntile + 7) >> 3;
#define SK_RED(C) do { C += __builtin_amdgcn_update_dpp(0, C, 0x128, 0xf, 0xf, true); C += __builtin_amdgcn_update_dpp(0, C, 0x124, 0xf, 0xf, true); \
        C += __builtin_amdgcn_update_dpp(0, C, 0x122, 0xf, 0xf, true); C += __builtin_amdgcn_update_dpp(0, C, 0x121, 0xf, 0xf, true); C += __shfl_xor(C, 16); } while (0)
#define SK_COUNT2(OP, R0, R1, C0, C1) do { _Pragma("unroll") for (int kb8 = 0; kb8 < 8; ++kb8) { if (kb8 < nblk8) { _Pragma("unroll") for (int k8 = 0; k8 < 8; ++k8) { \
        C0 += (sk[0][8 * kb8 + k8] OP (R0)) ? 1 : 0; C1 += (sk[1][8 * kb8 + k8] OP (R1)) ? 1 : 0; } } } SK_RED(C0); SK_RED(C1); } while (0)
    unsigned KthA[2] = {0u, 0u}; int needA[2] = {0, 0};
    const bool big0 = (tq0 + 1 > 256), big1 = (tq0 + 2 > 256); bool exact = true;
    if (__any(big0 || big1) && (bmode & 2)) {
        exact = false;
#pragma unroll 1
        for (int bit = 31; bit >= 0; --bit) { const unsigned c0 = KthA[0] | (1u << bit), c1 = KthA[1] | (1u << bit); int n0 = 0, n1 = 0;
            SK_COUNT2(>=, c0, c1, n0, n1);
            if (n0 >= 256) KthA[0] = c0;
            if (n1 >= 256) KthA[1] = c1;
            if (__all((n0 == 256 || !big0) && (n1 == 256 || !big1))) { exact = true; break; }
        }
        if (!exact) { int g0 = 0, g1 = 0; SK_COUNT2(>, KthA[0], KthA[1], g0, g1); needA[0] = 256 - g0; needA[1] = 256 - g1; }
    }
#pragma unroll
    for (int qq = 0; qq < 2; ++qq) {
        if (!(bmode & 4)) break;
        const int tq = tq0 + qq; const bool big = qq ? big1 : big0; const unsigned Kth = KthA[qq]; const int need = needA[qq];
        LAS unsigned short* sx = sidx + (2 * hh + qq) * 256;
        int base = 0, tie_taken = 0; int ql2 = ql; asm volatile("" : "+v"(ql2));
#pragma unroll
        for (int kb8 = 0; kb8 < 8; ++kb8) { if (kb8 < nblk8) {
#pragma unroll
            for (int k8 = 0; k8 < 8; ++k8) { const int kt = 8 * kb8 + k8; const int s = 32 * kt + ql2; const unsigned k = sk[qq][kt]; bool take;
                if (!big) take = (s <= tq);
                else if (exact) take = (k >= Kth);
                else { const bool tie = (k == Kth); const unsigned long long mt = __ballot(tie); const unsigned mt32 = hh ? (unsigned)(mt >> 32) : (unsigned)mt;
                    take = (k > Kth) || (tie && (tie_taken + __popc(mt32 & ltm)) < need); tie_taken += __popc(mt32); }
                const unsigned long long ms = __ballot(take); const unsigned ms32 = hh ? (unsigned)(ms >> 32) : (unsigned)ms;
                if (take) sx[base + __popc(ms32 & ltm)] = (unsigned short)s;
                base += __popc(ms32); } } }
    }
#undef SK_COUNT2
#undef SK_RED
    LDS_WAIT(); asm volatile("" ::: "memory");
#pragma unroll
    for (int qi = 0; qi < 4; ++qi) { const int tq = t0 + qi; const int nsel = (tq + 1 < 256) ? tq + 1 : 256;
#pragma unroll
        for (int j = 0; j < 4; ++j) { const int pos = lane + 64 * j; if (pos < nsel) sbk[qi * 256 + pos] = bkt[tq - (int)sidx[qi * 256 + pos]]; } }
    LDS_WAIT(); asm volatile("" ::: "memory");
#pragma unroll 1
    for (int qi = 0; qi < 4; ++qi) { if (!(bmode & 8)) break; const int tq = t0 + qi; const int nsel = (tq + 1 < 256) ? tq + 1 : 256;
        mixB_attend(a, m0 + qi, sidx + qi * 256, sbk + qi * 256, nsel, lds, img, lane); asm volatile("" ::: "memory"); }
}
__device__ __forceinline__ void mixers_phase(const Args& a, int l, LAS unsigned char* lds, int bid, int G, int tid, int wave, int lane, int qsel = 0, int mixmask = 15, const int bmode = 15) {
    unsigned* qh = (unsigned*)(a.ws + WS_CTL) + CW_Q + 64 * l + 16 * qsel;
    LAS unsigned char* wscr = lds + wave * 12800;
    for (int it = bid; it < 256; it += G) {
        if (it < 128 && (mixmask & 1)) dscan_item(a, l, it, lds, tid);
        if (it >= 128 && (mixmask & 2)) cscan_item(a, l, it - 128, lds, tid);
        __syncthreads(); }
    mixA_tables(a, lds, tid); __syncthreads();
    for (;;) {
        unsigned cq = 0; if (lane == 0) cq = __hip_atomic_fetch_add(qh, 1u, __ATOMIC_RELAXED, __HIP_MEMORY_SCOPE_AGENT);
        cq = (unsigned)__builtin_amdgcn_readfirstlane((int)cq);
        if (cq >= 16384u) break;
        if (cq < 8192u) { if (!(mixmask & 8)) continue; const int tb = 255 - (int)(cq >> 5), b = (int)(cq & 31u); const int m0 = b * SEQ + tb * 8;
#pragma unroll 1
            for (int k = 0; k < 2; ++k) {
#ifndef MIX_NO_B
                mixB_group(a, l, m0 + 4 * k, lds, wscr, lane, bmode);
#endif
            } }
        else { if (!(mixmask & 4)) continue;
#ifndef MIX_NO_A
            mixA_task(a, (int)(cq - 8192u), lds, wave, lane);
#endif
        }
    }
}

constexpr int RREC_OFF = MISC_OFF + 4096, LCNT_OFF = MISC_OFF + 10240, LBASE_OFF = MISC_OFF + 10368;
__device__ __forceinline__ void ln1_route_phase(const Args& a, int l, LAS unsigned char* lds, int bid, int G, int tid, int wave, int lane) {
    bf16* XB = (bf16*)(a.ws + WS_XB); const float* WRT = (const float*)(a.ws + WS_RT) + (size_t)l * 36 * 1024;
    unsigned* tokinfo = (unsigned*)(a.ws + WS_TOK); unsigned* cntg = (unsigned*)(a.ws + WS_CTL) + CW_CNT + (l * 32) * 64;
    const float* lng = a.in[21] + (l * 2 + 0) * 1024; const float* lnb = a.in[22] + (l * 2 + 0) * 1024;
    const float* brg = a.in[24] + l * 4; const float* bre = a.in[26] + l * 32;
    LAS float* sW = (LAS float*)lds;
    LAS unsigned* rrec = (LAS unsigned*)(lds + RREC_OFF); LAS int* lcnt = (LAS int*)(lds + LCNT_OFF); LAS unsigned* lbase = (LAS unsigned*)(lds + LBASE_OFF);
    for (int i = tid; i < 32 * 1024 / 4; i += NTHR) *(LAS f32x4*)(sW + 4 * i) = *(const f32x4*)(WRT + 4 * 1024 + 4 * i);
    f32x4 gam[4], bet[4], wg[4][4];
#pragma unroll
    for (int j = 0; j < 4; ++j) { gam[j] = *(const f32x4*)(lng + 4 * lane + 256 * j); bet[j] = *(const f32x4*)(lnb + 4 * lane + 256 * j);
#pragma unroll
        for (int e = 0; e < 4; ++e) wg[e][j] = *(const f32x4*)(WRT + e * 1024 + 4 * lane + 256 * j); }
    for (int blk = bid; blk < NTOK / 256; blk += G) {
        if (tid < 32) lcnt[tid] = 0;
        __syncthreads();
#pragma unroll 1
        for (int rg = 0; rg < 8; ++rg) {
            const int rl0 = wave * 32 + rg * 4; f32x4 x[4][4];
#pragma unroll
            for (int r = 0; r < 4; ++r) { bf16* xr = XB + (size_t)(blk * 256 + rl0 + r) * 1024; float s = 0.f;
#pragma unroll
                for (int j = 0; j < 4; ++j) { const u32x2 w = *(const u32x2*)(xr + 4 * lane + 256 * j); x[r][j] = (f32x4){bflo(w.x), bfhi(w.x), bflo(w.y), bfhi(w.y)}; s += (x[r][j][0] + x[r][j][1]) + (x[r][j][2] + x[r][j][3]); }
                const float mean = wave_sum(s) * (1.f / 1024.f); float q = 0.f;
#pragma unroll
                for (int j = 0; j < 4; ++j) { x[r][j] = x[r][j] - mean; q += (x[r][j][0] * x[r][j][0] + x[r][j][1] * x[r][j][1]) + (x[r][j][2] * x[r][j][2] + x[r][j][3] * x[r][j][3]); }
                const float rstd = rsqrtf(wave_sum(q) * (1.f / 1024.f) + LN_EPS);
#pragma unroll
                for (int j = 0; j < 4; ++j) { x[r][j] = x[r][j] * rstd * gam[j] + bet[j]; u32x2 w; w.x = pk2(x[r][j][0], x[r][j][1]); w.y = pk2(x[r][j][2], x[r][j][3]); *(u32x2*)(xr + 4 * lane + 256 * j) = w; }
                }
            float gl[4][4];
#pragma unroll
            for (int e = 0; e < 4; ++e)
#pragma unroll
                for (int r = 0; r < 4; ++r) { float d = 0.f;
#pragma unroll
                    for (int j = 0; j < 4; ++j) d += (x[r][j][0] * wg[e][j][0] + x[r][j][1] * wg[e][j][1]) + (x[r][j][2] * wg[e][j][2] + x[r][j][3] * wg[e][j][3]);
                    gl[r][e] = wave_sum(d) + brg[e]; }
#pragma unroll
            for (int r = 0; r < 4; ++r) {
                const float g0 = gl[r][0], g1 = gl[r][1], g2 = gl[r][2], g3 = gl[r][3];
                int gsv = 0; float gm = g0; if (g1 > gm) { gm = g1; gsv = 1; } if (g2 > gm) { gm = g2; gsv = 2; } if (g3 > gm) { gm = g3; gsv = 3; }
                const int gs = __builtin_amdgcn_readfirstlane(gsv);
                const float ptop = 1.f / (__expf(g0 - gm) + __expf(g1 - gm) + __expf(g2 - gm) + __expf(g3 - gm));
                float v0 = -INFINITY, v1 = -INFINITY; int i0 = 0, i1 = 0;
#pragma unroll 2
                for (int jj = 0; jj < 8; ++jj) { const int e = gs * 8 + jj; float d = 0.f;
#pragma unroll
                    for (int j = 0; j < 4; ++j) { const f32x4 w4 = *(const LAS f32x4*)(sW + e * 1024 + 4 * lane + 256 * j); d += (x[r][j][0] * w4[0] + x[r][j][1] * w4[1]) + (x[r][j][2] * w4[2] + x[r][j][3] * w4[3]); }
                    const float le = wave_sum(d) + bre[e];
                    if (le > v0) { v1 = v0; i1 = i0; v0 = le; i0 = jj; } else if (le > v1) { v1 = le; i1 = jj; } }
                const float ex = __expf(v1 - v0), w0 = ptop / (1.f + ex), w1 = ptop * ex / (1.f + ex);
                if (lane == 0) { const int e0 = gs * 8 + i0, e1 = gs * 8 + i1; const int rl = rl0 + r;
                    const int p0 = atomicAdd((int*)&lcnt[e0], 1), p1 = atomicAdd((int*)&lcnt[e1], 1);
                    rrec[rl * 6 + 0] = (unsigned)e0; rrec[rl * 6 + 1] = (unsigned)p0; rrec[rl * 6 + 2] = __float_as_uint(w0); rrec[rl * 6 + 3] = (unsigned)e1; rrec[rl * 6 + 4] = (unsigned)p1; rrec[rl * 6 + 5] = __float_as_uint(w1); } }
        }
        __syncthreads();
        if (tid < 32) lbase[tid] = __hip_atomic_fetch_add(cntg + tid * 64, (unsigned)lcnt[tid], __ATOMIC_RELAXED, __HIP_MEMORY_SCOPE_AGENT);
        __syncthreads();
        if (tid < 256) { const unsigned e0 = rrec[tid * 6 + 0], e1 = rrec[tid * 6 + 3]; unsigned* ti = tokinfo + (size_t)(blk * 256 + tid) * 8;
            u32x4 o0, o1; o0.x = e0; o0.y = lbase[e0] + rrec[tid * 6 + 1]; o0.z = rrec[tid * 6 + 2]; o0.w = e1; o1.x = lbase[e1] + rrec[tid * 6 + 4]; o1.y = rrec[tid * 6 + 5]; o1.z = 0u; o1.w = 0u;
            *(u32x4*)ti = o0; *(u32x4*)(ti + 4) = o1; }
        __syncthreads();
    }
}
__device__ __forceinline__ void moe_table(const Args& a, int l, LAS unsigned char* lds, int tid) {
    LAS int* tstart = (LAS int*)(lds + TST_OFF);
    if (tid == 0) { const unsigned* cntg = (const unsigned*)(a.ws + WS_CTL) + CW_CNT + (l * 32) * 64; int acc = 0;
        for (int e = 0; e < 32; ++e) { tstart[e] = acc; acc += (int)((__hip_atomic_load(cntg + e * 64, __ATOMIC_RELAXED, __HIP_MEMORY_SCOPE_AGENT) + 255u) >> 8); }
        tstart[32] = acc; }
    __syncthreads();
}
__device__ __forceinline__ void scatter_phase(const Args& a, int l, LAS unsigned char* lds, int bid, int G, int tid, int gw, int NGW, int lane) {
    const LAS int* tstart = (const LAS int*)(lds + TST_OFF);
    const bf16* XB = (const bf16*)(a.ws + WS_XB); bf16* XS = (bf16*)(a.ws + WS_BIG); unsigned* rowinfo = (unsigned*)(a.ws + WS_ROW); const unsigned* tokinfo = (const unsigned*)(a.ws + WS_TOK);
    const unsigned* cntg = (const unsigned*)(a.ws + WS_CTL) + CW_CNT + (l * 32) * 64;
    for (int e = bid; e < 32; e += G) { const int c = (int)__hip_atomic_load(cntg + e * 64, __ATOMIC_RELAXED, __HIP_MEMORY_SCOPE_AGENT); const int r0 = tstart[e] * 256, r1 = tstart[e + 1] * 256;
        unsigned neg_ = 0xffffffffu, zer_ = 0u; asm volatile("" : "+v"(neg_), "+v"(zer_));
        for (int r = r0 + c + tid; r < r1; r += NTHR) { rowinfo[2 * (size_t)r] = neg_; rowinfo[2 * (size_t)r + 1] = zer_; } }
    u32x4 nt0, nv0, nv1; u32x2 nt1;
#define SC_LOAD(mm) do { nt0 = *(const u32x4*)(tokinfo + (size_t)(mm) * 8); nt1 = *(const u32x2*)(tokinfo + (size_t)(mm) * 8 + 4); const u32x4* src_ = (const u32x4*)(XB + (size_t)(mm) * 1024); nv0 = src_[lane]; nv1 = src_[64 + lane]; } while (0)
    if (gw < NTOK) SC_LOAD(gw);
    for (int m = gw; m < NTOK; m += NGW) {
        const u32x4 t0 = nt0, v0 = nv0, v1 = nv1; const u32x2 t1 = nt1;
        if (m + NGW < NTOK) SC_LOAD(m + NGW);
        const size_t r0 = (size_t)tstart[t0.x] * 256 + t0.y, r1 = (size_t)tstart[t0.w] * 256 + t1.x;
        u32x4* d0 = (u32x4*)(XS + r0 * 1024); u32x4* d1 = (u32x4*)(XS + r1 * 1024);
        d0[lane] = v0; d0[64 + lane] = v1; d1[lane] = v0; d1[64 + lane] = v1;
        if (lane == 0) { rowinfo[2 * r0] = (unsigned)(m * 2); rowinfo[2 * r0 + 1] = t0.z; rowinfo[2 * r1] = (unsigned)(m * 2 + 1); rowinfo[2 * r1 + 1] = t1.y; }
    }
}
__device__ __forceinline__ void ln2_phase(const Args& a, int l, int gw, int NGW, int lane) {
    bf16* XB = (bf16*)(a.ws + WS_XB); const bf16* Y = (const bf16*)(a.ws + WS_BIG);
    const float* lng = a.in[21] + (l * 2 + 1) * 1024; const float* lnb = a.in[22] + (l * 2 + 1) * 1024;
    f32x4 gam[4], bet[4];
#pragma unroll
    for (int j = 0; j < 4; ++j) { gam[j] = *(const f32x4*)(lng + 4 * lane + 256 * j); bet[j] = *(const f32x4*)(lnb + 4 * lane + 256 * j); }
    u32x2 nw[4], np2[4], nq2[4];
#define LN2_LOAD(mm) do { const bf16* xr_ = XB + (size_t)(mm) * 1024 + 4 * lane; const bf16* y0_ = Y + (size_t)(mm) * 1024 + 4 * lane; const bf16* y1_ = Y + ((size_t)NTOK + (mm)) * 1024 + 4 * lane; \
        _Pragma("unroll") for (int j = 0; j < 4; ++j) { nw[j] = *(const u32x2*)(xr_ + 256 * j); np2[j] = *(const u32x2*)(y0_ + 256 * j); nq2[j] = *(const u32x2*)(y1_ + 256 * j); } } while (0)
    if (gw < NTOK) LN2_LOAD(gw);
    for (int m = gw; m < NTOK; m += NGW) {
        bf16* xr = XB + (size_t)m * 1024;
        u32x2 cw[4], cp2[4], cq2[4];
#pragma unroll
        for (int j = 0; j < 4; ++j) { cw[j] = nw[j]; cp2[j] = np2[j]; cq2[j] = nq2[j]; }
        if (m + NGW < NTOK) LN2_LOAD(m + NGW);
        f32x4 x[4]; float s = 0.f;
#pragma unroll
        for (int j = 0; j < 4; ++j) { const u32x2 w = cw[j], p = cp2[j], q = cq2[j];
            x[j] = (f32x4){DN_ALPHA * bflo(w.x) + (bflo(p.x) + bflo(q.x)), DN_ALPHA * bfhi(w.x) + (bfhi(p.x) + bfhi(q.x)), DN_ALPHA * bflo(w.y) + (bflo(p.y) + bflo(q.y)), DN_ALPHA * bfhi(w.y) + (bfhi(p.y) + bfhi(q.y))};
            s += (x[j][0] + x[j][1]) + (x[j][2] + x[j][3]); }
        const float mean = wave_sum(s) * (1.f / 1024.f); float q = 0.f;
#pragma unroll
        for (int j = 0; j < 4; ++j) { x[j] = x[j] - mean; q += (x[j][0] * x[j][0] + x[j][1] * x[j][1]) + (x[j][2] * x[j][2] + x[j][3] * x[j][3]); }
        const float rstd = rsqrtf(wave_sum(q) * (1.f / 1024.f) + LN_EPS);
#pragma unroll
        for (int j = 0; j < 4; ++j) { x[j] = x[j] * rstd * gam[j] + bet[j];
            if (l == NLAYER - 1) *(f32x4*)(a.out + (size_t)m * 1024 + 4 * lane + 256 * j) = x[j];
            else { u32x2 w; w.x = pk2(x[j][0], x[j][1]); w.y = pk2(x[j][2], x[j][3]); *(u32x2*)(xr + 4 * lane + 256 * j) = w; } }
    }
}

#ifndef MK_MULTI
#define MK_MULTI 0
#endif
constexpr int NPHASE = 12;
__global__ void __launch_bounds__(NTHR, 2) fwd(Args a) {
    extern __shared__ __attribute__((aligned(16))) unsigned char lds_raw[];
    LAS unsigned char* lds = (LAS unsigned char*)lds_raw;
    const int G0 = gridDim.x, bid0 = blockIdx.x, wave0 = __builtin_amdgcn_readfirstlane((int)(threadIdx.x >> 6));
#define PH_IDS unsigned on_ = ~0u; asm volatile("" : "+s"(on_)); int lz_ = (int)__builtin_amdgcn_mbcnt_hi(on_, __builtin_amdgcn_mbcnt_lo(on_, 0u)); int wz_ = wave0, bz_ = bid0, gz_ = G0; asm volatile("" : "+s"(wz_), "+s"(bz_), "+s"(gz_)); \
    const int lane = lz_, wave = wz_, tid = wz_ * 64 + lz_, bid = bz_, G = gz_, NGW = gz_ * NWAVES, gw = bid * NWAVES + wave; (void)lane; (void)gw; (void)wave; (void)tid; (void)NGW;
#define PH_ARGS(LV) const __attribute__((address_space(4))) Args* kp_ = (const __attribute__((address_space(4))) Args*)__builtin_amdgcn_kernarg_segment_ptr(); asm volatile("" : "+s"(kp_)); const Args& b = *(const Args*)kp_; int lq = (LV); asm volatile("" : "+s"(lq)); (void)lq; \
    bf16* XB = (bf16*)(b.ws + WS_XB); bf16* PB = (bf16*)(b.ws + WS_BIG); bf16* YS = (bf16*)((unsigned char*)b.out + DO_YS); bf16* MG = (bf16*)((unsigned char*)b.out + DO_MG); \
    unsigned* rowinfo = (unsigned*)(b.ws + WS_ROW); unsigned char* wl = b.ws + WS_W + (size_t)lq * WL_SIZE; (void)XB; (void)PB; (void)YS; (void)MG; (void)rowinfo; (void)wl;
    unsigned* ctl = (unsigned*)(a.ws + WS_CTL);
    { PH_IDS
    for (int u = tid; u < (LDS_BYTES - MISC_OFF) / 4; u += NTHR) ((LAS unsigned*)(lds + MISC_OFF))[u] = 0u;
    __syncthreads();
    for (int d = tid; d < 2048; d += NTHR) ((LAS unsigned char*)(lds + BKT_OFF))[d] = (unsigned char)t5_bucket(d);
    if (tid < 256) ((LAS float*)(lds + RPB_OFF))[tid] = a.in[1][tid];
    __syncthreads(); }
    XcdBarrier bar; bar.bar = ctl + CW_BAR; bar.x = 0; bar.st = nullptr;
    if (a.use_bar) bar = xcd_barrier_post(ctl + CW_BAR, (volatile LAS unsigned*)(lds + MISC_OFF) + 8);
#define GRID_BAR() do { if (a.use_bar) { const __attribute__((address_space(4))) Args* kq_ = (const __attribute__((address_space(4))) Args*)__builtin_amdgcn_kernarg_segment_ptr(); asm volatile("" : "+s"(kq_)); \
        XcdBarrier bb_ = bar; bb_.bar = (unsigned*)(kq_->ws + WS_CTL) + CW_BAR; xcd_barrier(bb_); } } while (0)
#ifndef PHMASK
#define PHMASK 0xFFF
#endif
#define IN(k) (((PHMASK >> (k)) & 1) && ((phm >> (k)) & 1u))

    unsigned phm = ((1u << a.ph_hi) - 1u) & ~((1u << a.ph_lo) - 1u);
    if (a.l_lo == 0 && IN(0)) { PH_IDS PH_ARGS(0) p0_prologue(b, lds, gw, NGW, wave, lane); GRID_BAR(); }
    for (int l = a.l_lo; l < a.l_hi; ++l) {
        asm volatile("" : "+s"(phm));
        if (IN(1)) { PH_IDS PH_ARGS(l) pg8::Gemm g{XB, (const bf16*)(wl + WL_IN), 1024, 1024, 1024}; pg8::GridOrder S; S.init(NTOK / 256, PW / 256, G, bid);
            pg8::EpiStoreBf16 E{PB, PW}; pg8::gemm_phase(lds, g, S, E, tid); GRID_BAR(); }
        if (IN(2)) { PH_IDS PH_ARGS(l) prep_phase(b, lq, lds, tid, gw, NGW, lane); GRID_BAR(); }
        if (IN(3)) { PH_IDS PH_ARGS(l) mixers_phase(b, lq, lds, bid, G, tid, wave, lane); GRID_BAR(); }
        if (IN(4)) { PH_IDS PH_ARGS(l) pg8::Gemm g{YS, (const bf16*)(wl + WL_BR), 1024, 256, 256}; pg8::GridOrder S; S.init(NTOK / 256, 16, G, bid, 4, 512);
            pg8::EpiStoreBf16 E{PB, 4096}; pg8::gemm_phase(lds, g, S, E, tid); GRID_BAR(); }
        if (IN(5)) { PH_IDS PH_ARGS(l) pg8::Gemm g{XB, (const bf16*)(wl + WL_IN) + (size_t)3072 * 1024, 1024, 1024, 1024}; pg8::GridOrder S; S.init(NTOK / 256, 16, G, bid);
            pg8::EpiGate E{PB, MG}; pg8::gemm_phase(lds, g, S, E, tid); GRID_BAR(); }
        if (IN(6)) { PH_IDS PH_ARGS(l) pg8::Gemm g{MG, (const bf16*)(wl + WL_OUT), 1024, 1024, 1024}; pg8::GridOrder S; S.init(NTOK / 256, 4, G, bid);
            pg8::EpiOut E{XB}; pg8::gemm_phase(lds, g, S, E, tid); GRID_BAR(); }
        if (IN(7)) { PH_IDS PH_ARGS(l) ln1_route_phase(b, lq, lds, bid, G, tid, wave, lane); GRID_BAR(); }
        if (IN(8)) { PH_IDS PH_ARGS(l) moe_table(b, lq, lds, tid); scatter_phase(b, lq, lds, bid, G, tid, gw, NGW, lane); GRID_BAR(); }
        if (IN(9)) { PH_IDS PH_ARGS(l) moe_table(b, lq, lds, tid); pg8::Gemm g{PB, (const bf16*)(wl + WL_GU), 1024, 1024, 1024}; pg8::MoeOrder S{(const LAS int*)(lds + TST_OFF), 1, G, bid};
            pg8::EpiUp E{rowinfo, (bf16*)(b.ws + WS_BIG + BIG_H)}; pg8::gemm_phase(lds, g, S, E, tid); GRID_BAR(); }
        if (IN(10)) { PH_IDS PH_ARGS(l) moe_table(b, lq, lds, tid); pg8::Gemm g{(const bf16*)(b.ws + WS_BIG + BIG_H), (const bf16*)(wl + WL_DN), 256, 256, 256}; pg8::MoeOrder S{(const LAS int*)(lds + TST_OFF), 2, G, bid};
            pg8::EpiDown E{rowinfo, PB}; pg8::gemm_phase(lds, g, S, E, tid); GRID_BAR(); }
        if (IN(11)) { PH_IDS PH_ARGS(l) ln2_phase(b, lq, gw, NGW, lane); if (l + 1 < a.l_hi) GRID_BAR(); }
    }
#undef IN
#undef GRID_BAR
}

extern "C" void kernel_launch(void* const* d_in, const int* in_sizes, int n_in, void* d_out, int out_size, void* d_ws, size_t ws_size, hipStream_t stream) {
    static int grid = 0;
    if (grid == 0) {
        if (n_in != 30 || out_size != NTOK * DM || ws_size < WS_END) { fprintf(stderr, "kernel_launch: unexpected shapes (n_in %d out %d ws %zu)\n", n_in, out_size, ws_size); grid = -1; return; }
        int dev = 0, cus = 0, per_cu = 0;
        if (hipGetDevice(&dev) != hipSuccess || hipDeviceGetAttribute(&cus, hipDeviceAttributeMultiprocessorCount, dev) != hipSuccess) { grid = -1; return; }
        if (hipFuncSetAttribute((const void*)fwd, hipFuncAttributeMaxDynamicSharedMemorySize, LDS_BYTES) != hipSuccess) { fprintf(stderr, "kernel_launch: hipFuncSetAttribute failed\n"); grid = -1; return; }
        if (hipOccupancyMaxActiveBlocksPerMultiprocessor(&per_cu, (const void*)fwd, NTHR, LDS_BYTES) != hipSuccess || per_cu < 1) fprintf(stderr, "kernel_launch: occupancy query says %d\n", per_cu);
        (void)hipGetLastError();
        grid = cus;
    }
    if (grid < 0) return;
    (void)hipMemsetAsync((char*)d_ws + WS_CTL, 0, CTL_ZERO_BYTES, stream);
    Args a{};
    for (int i = 0; i < 30; ++i) a.in[i] = (const float*)d_in[i];
    a.out = (float*)d_out; a.ws = (unsigned char*)d_ws; a.pad = 0;
#if MK_MULTI
    a.use_bar = 0;
    for (int l = 0; l < NLAYER; ++l)
        for (int ph = (l == 0 ? 0 : 1); ph < NPHASE; ++ph) { a.l_lo = l; a.l_hi = l + 1; a.ph_lo = ph; a.ph_hi = ph + 1;
            hipLaunchKernelGGL(fwd, dim3(grid), dim3(NTHR), LDS_BYTES, stream, a); }
#else
    a.use_bar = 1; a.l_lo = 0; a.l_hi = NLAYER; a.ph_lo = 0; a.ph_hi = NPHASE;
    hipLaunchKernelGGL(fwd, dim3(grid), dim3(NTHR), LDS_BYTES, stream, a);
#endif
    const hipError_t le = hipPeekAtLastError();
    if (le != hipSuccess) fprintf(stderr, "kernel_launch: launch failed: %s\n", hipGetErrorName(le));
}
```

```cpp
#include <hip/hip_runtime.h>
#include <cstdio>
#include <cstdint>

#define LAS __attribute__((address_space(3)))
#define GAS __attribute__((address_space(1)))
typedef unsigned short bf16;
typedef short bf16x8 __attribute__((ext_vector_type(8)));
typedef float f32x4 __attribute__((ext_vector_type(4)));
typedef float f32x2 __attribute__((ext_vector_type(2)));
typedef unsigned u32x4 __attribute__((ext_vector_type(4)));
typedef unsigned u32x2 __attribute__((ext_vector_type(2)));

namespace pg8 {
constexpr int BM = 256, BK = 64, HALF = 128, HTB = HALF * BK * 2  , STAGE_BYTES = 8 * HTB, NXCD = 8, WGM = 8;

__host__ __device__ __forceinline__ int lds_byte(int r, int c) { const int st = (r >> 4) * 2 + (c >> 5), rr = r & 15, cc = c & 31, ob = rr * 64 + cc * 2; return st * 1024 + (ob ^ (((ob >> 9) & 1) << 5)); }
__host__ __device__ __forceinline__ void stage_rc(int b, int& R, int& C) { const int st = b / 1024, sb = b % 1024, swz = sb ^ (((sb >> 9) & 1) << 5); R = (st >> 1) * 16 + swz / 64; C = (st & 1) * 32 + (swz % 64) / 2; }
__host__ __device__ __forceinline__ int perm32(int rho) { const int n = rho >> 4, i = rho & 15; return 8 * (i >> 2) + 4 * n + (i & 3); }

struct Unit { int pm, pn, pb; unsigned aoff; };
struct Gemm { const bf16* A; const bf16* Bt; int lda, ldb, K; };

struct GridOrder {
    int nM, nN, nwg, G, c, a_grp, a_grp_bytes;
    __device__ void init(int nM_, int nN_, int G_, int c_, int a_grp_ = 0, int a_grp_bytes_ = 0) { nM = nM_; nN = nN_; nwg = nM * nN; G = G_; c = c_; a_grp = a_grp_; a_grp_bytes = a_grp_bytes_; }
    __device__ bool next(int i, Unit& u) const {
        const long L = (long)i * G + c; if (L >= nwg) return false;
        int wgid = (int)L; { const int q = nwg / NXCD, r = nwg % NXCD, xcd = wgid % NXCD, off = wgid / NXCD; wgid = (xcd < r ? xcd * (q + 1) : r * (q + 1) + (xcd - r) * q) + off; }
        const int nig = WGM * nN, gid = wgid / nig, fm = gid * WGM, gsz = (nM - fm) < WGM ? (nM - fm) : WGM;
        u.pm = fm + ((wgid % nig) % gsz); u.pn = (wgid % nig) / gsz; u.pb = u.pn; u.aoff = a_grp ? (unsigned)((u.pn / a_grp) * a_grp_bytes) : 0u; return true;
    }
};
struct MoeOrder {
    const LAS int* tstart; int nsl, G, c;
    __device__ bool next(int i, Unit& u) const {
        const int L = i * G + c, total = tstart[32] << nsl; if (L >= total) return false;
        const int rt = L >> nsl, pn = L & ((1 << nsl) - 1); int e = 0;
        while (e < 31 && rt >= tstart[e + 1]) ++e;
        u.pm = rt; u.pn = pn; u.pb = (e << nsl) + pn; u.aoff = 0u; return true;
    }
};

__device__ __forceinline__ unsigned cvt_pk_bf16(float lo, float hi) { unsigned r; asm volatile("v_cvt_pk_bf16_f32 %0, %1, %2" : "=v"(r) : "v"(lo), "v"(hi)); return r; }

template <class Epi, class Sched>
__device__ __forceinline__ void gemm_phase(LAS unsigned char* lds, const Gemm g, const Sched& S, const Epi& E, const int tid) {
    const int wid = __builtin_amdgcn_readfirstlane(tid >> 6), lane = tid & 63, wr = wid >> 2, wc = wid & 3, fr = lane & 15, fq = lane >> 4;
    const int K = g.K, nt = K / BK;
    unsigned voffA[2], voffB[2];
#pragma unroll
    for (int i = 0; i < 2; ++i) { int R, C; stage_rc(tid * 16 + i * 8192, R, C); const int Rb = Epi::PERM ? ((R & ~31) + perm32(R & 31)) : R;
        voffA[i] = (unsigned)(R * g.lda + C) * 2u; voffB[i] = (unsigned)(Rb * g.ldb + C) * 2u; }
    const size_t kstep = (size_t)(BK * 2);
    const size_t hstepA = (size_t)HALF * g.lda * 2, hstepB = (size_t)HALF * g.ldb * 2;
    const size_t tstepA = 2 * hstepA, tstepB = 2 * hstepB;
    const unsigned ldsw = (unsigned)wid * 1024u;
    const int aoff = lds_byte(wr * 64 + fr, fq * 8), boff = lds_byte(wc * 32 + fr, fq * 8);
#define PG8_SA(b, h) (((b) * 2 + (h)) * HTB)
#define PG8_SB(b, h) ((4 + (b) * 2 + (h)) * HTB)
#define PG8_STAGE(bufoff, gbase, voff) do { _Pragma("unroll") for (int _i = 0; _i < 2; ++_i) \
        __builtin_amdgcn_global_load_lds((const unsigned*)((const char*)(gbase) + (voff)[_i]), (LAS unsigned*)(lds + (bufoff) + ldsw + _i * 8192), 16, 0, 0); } while (0)
#define PG8_LDA(dst, b, h) do { _Pragma("unroll") for (int m = 0; m < 4; ++m) _Pragma("unroll") for (int k = 0; k < 2; ++k) dst[m][k] = *(const LAS bf16x8*)(lds + PG8_SA(b, h) + aoff + m * 2048 + k * 1024); } while (0)
#define PG8_LDB(dst, b, h) do { _Pragma("unroll") for (int n = 0; n < 2; ++n) _Pragma("unroll") for (int k = 0; k < 2; ++k) dst[n][k] = *(const LAS bf16x8*)(lds + PG8_SB(b, h) + boff + n * 2048 + k * 1024); } while (0)
#define PG8_MMA(ai, bj, At, Bt) do { __builtin_amdgcn_s_setprio(1); _Pragma("unroll") for (int m = 0; m < 4; ++m) _Pragma("unroll") for (int n = 0; n < 2; ++n) _Pragma("unroll") for (int k = 0; k < 2; ++k) \
        acc[ai][bj][m][n] = __builtin_amdgcn_mfma_f32_16x16x32_bf16(Bt[n][k], At[m][k], acc[ai][bj][m][n], 0, 0, 0); __builtin_amdgcn_s_setprio(0); } while (0)
#define PG8_WAIT_V(n) asm volatile("s_waitcnt vmcnt(" #n ")" ::: "memory")
#define PG8_WAIT_L(n) asm volatile("s_waitcnt lgkmcnt(" #n ")" ::: "memory")
#define PG8_BAR __builtin_amdgcn_s_barrier()
#define PG8_SCHED __builtin_amdgcn_sched_barrier(0)
    Unit cur, nxt; int ui = 0;
    if (!S.next(0, cur)) return;
    f32x4 acc[2][2][4][2];
#pragma unroll
    for (int a = 0; a < 2; ++a)
#pragma unroll
        for (int b = 0; b < 2; ++b)
#pragma unroll
            for (int m = 0; m < 4; ++m)
#pragma unroll
                for (int n = 0; n < 2; ++n) acc[a][b][m][n] = (f32x4){0.f, 0.f, 0.f, 0.f};
    bf16x8 At[4][2], B0[2][2], B1[2][2];
    const char* cA = (const char*)g.A + (size_t)cur.pm * tstepA + cur.aoff; const char* cB = (const char*)g.Bt + (size_t)cur.pb * tstepB;
    PG8_STAGE(PG8_SB(0, 0), cB, voffB); PG8_STAGE(PG8_SB(0, 1), cB + hstepB, voffB); PG8_STAGE(PG8_SA(0, 0), cA, voffA); PG8_STAGE(PG8_SA(0, 1), cA + hstepA, voffA);
    if (wr == 1) PG8_BAR;
    PG8_WAIT_V(2); PG8_BAR;
    PG8_STAGE(PG8_SB(1, 0), cB + kstep, voffB); PG8_STAGE(PG8_SA(1, 0), cA + kstep, voffA); PG8_STAGE(PG8_SB(1, 1), cB + hstepB + kstep, voffB);
    PG8_WAIT_V(6); PG8_BAR;
    for (;;) {
        const bool has_next = S.next(ui + 1, nxt);
        const char* nA = has_next ? (const char*)g.A + (size_t)nxt.pm * tstepA + nxt.aoff : cA; const char* nB = has_next ? (const char*)g.Bt + (size_t)nxt.pb * tstepB : cB;
        for (int t = 0; t < nt; t += 2) {
            const bool last = (t == nt - 2);
            const char* a1 = cA + (size_t)(t + 1) * kstep;
            const char* a2 = last ? nA : cA + (size_t)(t + 2) * kstep; const char* b2 = last ? nB : cB + (size_t)(t + 2) * kstep;
            const char* a3 = a2 + kstep; const char* b3 = b2 + kstep;
            PG8_LDB(B0, 0, 0); PG8_LDB(B1, 0, 1); PG8_SCHED; PG8_LDA(At, 0, 0); PG8_STAGE(PG8_SA(1, 1), a1 + hstepA, voffA);
            PG8_WAIT_V(8); PG8_WAIT_L(0); PG8_BAR; PG8_MMA(0, 0, At, B0); PG8_MMA(0, 1, At, B1); PG8_BAR; PG8_SCHED;
            PG8_LDA(At, 0, 1); PG8_STAGE(PG8_SB(0, 0), b2, voffB); PG8_STAGE(PG8_SB(0, 1), b2 + hstepB, voffB); PG8_STAGE(PG8_SA(0, 0), a2, voffA);
            PG8_WAIT_V(8); PG8_WAIT_L(0); PG8_BAR; PG8_MMA(1, 0, At, B0); PG8_MMA(1, 1, At, B1); PG8_BAR; PG8_SCHED;
            PG8_LDB(B0, 1, 0); PG8_LDB(B1, 1, 1); PG8_SCHED; PG8_LDA(At, 1, 0); PG8_STAGE(PG8_SA(0, 1), a2 + hstepA, voffA);
            PG8_WAIT_V(8); PG8_WAIT_L(0); PG8_BAR; PG8_MMA(0, 0, At, B0); PG8_MMA(0, 1, At, B1); PG8_BAR; PG8_SCHED;
            PG8_LDA(At, 1, 1); PG8_STAGE(PG8_SB(1, 0), b3, voffB); PG8_STAGE(PG8_SB(1, 1), b3 + hstepB, voffB); PG8_STAGE(PG8_SA(1, 0), a3, voffA);
            PG8_WAIT_V(8); PG8_WAIT_L(0); PG8_BAR; PG8_MMA(1, 0, At, B0); PG8_MMA(1, 1, At, B1); PG8_BAR; PG8_SCHED;
        }
        if (wr == 0) PG8_BAR;
        { unsigned on_ = ~0u; asm volatile("" : "+s"(on_)); const int lz_ = (int)__builtin_amdgcn_mbcnt_hi(on_, __builtin_amdgcn_mbcnt_lo(on_, 0u));
          E(acc, cur, wr, wc, lz_ & 15, lz_ >> 4); }
        if (!has_next) break;
#pragma unroll
        for (int a = 0; a < 2; ++a)
#pragma unroll
            for (int b = 0; b < 2; ++b)
#pragma unroll
                for (int m = 0; m < 4; ++m)
#pragma unroll
                    for (int n = 0; n < 2; ++n) acc[a][b][m][n] = (f32x4){0.f, 0.f, 0.f, 0.f};
        cur = nxt; cA = nA; cB = nB; ++ui;
        if (wr == 1) PG8_BAR;
    }
    PG8_WAIT_V(0);
    PG8_BAR;
#undef PG8_SA
#undef PG8_SB
#undef PG8_STAGE
#undef PG8_LDA
#undef PG8_LDB
#undef PG8_MMA
#undef PG8_WAIT_V
#undef PG8_WAIT_L
#undef PG8_BAR
#undef PG8_SCHED
}
}

constexpr int NTOK = 65536, DM = 1024, SEQ = 2048, NBATCH = 32, NLAYER = 4;
constexpr int PW = 3072;
constexpr int PC_AQ = 0, PC_AK = 256, PC_AV = 512, PC_BQ = 768, PC_CKV = 1024, PC_IQ = 1088, PC_IK = 1344, PC_IW = 1376,
              PC_CQ = 1384, PC_CK = 1512, PC_CV = 1640, PC_CA = 1896, PC_CG = 1912, PC_D = 2168;
constexpr int IN_W = 7096;
constexpr float LN_EPS = 1e-5f;
constexpr float DN_ALPHA = 1.6817928305074292f;
constexpr int NWAVES = 8, NTHR = 512;
constexpr int MOE_ROWS = 2 * NTOK + 32 * 256;

constexpr size_t MiB = 1u << 20;
constexpr size_t WS_CTL = 0, CTL_ZERO_BYTES = 1 * MiB;
constexpr size_t WS_TOK = 1 * MiB;
constexpr size_t WS_ROW = 3 * MiB;
constexpr size_t WS_BON = 5 * MiB;
constexpr size_t WS_RT = 6 * MiB;
constexpr size_t WS_CKVN = 8 * MiB;
constexpr size_t WS_CA = 16 * MiB;
constexpr size_t WS_W = 48 * MiB;
constexpr size_t WL_IN = 0, WL_BR = 14 * MiB, WL_OUT = 16 * MiB, WL_GU = 18 * MiB, WL_DN = 50 * MiB, WL_SIZE = 66 * MiB;
constexpr size_t WS_XB = 312 * MiB;
constexpr size_t WS_BIG = 440 * MiB;
constexpr size_t BIG_DW = 384 * MiB, BIG_DAI = 448 * MiB, BIG_DG = 480 * MiB;
constexpr size_t BIG_H = 272 * MiB;
constexpr size_t WS_END = 952 * MiB;
constexpr size_t DO_YS = 0, DO_MG = 128 * MiB, DO_DR = 128 * MiB, DO_DKP = 160 * MiB, DO_DV = 192 * MiB, DO_DKK = 224 * MiB;

constexpr int CW_TMO = 0, CW_CODE = 1;
constexpr int CW_BAR = 4096;
constexpr int CW_Q = 8192;
constexpr int CW_CNT = 16384;

constexpr int RING_BYTES = 131072;
constexpr int MISC_OFF = RING_BYTES;
constexpr int TST_OFF = MISC_OFF + 512;
constexpr int BKT_OFF = MISC_OFF + 1024;
constexpr int RPB_OFF = MISC_OFF + 3072;
constexpr int LDS_BYTES = 147456;

#define LDS_WAIT() asm volatile("s_waitcnt lgkmcnt(0)" ::: "memory")
#define VM_WAIT() asm volatile("s_waitcnt vmcnt(0)" ::: "memory")
__device__ __forceinline__ float bf2f(unsigned b) { return __uint_as_float(b << 16); }
__device__ __forceinline__ unsigned f2bf(float f) { unsigned u = __float_as_uint(f); return (u + 0x7fffu + ((u >> 16) & 1u)) >> 16; }
__device__ __forceinline__ unsigned pk2(float lo, float hi) { return f2bf(lo) | (f2bf(hi) << 16); }
__device__ __forceinline__ float bflo(unsigned w) { return __uint_as_float(w << 16); }
__device__ __forceinline__ float bfhi(unsigned w) { return __uint_as_float(w & 0xffff0000u); }
template <int CTRL> __device__ __forceinline__ float dppf(float v) {
    return __builtin_bit_cast(float, __builtin_amdgcn_update_dpp(0, __builtin_bit_cast(int, v), CTRL, 0xf, 0xf, true));
}
__device__ __forceinline__ float wave_sum(float v) {
    v += dppf<0x128>(v); v += dppf<0x124>(v); v += dppf<0x122>(v); v += dppf<0x121>(v);
    v += __shfl_xor(v, 16); v += __shfl_xor(v, 32); return v;
}
__device__ __forceinline__ float wave_max(float v) {
#pragma unroll
    for (int o = 1; o < 64; o <<= 1) v = fmaxf(v, __shfl_xor(v, o));
    return v;
}
__device__ __forceinline__ float sum8(float v) { v += dppf<0xB1>(v); v += dppf<0x4E>(v); v += dppf<0x141>(v); return v; }
__device__ __forceinline__ float sigmoidf_(float x) { return 1.f / (1.f + __expf(-x)); }
__device__ __forceinline__ float log_sigmoidf_(float z) { return fminf(z, 0.f) - log1pf(__expf(-fabsf(z))); }

#define XB_TMO      128
#define XB_XCNT(j)  (256  + 64 * (j))
#define XB_XSUB(j)  (1280 + 64 * (j))
#define XB_XGEN(j)  (2304 + 64 * (j))
#define XB_TOP      3328
#define XB_TOPGEN   3392
#define XCD_BAR_WORDS 3456
#define XB_SPIN_CAP (1u << 22)

__device__ __forceinline__ unsigned xb_ld(unsigned* p)              { return __hip_atomic_load(p, __ATOMIC_RELAXED, __HIP_MEMORY_SCOPE_AGENT); }
__device__ __forceinline__ unsigned xb_add(unsigned* p, unsigned v) { return __hip_atomic_fetch_add(p, v, __ATOMIC_RELAXED, __HIP_MEMORY_SCOPE_AGENT); }
__device__ __forceinline__ unsigned xb_xcc_id() { return (unsigned)__builtin_amdgcn_s_getreg((3 << 11) | 20) & 0xFu; }
#define XB_SPIN(cond, bar) do { unsigned _sp = 0; while (cond) { __builtin_amdgcn_s_sleep(1); \
    if ((++_sp & 255u) == 0u) { if (xb_ld(&(bar)[XB_TMO])) break; if (_sp > XB_SPIN_CAP) { atomicAdd(&(bar)[XB_TMO], 1u); break; } } } } while (0)

struct XcdBarrier { unsigned* bar; unsigned x; volatile LAS unsigned* st; };

__device__ __forceinline__ XcdBarrier xcd_barrier_post(unsigned* bar, volatile LAS unsigned* st) {
    XcdBarrier b; b.bar = bar; b.x = xb_xcc_id(); b.st = st;
    if (threadIdx.x == 0) (void)xb_add(&bar[XB_XCNT(b.x)], 1u);
    return b;
}
__device__ __forceinline__ void xcd_barrier_complete(unsigned* bar, unsigned x, unsigned& nloc, unsigned& nx) {
    const unsigned G = gridDim.x * gridDim.y * gridDim.z;
    unsigned sum, cnt, mine, sp = 0u;
    for (;;) {
        sum = 0u; cnt = 0u; mine = 0u;
#pragma unroll
        for (unsigned j = 0; j < 16; ++j) { const unsigned c = xb_ld(&bar[XB_XCNT(j)]); sum += c; cnt += (c > 0u) ? 1u : 0u; mine = (j == x) ? c : mine; }
        if (sum == G) break;
        __builtin_amdgcn_s_sleep(1);
        if ((++sp & 255u) == 0u) { if (xb_ld(&bar[XB_TMO])) break; if (sp > XB_SPIN_CAP) { atomicAdd(&bar[XB_TMO], 1u); break; } }
    }
    nloc = mine > 0u ? mine : 1u; nx = cnt > 0u ? cnt : 1u;
}
__device__ __forceinline__ void xcd_barrier(const XcdBarrier& b) {
    asm volatile("s_waitcnt vmcnt(0)" ::: "memory");
    __syncthreads();
    if (threadIdx.x == 0) {
        unsigned* bar = b.bar;
        __builtin_amdgcn_s_waitcnt(0);
        unsigned nloc = b.st[0], nx = b.st[1];
        if (nloc == 0u) { xcd_barrier_complete(bar, b.x, nloc, nx); b.st[0] = nloc; b.st[1] = nx; }
        const unsigned old = xb_add(&bar[XB_XSUB(b.x)], 1u);
        const unsigned gen = old / nloc;
        if (old + 1u == (gen + 1u) * nloc) {
            __builtin_amdgcn_fence(__ATOMIC_RELEASE, "agent");
            asm volatile("s_waitcnt vmcnt(0)" ::: "memory");
            const unsigned og = xb_add(&bar[XB_TOP], 1u);
            const unsigned tg = og / nx;
            if (og + 1u == (tg + 1u) * nx) xb_add(&bar[XB_TOPGEN], 1u);
            else XB_SPIN(xb_ld(&bar[XB_TOPGEN]) == tg, bar);
            __builtin_amdgcn_fence(__ATOMIC_ACQUIRE, "agent");
            xb_add(&bar[XB_XGEN(b.x)], 1u);
            asm volatile("s_waitcnt vmcnt(0)" ::: "memory");
        } else {
            XB_SPIN(xb_ld(&bar[XB_XGEN(b.x)]) == gen, bar);
            __builtin_amdgcn_fence(__ATOMIC_ACQUIRE, "agent");
            asm volatile("s_waitcnt vmcnt(0)" ::: "memory");
        }
    }
    __syncthreads();
}

__device__ __forceinline__ int t5_bucket(int d) {
    if (d < 16) return d;
    int b = 16;
    b += (d >= 22) + (d >= 30) + (d >= 40) + (d >= 54) + (d >= 73) + (d >= 99) + (d >= 134) + (d >= 182) + (d >= 246) + (d >= 332) + (d >= 450) + (d >= 609) + (d >= 825) + (d >= 1117) + (d >= 1513);
    return b;
}
struct Args { const float* in[30]; float* out; unsigned char* ws; int l_lo, l_hi, ph_lo, ph_hi, use_bar, pad; };

namespace pg8 {
struct EpiStoreBf16 {
    static constexpr bool PERM = true;
    bf16* O; int ldc;
    __device__ __forceinline__ void operator()(const f32x4 (&acc)[2][2][4][2], const Unit& u, int wr, int wc, int fr, int fq) const {
        const int row0 = u.pm * BM + wr * 64 + fr, col0 = u.pn * BM + wc * 32 + 8 * fq;
#pragma unroll
        for (int ai = 0; ai < 2; ++ai)
#pragma unroll
            for (int m = 0; m < 4; ++m) { bf16* rowp = O + (size_t)(row0 + ai * HALF + m * 16) * ldc + col0;
#pragma unroll
                for (int bj = 0; bj < 2; ++bj) { const f32x4 v0 = acc[ai][bj][m][0], v1 = acc[ai][bj][m][1];
                    u32x4 w; w.x = cvt_pk_bf16(v0[0], v0[1]); w.y = cvt_pk_bf16(v0[2], v0[3]); w.z = cvt_pk_bf16(v1[0], v1[1]); w.w = cvt_pk_bf16(v1[2], v1[3]);
                    *(u32x4*)(rowp + bj * HALF) = w; } }
    }
};
struct EpiGate {
    static constexpr bool PERM = false;
    const bf16* BR; bf16* MG;
    __device__ __forceinline__ void operator()(const f32x4 (&acc)[2][2][4][2], const Unit& u, int wr, int wc, int fr, int fq) const {
        const int row0 = u.pm * BM + wr * 64 + fr, j0 = u.pn * 64 + wc * 16 + 4 * fq;
#pragma unroll
        for (int ai = 0; ai < 2; ++ai)
#pragma unroll
            for (int m = 0; m < 4; ++m) { const size_t r = (size_t)(row0 + ai * HALF + m * 16);
                float mg0 = 0.f, mg1 = 0.f, mg2 = 0.f, mg3 = 0.f;
#pragma unroll
                for (int bj = 0; bj < 2; ++bj)
#pragma unroll
                    for (int n = 0; n < 2; ++n) { const int g = 2 * bj + n; const u32x2 b = *(const u32x2*)(BR + r * 4096 + g * 1024 + j0); const f32x4 a = acc[ai][bj][m][n];
                        mg0 += sigmoidf_(a[0]) * bflo(b.x); mg1 += sigmoidf_(a[1]) * bfhi(b.x); mg2 += sigmoidf_(a[2]) * bflo(b.y); mg3 += sigmoidf_(a[3]) * bfhi(b.y); }
                u32x2 w; w.x = cvt_pk_bf16(mg0, mg1); w.y = cvt_pk_bf16(mg2, mg3);
                *(u32x2*)(MG + r * 1024 + j0) = w; }
    }
};
struct EpiOut {
    static constexpr bool PERM = true;
    bf16* XB;
    __device__ __forceinline__ void operator()(const f32x4 (&acc)[2][2][4][2], const Unit& u, int wr, int wc, int fr, int fq) const {
        const int row0 = u.pm * BM + wr * 64 + fr, col0 = u.pn * BM + wc * 32 + 8 * fq;
#pragma unroll
        for (int ai = 0; ai < 2; ++ai)
#pragma unroll
            for (int m = 0; m < 4; ++m) { bf16* rowp = XB + (size_t)(row0 + ai * HALF + m * 16) * 1024 + col0;
#pragma unroll
                for (int bj = 0; bj < 2; ++bj) { const f32x4 v0 = acc[ai][bj][m][0], v1 = acc[ai][bj][m][1]; const u32x4 x = *(const u32x4*)(rowp + bj * HALF);
                    u32x4 w; w.x = cvt_pk_bf16(DN_ALPHA * bflo(x.x) + v0[0], DN_ALPHA * bfhi(x.x) + v0[1]); w.y = cvt_pk_bf16(DN_ALPHA * bflo(x.y) + v0[2], DN_ALPHA * bfhi(x.y) + v0[3]);
                    w.z = cvt_pk_bf16(DN_ALPHA * bflo(x.z) + v1[0], DN_ALPHA * bfhi(x.z) + v1[1]); w.w = cvt_pk_bf16(DN_ALPHA * bflo(x.w) + v1[2], DN_ALPHA * bfhi(x.w) + v1[3]);
                    *(u32x4*)(rowp + bj * HALF) = w; } }
    }
};
struct EpiUp {
    static constexpr bool PERM = true;
    const unsigned* rowinfo; bf16* H;
    __device__ __forceinline__ void operator()(const f32x4 (&acc)[2][2][4][2], const Unit& u, int wr, int wc, int fr, int fq) const {
        const int row0 = u.pm * BM + wr * 64 + fr, col0 = u.pn * 128 + wc * 32 + 8 * fq;
#pragma unroll
        for (int ai = 0; ai < 2; ++ai)
#pragma unroll
            for (int m = 0; m < 4; ++m) { const size_t r = (size_t)(row0 + ai * HALF + m * 16); const float w = __uint_as_float(rowinfo[2 * r + 1]);
                const f32x4 g0 = acc[ai][0][m][0], g1 = acc[ai][0][m][1], u0 = acc[ai][1][m][0], u1 = acc[ai][1][m][1];
                float h[8];
#pragma unroll
                for (int e = 0; e < 4; ++e) { h[e] = g0[e] * sigmoidf_(g0[e]) * u0[e] * w; h[4 + e] = g1[e] * sigmoidf_(g1[e]) * u1[e] * w; }
                u32x4 o; o.x = cvt_pk_bf16(h[0], h[1]); o.y = cvt_pk_bf16(h[2], h[3]); o.z = cvt_pk_bf16(h[4], h[5]); o.w = cvt_pk_bf16(h[6], h[7]);
                *(u32x4*)(H + r * 256 + col0) = o; }
    }
};
struct EpiDown {
    static constexpr bool PERM = true;
    const unsigned* rowinfo; bf16* Y;
    __device__ __forceinline__ void operator()(const f32x4 (&acc)[2][2][4][2], const Unit& u, int wr, int wc, int fr, int fq) const {
        const int row0 = u.pm * BM + wr * 64 + fr, col0 = u.pn * BM + wc * 32 + 8 * fq;
#pragma unroll
        for (int ai = 0; ai < 2; ++ai)
#pragma unroll
            for (int m = 0; m < 4; ++m) { const size_t r = (size_t)(row0 + ai * HALF + m * 16); const int ri = (int)rowinfo[2 * r];
                if (ri >= 0) { bf16* rowp = Y + ((size_t)(ri & 1) * NTOK + (size_t)(ri >> 1)) * 1024 + col0;
#pragma unroll
                    for (int bj = 0; bj < 2; ++bj) { const f32x4 v0 = acc[ai][bj][m][0], v1 = acc[ai][bj][m][1];
                        u32x4 w; w.x = cvt_pk_bf16(v0[0], v0[1]); w.y = cvt_pk_bf16(v0[2], v0[3]); w.z = cvt_pk_bf16(v1[0], v1[1]); w.w = cvt_pk_bf16(v1[2], v1[3]);
                        *(u32x4*)(rowp + bj * HALF) = w; } } }
    }
};
}

struct RowMap { int kind, base, g, off;
    __device__ __forceinline__ int operator()(int n) const {
        if (kind == 0) return base + n;
        if (kind == 1) { const int j = base + n, jj = j & 63, pn = j >> 6; return 3072 + pn * 256 + 128 * (g >> 1) + 32 * (jj >> 4) + 16 * (g & 1) + 4 * ((jj >> 2) & 3) + (jj & 3); }
        const int h = base + n; return (h >> 7) * 256 + off + (h & 127);
    }
};
__device__ __forceinline__ void transpose_item(const float* W, int ldw, int k0, int scol0, int nvalid, bf16* WT, int ldk, const RowMap& rm, LAS float* scr, int lane) {
    const int nn = lane & 31;
#pragma unroll 8
    for (int i = 0; i < 32; ++i) { const int kk = 2 * i + (lane >> 5); scr[kk * 33 + nn] = (nn < nvalid) ? W[(size_t)(k0 + kk) * ldw + scol0 + nn] : 0.f; }
    LDS_WAIT(); asm volatile("" ::: "memory");
    const int c = lane & 7;
#pragma unroll
    for (int j = 0; j < 4; ++j) { const int n = (lane >> 3) + 8 * j; const LAS float* s = scr + (8 * c) * 33 + n;
        u32x4 o; o.x = pk2(s[0 * 33], s[1 * 33]); o.y = pk2(s[2 * 33], s[3 * 33]); o.z = pk2(s[4 * 33], s[5 * 33]); o.w = pk2(s[6 * 33], s[7 * 33]);
        *(u32x4*)(WT + (size_t)rm(n) * ldk + k0 + 8 * c) = o; }
    LDS_WAIT(); asm volatile("" ::: "memory");
}
__device__ __forceinline__ void p0_prologue(const Args& a, LAS unsigned char* lds, int gw, int NGW, int wave, int lane) {
    LAS float* scr = (LAS float*)(lds + wave * 16384);
    constexpr int IPL = 16896;
    for (int it = gw; it < NLAYER * IPL; it += NGW) {
        const int l = it / IPL; int r = it - l * IPL;
        unsigned char* wl = a.ws + WS_W + (size_t)l * WL_SIZE;
        RowMap rm; rm.kind = 0; rm.base = 0; rm.g = 0; rm.off = 0;
        if (r < 1536) { const int nt = r % 96, kt = r / 96, n0 = 32 * nt; int nv = 3000 - n0; nv = nv < 0 ? 0 : (nv > 32 ? 32 : nv); rm.base = n0;
            transpose_item(a.in[2] + (size_t)l * 1024 * IN_W, IN_W, 64 * kt, n0, nv, (bf16*)(wl + WL_IN), 1024, rm, scr, lane); continue; }
        r -= 1536;
        if (r < 2048) { const int nt = r % 128, kt = r / 128, gc0 = 32 * nt; rm.kind = 1; rm.g = gc0 >> 10; rm.base = gc0 & 1023;
            transpose_item(a.in[2] + (size_t)l * 1024 * IN_W, IN_W, 64 * kt, 3000 + gc0, 32, (bf16*)(wl + WL_IN), 1024, rm, scr, lane); continue; }
        r -= 2048;
        if (r < 512) { const int nb = r / 128, rr = r % 128, nt = rr % 32, kt = rr / 32; rm.base = nb * 1024 + 32 * nt;
            if (nb != 1) transpose_item(a.in[19] + (size_t)(l * 4 + nb) * 256 * 1024, 1024, 64 * kt, 32 * nt, 32, (bf16*)(wl + WL_BR), 256, rm, scr, lane); continue; }
        r -= 512;
        if (r < 512) { const int nt = r % 32, kt = r / 32; rm.base = 32 * nt;
            transpose_item(a.in[20] + (size_t)l * 1024 * 1024, 1024, 64 * kt, 32 * nt, 32, (bf16*)(wl + WL_OUT), 1024, rm, scr, lane); continue; }
        r -= 512;
        if (r < 8192) { const int up = r >= 4096; if (up) r -= 4096; const int e = r / 128, rr = r % 128, nt = rr % 8, kt = rr / 8; rm.kind = 2; rm.base = 32 * nt; rm.off = up ? 128 : 0;
            transpose_item(a.in[up ? 28 : 27] + (size_t)(l * 32 + e) * 1024 * 256, 256, 64 * kt, 32 * nt, 32, (bf16*)(wl + WL_GU) + (size_t)e * 512 * 1024, 1024, rm, scr, lane); continue; }
        r -= 8192;
        { const int e = r / 128, rr = r % 128, nt = rr % 32, kt = rr / 32; rm.base = 32 * nt;
            transpose_item(a.in[29] + (size_t)(l * 32 + e) * 256 * 1024, 1024, 64 * kt, 32 * nt, 32, (bf16*)(wl + WL_DN) + (size_t)e * 1024 * 256, 256, rm, scr, lane); }
    }
    { float* WRT = (float*)(a.ws + WS_RT); const int gt = gw * 64 + lane, NT = NGW * 64;
      for (int i = gt; i < NLAYER * 4 * 64 * 1024; i += NT) { const int j = i & 1023, c = (i >> 10) & 63, h = (i >> 16) & 3, l = i >> 18;
          const float* wu = a.in[4] + ((size_t)(l * 4 + h) * 64 + c) * 64; const float* wb = a.in[19] + ((size_t)(l * 4 + 1) * 256 + h * 64) * 1024 + j; float acc = 0.f;
#pragma unroll 8
          for (int d = 0; d < 64; ++d) acc += wu[d] * wb[(size_t)d * 1024];
          ((bf16*)(a.ws + WS_W + (size_t)l * WL_SIZE + WL_BR))[(size_t)(1024 + j) * 256 + h * 64 + c] = (bf16)f2bf(acc); }
      for (int i = gt; i < NLAYER * 36 * 1024; i += NT) { const int k = i & 1023, e = (i >> 10) % 36, l = i / (36 * 1024);
          WRT[i] = e < 4 ? a.in[23][((size_t)l * 1024 + k) * 4 + e] : a.in[25][((size_t)l * 1024 + k) * 32 + (e - 4)]; }
      const f32x4* xs = (const f32x4*)a.in[0]; u32x4* xd = (u32x4*)(a.ws + WS_XB);
      for (int i = gt; i < NTOK * DM / 8; i += NT) { const f32x4 v0 = xs[2 * i], v1 = xs[2 * i + 1]; u32x4 o; o.x = pk2(v0[0], v0[1]); o.y = pk2(v0[2], v0[3]); o.z = pk2(v1[0], v1[1]); o.w = pk2(v1[2], v1[3]); xd[i] = o; } }
}

__device__ __forceinline__ float softplusf_(float x) { return fmaxf(x, 0.f) + log1pf(__expf(-fabsf(x))); }
__device__ __forceinline__ void prep_phase(const Args& a, int l, LAS unsigned char* lds, int tid, int gw, int NGW, int lane) {
    const bf16* P = (const bf16*)(a.ws + WS_BIG);
    bf16* CKVN = (bf16*)(a.ws + WS_CKVN); bf16* CQH = (bf16*)(a.ws + WS_CA); bf16* CKT = (bf16*)(a.ws + WS_CA + 16 * MiB); float* CCL = (float*)(a.ws + WS_END); float* BON = (float*)(a.ws + WS_BON);
    bf16* DR = (bf16*)((unsigned char*)a.out + DO_DR); bf16* DKP = (bf16*)((unsigned char*)a.out + DO_DKP); bf16* DV = (bf16*)((unsigned char*)a.out + DO_DV); bf16* DKK = (bf16*)((unsigned char*)a.out + DO_DKK);
    float* DW = (float*)(a.ws + WS_BIG + BIG_DW); bf16* DAI = (bf16*)(a.ws + WS_BIG + BIG_DAI); bf16* DG = (bf16*)(a.ws + WS_BIG + BIG_DG);
    const float* kvg = a.in[3] + l * 64; const float* aup = a.in[5] + l * 16 * 128; const float* abias = a.in[6] + l * 128;
    const float* mu = a.in[8] + l * 832; const float* w0 = a.in[9] + l * 256; const float* w2 = a.in[10] + l * 16 * 256; const float* a0 = a.in[11] + l * 256;
    const float* a2 = a.in[12] + l * 16 * 256; const float* g2 = a.in[13] + l * 32 * 256; const float* kkw = a.in[14] + l * 256; const float* kaw = a.in[15] + l * 256; const float* rkw = a.in[16] + l * 256;
    LAS float* sW2 = (LAS float*)lds; LAS float* sA2 = (LAS float*)(lds + 16384); LAS float* sG2 = (LAS float*)(lds + 32768); LAS float* sUP = (LAS float*)(lds + 65536);
    for (int i = tid; i < 4096; i += NTHR) { sW2[i] = w2[i]; sA2[i] = a2[i]; }
    for (int i = tid; i < 8192; i += NTHR) sG2[i] = g2[i];
    for (int i = tid; i < 2048; i += NTHR) sUP[i] = aup[i];
    __syncthreads();
    float mu_r[13], w0_r[4], a0_r[4], kk_r[4], ka_r[4], rk_r[4];
#pragma unroll
    for (int i = 0; i < 13; ++i) mu_r[i] = mu[64 * i + lane];
#pragma unroll
    for (int i = 0; i < 4; ++i) { const int c = 64 * i + lane; w0_r[i] = w0[c]; a0_r[i] = a0[c]; kk_r[i] = kkw[c]; ka_r[i] = kaw[c]; rk_r[i] = rkw[c]; }
    const float kvg_r = kvg[lane], ab0 = abias[lane], ab1 = abias[64 + lane];
    unsigned short nc[13], np_[13], nckv, nca, nq0, nq1, nk0, nk1;
#define PREP_LOAD(mm) do { const int tt_ = (mm) & (SEQ - 1); const bf16* pr_ = P + (size_t)(mm) * PW; const bf16* pp_ = pr_ - (tt_ > 0 ? PW : 0); \
        _Pragma("unroll") for (int i = 0; i < 13; ++i) { nc[i] = pr_[PC_D + 64 * i + lane]; np_[i] = pp_[PC_D + 64 * i + lane]; } nckv = pr_[PC_CKV + lane]; nca = pr_[PC_CA + (lane & 15)]; nq0 = pr_[PC_CQ + lane]; nq1 = pr_[PC_CQ + 64 + lane]; nk0 = pr_[PC_CK + lane]; nk1 = pr_[PC_CK + 64 + lane]; } while (0)
    constexpr int NCK = NTOK / 16;
    float* DCL = DW;
    if (gw < NCK) PREP_LOAD(gw * 16);
    for (int ck = gw; ck < NCK; ck += NGW) {
      float cpr[4] = {1.f, 1.f, 1.f, 1.f}; float cprc0 = 1.f, cprc1 = 1.f;
#pragma unroll 1
      for (int tt = 0; tt < 16; ++tt) {
        const int m = ck * 16 + tt;
        const int t = m & (SEQ - 1);
        unsigned short cc_[13], cp_[13];
#pragma unroll
        for (int i = 0; i < 13; ++i) { cc_[i] = nc[i]; cp_[i] = np_[i]; }
        const unsigned short cckv = nckv, cca = nca, cq0 = nq0, cq1 = nq1, ck0 = nk0, ck1 = nk1;
        if (tt < 15) PREP_LOAD(m + 1); else if (ck + NGW < NCK) PREP_LOAD((ck + NGW) * 16);
        { const float x = bf2f(cckv); const float ss = wave_sum(x * x); const float rn = rsqrtf(ss * (1.f / 64.f) + 1e-6f); CKVN[(size_t)m * 64 + lane] = (bf16)f2bf(x * rn * kvg_r); }
        { const float cav = (lane < 16) ? bf2f(cca) : 0.f; float z0 = ab0, z1 = ab1;
#pragma unroll
          for (int i = 0; i < 16; ++i) { const float cv = __shfl(cav, i); z0 += cv * sUP[i * 128 + lane]; z1 += cv * sUP[i * 128 + 64 + lane]; }
          cprc0 *= __expf(log_sigmoidf_(z0) * (1.f / 16.f)); cprc1 *= __expf(log_sigmoidf_(z1) * (1.f / 16.f));
          CQH[(size_t)m * 128 + lane] = (bf16)f2bf(bf2f(cq0) * cprc0); CQH[(size_t)m * 128 + 64 + lane] = (bf16)f2bf(bf2f(cq1) * cprc1);
          CKT[(size_t)m * 128 + lane] = (bf16)f2bf(bf2f(ck0) / cprc0); CKT[(size_t)m * 128 + 64 + lane] = (bf16)f2bf(bf2f(ck1) / cprc1);
          if (tt == 15) { CCL[(size_t)ck * 128 + lane] = cprc0; CCL[(size_t)ck * 128 + 64 + lane] = cprc1; } }
        float xs[13];
#pragma unroll
        for (int i = 0; i < 13; ++i) { const float cur = bf2f(cc_[i]); const float prev = (t > 0) ? bf2f(cp_[i]) : 0.f; xs[i] = cur + (prev - cur) * mu_r[i]; }
        const float low = xs[12], tw = tanhf(low), sg = sigmoidf_(low);
        float wr_[4], ar_[4], gv_[4];
#pragma unroll
        for (int i = 0; i < 4; ++i) { wr_[i] = w0_r[i]; ar_[i] = a0_r[i]; gv_[i] = 0.f; }
#pragma unroll 4
        for (int j = 0; j < 16; ++j) { const float tj = __shfl(tw, j), aj = __shfl(low, 16 + j);
#pragma unroll
            for (int i = 0; i < 4; ++i) { wr_[i] += tj * sW2[j * 256 + 64 * i + lane]; ar_[i] += aj * sA2[j * 256 + 64 * i + lane]; } }
#pragma unroll 4
        for (int j = 0; j < 32; ++j) { const float sj = __shfl(sg, 32 + j);
#pragma unroll
            for (int i = 0; i < 4; ++i) gv_[i] += sj * sG2[j * 256 + 64 * i + lane]; }
#pragma unroll
        for (int i = 0; i < 4; ++i) { const int c = 64 * i + lane;
            const float w_raw = -softplusf_(-wr_[i]) - 0.5f, wdec = __expf(-__expf(w_raw));
            const float av = sigmoidf_(ar_[i]);
            const float kx = xs[4 + i]; float kkv = kx * kk_r[i]; const float nrm = sqrtf(wave_sum(kkv * kkv)); kkv = kkv / fmaxf(nrm, 1e-12f);
            const float kp = kx * (1.f + (av - 1.f) * ka_r[i]);
            const float rx = xs[i], vx = xs[8 + i];
            const float bon = wave_sum(rx * kp * rk_r[i]);
            const size_t o = (size_t)m * 256 + c;
            const float ahat = -kkv * cpr[i]; cpr[i] *= wdec; const float cinv = 1.f / cpr[i];
            DR[o] = (bf16)f2bf(rx * cpr[i]); DKP[o] = (bf16)f2bf(kp * cinv); DV[o] = (bf16)f2bf(vx); DKK[o] = (bf16)f2bf(ahat); DAI[o] = (bf16)f2bf(kkv * av * cinv); DG[o] = (bf16)f2bf(gv_[i]);
            if (tt == 15) DCL[(size_t)ck * 256 + c] = cpr[i];
            if (lane == 0) BON[(size_t)m * 4 + i] = bon; }
      }
    }
#undef PREP_LOAD
    __syncthreads();
}

typedef float f32x16 __attribute__((ext_vector_type(16)));
typedef short s16x4 __attribute__((ext_vector_type(4)));
typedef short v4i16_t __attribute__((ext_vector_type(4)));
typedef float f32x2_t __attribute__((ext_vector_type(2))); typedef __bf16 bf16x2_t __attribute__((ext_vector_type(2)));
__device__ __forceinline__ unsigned cvtpk_s(float lo, float hi) { f32x2_t v = {lo, hi}; bf16x2_t b = __builtin_convertvector(v, bf16x2_t); return __builtin_bit_cast(unsigned, b); }
__device__ __forceinline__ s16x4 vtr(const LAS unsigned char* p) { return __builtin_bit_cast(s16x4, __builtin_amdgcn_ds_read_tr16_b64_v4i16((LAS v4i16_t*)p)); }
constexpr int ATB_OFF = 102400;
constexpr int AVI_OFF = 3584;
constexpr float LOG2E = 1.4426950408889634f;
__device__ __forceinline__ void mixA_tables(const Args& a, LAS unsigned char* lds, int tid) {
    LAS float* tb = (LAS float*)(lds + ATB_OFF);
    for (int i = tid; i < 3 * 4 * 192; i += NTHR) { const int e = i % 192, h = (i / 192) & 3, f = i / 768; const int dist = 159 - e; const int dl = f == 0 ? 16 : (f == 1 ? 4 : 1);
        float v = -INFINITY;
        if (dist >= 0 && dist <= 128) { int dd = dist * dl; dd = dd > 2047 ? 2047 : dd; v = a.in[1][t5_bucket(dd) * 8 + h] * LOG2E; }
        tb[i] = v; }
}
__device__ __forceinline__ void mixA_task(const Args& a, int task, LAS unsigned char* lds, int wave, int lane_in) {
    int lane = lane_in; asm volatile("" : "+v"(lane));
    const bf16* P = (const bf16*)(a.ws + WS_BIG); bf16* YS = (bf16*)((unsigned char*)a.out + DO_YS);
    const int cc = 3 - (task & 3), r = (task >> 2) & 15, h = (task >> 6) & 3, b = task >> 8;
    const int ql = lane & 31, hh = lane >> 5, n0 = 32 * cc;
    const size_t rowb = (size_t)b * SEQ; const int tq = 16 * (n0 + ql) + r;
    const LAS float* tball = (const LAS float*)(lds + ATB_OFF) + h * 192;
    LAS unsigned char* vimg = lds + AVI_OFF + wave * 12800;
    bf16x8 qf[4];
    { const bf16* qp = P + (rowb + tq) * PW + PC_AQ + h * 64 + 8 * hh;
#pragma unroll
      for (int ks = 0; ks < 4; ++ks) qf[ks] = *(const bf16x8*)(qp + 16 * ks); }
    f32x16 o0, o1;
#pragma unroll
    for (int i = 0; i < 16; ++i) { o0[i] = 0.f; o1[i] = 0.f; }
    float m = -INFINITY, lsum = 0.f;
    const float SC = 0.125f * LOG2E;
    const int vst = (lane >> 1) * 144 + (lane & 1) * 64;
    const int i16 = lane & 15, tq4 = i16 >> 2, tp = i16 & 3, g16 = (lane >> 4) & 1;
    const int vrd = (4 * hh + tq4) * 144 + 32 * g16 + 8 * tp;
#pragma unroll 1
    for (int f = 0; f < 3; ++f) {
        const int dsh = f == 0 ? 4 : (f == 1 ? 2 : 0);
        const int rho = r & ((1 << dsh) - 1);
        const int qpos = (tq - rho) >> dsh;
        const int qmin = (16 * n0 + r - rho) >> dsh, qmax = (16 * (n0 + 31) + r - rho) >> dsh;
        int klo = qmin - 128; klo = klo < 0 ? 0 : klo; klo &= ~31;
        const LAS float* tbf = tball + f * 768;
        bf16x8 nk[4]; u32x4 nv0, nv1, nv2, nv3;
#define A_LOAD(KK0) do { const size_t tk_ = rowb + (((size_t)((KK0) + ql)) << dsh) + rho; const bf16* kp_ = P + tk_ * PW + PC_AK + h * 64 + 8 * hh; \
            _Pragma("unroll") for (int ks = 0; ks < 4; ++ks) nk[ks] = *(const bf16x8*)(kp_ + 16 * ks); \
            const size_t tv_ = rowb + (((size_t)((KK0) + (lane >> 1))) << dsh) + rho; const u32x4* vp_ = (const u32x4*)(P + tv_ * PW + PC_AV + h * 64 + 32 * (lane & 1)); \
            nv0 = vp_[0]; nv1 = vp_[1]; nv2 = vp_[2]; nv3 = vp_[3]; } while (0)
        A_LOAD(qmax & ~31);
#pragma unroll 1
        for (int k0 = qmax & ~31; k0 >= klo; k0 -= 32) {
            bf16x8 kf[4];
#pragma unroll
            for (int ks = 0; ks < 4; ++ks) kf[ks] = nk[ks];
            const u32x4 v0 = nv0, v1 = nv1, v2 = nv2, v3 = nv3;
            if (k0 - 32 >= klo) A_LOAD(k0 - 32);
            f32x16 st;
#pragma unroll
            for (int i = 0; i < 16; ++i) st[i] = 0.f;
#pragma unroll
            for (int ks = 0; ks < 4; ++ks) st = __builtin_amdgcn_mfma_f32_32x32x16_bf16(kf[ks], qf[ks], st, 0, 0, 0);
            *(LAS u32x4*)(vimg + vst) = v0; *(LAS u32x4*)(vimg + vst + 16) = v1; *(LAS u32x4*)(vimg + vst + 32) = v2; *(LAS u32x4*)(vimg + vst + 48) = v3;
            const int D0 = qpos - k0 - 4 * hh; const int e0 = (D0 >= 0 && D0 <= 159) ? 159 - D0 : 0;
            const LAS float* tp_ = tbf + e0;
            float mx = -INFINITY;
#pragma unroll
            for (int i = 0; i < 16; ++i) { st[i] = st[i] * SC + tp_[(i & 3) + 8 * (i >> 2)]; mx = fmaxf(mx, st[i]); }
            mx = fmaxf(mx, __shfl_xor(mx, 32));
            const float mn = fmaxf(m, mx), alpha = __builtin_amdgcn_exp2f(m - mn);
            m = mn; float ps = 0.f;
#pragma unroll
            for (int i = 0; i < 16; ++i) { st[i] = __builtin_amdgcn_exp2f(st[i] - mn); ps += st[i]; }
            lsum = lsum * alpha + ps;
#pragma unroll
            for (int i = 0; i < 16; ++i) { o0[i] *= alpha; o1[i] *= alpha; }
            bf16x8 pf[2];
#pragma unroll
            for (int s = 0; s < 2; ++s) { u32x4 w; w.x = cvtpk_s(st[8 * s], st[8 * s + 1]); w.y = cvtpk_s(st[8 * s + 2], st[8 * s + 3]); w.z = cvtpk_s(st[8 * s + 4], st[8 * s + 5]); w.w = cvtpk_s(st[8 * s + 6], st[8 * s + 7]); pf[s] = __builtin_bit_cast(bf16x8, w); }
            asm volatile("s_waitcnt lgkmcnt(0)" ::: "memory");
#pragma unroll
            for (int s = 0; s < 2; ++s) {
                const s16x4 a00 = vtr(vimg + vrd + (16 * s) * 144), a01 = vtr(vimg + vrd + (16 * s + 8) * 144);
                const s16x4 a10 = vtr(vimg + vrd + (16 * s) * 144 + 64), a11 = vtr(vimg + vrd + (16 * s + 8) * 144 + 64);
                const bf16x8 A0 = (bf16x8){a00[0], a00[1], a00[2], a00[3], a01[0], a01[1], a01[2], a01[3]};
                const bf16x8 A1 = (bf16x8){a10[0], a10[1], a10[2], a10[3], a11[0], a11[1], a11[2], a11[3]};
                o0 = __builtin_amdgcn_mfma_f32_32x32x16_bf16(A0, pf[s], o0, 0, 0, 0);
                o1 = __builtin_amdgcn_mfma_f32_32x32x16_bf16(A1, pf[s], o1, 0, 0, 0);
            }
            asm volatile("s_waitcnt lgkmcnt(0)" ::: "memory");
        }
#undef A_LOAD
    }
    const float lt = lsum + __shfl_xor(lsum, 32); const float inv = 1.f / lt;
    bf16* yo = YS + (rowb + tq) * 1024 + h * 64 + 4 * hh;
#pragma unroll
    for (int g = 0; g < 4; ++g) {
        u32x2 w; w.x = cvtpk_s(o0[4 * g] * inv, o0[4 * g + 1] * inv); w.y = cvtpk_s(o0[4 * g + 2] * inv, o0[4 * g + 3] * inv); *(u32x2*)(yo + 8 * g) = w;
        u32x2 x; x.x = cvtpk_s(o1[4 * g] * inv, o1[4 * g + 1] * inv); x.y = cvtpk_s(o1[4 * g + 2] * inv, o1[4 * g + 3] * inv); *(u32x2*)(yo + 32 + 8 * g) = x; }
}

__device__ __forceinline__ unsigned fkey(float f) { const unsigned u = __float_as_uint(f); return (u & 0x80000000u) ? ~u : (u | 0x80000000u); }
typedef float f32x4v __attribute__((ext_vector_type(4)));
__device__ __forceinline__ void mixB_attend(const Args& a, int m, const LAS unsigned short* sidx, const LAS unsigned char* sbk, int nsel, LAS unsigned char* lds, LAS unsigned char* img, int lane) {
    const bf16* P = (const bf16*)(a.ws + WS_BIG); const bf16* CKVN = (const bf16*)(a.ws + WS_CKVN); bf16* YS = (bf16*)((unsigned char*)a.out + DO_YS);
    const LAS float* rpb = (const LAS float*)(lds + RPB_OFF);
    const int t = m & (SEQ - 1); const size_t rowb = (size_t)(m - t); const bf16* prow = P + (size_t)m * PW;
    const int hc = lane & 15, g = lane >> 4, hd = lane & 3;
    bf16x8 qB[2];
    { const bf16x8 z = (bf16x8){0, 0, 0, 0, 0, 0, 0, 0}; const bf16* qp = prow + PC_BQ + hd * 64 + 8 * g;
      const bf16x8 q0 = *(const bf16x8*)(qp), q1 = *(const bf16x8*)(qp + 32); qB[0] = hc < 4 ? q0 : z; qB[1] = hc < 4 ? q1 : z; }
    f32x4v oT[4];
#pragma unroll
    for (int mt = 0; mt < 4; ++mt) oT[mt] = (f32x4v){0.f, 0.f, 0.f, 0.f};
    float mrun = -INFINITY, lsum = 0.f;
    const float SC = 0.125f * LOG2E;
    const int i16 = lane & 15, tq4 = i16 >> 2, tp = i16 & 3;
    const int rd_row = (lane & 15) * 144 + 16 * g;
    const int rd_tr = (4 * g + tq4) * 144 + 8 * tp;
    u32x4 g0, g1, g2, g3, g4, g5, g6, g7;
#define BG_LOAD(CH) do { const int kk_ = 64 * (CH) + lane; const int idx_ = (int)sidx[kk_ < nsel ? kk_ : 0] & (SEQ - 1); const u32x4* cp_ = (const u32x4*)(CKVN + (rowb + idx_) * 64); \
        g0 = cp_[0]; g1 = cp_[1]; g2 = cp_[2]; g3 = cp_[3]; g4 = cp_[4]; g5 = cp_[5]; g6 = cp_[6]; g7 = cp_[7]; } while (0)
    BG_LOAD(0);
#pragma unroll 1
    for (int ch = 0; ch < 4; ++ch) {
        if (64 * ch >= nsel) break;
        { LAS u32x4* ip = (LAS u32x4*)(img + lane * 144); ip[0] = g0; ip[1] = g1; ip[2] = g2; ip[3] = g3; ip[4] = g4; ip[5] = g5; ip[6] = g6; ip[7] = g7; }
        if (64 * (ch + 1) < nsel) BG_LOAD(ch + 1);
        asm volatile("s_waitcnt lgkmcnt(0)" ::: "memory");
        f32x4v st[4];
        float mx = -INFINITY;
#pragma unroll
        for (int kt = 0; kt < 4; ++kt) {
            const bf16x8 a0 = *(const LAS bf16x8*)(img + rd_row + (16 * kt) * 144), a1 = *(const LAS bf16x8*)(img + rd_row + (16 * kt) * 144 + 64);
            f32x4v acc = (f32x4v){0.f, 0.f, 0.f, 0.f};
            acc = __builtin_amdgcn_mfma_f32_16x16x32_bf16(a0, qB[0], acc, 0, 0, 0);
            acc = __builtin_amdgcn_mfma_f32_16x16x32_bf16(a1, qB[1], acc, 0, 0, 0);
            const int kb = 64 * ch + 16 * kt + 4 * g;
            const unsigned bk4 = *(const LAS unsigned*)(sbk + kb);
#pragma unroll
            for (int i = 0; i < 4; ++i) { const int bk = (bk4 >> (8 * i)) & 0xff; const float bias = rpb[bk * 8 + 4 + hd] * LOG2E;
                const float v = (kb + i < nsel) ? acc[i] * SC + bias : -INFINITY; acc[i] = v; mx = fmaxf(mx, v); }
            st[kt] = acc; }
        mx = fmaxf(mx, __shfl_xor(mx, 16)); mx = fmaxf(mx, __shfl_xor(mx, 32));
        const float mn = fmaxf(mrun, mx), alpha = __builtin_amdgcn_exp2f(mrun - mn); mrun = mn;
        float ps = 0.f;
#pragma unroll
        for (int kt = 0; kt < 4; ++kt)
#pragma unroll
            for (int i = 0; i < 4; ++i) { st[kt][i] = __builtin_amdgcn_exp2f(st[kt][i] - mn); ps += st[kt][i]; }
        lsum = lsum * alpha + ps;
#pragma unroll
        for (int mt = 0; mt < 4; ++mt) oT[mt] = oT[mt] * alpha;
#pragma unroll
        for (int ks2 = 0; ks2 < 2; ++ks2) {
            u32x4 w; w.x = cvtpk_s(st[2 * ks2][0], st[2 * ks2][1]); w.y = cvtpk_s(st[2 * ks2][2], st[2 * ks2][3]); w.z = cvtpk_s(st[2 * ks2 + 1][0], st[2 * ks2 + 1][1]); w.w = cvtpk_s(st[2 * ks2 + 1][2], st[2 * ks2 + 1][3]);
            const bf16x8 pB = __builtin_bit_cast(bf16x8, w);
#pragma unroll
            for (int mt = 0; mt < 4; ++mt) {
                const s16x4 lo = vtr(img + rd_tr + (32 * ks2) * 144 + 32 * mt), hi = vtr(img + rd_tr + (32 * ks2 + 16) * 144 + 32 * mt);
                const bf16x8 A = (bf16x8){lo[0], lo[1], lo[2], lo[3], hi[0], hi[1], hi[2], hi[3]};
                oT[mt] = __builtin_amdgcn_mfma_f32_16x16x32_bf16(A, pB, oT[mt], 0, 0, 0); } }
        asm volatile("s_waitcnt lgkmcnt(0)" ::: "memory");
    }
#undef BG_LOAD
    float lt = lsum; lt += __shfl_xor(lt, 16); lt += __shfl_xor(lt, 32);
    const float inv = 1.f / lt;
    if (hc < 4) { bf16* yo = YS + (size_t)m * 1024 + 256 + hc * 64 + 4 * g;
#pragma unroll
        for (int mt = 0; mt < 4; ++mt) { u32x2 w; w.x = cvtpk_s(oT[mt][0] * inv, oT[mt][1] * inv); w.y = cvtpk_s(oT[mt][2] * inv, oT[mt][3] * inv); *(u32x2*)(yo + 16 * mt) = w; } }
}
__device__ __forceinline__ void mixB_group(const Args& a, int l, int m0, LAS unsigned char* lds, LAS unsigned char* wscr, int lane_in, const int bmode = 15) {
    int lane = lane_in; asm volatile("" : "+v"(lane));
    const bf16* P = (const bf16*)(a.ws + WS_BIG);
    const int t0 = m0 & (SEQ - 1); const size_t rowb = (size_t)(m0 - t0);
    const int ql = lane & 31, hh = lane >> 5;
    LAS unsigned short* sidx = (LAS unsigned short*)wscr;
    LAS unsigned char* sbk = wscr + 2048;
    LAS unsigned char* img = wscr + 3584;
    const LAS unsigned char* bkt = lds + BKT_OFF;
    bf16x8 qf[2];
    { const int rho = ql, qi = 2 * ((rho >> 2) & 1) + (rho >> 4), hd = 4 * ((rho >> 3) & 1) + (rho & 3);
      const bf16* ip = P + (size_t)(m0 + qi) * PW + PC_IQ + hd * 32 + 8 * hh;
      qf[0] = *(const bf16x8*)(ip); qf[1] = *(const bf16x8*)(ip + 16); }
    float iw[2][8];
#pragma unroll
    for (int qq = 0; qq < 2; ++qq) { const u32x4 w = *(const u32x4*)(P + (size_t)(m0 + 2 * hh + qq) * PW + PC_IW); const float s = 0.0625f;
        iw[qq][0] = bflo(w.x) * s; iw[qq][1] = bfhi(w.x) * s; iw[qq][2] = bflo(w.y) * s; iw[qq][3] = bfhi(w.y) * s; iw[qq][4] = bflo(w.z) * s; iw[qq][5] = bfhi(w.z) * s; iw[qq][6] = bflo(w.w) * s; iw[qq][7] = bfhi(w.w) * s; }
    const int tq0 = t0 + 2 * hh;
    const int ntile = ((t0 + 3) >> 5) + 1;
    unsigned sk[2][64];
#pragma unroll
    for (int kb4 = 0; kb4 < 32; ++kb4) {
        if (2 * kb4 < ntile && (bmode & 1)) {
            bf16x8 kf0[2], kf1[2];
#pragma unroll
            for (int k4 = 0; k4 < 2; ++k4) { const int s = 32 * (2 * kb4 + k4) + ql; const bf16* kp = P + (rowb + s) * PW + PC_IK + 8 * hh; kf0[k4] = *(const bf16x8*)(kp); kf1[k4] = *(const bf16x8*)(kp + 16); }
#pragma unroll
            for (int k4 = 0; k4 < 2; ++k4) { const int kt = 2 * kb4 + k4; const int s = 32 * kt + ql;
                f32x16 acc;
#pragma unroll
                for (int i = 0; i < 16; ++i) acc[i] = 0.f;
                acc = __builtin_amdgcn_mfma_f32_32x32x16_bf16(qf[0], kf0[k4], acc, 0, 0, 0);
                acc = __builtin_amdgcn_mfma_f32_32x32x16_bf16(qf[1], kf1[k4], acc, 0, 0, 0);
                float s0 = 0.f, s1 = 0.f;
#pragma unroll
                for (int i = 0; i < 8; ++i) { s0 += fmaxf(acc[i], 0.f) * iw[0][i]; s1 += fmaxf(acc[8 + i], 0.f) * iw[1][i]; }
                sk[0][kt] = (s <= tq0) ? fkey(s0) : 0x007fffffu; sk[1][kt] = (s <= tq0 + 1) ? fkey(s1) : 0x007fffffu; }
        } else {
#pragma unroll
            for (int k4 = 0; k4 < 2; ++k4) { sk[0][2 * kb4 + k4] = 0x007fffffu; sk[1][2 * kb4 + k4] = 0x007fffffu; }
        }
    }
    const unsigned ltm = (1u << ql) - 1u;
    const int nblk8 = (ntile + 7) >> 3;
#define SK_RED(C) do { C += __builtin_amdgcn_update_dpp(0, C, 0x128, 0xf, 0xf, true); C += __builtin_amdgcn_update_dpp(0, C, 0x124, 0xf, 0xf, true); \
        C += __builtin_amdgcn_update_dpp(0, C, 0x122, 0xf, 0xf, true); C += __builtin_amdgcn_update_dpp(0, C, 0x121, 0xf, 0xf, true); C += __shfl_xor(C, 16); } while (0)
#define SK_COUNT2(OP, R0, R1, C0, C1) do { _Pragma("unroll") for (int kb8 = 0; kb8 < 8; ++kb8) { if (kb8 < nblk8) { _Pragma("unroll") for (int k8 = 0; k8 < 8; ++k8) { \
        C0 += (sk[0][8 * kb8 + k8] OP (R0)) ? 1 : 0; C1 += (sk[1][8 * kb8 + k8] OP (R1)) ? 1 : 0; } } } SK_RED(C0); SK_RED(C1); } while (0)
    unsigned KthA[2] = {0u, 0u}; int needA[2] = {0, 0};
    const bool big0 = (tq0 + 1 > 256), big1 = (tq0 + 2 > 256); bool exact = true;
    if (__any(big0 || big1) && (bmode & 2)) {
        exact = false;
#pragma unroll 1
        for (int bit = 31; bit >= 0; --bit) { const unsigned c0 = KthA[0] | (1u << bit), c1 = KthA[1] | (1u << bit); int n0 = 0, n1 = 0;
            SK_COUNT2(>=, c0, c1, n0, n1);
            if (n0 >= 256) KthA[0] = c0;
            if (n1 >= 256) KthA[1] = c1;
            if (__all((n0 == 256 || !big0) && (n1 == 256 || !big1))) { exact = true; break; }
        }
        if (!exact) { int g0 = 0, g1 = 0; SK_COUNT2(>, KthA[0], KthA[1], g0, g1); needA[0] = 256 - g0; needA[1] = 256 - g1; }
    }
#pragma unroll
    for (int qq = 0; qq < 2; ++qq) {
        if (!(bmode & 4)) break;
        const int tq = tq0 + qq; const bool big = qq ? big1 : big0; const unsigned Kth = KthA[qq]; const int need = needA[qq];
        LAS unsigned short* sx = sidx + (2 * hh + qq) * 256;
        int base = 0, tie_taken = 0; int ql2 = ql; asm volatile("" : "+v"(ql2));
#pragma unroll
        for (int kb8 = 0; kb8 < 8; ++kb8) { if (kb8 < nblk8) {
#pragma unroll
            for (int k8 = 0; k8 < 8; ++k8) { const int kt = 8 * kb8 + k8; const int s = 32 * kt + ql2; const unsigned k = sk[qq][kt]; bool take;
                if (!big) take = (s <= tq);
                else if (exact) take = (k >= Kth);
                else { const bool tie = (k == Kth); const unsigned long long mt = __ballot(tie); const unsigned mt32 = hh ? (unsigned)(mt >> 32) : (unsigned)mt;
                    take = (k > Kth) || (tie && (tie_taken + __popc(mt32 & ltm)) < need); tie_taken += __popc(mt32); }
                const unsigned long long ms = __ballot(take); const unsigned ms32 = hh ? (unsigned)(ms >> 32) : (unsigned)ms;
                if (take) sx[base + __popc(ms32 & ltm)] = (unsigned short)s;
                base += __popc(ms32); } } }
    }
#undef SK_COUNT2
#undef SK_RED
    LDS_WAIT(); asm volatile("" ::: "memory");
#pragma unroll
    for (int qi = 0; qi < 4; ++qi) { const int tq = t0 + qi; const int nsel = (tq + 1 < 256) ? tq + 1 : 256;
#pragma unroll
        for (int j = 0; j < 4; ++j) { const int pos = lane + 64 * j; if (pos < nsel) sbk[qi * 256 + pos] = bkt[tq - (int)sidx[qi * 256 + pos]]; } }
    LDS_WAIT(); asm volatile("" ::: "memory");
#pragma unroll 1
    for (int qi = 0; qi < 4; ++qi) { if (!(bmode & 8)) break; const int tq = t0 + qi; const int nsel = (tq + 1 < 256) ? tq + 1 : 256;
        mixB_attend(a, m0 + qi, sidx + qi * 256, sbk + qi * 256, nsel, lds, img, lane); asm volatile("" ::: "memory"); }
}
constexpr int DM_OFF = 111616;
__device__ __forceinline__ bf16x8 frag2(const LAS unsigned char* p0, const LAS unsigned char* p1) {
    const s16x4 lo = *(const LAS s16x4*)p0, hi = *(const LAS s16x4*)p1; return (bf16x8){lo[0], lo[1], lo[2], lo[3], hi[0], hi[1], hi[2], hi[3]}; }
__device__ __forceinline__ bf16x8 fragtr(const LAS unsigned char* p0, const LAS unsigned char* p1) {
    const s16x4 lo = vtr(p0), hi = vtr(p1); return (bf16x8){lo[0], lo[1], lo[2], lo[3], hi[0], hi[1], hi[2], hi[3]}; }
__device__ __forceinline__ bf16x8 packf(f32x4 lo, f32x4 hi) { u32x4 w; w.x = cvtpk_s(lo[0], lo[1]); w.y = cvtpk_s(lo[2], lo[3]); w.z = cvtpk_s(hi[0], hi[1]); w.w = cvtpk_s(hi[2], hi[3]); return __builtin_bit_cast(bf16x8, w); }
__device__ __forceinline__ void dchunk_wave(const Args& a, int l, int bh, LAS unsigned char* dm, int lane_in) {
    int lane = lane_in; asm volatile("" : "+v"(lane));
    const int b = bh >> 2, h = bh & 3, hc = lane & 15, g = lane >> 4;
    LAS unsigned char* sAT = dm; LAS unsigned char* sBT = dm + 2304; LAS unsigned char* sKT = dm + 4608; LAS unsigned char* sRT = dm + 6912; LAS unsigned char* sVT = dm + 9216; LAS unsigned char* sUT = dm + 11520;
    LAS float* sW1 = (LAS float*)(dm + 13824); LAS float* sMB = (LAS float*)(dm + 17920); LAS float* sCL = (LAS float*)(dm + 18944); LAS float* sBON = (LAS float*)(dm + 19200);
    const bf16* DR = (const bf16*)((unsigned char*)a.out + DO_DR); const bf16* DKP = (const bf16*)((unsigned char*)a.out + DO_DKP); const bf16* DV = (const bf16*)((unsigned char*)a.out + DO_DV); const bf16* DKK = (const bf16*)((unsigned char*)a.out + DO_DKK);
    const float* DCL = (const float*)(a.ws + WS_BIG + BIG_DW); const bf16* DAI = (const bf16*)(a.ws + WS_BIG + BIG_DAI); const bf16* DG = (const bf16*)(a.ws + WS_BIG + BIG_DG);
    const float* BON = (const float*)(a.ws + WS_BON); bf16* YS = (bf16*)((unsigned char*)a.out + DO_YS);
    float gnw[4], gnb[4];
#pragma unroll
    for (int vt = 0; vt < 4; ++vt) { gnw[vt] = a.in[17][l * 256 + h * 64 + 16 * vt + hc]; gnb[vt] = a.in[18][l * 256 + h * 64 + 16 * vt + hc]; }
    const size_t tok0 = (size_t)b * SEQ;
    f32x4v T[4][4];
#pragma unroll
    for (int kt = 0; kt < 4; ++kt)
#pragma unroll
        for (int vt = 0; vt < 4; ++vt) T[kt][vt] = (f32x4v){0.f, 0.f, 0.f, 0.f};
    const int lrow = lane >> 3, lseg = lane & 7;
    u32x4 nA0, nA1, nB0, nB1, nK0, nK1, nR0, nR1, nV0, nV1; float nCL, nBON;
#define DC_LOAD(CH) do { const size_t e0_ = (tok0 + (size_t)(CH) * 16 + lrow) * 256 + h * 64 + 8 * lseg, e1_ = e0_ + 8 * 256; \
        nA0 = *(const u32x4*)(DKK + e0_); nA1 = *(const u32x4*)(DKK + e1_); nB0 = *(const u32x4*)(DAI + e0_); nB1 = *(const u32x4*)(DAI + e1_); nK0 = *(const u32x4*)(DKP + e0_); nK1 = *(const u32x4*)(DKP + e1_); \
        nR0 = *(const u32x4*)(DR + e0_); nR1 = *(const u32x4*)(DR + e1_); nV0 = *(const u32x4*)(DV + e0_); nV1 = *(const u32x4*)(DV + e1_); \
        nCL = DCL[((size_t)b * (SEQ / 16) + (CH)) * 256 + h * 64 + lane]; nBON = BON[(tok0 + (size_t)(CH) * 16 + (lane & 15)) * 4 + h]; } while (0)
    DC_LOAD(0);
    const int st0 = lrow * 144 + lseg * 16, st1 = st0 + 8 * 144;
    const int rdf = hc * 144 + 8 * g;
    const int rdt = (4 * g + (hc >> 2)) * 144 + 8 * (hc & 3);
    __builtin_amdgcn_s_setprio(2);
#pragma unroll 1
    for (int ch = 0; ch < SEQ / 16; ++ch) {
        *(LAS u32x4*)(sAT + st0) = nA0; *(LAS u32x4*)(sAT + st1) = nA1; *(LAS u32x4*)(sBT + st0) = nB0; *(LAS u32x4*)(sBT + st1) = nB1; *(LAS u32x4*)(sKT + st0) = nK0; *(LAS u32x4*)(sKT + st1) = nK1;
        *(LAS u32x4*)(sRT + st0) = nR0; *(LAS u32x4*)(sRT + st1) = nR1; *(LAS u32x4*)(sVT + st0) = nV0; *(LAS u32x4*)(sVT + st1) = nV1; sCL[lane] = nCL; if (lane < 16) sBON[lane] = nBON;
        unsigned short gq[4][4];
#pragma unroll
        for (int vt = 0; vt < 4; ++vt)
#pragma unroll
            for (int i = 0; i < 4; ++i) gq[vt][i] = DG[(tok0 + (size_t)ch * 16 + 4 * g + i) * 256 + h * 64 + 16 * vt + hc];
        asm volatile("s_waitcnt lgkmcnt(0)" ::: "memory");
        bf16x8 fA[2], fR[2], fB[2], fK[2];
#pragma unroll
        for (int ks = 0; ks < 2; ++ks) { fA[ks] = frag2(sAT + rdf + 64 * ks, sAT + rdf + 64 * ks + 32); fR[ks] = frag2(sRT + rdf + 64 * ks, sRT + rdf + 64 * ks + 32);
            fB[ks] = frag2(sBT + rdf + 64 * ks, sBT + rdf + 64 * ks + 32); fK[ks] = frag2(sKT + rdf + 64 * ks, sKT + rdf + 64 * ks + 32); }
        f32x4v U0[4], Y0[4];
#pragma unroll
        for (int vt = 0; vt < 4; ++vt) { const bf16x8 s0 = packf(T[0][vt], T[1][vt]), s1 = packf(T[2][vt], T[3][vt]);
            f32x4v u = (f32x4v){0.f, 0.f, 0.f, 0.f}, y = (f32x4v){0.f, 0.f, 0.f, 0.f};
            u = __builtin_amdgcn_mfma_f32_16x16x32_bf16(fA[0], s0, u, 0, 0, 0); u = __builtin_amdgcn_mfma_f32_16x16x32_bf16(fA[1], s1, u, 0, 0, 0);
            y = __builtin_amdgcn_mfma_f32_16x16x32_bf16(fR[0], s0, y, 0, 0, 0); y = __builtin_amdgcn_mfma_f32_16x16x32_bf16(fR[1], s1, y, 0, 0, 0);
            U0[vt] = u; Y0[vt] = y; }
        f32x4v Mka = (f32x4v){0.f, 0.f, 0.f, 0.f}, Mba = Mka, Mkr = Mka, Mbr = Mka;
#pragma unroll
        for (int ks = 0; ks < 2; ++ks) { Mka = __builtin_amdgcn_mfma_f32_16x16x32_bf16(fK[ks], fA[ks], Mka, 0, 0, 0); Mba = __builtin_amdgcn_mfma_f32_16x16x32_bf16(fB[ks], fA[ks], Mba, 0, 0, 0);
            Mkr = __builtin_amdgcn_mfma_f32_16x16x32_bf16(fK[ks], fR[ks], Mkr, 0, 0, 0); Mbr = __builtin_amdgcn_mfma_f32_16x16x32_bf16(fB[ks], fR[ks], Mbr, 0, 0, 0); }
#pragma unroll
        for (int i = 0; i < 4; ++i) { const int srow = 4 * g + i; if (!(srow < hc)) { Mka[i] = 0.f; Mba[i] = 0.f; } if (!(srow <= hc)) { Mkr[i] = 0.f; Mbr[i] = 0.f; } }
        if (ch + 1 < SEQ / 16) DC_LOAD(ch + 1);
        const f32x4v z4 = (f32x4v){0.f, 0.f, 0.f, 0.f};
        { const bf16x8 aM = packf(Mka, z4);
#pragma unroll
          for (int vt = 0; vt < 4; ++vt) { const s16x4 lo = vtr(sVT + rdt + 32 * vt); const bf16x8 bV = (bf16x8){lo[0], lo[1], lo[2], lo[3], 0, 0, 0, 0};
              U0[vt] = __builtin_amdgcn_mfma_f32_16x16x32_bf16(aM, bV, U0[vt], 0, 0, 0); } }
#pragma unroll
        for (int vt = 0; vt < 4; ++vt)
#pragma unroll
            for (int i = 0; i < 4; ++i) sW1[(4 * g + i) * 64 + 16 * vt + hc] = U0[vt][i];
        *(LAS f32x4v*)(sMB + hc * 16 + 4 * g) = Mba;
        asm volatile("s_waitcnt lgkmcnt(0)" ::: "memory");
        { float u[16];
#pragma unroll
          for (int t = 0; t < 16; ++t) { float acc = sW1[t * 64 + lane];
#pragma unroll
              for (int sq = 0; sq < 4; ++sq) { if (4 * sq < t) { const f32x4v mb = *(const LAS f32x4v*)(sMB + t * 16 + 4 * sq);
#pragma unroll
                  for (int e = 0; e < 4; ++e) if (4 * sq + e < t) acc += mb[e] * u[4 * sq + e]; } }
              u[t] = acc; ((LAS bf16*)sUT)[t * 72 + lane] = (bf16)f2bf(acc); } }
        asm volatile("s_waitcnt lgkmcnt(0)" ::: "memory");
        f32x4v bonv = *(const LAS f32x4v*)(sBON + 4 * g);
        { const bf16x8 aM = packf(Mbr, Mkr);
#pragma unroll
          for (int vt = 0; vt < 4; ++vt) { const bf16x8 bUV = fragtr(sUT + rdt + 32 * vt, sVT + rdt + 32 * vt); Y0[vt] = __builtin_amdgcn_mfma_f32_16x16x32_bf16(aM, bUV, Y0[vt], 0, 0, 0); } }
        { bf16x8 bUV[4];
#pragma unroll
          for (int vt = 0; vt < 4; ++vt) bUV[vt] = fragtr(sUT + rdt + 32 * vt, sVT + rdt + 32 * vt);
#pragma unroll
          for (int kt = 0; kt < 4; ++kt) { const bf16x8 aBK = fragtr(sBT + rdt + 32 * kt, sKT + rdt + 32 * kt); const f32x4v cl = *(const LAS f32x4v*)(sCL + 16 * kt + 4 * g);
#pragma unroll
              for (int vt = 0; vt < 4; ++vt) T[kt][vt] = __builtin_amdgcn_mfma_f32_16x16x32_bf16(aBK, bUV[vt], T[kt][vt], 0, 0, 0) * cl; } }
#pragma unroll
        for (int i = 0; i < 4; ++i) { float sm = (Y0[0][i] + Y0[1][i]) + (Y0[2][i] + Y0[3][i]);
            sm += dppf<0x128>(sm); sm += dppf<0x124>(sm); sm += dppf<0x122>(sm); sm += dppf<0x121>(sm);
            const float mean = sm * (1.f / 64.f); float sq = 0.f;
#pragma unroll
            for (int vt = 0; vt < 4; ++vt) { const float d = Y0[vt][i] - mean; sq += d * d; }
            sq += dppf<0x128>(sq); sq += dppf<0x124>(sq); sq += dppf<0x122>(sq); sq += dppf<0x121>(sq);
            const float rstd = rsqrtf(sq * (1.f / 64.f) + 64e-5f); const int t = 4 * g + i;
#pragma unroll
            for (int vt = 0; vt < 4; ++vt) { const float vv = bf2f(((const LAS bf16*)sVT)[t * 72 + 16 * vt + hc]);
                const float o = ((Y0[vt][i] - mean) * rstd * gnw[vt] + gnb[vt] + bonv[i] * vv) * bf2f(gq[vt][i]);
                YS[(tok0 + (size_t)ch * 16 + t) * 1024 + 768 + h * 64 + 16 * vt + hc] = (bf16)f2bf(o); } }
        asm volatile("s_waitcnt lgkmcnt(0)" ::: "memory");
    }
    __builtin_amdgcn_s_setprio(0);
#undef DC_LOAD
}
__device__ __forceinline__ void cchunk_wave(const Args& a, int l, int bh, LAS unsigned char* dm, int lane_in) {
    int lane = lane_in; asm volatile("" : "+v"(lane));
    const int b = bh >> 2, h = bh & 3, hc = lane & 15, g = lane >> 4;
    LAS unsigned char* sQT = dm; LAS unsigned char* sKT = dm + 1280; LAS unsigned char* sVT = dm + 2560; LAS float* sCL = (LAS float*)(dm + 4864);
    const bf16* P = (const bf16*)(a.ws + WS_BIG); const bf16* CQH = (const bf16*)(a.ws + WS_CA); const bf16* CKT = (const bf16*)(a.ws + WS_CA + 16 * MiB); const float* CCL = (const float*)(a.ws + WS_END);
    bf16* YS = (bf16*)((unsigned char*)a.out + DO_YS);
    float ng[4];
#pragma unroll
    for (int vt = 0; vt < 4; ++vt) ng[vt] = a.in[7][l * 256 + h * 64 + 16 * vt + hc];
    const size_t tok0 = (size_t)b * SEQ;
    f32x4v T[2][4];
#pragma unroll
    for (int kt = 0; kt < 2; ++kt)
#pragma unroll
        for (int vt = 0; vt < 4; ++vt) T[kt][vt] = (f32x4v){0.f, 0.f, 0.f, 0.f};
    const int qrow = lane >> 2, qseg = lane & 3, lrow = lane >> 3, lseg = lane & 7;
    u32x4 nQ, nK, nV0, nV1; float nCL;
#define CC_LOAD(CH) do { const size_t tq_ = tok0 + (size_t)(CH) * 16 + qrow; nQ = *(const u32x4*)(CQH + tq_ * 128 + h * 32 + 8 * qseg); nK = *(const u32x4*)(CKT + tq_ * 128 + h * 32 + 8 * qseg); \
        const size_t tv_ = tok0 + (size_t)(CH) * 16 + lrow; nV0 = *(const u32x4*)(P + tv_ * PW + PC_CV + h * 64 + 8 * lseg); nV1 = *(const u32x4*)(P + (tv_ + 8) * PW + PC_CV + h * 64 + 8 * lseg); \
        nCL = CCL[((size_t)b * (SEQ / 16) + (CH)) * 128 + h * 32 + (lane & 31)]; } while (0)
    CC_LOAD(0);
    const int rdf = hc * 80 + 8 * g;
    const int rdtk = (4 * g + (hc >> 2)) * 80 + 8 * (hc & 3);
    const int rdtv = (4 * g + (hc >> 2)) * 144 + 8 * (hc & 3);
    __builtin_amdgcn_s_setprio(2);
#pragma unroll 1
    for (int ch = 0; ch < SEQ / 16; ++ch) {
        *(LAS u32x4*)(sQT + qrow * 80 + qseg * 16) = nQ; *(LAS u32x4*)(sKT + qrow * 80 + qseg * 16) = nK;
        *(LAS u32x4*)(sVT + lrow * 144 + lseg * 16) = nV0; *(LAS u32x4*)(sVT + (lrow + 8) * 144 + lseg * 16) = nV1; if (lane < 32) sCL[lane] = nCL;
        unsigned short gq[4][4];
#pragma unroll
        for (int vt = 0; vt < 4; ++vt)
#pragma unroll
            for (int i = 0; i < 4; ++i) gq[vt][i] = P[(tok0 + (size_t)ch * 16 + 4 * g + i) * PW + PC_CG + h * 64 + 16 * vt + hc];
        asm volatile("s_waitcnt lgkmcnt(0)" ::: "memory");
        const bf16x8 fQ = frag2(sQT + rdf, sQT + rdf + 32), fK = frag2(sKT + rdf, sKT + rdf + 32);
        f32x4v Y0[4];
#pragma unroll
        for (int vt = 0; vt < 4; ++vt) { const bf16x8 s0 = packf(T[0][vt], T[1][vt]); Y0[vt] = __builtin_amdgcn_mfma_f32_16x16x32_bf16(fQ, s0, (f32x4v){0.f, 0.f, 0.f, 0.f}, 0, 0, 0); }
        f32x4v Mkq = __builtin_amdgcn_mfma_f32_16x16x32_bf16(fK, fQ, (f32x4v){0.f, 0.f, 0.f, 0.f}, 0, 0, 0);
#pragma unroll
        for (int i = 0; i < 4; ++i) if (!(4 * g + i <= hc)) Mkq[i] = 0.f;
        if (ch + 1 < SEQ / 16) CC_LOAD(ch + 1);
        const f32x4v z4 = (f32x4v){0.f, 0.f, 0.f, 0.f};
        bf16x8 bV[4];
#pragma unroll
        for (int vt = 0; vt < 4; ++vt) { const s16x4 lo = vtr(sVT + rdtv + 32 * vt); bV[vt] = (bf16x8){lo[0], lo[1], lo[2], lo[3], 0, 0, 0, 0}; }
        { const bf16x8 aM = packf(Mkq, z4);
#pragma unroll
          for (int vt = 0; vt < 4; ++vt) Y0[vt] = __builtin_amdgcn_mfma_f32_16x16x32_bf16(aM, bV[vt], Y0[vt], 0, 0, 0); }
#pragma unroll
        for (int kt = 0; kt < 2; ++kt) { const s16x4 lo = vtr(sKT + rdtk + 32 * kt); const bf16x8 aK = (bf16x8){lo[0], lo[1], lo[2], lo[3], 0, 0, 0, 0}; const f32x4v cl = *(const LAS f32x4v*)(sCL + 16 * kt + 4 * g);
#pragma unroll
            for (int vt = 0; vt < 4; ++vt) T[kt][vt] = __builtin_amdgcn_mfma_f32_16x16x32_bf16(aK, bV[vt], T[kt][vt], 0, 0, 0) * cl; }
#pragma unroll
        for (int i = 0; i < 4; ++i) { float sq = 0.f;
#pragma unroll
            for (int vt = 0; vt < 4; ++vt) { const float o = Y0[vt][i] * 0.17677669529663687f; Y0[vt][i] = o; sq += o * o; }
            sq += dppf<0x128>(sq); sq += dppf<0x124>(sq); sq += dppf<0x122>(sq); sq += dppf<0x121>(sq);
            const float rn = rsqrtf(sq * (1.f / 64.f) + 1e-6f); const int t = 4 * g + i;
#pragma unroll
            for (int vt = 0; vt < 4; ++vt) { const float gg = bf2f(gq[vt][i]);
                YS[(tok0 + (size_t)ch * 16 + t) * 1024 + 512 + h * 64 + 16 * vt + hc] = (bf16)f2bf(gg * sigmoidf_(gg) * (Y0[vt][i] * rn * ng[vt])); } }
        asm volatile("s_waitcnt lgkmcnt(0)" ::: "memory");
    }
    __builtin_amdgcn_s_setprio(0);
#undef CC_LOAD
}
__device__ __forceinline__ void mixers_phase(const Args& a, int l, LAS unsigned char* lds, int bid, int G, int tid, int wave, int lane, int qsel = 0, int mixmask = 15, const int bmode = 15) {
    unsigned* qh = (unsigned*)(a.ws + WS_CTL) + CW_Q + 64 * l + 16 * qsel;
    LAS unsigned char* wscr = lds + wave * 12800;
    mixA_tables(a, lds, tid); __syncthreads();
    if (wave == 0) for (int it = bid; it < 256; it += G) { if (it < 128) { if (mixmask & 1) dchunk_wave(a, l, it, lds + DM_OFF, lane); } else { if (mixmask & 2) cchunk_wave(a, l, it - 128, lds + DM_OFF, lane); } }
    for (;;) {
        unsigned cq = 0; if (lane == 0) cq = __hip_atomic_fetch_add(qh, 1u, __ATOMIC_RELAXED, __HIP_MEMORY_SCOPE_AGENT);
        cq = (unsigned)__builtin_amdgcn_readfirstlane((int)cq);
        if (cq >= 16384u) break;
        if (cq < 8192u) { if (!(mixmask & 8)) continue; const int tb = 255 - (int)(cq >> 5), b = (int)(cq & 31u); const int m0 = b * SEQ + tb * 8;
#pragma unroll 1
            for (int k = 0; k < 2; ++k) {
#ifndef MIX_NO_B
                mixB_group(a, l, m0 + 4 * k, lds, wscr, lane, bmode);
#endif
            } }
        else { if (!(mixmask & 4)) continue;
#ifndef MIX_NO_A
            mixA_task(a, (int)(cq - 8192u), lds, wave, lane);
#endif
        }
    }
}

constexpr int RREC_OFF = MISC_OFF + 4096, LCNT_OFF = MISC_OFF + 10240, LBASE_OFF = MISC_OFF + 10368;
__device__ __forceinline__ void ln1_route_phase(const Args& a, int l, LAS unsigned char* lds, int bid, int G, int tid, int wave, int lane) {
    bf16* XB = (bf16*)(a.ws + WS_XB); const float* WRT = (const float*)(a.ws + WS_RT) + (size_t)l * 36 * 1024;
    unsigned* tokinfo = (unsigned*)(a.ws + WS_TOK); unsigned* cntg = (unsigned*)(a.ws + WS_CTL) + CW_CNT + (l * 32) * 64;
    const float* lng = a.in[21] + (l * 2 + 0) * 1024; const float* lnb = a.in[22] + (l * 2 + 0) * 1024;
    const float* brg = a.in[24] + l * 4; const float* bre = a.in[26] + l * 32;
    LAS float* sW = (LAS float*)lds;
    LAS unsigned* rrec = (LAS unsigned*)(lds + RREC_OFF); LAS int* lcnt = (LAS int*)(lds + LCNT_OFF); LAS unsigned* lbase = (LAS unsigned*)(lds + LBASE_OFF);
    for (int i = tid; i < 32 * 1024 / 4; i += NTHR) *(LAS f32x4*)(sW + 4 * i) = *(const f32x4*)(WRT + 4 * 1024 + 4 * i);
    f32x4 gam[4], bet[4], wg[4][4];
#pragma unroll
    for (int j = 0; j < 4; ++j) { gam[j] = *(const f32x4*)(lng + 4 * lane + 256 * j); bet[j] = *(const f32x4*)(lnb + 4 * lane + 256 * j);
#pragma unroll
        for (int e = 0; e < 4; ++e) wg[e][j] = *(const f32x4*)(WRT + e * 1024 + 4 * lane + 256 * j); }
    for (int blk = bid; blk < NTOK / 256; blk += G) {
        if (tid < 32) lcnt[tid] = 0;
        __syncthreads();
#pragma unroll 1
        for (int rg = 0; rg < 8; ++rg) {
            const int rl0 = wave * 32 + rg * 4; f32x4 x[4][4];
#pragma unroll
            for (int r = 0; r < 4; ++r) { bf16* xr = XB + (size_t)(blk * 256 + rl0 + r) * 1024; float s = 0.f;
#pragma unroll
                for (int j = 0; j < 4; ++j) { const u32x2 w = *(const u32x2*)(xr + 4 * lane + 256 * j); x[r][j] = (f32x4){bflo(w.x), bfhi(w.x), bflo(w.y), bfhi(w.y)}; s += (x[r][j][0] + x[r][j][1]) + (x[r][j][2] + x[r][j][3]); }
                const float mean = wave_sum(s) * (1.f / 1024.f); float q = 0.f;
#pragma unroll
                for (int j = 0; j < 4; ++j) { x[r][j] = x[r][j] - mean; q += (x[r][j][0] * x[r][j][0] + x[r][j][1] * x[r][j][1]) + (x[r][j][2] * x[r][j][2] + x[r][j][3] * x[r][j][3]); }
                const float rstd = rsqrtf(wave_sum(q) * (1.f / 1024.f) + LN_EPS);
#pragma unroll
                for (int j = 0; j < 4; ++j) { x[r][j] = x[r][j] * rstd * gam[j] + bet[j]; u32x2 w; w.x = pk2(x[r][j][0], x[r][j][1]); w.y = pk2(x[r][j][2], x[r][j][3]); *(u32x2*)(xr + 4 * lane + 256 * j) = w; }
                }
            float gl[4][4];
#pragma unroll
            for (int e = 0; e < 4; ++e)
#pragma unroll
                for (int r = 0; r < 4; ++r) { float d = 0.f;
#pragma unroll
                    for (int j = 0; j < 4; ++j) d += (x[r][j][0] * wg[e][j][0] + x[r][j][1] * wg[e][j][1]) + (x[r][j][2] * wg[e][j][2] + x[r][j][3] * wg[e][j][3]);
                    gl[r][e] = wave_sum(d) + brg[e]; }
#pragma unroll
            for (int r = 0; r < 4; ++r) {
                const float g0 = gl[r][0], g1 = gl[r][1], g2 = gl[r][2], g3 = gl[r][3];
                int gsv = 0; float gm = g0; if (g1 > gm) { gm = g1; gsv = 1; } if (g2 > gm) { gm = g2; gsv = 2; } if (g3 > gm) { gm = g3; gsv = 3; }
                const int gs = __builtin_amdgcn_readfirstlane(gsv);
                const float ptop = 1.f / (__expf(g0 - gm) + __expf(g1 - gm) + __expf(g2 - gm) + __expf(g3 - gm));
                float v0 = -INFINITY, v1 = -INFINITY; int i0 = 0, i1 = 0;
#pragma unroll 2
                for (int jj = 0; jj < 8; ++jj) { const int e = gs * 8 + jj; float d = 0.f;
#pragma unroll
                    for (int j = 0; j < 4; ++j) { const f32x4 w4 = *(const LAS f32x4*)(sW + e * 1024 + 4 * lane + 256 * j); d += (x[r][j][0] * w4[0] + x[r][j][1] * w4[1]) + (x[r][j][2] * w4[2] + x[r][j][3] * w4[3]); }
                    const float le = wave_sum(d) + bre[e];
                    if (le > v0) { v1 = v0; i1 = i0; v0 = le; i0 = jj; } else if (le > v1) { v1 = le; i1 = jj; } }
                const float ex = __expf(v1 - v0), w0 = ptop / (1.f + ex), w1 = ptop * ex / (1.f + ex);
                if (lane == 0) { const int e0 = gs * 8 + i0, e1 = gs * 8 + i1; const int rl = rl0 + r;
                    const int p0 = atomicAdd((int*)&lcnt[e0], 1), p1 = atomicAdd((int*)&lcnt[e1], 1);
                    rrec[rl * 6 + 0] = (unsigned)e0; rrec[rl * 6 + 1] = (unsigned)p0; rrec[rl * 6 + 2] = __float_as_uint(w0); rrec[rl * 6 + 3] = (unsigned)e1; rrec[rl * 6 + 4] = (unsigned)p1; rrec[rl * 6 + 5] = __float_as_uint(w1); } }
        }
        __syncthreads();
        if (tid < 32) lbase[tid] = __hip_atomic_fetch_add(cntg + tid * 64, (unsigned)lcnt[tid], __ATOMIC_RELAXED, __HIP_MEMORY_SCOPE_AGENT);
        __syncthreads();
        if (tid < 256) { const unsigned e0 = rrec[tid * 6 + 0], e1 = rrec[tid * 6 + 3]; unsigned* ti = tokinfo + (size_t)(blk * 256 + tid) * 8;
            u32x4 o0, o1; o0.x = e0; o0.y = lbase[e0] + rrec[tid * 6 + 1]; o0.z = rrec[tid * 6 + 2]; o0.w = e1; o1.x = lbase[e1] + rrec[tid * 6 + 4]; o1.y = rrec[tid * 6 + 5]; o1.z = 0u; o1.w = 0u;
            *(u32x4*)ti = o0; *(u32x4*)(ti + 4) = o1; }
        __syncthreads();
    }
}
__device__ __forceinline__ void moe_table(const Args& a, int l, LAS unsigned char* lds, int tid) {
    LAS int* tstart = (LAS int*)(lds + TST_OFF);
    if (tid == 0) { const unsigned* cntg = (const unsigned*)(a.ws + WS_CTL) + CW_CNT + (l * 32) * 64; int acc = 0;
        for (int e = 0; e < 32; ++e) { tstart[e] = acc; acc += (int)((__hip_atomic_load(cntg + e * 64, __ATOMIC_RELAXED, __HIP_MEMORY_SCOPE_AGENT) + 255u) >> 8); }
        tstart[32] = acc; }
    __syncthreads();
}
__device__ __forceinline__ void scatter_phase(const Args& a, int l, LAS unsigned char* lds, int bid, int G, int tid, int gw, int NGW, int lane) {
    const LAS int* tstart = (const LAS int*)(lds + TST_OFF);
    const bf16* XB = (const bf16*)(a.ws + WS_XB); bf16* XS = (bf16*)(a.ws + WS_BIG); unsigned* rowinfo = (unsigned*)(a.ws + WS_ROW); const unsigned* tokinfo = (const unsigned*)(a.ws + WS_TOK);
    const unsigned* cntg = (const unsigned*)(a.ws + WS_CTL) + CW_CNT + (l * 32) * 64;
    for (int e = bid; e < 32; e += G) { const int c = (int)__hip_atomic_load(cntg + e * 64, __ATOMIC_RELAXED, __HIP_MEMORY_SCOPE_AGENT); const int r0 = tstart[e] * 256, r1 = tstart[e + 1] * 256;
        unsigned neg_ = 0xffffffffu, zer_ = 0u; asm volatile("" : "+v"(neg_), "+v"(zer_));
        for (int r = r0 + c + tid; r < r1; r += NTHR) { rowinfo[2 * (size_t)r] = neg_; rowinfo[2 * (size_t)r + 1] = zer_; } }
    u32x4 nt0, nv0, nv1; u32x2 nt1;
#define SC_LOAD(mm) do { nt0 = *(const u32x4*)(tokinfo + (size_t)(mm) * 8); nt1 = *(const u32x2*)(tokinfo + (size_t)(mm) * 8 + 4); const u32x4* src_ = (const u32x4*)(XB + (size_t)(mm) * 1024); nv0 = src_[lane]; nv1 = src_[64 + lane]; } while (0)
    if (gw < NTOK) SC_LOAD(gw);
    for (int m = gw; m < NTOK; m += NGW) {
        const u32x4 t0 = nt0, v0 = nv0, v1 = nv1; const u32x2 t1 = nt1;
        if (m + NGW < NTOK) SC_LOAD(m + NGW);
        const size_t r0 = (size_t)tstart[t0.x] * 256 + t0.y, r1 = (size_t)tstart[t0.w] * 256 + t1.x;
        u32x4* d0 = (u32x4*)(XS + r0 * 1024); u32x4* d1 = (u32x4*)(XS + r1 * 1024);
        d0[lane] = v0; d0[64 + lane] = v1; d1[lane] = v0; d1[64 + lane] = v1;
        if (lane == 0) { rowinfo[2 * r0] = (unsigned)(m * 2); rowinfo[2 * r0 + 1] = t0.z; rowinfo[2 * r1] = (unsigned)(m * 2 + 1); rowinfo[2 * r1 + 1] = t1.y; }
    }
}
__device__ __forceinline__ void ln2_phase(const Args& a, int l, int gw, int NGW, int lane) {
    bf16* XB = (bf16*)(a.ws + WS_XB); const bf16* Y = (const bf16*)(a.ws + WS_BIG);
    const float* lng = a.in[21] + (l * 2 + 1) * 1024; const float* lnb = a.in[22] + (l * 2 + 1) * 1024;
    f32x4 gam[4], bet[4];
#pragma unroll
    for (int j = 0; j < 4; ++j) { gam[j] = *(const f32x4*)(lng + 4 * lane + 256 * j); bet[j] = *(const f32x4*)(lnb + 4 * lane + 256 * j); }
    u32x2 nw[4], np2[4], nq2[4];
#define LN2_LOAD(mm) do { const bf16* xr_ = XB + (size_t)(mm) * 1024 + 4 * lane; const bf16* y0_ = Y + (size_t)(mm) * 1024 + 4 * lane; const bf16* y1_ = Y + ((size_t)NTOK + (mm)) * 1024 + 4 * lane; \
        _Pragma("unroll") for (int j = 0; j < 4; ++j) { nw[j] = *(const u32x2*)(xr_ + 256 * j); np2[j] = *(const u32x2*)(y0_ + 256 * j); nq2[j] = *(const u32x2*)(y1_ + 256 * j); } } while (0)
    if (gw < NTOK) LN2_LOAD(gw);
    for (int m = gw; m < NTOK; m += NGW) {
        bf16* xr = XB + (size_t)m * 1024;
        u32x2 cw[4], cp2[4], cq2[4];
#pragma unroll
        for (int j = 0; j < 4; ++j) { cw[j] = nw[j]; cp2[j] = np2[j]; cq2[j] = nq2[j]; }
        if (m + NGW < NTOK) LN2_LOAD(m + NGW);
        f32x4 x[4]; float s = 0.f;
#pragma unroll
        for (int j = 0; j < 4; ++j) { const u32x2 w = cw[j], p = cp2[j], q = cq2[j];
            x[j] = (f32x4){DN_ALPHA * bflo(w.x) + (bflo(p.x) + bflo(q.x)), DN_ALPHA * bfhi(w.x) + (bfhi(p.x) + bfhi(q.x)), DN_ALPHA * bflo(w.y) + (bflo(p.y) + bflo(q.y)), DN_ALPHA * bfhi(w.y) + (bfhi(p.y) + bfhi(q.y))};
            s += (x[j][0] + x[j][1]) + (x[j][2] + x[j][3]); }
        const float mean = wave_sum(s) * (1.f / 1024.f); float q = 0.f;
#pragma unroll
        for (int j = 0; j < 4; ++j) { x[j] = x[j] - mean; q += (x[j][0] * x[j][0] + x[j][1] * x[j][1]) + (x[j][2] * x[j][2] + x[j][3] * x[j][3]); }
        const float rstd = rsqrtf(wave_sum(q) * (1.f / 1024.f) + LN_EPS);
#pragma unroll
        for (int j = 0; j < 4; ++j) { x[j] = x[j] * rstd * gam[j] + bet[j];
            if (l == NLAYER - 1) *(f32x4*)(a.out + (size_t)m * 1024 + 4 * lane + 256 * j) = x[j];
            else { u32x2 w; w.x = pk2(x[j][0], x[j][1]); w.y = pk2(x[j][2], x[j][3]); *(u32x2*)(xr + 4 * lane + 256 * j) = w; } }
    }
}

#ifndef MK_MULTI
#define MK_MULTI 0
#endif
constexpr int NPHASE = 12;
__global__ void __launch_bounds__(NTHR, 2) fwd(Args a) {
    extern __shared__ __attribute__((aligned(16))) unsigned char lds_raw[];
    LAS unsigned char* lds = (LAS unsigned char*)lds_raw;
    const int G0 = gridDim.x, bid0 = blockIdx.x, wave0 = __builtin_amdgcn_readfirstlane((int)(threadIdx.x >> 6));
#define PH_IDS unsigned on_ = ~0u; asm volatile("" : "+s"(on_)); int lz_ = (int)__builtin_amdgcn_mbcnt_hi(on_, __builtin_amdgcn_mbcnt_lo(on_, 0u)); int wz_ = wave0, bz_ = bid0, gz_ = G0; asm volatile("" : "+s"(wz_), "+s"(bz_), "+s"(gz_)); \
    const int lane = lz_, wave = wz_, tid = wz_ * 64 + lz_, bid = bz_, G = gz_, NGW = gz_ * NWAVES, gw = bid * NWAVES + wave; (void)lane; (void)gw; (void)wave; (void)tid; (void)NGW;
#define PH_ARGS(LV) const __attribute__((address_space(4))) Args* kp_ = (const __attribute__((address_space(4))) Args*)__builtin_amdgcn_kernarg_segment_ptr(); asm volatile("" : "+s"(kp_)); const Args& b = *(const Args*)kp_; int lq = (LV); asm volatile("" : "+s"(lq)); (void)lq; \
    bf16* XB = (bf16*)(b.ws + WS_XB); bf16* PB = (bf16*)(b.ws + WS_BIG); bf16* YS = (bf16*)((unsigned char*)b.out + DO_YS); bf16* MG = (bf16*)((unsigned char*)b.out + DO_MG); \
    unsigned* rowinfo = (unsigned*)(b.ws + WS_ROW); unsigned char* wl = b.ws + WS_W + (size_t)lq * WL_SIZE; (void)XB; (void)PB; (void)YS; (void)MG; (void)rowinfo; (void)wl;
    unsigned* ctl = (unsigned*)(a.ws + WS_CTL);
    { PH_IDS
    for (int u = tid; u < (LDS_BYTES - MISC_OFF) / 4; u += NTHR) ((LAS unsigned*)(lds + MISC_OFF))[u] = 0u;
    __syncthreads();
    for (int d = tid; d < 2048; d += NTHR) ((LAS unsigned char*)(lds + BKT_OFF))[d] = (unsigned char)t5_bucket(d);
    if (tid < 256) ((LAS float*)(lds + RPB_OFF))[tid] = a.in[1][tid];
    __syncthreads(); }
    XcdBarrier bar; bar.bar = ctl + CW_BAR; bar.x = 0; bar.st = nullptr;
    if (a.use_bar) bar = xcd_barrier_post(ctl + CW_BAR, (volatile LAS unsigned*)(lds + MISC_OFF) + 8);
#define GRID_BAR() do { if (a.use_bar) { const __attribute__((address_space(4))) Args* kq_ = (const __attribute__((address_space(4))) Args*)__builtin_amdgcn_kernarg_segment_ptr(); asm volatile("" : "+s"(kq_)); \
        XcdBarrier bb_ = bar; bb_.bar = (unsigned*)(kq_->ws + WS_CTL) + CW_BAR; xcd_barrier(bb_); } } while (0)
#ifndef PHMASK
#define PHMASK 0xFFF
#endif
#define IN(k) (((PHMASK >> (k)) & 1) && ((phm >> (k)) & 1u))

    unsigned phm = ((1u << a.ph_hi) - 1u) & ~((1u << a.ph_lo) - 1u);
    if (a.l_lo == 0 && IN(0)) { PH_IDS PH_ARGS(0) p0_prologue(b, lds, gw, NGW, wave, lane); GRID_BAR(); }
    for (int l = a.l_lo; l < a.l_hi; ++l) {
        asm volatile("" : "+s"(phm));
        if (IN(1)) { PH_IDS PH_ARGS(l) pg8::Gemm g{XB, (const bf16*)(wl + WL_IN), 1024, 1024, 1024}; pg8::GridOrder S; S.init(NTOK / 256, PW / 256, G, bid);
            pg8::EpiStoreBf16 E{PB, PW}; pg8::gemm_phase(lds, g, S, E, tid); GRID_BAR(); }
        if (IN(2)) { PH_IDS PH_ARGS(l) prep_phase(b, lq, lds, tid, gw, NGW, lane); GRID_BAR(); }
        if (IN(3)) { PH_IDS PH_ARGS(l) mixers_phase(b, lq, lds, bid, G, tid, wave, lane); GRID_BAR(); }
        if (IN(4)) { PH_IDS PH_ARGS(l) pg8::Gemm g{YS, (const bf16*)(wl + WL_BR), 1024, 256, 256}; pg8::GridOrder S; S.init(NTOK / 256, 16, G, bid, 4, 512);
            pg8::EpiStoreBf16 E{PB, 4096}; pg8::gemm_phase(lds, g, S, E, tid); GRID_BAR(); }
        if (IN(5)) { PH_IDS PH_ARGS(l) pg8::Gemm g{XB, (const bf16*)(wl + WL_IN) + (size_t)3072 * 1024, 1024, 1024, 1024}; pg8::GridOrder S; S.init(NTOK / 256, 16, G, bid);
            pg8::EpiGate E{PB, MG}; pg8::gemm_phase(lds, g, S, E, tid); GRID_BAR(); }
        if (IN(6)) { PH_IDS PH_ARGS(l) pg8::Gemm g{MG, (const bf16*)(wl + WL_OUT), 1024, 1024, 1024}; pg8::GridOrder S; S.init(NTOK / 256, 4, G, bid);
            pg8::EpiOut E{XB}; pg8::gemm_phase(lds, g, S, E, tid); GRID_BAR(); }
        if (IN(7)) { PH_IDS PH_ARGS(l) ln1_route_phase(b, lq, lds, bid, G, tid, wave, lane); GRID_BAR(); }
        if (IN(8)) { PH_IDS PH_ARGS(l) moe_table(b, lq, lds, tid); scatter_phase(b, lq, lds, bid, G, tid, gw, NGW, lane); GRID_BAR(); }
        if (IN(9)) { PH_IDS PH_ARGS(l) moe_table(b, lq, lds, tid); pg8::Gemm g{PB, (const bf16*)(wl + WL_GU), 1024, 1024, 1024}; pg8::MoeOrder S{(const LAS int*)(lds + TST_OFF), 1, G, bid};
            pg8::EpiUp E{rowinfo, (bf16*)(b.ws + WS_BIG + BIG_H)}; pg8::gemm_phase(lds, g, S, E, tid); GRID_BAR(); }
        if (IN(10)) { PH_IDS PH_ARGS(l) moe_table(b, lq, lds, tid); pg8::Gemm g{(const bf16*)(b.ws + WS_BIG + BIG_H), (const bf16*)(wl + WL_DN), 256, 256, 256}; pg8::MoeOrder S{(const LAS int*)(lds + TST_OFF), 2, G, bid};
            pg8::EpiDown E{rowinfo, PB}; pg8::gemm_phase(lds, g, S, E, tid); GRID_BAR(); }
        if (IN(11)) { PH_IDS PH_ARGS(l) ln2_phase(b, lq, gw, NGW, lane); if (l + 1 < a.l_hi) GRID_BAR(); }
    }
#undef IN
#undef GRID_BAR
}

extern "C" void kernel_launch(void* const* d_in, const int* in_sizes, int n_in, void* d_out, int out_size, void* d_ws, size_t ws_size, hipStream_t stream) {
    static int grid = 0;
    if (grid == 0) {
        if (n_in != 30 || out_size != NTOK * DM || ws_size < WS_END + 2 * MiB) { fprintf(stderr, "kernel_launch: unexpected shapes (n_in %d out %d ws %zu)\n", n_in, out_size, ws_size); grid = -1; return; }
        int dev = 0, cus = 0, per_cu = 0;
        if (hipGetDevice(&dev) != hipSuccess || hipDeviceGetAttribute(&cus, hipDeviceAttributeMultiprocessorCount, dev) != hipSuccess) { grid = -1; return; }
        if (hipFuncSetAttribute((const void*)fwd, hipFuncAttributeMaxDynamicSharedMemorySize, LDS_BYTES) != hipSuccess) { fprintf(stderr, "kernel_launch: hipFuncSetAttribute failed\n"); grid = -1; return; }
        if (hipOccupancyMaxActiveBlocksPerMultiprocessor(&per_cu, (const void*)fwd, NTHR, LDS_BYTES) != hipSuccess || per_cu < 1) fprintf(stderr, "kernel_launch: occupancy query says %d\n", per_cu);
        (void)hipGetLastError();
        grid = cus;
    }
    if (grid < 0) return;
    (void)hipMemsetAsync((char*)d_ws + WS_CTL, 0, CTL_ZERO_BYTES, stream);
    Args a{};
    for (int i = 0; i < 30; ++i) a.in[i] = (const float*)d_in[i];
    a.out = (float*)d_out; a.ws = (unsigned char*)d_ws; a.pad = 0;
#if MK_MULTI
    a.use_bar = 0;
    for (int l = 0; l < NLAYER; ++l)
        for (int ph = (l == 0 ? 0 : 1); ph < NPHASE; ++ph) { a.l_lo = l; a.l_hi = l + 1; a.ph_lo = ph; a.ph_hi = ph + 1;
            hipLaunchKernelGGL(fwd, dim3(grid), dim3(NTHR), LDS_BYTES, stream, a); }
#else
    a.use_bar = 1; a.l_lo = 0; a.l_hi = NLAYER; a.ph_lo = 0; a.ph_hi = NPHASE;
    hipLaunchKernelGGL(fwd, dim3(grid), dim3(NTHR), LDS_BYTES, stream, a);
#endif
    const hipError_t le = hipPeekAtLastError();
    if (le != hipSuccess) fprintf(stderr, "kernel_launch: launch failed: %s\n", hipGetErrorName(le));
}
```

```cpp
#include <hip/hip_runtime.h>
#include <cstdio>
#include <cstdint>

#define LAS __attribute__((address_space(3)))
#define GAS __attribute__((address_space(1)))
typedef unsigned short bf16;
typedef short bf16x8 __attribute__((ext_vector_type(8)));
typedef float f32x4 __attribute__((ext_vector_type(4)));
typedef float f32x2 __attribute__((ext_vector_type(2)));
typedef unsigned u32x4 __attribute__((ext_vector_type(4)));
typedef unsigned u32x2 __attribute__((ext_vector_type(2)));

namespace pg8 {
constexpr int BM = 256, BK = 64, HALF = 128, HTB = HALF * BK * 2  , STAGE_BYTES = 8 * HTB, NXCD = 8, WGM = 8;

__host__ __device__ __forceinline__ int lds_byte(int r, int c) { const int st = (r >> 4) * 2 + (c >> 5), rr = r & 15, cc = c & 31, ob = rr * 64 + cc * 2; return st * 1024 + (ob ^ (((ob >> 9) & 1) << 5)); }
__host__ __device__ __forceinline__ void stage_rc(int b, int& R, int& C) { const int st = b / 1024, sb = b % 1024, swz = sb ^ (((sb >> 9) & 1) << 5); R = (st >> 1) * 16 + swz / 64; C = (st & 1) * 32 + (swz % 64) / 2; }
__host__ __device__ __forceinline__ int perm32(int rho) { const int n = rho >> 4, i = rho & 15; return 8 * (i >> 2) + 4 * n + (i & 3); }

struct Unit { int pm, pn, pb; unsigned aoff; };
struct Gemm { const bf16* A; const bf16* Bt; int lda, ldb, K; };

struct GridOrder {
    int nM, nN, nwg, G, c, a_grp, a_grp_bytes;
    __device__ void init(int nM_, int nN_, int G_, int c_, int a_grp_ = 0, int a_grp_bytes_ = 0) { nM = nM_; nN = nN_; nwg = nM * nN; G = G_; c = c_; a_grp = a_grp_; a_grp_bytes = a_grp_bytes_; }
    __device__ bool next(int i, Unit& u) const {
        const long L = (long)i * G + c; if (L >= nwg) return false;
        int wgid = (int)L; { const int q = nwg / NXCD, r = nwg % NXCD, xcd = wgid % NXCD, off = wgid / NXCD; wgid = (xcd < r ? xcd * (q + 1) : r * (q + 1) + (xcd - r) * q) + off; }
        const int nig = WGM * nN, gid = wgid / nig, fm = gid * WGM, gsz = (nM - fm) < WGM ? (nM - fm) : WGM;
        u.pm = fm + ((wgid % nig) % gsz); u.pn = (wgid % nig) / gsz; u.pb = u.pn; u.aoff = a_grp ? (unsigned)((u.pn / a_grp) * a_grp_bytes) : 0u; return true;
    }
};
struct MoeOrder {
    const LAS int* tstart; int nsl, G, c;
    __device__ bool next(int i, Unit& u) const {
        const int L = i * G + c, total = tstart[32] << nsl; if (L >= total) return false;
        const int rt = L >> nsl, pn = L & ((1 << nsl) - 1); int e = 0;
        while (e < 31 && rt >= tstart[e + 1]) ++e;
        u.pm = rt; u.pn = pn; u.pb = (e << nsl) + pn; u.aoff = 0u; return true;
    }
};

__device__ __forceinline__ unsigned cvt_pk_bf16(float lo, float hi) { unsigned r; asm volatile("v_cvt_pk_bf16_f32 %0, %1, %2" : "=v"(r) : "v"(lo), "v"(hi)); return r; }

template <class Epi, class Sched>
__device__ __forceinline__ void gemm_phase(LAS unsigned char* lds, const Gemm g, const Sched& S, const Epi& E, const int tid) {
    const int wid = __builtin_amdgcn_readfirstlane(tid >> 6), lane = tid & 63, wr = wid >> 2, wc = wid & 3, fr = lane & 15, fq = lane >> 4;
    const int K = g.K, nt = K / BK;
    unsigned voffA[2], voffB[2];
#pragma unroll
    for (int i = 0; i < 2; ++i) { int R, C; stage_rc(tid * 16 + i * 8192, R, C); const int Rb = Epi::PERM ? ((R & ~31) + perm32(R & 31)) : R;
        voffA[i] = (unsigned)(R * g.lda + C) * 2u; voffB[i] = (unsigned)(Rb * g.ldb + C) * 2u; }
    const size_t kstep = (size_t)(BK * 2);
    const size_t hstepA = (size_t)HALF * g.lda * 2, hstepB = (size_t)HALF * g.ldb * 2;
    const size_t tstepA = 2 * hstepA, tstepB = 2 * hstepB;
    const unsigned ldsw = (unsigned)wid * 1024u;
    const int aoff = lds_byte(wr * 64 + fr, fq * 8), boff = lds_byte(wc * 32 + fr, fq * 8);
#define PG8_SA(b, h) (((b) * 2 + (h)) * HTB)
#define PG8_SB(b, h) ((4 + (b) * 2 + (h)) * HTB)
#define PG8_STAGE(bufoff, gbase, voff) do { _Pragma("unroll") for (int _i = 0; _i < 2; ++_i) \
        __builtin_amdgcn_global_load_lds((const unsigned*)((const char*)(gbase) + (voff)[_i]), (LAS unsigned*)(lds + (bufoff) + ldsw + _i * 8192), 16, 0, 0); } while (0)
#define PG8_LDA(dst, b, h) do { _Pragma("unroll") for (int m = 0; m < 4; ++m) _Pragma("unroll") for (int k = 0; k < 2; ++k) dst[m][k] = *(const LAS bf16x8*)(lds + PG8_SA(b, h) + aoff + m * 2048 + k * 1024); } while (0)
#define PG8_LDB(dst, b, h) do { _Pragma("unroll") for (int n = 0; n < 2; ++n) _Pragma("unroll") for (int k = 0; k < 2; ++k) dst[n][k] = *(const LAS bf16x8*)(lds + PG8_SB(b, h) + boff + n * 2048 + k * 1024); } while (0)
#define PG8_MMA(ai, bj, At, Bt) do { __builtin_amdgcn_s_setprio(1); _Pragma("unroll") for (int m = 0; m < 4; ++m) _Pragma("unroll") for (int n = 0; n < 2; ++n) _Pragma("unroll") for (int k = 0; k < 2; ++k) \
        acc[ai][bj][m][n] = __builtin_amdgcn_mfma_f32_16x16x32_bf16(Bt[n][k], At[m][k], acc[ai][bj][m][n], 0, 0, 0); __builtin_amdgcn_s_setprio(0); } while (0)
#define PG8_WAIT_V(n) asm volatile("s_waitcnt vmcnt(" #n ")" ::: "memory")
#define PG8_WAIT_L(n) asm volatile("s_waitcnt lgkmcnt(" #n ")" ::: "memory")
#define PG8_BAR __builtin_amdgcn_s_barrier()
#define PG8_SCHED __builtin_amdgcn_sched_barrier(0)
    Unit cur, nxt; int ui = 0;
    if (!S.next(0, cur)) return;
    f32x4 acc[2][2][4][2];
#pragma unroll
    for (int a = 0; a < 2; ++a)
#pragma unroll
        for (int b = 0; b < 2; ++b)
#pragma unroll
            for (int m = 0; m < 4; ++m)
#pragma unroll
                for (int n = 0; n < 2; ++n) acc[a][b][m][n] = (f32x4){0.f, 0.f, 0.f, 0.f};
    bf16x8 At[4][2], B0[2][2], B1[2][2];
    const char* cA = (const char*)g.A + (size_t)cur.pm * tstepA + cur.aoff; const char* cB = (const char*)g.Bt + (size_t)cur.pb * tstepB;
    PG8_STAGE(PG8_SB(0, 0), cB, voffB); PG8_STAGE(PG8_SB(0, 1), cB + hstepB, voffB); PG8_STAGE(PG8_SA(0, 0), cA, voffA); PG8_STAGE(PG8_SA(0, 1), cA + hstepA, voffA);
    if (wr == 1) PG8_BAR;
    PG8_WAIT_V(2); PG8_BAR;
    PG8_STAGE(PG8_SB(1, 0), cB + kstep, voffB); PG8_STAGE(PG8_SA(1, 0), cA + kstep, voffA); PG8_STAGE(PG8_SB(1, 1), cB + hstepB + kstep, voffB);
    PG8_WAIT_V(6); PG8_BAR;
    for (;;) {
        const bool has_next = S.next(ui + 1, nxt);
        const char* nA = has_next ? (const char*)g.A + (size_t)nxt.pm * tstepA + nxt.aoff : cA; const char* nB = has_next ? (const char*)g.Bt + (size_t)nxt.pb * tstepB : cB;
        for (int t = 0; t < nt; t += 2) {
            const bool last = (t == nt - 2);
            const char* a1 = cA + (size_t)(t + 1) * kstep;
            const char* a2 = last ? nA : cA + (size_t)(t + 2) * kstep; const char* b2 = last ? nB : cB + (size_t)(t + 2) * kstep;
            const char* a3 = a2 + kstep; const char* b3 = b2 + kstep;
            PG8_LDB(B0, 0, 0); PG8_LDB(B1, 0, 1); PG8_SCHED; PG8_LDA(At, 0, 0); PG8_STAGE(PG8_SA(1, 1), a1 + hstepA, voffA);
            PG8_WAIT_V(8); PG8_WAIT_L(0); PG8_BAR; PG8_MMA(0, 0, At, B0); PG8_MMA(0, 1, At, B1); PG8_BAR; PG8_SCHED;
            PG8_LDA(At, 0, 1); PG8_STAGE(PG8_SB(0, 0), b2, voffB); PG8_STAGE(PG8_SB(0, 1), b2 + hstepB, voffB); PG8_STAGE(PG8_SA(0, 0), a2, voffA);
            PG8_WAIT_V(8); PG8_WAIT_L(0); PG8_BAR; PG8_MMA(1, 0, At, B0); PG8_MMA(1, 1, At, B1); PG8_BAR; PG8_SCHED;
            PG8_LDB(B0, 1, 0); PG8_LDB(B1, 1, 1); PG8_SCHED; PG8_LDA(At, 1, 0); PG8_STAGE(PG8_SA(0, 1), a2 + hstepA, voffA);
            PG8_WAIT_V(8); PG8_WAIT_L(0); PG8_BAR; PG8_MMA(0, 0, At, B0); PG8_MMA(0, 1, At, B1); PG8_BAR; PG8_SCHED;
            PG8_LDA(At, 1, 1); PG8_STAGE(PG8_SB(1, 0), b3, voffB); PG8_STAGE(PG8_SB(1, 1), b3 + hstepB, voffB); PG8_STAGE(PG8_SA(1, 0), a3, voffA);
            PG8_WAIT_V(8); PG8_WAIT_L(0); PG8_BAR; PG8_MMA(1, 0, At, B0); PG8_MMA(1, 1, At, B1); PG8_BAR; PG8_SCHED;
        }
        if (wr == 0) PG8_BAR;
        { unsigned on_ = ~0u; asm volatile("" : "+s"(on_)); const int lz_ = (int)__builtin_amdgcn_mbcnt_hi(on_, __builtin_amdgcn_mbcnt_lo(on_, 0u));
          E(acc, cur, wr, wc, lz_ & 15, lz_ >> 4); }
        if (!has_next) break;
#pragma unroll
        for (int a = 0; a < 2; ++a)
#pragma unroll
            for (int b = 0; b < 2; ++b)
#pragma unroll
                for (int m = 0; m < 4; ++m)
#pragma unroll
                    for (int n = 0; n < 2; ++n) acc[a][b][m][n] = (f32x4){0.f, 0.f, 0.f, 0.f};
        cur = nxt; cA = nA; cB = nB; ++ui;
        if (wr == 1) PG8_BAR;
    }
    PG8_WAIT_V(0);
    PG8_BAR;
#undef PG8_SA
#undef PG8_SB
#undef PG8_STAGE
#undef PG8_LDA
#undef PG8_LDB
#undef PG8_MMA
#undef PG8_WAIT_V
#undef PG8_WAIT_L
#undef PG8_BAR
#undef PG8_SCHED
}
}

constexpr int NTOK = 65536, DM = 1024, SEQ = 2048, NBATCH = 32, NLAYER = 4;
constexpr int PW = 3072;
constexpr int PC_AQ = 0, PC_AK = 256, PC_AV = 512, PC_BQ = 768, PC_CKV = 1024, PC_IQ = 1088, PC_IK = 1344, PC_IW = 1376,
              PC_CQ = 1384, PC_CK = 1512, PC_CV = 1640, PC_CA = 1896, PC_CG = 1912, PC_D = 2168;
constexpr int IN_W = 7096;
constexpr float LN_EPS = 1e-5f;
constexpr float DN_ALPHA = 1.6817928305074292f;
constexpr int NWAVES = 8, NTHR = 512;
constexpr int MOE_ROWS = 2 * NTOK + 32 * 256;

constexpr size_t MiB = 1u << 20;
constexpr size_t WS_CTL = 0, CTL_ZERO_BYTES = 1 * MiB;
constexpr size_t WS_TOK = 1 * MiB;
constexpr size_t WS_ROW = 3 * MiB;
constexpr size_t WS_BON = 5 * MiB;
constexpr size_t WS_RT = 6 * MiB;
constexpr size_t WS_CKVN = 8 * MiB;
constexpr size_t WS_CA = 16 * MiB;
constexpr size_t WS_W = 48 * MiB;
constexpr size_t WL_IN = 0, WL_BR = 14 * MiB, WL_OUT = 16 * MiB, WL_GU = 18 * MiB, WL_DN = 50 * MiB, WL_SIZE = 66 * MiB;
constexpr size_t WS_XB = 312 * MiB;
constexpr size_t WS_BIG = 440 * MiB;
constexpr size_t BIG_DW = 384 * MiB, BIG_DAI = 448 * MiB, BIG_DG = 480 * MiB;
constexpr size_t BIG_H = 272 * MiB;
constexpr size_t WS_END = 952 * MiB;
constexpr size_t DO_YS = 0, DO_MG = 128 * MiB, DO_DR = 128 * MiB, DO_DKP = 160 * MiB, DO_DV = 192 * MiB, DO_DKK = 224 * MiB;

constexpr int CW_TMO = 0, CW_CODE = 1;
constexpr int CW_BAR = 4096;
constexpr int CW_Q = 8192;
constexpr int CW_CNT = 16384;

constexpr int RING_BYTES = 131072;
constexpr int MISC_OFF = RING_BYTES;
constexpr int TST_OFF = MISC_OFF + 512;
constexpr int BKT_OFF = MISC_OFF + 1024;
constexpr int RPB_OFF = MISC_OFF + 3072;
constexpr int LDS_BYTES = 147456;

#define LDS_WAIT() asm volatile("s_waitcnt lgkmcnt(0)" ::: "memory")
#define VM_WAIT() asm volatile("s_waitcnt vmcnt(0)" ::: "memory")
__device__ __forceinline__ float bf2f(unsigned b) { return __uint_as_float(b << 16); }
__device__ __forceinline__ unsigned f2bf(float f) { unsigned u = __float_as_uint(f); return (u + 0x7fffu + ((u >> 16) & 1u)) >> 16; }
__device__ __forceinline__ unsigned pk2(float lo, float hi) { return f2bf(lo) | (f2bf(hi) << 16); }
__device__ __forceinline__ float bflo(unsigned w) { return __uint_as_float(w << 16); }
__device__ __forceinline__ float bfhi(unsigned w) { return __uint_as_float(w & 0xffff0000u); }
template <int CTRL> __device__ __forceinline__ float dppf(float v) {
    return __builtin_bit_cast(float, __builtin_amdgcn_update_dpp(0, __builtin_bit_cast(int, v), CTRL, 0xf, 0xf, true));
}
__device__ __forceinline__ float wave_sum(float v) {
    v += dppf<0x128>(v); v += dppf<0x124>(v); v += dppf<0x122>(v); v += dppf<0x121>(v);
    v += __shfl_xor(v, 16); v += __shfl_xor(v, 32); return v;
}
__device__ __forceinline__ float wave_max(float v) {
#pragma unroll
    for (int o = 1; o < 64; o <<= 1) v = fmaxf(v, __shfl_xor(v, o));
    return v;
}
__device__ __forceinline__ float sum8(float v) { v += dppf<0xB1>(v); v += dppf<0x4E>(v); v += dppf<0x141>(v); return v; }
__device__ __forceinline__ float sigmoidf_(float x) { return __builtin_amdgcn_rcpf(1.f + __expf(-x)); }
__device__ __forceinline__ float log_sigmoidf_(float z) { return fminf(z, 0.f) - __logf(1.f + __expf(-fabsf(z))); }

#define XB_TMO      128
#define XB_XCNT(j)  (256  + 64 * (j))
#define XB_XSUB(j)  (1280 + 64 * (j))
#define XB_XGEN(j)  (2304 + 64 * (j))
#define XB_TOP      3328
#define XB_TOPGEN   3392
#define XCD_BAR_WORDS 3456
#define XB_SPIN_CAP (1u << 22)

__device__ __forceinline__ unsigned xb_ld(unsigned* p)              { return __hip_atomic_load(p, __ATOMIC_RELAXED, __HIP_MEMORY_SCOPE_AGENT); }
__device__ __forceinline__ unsigned xb_add(unsigned* p, unsigned v) { return __hip_atomic_fetch_add(p, v, __ATOMIC_RELAXED, __HIP_MEMORY_SCOPE_AGENT); }
__device__ __forceinline__ unsigned xb_xcc_id() { return (unsigned)__builtin_amdgcn_s_getreg((3 << 11) | 20) & 0xFu; }
#define XB_SPIN(cond, bar) do { unsigned _sp = 0; while (cond) { __builtin_amdgcn_s_sleep(1); \
    if ((++_sp & 255u) == 0u) { if (xb_ld(&(bar)[XB_TMO])) break; if (_sp > XB_SPIN_CAP) { atomicAdd(&(bar)[XB_TMO], 1u); break; } } } } while (0)

struct XcdBarrier { unsigned* bar; unsigned x; volatile LAS unsigned* st; };

__device__ __forceinline__ XcdBarrier xcd_barrier_post(unsigned* bar, volatile LAS unsigned* st) {
    XcdBarrier b; b.bar = bar; b.x = xb_xcc_id(); b.st = st;
    if (threadIdx.x == 0) (void)xb_add(&bar[XB_XCNT(b.x)], 1u);
    return b;
}
__device__ __forceinline__ void xcd_barrier_complete(unsigned* bar, unsigned x, unsigned& nloc, unsigned& nx) {
    const unsigned G = gridDim.x * gridDim.y * gridDim.z;
    unsigned sum, cnt, mine, sp = 0u;
    for (;;) {
        sum = 0u; cnt = 0u; mine = 0u;
#pragma unroll
        for (unsigned j = 0; j < 16; ++j) { const unsigned c = xb_ld(&bar[XB_XCNT(j)]); sum += c; cnt += (c > 0u) ? 1u : 0u; mine = (j == x) ? c : mine; }
        if (sum == G) break;
        __builtin_amdgcn_s_sleep(1);
        if ((++sp & 255u) == 0u) { if (xb_ld(&bar[XB_TMO])) break; if (sp > XB_SPIN_CAP) { atomicAdd(&bar[XB_TMO], 1u); break; } }
    }
    nloc = mine > 0u ? mine : 1u; nx = cnt > 0u ? cnt : 1u;
}
__device__ __forceinline__ void xcd_barrier(const XcdBarrier& b) {
    asm volatile("s_waitcnt vmcnt(0)" ::: "memory");
    __syncthreads();
    if (threadIdx.x == 0) {
        unsigned* bar = b.bar;
        __builtin_amdgcn_s_waitcnt(0);
        unsigned nloc = b.st[0], nx = b.st[1];
        if (nloc == 0u) { xcd_barrier_complete(bar, b.x, nloc, nx); b.st[0] = nloc; b.st[1] = nx; }
        const unsigned old = xb_add(&bar[XB_XSUB(b.x)], 1u);
        const unsigned gen = old / nloc;
        if (old + 1u == (gen + 1u) * nloc) {
            __builtin_amdgcn_fence(__ATOMIC_RELEASE, "agent");
            asm volatile("s_waitcnt vmcnt(0)" ::: "memory");
            const unsigned og = xb_add(&bar[XB_TOP], 1u);
            const unsigned tg = og / nx;
            if (og + 1u == (tg + 1u) * nx) xb_add(&bar[XB_TOPGEN], 1u);
            else XB_SPIN(xb_ld(&bar[XB_TOPGEN]) == tg, bar);
            __builtin_amdgcn_fence(__ATOMIC_ACQUIRE, "agent");
            xb_add(&bar[XB_XGEN(b.x)], 1u);
            asm volatile("s_waitcnt vmcnt(0)" ::: "memory");
        } else {
            XB_SPIN(xb_ld(&bar[XB_XGEN(b.x)]) == gen, bar);
            __builtin_amdgcn_fence(__ATOMIC_ACQUIRE, "agent");
            asm volatile("s_waitcnt vmcnt(0)" ::: "memory");
        }
    }
    __syncthreads();
}

__device__ __forceinline__ int t5_bucket(int d) {
    if (d < 16) return d;
    int b = 16;
    b += (d >= 22) + (d >= 30) + (d >= 40) + (d >= 54) + (d >= 73) + (d >= 99) + (d >= 134) + (d >= 182) + (d >= 246) + (d >= 332) + (d >= 450) + (d >= 609) + (d >= 825) + (d >= 1117) + (d >= 1513);
    return b;
}
struct Args { const float* in[30]; float* out; unsigned char* ws; int l_lo, l_hi, ph_lo, ph_hi, use_bar, pad; };

namespace pg8 {
struct EpiStoreBf16 {
    static constexpr bool PERM = true;
    bf16* O; int ldc;
    __device__ __forceinline__ void operator()(const f32x4 (&acc)[2][2][4][2], const Unit& u, int wr, int wc, int fr, int fq) const {
        const int row0 = u.pm * BM + wr * 64 + fr, col0 = u.pn * BM + wc * 32 + 8 * fq;
#pragma unroll
        for (int ai = 0; ai < 2; ++ai)
#pragma unroll
            for (int m = 0; m < 4; ++m) { bf16* rowp = O + (size_t)(row0 + ai * HALF + m * 16) * ldc + col0;
#pragma unroll
                for (int bj = 0; bj < 2; ++bj) { const f32x4 v0 = acc[ai][bj][m][0], v1 = acc[ai][bj][m][1];
                    u32x4 w; w.x = cvt_pk_bf16(v0[0], v0[1]); w.y = cvt_pk_bf16(v0[2], v0[3]); w.z = cvt_pk_bf16(v1[0], v1[1]); w.w = cvt_pk_bf16(v1[2], v1[3]);
                    *(u32x4*)(rowp + bj * HALF) = w; } }
    }
};
struct EpiGate {
    static constexpr bool PERM = false;
    const bf16* BR; bf16* MG;
    __device__ __forceinline__ void operator()(const f32x4 (&acc)[2][2][4][2], const Unit& u, int wr, int wc, int fr, int fq) const {
        const int row0 = u.pm * BM + wr * 64 + fr, j0 = u.pn * 64 + wc * 16 + 4 * fq;
#pragma unroll
        for (int ai = 0; ai < 2; ++ai)
#pragma unroll
            for (int m = 0; m < 4; ++m) { const size_t r = (size_t)(row0 + ai * HALF + m * 16);
                float mg0 = 0.f, mg1 = 0.f, mg2 = 0.f, mg3 = 0.f;
#pragma unroll
                for (int bj = 0; bj < 2; ++bj)
#pragma unroll
                    for (int n = 0; n < 2; ++n) { const int g = 2 * bj + n; const u32x2 b = *(const u32x2*)(BR + r * 4096 + g * 1024 + j0); const f32x4 a = acc[ai][bj][m][n];
                        mg0 += sigmoidf_(a[0]) * bflo(b.x); mg1 += sigmoidf_(a[1]) * bfhi(b.x); mg2 += sigmoidf_(a[2]) * bflo(b.y); mg3 += sigmoidf_(a[3]) * bfhi(b.y); }
                u32x2 w; w.x = cvt_pk_bf16(mg0, mg1); w.y = cvt_pk_bf16(mg2, mg3);
                *(u32x2*)(MG + r * 1024 + j0) = w; }
    }
};
struct EpiOut {
    static constexpr bool PERM = true;
    bf16* XB;
    __device__ __forceinline__ void operator()(const f32x4 (&acc)[2][2][4][2], const Unit& u, int wr, int wc, int fr, int fq) const {
        const int row0 = u.pm * BM + wr * 64 + fr, col0 = u.pn * BM + wc * 32 + 8 * fq;
#pragma unroll
        for (int ai = 0; ai < 2; ++ai)
#pragma unroll
            for (int m = 0; m < 4; ++m) { bf16* rowp = XB + (size_t)(row0 + ai * HALF + m * 16) * 1024 + col0;
#pragma unroll
                for (int bj = 0; bj < 2; ++bj) { const f32x4 v0 = acc[ai][bj][m][0], v1 = acc[ai][bj][m][1]; const u32x4 x = *(const u32x4*)(rowp + bj * HALF);
                    u32x4 w; w.x = cvt_pk_bf16(DN_ALPHA * bflo(x.x) + v0[0], DN_ALPHA * bfhi(x.x) + v0[1]); w.y = cvt_pk_bf16(DN_ALPHA * bflo(x.y) + v0[2], DN_ALPHA * bfhi(x.y) + v0[3]);
                    w.z = cvt_pk_bf16(DN_ALPHA * bflo(x.z) + v1[0], DN_ALPHA * bfhi(x.z) + v1[1]); w.w = cvt_pk_bf16(DN_ALPHA * bflo(x.w) + v1[2], DN_ALPHA * bfhi(x.w) + v1[3]);
                    *(u32x4*)(rowp + bj * HALF) = w; } }
    }
};
struct EpiUp {
    static constexpr bool PERM = true;
    const unsigned* rowinfo; bf16* H;
    __device__ __forceinline__ void operator()(const f32x4 (&acc)[2][2][4][2], const Unit& u, int wr, int wc, int fr, int fq) const {
        const int row0 = u.pm * BM + wr * 64 + fr, col0 = u.pn * 128 + wc * 32 + 8 * fq;
#pragma unroll
        for (int ai = 0; ai < 2; ++ai)
#pragma unroll
            for (int m = 0; m < 4; ++m) { const size_t r = (size_t)(row0 + ai * HALF + m * 16); const float w = __uint_as_float(rowinfo[2 * r + 1]);
                const f32x4 g0 = acc[ai][0][m][0], g1 = acc[ai][0][m][1], u0 = acc[ai][1][m][0], u1 = acc[ai][1][m][1];
                float h[8];
#pragma unroll
                for (int e = 0; e < 4; ++e) { h[e] = g0[e] * sigmoidf_(g0[e]) * u0[e] * w; h[4 + e] = g1[e] * sigmoidf_(g1[e]) * u1[e] * w; }
                u32x4 o; o.x = cvt_pk_bf16(h[0], h[1]); o.y = cvt_pk_bf16(h[2], h[3]); o.z = cvt_pk_bf16(h[4], h[5]); o.w = cvt_pk_bf16(h[6], h[7]);
                *(u32x4*)(H + r * 256 + col0) = o; }
    }
};
struct EpiDown {
    static constexpr bool PERM = true;
    const unsigned* rowinfo; bf16* Y;
    __device__ __forceinline__ void operator()(const f32x4 (&acc)[2][2][4][2], const Unit& u, int wr, int wc, int fr, int fq) const {
        const int row0 = u.pm * BM + wr * 64 + fr, col0 = u.pn * BM + wc * 32 + 8 * fq;
#pragma unroll
        for (int ai = 0; ai < 2; ++ai)
#pragma unroll
            for (int m = 0; m < 4; ++m) { const size_t r = (size_t)(row0 + ai * HALF + m * 16); const int ri = (int)rowinfo[2 * r];
                if (ri >= 0) { bf16* rowp = Y + ((size_t)(ri & 1) * NTOK + (size_t)(ri >> 1)) * 1024 + col0;
#pragma unroll
                    for (int bj = 0; bj < 2; ++bj) { const f32x4 v0 = acc[ai][bj][m][0], v1 = acc[ai][bj][m][1];
                        u32x4 w; w.x = cvt_pk_bf16(v0[0], v0[1]); w.y = cvt_pk_bf16(v0[2], v0[3]); w.z = cvt_pk_bf16(v1[0], v1[1]); w.w = cvt_pk_bf16(v1[2], v1[3]);
                        *(u32x4*)(rowp + bj * HALF) = w; } } }
    }
};
}

struct RowMap { int kind, base, g, off;
    __device__ __forceinline__ int operator()(int n) const {
        if (kind == 0) return base + n;
        if (kind == 1) { const int j = base + n, jj = j & 63, pn = j >> 6; return 3072 + pn * 256 + 128 * (g >> 1) + 32 * (jj >> 4) + 16 * (g & 1) + 4 * ((jj >> 2) & 3) + (jj & 3); }
        const int h = base + n; return (h >> 7) * 256 + off + (h & 127);
    }
};
__device__ __forceinline__ void transpose_item(const float* W, int ldw, int k0, int scol0, int nvalid, bf16* WT, int ldk, const RowMap& rm, LAS float* scr, int lane) {
    const int nn = lane & 31;
#pragma unroll 8
    for (int i = 0; i < 32; ++i) { const int kk = 2 * i + (lane >> 5); scr[kk * 33 + nn] = (nn < nvalid) ? W[(size_t)(k0 + kk) * ldw + scol0 + nn] : 0.f; }
    LDS_WAIT(); asm volatile("" ::: "memory");
    const int c = lane & 7;
#pragma unroll
    for (int j = 0; j < 4; ++j) { const int n = (lane >> 3) + 8 * j; const LAS float* s = scr + (8 * c) * 33 + n;
        u32x4 o; o.x = pk2(s[0 * 33], s[1 * 33]); o.y = pk2(s[2 * 33], s[3 * 33]); o.z = pk2(s[4 * 33], s[5 * 33]); o.w = pk2(s[6 * 33], s[7 * 33]);
        *(u32x4*)(WT + (size_t)rm(n) * ldk + k0 + 8 * c) = o; }
    LDS_WAIT(); asm volatile("" ::: "memory");
}
__device__ __forceinline__ void p0_prologue(const Args& a, LAS unsigned char* lds, int gw, int NGW, int wave, int lane) {
    LAS float* scr = (LAS float*)(lds + wave * 16384);
    constexpr int IPL = 16896;
    for (int it = gw; it < NLAYER * IPL; it += NGW) {
        const int l = it / IPL; int r = it - l * IPL;
        unsigned char* wl = a.ws + WS_W + (size_t)l * WL_SIZE;
        RowMap rm; rm.kind = 0; rm.base = 0; rm.g = 0; rm.off = 0;
        if (r < 1536) { const int nt = r % 96, kt = r / 96, n0 = 32 * nt; int nv = 3000 - n0; nv = nv < 0 ? 0 : (nv > 32 ? 32 : nv); rm.base = n0;
            transpose_item(a.in[2] + (size_t)l * 1024 * IN_W, IN_W, 64 * kt, n0, nv, (bf16*)(wl + WL_IN), 1024, rm, scr, lane); continue; }
        r -= 1536;
        if (r < 2048) { const int nt = r % 128, kt = r / 128, gc0 = 32 * nt; rm.kind = 1; rm.g = gc0 >> 10; rm.base = gc0 & 1023;
            transpose_item(a.in[2] + (size_t)l * 1024 * IN_W, IN_W, 64 * kt, 3000 + gc0, 32, (bf16*)(wl + WL_IN), 1024, rm, scr, lane); continue; }
        r -= 2048;
        if (r < 512) { const int nb = r / 128, rr = r % 128, nt = rr % 32, kt = rr / 32; rm.base = nb * 1024 + 32 * nt;
            if (nb != 1) transpose_item(a.in[19] + (size_t)(l * 4 + nb) * 256 * 1024, 1024, 64 * kt, 32 * nt, 32, (bf16*)(wl + WL_BR), 256, rm, scr, lane); continue; }
        r -= 512;
        if (r < 512) { const int nt = r % 32, kt = r / 32; rm.base = 32 * nt;
            transpose_item(a.in[20] + (size_t)l * 1024 * 1024, 1024, 64 * kt, 32 * nt, 32, (bf16*)(wl + WL_OUT), 1024, rm, scr, lane); continue; }
        r -= 512;
        if (r < 8192) { const int up = r >= 4096; if (up) r -= 4096; const int e = r / 128, rr = r % 128, nt = rr % 8, kt = rr / 8; rm.kind = 2; rm.base = 32 * nt; rm.off = up ? 128 : 0;
            transpose_item(a.in[up ? 28 : 27] + (size_t)(l * 32 + e) * 1024 * 256, 256, 64 * kt, 32 * nt, 32, (bf16*)(wl + WL_GU) + (size_t)e * 512 * 1024, 1024, rm, scr, lane); continue; }
        r -= 8192;
        { const int e = r / 128, rr = r % 128, nt = rr % 32, kt = rr / 32; rm.base = 32 * nt;
            transpose_item(a.in[29] + (size_t)(l * 32 + e) * 256 * 1024, 1024, 64 * kt, 32 * nt, 32, (bf16*)(wl + WL_DN) + (size_t)e * 1024 * 256, 256, rm, scr, lane); }
    }
    { float* WRT = (float*)(a.ws + WS_RT); const int gt = gw * 64 + lane, NT = NGW * 64;
      for (int i = gt; i < NLAYER * 4 * 64 * 1024; i += NT) { const int j = i & 1023, c = (i >> 10) & 63, h = (i >> 16) & 3, l = i >> 18;
          const float* wu = a.in[4] + ((size_t)(l * 4 + h) * 64 + c) * 64; const float* wb = a.in[19] + ((size_t)(l * 4 + 1) * 256 + h * 64) * 1024 + j; float acc = 0.f;
#pragma unroll 8
          for (int d = 0; d < 64; ++d) acc += wu[d] * wb[(size_t)d * 1024];
          ((bf16*)(a.ws + WS_W + (size_t)l * WL_SIZE + WL_BR))[(size_t)(1024 + j) * 256 + h * 64 + c] = (bf16)f2bf(acc); }
      for (int i = gt; i < NLAYER * 36 * 1024; i += NT) { const int k = i & 1023, e = (i >> 10) % 36, l = i / (36 * 1024);
          WRT[i] = e < 4 ? a.in[23][((size_t)l * 1024 + k) * 4 + e] : a.in[25][((size_t)l * 1024 + k) * 32 + (e - 4)]; }
      const f32x4* xs = (const f32x4*)a.in[0]; u32x4* xd = (u32x4*)(a.ws + WS_XB);
      for (int i = gt; i < NTOK * DM / 8; i += NT) { const f32x4 v0 = xs[2 * i], v1 = xs[2 * i + 1]; u32x4 o; o.x = pk2(v0[0], v0[1]); o.y = pk2(v0[2], v0[3]); o.z = pk2(v1[0], v1[1]); o.w = pk2(v1[2], v1[3]); xd[i] = o; } }
}

__device__ __forceinline__ float softplusf_(float x) { return fmaxf(x, 0.f) + __logf(1.f + __expf(-fabsf(x))); }
__device__ __forceinline__ float tanhf_(float x) { const float e = __expf(-2.f * fabsf(x)); const float t = (1.f - e) * __builtin_amdgcn_rcpf(1.f + e); return x < 0.f ? -t : t; }
__device__ __forceinline__ void prep_phase(const Args& a, int l, LAS unsigned char* lds, int tid, int gw, int NGW, int lane) {
    const int wave = __builtin_amdgcn_readfirstlane(tid >> 6);
    const bf16* P = (const bf16*)(a.ws + WS_BIG);
    bf16* CKVN = (bf16*)(a.ws + WS_CKVN); bf16* CQH = (bf16*)(a.ws + WS_CA); bf16* CKT = (bf16*)(a.ws + WS_CA + 16 * MiB); float* CCL = (float*)(a.ws + WS_END); float* BON = (float*)(a.ws + WS_BON);
    bf16* DR = (bf16*)((unsigned char*)a.out + DO_DR); bf16* DKP = (bf16*)((unsigned char*)a.out + DO_DKP); bf16* DV = (bf16*)((unsigned char*)a.out + DO_DV); bf16* DKK = (bf16*)((unsigned char*)a.out + DO_DKK);
    float* DW = (float*)(a.ws + WS_BIG + BIG_DW); bf16* DAI = (bf16*)(a.ws + WS_BIG + BIG_DAI); bf16* DG = (bf16*)(a.ws + WS_BIG + BIG_DG);
    const float* kvg = a.in[3] + l * 64; const float* aup = a.in[5] + l * 16 * 128; const float* abias = a.in[6] + l * 128;
    const float* mu = a.in[8] + l * 832; const float* w0 = a.in[9] + l * 256; const float* w2 = a.in[10] + l * 16 * 256; const float* a0 = a.in[11] + l * 256;
    const float* a2 = a.in[12] + l * 16 * 256; const float* g2 = a.in[13] + l * 32 * 256; const float* kkw = a.in[14] + l * 256; const float* kaw = a.in[15] + l * 256; const float* rkw = a.in[16] + l * 256;
    LAS float* sW2 = (LAS float*)lds; LAS float* sA2 = (LAS float*)(lds + 16384); LAS float* sG2 = (LAS float*)(lds + 32768); LAS float* sUP = (LAS float*)(lds + 65536);
    for (int i = tid; i < 4096; i += NTHR) { sW2[i] = w2[i]; sA2[i] = a2[i]; }
    for (int i = tid; i < 8192; i += NTHR) sG2[i] = g2[i];
    for (int i = tid; i < 2048; i += NTHR) sUP[i] = aup[i];
    __syncthreads();
    float mu_r[13], w0_r[4], a0_r[4], kk_r[4], ka_r[4], rk_r[4];
#pragma unroll
    for (int i = 0; i < 13; ++i) mu_r[i] = mu[64 * i + lane];
#pragma unroll
    for (int i = 0; i < 4; ++i) { const int c = 64 * i + lane; w0_r[i] = w0[c]; a0_r[i] = a0[c]; kk_r[i] = kkw[c]; ka_r[i] = kaw[c]; rk_r[i] = rkw[c]; }
    const float kvg_r = kvg[lane], ab0 = abias[lane], ab1 = abias[64 + lane];
    unsigned short nc[13], np_[13], nckv, nca, nq0, nq1, nk0, nk1;
#define PREP_LOAD(mm) do { const bf16* pr_ = P + (size_t)(mm) * PW; \
        _Pragma("unroll") for (int i = 0; i < 13; ++i) nc[i] = pr_[PC_D + 64 * i + lane]; nckv = pr_[PC_CKV + lane]; nca = pr_[PC_CA + (lane & 15)]; nq0 = pr_[PC_CQ + lane]; nq1 = pr_[PC_CQ + 64 + lane]; nk0 = pr_[PC_CK + lane]; nk1 = pr_[PC_CK + 64 + lane]; } while (0)
    constexpr int NCK = NTOK / 16;
    float* DCL = DW;
#define PREP_LOADP(mm) do { const int tt_ = (mm) & (SEQ - 1); const bf16* pp_ = P + (size_t)(mm) * PW - (tt_ > 0 ? PW : 0); _Pragma("unroll") for (int i = 0; i < 13; ++i) np_[i] = pp_[PC_D + 64 * i + lane]; } while (0)
    if (gw < NCK) { PREP_LOAD(gw * 16); PREP_LOADP(gw * 16); }
    for (int ck = gw; ck < NCK; ck += NGW) {
      float cpr[4] = {1.f, 1.f, 1.f, 1.f}; float cprc0 = 1.f, cprc1 = 1.f;
#pragma unroll 1
      for (int tt = 0; tt < 16; ++tt) {
        const int m = ck * 16 + tt;
        const int t = m & (SEQ - 1);
        unsigned short cc_[13], cp_[13];
#pragma unroll
        for (int i = 0; i < 13; ++i) { cc_[i] = nc[i]; cp_[i] = np_[i]; np_[i] = nc[i]; }
        const unsigned short cckv = nckv, cca = nca, cq0 = nq0, cq1 = nq1, ck0 = nk0, ck1 = nk1;
        if (tt < 15) PREP_LOAD(m + 1); else if (ck + NGW < NCK) { PREP_LOAD((ck + NGW) * 16); PREP_LOADP((ck + NGW) * 16); }
        { const float x = bf2f(cckv); const float ss = wave_sum(x * x); const float rn = rsqrtf(ss * (1.f / 64.f) + 1e-6f); CKVN[(size_t)m * 64 + lane] = (bf16)f2bf(x * rn * kvg_r); }
        { const float cav = (lane < 16) ? bf2f(cca) : 0.f; float z0 = ab0, z1 = ab1;
#pragma unroll
          for (int i = 0; i < 16; ++i) { const float cv = __shfl(cav, i); z0 += cv * sUP[i * 128 + lane]; z1 += cv * sUP[i * 128 + 64 + lane]; }
          cprc0 *= __expf(log_sigmoidf_(z0) * (1.f / 16.f)); cprc1 *= __expf(log_sigmoidf_(z1) * (1.f / 16.f));
          CQH[(size_t)m * 128 + lane] = (bf16)f2bf(bf2f(cq0) * cprc0); CQH[(size_t)m * 128 + 64 + lane] = (bf16)f2bf(bf2f(cq1) * cprc1);
          CKT[(size_t)m * 128 + lane] = (bf16)f2bf(bf2f(ck0) * __builtin_amdgcn_rcpf(cprc0)); CKT[(size_t)m * 128 + 64 + lane] = (bf16)f2bf(bf2f(ck1) * __builtin_amdgcn_rcpf(cprc1));
          if (tt == 15) { CCL[(size_t)ck * 128 + lane] = cprc0; CCL[(size_t)ck * 128 + 64 + lane] = cprc1; } }
        float xs[13];
#pragma unroll
        for (int i = 0; i < 13; ++i) { const float cur = bf2f(cc_[i]); const float prev = (t > 0) ? bf2f(cp_[i]) : 0.f; xs[i] = cur + (prev - cur) * mu_r[i]; }
        const float low = xs[12], tw = tanhf_(low), sg = sigmoidf_(low);
        float wr_[4], ar_[4], gv_[4];
#pragma unroll
        for (int i = 0; i < 4; ++i) { wr_[i] = w0_r[i]; ar_[i] = a0_r[i]; gv_[i] = 0.f; }
#pragma unroll 4
        for (int j = 0; j < 16; ++j) { const float tj = __shfl(tw, j), aj = __shfl(low, 16 + j);
#pragma unroll
            for (int i = 0; i < 4; ++i) { wr_[i] += tj * sW2[j * 256 + 64 * i + lane]; ar_[i] += aj * sA2[j * 256 + 64 * i + lane]; } }
#pragma unroll 4
        for (int j = 0; j < 32; ++j) { const float sj = __shfl(sg, 32 + j);
#pragma unroll
            for (int i = 0; i < 4; ++i) gv_[i] += sj * sG2[j * 256 + 64 * i + lane]; }
#pragma unroll
        for (int i = 0; i < 4; ++i) { const int c = 64 * i + lane;
            const float w_raw = -softplusf_(-wr_[i]) - 0.5f, wdec = __expf(-__expf(w_raw));
            const float av = sigmoidf_(ar_[i]);
            const float kx = xs[4 + i]; float kkv = kx * kk_r[i]; const float nrm = sqrtf(wave_sum(kkv * kkv)); kkv = kkv * __builtin_amdgcn_rcpf(fmaxf(nrm, 1e-12f));
            const float kp = kx * (1.f + (av - 1.f) * ka_r[i]);
            const float rx = xs[i], vx = xs[8 + i];
            const float bon = wave_sum(rx * kp * rk_r[i]);
            const size_t o = (size_t)m * 256 + c;
            const float ahat = -kkv * cpr[i]; cpr[i] *= wdec; const float cinv = __builtin_amdgcn_rcpf(cpr[i]);
            DR[o] = (bf16)f2bf(rx * cpr[i]); DKP[o] = (bf16)f2bf(kp * cinv); DV[o] = (bf16)f2bf(vx); DKK[o] = (bf16)f2bf(ahat); DAI[o] = (bf16)f2bf(kkv * av * cinv); DG[o] = (bf16)f2bf(gv_[i]);
            if (tt == 15) DCL[(size_t)ck * 256 + c] = cpr[i];
            if (lane == 0) BON[(size_t)m * 4 + i] = bon; }
      }
    }
#undef PREP_LOAD
#undef PREP_LOADP
    __syncthreads();
}

typedef float f32x16 __attribute__((ext_vector_type(16)));
typedef short s16x4 __attribute__((ext_vector_type(4)));
typedef short v4i16_t __attribute__((ext_vector_type(4)));
typedef float f32x2_t __attribute__((ext_vector_type(2))); typedef __bf16 bf16x2_t __attribute__((ext_vector_type(2)));
__device__ __forceinline__ unsigned cvtpk_s(float lo, float hi) { f32x2_t v = {lo, hi}; bf16x2_t b = __builtin_convertvector(v, bf16x2_t); return __builtin_bit_cast(unsigned, b); }
__device__ __forceinline__ s16x4 vtr(const LAS unsigned char* p) { return __builtin_bit_cast(s16x4, __builtin_amdgcn_ds_read_tr16_b64_v4i16((LAS v4i16_t*)p)); }
constexpr int ATB_OFF = 102400;
constexpr int AVI_OFF = 3584;
constexpr float LOG2E = 1.4426950408889634f;
__device__ __forceinline__ void mixA_tables(const Args& a, LAS unsigned char* lds, int tid) {
    LAS float* tb = (LAS float*)(lds + ATB_OFF);
    for (int i = tid; i < 3 * 4 * 192; i += NTHR) { const int e = i % 192, h = (i / 192) & 3, f = i / 768; const int dist = 159 - e; const int dl = f == 0 ? 16 : (f == 1 ? 4 : 1);
        float v = -INFINITY;
        if (dist >= 0 && dist <= 128) { int dd = dist * dl; dd = dd > 2047 ? 2047 : dd; v = a.in[1][t5_bucket(dd) * 8 + h] * LOG2E; }
        tb[i] = v; }
}
__device__ __forceinline__ void mixA_task(const Args& a, int task, LAS unsigned char* lds, int wave, int lane_in) {
    int lane = lane_in; asm volatile("" : "+v"(lane));
    const bf16* P = (const bf16*)(a.ws + WS_BIG); bf16* YS = (bf16*)((unsigned char*)a.out + DO_YS);
    const int cc = 3 - (task & 3), r = (task >> 2) & 15, h = (task >> 6) & 3, b = task >> 8;
    const int ql = lane & 31, hh = lane >> 5, n0 = 32 * cc;
    const size_t rowb = (size_t)b * SEQ; const int tq = 16 * (n0 + ql) + r;
    const LAS float* tball = (const LAS float*)(lds + ATB_OFF) + h * 192;
    LAS unsigned char* vimg = lds + AVI_OFF + wave * 12800;
    bf16x8 qf[4];
    { const bf16* qp = P + (rowb + tq) * PW + PC_AQ + h * 64 + 8 * hh;
#pragma unroll
      for (int ks = 0; ks < 4; ++ks) qf[ks] = *(const bf16x8*)(qp + 16 * ks); }
    f32x16 o0, o1;
#pragma unroll
    for (int i = 0; i < 16; ++i) { o0[i] = 0.f; o1[i] = 0.f; }
    float m = -INFINITY, lsum = 0.f;
    const float SC = 0.125f * LOG2E;
    const int vst = (lane >> 1) * 144 + (lane & 1) * 64;
    const int i16 = lane & 15, tq4 = i16 >> 2, tp = i16 & 3, g16 = (lane >> 4) & 1;
    const int vrd = (4 * hh + tq4) * 144 + 32 * g16 + 8 * tp;
#pragma unroll 1
    for (int f = 0; f < 3; ++f) {
        const int dsh = f == 0 ? 4 : (f == 1 ? 2 : 0);
        const int rho = r & ((1 << dsh) - 1);
        const int qpos = (tq - rho) >> dsh;
        const int qmin = (16 * n0 + r - rho) >> dsh, qmax = (16 * (n0 + 31) + r - rho) >> dsh;
        int klo = qmin - 128; klo = klo < 0 ? 0 : klo; klo &= ~31;
        const LAS float* tbf = tball + f * 768;
        bf16x8 kA[4], kB[4]; u32x4 vA0, vA1, vA2, vA3, vB0, vB1, vB2, vB3;
#define A_LOAD(KF, W0, W1, W2, W3, KK0) do { const size_t tk_ = rowb + (((size_t)((KK0) + ql)) << dsh) + rho; const bf16* kp_ = P + tk_ * PW + PC_AK + h * 64 + 8 * hh; \
            _Pragma("unroll") for (int ks = 0; ks < 4; ++ks) KF[ks] = *(const bf16x8*)(kp_ + 16 * ks); \
            const size_t tv_ = rowb + (((size_t)((KK0) + (lane >> 1))) << dsh) + rho; const u32x4* vp_ = (const u32x4*)(P + tv_ * PW + PC_AV + h * 64 + 32 * (lane & 1)); \
            W0 = vp_[0]; W1 = vp_[1]; W2 = vp_[2]; W3 = vp_[3]; } while (0)
#define A_TILE(KF, W0, W1, W2, W3, K0) do { \
            f32x16 st; \
            _Pragma("unroll") for (int i = 0; i < 16; ++i) st[i] = 0.f; \
            _Pragma("unroll") for (int ks = 0; ks < 4; ++ks) st = __builtin_amdgcn_mfma_f32_32x32x16_bf16(KF[ks], qf[ks], st, 0, 0, 0); \
            *(LAS u32x4*)(vimg + vst) = W0; *(LAS u32x4*)(vimg + vst + 16) = W1; *(LAS u32x4*)(vimg + vst + 32) = W2; *(LAS u32x4*)(vimg + vst + 48) = W3; \
            __builtin_amdgcn_sched_barrier(0); \
            if ((K0) - 64 >= klo) A_LOAD(KF, W0, W1, W2, W3, (K0) - 64); \
            __builtin_amdgcn_sched_barrier(0); \
            const int D0 = qpos - (K0) - 4 * hh; const int e0 = (D0 >= 0 && D0 <= 159) ? 159 - D0 : 0; \
            const LAS float* tp_ = tbf + e0; \
            float mx = -INFINITY; \
            _Pragma("unroll") for (int i = 0; i < 16; ++i) { st[i] = st[i] * SC + tp_[(i & 3) + 8 * (i >> 2)]; mx = fmaxf(mx, st[i]); } \
            mx = fmaxf(mx, __shfl_xor(mx, 32)); \
            const float mn = fmaxf(m, mx), alpha = __builtin_amdgcn_exp2f(m - mn); \
            m = mn; float ps = 0.f; \
            _Pragma("unroll") for (int i = 0; i < 16; ++i) { st[i] = __builtin_amdgcn_exp2f(st[i] - mn); ps += st[i]; } \
            lsum = lsum * alpha + ps; \
            _Pragma("unroll") for (int i = 0; i < 16; ++i) { o0[i] *= alpha; o1[i] *= alpha; } \
            bf16x8 pf[2]; \
            _Pragma("unroll") for (int s = 0; s < 2; ++s) { u32x4 w; w.x = cvtpk_s(st[8 * s], st[8 * s + 1]); w.y = cvtpk_s(st[8 * s + 2], st[8 * s + 3]); w.z = cvtpk_s(st[8 * s + 4], st[8 * s + 5]); w.w = cvtpk_s(st[8 * s + 6], st[8 * s + 7]); pf[s] = __builtin_bit_cast(bf16x8, w); } \
            asm volatile("s_waitcnt lgkmcnt(0)" ::: "memory"); \
            _Pragma("unroll") for (int s = 0; s < 2; ++s) { \
                const s16x4 a00 = vtr(vimg + vrd + (16 * s) * 144), a01 = vtr(vimg + vrd + (16 * s + 8) * 144); \
                const s16x4 a10 = vtr(vimg + vrd + (16 * s) * 144 + 64), a11 = vtr(vimg + vrd + (16 * s + 8) * 144 + 64); \
                const bf16x8 A0 = (bf16x8){a00[0], a00[1], a00[2], a00[3], a01[0], a01[1], a01[2], a01[3]}; \
                const bf16x8 A1 = (bf16x8){a10[0], a10[1], a10[2], a10[3], a11[0], a11[1], a11[2], a11[3]}; \
                o0 = __builtin_amdgcn_mfma_f32_32x32x16_bf16(A0, pf[s], o0, 0, 0, 0); \
                o1 = __builtin_amdgcn_mfma_f32_32x32x16_bf16(A1, pf[s], o1, 0, 0, 0); } \
            asm volatile("s_waitcnt lgkmcnt(0)" ::: "memory"); } while (0)
        int k0 = qmax & ~31;
        A_LOAD(kA, vA0, vA1, vA2, vA3, k0);
        if (k0 - 32 >= klo) A_LOAD(kB, vB0, vB1, vB2, vB3, k0 - 32);
#pragma unroll 1
        while (k0 >= klo) {
            A_TILE(kA, vA0, vA1, vA2, vA3, k0);
            k0 -= 32; if (k0 < klo) break;
            A_TILE(kB, vB0, vB1, vB2, vB3, k0);
            k0 -= 32;
        }
#undef A_TILE
#undef A_LOAD
    }
    const float lt = lsum + __shfl_xor(lsum, 32); const float inv = 1.f / lt;
    bf16* yo = YS + (rowb + tq) * 1024 + h * 64 + 4 * hh;
#pragma unroll
    for (int g = 0; g < 4; ++g) {
        u32x2 w; w.x = cvtpk_s(o0[4 * g] * inv, o0[4 * g + 1] * inv); w.y = cvtpk_s(o0[4 * g + 2] * inv, o0[4 * g + 3] * inv); *(u32x2*)(yo + 8 * g) = w;
        u32x2 x; x.x = cvtpk_s(o1[4 * g] * inv, o1[4 * g + 1] * inv); x.y = cvtpk_s(o1[4 * g + 2] * inv, o1[4 * g + 3] * inv); *(u32x2*)(yo + 32 + 8 * g) = x; }
}

__device__ __forceinline__ unsigned fkey(float f) { const unsigned u = __float_as_uint(f); return (u & 0x80000000u) ? ~u : (u | 0x80000000u); }
typedef float f32x4v __attribute__((ext_vector_type(4)));
__device__ __forceinline__ void mixB_attend(const Args& a, int m, const LAS unsigned short* sidx, const LAS unsigned char* sbk, int nsel, LAS unsigned char* lds, LAS unsigned char* img, int lane) {
    const bf16* P = (const bf16*)(a.ws + WS_BIG); const bf16* CKVN = (const bf16*)(a.ws + WS_CKVN); bf16* YS = (bf16*)((unsigned char*)a.out + DO_YS);
    const LAS float* rpb = (const LAS float*)(lds + RPB_OFF);
    const int t = m & (SEQ - 1); const size_t rowb = (size_t)(m - t); const bf16* prow = P + (size_t)m * PW;
    const int hc = lane & 15, g = lane >> 4, hd = lane & 3;
    bf16x8 qB[2];
    { const bf16x8 z = (bf16x8){0, 0, 0, 0, 0, 0, 0, 0}; const bf16* qp = prow + PC_BQ + hd * 64 + 8 * g;
      const bf16x8 q0 = *(const bf16x8*)(qp), q1 = *(const bf16x8*)(qp + 32); qB[0] = hc < 4 ? q0 : z; qB[1] = hc < 4 ? q1 : z; }
    f32x4v oT[4];
#pragma unroll
    for (int mt = 0; mt < 4; ++mt) oT[mt] = (f32x4v){0.f, 0.f, 0.f, 0.f};
    float mrun = -INFINITY, lsum = 0.f;
    const float SC = 0.125f * LOG2E;
    const int i16 = lane & 15, tq4 = i16 >> 2, tp = i16 & 3;
    const int rd_row = (lane & 15) * 144 + 16 * g;
    const int rd_tr = (4 * g + tq4) * 144 + 8 * tp;
    u32x4 g0, g1, g2, g3, g4, g5, g6, g7;
#define BG_LOAD(CH) do { const int kk_ = 64 * (CH) + lane; const int idx_ = (int)sidx[kk_ < nsel ? kk_ : 0] & (SEQ - 1); const u32x4* cp_ = (const u32x4*)(CKVN + (rowb + idx_) * 64); \
        g0 = cp_[0]; g1 = cp_[1]; g2 = cp_[2]; g3 = cp_[3]; g4 = cp_[4]; g5 = cp_[5]; g6 = cp_[6]; g7 = cp_[7]; } while (0)
    BG_LOAD(0);
#pragma unroll 1
    for (int ch = 0; ch < 4; ++ch) {
        if (64 * ch >= nsel) break;
        { LAS u32x4* ip = (LAS u32x4*)(img + lane * 144); ip[0] = g0; ip[1] = g1; ip[2] = g2; ip[3] = g3; ip[4] = g4; ip[5] = g5; ip[6] = g6; ip[7] = g7; }
        if (64 * (ch + 1) < nsel) BG_LOAD(ch + 1);
        asm volatile("s_waitcnt lgkmcnt(0)" ::: "memory");
        f32x4v st[4];
        float mx = -INFINITY;
#pragma unroll
        for (int kt = 0; kt < 4; ++kt) {
            const bf16x8 a0 = *(const LAS bf16x8*)(img + rd_row + (16 * kt) * 144), a1 = *(const LAS bf16x8*)(img + rd_row + (16 * kt) * 144 + 64);
            f32x4v acc = (f32x4v){0.f, 0.f, 0.f, 0.f};
            acc = __builtin_amdgcn_mfma_f32_16x16x32_bf16(a0, qB[0], acc, 0, 0, 0);
            acc = __builtin_amdgcn_mfma_f32_16x16x32_bf16(a1, qB[1], acc, 0, 0, 0);
            const int kb = 64 * ch + 16 * kt + 4 * g;
            const unsigned bk4 = *(const LAS unsigned*)(sbk + kb);
#pragma unroll
            for (int i = 0; i < 4; ++i) { const int bk = (bk4 >> (8 * i)) & 0xff; const float bias = rpb[bk * 8 + 4 + hd] * LOG2E;
                const float v = (kb + i < nsel) ? acc[i] * SC + bias : -INFINITY; acc[i] = v; mx = fmaxf(mx, v); }
            st[kt] = acc; }
        mx = fmaxf(mx, __shfl_xor(mx, 16)); mx = fmaxf(mx, __shfl_xor(mx, 32));
        const float mn = fmaxf(mrun, mx), alpha = __builtin_amdgcn_exp2f(mrun - mn); mrun = mn;
        float ps = 0.f;
#pragma unroll
        for (int kt = 0; kt < 4; ++kt)
#pragma unroll
            for (int i = 0; i < 4; ++i) { st[kt][i] = __builtin_amdgcn_exp2f(st[kt][i] - mn); ps += st[kt][i]; }
        lsum = lsum * alpha + ps;
#pragma unroll
        for (int mt = 0; mt < 4; ++mt) oT[mt] = oT[mt] * alpha;
#pragma unroll
        for (int ks2 = 0; ks2 < 2; ++ks2) {
            u32x4 w; w.x = cvtpk_s(st[2 * ks2][0], st[2 * ks2][1]); w.y = cvtpk_s(st[2 * ks2][2], st[2 * ks2][3]); w.z = cvtpk_s(st[2 * ks2 + 1][0], st[2 * ks2 + 1][1]); w.w = cvtpk_s(st[2 * ks2 + 1][2], st[2 * ks2 + 1][3]);
            const bf16x8 pB = __builtin_bit_cast(bf16x8, w);
#pragma unroll
            for (int mt = 0; mt < 4; ++mt) {
                const s16x4 lo = vtr(img + rd_tr + (32 * ks2) * 144 + 32 * mt), hi = vtr(img + rd_tr + (32 * ks2 + 16) * 144 + 32 * mt);
                const bf16x8 A = (bf16x8){lo[0], lo[1], lo[2], lo[3], hi[0], hi[1], hi[2], hi[3]};
                oT[mt] = __builtin_amdgcn_mfma_f32_16x16x32_bf16(A, pB, oT[mt], 0, 0, 0); } }
        asm volatile("s_waitcnt lgkmcnt(0)" ::: "memory");
    }
#undef BG_LOAD
    float lt = lsum; lt += __shfl_xor(lt, 16); lt += __shfl_xor(lt, 32);
    const float inv = 1.f / lt;
    if (hc < 4) { bf16* yo = YS + (size_t)m * 1024 + 256 + hc * 64 + 4 * g;
#pragma unroll
        for (int mt = 0; mt < 4; ++mt) { u32x2 w; w.x = cvtpk_s(oT[mt][0] * inv, oT[mt][1] * inv); w.y = cvtpk_s(oT[mt][2] * inv, oT[mt][3] * inv); *(u32x2*)(yo + 16 * mt) = w; } }
}
__device__ __forceinline__ void mixB_group(const Args& a, int l, int m0, LAS unsigned char* lds, LAS unsigned char* wscr, int lane_in, const int bmode = 15) {
    int lane = lane_in; asm volatile("" : "+v"(lane));
    const bf16* P = (const bf16*)(a.ws + WS_BIG);
    const int t0 = m0 & (SEQ - 1); const size_t rowb = (size_t)(m0 - t0);
    const int ql = lane & 31, hh = lane >> 5;
    LAS unsigned short* sidx = (LAS unsigned short*)wscr;
    LAS unsigned char* sbk = wscr + 2048;
    LAS unsigned char* img = wscr + 3584;
    const LAS unsigned char* bkt = lds + BKT_OFF;
    bf16x8 qf[2];
    { const int rho = ql, qi = 2 * ((rho >> 2) & 1) + (rho >> 4), hd = 4 * ((rho >> 3) & 1) + (rho & 3);
      const bf16* ip = P + (size_t)(m0 + qi) * PW + PC_IQ + hd * 32 + 8 * hh;
      qf[0] = *(const bf16x8*)(ip); qf[1] = *(const bf16x8*)(ip + 16); }
    float iw[2][8];
#pragma unroll
    for (int qq = 0; qq < 2; ++qq) { const u32x4 w = *(const u32x4*)(P + (size_t)(m0 + 2 * hh + qq) * PW + PC_IW); const float s = 0.0625f;
        iw[qq][0] = bflo(w.x) * s; iw[qq][1] = bfhi(w.x) * s; iw[qq][2] = bflo(w.y) * s; iw[qq][3] = bfhi(w.y) * s; iw[qq][4] = bflo(w.z) * s; iw[qq][5] = bfhi(w.z) * s; iw[qq][6] = bflo(w.w) * s; iw[qq][7] = bfhi(w.w) * s; }
    const int tq0 = t0 + 2 * hh;
    const int ntile = ((t0 + 3) >> 5) + 1;
    unsigned sk[2][64];
#pragma unroll
    for (int kb4 = 0; kb4 < 32; ++kb4) {
        if (2 * kb4 < ntile && (bmode & 1)) {
            bf16x8 kf0[2], kf1[2];
#pragma unroll
            for (int k4 = 0; k4 < 2; ++k4) { const int s = 32 * (2 * kb4 + k4) + ql; const bf16* kp = P + (rowb + s) * PW + PC_IK + 8 * hh; kf0[k4] = *(const bf16x8*)(kp); kf1[k4] = *(const bf16x8*)(kp + 16); }
#pragma unroll
            for (int k4 = 0; k4 < 2; ++k4) { const int kt = 2 * kb4 + k4; const int s = 32 * kt + ql;
                f32x16 acc;
#pragma unroll
                for (int i = 0; i < 16; ++i) acc[i] = 0.f;
                acc = __builtin_amdgcn_mfma_f32_32x32x16_bf16(qf[0], kf0[k4], acc, 0, 0, 0);
                acc = __builtin_amdgcn_mfma_f32_32x32x16_bf16(qf[1], kf1[k4], acc, 0, 0, 0);
                float s0 = 0.f, s1 = 0.f;
#pragma unroll
                for (int i = 0; i < 8; ++i) { s0 += fmaxf(acc[i], 0.f) * iw[0][i]; s1 += fmaxf(acc[8 + i], 0.f) * iw[1][i]; }
                sk[0][kt] = (s <= tq0) ? fkey(s0) : 0x007fffffu; sk[1][kt] = (s <= tq0 + 1) ? fkey(s1) : 0x007fffffu; }
        } else {
#pragma unroll
            for (int k4 = 0; k4 < 2; ++k4) { sk[0][2 * kb4 + k4] = 0x007fffffu; sk[1][2 * kb4 + k4] = 0x007fffffu; }
        }
    }
    const unsigned ltm = (1u << ql) - 1u;
    const int nblk8 = (ntile + 7) >> 3;
#define SK_RED(C) do { C += __builtin_amdgcn_update_dpp(0, C, 0x128, 0xf, 0xf, true); C += __builtin_amdgcn_update_dpp(0, C, 0x124, 0xf, 0xf, true); \
        C += __builtin_amdgcn_update_dpp(0, C, 0x122, 0xf, 0xf, true); C += __builtin_amdgcn_update_dpp(0, C, 0x121, 0xf, 0xf, true); C += __shfl_xor(C, 16); } while (0)
#define SK_COUNT2(OP, R0, R1, C0, C1) do { _Pragma("unroll") for (int kb8 = 0; kb8 < 8; ++kb8) { if (kb8 < nblk8) { _Pragma("unroll") for (int k8 = 0; k8 < 8; ++k8) { \
        C0 += (sk[0][8 * kb8 + k8] OP (R0)) ? 1 : 0; C1 += (sk[1][8 * kb8 + k8] OP (R1)) ? 1 : 0; } } } SK_RED(C0); SK_RED(C1); } while (0)
    unsigned KthA[2] = {0u, 0u}; int needA[2] = {0, 0};
    const bool big0 = (tq0 + 1 > 256), big1 = (tq0 + 2 > 256); bool exact = true;
    if (__any(big0 || big1) && (bmode & 2)) {
        exact = false;
#pragma unroll 1
        for (int bit = 31; bit >= 0; --bit) { const unsigned c0 = KthA[0] | (1u << bit), c1 = KthA[1] | (1u << bit); int n0 = 0, n1 = 0;
            SK_COUNT2(>=, c0, c1, n0, n1);
            if (n0 >= 256) KthA[0] = c0;
            if (n1 >= 256) KthA[1] = c1;
            if (__all((n0 == 256 || !big0) && (n1 == 256 || !big1))) { exact = true; break; }
        }
        if (!exact) { int g0 = 0, g1 = 0; SK_COUNT2(>, KthA[0], KthA[1], g0, g1); needA[0] = 256 - g0; needA[1] = 256 - g1; }
    }
#pragma unroll
    for (int qq = 0; qq < 2; ++qq) {
        if (!(bmode & 4)) break;
        const int tq = tq0 + qq; const bool big = qq ? big1 : big0; const unsigned Kth = KthA[qq]; const int need = needA[qq];
        LAS unsigned short* sx = sidx + (2 * hh + qq) * 256;
        int base = 0, tie_taken = 0; int ql2 = ql; asm volatile("" : "+v"(ql2));
#pragma unroll
        for (int kb8 = 0; kb8 < 8; ++kb8) { if (kb8 < nblk8) {
#pragma unroll
            for (int k8 = 0; k8 < 8; ++k8) { const int kt = 8 * kb8 + k8; const int s = 32 * kt + ql2; const unsigned k = sk[qq][kt]; bool take;
                if (!big) take = (s <= tq);
                else if (exact) take = (k >= Kth);
                else { const bool tie = (k == Kth); const unsigned long long mt = __ballot(tie); const unsigned mt32 = hh ? (unsigned)(mt >> 32) : (unsigned)mt;
                    take = (k > Kth) || (tie && (tie_taken + __popc(mt32 & ltm)) < need); tie_taken += __popc(mt32); }
                const unsigned long long ms = __ballot(take); const unsigned ms32 = hh ? (unsigned)(ms >> 32) : (unsigned)ms;
                if (take) sx[base + __popc(ms32 & ltm)] = (unsigned short)s;
                base += __popc(ms32); } } }
    }
#undef SK_COUNT2
#undef SK_RED
    LDS_WAIT(); asm volatile("" ::: "memory");
#pragma unroll
    for (int qi = 0; qi < 4; ++qi) { const int tq = t0 + qi; const int nsel = (tq + 1 < 256) ? tq + 1 : 256;
#pragma unroll
        for (int j = 0; j < 4; ++j) { const int pos = lane + 64 * j; if (pos < nsel) sbk[qi * 256 + pos] = bkt[tq - (int)sidx[qi * 256 + pos]]; } }
    LDS_WAIT(); asm volatile("" ::: "memory");
#pragma unroll 1
    for (int qi = 0; qi < 4; ++qi) { if (!(bmode & 8)) break; const int tq = t0 + qi; const int nsel = (tq + 1 < 256) ? tq + 1 : 256;
        mixB_attend(a, m0 + qi, sidx + qi * 256, sbk + qi * 256, nsel, lds, img, lane); asm volatile("" ::: "memory"); }
}
constexpr int DM_OFF = 111616;
__device__ __forceinline__ bf16x8 frag2(const LAS unsigned char* p0, const LAS unsigned char* p1) {
    const s16x4 lo = *(const LAS s16x4*)p0, hi = *(const LAS s16x4*)p1; return (bf16x8){lo[0], lo[1], lo[2], lo[3], hi[0], hi[1], hi[2], hi[3]}; }
__device__ __forceinline__ bf16x8 fragtr(const LAS unsigned char* p0, const LAS unsigned char* p1) {
    const s16x4 lo = vtr(p0), hi = vtr(p1); return (bf16x8){lo[0], lo[1], lo[2], lo[3], hi[0], hi[1], hi[2], hi[3]}; }
__device__ __forceinline__ bf16x8 packf(f32x4 lo, f32x4 hi) { u32x4 w; w.x = cvtpk_s(lo[0], lo[1]); w.y = cvtpk_s(lo[2], lo[3]); w.z = cvtpk_s(hi[0], hi[1]); w.w = cvtpk_s(hi[2], hi[3]); return __builtin_bit_cast(bf16x8, w); }
__device__ __forceinline__ void dchunk_wave(const Args& a, int l, int bh, LAS unsigned char* dm, int lane_in) {
    int lane = lane_in; asm volatile("" : "+v"(lane));
    const int b = bh >> 2, h = bh & 3, hc = lane & 15, g = lane >> 4;
    LAS unsigned char* sAT = dm; LAS unsigned char* sBT = dm + 2304; LAS unsigned char* sKT = dm + 4608; LAS unsigned char* sRT = dm + 6912; LAS unsigned char* sVT = dm + 9216; LAS unsigned char* sUT = dm + 11520;
    LAS float* sW1 = (LAS float*)(dm + 13824); LAS float* sMB = (LAS float*)(dm + 17920); LAS float* sCL = (LAS float*)(dm + 18944); LAS float* sBON = (LAS float*)(dm + 19200);
    const bf16* DR = (const bf16*)((unsigned char*)a.out + DO_DR); const bf16* DKP = (const bf16*)((unsigned char*)a.out + DO_DKP); const bf16* DV = (const bf16*)((unsigned char*)a.out + DO_DV); const bf16* DKK = (const bf16*)((unsigned char*)a.out + DO_DKK);
    const float* DCL = (const float*)(a.ws + WS_BIG + BIG_DW); const bf16* DAI = (const bf16*)(a.ws + WS_BIG + BIG_DAI); const bf16* DG = (const bf16*)(a.ws + WS_BIG + BIG_DG);
    const float* BON = (const float*)(a.ws + WS_BON); bf16* YS = (bf16*)((unsigned char*)a.out + DO_YS);
    float gnw[4], gnb[4];
#pragma unroll
    for (int vt = 0; vt < 4; ++vt) { gnw[vt] = a.in[17][l * 256 + h * 64 + 16 * vt + hc]; gnb[vt] = a.in[18][l * 256 + h * 64 + 16 * vt + hc]; }
    const size_t tok0 = (size_t)b * SEQ;
    f32x4v T[4][4];
#pragma unroll
    for (int kt = 0; kt < 4; ++kt)
#pragma unroll
        for (int vt = 0; vt < 4; ++vt) T[kt][vt] = (f32x4v){0.f, 0.f, 0.f, 0.f};
    const int lrow = lane >> 3, lseg = lane & 7;
    u32x4 nA0, nA1, nB0, nB1, nK0, nK1, nR0, nR1, nV0, nV1; float nCL, nBON;
#define DC_LOAD(CH) do { const size_t e0_ = (tok0 + (size_t)(CH) * 16 + lrow) * 256 + h * 64 + 8 * lseg, e1_ = e0_ + 8 * 256; \
        nA0 = *(const u32x4*)(DKK + e0_); nA1 = *(const u32x4*)(DKK + e1_); nB0 = *(const u32x4*)(DAI + e0_); nB1 = *(const u32x4*)(DAI + e1_); nK0 = *(const u32x4*)(DKP + e0_); nK1 = *(const u32x4*)(DKP + e1_); \
        nR0 = *(const u32x4*)(DR + e0_); nR1 = *(const u32x4*)(DR + e1_); nV0 = *(const u32x4*)(DV + e0_); nV1 = *(const u32x4*)(DV + e1_); \
        nCL = DCL[((size_t)b * (SEQ / 16) + (CH)) * 256 + h * 64 + lane]; nBON = BON[(tok0 + (size_t)(CH) * 16 + (lane & 15)) * 4 + h]; } while (0)
    DC_LOAD(0);
    const int st0 = lrow * 144 + lseg * 16, st1 = st0 + 8 * 144;
    const int rdf = hc * 144 + 8 * g;
    const int rdt = (4 * g + (hc >> 2)) * 144 + 8 * (hc & 3);
    __builtin_amdgcn_s_setprio(2);
#pragma unroll 1
    for (int ch = 0; ch < SEQ / 16; ++ch) {
        *(LAS u32x4*)(sAT + st0) = nA0; *(LAS u32x4*)(sAT + st1) = nA1; *(LAS u32x4*)(sBT + st0) = nB0; *(LAS u32x4*)(sBT + st1) = nB1; *(LAS u32x4*)(sKT + st0) = nK0; *(LAS u32x4*)(sKT + st1) = nK1;
        *(LAS u32x4*)(sRT + st0) = nR0; *(LAS u32x4*)(sRT + st1) = nR1; *(LAS u32x4*)(sVT + st0) = nV0; *(LAS u32x4*)(sVT + st1) = nV1; sCL[lane] = nCL; if (lane < 16) sBON[lane] = nBON;
        unsigned short gq[4][4];
#pragma unroll
        for (int vt = 0; vt < 4; ++vt)
#pragma unroll
            for (int i = 0; i < 4; ++i) gq[vt][i] = DG[(tok0 + (size_t)ch * 16 + 4 * g + i) * 256 + h * 64 + 16 * vt + hc];
        asm volatile("s_waitcnt lgkmcnt(0)" ::: "memory");
        bf16x8 fA[2], fR[2], fB[2], fK[2];
#pragma unroll
        for (int ks = 0; ks < 2; ++ks) { fA[ks] = frag2(sAT + rdf + 64 * ks, sAT + rdf + 64 * ks + 32); fR[ks] = frag2(sRT + rdf + 64 * ks, sRT + rdf + 64 * ks + 32);
            fB[ks] = frag2(sBT + rdf + 64 * ks, sBT + rdf + 64 * ks + 32); fK[ks] = frag2(sKT + rdf + 64 * ks, sKT + rdf + 64 * ks + 32); }
        f32x4v U0[4], Y0[4];
#pragma unroll
        for (int vt = 0; vt < 4; ++vt) { const bf16x8 s0 = packf(T[0][vt], T[1][vt]), s1 = packf(T[2][vt], T[3][vt]);
            f32x4v u = (f32x4v){0.f, 0.f, 0.f, 0.f}, y = (f32x4v){0.f, 0.f, 0.f, 0.f};
            u = __builtin_amdgcn_mfma_f32_16x16x32_bf16(fA[0], s0, u, 0, 0, 0); u = __builtin_amdgcn_mfma_f32_16x16x32_bf16(fA[1], s1, u, 0, 0, 0);
            y = __builtin_amdgcn_mfma_f32_16x16x32_bf16(fR[0], s0, y, 0, 0, 0); y = __builtin_amdgcn_mfma_f32_16x16x32_bf16(fR[1], s1, y, 0, 0, 0);
            U0[vt] = u; Y0[vt] = y; }
        f32x4v Mka = (f32x4v){0.f, 0.f, 0.f, 0.f}, Mba = Mka, Mkr = Mka, Mbr = Mka;
#pragma unroll
        for (int ks = 0; ks < 2; ++ks) { Mka = __builtin_amdgcn_mfma_f32_16x16x32_bf16(fK[ks], fA[ks], Mka, 0, 0, 0); Mba = __builtin_amdgcn_mfma_f32_16x16x32_bf16(fB[ks], fA[ks], Mba, 0, 0, 0);
            Mkr = __builtin_amdgcn_mfma_f32_16x16x32_bf16(fK[ks], fR[ks], Mkr, 0, 0, 0); Mbr = __builtin_amdgcn_mfma_f32_16x16x32_bf16(fB[ks], fR[ks], Mbr, 0, 0, 0); }
#pragma unroll
        for (int i = 0; i < 4; ++i) { const int srow = 4 * g + i; if (!(srow < hc)) { Mka[i] = 0.f; Mba[i] = 0.f; } if (!(srow <= hc)) { Mkr[i] = 0.f; Mbr[i] = 0.f; } }
        if (ch + 1 < SEQ / 16) DC_LOAD(ch + 1);
        const f32x4v z4 = (f32x4v){0.f, 0.f, 0.f, 0.f};
        { const bf16x8 aM = packf(Mka, z4);
#pragma unroll
          for (int vt = 0; vt < 4; ++vt) { const s16x4 lo = vtr(sVT + rdt + 32 * vt); const bf16x8 bV = (bf16x8){lo[0], lo[1], lo[2], lo[3], 0, 0, 0, 0};
              U0[vt] = __builtin_amdgcn_mfma_f32_16x16x32_bf16(aM, bV, U0[vt], 0, 0, 0); } }
#pragma unroll
        for (int vt = 0; vt < 4; ++vt)
#pragma unroll
            for (int i = 0; i < 4; ++i) sW1[(4 * g + i) * 64 + 16 * vt + hc] = U0[vt][i];
        *(LAS f32x4v*)(sMB + hc * 16 + 4 * g) = Mba;
        asm volatile("s_waitcnt lgkmcnt(0)" ::: "memory");
        { float u[16];
#pragma unroll
          for (int t = 0; t < 16; ++t) { float acc = sW1[t * 64 + lane];
#pragma unroll
              for (int sq = 0; sq < 4; ++sq) { if (4 * sq < t) { const f32x4v mb = *(const LAS f32x4v*)(sMB + t * 16 + 4 * sq);
#pragma unroll
                  for (int e = 0; e < 4; ++e) if (4 * sq + e < t) acc += mb[e] * u[4 * sq + e]; } }
              u[t] = acc; ((LAS bf16*)sUT)[t * 72 + lane] = (bf16)f2bf(acc); } }
        asm volatile("s_waitcnt lgkmcnt(0)" ::: "memory");
        f32x4v bonv = *(const LAS f32x4v*)(sBON + 4 * g);
        { const bf16x8 aM = packf(Mbr, Mkr);
#pragma unroll
          for (int vt = 0; vt < 4; ++vt) { const bf16x8 bUV = fragtr(sUT + rdt + 32 * vt, sVT + rdt + 32 * vt); Y0[vt] = __builtin_amdgcn_mfma_f32_16x16x32_bf16(aM, bUV, Y0[vt], 0, 0, 0); } }
        { bf16x8 bUV[4];
#pragma unroll
          for (int vt = 0; vt < 4; ++vt) bUV[vt] = fragtr(sUT + rdt + 32 * vt, sVT + rdt + 32 * vt);
#pragma unroll
          for (int kt = 0; kt < 4; ++kt) { const bf16x8 aBK = fragtr(sBT + rdt + 32 * kt, sKT + rdt + 32 * kt); const f32x4v cl = *(const LAS f32x4v*)(sCL + 16 * kt + 4 * g);
#pragma unroll
              for (int vt = 0; vt < 4; ++vt) T[kt][vt] = __builtin_amdgcn_mfma_f32_16x16x32_bf16(aBK, bUV[vt], T[kt][vt], 0, 0, 0) * cl; } }
#pragma unroll
        for (int i = 0; i < 4; ++i) { float sm = (Y0[0][i] + Y0[1][i]) + (Y0[2][i] + Y0[3][i]);
            sm += dppf<0x128>(sm); sm += dppf<0x124>(sm); sm += dppf<0x122>(sm); sm += dppf<0x121>(sm);
            const float mean = sm * (1.f / 64.f); float sq = 0.f;
#pragma unroll
            for (int vt = 0; vt < 4; ++vt) { const float d = Y0[vt][i] - mean; sq += d * d; }
            sq += dppf<0x128>(sq); sq += dppf<0x124>(sq); sq += dppf<0x122>(sq); sq += dppf<0x121>(sq);
            const float rstd = rsqrtf(sq * (1.f / 64.f) + 64e-5f); const int t = 4 * g + i;
#pragma unroll
            for (int vt = 0; vt < 4; ++vt) { const float vv = bf2f(((const LAS bf16*)sVT)[t * 72 + 16 * vt + hc]);
                const float o = ((Y0[vt][i] - mean) * rstd * gnw[vt] + gnb[vt] + bonv[i] * vv) * bf2f(gq[vt][i]);
                YS[(tok0 + (size_t)ch * 16 + t) * 1024 + 768 + h * 64 + 16 * vt + hc] = (bf16)f2bf(o); } }
        asm volatile("s_waitcnt lgkmcnt(0)" ::: "memory");
    }
    __builtin_amdgcn_s_setprio(0);
#undef DC_LOAD
}
__device__ __forceinline__ void cchunk_wave(const Args& a, int l, int bh, LAS unsigned char* dm, int lane_in) {
    int lane = lane_in; asm volatile("" : "+v"(lane));
    const int b = bh >> 2, h = bh & 3, hc = lane & 15, g = lane >> 4;
    LAS unsigned char* sQT = dm; LAS unsigned char* sKT = dm + 1280; LAS unsigned char* sVT = dm + 2560; LAS float* sCL = (LAS float*)(dm + 4864);
    const bf16* P = (const bf16*)(a.ws + WS_BIG); const bf16* CQH = (const bf16*)(a.ws + WS_CA); const bf16* CKT = (const bf16*)(a.ws + WS_CA + 16 * MiB); const float* CCL = (const float*)(a.ws + WS_END);
    bf16* YS = (bf16*)((unsigned char*)a.out + DO_YS);
    float ng[4];
#pragma unroll
    for (int vt = 0; vt < 4; ++vt) ng[vt] = a.in[7][l * 256 + h * 64 + 16 * vt + hc];
    const size_t tok0 = (size_t)b * SEQ;
    f32x4v T[2][4];
#pragma unroll
    for (int kt = 0; kt < 2; ++kt)
#pragma unroll
        for (int vt = 0; vt < 4; ++vt) T[kt][vt] = (f32x4v){0.f, 0.f, 0.f, 0.f};
    const int qrow = lane >> 2, qseg = lane & 3, lrow = lane >> 3, lseg = lane & 7;
    u32x4 nQ, nK, nV0, nV1; float nCL;
#define CC_LOAD(CH) do { const size_t tq_ = tok0 + (size_t)(CH) * 16 + qrow; nQ = *(const u32x4*)(CQH + tq_ * 128 + h * 32 + 8 * qseg); nK = *(const u32x4*)(CKT + tq_ * 128 + h * 32 + 8 * qseg); \
        const size_t tv_ = tok0 + (size_t)(CH) * 16 + lrow; nV0 = *(const u32x4*)(P + tv_ * PW + PC_CV + h * 64 + 8 * lseg); nV1 = *(const u32x4*)(P + (tv_ + 8) * PW + PC_CV + h * 64 + 8 * lseg); \
        nCL = CCL[((size_t)b * (SEQ / 16) + (CH)) * 128 + h * 32 + (lane & 31)]; } while (0)
    CC_LOAD(0);
    const int rdf = hc * 80 + 8 * g;
    const int rdtk = (4 * g + (hc >> 2)) * 80 + 8 * (hc & 3);
    const int rdtv = (4 * g + (hc >> 2)) * 144 + 8 * (hc & 3);
    __builtin_amdgcn_s_setprio(2);
#pragma unroll 1
    for (int ch = 0; ch < SEQ / 16; ++ch) {
        *(LAS u32x4*)(sQT + qrow * 80 + qseg * 16) = nQ; *(LAS u32x4*)(sKT + qrow * 80 + qseg * 16) = nK;
        *(LAS u32x4*)(sVT + lrow * 144 + lseg * 16) = nV0; *(LAS u32x4*)(sVT + (lrow + 8) * 144 + lseg * 16) = nV1; if (lane < 32) sCL[lane] = nCL;
        unsigned short gq[4][4];
#pragma unroll
        for (int vt = 0; vt < 4; ++vt)
#pragma unroll
            for (int i = 0; i < 4; ++i) gq[vt][i] = P[(tok0 + (size_t)ch * 16 + 4 * g + i) * PW + PC_CG + h * 64 + 16 * vt + hc];
        asm volatile("s_waitcnt lgkmcnt(0)" ::: "memory");
        const bf16x8 fQ = frag2(sQT + rdf, sQT + rdf + 32), fK = frag2(sKT + rdf, sKT + rdf + 32);
        f32x4v Y0[4];
#pragma unroll
        for (int vt = 0; vt < 4; ++vt) { const bf16x8 s0 = packf(T[0][vt], T[1][vt]); Y0[vt] = __builtin_amdgcn_mfma_f32_16x16x32_bf16(fQ, s0, (f32x4v){0.f, 0.f, 0.f, 0.f}, 0, 0, 0); }
        f32x4v Mkq = __builtin_amdgcn_mfma_f32_16x16x32_bf16(fK, fQ, (f32x4v){0.f, 0.f, 0.f, 0.f}, 0, 0, 0);
#pragma unroll
        for (int i = 0; i < 4; ++i) if (!(4 * g + i <= hc)) Mkq[i] = 0.f;
        if (ch + 1 < SEQ / 16) CC_LOAD(ch + 1);
        const f32x4v z4 = (f32x4v){0.f, 0.f, 0.f, 0.f};
        bf16x8 bV[4];
#pragma unroll
        for (int vt = 0; vt < 4; ++vt) { const s16x4 lo = vtr(sVT + rdtv + 32 * vt); bV[vt] = (bf16x8){lo[0], lo[1], lo[2], lo[3], 0, 0, 0, 0}; }
        { const bf16x8 aM = packf(Mkq, z4);
#pragma unroll
          for (int vt = 0; vt < 4; ++vt) Y0[vt] = __builtin_amdgcn_mfma_f32_16x16x32_bf16(aM, bV[vt], Y0[vt], 0, 0, 0); }
#pragma unroll
        for (int kt = 0; kt < 2; ++kt) { const s16x4 lo = vtr(sKT + rdtk + 32 * kt); const bf16x8 aK = (bf16x8){lo[0], lo[1], lo[2], lo[3], 0, 0, 0, 0}; const f32x4v cl = *(const LAS f32x4v*)(sCL + 16 * kt + 4 * g);
#pragma unroll
            for (int vt = 0; vt < 4; ++vt) T[kt][vt] = __builtin_amdgcn_mfma_f32_16x16x32_bf16(aK, bV[vt], T[kt][vt], 0, 0, 0) * cl; }
#pragma unroll
        for (int i = 0; i < 4; ++i) { float sq = 0.f;
#pragma unroll
            for (int vt = 0; vt < 4; ++vt) { const float o = Y0[vt][i] * 0.17677669529663687f; Y0[vt][i] = o; sq += o * o; }
            sq += dppf<0x128>(sq); sq += dppf<0x124>(sq); sq += dppf<0x122>(sq); sq += dppf<0x121>(sq);
            const float rn = rsqrtf(sq * (1.f / 64.f) + 1e-6f); const int t = 4 * g + i;
#pragma unroll
            for (int vt = 0; vt < 4; ++vt) { const float gg = bf2f(gq[vt][i]);
                YS[(tok0 + (size_t)ch * 16 + t) * 1024 + 512 + h * 64 + 16 * vt + hc] = (bf16)f2bf(gg * sigmoidf_(gg) * (Y0[vt][i] * rn * ng[vt])); } }
        asm volatile("s_waitcnt lgkmcnt(0)" ::: "memory");
    }
    __builtin_amdgcn_s_setprio(0);
#undef CC_LOAD
}
__device__ __forceinline__ void mixers_phase(const Args& a, int l, LAS unsigned char* lds, int bid, int G, int tid, int wave, int lane, int qsel = 0, int mixmask = 15, const int bmode = 15) {
    unsigned* qh = (unsigned*)(a.ws + WS_CTL) + CW_Q + 64 * l + 16 * qsel;
    LAS unsigned char* wscr = lds + wave * 12800;
    mixA_tables(a, lds, tid); __syncthreads();
    if (wave == 0) for (int it = bid; it < 256; it += G) { if (it < 128) { if (mixmask & 1) dchunk_wave(a, l, it, lds + DM_OFF, lane); } else { if (mixmask & 2) cchunk_wave(a, l, it - 128, lds + DM_OFF, lane); } }
    for (;;) {
        unsigned cq = 0; if (lane == 0) cq = __hip_atomic_fetch_add(qh, 1u, __ATOMIC_RELAXED, __HIP_MEMORY_SCOPE_AGENT);
        cq = (unsigned)__builtin_amdgcn_readfirstlane((int)cq);
        if (cq >= 16384u) break;
        if (cq < 8192u) { if (!(mixmask & 8)) continue; const int tb = 255 - (int)(cq >> 5), b = (int)(cq & 31u); const int m0 = b * SEQ + tb * 8;
#pragma unroll 1
            for (int k = 0; k < 2; ++k) {
#ifndef MIX_NO_B
                mixB_group(a, l, m0 + 4 * k, lds, wscr, lane, bmode);
#endif
            } }
        else { if (!(mixmask & 4)) continue;
#ifndef MIX_NO_A
            mixA_task(a, (int)(cq - 8192u), lds, wave, lane);
#endif
        }
    }
}

constexpr int RREC_OFF = MISC_OFF + 4096, LCNT_OFF = MISC_OFF + 10240, LBASE_OFF = MISC_OFF + 10368;
__device__ __forceinline__ void ln1_route_phase(const Args& a, int l, LAS unsigned char* lds, int bid, int G, int tid, int wave, int lane) {
    bf16* XB = (bf16*)(a.ws + WS_XB); const float* WRT = (const float*)(a.ws + WS_RT) + (size_t)l * 36 * 1024;
    unsigned* tokinfo = (unsigned*)(a.ws + WS_TOK); unsigned* cntg = (unsigned*)(a.ws + WS_CTL) + CW_CNT + (l * 32) * 64;
    const float* lng = a.in[21] + (l * 2 + 0) * 1024; const float* lnb = a.in[22] + (l * 2 + 0) * 1024;
    const float* brg = a.in[24] + l * 4; const float* bre = a.in[26] + l * 32;
    LAS float* sW = (LAS float*)lds;
    LAS unsigned* rrec = (LAS unsigned*)(lds + RREC_OFF); LAS int* lcnt = (LAS int*)(lds + LCNT_OFF); LAS unsigned* lbase = (LAS unsigned*)(lds + LBASE_OFF);
    for (int i = tid; i < 32 * 1024 / 4; i += NTHR) *(LAS f32x4*)(sW + 4 * i) = *(const f32x4*)(WRT + 4 * 1024 + 4 * i);
    f32x4 gam[4], bet[4], wg[4][4];
#pragma unroll
    for (int j = 0; j < 4; ++j) { gam[j] = *(const f32x4*)(lng + 4 * lane + 256 * j); bet[j] = *(const f32x4*)(lnb + 4 * lane + 256 * j);
#pragma unroll
        for (int e = 0; e < 4; ++e) wg[e][j] = *(const f32x4*)(WRT + e * 1024 + 4 * lane + 256 * j); }
    for (int blk = bid; blk < NTOK / 256; blk += G) {
        if (tid < 32) lcnt[tid] = 0;
        __syncthreads();
#pragma unroll 1
        for (int rg = 0; rg < 8; ++rg) {
            const int rl0 = wave * 32 + rg * 4; f32x4 x[4][4];
#pragma unroll
            for (int r = 0; r < 4; ++r) { bf16* xr = XB + (size_t)(blk * 256 + rl0 + r) * 1024; float s = 0.f;
#pragma unroll
                for (int j = 0; j < 4; ++j) { const u32x2 w = *(const u32x2*)(xr + 4 * lane + 256 * j); x[r][j] = (f32x4){bflo(w.x), bfhi(w.x), bflo(w.y), bfhi(w.y)}; s += (x[r][j][0] + x[r][j][1]) + (x[r][j][2] + x[r][j][3]); }
                const float mean = wave_sum(s) * (1.f / 1024.f); float q = 0.f;
#pragma unroll
                for (int j = 0; j < 4; ++j) { x[r][j] = x[r][j] - mean; q += (x[r][j][0] * x[r][j][0] + x[r][j][1] * x[r][j][1]) + (x[r][j][2] * x[r][j][2] + x[r][j][3] * x[r][j][3]); }
                const float rstd = rsqrtf(wave_sum(q) * (1.f / 1024.f) + LN_EPS);
#pragma unroll
                for (int j = 0; j < 4; ++j) { x[r][j] = x[r][j] * rstd * gam[j] + bet[j]; u32x2 w; w.x = pk2(x[r][j][0], x[r][j][1]); w.y = pk2(x[r][j][2], x[r][j][3]); *(u32x2*)(xr + 4 * lane + 256 * j) = w; }
                }
            float gl[4][4];
#pragma unroll
            for (int e = 0; e < 4; ++e)
#pragma unroll
                for (int r = 0; r < 4; ++r) { float d = 0.f;
#pragma unroll
                    for (int j = 0; j < 4; ++j) d += (x[r][j][0] * wg[e][j][0] + x[r][j][1] * wg[e][j][1]) + (x[r][j][2] * wg[e][j][2] + x[r][j][3] * wg[e][j][3]);
                    gl[r][e] = wave_sum(d) + brg[e]; }
#pragma unroll
            for (int r = 0; r < 4; ++r) {
                const float g0 = gl[r][0], g1 = gl[r][1], g2 = gl[r][2], g3 = gl[r][3];
                int gsv = 0; float gm = g0; if (g1 > gm) { gm = g1; gsv = 1; } if (g2 > gm) { gm = g2; gsv = 2; } if (g3 > gm) { gm = g3; gsv = 3; }
                const int gs = __builtin_amdgcn_readfirstlane(gsv);
                const float ptop = 1.f / (__expf(g0 - gm) + __expf(g1 - gm) + __expf(g2 - gm) + __expf(g3 - gm));
                float v0 = -INFINITY, v1 = -INFINITY; int i0 = 0, i1 = 0;
#pragma unroll 2
                for (int jj = 0; jj < 8; ++jj) { const int e = gs * 8 + jj; float d = 0.f;
#pragma unroll
                    for (int j = 0; j < 4; ++j) { const f32x4 w4 = *(const LAS f32x4*)(sW + e * 1024 + 4 * lane + 256 * j); d += (x[r][j][0] * w4[0] + x[r][j][1] * w4[1]) + (x[r][j][2] * w4[2] + x[r][j][3] * w4[3]); }
                    const float le = wave_sum(d) + bre[e];
                    if (le > v0) { v1 = v0; i1 = i0; v0 = le; i0 = jj; } else if (le > v1) { v1 = le; i1 = jj; } }
                const float ex = __expf(v1 - v0), w0 = ptop / (1.f + ex), w1 = ptop * ex / (1.f + ex);
                if (lane == 0) { const int e0 = gs * 8 + i0, e1 = gs * 8 + i1; const int rl = rl0 + r;
                    const int p0 = atomicAdd((int*)&lcnt[e0], 1), p1 = atomicAdd((int*)&lcnt[e1], 1);
                    rrec[rl * 6 + 0] = (unsigned)e0; rrec[rl * 6 + 1] = (unsigned)p0; rrec[rl * 6 + 2] = __float_as_uint(w0); rrec[rl * 6 + 3] = (unsigned)e1; rrec[rl * 6 + 4] = (unsigned)p1; rrec[rl * 6 + 5] = __float_as_uint(w1); } }
        }
        __syncthreads();
        if (tid < 32) lbase[tid] = __hip_atomic_fetch_add(cntg + tid * 64, (unsigned)lcnt[tid], __ATOMIC_RELAXED, __HIP_MEMORY_SCOPE_AGENT);
        __syncthreads();
        if (tid < 256) { const unsigned e0 = rrec[tid * 6 + 0], e1 = rrec[tid * 6 + 3]; unsigned* ti = tokinfo + (size_t)(blk * 256 + tid) * 8;
            u32x4 o0, o1; o0.x = e0; o0.y = lbase[e0] + rrec[tid * 6 + 1]; o0.z = rrec[tid * 6 + 2]; o0.w = e1; o1.x = lbase[e1] + rrec[tid * 6 + 4]; o1.y = rrec[tid * 6 + 5]; o1.z = 0u; o1.w = 0u;
            *(u32x4*)ti = o0; *(u32x4*)(ti + 4) = o1; }
        __syncthreads();
    }
}
__device__ __forceinline__ void moe_table(const Args& a, int l, LAS unsigned char* lds, int tid) {
    LAS int* tstart = (LAS int*)(lds + TST_OFF);
    if (tid == 0) { const unsigned* cntg = (const unsigned*)(a.ws + WS_CTL) + CW_CNT + (l * 32) * 64; int acc = 0;
        for (int e = 0; e < 32; ++e) { tstart[e] = acc; acc += (int)((__hip_atomic_load(cntg + e * 64, __ATOMIC_RELAXED, __HIP_MEMORY_SCOPE_AGENT) + 255u) >> 8); }
        tstart[32] = acc; }
    __syncthreads();
}
__device__ __forceinline__ void scatter_phase(const Args& a, int l, LAS unsigned char* lds, int bid, int G, int tid, int gw, int NGW, int lane) {
    const LAS int* tstart = (const LAS int*)(lds + TST_OFF);
    const bf16* XB = (const bf16*)(a.ws + WS_XB); bf16* XS = (bf16*)(a.ws + WS_BIG); unsigned* rowinfo = (unsigned*)(a.ws + WS_ROW); const unsigned* tokinfo = (const unsigned*)(a.ws + WS_TOK);
    const unsigned* cntg = (const unsigned*)(a.ws + WS_CTL) + CW_CNT + (l * 32) * 64;
    for (int e = bid; e < 32; e += G) { const int c = (int)__hip_atomic_load(cntg + e * 64, __ATOMIC_RELAXED, __HIP_MEMORY_SCOPE_AGENT); const int r0 = tstart[e] * 256, r1 = tstart[e + 1] * 256;
        unsigned neg_ = 0xffffffffu, zer_ = 0u; asm volatile("" : "+v"(neg_), "+v"(zer_));
        for (int r = r0 + c + tid; r < r1; r += NTHR) { rowinfo[2 * (size_t)r] = neg_; rowinfo[2 * (size_t)r + 1] = zer_; } }
    u32x4 nt0, nv0, nv1; u32x2 nt1;
#define SC_LOAD(mm) do { nt0 = *(const u32x4*)(tokinfo + (size_t)(mm) * 8); nt1 = *(const u32x2*)(tokinfo + (size_t)(mm) * 8 + 4); const u32x4* src_ = (const u32x4*)(XB + (size_t)(mm) * 1024); nv0 = src_[lane]; nv1 = src_[64 + lane]; } while (0)
    if (gw < NTOK) SC_LOAD(gw);
    for (int m = gw; m < NTOK; m += NGW) {
        const u32x4 t0 = nt0, v0 = nv0, v1 = nv1; const u32x2 t1 = nt1;
        if (m + NGW < NTOK) SC_LOAD(m + NGW);
        const size_t r0 = (size_t)tstart[t0.x] * 256 + t0.y, r1 = (size_t)tstart[t0.w] * 256 + t1.x;
        u32x4* d0 = (u32x4*)(XS + r0 * 1024); u32x4* d1 = (u32x4*)(XS + r1 * 1024);
        d0[lane] = v0; d0[64 + lane] = v1; d1[lane] = v0; d1[64 + lane] = v1;
        if (lane == 0) { rowinfo[2 * r0] = (unsigned)(m * 2); rowinfo[2 * r0 + 1] = t0.z; rowinfo[2 * r1] = (unsigned)(m * 2 + 1); rowinfo[2 * r1 + 1] = t1.y; }
    }
}
__device__ __forceinline__ void ln2_phase(const Args& a, int l, int gw, int NGW, int lane) {
    bf16* XB = (bf16*)(a.ws + WS_XB); const bf16* Y = (const bf16*)(a.ws + WS_BIG);
    const float* lng = a.in[21] + (l * 2 + 1) * 1024; const float* lnb = a.in[22] + (l * 2 + 1) * 1024;
    f32x4 gam[4], bet[4];
#pragma unroll
    for (int j = 0; j < 4; ++j) { gam[j] = *(const f32x4*)(lng + 4 * lane + 256 * j); bet[j] = *(const f32x4*)(lnb + 4 * lane + 256 * j); }
    u32x2 nw[4], np2[4], nq2[4];
#define LN2_LOAD(mm) do { const bf16* xr_ = XB + (size_t)(mm) * 1024 + 4 * lane; const bf16* y0_ = Y + (size_t)(mm) * 1024 + 4 * lane; const bf16* y1_ = Y + ((size_t)NTOK + (mm)) * 1024 + 4 * lane; \
        _Pragma("unroll") for (int j = 0; j < 4; ++j) { nw[j] = *(const u32x2*)(xr_ + 256 * j); np2[j] = *(const u32x2*)(y0_ + 256 * j); nq2[j] = *(const u32x2*)(y1_ + 256 * j); } } while (0)
    if (gw < NTOK) LN2_LOAD(gw);
    for (int m = gw; m < NTOK; m += NGW) {
        bf16* xr = XB + (size_t)m * 1024;
        u32x2 cw[4], cp2[4], cq2[4];
#pragma unroll
        for (int j = 0; j < 4; ++j) { cw[j] = nw[j]; cp2[j] = np2[j]; cq2[j] = nq2[j]; }
        if (m + NGW < NTOK) LN2_LOAD(m + NGW);
        f32x4 x[4]; float s = 0.f;
#pragma unroll
        for (int j = 0; j < 4; ++j) { const u32x2 w = cw[j], p = cp2[j], q = cq2[j];
            x[j] = (f32x4){DN_ALPHA * bflo(w.x) + (bflo(p.x) + bflo(q.x)), DN_ALPHA * bfhi(w.x) + (bfhi(p.x) + bfhi(q.x)), DN_ALPHA * bflo(w.y) + (bflo(p.y) + bflo(q.y)), DN_ALPHA * bfhi(w.y) + (bfhi(p.y) + bfhi(q.y))};
            s += (x[j][0] + x[j][1]) + (x[j][2] + x[j][3]); }
        const float mean = wave_sum(s) * (1.f / 1024.f); float q = 0.f;
#pragma unroll
        for (int j = 0; j < 4; ++j) { x[j] = x[j] - mean; q += (x[j][0] * x[j][0] + x[j][1] * x[j][1]) + (x[j][2] * x[j][2] + x[j][3] * x[j][3]); }
        const float rstd = rsqrtf(wave_sum(q) * (1.f / 1024.f) + LN_EPS);
#pragma unroll
        for (int j = 0; j < 4; ++j) { x[j] = x[j] * rstd * gam[j] + bet[j];
            if (l == NLAYER - 1) *(f32x4*)(a.out + (size_t)m * 1024 + 4 * lane + 256 * j) = x[j];
            else { u32x2 w; w.x = pk2(x[j][0], x[j][1]); w.y = pk2(x[j][2], x[j][3]); *(u32x2*)(xr + 4 * lane + 256 * j) = w; } }
    }
}

#ifndef MK_MULTI
#define MK_MULTI 0
#endif
constexpr int NPHASE = 12;
__global__ void __launch_bounds__(NTHR, 2) fwd(Args a) {
    extern __shared__ __attribute__((aligned(16))) unsigned char lds_raw[];
    LAS unsigned char* lds = (LAS unsigned char*)lds_raw;
    const int G0 = gridDim.x, bid0 = blockIdx.x, wave0 = __builtin_amdgcn_readfirstlane((int)(threadIdx.x >> 6));
#define PH_IDS unsigned on_ = ~0u; asm volatile("" : "+s"(on_)); int lz_ = (int)__builtin_amdgcn_mbcnt_hi(on_, __builtin_amdgcn_mbcnt_lo(on_, 0u)); int wz_ = wave0, bz_ = bid0, gz_ = G0; asm volatile("" : "+s"(wz_), "+s"(bz_), "+s"(gz_)); \
    const int lane = lz_, wave = wz_, tid = wz_ * 64 + lz_, bid = bz_, G = gz_, NGW = gz_ * NWAVES, gw = bid * NWAVES + wave; (void)lane; (void)gw; (void)wave; (void)tid; (void)NGW;
#define PH_ARGS(LV) const __attribute__((address_space(4))) Args* kp_ = (const __attribute__((address_space(4))) Args*)__builtin_amdgcn_kernarg_segment_ptr(); asm volatile("" : "+s"(kp_)); const Args& b = *(const Args*)kp_; int lq = (LV); asm volatile("" : "+s"(lq)); (void)lq; \
    bf16* XB = (bf16*)(b.ws + WS_XB); bf16* PB = (bf16*)(b.ws + WS_BIG); bf16* YS = (bf16*)((unsigned char*)b.out + DO_YS); bf16* MG = (bf16*)((unsigned char*)b.out + DO_MG); \
    unsigned* rowinfo = (unsigned*)(b.ws + WS_ROW); unsigned char* wl = b.ws + WS_W + (size_t)lq * WL_SIZE; (void)XB; (void)PB; (void)YS; (void)MG; (void)rowinfo; (void)wl;
    unsigned* ctl = (unsigned*)(a.ws + WS_CTL);
    { PH_IDS
    for (int u = tid; u < (LDS_BYTES - MISC_OFF) / 4; u += NTHR) ((LAS unsigned*)(lds + MISC_OFF))[u] = 0u;
    __syncthreads();
    for (int d = tid; d < 2048; d += NTHR) ((LAS unsigned char*)(lds + BKT_OFF))[d] = (unsigned char)t5_bucket(d);
    if (tid < 256) ((LAS float*)(lds + RPB_OFF))[tid] = a.in[1][tid];
    __syncthreads(); }
    XcdBarrier bar; bar.bar = ctl + CW_BAR; bar.x = 0; bar.st = nullptr;
    if (a.use_bar) bar = xcd_barrier_post(ctl + CW_BAR, (volatile LAS unsigned*)(lds + MISC_OFF) + 8);
#define GRID_BAR() do { if (a.use_bar) { const __attribute__((address_space(4))) Args* kq_ = (const __attribute__((address_space(4))) Args*)__builtin_amdgcn_kernarg_segment_ptr(); asm volatile("" : "+s"(kq_)); \
        XcdBarrier bb_ = bar; bb_.bar = (unsigned*)(kq_->ws + WS_CTL) + CW_BAR; xcd_barrier(bb_); } } while (0)
#ifndef PHMASK
#define PHMASK 0xFFF
#endif
#define IN(k) (((PHMASK >> (k)) & 1) && ((phm >> (k)) & 1u))

    unsigned phm = ((1u << a.ph_hi) - 1u) & ~((1u << a.ph_lo) - 1u);
    if (a.l_lo == 0 && IN(0)) { PH_IDS PH_ARGS(0) p0_prologue(b, lds, gw, NGW, wave, lane); GRID_BAR(); }
    for (int l = a.l_lo; l < a.l_hi; ++l) {
        asm volatile("" : "+s"(phm));
        if (IN(1)) { PH_IDS PH_ARGS(l) pg8::Gemm g{XB, (const bf16*)(wl + WL_IN), 1024, 1024, 1024}; pg8::GridOrder S; S.init(NTOK / 256, PW / 256, G, bid);
            pg8::EpiStoreBf16 E{PB, PW}; pg8::gemm_phase(lds, g, S, E, tid); GRID_BAR(); }
        if (IN(2)) { PH_IDS PH_ARGS(l) prep_phase(b, lq, lds, tid, gw, NGW, lane); GRID_BAR(); }
        if (IN(3)) { PH_IDS PH_ARGS(l) mixers_phase(b, lq, lds, bid, G, tid, wave, lane); GRID_BAR(); }
        if (IN(4)) { PH_IDS PH_ARGS(l) pg8::Gemm g{YS, (const bf16*)(wl + WL_BR), 1024, 256, 256}; pg8::GridOrder S; S.init(NTOK / 256, 16, G, bid, 4, 512);
            pg8::EpiStoreBf16 E{PB, 4096}; pg8::gemm_phase(lds, g, S, E, tid); GRID_BAR(); }
        if (IN(5)) { PH_IDS PH_ARGS(l) pg8::Gemm g{XB, (const bf16*)(wl + WL_IN) + (size_t)3072 * 1024, 1024, 1024, 1024}; pg8::GridOrder S; S.init(NTOK / 256, 16, G, bid);
            pg8::EpiGate E{PB, MG}; pg8::gemm_phase(lds, g, S, E, tid); GRID_BAR(); }
        if (IN(6)) { PH_IDS PH_ARGS(l) pg8::Gemm g{MG, (const bf16*)(wl + WL_OUT), 1024, 1024, 1024}; pg8::GridOrder S; S.init(NTOK / 256, 4, G, bid);
            pg8::EpiOut E{XB}; pg8::gemm_phase(lds, g, S, E, tid); GRID_BAR(); }
        if (IN(7)) { PH_IDS PH_ARGS(l) ln1_route_phase(b, lq, lds, bid, G, tid, wave, lane); GRID_BAR(); }
        if (IN(8)) { PH_IDS PH_ARGS(l) moe_table(b, lq, lds, tid); scatter_phase(b, lq, lds, bid, G, tid, gw, NGW, lane); GRID_BAR(); }
        if (IN(9)) { PH_IDS PH_ARGS(l) moe_table(b, lq, lds, tid); pg8::Gemm g{PB, (const bf16*)(wl + WL_GU), 1024, 1024, 1024}; pg8::MoeOrder S{(const LAS int*)(lds + TST_OFF), 1, G, bid};
            pg8::EpiUp E{rowinfo, (bf16*)(b.ws + WS_BIG + BIG_H)}; pg8::gemm_phase(lds, g, S, E, tid); GRID_BAR(); }
        if (IN(10)) { PH_IDS PH_ARGS(l) moe_table(b, lq, lds, tid); pg8::Gemm g{(const bf16*)(b.ws + WS_BIG + BIG_H), (const bf16*)(wl + WL_DN), 256, 256, 256}; pg8::MoeOrder S{(const LAS int*)(lds + TST_OFF), 2, G, bid};
            pg8::EpiDown E{rowinfo, PB}; pg8::gemm_phase(lds, g, S, E, tid); GRID_BAR(); }
        if (IN(11)) { PH_IDS PH_ARGS(l) ln2_phase(b, lq, gw, NGW, lane); if (l + 1 < a.l_hi) GRID_BAR(); }
    }
#undef IN
#undef GRID_BAR
}

extern "C" void kernel_launch(void* const* d_in, const int* in_sizes, int n_in, void* d_out, int out_size, void* d_ws, size_t ws_size, hipStream_t stream) {
    static int grid = 0;
    if (grid == 0) {
        if (n_in != 30 || out_size != NTOK * DM || ws_size < WS_END + 2 * MiB) { fprintf(stderr, "kernel_launch: unexpected shapes (n_in %d out %d ws %zu)\n", n_in, out_size, ws_size); grid = -1; return; }
        int dev = 0, cus = 0, per_cu = 0;
        if (hipGetDevice(&dev) != hipSuccess || hipDeviceGetAttribute(&cus, hipDeviceAttributeMultiprocessorCount, dev) != hipSuccess) { grid = -1; return; }
        if (hipFuncSetAttribute((const void*)fwd, hipFuncAttributeMaxDynamicSharedMemorySize, LDS_BYTES) != hipSuccess) { fprintf(stderr, "kernel_launch: hipFuncSetAttribute failed\n"); grid = -1; return; }
        if (hipOccupancyMaxActiveBlocksPerMultiprocessor(&per_cu, (const void*)fwd, NTHR, LDS_BYTES) != hipSuccess || per_cu < 1) fprintf(stderr, "kernel_launch: occupancy query says %d\n", per_cu);
        (void)hipGetLastError();
        grid = cus;
    }
    if (grid < 0) return;
    (void)hipMemsetAsync((char*)d_ws + WS_CTL, 0, CTL_ZERO_BYTES, stream);
    Args a{};
    for (int i = 0; i < 30; ++i) a.in[i] = (const float*)d_in[i];
    a.out = (float*)d_out; a.ws = (unsigned char*)d_ws; a.pad = 0;
#if MK_MULTI
    a.use_bar = 0;
    for (int l = 0; l < NLAYER; ++l)
        for (int ph = (l == 0 ? 0 : 1); ph < NPHASE; ++ph) { a.l_lo = l; a.l_hi = l + 1; a.ph_lo = ph; a.ph_hi = ph + 1;
            hipLaunchKernelGGL(fwd, dim3(grid), dim3(NTHR), LDS_BYTES, stream, a); }
#else
    a.use_bar = 1; a.l_lo = 0; a.l_hi = NLAYER; a.ph_lo = 0; a.ph_hi = NPHASE;
    hipLaunchKernelGGL(fwd, dim3(grid), dim3(NTHR), LDS_BYTES, stream, a);
#endif
    const hipError_t le = hipPeekAtLastError();
    if (le != hipSuccess) fprintf(stderr, "kernel_launch: launch failed: %s\n", hipGetErrorName(le));
}
```

```cpp
#include <hip/hip_runtime.h>
#include <cstdio>
#include <cstdint>

#define LAS __attribute__((address_space(3)))
#define GAS __attribute__((address_space(1)))
typedef unsigned short bf16;
typedef short bf16x8 __attribute__((ext_vector_type(8)));
typedef float f32x4 __attribute__((ext_vector_type(4)));
typedef float f32x2 __attribute__((ext_vector_type(2)));
typedef unsigned u32x4 __attribute__((ext_vector_type(4)));
typedef unsigned u32x2 __attribute__((ext_vector_type(2)));

namespace pg8 {
constexpr int BM = 256, BK = 64, HALF = 128, HTB = HALF * BK * 2  , STAGE_BYTES = 8 * HTB, NXCD = 8, WGM = 8;

__host__ __device__ __forceinline__ int lds_byte(int r, int c) { const int st = (r >> 4) * 2 + (c >> 5), rr = r & 15, cc = c & 31, ob = rr * 64 + cc * 2; return st * 1024 + (ob ^ (((ob >> 9) & 1) << 5)); }
__host__ __device__ __forceinline__ void stage_rc(int b, int& R, int& C) { const int st = b / 1024, sb = b % 1024, swz = sb ^ (((sb >> 9) & 1) << 5); R = (st >> 1) * 16 + swz / 64; C = (st & 1) * 32 + (swz % 64) / 2; }
__host__ __device__ __forceinline__ int perm32(int rho) { const int n = rho >> 4, i = rho & 15; return 8 * (i >> 2) + 4 * n + (i & 3); }

struct Unit { int pm, pn, pb; unsigned aoff; };
struct Gemm { const bf16* A; const bf16* Bt; int lda, ldb, K; };

struct GridOrder {
    int nM, nN, nwg, G, c, a_grp, a_grp_bytes;
    __device__ void init(int nM_, int nN_, int G_, int c_, int a_grp_ = 0, int a_grp_bytes_ = 0) { nM = nM_; nN = nN_; nwg = nM * nN; G = G_; c = c_; a_grp = a_grp_; a_grp_bytes = a_grp_bytes_; }
    __device__ bool next(int i, Unit& u) const {
        const long L = (long)i * G + c; if (L >= nwg) return false;
        int wgid = (int)L; { const int q = nwg / NXCD, r = nwg % NXCD, xcd = wgid % NXCD, off = wgid / NXCD; wgid = (xcd < r ? xcd * (q + 1) : r * (q + 1) + (xcd - r) * q) + off; }
        const int nig = WGM * nN, gid = wgid / nig, fm = gid * WGM, gsz = (nM - fm) < WGM ? (nM - fm) : WGM;
        u.pm = fm + ((wgid % nig) % gsz); u.pn = (wgid % nig) / gsz; u.pb = u.pn; u.aoff = a_grp ? (unsigned)((u.pn / a_grp) * a_grp_bytes) : 0u; return true;
    }
};
struct MoeOrder {
    const LAS int* tstart; int nsl, G, c;
    __device__ bool next(int i, Unit& u) const {
        const int L = i * G + c, total = tstart[32] << nsl; if (L >= total) return false;
        const int rt = L >> nsl, pn = L & ((1 << nsl) - 1); int e = 0;
        while (e < 31 && rt >= tstart[e + 1]) ++e;
        u.pm = rt; u.pn = pn; u.pb = (e << nsl) + pn; u.aoff = 0u; return true;
    }
};

__device__ __forceinline__ unsigned cvt_pk_bf16(float lo, float hi) { unsigned r; asm volatile("v_cvt_pk_bf16_f32 %0, %1, %2" : "=v"(r) : "v"(lo), "v"(hi)); return r; }

template <class Epi, class Sched, bool GATHER = false>
__device__ __forceinline__ void gemm_phase(LAS unsigned char* lds, const Gemm g, const Sched& S, const Epi& E, const int tid, const unsigned* rowtab = nullptr) {
    const int wid = __builtin_amdgcn_readfirstlane(tid >> 6), lane = tid & 63, wr = wid >> 2, wc = wid & 3, fr = lane & 15, fq = lane >> 4;
    const int K = g.K, nt = K / BK;
    unsigned voffA[2], voffB[2];
#pragma unroll
    for (int i = 0; i < 2; ++i) { int R, C; stage_rc(tid * 16 + i * 8192, R, C); const int Rb = Epi::PERM ? ((R & ~31) + perm32(R & 31)) : R;
        voffA[i] = (unsigned)(R * g.lda + C) * 2u; voffB[i] = (unsigned)(Rb * g.ldb + C) * 2u; }
    const size_t kstep = (size_t)(BK * 2);
    const size_t hstepA = (size_t)HALF * g.lda * 2, hstepB = (size_t)HALF * g.ldb * 2;
    const size_t tstepA = 2 * hstepA, tstepB = 2 * hstepB;
    const unsigned ldsw = (unsigned)wid * 1024u;
    const int aoff = lds_byte(wr * 64 + fr, fq * 8), boff = lds_byte(wc * 32 + fr, fq * 8);
#define PG8_SA(b, h) (((b) * 2 + (h)) * HTB)
#define PG8_SB(b, h) ((4 + (b) * 2 + (h)) * HTB)
#define PG8_STAGE(bufoff, gbase, voff) do { _Pragma("unroll") for (int _i = 0; _i < 2; ++_i) \
        __builtin_amdgcn_global_load_lds((const unsigned*)((const char*)(gbase) + (voff)[_i]), (LAS unsigned*)(lds + (bufoff) + ldsw + _i * 8192), 16, 0, 0); } while (0)
#define PG8_STAGE_A(bufoff, gbase, h) do { if constexpr (GATHER) { PG8_STAGE(bufoff, gbase, vgA[h]); } else { PG8_STAGE(bufoff, (gbase) + (h) * hstepA, voffA); } } while (0)
#define PG8_STAGE_AX(bufoff, gbase, h, useN) do { if constexpr (GATHER) { unsigned vs_[2] = {(useN) ? vgN[h][0] : vgA[h][0], (useN) ? vgN[h][1] : vgA[h][1]}; PG8_STAGE(bufoff, gbase, vs_); } else { PG8_STAGE(bufoff, (gbase) + (h) * hstepA, voffA); } } while (0)
#define PG8_LDA(dst, b, h) do { _Pragma("unroll") for (int m = 0; m < 4; ++m) _Pragma("unroll") for (int k = 0; k < 2; ++k) dst[m][k] = *(const LAS bf16x8*)(lds + PG8_SA(b, h) + aoff + m * 2048 + k * 1024); } while (0)
#define PG8_LDB(dst, b, h) do { _Pragma("unroll") for (int n = 0; n < 2; ++n) _Pragma("unroll") for (int k = 0; k < 2; ++k) dst[n][k] = *(const LAS bf16x8*)(lds + PG8_SB(b, h) + boff + n * 2048 + k * 1024); } while (0)
#define PG8_MMA(ai, bj, At, Bt) do { __builtin_amdgcn_s_setprio(1); _Pragma("unroll") for (int m = 0; m < 4; ++m) _Pragma("unroll") for (int n = 0; n < 2; ++n) _Pragma("unroll") for (int k = 0; k < 2; ++k) \
        acc[ai][bj][m][n] = __builtin_amdgcn_mfma_f32_16x16x32_bf16(Bt[n][k], At[m][k], acc[ai][bj][m][n], 0, 0, 0); __builtin_amdgcn_s_setprio(0); } while (0)
#define PG8_WAIT_V(n) asm volatile("s_waitcnt vmcnt(" #n ")" ::: "memory")
#define PG8_WAIT_L(n) asm volatile("s_waitcnt lgkmcnt(" #n ")" ::: "memory")
#define PG8_BAR __builtin_amdgcn_s_barrier()
#define PG8_SCHED __builtin_amdgcn_sched_barrier(0)
    Unit cur, nxt; int ui = 0;
    if (!S.next(0, cur)) return;
    unsigned vgA[2][2], vgN[2][2];
    int gR[2], gC[2];
#pragma unroll
    for (int i = 0; i < 2; ++i) stage_rc(tid * 16 + i * 8192, gR[i], gC[i]);
#define PG8_GOFF(DST, PM) do { if constexpr (GATHER) { _Pragma("unroll") for (int h_ = 0; h_ < 2; ++h_) _Pragma("unroll") for (int i_ = 0; i_ < 2; ++i_) { \
        const int ri_ = (int)rowtab[2 * ((size_t)(PM) * BM + h_ * HALF + gR[i_])]; const unsigned tok_ = ri_ < 0 ? 0u : (unsigned)ri_ >> 1; DST[h_][i_] = (tok_ * (unsigned)g.lda + (unsigned)gC[i_]) * 2u; } } } while (0)
    PG8_GOFF(vgA, cur.pm);
    f32x4 acc[2][2][4][2];
#pragma unroll
    for (int a = 0; a < 2; ++a)
#pragma unroll
        for (int b = 0; b < 2; ++b)
#pragma unroll
            for (int m = 0; m < 4; ++m)
#pragma unroll
                for (int n = 0; n < 2; ++n) acc[a][b][m][n] = (f32x4){0.f, 0.f, 0.f, 0.f};
    bf16x8 At[4][2], B0[2][2], B1[2][2];
    const char* cA = GATHER ? (const char*)g.A : (const char*)g.A + (size_t)cur.pm * tstepA + cur.aoff; const char* cB = (const char*)g.Bt + (size_t)cur.pb * tstepB;
    PG8_STAGE(PG8_SB(0, 0), cB, voffB); PG8_STAGE(PG8_SB(0, 1), cB + hstepB, voffB); PG8_STAGE_A(PG8_SA(0, 0), cA, 0); PG8_STAGE_A(PG8_SA(0, 1), cA, 1);
    if (wr == 1) PG8_BAR;
    PG8_WAIT_V(2); PG8_BAR;
    PG8_STAGE(PG8_SB(1, 0), cB + kstep, voffB); PG8_STAGE_A(PG8_SA(1, 0), cA + kstep, 0); PG8_STAGE(PG8_SB(1, 1), cB + hstepB + kstep, voffB);
    PG8_WAIT_V(6); PG8_BAR;
    for (;;) {
        const bool has_next = S.next(ui + 1, nxt);
        if (has_next) PG8_GOFF(vgN, nxt.pm); else { if constexpr (GATHER) { vgN[0][0] = vgA[0][0]; vgN[0][1] = vgA[0][1]; vgN[1][0] = vgA[1][0]; vgN[1][1] = vgA[1][1]; } }
        const char* nA = GATHER ? cA : (has_next ? (const char*)g.A + (size_t)nxt.pm * tstepA + nxt.aoff : cA); const char* nB = has_next ? (const char*)g.Bt + (size_t)nxt.pb * tstepB : cB;
        for (int t = 0; t < nt; t += 2) {
            const bool last = (t == nt - 2);
            const char* a1 = cA + (size_t)(t + 1) * kstep;
            const char* a2 = last ? nA : cA + (size_t)(t + 2) * kstep; const char* b2 = last ? nB : cB + (size_t)(t + 2) * kstep;
            const char* a3 = a2 + kstep; const char* b3 = b2 + kstep;
            PG8_LDB(B0, 0, 0); PG8_LDB(B1, 0, 1); PG8_SCHED; PG8_LDA(At, 0, 0); PG8_STAGE_AX(PG8_SA(1, 1), a1, 1, false);
            PG8_WAIT_V(8); PG8_WAIT_L(0); PG8_BAR; PG8_MMA(0, 0, At, B0); PG8_MMA(0, 1, At, B1); PG8_BAR; PG8_SCHED;
            PG8_LDA(At, 0, 1); PG8_STAGE(PG8_SB(0, 0), b2, voffB); PG8_STAGE(PG8_SB(0, 1), b2 + hstepB, voffB); PG8_STAGE_AX(PG8_SA(0, 0), a2, 0, last);
            PG8_WAIT_V(8); PG8_WAIT_L(0); PG8_BAR; PG8_MMA(1, 0, At, B0); PG8_MMA(1, 1, At, B1); PG8_BAR; PG8_SCHED;
            PG8_LDB(B0, 1, 0); PG8_LDB(B1, 1, 1); PG8_SCHED; PG8_LDA(At, 1, 0); PG8_STAGE_AX(PG8_SA(0, 1), a2, 1, last);
            PG8_WAIT_V(8); PG8_WAIT_L(0); PG8_BAR; PG8_MMA(0, 0, At, B0); PG8_MMA(0, 1, At, B1); PG8_BAR; PG8_SCHED;
            PG8_LDA(At, 1, 1); PG8_STAGE(PG8_SB(1, 0), b3, voffB); PG8_STAGE(PG8_SB(1, 1), b3 + hstepB, voffB); PG8_STAGE_AX(PG8_SA(1, 0), a3, 0, last);
            PG8_WAIT_V(8); PG8_WAIT_L(0); PG8_BAR; PG8_MMA(1, 0, At, B0); PG8_MMA(1, 1, At, B1); PG8_BAR; PG8_SCHED;
        }
        if (wr == 0) PG8_BAR;
        { unsigned on_ = ~0u; asm volatile("" : "+s"(on_)); const int lz_ = (int)__builtin_amdgcn_mbcnt_hi(on_, __builtin_amdgcn_mbcnt_lo(on_, 0u));
          E(acc, cur, wr, wc, lz_ & 15, lz_ >> 4); }
        if (!has_next) break;
#pragma unroll
        for (int a = 0; a < 2; ++a)
#pragma unroll
            for (int b = 0; b < 2; ++b)
#pragma unroll
                for (int m = 0; m < 4; ++m)
#pragma unroll
                    for (int n = 0; n < 2; ++n) acc[a][b][m][n] = (f32x4){0.f, 0.f, 0.f, 0.f};
        cur = nxt; cA = nA; cB = nB; ++ui;
        if constexpr (GATHER) { vgA[0][0] = vgN[0][0]; vgA[0][1] = vgN[0][1]; vgA[1][0] = vgN[1][0]; vgA[1][1] = vgN[1][1]; }
        if (wr == 1) PG8_BAR;
    }
    PG8_WAIT_V(0);
    PG8_BAR;
#undef PG8_SA
#undef PG8_STAGE_A
#undef PG8_STAGE_AX
#undef PG8_GOFF
#undef PG8_SB
#undef PG8_STAGE
#undef PG8_LDA
#undef PG8_LDB
#undef PG8_MMA
#undef PG8_WAIT_V
#undef PG8_WAIT_L
#undef PG8_BAR
#undef PG8_SCHED
}
}

constexpr int NTOK = 65536, DM = 1024, SEQ = 2048, NBATCH = 32, NLAYER = 4;
constexpr int PW = 3072;
constexpr int PC_AQ = 0, PC_AK = 256, PC_AV = 512, PC_BQ = 768, PC_CKV = 1024, PC_IQ = 1088, PC_IK = 1344, PC_IW = 1376,
              PC_CQ = 1384, PC_CK = 1512, PC_CV = 1640, PC_CA = 1896, PC_CG = 1912, PC_D = 2168;
constexpr int IN_W = 7096;
constexpr float LN_EPS = 1e-5f;
constexpr float DN_ALPHA = 1.6817928305074292f;
constexpr int NWAVES = 8, NTHR = 512;
constexpr int MOE_ROWS = 2 * NTOK + 32 * 256;

constexpr size_t MiB = 1u << 20;
constexpr size_t WS_CTL = 0, CTL_ZERO_BYTES = 1 * MiB;
constexpr size_t WS_TOK = 1 * MiB;
constexpr size_t WS_ROW = 3 * MiB;
constexpr size_t WS_BON = 5 * MiB;
constexpr size_t WS_RT = 6 * MiB;
constexpr size_t WS_CKVN = 8 * MiB;
constexpr size_t WS_CA = 16 * MiB;
constexpr size_t WS_W = 48 * MiB;
constexpr size_t WL_IN = 0, WL_BR = 14 * MiB, WL_OUT = 16 * MiB, WL_GU = 18 * MiB, WL_DN = 50 * MiB, WL_SIZE = 66 * MiB;
constexpr size_t WS_XB = 312 * MiB;
constexpr size_t WS_BIG = 440 * MiB;
constexpr size_t BIG_DW = 384 * MiB, BIG_DAI = 448 * MiB, BIG_DG = 480 * MiB;
constexpr size_t BIG_H = 272 * MiB;
constexpr size_t WS_END = 952 * MiB;
constexpr size_t DO_YS = 0, DO_MG = 128 * MiB, DO_DR = 128 * MiB, DO_DKP = 160 * MiB, DO_DV = 192 * MiB, DO_DKK = 224 * MiB;

constexpr int CW_TMO = 0, CW_CODE = 1;
constexpr int CW_BAR = 4096;
constexpr int CW_Q = 8192;
constexpr int CW_CNT = 16384;

constexpr int RING_BYTES = 131072;
constexpr int MISC_OFF = RING_BYTES;
constexpr int TST_OFF = MISC_OFF + 512;
constexpr int BKT_OFF = MISC_OFF + 1024;
constexpr int RPB_OFF = MISC_OFF + 3072;
constexpr int LDS_BYTES = 147456;

#define LDS_WAIT() asm volatile("s_waitcnt lgkmcnt(0)" ::: "memory")
#define VM_WAIT() asm volatile("s_waitcnt vmcnt(0)" ::: "memory")
__device__ __forceinline__ float bf2f(unsigned b) { return __uint_as_float(b << 16); }
__device__ __forceinline__ unsigned f2bf(float f) { unsigned u = __float_as_uint(f); return (u + 0x7fffu + ((u >> 16) & 1u)) >> 16; }
__device__ __forceinline__ unsigned pk2(float lo, float hi) { return f2bf(lo) | (f2bf(hi) << 16); }
__device__ __forceinline__ float bflo(unsigned w) { return __uint_as_float(w << 16); }
__device__ __forceinline__ float bfhi(unsigned w) { return __uint_as_float(w & 0xffff0000u); }
template <int CTRL> __device__ __forceinline__ float dppf(float v) {
    return __builtin_bit_cast(float, __builtin_amdgcn_update_dpp(0, __builtin_bit_cast(int, v), CTRL, 0xf, 0xf, true));
}
__device__ __forceinline__ float wave_sum(float v) {
    v += dppf<0x128>(v); v += dppf<0x124>(v); v += dppf<0x122>(v); v += dppf<0x121>(v);
    v += __shfl_xor(v, 16); v += __shfl_xor(v, 32); return v;
}
__device__ __forceinline__ float wave_max(float v) {
#pragma unroll
    for (int o = 1; o < 64; o <<= 1) v = fmaxf(v, __shfl_xor(v, o));
    return v;
}
__device__ __forceinline__ float sum8(float v) { v += dppf<0xB1>(v); v += dppf<0x4E>(v); v += dppf<0x141>(v); return v; }
__device__ __forceinline__ float sigmoidf_(float x) { return __builtin_amdgcn_rcpf(1.f + __expf(-x)); }
__device__ __forceinline__ float log_sigmoidf_(float z) { return fminf(z, 0.f) - __logf(1.f + __expf(-fabsf(z))); }

#define XB_TMO      128
#define XB_XCNT(j)  (256  + 64 * (j))
#define XB_XSUB(j)  (1280 + 64 * (j))
#define XB_XGEN(j)  (2304 + 64 * (j))
#define XB_TOP      3328
#define XB_TOPGEN   3392
#define XCD_BAR_WORDS 3456
#define XB_SPIN_CAP (1u << 22)

__device__ __forceinline__ unsigned xb_ld(unsigned* p)              { return __hip_atomic_load(p, __ATOMIC_RELAXED, __HIP_MEMORY_SCOPE_AGENT); }
__device__ __forceinline__ unsigned xb_add(unsigned* p, unsigned v) { return __hip_atomic_fetch_add(p, v, __ATOMIC_RELAXED, __HIP_MEMORY_SCOPE_AGENT); }
__device__ __forceinline__ unsigned xb_xcc_id() { return (unsigned)__builtin_amdgcn_s_getreg((3 << 11) | 20) & 0xFu; }
#define XB_SPIN(cond, bar) do { unsigned _sp = 0; while (cond) { __builtin_amdgcn_s_sleep(1); \
    if ((++_sp & 255u) == 0u) { if (xb_ld(&(bar)[XB_TMO])) break; if (_sp > XB_SPIN_CAP) { atomicAdd(&(bar)[XB_TMO], 1u); break; } } } } while (0)

struct XcdBarrier { unsigned* bar; unsigned x; volatile LAS unsigned* st; };

__device__ __forceinline__ XcdBarrier xcd_barrier_post(unsigned* bar, volatile LAS unsigned* st) {
    XcdBarrier b; b.bar = bar; b.x = xb_xcc_id(); b.st = st;
    if (threadIdx.x == 0) (void)xb_add(&bar[XB_XCNT(b.x)], 1u);
    return b;
}
__device__ __forceinline__ void xcd_barrier_complete(unsigned* bar, unsigned x, unsigned& nloc, unsigned& nx) {
    const unsigned G = gridDim.x * gridDim.y * gridDim.z;
    unsigned sum, cnt, mine, sp = 0u;
    for (;;) {
        sum = 0u; cnt = 0u; mine = 0u;
#pragma unroll
        for (unsigned j = 0; j < 16; ++j) { const unsigned c = xb_ld(&bar[XB_XCNT(j)]); sum += c; cnt += (c > 0u) ? 1u : 0u; mine = (j == x) ? c : mine; }
        if (sum == G) break;
        __builtin_amdgcn_s_sleep(1);
        if ((++sp & 255u) == 0u) { if (xb_ld(&bar[XB_TMO])) break; if (sp > XB_SPIN_CAP) { atomicAdd(&bar[XB_TMO], 1u); break; } }
    }
    nloc = mine > 0u ? mine : 1u; nx = cnt > 0u ? cnt : 1u;
}
__device__ __forceinline__ void xcd_barrier(const XcdBarrier& b) {
    asm volatile("s_waitcnt vmcnt(0)" ::: "memory");
    __syncthreads();
    if (threadIdx.x == 0) {
        unsigned* bar = b.bar;
        __builtin_amdgcn_s_waitcnt(0);
        unsigned nloc = b.st[0], nx = b.st[1];
        if (nloc == 0u) { xcd_barrier_complete(bar, b.x, nloc, nx); b.st[0] = nloc; b.st[1] = nx; }
        const unsigned old = xb_add(&bar[XB_XSUB(b.x)], 1u);
        const unsigned gen = old / nloc;
        if (old + 1u == (gen + 1u) * nloc) {
            __builtin_amdgcn_fence(__ATOMIC_RELEASE, "agent");
            asm volatile("s_waitcnt vmcnt(0)" ::: "memory");
            const unsigned og = xb_add(&bar[XB_TOP], 1u);
            const unsigned tg = og / nx;
            if (og + 1u == (tg + 1u) * nx) xb_add(&bar[XB_TOPGEN], 1u);
            else XB_SPIN(xb_ld(&bar[XB_TOPGEN]) == tg, bar);
            __builtin_amdgcn_fence(__ATOMIC_ACQUIRE, "agent");
            xb_add(&bar[XB_XGEN(b.x)], 1u);
            asm volatile("s_waitcnt vmcnt(0)" ::: "memory");
        } else {
            XB_SPIN(xb_ld(&bar[XB_XGEN(b.x)]) == gen, bar);
            __builtin_amdgcn_fence(__ATOMIC_ACQUIRE, "agent");
            asm volatile("s_waitcnt vmcnt(0)" ::: "memory");
        }
    }
    __syncthreads();
}

__device__ __forceinline__ int t5_bucket(int d) {
    if (d < 16) return d;
    int b = 16;
    b += (d >= 22) + (d >= 30) + (d >= 40) + (d >= 54) + (d >= 73) + (d >= 99) + (d >= 134) + (d >= 182) + (d >= 246) + (d >= 332) + (d >= 450) + (d >= 609) + (d >= 825) + (d >= 1117) + (d >= 1513);
    return b;
}
struct Args { const float* in[30]; float* out; unsigned char* ws; int l_lo, l_hi, ph_lo, ph_hi, use_bar, pad; };

namespace pg8 {
struct EpiStoreBf16 {
    static constexpr bool PERM = true;
    bf16* O; int ldc;
    __device__ __forceinline__ void operator()(const f32x4 (&acc)[2][2][4][2], const Unit& u, int wr, int wc, int fr, int fq) const {
        const int row0 = u.pm * BM + wr * 64 + fr, col0 = u.pn * BM + wc * 32 + 8 * fq;
#pragma unroll
        for (int ai = 0; ai < 2; ++ai)
#pragma unroll
            for (int m = 0; m < 4; ++m) { bf16* rowp = O + (size_t)(row0 + ai * HALF + m * 16) * ldc + col0;
#pragma unroll
                for (int bj = 0; bj < 2; ++bj) { const f32x4 v0 = acc[ai][bj][m][0], v1 = acc[ai][bj][m][1];
                    u32x4 w; w.x = cvt_pk_bf16(v0[0], v0[1]); w.y = cvt_pk_bf16(v0[2], v0[3]); w.z = cvt_pk_bf16(v1[0], v1[1]); w.w = cvt_pk_bf16(v1[2], v1[3]);
                    *(u32x4*)(rowp + bj * HALF) = w; } }
    }
};
struct EpiGate {
    static constexpr bool PERM = false;
    const bf16* BR; bf16* MG;
    __device__ __forceinline__ void operator()(const f32x4 (&acc)[2][2][4][2], const Unit& u, int wr, int wc, int fr, int fq) const {
        const int row0 = u.pm * BM + wr * 64 + fr, j0 = u.pn * 64 + wc * 16 + 4 * fq;
#pragma unroll
        for (int ai = 0; ai < 2; ++ai)
#pragma unroll
            for (int m = 0; m < 4; ++m) { const size_t r = (size_t)(row0 + ai * HALF + m * 16);
                float mg0 = 0.f, mg1 = 0.f, mg2 = 0.f, mg3 = 0.f;
#pragma unroll
                for (int bj = 0; bj < 2; ++bj)
#pragma unroll
                    for (int n = 0; n < 2; ++n) { const int g = 2 * bj + n; const u32x2 b = *(const u32x2*)(BR + r * 4096 + g * 1024 + j0); const f32x4 a = acc[ai][bj][m][n];
                        mg0 += sigmoidf_(a[0]) * bflo(b.x); mg1 += sigmoidf_(a[1]) * bfhi(b.x); mg2 += sigmoidf_(a[2]) * bflo(b.y); mg3 += sigmoidf_(a[3]) * bfhi(b.y); }
                u32x2 w; w.x = cvt_pk_bf16(mg0, mg1); w.y = cvt_pk_bf16(mg2, mg3);
                *(u32x2*)(MG + r * 1024 + j0) = w; }
    }
};
struct EpiOut {
    static constexpr bool PERM = true;
    bf16* XB;
    __device__ __forceinline__ void operator()(const f32x4 (&acc)[2][2][4][2], const Unit& u, int wr, int wc, int fr, int fq) const {
        const int row0 = u.pm * BM + wr * 64 + fr, col0 = u.pn * BM + wc * 32 + 8 * fq;
#pragma unroll
        for (int ai = 0; ai < 2; ++ai)
#pragma unroll
            for (int m = 0; m < 4; ++m) { bf16* rowp = XB + (size_t)(row0 + ai * HALF + m * 16) * 1024 + col0;
#pragma unroll
                for (int bj = 0; bj < 2; ++bj) { const f32x4 v0 = acc[ai][bj][m][0], v1 = acc[ai][bj][m][1]; const u32x4 x = *(const u32x4*)(rowp + bj * HALF);
                    u32x4 w; w.x = cvt_pk_bf16(DN_ALPHA * bflo(x.x) + v0[0], DN_ALPHA * bfhi(x.x) + v0[1]); w.y = cvt_pk_bf16(DN_ALPHA * bflo(x.y) + v0[2], DN_ALPHA * bfhi(x.y) + v0[3]);
                    w.z = cvt_pk_bf16(DN_ALPHA * bflo(x.z) + v1[0], DN_ALPHA * bfhi(x.z) + v1[1]); w.w = cvt_pk_bf16(DN_ALPHA * bflo(x.w) + v1[2], DN_ALPHA * bfhi(x.w) + v1[3]);
                    *(u32x4*)(rowp + bj * HALF) = w; } }
    }
};
struct EpiUp {
    static constexpr bool PERM = true;
    const unsigned* rowinfo; bf16* H;
    __device__ __forceinline__ void operator()(const f32x4 (&acc)[2][2][4][2], const Unit& u, int wr, int wc, int fr, int fq) const {
        const int row0 = u.pm * BM + wr * 64 + fr, col0 = u.pn * 128 + wc * 32 + 8 * fq;
#pragma unroll
        for (int ai = 0; ai < 2; ++ai)
#pragma unroll
            for (int m = 0; m < 4; ++m) { const size_t r = (size_t)(row0 + ai * HALF + m * 16); const float w = __uint_as_float(rowinfo[2 * r + 1]);
                const f32x4 g0 = acc[ai][0][m][0], g1 = acc[ai][0][m][1], u0 = acc[ai][1][m][0], u1 = acc[ai][1][m][1];
                float h[8];
#pragma unroll
                for (int e = 0; e < 4; ++e) { h[e] = g0[e] * sigmoidf_(g0[e]) * u0[e] * w; h[4 + e] = g1[e] * sigmoidf_(g1[e]) * u1[e] * w; }
                u32x4 o; o.x = cvt_pk_bf16(h[0], h[1]); o.y = cvt_pk_bf16(h[2], h[3]); o.z = cvt_pk_bf16(h[4], h[5]); o.w = cvt_pk_bf16(h[6], h[7]);
                *(u32x4*)(H + r * 256 + col0) = o; }
    }
};
struct EpiDown {
    static constexpr bool PERM = true;
    const unsigned* rowinfo; bf16* Y;
    __device__ __forceinline__ void operator()(const f32x4 (&acc)[2][2][4][2], const Unit& u, int wr, int wc, int fr, int fq) const {
        const int row0 = u.pm * BM + wr * 64 + fr, col0 = u.pn * BM + wc * 32 + 8 * fq;
#pragma unroll
        for (int ai = 0; ai < 2; ++ai)
#pragma unroll
            for (int m = 0; m < 4; ++m) { const size_t r = (size_t)(row0 + ai * HALF + m * 16); const int ri = (int)rowinfo[2 * r];
                if (ri >= 0) { bf16* rowp = Y + ((size_t)(ri & 1) * NTOK + (size_t)(ri >> 1)) * 1024 + col0;
#pragma unroll
                    for (int bj = 0; bj < 2; ++bj) { const f32x4 v0 = acc[ai][bj][m][0], v1 = acc[ai][bj][m][1];
                        u32x4 w; w.x = cvt_pk_bf16(v0[0], v0[1]); w.y = cvt_pk_bf16(v0[2], v0[3]); w.z = cvt_pk_bf16(v1[0], v1[1]); w.w = cvt_pk_bf16(v1[2], v1[3]);
                        *(u32x4*)(rowp + bj * HALF) = w; } } }
    }
};
}

struct RowMap { int kind, base, g, off;
    __device__ __forceinline__ int operator()(int n) const {
        if (kind == 0) return base + n;
        if (kind == 1) { const int j = base + n, jj = j & 63, pn = j >> 6; return 3072 + pn * 256 + 128 * (g >> 1) + 32 * (jj >> 4) + 16 * (g & 1) + 4 * ((jj >> 2) & 3) + (jj & 3); }
        const int h = base + n; return (h >> 7) * 256 + off + (h & 127);
    }
};
__device__ __forceinline__ void transpose_item(const float* W, int ldw, int k0, int scol0, int nvalid, bf16* WT, int ldk, const RowMap& rm, LAS float* scr, int lane) {
    const int nn = lane & 31;
#pragma unroll 8
    for (int i = 0; i < 32; ++i) { const int kk = 2 * i + (lane >> 5); scr[kk * 33 + nn] = (nn < nvalid) ? W[(size_t)(k0 + kk) * ldw + scol0 + nn] : 0.f; }
    LDS_WAIT(); asm volatile("" ::: "memory");
    const int c = lane & 7;
#pragma unroll
    for (int j = 0; j < 4; ++j) { const int n = (lane >> 3) + 8 * j; const LAS float* s = scr + (8 * c) * 33 + n;
        u32x4 o; o.x = pk2(s[0 * 33], s[1 * 33]); o.y = pk2(s[2 * 33], s[3 * 33]); o.z = pk2(s[4 * 33], s[5 * 33]); o.w = pk2(s[6 * 33], s[7 * 33]);
        *(u32x4*)(WT + (size_t)rm(n) * ldk + k0 + 8 * c) = o; }
    LDS_WAIT(); asm volatile("" ::: "memory");
}
__device__ __forceinline__ void p0_prologue(const Args& a, LAS unsigned char* lds, int gw, int NGW, int wave, int lane) {
    LAS float* scr = (LAS float*)(lds + wave * 16384);
    constexpr int IPL = 16896;
    for (int it = gw; it < NLAYER * IPL; it += NGW) {
        const int l = it / IPL; int r = it - l * IPL;
        unsigned char* wl = a.ws + WS_W + (size_t)l * WL_SIZE;
        RowMap rm; rm.kind = 0; rm.base = 0; rm.g = 0; rm.off = 0;
        if (r < 1536) { const int nt = r % 96, kt = r / 96, n0 = 32 * nt; int nv = 3000 - n0; nv = nv < 0 ? 0 : (nv > 32 ? 32 : nv); rm.base = n0;
            transpose_item(a.in[2] + (size_t)l * 1024 * IN_W, IN_W, 64 * kt, n0, nv, (bf16*)(wl + WL_IN), 1024, rm, scr, lane); continue; }
        r -= 1536;
        if (r < 2048) { const int nt = r % 128, kt = r / 128, gc0 = 32 * nt; rm.kind = 1; rm.g = gc0 >> 10; rm.base = gc0 & 1023;
            transpose_item(a.in[2] + (size_t)l * 1024 * IN_W, IN_W, 64 * kt, 3000 + gc0, 32, (bf16*)(wl + WL_IN), 1024, rm, scr, lane); continue; }
        r -= 2048;
        if (r < 512) { const int nb = r / 128, rr = r % 128, nt = rr % 32, kt = rr / 32; rm.base = nb * 1024 + 32 * nt;
            if (nb != 1) transpose_item(a.in[19] + (size_t)(l * 4 + nb) * 256 * 1024, 1024, 64 * kt, 32 * nt, 32, (bf16*)(wl + WL_BR), 256, rm, scr, lane); continue; }
        r -= 512;
        if (r < 512) { const int nt = r % 32, kt = r / 32; rm.base = 32 * nt;
            transpose_item(a.in[20] + (size_t)l * 1024 * 1024, 1024, 64 * kt, 32 * nt, 32, (bf16*)(wl + WL_OUT), 1024, rm, scr, lane); continue; }
        r -= 512;
        if (r < 8192) { const int up = r >= 4096; if (up) r -= 4096; const int e = r / 128, rr = r % 128, nt = rr % 8, kt = rr / 8; rm.kind = 2; rm.base = 32 * nt; rm.off = up ? 128 : 0;
            transpose_item(a.in[up ? 28 : 27] + (size_t)(l * 32 + e) * 1024 * 256, 256, 64 * kt, 32 * nt, 32, (bf16*)(wl + WL_GU) + (size_t)e * 512 * 1024, 1024, rm, scr, lane); continue; }
        r -= 8192;
        { const int e = r / 128, rr = r % 128, nt = rr % 32, kt = rr / 32; rm.base = 32 * nt;
            transpose_item(a.in[29] + (size_t)(l * 32 + e) * 256 * 1024, 1024, 64 * kt, 32 * nt, 32, (bf16*)(wl + WL_DN) + (size_t)e * 1024 * 256, 256, rm, scr, lane); }
    }
    { float* WRT = (float*)(a.ws + WS_RT); const int gt = gw * 64 + lane, NT = NGW * 64;
      for (int i = gt; i < NLAYER * 4 * 64 * 1024; i += NT) { const int j = i & 1023, c = (i >> 10) & 63, h = (i >> 16) & 3, l = i >> 18;
          const float* wu = a.in[4] + ((size_t)(l * 4 + h) * 64 + c) * 64; const float* wb = a.in[19] + ((size_t)(l * 4 + 1) * 256 + h * 64) * 1024 + j; float acc = 0.f;
#pragma unroll 8
          for (int d = 0; d < 64; ++d) acc += wu[d] * wb[(size_t)d * 1024];
          ((bf16*)(a.ws + WS_W + (size_t)l * WL_SIZE + WL_BR))[(size_t)(1024 + j) * 256 + h * 64 + c] = (bf16)f2bf(acc); }
      for (int i = gt; i < NLAYER * 36 * 1024; i += NT) { const int k = i & 1023, e = (i >> 10) % 36, l = i / (36 * 1024);
          WRT[i] = e < 4 ? a.in[23][((size_t)l * 1024 + k) * 4 + e] : a.in[25][((size_t)l * 1024 + k) * 32 + (e - 4)]; }
      const f32x4* xs = (const f32x4*)a.in[0]; u32x4* xd = (u32x4*)(a.ws + WS_XB);
      for (int i = gt; i < NTOK * DM / 8; i += NT) { const f32x4 v0 = xs[2 * i], v1 = xs[2 * i + 1]; u32x4 o; o.x = pk2(v0[0], v0[1]); o.y = pk2(v0[2], v0[3]); o.z = pk2(v1[0], v1[1]); o.w = pk2(v1[2], v1[3]); xd[i] = o; } }
}

__device__ __forceinline__ float softplusf_(float x) { return fmaxf(x, 0.f) + __logf(1.f + __expf(-fabsf(x))); }
__device__ __forceinline__ float tanhf_(float x) { const float e = __expf(-2.f * fabsf(x)); const float t = (1.f - e) * __builtin_amdgcn_rcpf(1.f + e); return x < 0.f ? -t : t; }
__device__ __forceinline__ void prep_phase(const Args& a, int l, LAS unsigned char* lds, int tid, int gw, int NGW, int lane, const int pmode = 7) {
    const int wave = __builtin_amdgcn_readfirstlane(tid >> 6);
    const bf16* P = (const bf16*)(a.ws + WS_BIG);
    bf16* CKVN = (bf16*)(a.ws + WS_CKVN); bf16* CQH = (bf16*)(a.ws + WS_CA); bf16* CKT = (bf16*)(a.ws + WS_CA + 16 * MiB); float* CCL = (float*)(a.ws + WS_END); float* BON = (float*)(a.ws + WS_BON);
    bf16* DR = (bf16*)((unsigned char*)a.out + DO_DR); bf16* DKP = (bf16*)((unsigned char*)a.out + DO_DKP); bf16* DV = (bf16*)((unsigned char*)a.out + DO_DV); bf16* DKK = (bf16*)((unsigned char*)a.out + DO_DKK);
    float* DW = (float*)(a.ws + WS_BIG + BIG_DW); bf16* DAI = (bf16*)(a.ws + WS_BIG + BIG_DAI); bf16* DG = (bf16*)(a.ws + WS_BIG + BIG_DG);
    const float* kvg = a.in[3] + l * 64; const float* aup = a.in[5] + l * 16 * 128; const float* abias = a.in[6] + l * 128;
    const float* mu = a.in[8] + l * 832; const float* w0 = a.in[9] + l * 256; const float* w2 = a.in[10] + l * 16 * 256; const float* a0 = a.in[11] + l * 256;
    const float* a2 = a.in[12] + l * 16 * 256; const float* g2 = a.in[13] + l * 32 * 256; const float* kkw = a.in[14] + l * 256; const float* kaw = a.in[15] + l * 256; const float* rkw = a.in[16] + l * 256;
    LAS float* sW2 = (LAS float*)lds; LAS float* sA2 = (LAS float*)(lds + 16384); LAS float* sG2 = (LAS float*)(lds + 32768); LAS float* sUP = (LAS float*)(lds + 65536);
    for (int i = tid; i < 4096; i += NTHR) { sW2[i] = w2[i]; sA2[i] = a2[i]; }
    for (int i = tid; i < 8192; i += NTHR) sG2[i] = g2[i];
    for (int i = tid; i < 2048; i += NTHR) sUP[i] = aup[i];
    __syncthreads();
    float mu_r[13], w0_r[4], a0_r[4], kk_r[4], ka_r[4], rk_r[4];
#pragma unroll
    for (int i = 0; i < 13; ++i) mu_r[i] = mu[64 * i + lane];
#pragma unroll
    for (int i = 0; i < 4; ++i) { const int c = 64 * i + lane; w0_r[i] = w0[c]; a0_r[i] = a0[c]; kk_r[i] = kkw[c]; ka_r[i] = kaw[c]; rk_r[i] = rkw[c]; }
    const float kvg_r = kvg[lane], ab0 = abias[lane], ab1 = abias[64 + lane];
    unsigned short nc[13], np_[13], nckv, nca, nq0, nq1, nk0, nk1;
#define PREP_LOAD(mm) do { const bf16* pr_ = P + (size_t)(mm) * PW; \
        _Pragma("unroll") for (int i = 0; i < 13; ++i) nc[i] = pr_[PC_D + 64 * i + lane]; nckv = pr_[PC_CKV + lane]; nca = pr_[PC_CA + (lane & 15)]; nq0 = pr_[PC_CQ + lane]; nq1 = pr_[PC_CQ + 64 + lane]; nk0 = pr_[PC_CK + lane]; nk1 = pr_[PC_CK + 64 + lane]; } while (0)
    constexpr int NCK = NTOK / 16;
    float* DCL = DW;
#define PREP_LOADP(mm) do { const int tt_ = (mm) & (SEQ - 1); const bf16* pp_ = P + (size_t)(mm) * PW - (tt_ > 0 ? PW : 0); _Pragma("unroll") for (int i = 0; i < 13; ++i) np_[i] = pp_[PC_D + 64 * i + lane]; } while (0)
    if (gw < NCK) { PREP_LOAD(gw * 16); PREP_LOADP(gw * 16); }
    for (int ck = gw; ck < NCK; ck += NGW) {
      float cpr[4] = {1.f, 1.f, 1.f, 1.f}; float cprc0 = 1.f, cprc1 = 1.f;
#pragma unroll 1
      for (int tt = 0; tt < 16; ++tt) {
        const int m = ck * 16 + tt;
        const int t = m & (SEQ - 1);
        unsigned short cc_[13], cp_[13];
#pragma unroll
        for (int i = 0; i < 13; ++i) { cc_[i] = nc[i]; cp_[i] = np_[i]; np_[i] = nc[i]; }
        const unsigned short cckv = nckv, cca = nca, cq0 = nq0, cq1 = nq1, ck0 = nk0, ck1 = nk1;
        if (tt < 15) PREP_LOAD(m + 1); else if (ck + NGW < NCK) { PREP_LOAD((ck + NGW) * 16); PREP_LOADP((ck + NGW) * 16); }
        { const float x = bf2f(cckv); const float ss = wave_sum(x * x); const float rn = rsqrtf(ss * (1.f / 64.f) + 1e-6f); CKVN[(size_t)m * 64 + lane] = (bf16)f2bf(x * rn * kvg_r); }
        { const float cav = (lane < 16) ? bf2f(cca) : 0.f; float z0 = ab0, z1 = ab1;
#pragma unroll
          for (int i = 0; i < 16; ++i) { const float cv = __shfl(cav, i); z0 += cv * sUP[i * 128 + lane]; z1 += cv * sUP[i * 128 + 64 + lane]; }
          cprc0 *= __expf(log_sigmoidf_(z0) * (1.f / 16.f)); cprc1 *= __expf(log_sigmoidf_(z1) * (1.f / 16.f));
          CQH[(size_t)m * 128 + lane] = (bf16)f2bf(bf2f(cq0) * cprc0); CQH[(size_t)m * 128 + 64 + lane] = (bf16)f2bf(bf2f(cq1) * cprc1);
          CKT[(size_t)m * 128 + lane] = (bf16)f2bf(bf2f(ck0) * __builtin_amdgcn_rcpf(cprc0)); CKT[(size_t)m * 128 + 64 + lane] = (bf16)f2bf(bf2f(ck1) * __builtin_amdgcn_rcpf(cprc1));
          if (tt == 15) { CCL[(size_t)ck * 128 + lane] = cprc0; CCL[(size_t)ck * 128 + 64 + lane] = cprc1; } }
        float xs[13];
#pragma unroll
        for (int i = 0; i < 13; ++i) { const float cur = bf2f(cc_[i]); const float prev = (t > 0) ? bf2f(cp_[i]) : 0.f; xs[i] = cur + (prev - cur) * mu_r[i]; }
        const float low = xs[12], tw = tanhf_(low), sg = sigmoidf_(low);
        float wr_[4], ar_[4], gv_[4];
#pragma unroll
        for (int i = 0; i < 4; ++i) { wr_[i] = w0_r[i]; ar_[i] = a0_r[i]; gv_[i] = 0.f; }
        if (pmode & 1)
#pragma unroll 4
        for (int j = 0; j < 16; ++j) { const float tj = __shfl(tw, j), aj = __shfl(low, 16 + j);
#pragma unroll
            for (int i = 0; i < 4; ++i) { wr_[i] += tj * sW2[j * 256 + 64 * i + lane]; ar_[i] += aj * sA2[j * 256 + 64 * i + lane]; } }
        if (pmode & 1)
#pragma unroll 4
        for (int j = 0; j < 32; ++j) { const float sj = __shfl(sg, 32 + j);
#pragma unroll
            for (int i = 0; i < 4; ++i) gv_[i] += sj * sG2[j * 256 + 64 * i + lane]; }
#pragma unroll
        for (int i = 0; i < 4; ++i) { const int c = 64 * i + lane;
            const float w_raw = -softplusf_(-wr_[i]) - 0.5f, wdec = __expf(-__expf(w_raw));
            const float av = sigmoidf_(ar_[i]);
            const float kx = xs[4 + i]; float kkv = kx * kk_r[i]; const float nrm = sqrtf(wave_sum(kkv * kkv)); kkv = kkv * __builtin_amdgcn_rcpf(fmaxf(nrm, 1e-12f));
            const float kp = kx * (1.f + (av - 1.f) * ka_r[i]);
            const float rx = xs[i], vx = xs[8 + i];
            const float bon = wave_sum(rx * kp * rk_r[i]);
            const size_t o = (size_t)m * 256 + c;
            const float ahat = -kkv * cpr[i]; cpr[i] *= wdec; const float cinv = __builtin_amdgcn_rcpf(cpr[i]);
            DR[o] = (bf16)f2bf(rx * cpr[i]); DKP[o] = (bf16)f2bf(kp * cinv); DV[o] = (bf16)f2bf(vx); DKK[o] = (bf16)f2bf(ahat); DAI[o] = (bf16)f2bf(kkv * av * cinv); DG[o] = (bf16)f2bf(gv_[i]);
            if (tt == 15) DCL[(size_t)ck * 256 + c] = cpr[i];
            if (lane == 0) BON[(size_t)m * 4 + i] = bon; }
      }
    }
#undef PREP_LOAD
#undef PREP_LOADP
    __syncthreads();
}

typedef float f32x16 __attribute__((ext_vector_type(16)));
typedef short s16x4 __attribute__((ext_vector_type(4)));
typedef short v4i16_t __attribute__((ext_vector_type(4)));
typedef float f32x2_t __attribute__((ext_vector_type(2))); typedef __bf16 bf16x2_t __attribute__((ext_vector_type(2)));
__device__ __forceinline__ unsigned cvtpk_s(float lo, float hi) { f32x2_t v = {lo, hi}; bf16x2_t b = __builtin_convertvector(v, bf16x2_t); return __builtin_bit_cast(unsigned, b); }
__device__ __forceinline__ s16x4 vtr(const LAS unsigned char* p) { return __builtin_bit_cast(s16x4, __builtin_amdgcn_ds_read_tr16_b64_v4i16((LAS v4i16_t*)p)); }
constexpr int ATB_OFF = 102400;
constexpr int AVI_OFF = 3584;
constexpr float LOG2E = 1.4426950408889634f;
__device__ __forceinline__ void mixA_tables(const Args& a, LAS unsigned char* lds, int tid) {
    LAS float* tb = (LAS float*)(lds + ATB_OFF);
    for (int i = tid; i < 3 * 4 * 192; i += NTHR) { const int e = i % 192, h = (i / 192) & 3, f = i / 768; const int dist = 159 - e; const int dl = f == 0 ? 16 : (f == 1 ? 4 : 1);
        float v = -INFINITY;
        if (dist >= 0 && dist <= 128) { int dd = dist * dl; dd = dd > 2047 ? 2047 : dd; v = a.in[1][t5_bucket(dd) * 8 + h] * LOG2E; }
        tb[i] = v; }
}
__device__ __forceinline__ void mixA_task(const Args& a, int task, LAS unsigned char* lds, int wave, int lane_in) {
    int lane = lane_in; asm volatile("" : "+v"(lane));
    const bf16* P = (const bf16*)(a.ws + WS_BIG); bf16* YS = (bf16*)((unsigned char*)a.out + DO_YS);
    const int cc = 3 - (task & 3), r = (task >> 2) & 15, h = (task >> 6) & 3, b = task >> 8;
    const int ql = lane & 31, hh = lane >> 5, n0 = 32 * cc;
    const size_t rowb = (size_t)b * SEQ; const int tq = 16 * (n0 + ql) + r;
    const LAS float* tball = (const LAS float*)(lds + ATB_OFF) + h * 192;
    LAS unsigned char* vimg = lds + AVI_OFF + wave * 12800;
    bf16x8 qf[4];
    { const bf16* qp = P + (rowb + tq) * PW + PC_AQ + h * 64 + 8 * hh;
#pragma unroll
      for (int ks = 0; ks < 4; ++ks) qf[ks] = *(const bf16x8*)(qp + 16 * ks); }
    f32x16 o0, o1;
#pragma unroll
    for (int i = 0; i < 16; ++i) { o0[i] = 0.f; o1[i] = 0.f; }
    float m = -INFINITY, lsum = 0.f;
    const float SC = 0.125f * LOG2E;
    const int vst = (lane >> 1) * 144 + (lane & 1) * 64;
    const int i16 = lane & 15, tq4 = i16 >> 2, tp = i16 & 3, g16 = (lane >> 4) & 1;
    const int vrd = (4 * hh + tq4) * 144 + 32 * g16 + 8 * tp;
#pragma unroll 1
    for (int f = 0; f < 3; ++f) {
        const int dsh = f == 0 ? 4 : (f == 1 ? 2 : 0);
        const int rho = r & ((1 << dsh) - 1);
        const int qpos = (tq - rho) >> dsh;
        const int qmin = (16 * n0 + r - rho) >> dsh, qmax = (16 * (n0 + 31) + r - rho) >> dsh;
        int klo = qmin - 128; klo = klo < 0 ? 0 : klo; klo &= ~31;
        const LAS float* tbf = tball + f * 768;
        bf16x8 kA[4], kB[4]; u32x4 vA0, vA1, vA2, vA3, vB0, vB1, vB2, vB3;
#define A_LOAD(KF, W0, W1, W2, W3, KK0) do { const size_t tk_ = rowb + (((size_t)((KK0) + ql)) << dsh) + rho; const bf16* kp_ = P + tk_ * PW + PC_AK + h * 64 + 8 * hh; \
            _Pragma("unroll") for (int ks = 0; ks < 4; ++ks) KF[ks] = *(const bf16x8*)(kp_ + 16 * ks); \
            const size_t tv_ = rowb + (((size_t)((KK0) + (lane >> 1))) << dsh) + rho; const u32x4* vp_ = (const u32x4*)(P + tv_ * PW + PC_AV + h * 64 + 32 * (lane & 1)); \
            W0 = vp_[0]; W1 = vp_[1]; W2 = vp_[2]; W3 = vp_[3]; } while (0)
#define A_TILE(KF, W0, W1, W2, W3, K0) do { \
            f32x16 st; \
            _Pragma("unroll") for (int i = 0; i < 16; ++i) st[i] = 0.f; \
            _Pragma("unroll") for (int ks = 0; ks < 4; ++ks) st = __builtin_amdgcn_mfma_f32_32x32x16_bf16(KF[ks], qf[ks], st, 0, 0, 0); \
            *(LAS u32x4*)(vimg + vst) = W0; *(LAS u32x4*)(vimg + vst + 16) = W1; *(LAS u32x4*)(vimg + vst + 32) = W2; *(LAS u32x4*)(vimg + vst + 48) = W3; \
            __builtin_amdgcn_sched_barrier(0); \
            if ((K0) - 64 >= klo) A_LOAD(KF, W0, W1, W2, W3, (K0) - 64); \
            __builtin_amdgcn_sched_barrier(0); \
            const int D0 = qpos - (K0) - 4 * hh; const int e0 = (D0 >= 0 && D0 <= 159) ? 159 - D0 : 0; \
            const LAS float* tp_ = tbf + e0; \
            float mx = -INFINITY; \
            _Pragma("unroll") for (int i = 0; i < 16; ++i) { st[i] = st[i] * SC + tp_[(i & 3) + 8 * (i >> 2)]; mx = fmaxf(mx, st[i]); } \
            mx = fmaxf(mx, __shfl_xor(mx, 32)); \
            const float mn = fmaxf(m, mx), alpha = __builtin_amdgcn_exp2f(m - mn); \
            m = mn; float ps = 0.f; \
            _Pragma("unroll") for (int i = 0; i < 16; ++i) { st[i] = __builtin_amdgcn_exp2f(st[i] - mn); ps += st[i]; } \
            lsum = lsum * alpha + ps; \
            _Pragma("unroll") for (int i = 0; i < 16; ++i) { o0[i] *= alpha; o1[i] *= alpha; } \
            bf16x8 pf[2]; \
            _Pragma("unroll") for (int s = 0; s < 2; ++s) { u32x4 w; w.x = cvtpk_s(st[8 * s], st[8 * s + 1]); w.y = cvtpk_s(st[8 * s + 2], st[8 * s + 3]); w.z = cvtpk_s(st[8 * s + 4], st[8 * s + 5]); w.w = cvtpk_s(st[8 * s + 6], st[8 * s + 7]); pf[s] = __builtin_bit_cast(bf16x8, w); } \
            asm volatile("s_waitcnt lgkmcnt(0)" ::: "memory"); \
            _Pragma("unroll") for (int s = 0; s < 2; ++s) { \
                const s16x4 a00 = vtr(vimg + vrd + (16 * s) * 144), a01 = vtr(vimg + vrd + (16 * s + 8) * 144); \
                const s16x4 a10 = vtr(vimg + vrd + (16 * s) * 144 + 64), a11 = vtr(vimg + vrd + (16 * s + 8) * 144 + 64); \
                const bf16x8 A0 = (bf16x8){a00[0], a00[1], a00[2], a00[3], a01[0], a01[1], a01[2], a01[3]}; \
                const bf16x8 A1 = (bf16x8){a10[0], a10[1], a10[2], a10[3], a11[0], a11[1], a11[2], a11[3]}; \
                o0 = __builtin_amdgcn_mfma_f32_32x32x16_bf16(A0, pf[s], o0, 0, 0, 0); \
                o1 = __builtin_amdgcn_mfma_f32_32x32x16_bf16(A1, pf[s], o1, 0, 0, 0); } \
            asm volatile("s_waitcnt lgkmcnt(0)" ::: "memory"); } while (0)
        int k0 = qmax & ~31;
        A_LOAD(kA, vA0, vA1, vA2, vA3, k0);
        if (k0 - 32 >= klo) A_LOAD(kB, vB0, vB1, vB2, vB3, k0 - 32);
#pragma unroll 1
        while (k0 >= klo) {
            A_TILE(kA, vA0, vA1, vA2, vA3, k0);
            k0 -= 32; if (k0 < klo) break;
            A_TILE(kB, vB0, vB1, vB2, vB3, k0);
            k0 -= 32;
        }
#undef A_TILE
#undef A_LOAD
    }
    const float lt = lsum + __shfl_xor(lsum, 32); const float inv = 1.f / lt;
    bf16* yo = YS + (rowb + tq) * 1024 + h * 64 + 4 * hh;
#pragma unroll
    for (int g = 0; g < 4; ++g) {
        u32x2 w; w.x = cvtpk_s(o0[4 * g] * inv, o0[4 * g + 1] * inv); w.y = cvtpk_s(o0[4 * g + 2] * inv, o0[4 * g + 3] * inv); *(u32x2*)(yo + 8 * g) = w;
        u32x2 x; x.x = cvtpk_s(o1[4 * g] * inv, o1[4 * g + 1] * inv); x.y = cvtpk_s(o1[4 * g + 2] * inv, o1[4 * g + 3] * inv); *(u32x2*)(yo + 32 + 8 * g) = x; }
}

__device__ __forceinline__ unsigned fkey(float f) { const unsigned u = __float_as_uint(f); return (u & 0x80000000u) ? ~u : (u | 0x80000000u); }
typedef float f32x4v __attribute__((ext_vector_type(4)));
__device__ __forceinline__ void mixB_attend(const Args& a, int m, const LAS unsigned short* sidx, const LAS unsigned char* sbk, int nsel, LAS unsigned char* lds, LAS unsigned char* img, int lane) {
    const bf16* P = (const bf16*)(a.ws + WS_BIG); const bf16* CKVN = (const bf16*)(a.ws + WS_CKVN); bf16* YS = (bf16*)((unsigned char*)a.out + DO_YS);
    const LAS float* rpb = (const LAS float*)(lds + RPB_OFF);
    const int t = m & (SEQ - 1); const size_t rowb = (size_t)(m - t); const bf16* prow = P + (size_t)m * PW;
    const int hc = lane & 15, g = lane >> 4, hd = lane & 3;
    bf16x8 qB[2];
    { const bf16x8 z = (bf16x8){0, 0, 0, 0, 0, 0, 0, 0}; const bf16* qp = prow + PC_BQ + hd * 64 + 8 * g;
      const bf16x8 q0 = *(const bf16x8*)(qp), q1 = *(const bf16x8*)(qp + 32); qB[0] = hc < 4 ? q0 : z; qB[1] = hc < 4 ? q1 : z; }
    f32x4v oT[4];
#pragma unroll
    for (int mt = 0; mt < 4; ++mt) oT[mt] = (f32x4v){0.f, 0.f, 0.f, 0.f};
    float mrun = -INFINITY, lsum = 0.f;
    const float SC = 0.125f * LOG2E;
    const int i16 = lane & 15, tq4 = i16 >> 2, tp = i16 & 3;
    const int rd_row = (lane & 15) * 144 + 16 * g;
    const int rd_tr = (4 * g + tq4) * 144 + 8 * tp;
    u32x4 g0, g1, g2, g3, g4, g5, g6, g7;
#define BG_LOAD(CH) do { const int kk_ = 64 * (CH) + lane; const int idx_ = (int)sidx[kk_ < nsel ? kk_ : 0] & (SEQ - 1); const u32x4* cp_ = (const u32x4*)(CKVN + (rowb + idx_) * 64); \
        g0 = cp_[0]; g1 = cp_[1]; g2 = cp_[2]; g3 = cp_[3]; g4 = cp_[4]; g5 = cp_[5]; g6 = cp_[6]; g7 = cp_[7]; } while (0)
    BG_LOAD(0);
#pragma unroll 1
    for (int ch = 0; ch < 4; ++ch) {
        if (64 * ch >= nsel) break;
        { LAS u32x4* ip = (LAS u32x4*)(img + lane * 144); ip[0] = g0; ip[1] = g1; ip[2] = g2; ip[3] = g3; ip[4] = g4; ip[5] = g5; ip[6] = g6; ip[7] = g7; }
        if (64 * (ch + 1) < nsel) BG_LOAD(ch + 1);
        asm volatile("s_waitcnt lgkmcnt(0)" ::: "memory");
        f32x4v st[4];
        float mx = -INFINITY;
#pragma unroll
        for (int kt = 0; kt < 4; ++kt) {
            const bf16x8 a0 = *(const LAS bf16x8*)(img + rd_row + (16 * kt) * 144), a1 = *(const LAS bf16x8*)(img + rd_row + (16 * kt) * 144 + 64);
            f32x4v acc = (f32x4v){0.f, 0.f, 0.f, 0.f};
            acc = __builtin_amdgcn_mfma_f32_16x16x32_bf16(a0, qB[0], acc, 0, 0, 0);
            acc = __builtin_amdgcn_mfma_f32_16x16x32_bf16(a1, qB[1], acc, 0, 0, 0);
            const int kb = 64 * ch + 16 * kt + 4 * g;
            const unsigned bk4 = *(const LAS unsigned*)(sbk + kb);
#pragma unroll
            for (int i = 0; i < 4; ++i) { const int bk = (bk4 >> (8 * i)) & 0xff; const float bias = rpb[bk * 8 + 4 + hd] * LOG2E;
                const float v = (kb + i < nsel) ? acc[i] * SC + bias : -INFINITY; acc[i] = v; mx = fmaxf(mx, v); }
            st[kt] = acc; }
        mx = fmaxf(mx, __shfl_xor(mx, 16)); mx = fmaxf(mx, __shfl_xor(mx, 32));
        const float mn = fmaxf(mrun, mx), alpha = __builtin_amdgcn_exp2f(mrun - mn); mrun = mn;
        float ps = 0.f;
#pragma unroll
        for (int kt = 0; kt < 4; ++kt)
#pragma unroll
            for (int i = 0; i < 4; ++i) { st[kt][i] = __builtin_amdgcn_exp2f(st[kt][i] - mn); ps += st[kt][i]; }
        lsum = lsum * alpha + ps;
#pragma unroll
        for (int mt = 0; mt < 4; ++mt) oT[mt] = oT[mt] * alpha;
#pragma unroll
        for (int ks2 = 0; ks2 < 2; ++ks2) {
            u32x4 w; w.x = cvtpk_s(st[2 * ks2][0], st[2 * ks2][1]); w.y = cvtpk_s(st[2 * ks2][2], st[2 * ks2][3]); w.z = cvtpk_s(st[2 * ks2 + 1][0], st[2 * ks2 + 1][1]); w.w = cvtpk_s(st[2 * ks2 + 1][2], st[2 * ks2 + 1][3]);
            const bf16x8 pB = __builtin_bit_cast(bf16x8, w);
#pragma unroll
            for (int mt = 0; mt < 4; ++mt) {
                const s16x4 lo = vtr(img + rd_tr + (32 * ks2) * 144 + 32 * mt), hi = vtr(img + rd_tr + (32 * ks2 + 16) * 144 + 32 * mt);
                const bf16x8 A = (bf16x8){lo[0], lo[1], lo[2], lo[3], hi[0], hi[1], hi[2], hi[3]};
                oT[mt] = __builtin_amdgcn_mfma_f32_16x16x32_bf16(A, pB, oT[mt], 0, 0, 0); } }
        asm volatile("s_waitcnt lgkmcnt(0)" ::: "memory");
    }
#undef BG_LOAD
    float lt = lsum; lt += __shfl_xor(lt, 16); lt += __shfl_xor(lt, 32);
    const float inv = 1.f / lt;
    if (hc < 4) { bf16* yo = YS + (size_t)m * 1024 + 256 + hc * 64 + 4 * g;
#pragma unroll
        for (int mt = 0; mt < 4; ++mt) { u32x2 w; w.x = cvtpk_s(oT[mt][0] * inv, oT[mt][1] * inv); w.y = cvtpk_s(oT[mt][2] * inv, oT[mt][3] * inv); *(u32x2*)(yo + 16 * mt) = w; } }
}
__device__ __forceinline__ void mixB_group(const Args& a, int l, int m0, LAS unsigned char* lds, LAS unsigned char* wscr, int lane_in, const int bmode = 15) {
    int lane = lane_in; asm volatile("" : "+v"(lane));
    const bf16* P = (const bf16*)(a.ws + WS_BIG);
    const int t0 = m0 & (SEQ - 1); const size_t rowb = (size_t)(m0 - t0);
    const int ql = lane & 31, hh = lane >> 5;
    LAS unsigned short* sidx = (LAS unsigned short*)wscr;
    LAS unsigned char* sbk = wscr + 2048;
    LAS unsigned char* img = wscr + 3584;
    const LAS unsigned char* bkt = lds + BKT_OFF;
    bf16x8 qf[2];
    { const int rho = ql, qi = 2 * ((rho >> 2) & 1) + (rho >> 4), hd = 4 * ((rho >> 3) & 1) + (rho & 3);
      const bf16* ip = P + (size_t)(m0 + qi) * PW + PC_IQ + hd * 32 + 8 * hh;
      qf[0] = *(const bf16x8*)(ip); qf[1] = *(const bf16x8*)(ip + 16); }
    float iw[2][8];
#pragma unroll
    for (int qq = 0; qq < 2; ++qq) { const u32x4 w = *(const u32x4*)(P + (size_t)(m0 + 2 * hh + qq) * PW + PC_IW); const float s = 0.0625f;
        iw[qq][0] = bflo(w.x) * s; iw[qq][1] = bfhi(w.x) * s; iw[qq][2] = bflo(w.y) * s; iw[qq][3] = bfhi(w.y) * s; iw[qq][4] = bflo(w.z) * s; iw[qq][5] = bfhi(w.z) * s; iw[qq][6] = bflo(w.w) * s; iw[qq][7] = bfhi(w.w) * s; }
    const int tq0 = t0 + 2 * hh;
    const int ntile = ((t0 + 3) >> 5) + 1;
    unsigned sk[2][64];
#pragma unroll
    for (int kb4 = 0; kb4 < 32; ++kb4) {
        if (2 * kb4 < ntile && (bmode & 1)) {
            bf16x8 kf0[2], kf1[2];
#pragma unroll
            for (int k4 = 0; k4 < 2; ++k4) { const int s = 32 * (2 * kb4 + k4) + ql; const bf16* kp = P + (rowb + s) * PW + PC_IK + 8 * hh; kf0[k4] = *(const bf16x8*)(kp); kf1[k4] = *(const bf16x8*)(kp + 16); }
#pragma unroll
            for (int k4 = 0; k4 < 2; ++k4) { const int kt = 2 * kb4 + k4; const int s = 32 * kt + ql;
                f32x16 acc;
#pragma unroll
                for (int i = 0; i < 16; ++i) acc[i] = 0.f;
                acc = __builtin_amdgcn_mfma_f32_32x32x16_bf16(qf[0], kf0[k4], acc, 0, 0, 0);
                acc = __builtin_amdgcn_mfma_f32_32x32x16_bf16(qf[1], kf1[k4], acc, 0, 0, 0);
                float s0 = 0.f, s1 = 0.f;
#pragma unroll
                for (int i = 0; i < 8; ++i) { s0 += fmaxf(acc[i], 0.f) * iw[0][i]; s1 += fmaxf(acc[8 + i], 0.f) * iw[1][i]; }
                sk[0][kt] = (s <= tq0) ? fkey(s0) : 0x007fffffu; sk[1][kt] = (s <= tq0 + 1) ? fkey(s1) : 0x007fffffu; }
        } else {
#pragma unroll
            for (int k4 = 0; k4 < 2; ++k4) { sk[0][2 * kb4 + k4] = 0x007fffffu; sk[1][2 * kb4 + k4] = 0x007fffffu; }
        }
    }
    const unsigned ltm = (1u << ql) - 1u;
    const int nblk8 = (ntile + 7) >> 3;
#define SK_RED(C) do { C += __builtin_amdgcn_update_dpp(0, C, 0x128, 0xf, 0xf, true); C += __builtin_amdgcn_update_dpp(0, C, 0x124, 0xf, 0xf, true); \
        C += __builtin_amdgcn_update_dpp(0, C, 0x122, 0xf, 0xf, true); C += __builtin_amdgcn_update_dpp(0, C, 0x121, 0xf, 0xf, true); C += __shfl_xor(C, 16); } while (0)
#define SK_COUNT2(OP, R0, R1, C0, C1) do { _Pragma("unroll") for (int kb8 = 0; kb8 < 8; ++kb8) { if (kb8 < nblk8) { _Pragma("unroll") for (int k8 = 0; k8 < 8; ++k8) { \
        C0 += (sk[0][8 * kb8 + k8] OP (R0)) ? 1 : 0; C1 += (sk[1][8 * kb8 + k8] OP (R1)) ? 1 : 0; } } } SK_RED(C0); SK_RED(C1); } while (0)
    unsigned KthA[2] = {0u, 0u}; int needA[2] = {0, 0};
    const bool big0 = (tq0 + 1 > 256), big1 = (tq0 + 2 > 256); bool exact = true;
    if (__any(big0 || big1) && (bmode & 2)) {
        exact = false;
#pragma unroll 1
        for (int bit = 31; bit >= 0; --bit) { const unsigned c0 = KthA[0] | (1u << bit), c1 = KthA[1] | (1u << bit); int n0 = 0, n1 = 0;
            SK_COUNT2(>=, c0, c1, n0, n1);
            if (n0 >= 256) KthA[0] = c0;
            if (n1 >= 256) KthA[1] = c1;
            if (__all((n0 == 256 || !big0) && (n1 == 256 || !big1))) { exact = true; break; }
        }
        if (!exact) { int g0 = 0, g1 = 0; SK_COUNT2(>, KthA[0], KthA[1], g0, g1); needA[0] = 256 - g0; needA[1] = 256 - g1; }
    }
#pragma unroll
    for (int qq = 0; qq < 2; ++qq) {
        if (!(bmode & 4)) break;
        const int tq = tq0 + qq; const bool big = qq ? big1 : big0; const unsigned Kth = KthA[qq]; const int need = needA[qq];
        LAS unsigned short* sx = sidx + (2 * hh + qq) * 256;
        int base = 0, tie_taken = 0; int ql2 = ql; asm volatile("" : "+v"(ql2));
#pragma unroll
        for (int kb8 = 0; kb8 < 8; ++kb8) { if (kb8 < nblk8) {
#pragma unroll
            for (int k8 = 0; k8 < 8; ++k8) { const int kt = 8 * kb8 + k8; const int s = 32 * kt + ql2; const unsigned k = sk[qq][kt]; bool take;
                if (!big) take = (s <= tq);
                else if (exact) take = (k >= Kth);
                else { const bool tie = (k == Kth); const unsigned long long mt = __ballot(tie); const unsigned mt32 = hh ? (unsigned)(mt >> 32) : (unsigned)mt;
                    take = (k > Kth) || (tie && (tie_taken + __popc(mt32 & ltm)) < need); tie_taken += __popc(mt32); }
                const unsigned long long ms = __ballot(take); const unsigned ms32 = hh ? (unsigned)(ms >> 32) : (unsigned)ms;
                if (take) sx[base + __popc(ms32 & ltm)] = (unsigned short)s;
                base += __popc(ms32); } } }
    }
#undef SK_COUNT2
#undef SK_RED
    LDS_WAIT(); asm volatile("" ::: "memory");
#pragma unroll
    for (int qi = 0; qi < 4; ++qi) { const int tq = t0 + qi; const int nsel = (tq + 1 < 256) ? tq + 1 : 256;
#pragma unroll
        for (int j = 0; j < 4; ++j) { const int pos = lane + 64 * j; if (pos < nsel) sbk[qi * 256 + pos] = bkt[tq - (int)sidx[qi * 256 + pos]]; } }
    LDS_WAIT(); asm volatile("" ::: "memory");
#pragma unroll 1
    for (int qi = 0; qi < 4; ++qi) { if (!(bmode & 8)) break; const int tq = t0 + qi; const int nsel = (tq + 1 < 256) ? tq + 1 : 256;
        mixB_attend(a, m0 + qi, sidx + qi * 256, sbk + qi * 256, nsel, lds, img, lane); asm volatile("" ::: "memory"); }
}
constexpr int DM_OFF = 111616;
__device__ __forceinline__ bf16x8 frag2(const LAS unsigned char* p0, const LAS unsigned char* p1) {
    const s16x4 lo = *(const LAS s16x4*)p0, hi = *(const LAS s16x4*)p1; return (bf16x8){lo[0], lo[1], lo[2], lo[3], hi[0], hi[1], hi[2], hi[3]}; }
__device__ __forceinline__ bf16x8 fragtr(const LAS unsigned char* p0, const LAS unsigned char* p1) {
    const s16x4 lo = vtr(p0), hi = vtr(p1); return (bf16x8){lo[0], lo[1], lo[2], lo[3], hi[0], hi[1], hi[2], hi[3]}; }
__device__ __forceinline__ bf16x8 packf(f32x4 lo, f32x4 hi) { u32x4 w; w.x = cvtpk_s(lo[0], lo[1]); w.y = cvtpk_s(lo[2], lo[3]); w.z = cvtpk_s(hi[0], hi[1]); w.w = cvtpk_s(hi[2], hi[3]); return __builtin_bit_cast(bf16x8, w); }
__device__ __forceinline__ void dchunk_wave(const Args& a, int l, int bh, LAS unsigned char* dm, int lane_in) {
    int lane = lane_in; asm volatile("" : "+v"(lane));
    const int b = bh >> 2, h = bh & 3, hc = lane & 15, g = lane >> 4;
    LAS unsigned char* sAT = dm; LAS unsigned char* sBT = dm + 2304; LAS unsigned char* sKT = dm + 4608; LAS unsigned char* sRT = dm + 6912; LAS unsigned char* sVT = dm + 9216; LAS unsigned char* sUT = dm + 11520;
    LAS float* sW1 = (LAS float*)(dm + 13824); LAS float* sMB = (LAS float*)(dm + 17920); LAS float* sCL = (LAS float*)(dm + 18944); LAS float* sBON = (LAS float*)(dm + 19200);
    const bf16* DR = (const bf16*)((unsigned char*)a.out + DO_DR); const bf16* DKP = (const bf16*)((unsigned char*)a.out + DO_DKP); const bf16* DV = (const bf16*)((unsigned char*)a.out + DO_DV); const bf16* DKK = (const bf16*)((unsigned char*)a.out + DO_DKK);
    const float* DCL = (const float*)(a.ws + WS_BIG + BIG_DW); const bf16* DAI = (const bf16*)(a.ws + WS_BIG + BIG_DAI); const bf16* DG = (const bf16*)(a.ws + WS_BIG + BIG_DG);
    const float* BON = (const float*)(a.ws + WS_BON); bf16* YS = (bf16*)((unsigned char*)a.out + DO_YS);
    float gnw[4], gnb[4];
#pragma unroll
    for (int vt = 0; vt < 4; ++vt) { gnw[vt] = a.in[17][l * 256 + h * 64 + 16 * vt + hc]; gnb[vt] = a.in[18][l * 256 + h * 64 + 16 * vt + hc]; }
    const size_t tok0 = (size_t)b * SEQ;
    f32x4v T[4][4];
#pragma unroll
    for (int kt = 0; kt < 4; ++kt)
#pragma unroll
        for (int vt = 0; vt < 4; ++vt) T[kt][vt] = (f32x4v){0.f, 0.f, 0.f, 0.f};
    const int lrow = lane >> 3, lseg = lane & 7;
    u32x4 nA0, nA1, nB0, nB1, nK0, nK1, nR0, nR1, nV0, nV1; float nCL, nBON;
#define DC_LOAD(CH) do { const size_t e0_ = (tok0 + (size_t)(CH) * 16 + lrow) * 256 + h * 64 + 8 * lseg, e1_ = e0_ + 8 * 256; \
        nA0 = *(const u32x4*)(DKK + e0_); nA1 = *(const u32x4*)(DKK + e1_); nB0 = *(const u32x4*)(DAI + e0_); nB1 = *(const u32x4*)(DAI + e1_); nK0 = *(const u32x4*)(DKP + e0_); nK1 = *(const u32x4*)(DKP + e1_); \
        nR0 = *(const u32x4*)(DR + e0_); nR1 = *(const u32x4*)(DR + e1_); nV0 = *(const u32x4*)(DV + e0_); nV1 = *(const u32x4*)(DV + e1_); \
        nCL = DCL[((size_t)b * (SEQ / 16) + (CH)) * 256 + h * 64 + lane]; nBON = BON[(tok0 + (size_t)(CH) * 16 + (lane & 15)) * 4 + h]; } while (0)
    DC_LOAD(0);
    const int st0 = lrow * 144 + lseg * 16, st1 = st0 + 8 * 144;
    const int rdf = hc * 144 + 8 * g;
    const int rdt = (4 * g + (hc >> 2)) * 144 + 8 * (hc & 3);
    __builtin_amdgcn_s_setprio(2);
#pragma unroll 1
    for (int ch = 0; ch < SEQ / 16; ++ch) {
        *(LAS u32x4*)(sAT + st0) = nA0; *(LAS u32x4*)(sAT + st1) = nA1; *(LAS u32x4*)(sBT + st0) = nB0; *(LAS u32x4*)(sBT + st1) = nB1; *(LAS u32x4*)(sKT + st0) = nK0; *(LAS u32x4*)(sKT + st1) = nK1;
        *(LAS u32x4*)(sRT + st0) = nR0; *(LAS u32x4*)(sRT + st1) = nR1; *(LAS u32x4*)(sVT + st0) = nV0; *(LAS u32x4*)(sVT + st1) = nV1; sCL[lane] = nCL; if (lane < 16) sBON[lane] = nBON;
        unsigned short gq[4][4];
#pragma unroll
        for (int vt = 0; vt < 4; ++vt)
#pragma unroll
            for (int i = 0; i < 4; ++i) gq[vt][i] = DG[(tok0 + (size_t)ch * 16 + 4 * g + i) * 256 + h * 64 + 16 * vt + hc];
        asm volatile("s_waitcnt lgkmcnt(0)" ::: "memory");
        bf16x8 fA[2], fR[2], fB[2], fK[2];
#pragma unroll
        for (int ks = 0; ks < 2; ++ks) { fA[ks] = frag2(sAT + rdf + 64 * ks, sAT + rdf + 64 * ks + 32); fR[ks] = frag2(sRT + rdf + 64 * ks, sRT + rdf + 64 * ks + 32);
            fB[ks] = frag2(sBT + rdf + 64 * ks, sBT + rdf + 64 * ks + 32); fK[ks] = frag2(sKT + rdf + 64 * ks, sKT + rdf + 64 * ks + 32); }
        f32x4v U0[4], Y0[4];
#pragma unroll
        for (int vt = 0; vt < 4; ++vt) { const bf16x8 s0 = packf(T[0][vt], T[1][vt]), s1 = packf(T[2][vt], T[3][vt]);
            f32x4v u = (f32x4v){0.f, 0.f, 0.f, 0.f}, y = (f32x4v){0.f, 0.f, 0.f, 0.f};
            u = __builtin_amdgcn_mfma_f32_16x16x32_bf16(fA[0], s0, u, 0, 0, 0); u = __builtin_amdgcn_mfma_f32_16x16x32_bf16(fA[1], s1, u, 0, 0, 0);
            y = __builtin_amdgcn_mfma_f32_16x16x32_bf16(fR[0], s0, y, 0, 0, 0); y = __builtin_amdgcn_mfma_f32_16x16x32_bf16(fR[1], s1, y, 0, 0, 0);
            U0[vt] = u; Y0[vt] = y; }
        f32x4v Mka = (f32x4v){0.f, 0.f, 0.f, 0.f}, Mba = Mka, Mkr = Mka, Mbr = Mka;
#pragma unroll
        for (int ks = 0; ks < 2; ++ks) { Mka = __builtin_amdgcn_mfma_f32_16x16x32_bf16(fK[ks], fA[ks], Mka, 0, 0, 0); Mba = __builtin_amdgcn_mfma_f32_16x16x32_bf16(fB[ks], fA[ks], Mba, 0, 0, 0);
            Mkr = __builtin_amdgcn_mfma_f32_16x16x32_bf16(fK[ks], fR[ks], Mkr, 0, 0, 0); Mbr = __builtin_amdgcn_mfma_f32_16x16x32_bf16(fB[ks], fR[ks], Mbr, 0, 0, 0); }
#pragma unroll
        for (int i = 0; i < 4; ++i) { const int srow = 4 * g + i; if (!(srow < hc)) { Mka[i] = 0.f; Mba[i] = 0.f; } if (!(srow <= hc)) { Mkr[i] = 0.f; Mbr[i] = 0.f; } }
        if (ch + 1 < SEQ / 16) DC_LOAD(ch + 1);
        const f32x4v z4 = (f32x4v){0.f, 0.f, 0.f, 0.f};
        { const bf16x8 aM = packf(Mka, z4);
#pragma unroll
          for (int vt = 0; vt < 4; ++vt) { const s16x4 lo = vtr(sVT + rdt + 32 * vt); const bf16x8 bV = (bf16x8){lo[0], lo[1], lo[2], lo[3], 0, 0, 0, 0};
              U0[vt] = __builtin_amdgcn_mfma_f32_16x16x32_bf16(aM, bV, U0[vt], 0, 0, 0); } }
#pragma unroll
        for (int vt = 0; vt < 4; ++vt)
#pragma unroll
            for (int i = 0; i < 4; ++i) sW1[(4 * g + i) * 64 + 16 * vt + hc] = U0[vt][i];
        *(LAS f32x4v*)(sMB + hc * 16 + 4 * g) = Mba;
        asm volatile("s_waitcnt lgkmcnt(0)" ::: "memory");
        { float u[16];
#pragma unroll
          for (int t = 0; t < 16; ++t) { float acc = sW1[t * 64 + lane];
#pragma unroll
              for (int sq = 0; sq < 4; ++sq) { if (4 * sq < t) { const f32x4v mb = *(const LAS f32x4v*)(sMB + t * 16 + 4 * sq);
#pragma unroll
                  for (int e = 0; e < 4; ++e) if (4 * sq + e < t) acc += mb[e] * u[4 * sq + e]; } }
              u[t] = acc; ((LAS bf16*)sUT)[t * 72 + lane] = (bf16)f2bf(acc); } }
        asm volatile("s_waitcnt lgkmcnt(0)" ::: "memory");
        f32x4v bonv = *(const LAS f32x4v*)(sBON + 4 * g);
        { const bf16x8 aM = packf(Mbr, Mkr);
#pragma unroll
          for (int vt = 0; vt < 4; ++vt) { const bf16x8 bUV = fragtr(sUT + rdt + 32 * vt, sVT + rdt + 32 * vt); Y0[vt] = __builtin_amdgcn_mfma_f32_16x16x32_bf16(aM, bUV, Y0[vt], 0, 0, 0); } }
        { bf16x8 bUV[4];
#pragma unroll
          for (int vt = 0; vt < 4; ++vt) bUV[vt] = fragtr(sUT + rdt + 32 * vt, sVT + rdt + 32 * vt);
#pragma unroll
          for (int kt = 0; kt < 4; ++kt) { const bf16x8 aBK = fragtr(sBT + rdt + 32 * kt, sKT + rdt + 32 * kt); const f32x4v cl = *(const LAS f32x4v*)(sCL + 16 * kt + 4 * g);
#pragma unroll
              for (int vt = 0; vt < 4; ++vt) T[kt][vt] = __builtin_amdgcn_mfma_f32_16x16x32_bf16(aBK, bUV[vt], T[kt][vt], 0, 0, 0) * cl; } }
#pragma unroll
        for (int i = 0; i < 4; ++i) { float sm = (Y0[0][i] + Y0[1][i]) + (Y0[2][i] + Y0[3][i]);
            sm += dppf<0x128>(sm); sm += dppf<0x124>(sm); sm += dppf<0x122>(sm); sm += dppf<0x121>(sm);
            const float mean = sm * (1.f / 64.f); float sq = 0.f;
#pragma unroll
            for (int vt = 0; vt < 4; ++vt) { const float d = Y0[vt][i] - mean; sq += d * d; }
            sq += dppf<0x128>(sq); sq += dppf<0x124>(sq); sq += dppf<0x122>(sq); sq += dppf<0x121>(sq);
            const float rstd = rsqrtf(sq * (1.f / 64.f) + 64e-5f); const int t = 4 * g + i;
#pragma unroll
            for (int vt = 0; vt < 4; ++vt) { const float vv = bf2f(((const LAS bf16*)sVT)[t * 72 + 16 * vt + hc]);
                const float o = ((Y0[vt][i] - mean) * rstd * gnw[vt] + gnb[vt] + bonv[i] * vv) * bf2f(gq[vt][i]);
                YS[(tok0 + (size_t)ch * 16 + t) * 1024 + 768 + h * 64 + 16 * vt + hc] = (bf16)f2bf(o); } }
        asm volatile("s_waitcnt lgkmcnt(0)" ::: "memory");
    }
    __builtin_amdgcn_s_setprio(0);
#undef DC_LOAD
}
__device__ __forceinline__ void cchunk_wave(const Args& a, int l, int bh, LAS unsigned char* dm, int lane_in) {
    int lane = lane_in; asm volatile("" : "+v"(lane));
    const int b = bh >> 2, h = bh & 3, hc = lane & 15, g = lane >> 4;
    LAS unsigned char* sQT = dm; LAS unsigned char* sKT = dm + 1280; LAS unsigned char* sVT = dm + 2560; LAS float* sCL = (LAS float*)(dm + 4864);
    const bf16* P = (const bf16*)(a.ws + WS_BIG); const bf16* CQH = (const bf16*)(a.ws + WS_CA); const bf16* CKT = (const bf16*)(a.ws + WS_CA + 16 * MiB); const float* CCL = (const float*)(a.ws + WS_END);
    bf16* YS = (bf16*)((unsigned char*)a.out + DO_YS);
    float ng[4];
#pragma unroll
    for (int vt = 0; vt < 4; ++vt) ng[vt] = a.in[7][l * 256 + h * 64 + 16 * vt + hc];
    const size_t tok0 = (size_t)b * SEQ;
    f32x4v T[2][4];
#pragma unroll
    for (int kt = 0; kt < 2; ++kt)
#pragma unroll
        for (int vt = 0; vt < 4; ++vt) T[kt][vt] = (f32x4v){0.f, 0.f, 0.f, 0.f};
    const int qrow = lane >> 2, qseg = lane & 3, lrow = lane >> 3, lseg = lane & 7;
    u32x4 nQ, nK, nV0, nV1; float nCL;
#define CC_LOAD(CH) do { const size_t tq_ = tok0 + (size_t)(CH) * 16 + qrow; nQ = *(const u32x4*)(CQH + tq_ * 128 + h * 32 + 8 * qseg); nK = *(const u32x4*)(CKT + tq_ * 128 + h * 32 + 8 * qseg); \
        const size_t tv_ = tok0 + (size_t)(CH) * 16 + lrow; nV0 = *(const u32x4*)(P + tv_ * PW + PC_CV + h * 64 + 8 * lseg); nV1 = *(const u32x4*)(P + (tv_ + 8) * PW + PC_CV + h * 64 + 8 * lseg); \
        nCL = CCL[((size_t)b * (SEQ / 16) + (CH)) * 128 + h * 32 + (lane & 31)]; } while (0)
    CC_LOAD(0);
    const int rdf = hc * 80 + 8 * g;
    const int rdtk = (4 * g + (hc >> 2)) * 80 + 8 * (hc & 3);
    const int rdtv = (4 * g + (hc >> 2)) * 144 + 8 * (hc & 3);
    __builtin_amdgcn_s_setprio(2);
#pragma unroll 1
    for (int ch = 0; ch < SEQ / 16; ++ch) {
        *(LAS u32x4*)(sQT + qrow * 80 + qseg * 16) = nQ; *(LAS u32x4*)(sKT + qrow * 80 + qseg * 16) = nK;
        *(LAS u32x4*)(sVT + lrow * 144 + lseg * 16) = nV0; *(LAS u32x4*)(sVT + (lrow + 8) * 144 + lseg * 16) = nV1; if (lane < 32) sCL[lane] = nCL;
        unsigned short gq[4][4];
#pragma unroll
        for (int vt = 0; vt < 4; ++vt)
#pragma unroll
            for (int i = 0; i < 4; ++i) gq[vt][i] = P[(tok0 + (size_t)ch * 16 + 4 * g + i) * PW + PC_CG + h * 64 + 16 * vt + hc];
        asm volatile("s_waitcnt lgkmcnt(0)" ::: "memory");
        const bf16x8 fQ = frag2(sQT + rdf, sQT + rdf + 32), fK = frag2(sKT + rdf, sKT + rdf + 32);
        f32x4v Y0[4];
#pragma unroll
        for (int vt = 0; vt < 4; ++vt) { const bf16x8 s0 = packf(T[0][vt], T[1][vt]); Y0[vt] = __builtin_amdgcn_mfma_f32_16x16x32_bf16(fQ, s0, (f32x4v){0.f, 0.f, 0.f, 0.f}, 0, 0, 0); }
        f32x4v Mkq = __builtin_amdgcn_mfma_f32_16x16x32_bf16(fK, fQ, (f32x4v){0.f, 0.f, 0.f, 0.f}, 0, 0, 0);
#pragma unroll
        for (int i = 0; i < 4; ++i) if (!(4 * g + i <= hc)) Mkq[i] = 0.f;
        if (ch + 1 < SEQ / 16) CC_LOAD(ch + 1);
        const f32x4v z4 = (f32x4v){0.f, 0.f, 0.f, 0.f};
        bf16x8 bV[4];
#pragma unroll
        for (int vt = 0; vt < 4; ++vt) { const s16x4 lo = vtr(sVT + rdtv + 32 * vt); bV[vt] = (bf16x8){lo[0], lo[1], lo[2], lo[3], 0, 0, 0, 0}; }
        { const bf16x8 aM = packf(Mkq, z4);
#pragma unroll
          for (int vt = 0; vt < 4; ++vt) Y0[vt] = __builtin_amdgcn_mfma_f32_16x16x32_bf16(aM, bV[vt], Y0[vt], 0, 0, 0); }
#pragma unroll
        for (int kt = 0; kt < 2; ++kt) { const s16x4 lo = vtr(sKT + rdtk + 32 * kt); const bf16x8 aK = (bf16x8){lo[0], lo[1], lo[2], lo[3], 0, 0, 0, 0}; const f32x4v cl = *(const LAS f32x4v*)(sCL + 16 * kt + 4 * g);
#pragma unroll
            for (int vt = 0; vt < 4; ++vt) T[kt][vt] = __builtin_amdgcn_mfma_f32_16x16x32_bf16(aK, bV[vt], T[kt][vt], 0, 0, 0) * cl; }
#pragma unroll
        for (int i = 0; i < 4; ++i) { float sq = 0.f;
#pragma unroll
            for (int vt = 0; vt < 4; ++vt) { const float o = Y0[vt][i] * 0.17677669529663687f; Y0[vt][i] = o; sq += o * o; }
            sq += dppf<0x128>(sq); sq += dppf<0x124>(sq); sq += dppf<0x122>(sq); sq += dppf<0x121>(sq);
            const float rn = rsqrtf(sq * (1.f / 64.f) + 1e-6f); const int t = 4 * g + i;
#pragma unroll
            for (int vt = 0; vt < 4; ++vt) { const float gg = bf2f(gq[vt][i]);
                YS[(tok0 + (size_t)ch * 16 + t) * 1024 + 512 + h * 64 + 16 * vt + hc] = (bf16)f2bf(gg * sigmoidf_(gg) * (Y0[vt][i] * rn * ng[vt])); } }
        asm volatile("s_waitcnt lgkmcnt(0)" ::: "memory");
    }
    __builtin_amdgcn_s_setprio(0);
#undef CC_LOAD
}
__device__ __forceinline__ void mixers_phase(const Args& a, int l, LAS unsigned char* lds, int bid, int G, int tid, int wave, int lane, int qsel = 0, int mixmask = 15, const int bmode = 15) {
    unsigned* qh = (unsigned*)(a.ws + WS_CTL) + CW_Q + 64 * l + 16 * qsel;
    LAS unsigned char* wscr = lds + wave * 12800;
    mixA_tables(a, lds, tid); __syncthreads();
    if (wave == 0) for (int it = bid; it < 256; it += G) { if (it < 128) { if (mixmask & 1) dchunk_wave(a, l, it, lds + DM_OFF, lane); } else { if (mixmask & 2) cchunk_wave(a, l, it - 128, lds + DM_OFF, lane); } }
    for (;;) {
        unsigned cq = 0; if (lane == 0) cq = __hip_atomic_fetch_add(qh, 1u, __ATOMIC_RELAXED, __HIP_MEMORY_SCOPE_AGENT);
        cq = (unsigned)__builtin_amdgcn_readfirstlane((int)cq);
        if (cq >= 16384u) break;
        if (cq < 8192u) { if (!(mixmask & 8)) continue; const int tb = 255 - (int)(cq >> 5), b = (int)(cq & 31u); const int m0 = b * SEQ + tb * 8;
#pragma unroll 1
            for (int k = 0; k < 2; ++k) {
#ifndef MIX_NO_B
                mixB_group(a, l, m0 + 4 * k, lds, wscr, lane, bmode);
#endif
            } }
        else { if (!(mixmask & 4)) continue;
#ifndef MIX_NO_A
            mixA_task(a, (int)(cq - 8192u), lds, wave, lane);
#endif
        }
    }
}

constexpr int RREC_OFF = MISC_OFF + 4096, LCNT_OFF = MISC_OFF + 10240, LBASE_OFF = MISC_OFF + 10368;
__device__ __forceinline__ void ln1_route_phase(const Args& a, int l, LAS unsigned char* lds, int bid, int G, int tid, int wave, int lane) {
    bf16* XB = (bf16*)(a.ws + WS_XB); const float* WRT = (const float*)(a.ws + WS_RT) + (size_t)l * 36 * 1024;
    unsigned* tokinfo = (unsigned*)(a.ws + WS_TOK); unsigned* cntg = (unsigned*)(a.ws + WS_CTL) + CW_CNT + (l * 32) * 64;
    const float* lng = a.in[21] + (l * 2 + 0) * 1024; const float* lnb = a.in[22] + (l * 2 + 0) * 1024;
    const float* brg = a.in[24] + l * 4; const float* bre = a.in[26] + l * 32;
    LAS float* sW = (LAS float*)lds;
    LAS unsigned* rrec = (LAS unsigned*)(lds + RREC_OFF); LAS int* lcnt = (LAS int*)(lds + LCNT_OFF); LAS unsigned* lbase = (LAS unsigned*)(lds + LBASE_OFF);
    for (int i = tid; i < 32 * 1024 / 4; i += NTHR) *(LAS f32x4*)(sW + 4 * i) = *(const f32x4*)(WRT + 4 * 1024 + 4 * i);
    f32x4 gam[4], bet[4], wg[4][4];
#pragma unroll
    for (int j = 0; j < 4; ++j) { gam[j] = *(const f32x4*)(lng + 4 * lane + 256 * j); bet[j] = *(const f32x4*)(lnb + 4 * lane + 256 * j);
#pragma unroll
        for (int e = 0; e < 4; ++e) wg[e][j] = *(const f32x4*)(WRT + e * 1024 + 4 * lane + 256 * j); }
    for (int blk = bid; blk < NTOK / 256; blk += G) {
        if (tid < 32) lcnt[tid] = 0;
        __syncthreads();
#pragma unroll 1
        for (int rg = 0; rg < 8; ++rg) {
            const int rl0 = wave * 32 + rg * 4; f32x4 x[4][4];
#pragma unroll
            for (int r = 0; r < 4; ++r) { bf16* xr = XB + (size_t)(blk * 256 + rl0 + r) * 1024; float s = 0.f;
#pragma unroll
                for (int j = 0; j < 4; ++j) { const u32x2 w = *(const u32x2*)(xr + 4 * lane + 256 * j); x[r][j] = (f32x4){bflo(w.x), bfhi(w.x), bflo(w.y), bfhi(w.y)}; s += (x[r][j][0] + x[r][j][1]) + (x[r][j][2] + x[r][j][3]); }
                const float mean = wave_sum(s) * (1.f / 1024.f); float q = 0.f;
#pragma unroll
                for (int j = 0; j < 4; ++j) { x[r][j] = x[r][j] - mean; q += (x[r][j][0] * x[r][j][0] + x[r][j][1] * x[r][j][1]) + (x[r][j][2] * x[r][j][2] + x[r][j][3] * x[r][j][3]); }
                const float rstd = rsqrtf(wave_sum(q) * (1.f / 1024.f) + LN_EPS);
#pragma unroll
                for (int j = 0; j < 4; ++j) { x[r][j] = x[r][j] * rstd * gam[j] + bet[j]; u32x2 w; w.x = pk2(x[r][j][0], x[r][j][1]); w.y = pk2(x[r][j][2], x[r][j][3]); *(u32x2*)(xr + 4 * lane + 256 * j) = w; }
                }
            float gl[4][4];
#pragma unroll
            for (int e = 0; e < 4; ++e)
#pragma unroll
                for (int r = 0; r < 4; ++r) { float d = 0.f;
#pragma unroll
                    for (int j = 0; j < 4; ++j) d += (x[r][j][0] * wg[e][j][0] + x[r][j][1] * wg[e][j][1]) + (x[r][j][2] * wg[e][j][2] + x[r][j][3] * wg[e][j][3]);
                    gl[r][e] = wave_sum(d) + brg[e]; }
#pragma unroll
            for (int r = 0; r < 4; ++r) {
                const float g0 = gl[r][0], g1 = gl[r][1], g2 = gl[r][2], g3 = gl[r][3];
                int gsv = 0; float gm = g0; if (g1 > gm) { gm = g1; gsv = 1; } if (g2 > gm) { gm = g2; gsv = 2; } if (g3 > gm) { gm = g3; gsv = 3; }
                const int gs = __builtin_amdgcn_readfirstlane(gsv);
                const float ptop = 1.f / (__expf(g0 - gm) + __expf(g1 - gm) + __expf(g2 - gm) + __expf(g3 - gm));
                float v0 = -INFINITY, v1 = -INFINITY; int i0 = 0, i1 = 0;
#pragma unroll 2
                for (int jj = 0; jj < 8; ++jj) { const int e = gs * 8 + jj; float d = 0.f;
#pragma unroll
                    for (int j = 0; j < 4; ++j) { const f32x4 w4 = *(const LAS f32x4*)(sW + e * 1024 + 4 * lane + 256 * j); d += (x[r][j][0] * w4[0] + x[r][j][1] * w4[1]) + (x[r][j][2] * w4[2] + x[r][j][3] * w4[3]); }
                    const float le = wave_sum(d) + bre[e];
                    if (le > v0) { v1 = v0; i1 = i0; v0 = le; i0 = jj; } else if (le > v1) { v1 = le; i1 = jj; } }
                const float ex = __expf(v1 - v0), w0 = ptop / (1.f + ex), w1 = ptop * ex / (1.f + ex);
                if (lane == 0) { const int e0 = gs * 8 + i0, e1 = gs * 8 + i1; const int rl = rl0 + r;
                    const int p0 = atomicAdd((int*)&lcnt[e0], 1), p1 = atomicAdd((int*)&lcnt[e1], 1);
                    rrec[rl * 6 + 0] = (unsigned)e0; rrec[rl * 6 + 1] = (unsigned)p0; rrec[rl * 6 + 2] = __float_as_uint(w0); rrec[rl * 6 + 3] = (unsigned)e1; rrec[rl * 6 + 4] = (unsigned)p1; rrec[rl * 6 + 5] = __float_as_uint(w1); } }
        }
        __syncthreads();
        if (tid < 32) lbase[tid] = __hip_atomic_fetch_add(cntg + tid * 64, (unsigned)lcnt[tid], __ATOMIC_RELAXED, __HIP_MEMORY_SCOPE_AGENT);
        __syncthreads();
        if (tid < 256) { const unsigned e0 = rrec[tid * 6 + 0], e1 = rrec[tid * 6 + 3]; unsigned* ti = tokinfo + (size_t)(blk * 256 + tid) * 8;
            u32x4 o0, o1; o0.x = e0; o0.y = lbase[e0] + rrec[tid * 6 + 1]; o0.z = rrec[tid * 6 + 2]; o0.w = e1; o1.x = lbase[e1] + rrec[tid * 6 + 4]; o1.y = rrec[tid * 6 + 5]; o1.z = 0u; o1.w = 0u;
            *(u32x4*)ti = o0; *(u32x4*)(ti + 4) = o1; }
        __syncthreads();
    }
}
__device__ __forceinline__ void moe_table(const Args& a, int l, LAS unsigned char* lds, int tid) {
    LAS int* tstart = (LAS int*)(lds + TST_OFF);
    if (tid < 64) { const unsigned* cntg = (const unsigned*)(a.ws + WS_CTL) + CW_CNT + (l * 32) * 64;
        int v = (tid < 32) ? (int)((__hip_atomic_load(cntg + tid * 64, __ATOMIC_RELAXED, __HIP_MEMORY_SCOPE_AGENT) + 255u) >> 8) : 0; const int mine = v;
#pragma unroll
        for (int o = 1; o < 32; o <<= 1) { const int u = __shfl_up(v, o); if ((tid & 63) >= o) v += u; }
        if (tid < 32) tstart[tid] = v - mine; if (tid == 31) tstart[32] = v; }
    __syncthreads();
}
__device__ __forceinline__ void scatter_phase(const Args& a, int l, LAS unsigned char* lds, int bid, int G, int tid, int gw, int NGW, int lane) {
    const LAS int* tstart = (const LAS int*)(lds + TST_OFF);
    const bf16* XB = (const bf16*)(a.ws + WS_XB); bf16* XS = (bf16*)(a.ws + WS_BIG); unsigned* rowinfo = (unsigned*)(a.ws + WS_ROW); const unsigned* tokinfo = (const unsigned*)(a.ws + WS_TOK);
    const unsigned* cntg = (const unsigned*)(a.ws + WS_CTL) + CW_CNT + (l * 32) * 64;
    for (int e = bid; e < 32; e += G) { const int c = (int)__hip_atomic_load(cntg + e * 64, __ATOMIC_RELAXED, __HIP_MEMORY_SCOPE_AGENT); const int r0 = tstart[e] * 256, r1 = tstart[e + 1] * 256;
        unsigned neg_ = 0xffffffffu, zer_ = 0u; asm volatile("" : "+v"(neg_), "+v"(zer_));
        for (int r = r0 + c + tid; r < r1; r += NTHR) { rowinfo[2 * (size_t)r] = neg_; rowinfo[2 * (size_t)r + 1] = zer_; } }
    u32x4 nt0; u32x2 nt1;
#define SC_LOAD(mm) do { nt0 = *(const u32x4*)(tokinfo + (size_t)(mm) * 8); nt1 = *(const u32x2*)(tokinfo + (size_t)(mm) * 8 + 4); } while (0)
    const int gt = gw * 64 + lane, NT = NGW * 64;
    for (int m = gt; m < NTOK; m += NT) {
        SC_LOAD(m); const u32x4 t0 = nt0; const u32x2 t1 = nt1;
        const size_t r0 = (size_t)tstart[t0.x] * 256 + t0.y, r1 = (size_t)tstart[t0.w] * 256 + t1.x;
        *(u32x2*)(rowinfo + 2 * r0) = (u32x2){(unsigned)(m * 2), t0.z}; *(u32x2*)(rowinfo + 2 * r1) = (u32x2){(unsigned)(m * 2 + 1), t1.y};
    }
#undef SC_LOAD
}
__device__ __forceinline__ void ln2_phase(const Args& a, int l, int gw, int NGW, int lane) {
    bf16* XB = (bf16*)(a.ws + WS_XB); const bf16* Y = (const bf16*)(a.ws + WS_BIG);
    const float* lng = a.in[21] + (l * 2 + 1) * 1024; const float* lnb = a.in[22] + (l * 2 + 1) * 1024;
    f32x4 gam[4], bet[4];
#pragma unroll
    for (int j = 0; j < 4; ++j) { gam[j] = *(const f32x4*)(lng + 4 * lane + 256 * j); bet[j] = *(const f32x4*)(lnb + 4 * lane + 256 * j); }
    u32x2 nw[4], np2[4], nq2[4];
#define LN2_LOAD(mm) do { const bf16* xr_ = XB + (size_t)(mm) * 1024 + 4 * lane; const bf16* y0_ = Y + (size_t)(mm) * 1024 + 4 * lane; const bf16* y1_ = Y + ((size_t)NTOK + (mm)) * 1024 + 4 * lane; \
        _Pragma("unroll") for (int j = 0; j < 4; ++j) { nw[j] = *(const u32x2*)(xr_ + 256 * j); np2[j] = *(const u32x2*)(y0_ + 256 * j); nq2[j] = *(const u32x2*)(y1_ + 256 * j); } } while (0)
    if (gw < NTOK) LN2_LOAD(gw);
    for (int m = gw; m < NTOK; m += NGW) {
        bf16* xr = XB + (size_t)m * 1024;
        u32x2 cw[4], cp2[4], cq2[4];
#pragma unroll
        for (int j = 0; j < 4; ++j) { cw[j] = nw[j]; cp2[j] = np2[j]; cq2[j] = nq2[j]; }
        if (m + NGW < NTOK) LN2_LOAD(m + NGW);
        f32x4 x[4]; float s = 0.f;
#pragma unroll
        for (int j = 0; j < 4; ++j) { const u32x2 w = cw[j], p = cp2[j], q = cq2[j];
            x[j] = (f32x4){DN_ALPHA * bflo(w.x) + (bflo(p.x) + bflo(q.x)), DN_ALPHA * bfhi(w.x) + (bfhi(p.x) + bfhi(q.x)), DN_ALPHA * bflo(w.y) + (bflo(p.y) + bflo(q.y)), DN_ALPHA * bfhi(w.y) + (bfhi(p.y) + bfhi(q.y))};
            s += (x[j][0] + x[j][1]) + (x[j][2] + x[j][3]); }
        const float mean = wave_sum(s) * (1.f / 1024.f); float q = 0.f;
#pragma unroll
        for (int j = 0; j < 4; ++j) { x[j] = x[j] - mean; q += (x[j][0] * x[j][0] + x[j][1] * x[j][1]) + (x[j][2] * x[j][2] + x[j][3] * x[j][3]); }
        const float rstd = rsqrtf(wave_sum(q) * (1.f / 1024.f) + LN_EPS);
#pragma unroll
        for (int j = 0; j < 4; ++j) { x[j] = x[j] * rstd * gam[j] + bet[j];
            if (l == NLAYER - 1) *(f32x4*)(a.out + (size_t)m * 1024 + 4 * lane + 256 * j) = x[j];
            else { u32x2 w; w.x = pk2(x[j][0], x[j][1]); w.y = pk2(x[j][2], x[j][3]); *(u32x2*)(xr + 4 * lane + 256 * j) = w; } }
    }
}

#ifndef MK_MULTI
#define MK_MULTI 0
#endif
constexpr int NPHASE = 12;
__global__ void __launch_bounds__(NTHR, 2) fwd(Args a) {
    extern __shared__ __attribute__((aligned(16))) unsigned char lds_raw[];
    LAS unsigned char* lds = (LAS unsigned char*)lds_raw;
    const int G0 = gridDim.x, bid0 = blockIdx.x, wave0 = __builtin_amdgcn_readfirstlane((int)(threadIdx.x >> 6));
#define PH_IDS unsigned on_ = ~0u; asm volatile("" : "+s"(on_)); int lz_ = (int)__builtin_amdgcn_mbcnt_hi(on_, __builtin_amdgcn_mbcnt_lo(on_, 0u)); int wz_ = wave0, bz_ = bid0, gz_ = G0; asm volatile("" : "+s"(wz_), "+s"(bz_), "+s"(gz_)); \
    const int lane = lz_, wave = wz_, tid = wz_ * 64 + lz_, bid = bz_, G = gz_, NGW = gz_ * NWAVES, gw = bid * NWAVES + wave; (void)lane; (void)gw; (void)wave; (void)tid; (void)NGW;
#define PH_ARGS(LV) const __attribute__((address_space(4))) Args* kp_ = (const __attribute__((address_space(4))) Args*)__builtin_amdgcn_kernarg_segment_ptr(); asm volatile("" : "+s"(kp_)); const Args& b = *(const Args*)kp_; int lq = (LV); asm volatile("" : "+s"(lq)); (void)lq; \
    bf16* XB = (bf16*)(b.ws + WS_XB); bf16* PB = (bf16*)(b.ws + WS_BIG); bf16* YS = (bf16*)((unsigned char*)b.out + DO_YS); bf16* MG = (bf16*)((unsigned char*)b.out + DO_MG); \
    unsigned* rowinfo = (unsigned*)(b.ws + WS_ROW); unsigned char* wl = b.ws + WS_W + (size_t)lq * WL_SIZE; (void)XB; (void)PB; (void)YS; (void)MG; (void)rowinfo; (void)wl;
    unsigned* ctl = (unsigned*)(a.ws + WS_CTL);
    { PH_IDS
    for (int u = tid; u < (LDS_BYTES - MISC_OFF) / 4; u += NTHR) ((LAS unsigned*)(lds + MISC_OFF))[u] = 0u;
    __syncthreads();
    for (int d = tid; d < 2048; d += NTHR) ((LAS unsigned char*)(lds + BKT_OFF))[d] = (unsigned char)t5_bucket(d);
    if (tid < 256) ((LAS float*)(lds + RPB_OFF))[tid] = a.in[1][tid];
    __syncthreads(); }
    XcdBarrier bar; bar.bar = ctl + CW_BAR; bar.x = 0; bar.st = nullptr;
    if (a.use_bar) bar = xcd_barrier_post(ctl + CW_BAR, (volatile LAS unsigned*)(lds + MISC_OFF) + 8);
#define GRID_BAR() do { if (a.use_bar) { const __attribute__((address_space(4))) Args* kq_ = (const __attribute__((address_space(4))) Args*)__builtin_amdgcn_kernarg_segment_ptr(); asm volatile("" : "+s"(kq_)); \
        XcdBarrier bb_ = bar; bb_.bar = (unsigned*)(kq_->ws + WS_CTL) + CW_BAR; xcd_barrier(bb_); } } while (0)
#ifndef PHMASK
#define PHMASK 0xFFF
#endif
#define IN(k) (((PHMASK >> (k)) & 1) && ((phm >> (k)) & 1u))

    unsigned phm = ((1u << a.ph_hi) - 1u) & ~((1u << a.ph_lo) - 1u);
    if (a.l_lo == 0 && IN(0)) { PH_IDS PH_ARGS(0) p0_prologue(b, lds, gw, NGW, wave, lane); GRID_BAR(); }
    for (int l = a.l_lo; l < a.l_hi; ++l) {
        asm volatile("" : "+s"(phm));
        if (IN(1)) { PH_IDS PH_ARGS(l) pg8::Gemm g{XB, (const bf16*)(wl + WL_IN), 1024, 1024, 1024}; pg8::GridOrder S; S.init(NTOK / 256, PW / 256, G, bid);
            pg8::EpiStoreBf16 E{PB, PW}; pg8::gemm_phase(lds, g, S, E, tid); GRID_BAR(); }
        if (IN(2)) { PH_IDS PH_ARGS(l) prep_phase(b, lq, lds, tid, gw, NGW, lane); GRID_BAR(); }
        if (IN(3)) { PH_IDS PH_ARGS(l) mixers_phase(b, lq, lds, bid, G, tid, wave, lane); GRID_BAR(); }
        if (IN(4)) { PH_IDS PH_ARGS(l) pg8::Gemm g{YS, (const bf16*)(wl + WL_BR), 1024, 256, 256}; pg8::GridOrder S; S.init(NTOK / 256, 16, G, bid, 4, 512);
            pg8::EpiStoreBf16 E{PB, 4096}; pg8::gemm_phase(lds, g, S, E, tid); GRID_BAR(); }
        if (IN(5)) { PH_IDS PH_ARGS(l) pg8::Gemm g{XB, (const bf16*)(wl + WL_IN) + (size_t)3072 * 1024, 1024, 1024, 1024}; pg8::GridOrder S; S.init(NTOK / 256, 16, G, bid);
            pg8::EpiGate E{PB, MG}; pg8::gemm_phase(lds, g, S, E, tid); GRID_BAR(); }
        if (IN(6)) { PH_IDS PH_ARGS(l) pg8::Gemm g{MG, (const bf16*)(wl + WL_OUT), 1024, 1024, 1024}; pg8::GridOrder S; S.init(NTOK / 256, 4, G, bid);
            pg8::EpiOut E{XB}; pg8::gemm_phase(lds, g, S, E, tid); GRID_BAR(); }
        if (IN(7)) { PH_IDS PH_ARGS(l) ln1_route_phase(b, lq, lds, bid, G, tid, wave, lane); GRID_BAR(); }
        if (IN(8)) { PH_IDS PH_ARGS(l) moe_table(b, lq, lds, tid); scatter_phase(b, lq, lds, bid, G, tid, gw, NGW, lane); GRID_BAR(); }
        if (IN(9)) { PH_IDS PH_ARGS(l) moe_table(b, lq, lds, tid); pg8::Gemm g{XB, (const bf16*)(wl + WL_GU), 1024, 1024, 1024}; pg8::MoeOrder S{(const LAS int*)(lds + TST_OFF), 1, G, bid};
            pg8::EpiUp E{rowinfo, (bf16*)(b.ws + WS_BIG + BIG_H)}; pg8::gemm_phase<pg8::EpiUp, pg8::MoeOrder, true>(lds, g, S, E, tid, rowinfo); GRID_BAR(); }
        if (IN(10)) { PH_IDS PH_ARGS(l) moe_table(b, lq, lds, tid); pg8::Gemm g{(const bf16*)(b.ws + WS_BIG + BIG_H), (const bf16*)(wl + WL_DN), 256, 256, 256}; pg8::MoeOrder S{(const LAS int*)(lds + TST_OFF), 2, G, bid};
            pg8::EpiDown E{rowinfo, PB}; pg8::gemm_phase(lds, g, S, E, tid); GRID_BAR(); }
        if (IN(11)) { PH_IDS PH_ARGS(l) ln2_phase(b, lq, gw, NGW, lane); if (l + 1 < a.l_hi) GRID_BAR(); }
    }
#undef IN
#undef GRID_BAR
}

extern "C" void kernel_launch(void* const* d_in, const int* in_sizes, int n_in, void* d_out, int out_size, void* d_ws, size_t ws_size, hipStream_t stream) {
    static int grid = 0;
    if (grid == 0) {
        if (n_in != 30 || out_size != NTOK * DM || ws_size < WS_END + 2 * MiB) { fprintf(stderr, "kernel_launch: unexpected shapes (n_in %d out %d ws %zu)\n", n_in, out_size, ws_size); grid = -1; return; }
        int dev = 0, cus = 0, per_cu = 0;
        if (hipGetDevice(&dev) != hipSuccess || hipDeviceGetAttribute(&cus, hipDeviceAttributeMultiprocessorCount, dev) != hipSuccess) { grid = -1; return; }
        if (hipFuncSetAttribute((const void*)fwd, hipFuncAttributeMaxDynamicSharedMemorySize, LDS_BYTES) != hipSuccess) { fprintf(stderr, "kernel_launch: hipFuncSetAttribute failed\n"); grid = -1; return; }
        if (hipOccupancyMaxActiveBlocksPerMultiprocessor(&per_cu, (const void*)fwd, NTHR, LDS_BYTES) != hipSuccess || per_cu < 1) fprintf(stderr, "kernel_launch: occupancy query says %d\n", per_cu);
        (void)hipGetLastError();
        grid = cus;
    }
    if (grid < 0) return;
    (void)hipMemsetAsync((char*)d_ws + WS_CTL, 0, CTL_ZERO_BYTES, stream);
    Args a{};
    for (int i = 0; i < 30; ++i) a.in[i] = (const float*)d_in[i];
    a.out = (float*)d_out; a.ws = (unsigned char*)d_ws; a.pad = 0;
#if MK_MULTI
    a.use_bar = 0;
    for (int l = 0; l < NLAYER; ++l)
        for (int ph = (l == 0 ? 0 : 1); ph < NPHASE; ++ph) { a.l_lo = l; a.l_hi = l + 1; a.ph_lo = ph; a.ph_hi = ph + 1;
            hipLaunchKernelGGL(fwd, dim3(grid), dim3(NTHR), LDS_BYTES, stream, a); }
#else
    a.use_bar = 1; a.l_lo = 0; a.l_hi = NLAYER; a.ph_lo = 0; a.ph_hi = NPHASE;
    hipLaunchKernelGGL(fwd, dim3(grid), dim3(NTHR), LDS_BYTES, stream, a);
#endif
    const hipError_t le = hipPeekAtLastError();
    if (le != hipSuccess) fprintf(stderr, "kernel_launch: launch failed: %s\n", hipGetErrorName(le));
}
```

```cpp
#include <hip/hip_runtime.h>
#include <cstdio>
#include <cstdint>

#define LAS __attribute__((address_space(3)))
#define GAS __attribute__((address_space(1)))
typedef unsigned short bf16;
typedef short bf16x8 __attribute__((ext_vector_type(8)));
typedef float f32x4 __attribute__((ext_vector_type(4)));
typedef float f32x2 __attribute__((ext_vector_type(2)));
typedef unsigned u32x4 __attribute__((ext_vector_type(4)));
typedef unsigned u32x2 __attribute__((ext_vector_type(2)));

namespace pg8 {
constexpr int BM = 256, BK = 64, HALF = 128, HTB = HALF * BK * 2  , STAGE_BYTES = 8 * HTB, NXCD = 8, WGM = 8;

__host__ __device__ __forceinline__ int lds_byte(int r, int c) { const int st = (r >> 4) * 2 + (c >> 5), rr = r & 15, cc = c & 31, ob = rr * 64 + cc * 2; return st * 1024 + (ob ^ (((ob >> 9) & 1) << 5)); }
__host__ __device__ __forceinline__ void stage_rc(int b, int& R, int& C) { const int st = b / 1024, sb = b % 1024, swz = sb ^ (((sb >> 9) & 1) << 5); R = (st >> 1) * 16 + swz / 64; C = (st & 1) * 32 + (swz % 64) / 2; }
__host__ __device__ __forceinline__ int perm32(int rho) { const int n = rho >> 4, i = rho & 15; return 8 * (i >> 2) + 4 * n + (i & 3); }

struct Unit { int pm, pn, pb; unsigned aoff; };
struct Gemm { const bf16* A; const bf16* Bt; int lda, ldb, K; };

struct GridOrder {
    int nM, nN, nwg, G, c, a_grp, a_grp_bytes;
    __device__ void init(int nM_, int nN_, int G_, int c_, int a_grp_ = 0, int a_grp_bytes_ = 0) { nM = nM_; nN = nN_; nwg = nM * nN; G = G_; c = c_; a_grp = a_grp_; a_grp_bytes = a_grp_bytes_; }
    __device__ bool next(int i, Unit& u) const {
        const long L = (long)i * G + c; if (L >= nwg) return false;
        int wgid = (int)L; { const int q = nwg / NXCD, r = nwg % NXCD, xcd = wgid % NXCD, off = wgid / NXCD; wgid = (xcd < r ? xcd * (q + 1) : r * (q + 1) + (xcd - r) * q) + off; }
        const int nig = WGM * nN, gid = wgid / nig, fm = gid * WGM, gsz = (nM - fm) < WGM ? (nM - fm) : WGM;
        u.pm = fm + ((wgid % nig) % gsz); u.pn = (wgid % nig) / gsz; u.pb = u.pn; u.aoff = a_grp ? (unsigned)((u.pn / a_grp) * a_grp_bytes) : 0u; return true;
    }
};
struct MoeOrder {
    const LAS int* tstart; int nsl, G, c;
    __device__ bool next(int i, Unit& u) const {
        const int L = i * G + c, total = tstart[32] << nsl; if (L >= total) return false;
        const int rt = L >> nsl, pn = L & ((1 << nsl) - 1); int e = 0;
        while (e < 31 && rt >= tstart[e + 1]) ++e;
        u.pm = rt; u.pn = pn; u.pb = (e << nsl) + pn; u.aoff = 0u; return true;
    }
};

__device__ __forceinline__ unsigned cvt_pk_bf16(float lo, float hi) { unsigned r; asm volatile("v_cvt_pk_bf16_f32 %0, %1, %2" : "=v"(r) : "v"(lo), "v"(hi)); return r; }

template <class Epi, class Sched, bool GATHER = false>
__device__ __forceinline__ void gemm_phase(LAS unsigned char* lds, const Gemm g, const Sched& S, const Epi& E, const int tid, const unsigned* rowtab = nullptr) {
    const int wid = __builtin_amdgcn_readfirstlane(tid >> 6), lane = tid & 63, wr = wid >> 2, wc = wid & 3, fr = lane & 15, fq = lane >> 4;
    const int K = g.K, nt = K / BK;
    unsigned voffA[2], voffB[2];
#pragma unroll
    for (int i = 0; i < 2; ++i) { int R, C; stage_rc(tid * 16 + i * 8192, R, C); const int Rb = Epi::PERM ? ((R & ~31) + perm32(R & 31)) : R;
        voffA[i] = (unsigned)(R * g.lda + C) * 2u; voffB[i] = (unsigned)(Rb * g.ldb + C) * 2u; }
    const size_t kstep = (size_t)(BK * 2);
    const size_t hstepA = (size_t)HALF * g.lda * 2, hstepB = (size_t)HALF * g.ldb * 2;
    const size_t tstepA = 2 * hstepA, tstepB = 2 * hstepB;
    const unsigned ldsw = (unsigned)wid * 1024u;
    const int aoff = lds_byte(wr * 64 + fr, fq * 8), boff = lds_byte(wc * 32 + fr, fq * 8);
#define PG8_SA(b, h) (((b) * 2 + (h)) * HTB)
#define PG8_SB(b, h) ((4 + (b) * 2 + (h)) * HTB)
#define PG8_STAGE(bufoff, gbase, voff) do { _Pragma("unroll") for (int _i = 0; _i < 2; ++_i) \
        __builtin_amdgcn_global_load_lds((const unsigned*)((const char*)(gbase) + (voff)[_i]), (LAS unsigned*)(lds + (bufoff) + ldsw + _i * 8192), 16, 0, 0); } while (0)
#define PG8_STAGE_A(bufoff, gbase, h) do { if constexpr (GATHER) { PG8_STAGE(bufoff, gbase, vgA[h]); } else { PG8_STAGE(bufoff, (gbase) + (h) * hstepA, voffA); } } while (0)
#define PG8_STAGE_AX(bufoff, gbase, h, useN) do { if constexpr (GATHER) { unsigned vs_[2] = {(useN) ? vgN[h][0] : vgA[h][0], (useN) ? vgN[h][1] : vgA[h][1]}; PG8_STAGE(bufoff, gbase, vs_); } else { PG8_STAGE(bufoff, (gbase) + (h) * hstepA, voffA); } } while (0)
#define PG8_LDA(dst, b, h) do { _Pragma("unroll") for (int m = 0; m < 4; ++m) _Pragma("unroll") for (int k = 0; k < 2; ++k) dst[m][k] = *(const LAS bf16x8*)(lds + PG8_SA(b, h) + aoff + m * 2048 + k * 1024); } while (0)
#define PG8_LDB(dst, b, h) do { _Pragma("unroll") for (int n = 0; n < 2; ++n) _Pragma("unroll") for (int k = 0; k < 2; ++k) dst[n][k] = *(const LAS bf16x8*)(lds + PG8_SB(b, h) + boff + n * 2048 + k * 1024); } while (0)
#define PG8_MMA(ai, bj, At, Bt) do { __builtin_amdgcn_s_setprio(1); _Pragma("unroll") for (int m = 0; m < 4; ++m) _Pragma("unroll") for (int n = 0; n < 2; ++n) _Pragma("unroll") for (int k = 0; k < 2; ++k) \
        acc[ai][bj][m][n] = __builtin_amdgcn_mfma_f32_16x16x32_bf16(Bt[n][k], At[m][k], acc[ai][bj][m][n], 0, 0, 0); __builtin_amdgcn_s_setprio(0); } while (0)
#define PG8_WAIT_V(n) asm volatile("s_waitcnt vmcnt(" #n ")" ::: "memory")
#define PG8_WAIT_L(n) asm volatile("s_waitcnt lgkmcnt(" #n ")" ::: "memory")
#define PG8_BAR __builtin_amdgcn_s_barrier()
#define PG8_SCHED __builtin_amdgcn_sched_barrier(0)
    Unit cur, nxt; int ui = 0;
    if (!S.next(0, cur)) return;
    unsigned vgA[2][2], vgN[2][2];
    int gR[2], gC[2];
#pragma unroll
    for (int i = 0; i < 2; ++i) stage_rc(tid * 16 + i * 8192, gR[i], gC[i]);
#define PG8_GOFF(DST, PM) do { if constexpr (GATHER) { _Pragma("unroll") for (int h_ = 0; h_ < 2; ++h_) _Pragma("unroll") for (int i_ = 0; i_ < 2; ++i_) { \
        const int ri_ = (int)rowtab[2 * ((size_t)(PM) * BM + h_ * HALF + gR[i_])]; const unsigned tok_ = ri_ < 0 ? 0u : (unsigned)ri_ >> 1; DST[h_][i_] = (tok_ * (unsigned)g.lda + (unsigned)gC[i_]) * 2u; } } } while (0)
    PG8_GOFF(vgA, cur.pm);
    f32x4 acc[2][2][4][2];
#pragma unroll
    for (int a = 0; a < 2; ++a)
#pragma unroll
        for (int b = 0; b < 2; ++b)
#pragma unroll
            for (int m = 0; m < 4; ++m)
#pragma unroll
                for (int n = 0; n < 2; ++n) acc[a][b][m][n] = (f32x4){0.f, 0.f, 0.f, 0.f};
    bf16x8 At[4][2], B0[2][2], B1[2][2];
    const char* cA = GATHER ? (const char*)g.A : (const char*)g.A + (size_t)cur.pm * tstepA + cur.aoff; const char* cB = (const char*)g.Bt + (size_t)cur.pb * tstepB;
    PG8_STAGE(PG8_SB(0, 0), cB, voffB); PG8_STAGE(PG8_SB(0, 1), cB + hstepB, voffB); PG8_STAGE_A(PG8_SA(0, 0), cA, 0); PG8_STAGE_A(PG8_SA(0, 1), cA, 1);
    if (wr == 1) PG8_BAR;
    PG8_WAIT_V(2); PG8_BAR;
    PG8_STAGE(PG8_SB(1, 0), cB + kstep, voffB); PG8_STAGE_A(PG8_SA(1, 0), cA + kstep, 0); PG8_STAGE(PG8_SB(1, 1), cB + hstepB + kstep, voffB);
    PG8_WAIT_V(6); PG8_BAR;
    for (;;) {
        const bool has_next = S.next(ui + 1, nxt);
        if (has_next) PG8_GOFF(vgN, nxt.pm); else { if constexpr (GATHER) { vgN[0][0] = vgA[0][0]; vgN[0][1] = vgA[0][1]; vgN[1][0] = vgA[1][0]; vgN[1][1] = vgA[1][1]; } }
        const char* nA = GATHER ? cA : (has_next ? (const char*)g.A + (size_t)nxt.pm * tstepA + nxt.aoff : cA); const char* nB = has_next ? (const char*)g.Bt + (size_t)nxt.pb * tstepB : cB;
        for (int t = 0; t < nt; t += 2) {
            const bool last = (t == nt - 2);
            const char* a1 = cA + (size_t)(t + 1) * kstep;
            const char* a2 = last ? nA : cA + (size_t)(t + 2) * kstep; const char* b2 = last ? nB : cB + (size_t)(t + 2) * kstep;
            const char* a3 = a2 + kstep; const char* b3 = b2 + kstep;
            PG8_LDB(B0, 0, 0); PG8_LDB(B1, 0, 1); PG8_SCHED; PG8_LDA(At, 0, 0); PG8_STAGE_AX(PG8_SA(1, 1), a1, 1, false);
            PG8_WAIT_V(8); PG8_WAIT_L(0); PG8_BAR; PG8_MMA(0, 0, At, B0); PG8_MMA(0, 1, At, B1); PG8_BAR; PG8_SCHED;
            PG8_LDA(At, 0, 1); PG8_STAGE(PG8_SB(0, 0), b2, voffB); PG8_STAGE(PG8_SB(0, 1), b2 + hstepB, voffB); PG8_STAGE_AX(PG8_SA(0, 0), a2, 0, last);
            PG8_WAIT_V(8); PG8_WAIT_L(0); PG8_BAR; PG8_MMA(1, 0, At, B0); PG8_MMA(1, 1, At, B1); PG8_BAR; PG8_SCHED;
            PG8_LDB(B0, 1, 0); PG8_LDB(B1, 1, 1); PG8_SCHED; PG8_LDA(At, 1, 0); PG8_STAGE_AX(PG8_SA(0, 1), a2, 1, last);
            PG8_WAIT_V(8); PG8_WAIT_L(0); PG8_BAR; PG8_MMA(0, 0, At, B0); PG8_MMA(0, 1, At, B1); PG8_BAR; PG8_SCHED;
            PG8_LDA(At, 1, 1); PG8_STAGE(PG8_SB(1, 0), b3, voffB); PG8_STAGE(PG8_SB(1, 1), b3 + hstepB, voffB); PG8_STAGE_AX(PG8_SA(1, 0), a3, 0, last);
            PG8_WAIT_V(8); PG8_WAIT_L(0); PG8_BAR; PG8_MMA(1, 0, At, B0); PG8_MMA(1, 1, At, B1); PG8_BAR; PG8_SCHED;
        }
        if (wr == 0) PG8_BAR;
        { unsigned on_ = ~0u; asm volatile("" : "+s"(on_)); const int lz_ = (int)__builtin_amdgcn_mbcnt_hi(on_, __builtin_amdgcn_mbcnt_lo(on_, 0u));
          E(acc, cur, wr, wc, lz_ & 15, lz_ >> 4); }
        if (!has_next) break;
#pragma unroll
        for (int a = 0; a < 2; ++a)
#pragma unroll
            for (int b = 0; b < 2; ++b)
#pragma unroll
                for (int m = 0; m < 4; ++m)
#pragma unroll
                    for (int n = 0; n < 2; ++n) acc[a][b][m][n] = (f32x4){0.f, 0.f, 0.f, 0.f};
        cur = nxt; cA = nA; cB = nB; ++ui;
        if constexpr (GATHER) { vgA[0][0] = vgN[0][0]; vgA[0][1] = vgN[0][1]; vgA[1][0] = vgN[1][0]; vgA[1][1] = vgN[1][1]; }
        if (wr == 1) PG8_BAR;
    }
    PG8_WAIT_V(0);
    PG8_BAR;
#undef PG8_SA
#undef PG8_STAGE_A
#undef PG8_STAGE_AX
#undef PG8_GOFF
#undef PG8_SB
#undef PG8_STAGE
#undef PG8_LDA
#undef PG8_LDB
#undef PG8_MMA
#undef PG8_WAIT_V
#undef PG8_WAIT_L
#undef PG8_BAR
#undef PG8_SCHED
}
}

constexpr int NTOK = 65536, DM = 1024, SEQ = 2048, NBATCH = 32, NLAYER = 4;
constexpr int PW = 3072;
constexpr int PC_AQ = 0, PC_AK = 256, PC_AV = 512, PC_BQ = 768, PC_CKV = 1024, PC_IQ = 1088, PC_IK = 1344, PC_IW = 1376,
              PC_CQ = 1384, PC_CK = 1512, PC_CV = 1640, PC_CA = 1896, PC_CG = 1912, PC_D = 2168;
constexpr int IN_W = 7096;
constexpr float LN_EPS = 1e-5f;
constexpr float DN_ALPHA = 1.6817928305074292f;
constexpr int NWAVES = 8, NTHR = 512;
constexpr int MOE_ROWS = 2 * NTOK + 32 * 256;

constexpr size_t MiB = 1u << 20;
constexpr size_t WS_CTL = 0, CTL_ZERO_BYTES = 1 * MiB;
constexpr size_t WS_TOK = 1 * MiB;
constexpr size_t WS_ROW = 3 * MiB;
constexpr size_t WS_BON = 5 * MiB;
constexpr size_t WS_RT = 6 * MiB;
constexpr size_t WS_CKVN = 8 * MiB;
constexpr size_t WS_CA = 16 * MiB;
constexpr size_t WS_W = 48 * MiB;
constexpr size_t WL_IN = 0, WL_BR = 14 * MiB, WL_OUT = 16 * MiB, WL_GU = 18 * MiB, WL_DN = 50 * MiB, WL_SIZE = 66 * MiB;
constexpr size_t WS_XB = 312 * MiB;
constexpr size_t WS_BIG = 440 * MiB;
constexpr size_t BIG_DW = 384 * MiB, BIG_DAI = 448 * MiB, BIG_DG = 480 * MiB;
constexpr size_t BIG_H = 272 * MiB;
constexpr size_t WS_END = 952 * MiB;
constexpr size_t DO_YS = 0, DO_MG = 128 * MiB, DO_DR = 128 * MiB, DO_DKP = 160 * MiB, DO_DV = 192 * MiB, DO_DKK = 224 * MiB;

constexpr int CW_TMO = 0, CW_CODE = 1;
constexpr int CW_BAR = 4096;
constexpr int CW_Q = 8192;
constexpr int CW_CNT = 16384;

constexpr int RING_BYTES = 131072;
constexpr int MISC_OFF = RING_BYTES;
constexpr int TST_OFF = MISC_OFF + 512;
constexpr int BKT_OFF = MISC_OFF + 1024;
constexpr int RPB_OFF = MISC_OFF + 3072;
constexpr int LDS_BYTES = 147456;

#define LDS_WAIT() asm volatile("s_waitcnt lgkmcnt(0)" ::: "memory")
#define VM_WAIT() asm volatile("s_waitcnt vmcnt(0)" ::: "memory")
__device__ __forceinline__ float bf2f(unsigned b) { return __uint_as_float(b << 16); }
__device__ __forceinline__ unsigned f2bf(float f) { unsigned u = __float_as_uint(f); return (u + 0x7fffu + ((u >> 16) & 1u)) >> 16; }
__device__ __forceinline__ unsigned pk2(float lo, float hi) { return f2bf(lo) | (f2bf(hi) << 16); }
__device__ __forceinline__ float bflo(unsigned w) { return __uint_as_float(w << 16); }
__device__ __forceinline__ float bfhi(unsigned w) { return __uint_as_float(w & 0xffff0000u); }
template <int CTRL> __device__ __forceinline__ float dppf(float v) {
    return __builtin_bit_cast(float, __builtin_amdgcn_update_dpp(0, __builtin_bit_cast(int, v), CTRL, 0xf, 0xf, true));
}
__device__ __forceinline__ float wave_sum(float v) {
    v += dppf<0x128>(v); v += dppf<0x124>(v); v += dppf<0x122>(v); v += dppf<0x121>(v);
    v += __shfl_xor(v, 16); v += __shfl_xor(v, 32); return v;
}
__device__ __forceinline__ float wave_max(float v) {
#pragma unroll
    for (int o = 1; o < 64; o <<= 1) v = fmaxf(v, __shfl_xor(v, o));
    return v;
}
__device__ __forceinline__ float sum8(float v) { v += dppf<0xB1>(v); v += dppf<0x4E>(v); v += dppf<0x141>(v); return v; }
__device__ __forceinline__ float sigmoidf_(float x) { return __builtin_amdgcn_rcpf(1.f + __expf(-x)); }
__device__ __forceinline__ float log_sigmoidf_(float z) { return fminf(z, 0.f) - __logf(1.f + __expf(-fabsf(z))); }

#define XB_TMO      128
#define XB_XCNT(j)  (256  + 64 * (j))
#define XB_XSUB(j)  (1280 + 64 * (j))
#define XB_XGEN(j)  (2304 + 64 * (j))
#define XB_TOP      3328
#define XB_TOPGEN   3392
#define XCD_BAR_WORDS 3456
#define XB_SPIN_CAP (1u << 22)

__device__ __forceinline__ unsigned xb_ld(unsigned* p)              { return __hip_atomic_load(p, __ATOMIC_RELAXED, __HIP_MEMORY_SCOPE_AGENT); }
__device__ __forceinline__ unsigned xb_add(unsigned* p, unsigned v) { return __hip_atomic_fetch_add(p, v, __ATOMIC_RELAXED, __HIP_MEMORY_SCOPE_AGENT); }
__device__ __forceinline__ unsigned xb_xcc_id() { return (unsigned)__builtin_amdgcn_s_getreg((3 << 11) | 20) & 0xFu; }
#define XB_SPIN(cond, bar) do { unsigned _sp = 0; while (cond) { __builtin_amdgcn_s_sleep(1); \
    if ((++_sp & 255u) == 0u) { if (xb_ld(&(bar)[XB_TMO])) break; if (_sp > XB_SPIN_CAP) { atomicAdd(&(bar)[XB_TMO], 1u); break; } } } } while (0)

struct XcdBarrier { unsigned* bar; unsigned x; volatile LAS unsigned* st; };

__device__ __forceinline__ XcdBarrier xcd_barrier_post(unsigned* bar, volatile LAS unsigned* st) {
    XcdBarrier b; b.bar = bar; b.x = xb_xcc_id(); b.st = st;
    if (threadIdx.x == 0) (void)xb_add(&bar[XB_XCNT(b.x)], 1u);
    return b;
}
__device__ __forceinline__ void xcd_barrier_complete(unsigned* bar, unsigned x, unsigned& nloc, unsigned& nx) {
    const unsigned G = gridDim.x * gridDim.y * gridDim.z;
    unsigned sum, cnt, mine, sp = 0u;
    for (;;) {
        sum = 0u; cnt = 0u; mine = 0u;
#pragma unroll
        for (unsigned j = 0; j < 16; ++j) { const unsigned c = xb_ld(&bar[XB_XCNT(j)]); sum += c; cnt += (c > 0u) ? 1u : 0u; mine = (j == x) ? c : mine; }
        if (sum == G) break;
        __builtin_amdgcn_s_sleep(1);
        if ((++sp & 255u) == 0u) { if (xb_ld(&bar[XB_TMO])) break; if (sp > XB_SPIN_CAP) { atomicAdd(&bar[XB_TMO], 1u); break; } }
    }
    nloc = mine > 0u ? mine : 1u; nx = cnt > 0u ? cnt : 1u;
}
__device__ __forceinline__ void xcd_barrier(const XcdBarrier& b) {
    asm volatile("s_waitcnt vmcnt(0)" ::: "memory");
    __syncthreads();
    if (threadIdx.x == 0) {
        unsigned* bar = b.bar;
        __builtin_amdgcn_s_waitcnt(0);
        unsigned nloc = b.st[0], nx = b.st[1];
        if (nloc == 0u) { xcd_barrier_complete(bar, b.x, nloc, nx); b.st[0] = nloc; b.st[1] = nx; }
        const unsigned old = xb_add(&bar[XB_XSUB(b.x)], 1u);
        const unsigned gen = old / nloc;
        if (old + 1u == (gen + 1u) * nloc) {
            __builtin_amdgcn_fence(__ATOMIC_RELEASE, "agent");
            asm volatile("s_waitcnt vmcnt(0)" ::: "memory");
            const unsigned og = xb_add(&bar[XB_TOP], 1u);
            const unsigned tg = og / nx;
            if (og + 1u == (tg + 1u) * nx) xb_add(&bar[XB_TOPGEN], 1u);
            else XB_SPIN(xb_ld(&bar[XB_TOPGEN]) == tg, bar);
            __builtin_amdgcn_fence(__ATOMIC_ACQUIRE, "agent");
            xb_add(&bar[XB_XGEN(b.x)], 1u);
            asm volatile("s_waitcnt vmcnt(0)" ::: "memory");
        } else {
            XB_SPIN(xb_ld(&bar[XB_XGEN(b.x)]) == gen, bar);
            __builtin_amdgcn_fence(__ATOMIC_ACQUIRE, "agent");
            asm volatile("s_waitcnt vmcnt(0)" ::: "memory");
        }
    }
    __syncthreads();
}

__device__ __forceinline__ int t5_bucket(int d) {
    if (d < 16) return d;
    int b = 16;
    b += (d >= 22) + (d >= 30) + (d >= 40) + (d >= 54) + (d >= 73) + (d >= 99) + (d >= 134) + (d >= 182) + (d >= 246) + (d >= 332) + (d >= 450) + (d >= 609) + (d >= 825) + (d >= 1117) + (d >= 1513);
    return b;
}
struct Args { const float* in[30]; float* out; unsigned char* ws; int l_lo, l_hi, ph_lo, ph_hi, use_bar, pad; };

namespace pg8 {
struct EpiStoreBf16 {
    static constexpr bool PERM = true;
    bf16* O; int ldc;
    __device__ __forceinline__ void operator()(const f32x4 (&acc)[2][2][4][2], const Unit& u, int wr, int wc, int fr, int fq) const {
        const int row0 = u.pm * BM + wr * 64 + fr, col0 = u.pn * BM + wc * 32 + 8 * fq;
#pragma unroll
        for (int ai = 0; ai < 2; ++ai)
#pragma unroll
            for (int m = 0; m < 4; ++m) { bf16* rowp = O + (size_t)(row0 + ai * HALF + m * 16) * ldc + col0;
#pragma unroll
                for (int bj = 0; bj < 2; ++bj) { const f32x4 v0 = acc[ai][bj][m][0], v1 = acc[ai][bj][m][1];
                    u32x4 w; w.x = cvt_pk_bf16(v0[0], v0[1]); w.y = cvt_pk_bf16(v0[2], v0[3]); w.z = cvt_pk_bf16(v1[0], v1[1]); w.w = cvt_pk_bf16(v1[2], v1[3]);
                    *(u32x4*)(rowp + bj * HALF) = w; } }
    }
};
struct EpiGate {
    static constexpr bool PERM = false;
    const bf16* BR; bf16* MG;
    __device__ __forceinline__ void operator()(const f32x4 (&acc)[2][2][4][2], const Unit& u, int wr, int wc, int fr, int fq) const {
        const int row0 = u.pm * BM + wr * 64 + fr, j0 = u.pn * 64 + wc * 16 + 4 * fq;
#pragma unroll
        for (int ai = 0; ai < 2; ++ai)
#pragma unroll
            for (int m = 0; m < 4; ++m) { const size_t r = (size_t)(row0 + ai * HALF + m * 16);
                float mg0 = 0.f, mg1 = 0.f, mg2 = 0.f, mg3 = 0.f;
#pragma unroll
                for (int bj = 0; bj < 2; ++bj)
#pragma unroll
                    for (int n = 0; n < 2; ++n) { const int g = 2 * bj + n; const u32x2 b = *(const u32x2*)(BR + r * 4096 + g * 1024 + j0); const f32x4 a = acc[ai][bj][m][n];
                        mg0 += sigmoidf_(a[0]) * bflo(b.x); mg1 += sigmoidf_(a[1]) * bfhi(b.x); mg2 += sigmoidf_(a[2]) * bflo(b.y); mg3 += sigmoidf_(a[3]) * bfhi(b.y); }
                u32x2 w; w.x = cvt_pk_bf16(mg0, mg1); w.y = cvt_pk_bf16(mg2, mg3);
                *(u32x2*)(MG + r * 1024 + j0) = w; }
    }
};
struct EpiOut {
    static constexpr bool PERM = true;
    bf16* XB;
    __device__ __forceinline__ void operator()(const f32x4 (&acc)[2][2][4][2], const Unit& u, int wr, int wc, int fr, int fq) const {
        const int row0 = u.pm * BM + wr * 64 + fr, col0 = u.pn * BM + wc * 32 + 8 * fq;
#pragma unroll
        for (int ai = 0; ai < 2; ++ai)
#pragma unroll
            for (int m = 0; m < 4; ++m) { bf16* rowp = XB + (size_t)(row0 + ai * HALF + m * 16) * 1024 + col0;
#pragma unroll
                for (int bj = 0; bj < 2; ++bj) { const f32x4 v0 = acc[ai][bj][m][0], v1 = acc[ai][bj][m][1]; const u32x4 x = *(const u32x4*)(rowp + bj * HALF);
                    u32x4 w; w.x = cvt_pk_bf16(DN_ALPHA * bflo(x.x) + v0[0], DN_ALPHA * bfhi(x.x) + v0[1]); w.y = cvt_pk_bf16(DN_ALPHA * bflo(x.y) + v0[2], DN_ALPHA * bfhi(x.y) + v0[3]);
                    w.z = cvt_pk_bf16(DN_ALPHA * bflo(x.z) + v1[0], DN_ALPHA * bfhi(x.z) + v1[1]); w.w = cvt_pk_bf16(DN_ALPHA * bflo(x.w) + v1[2], DN_ALPHA * bfhi(x.w) + v1[3]);
                    *(u32x4*)(rowp + bj * HALF) = w; } }
    }
};
struct EpiUp {
    static constexpr bool PERM = true;
    const unsigned* rowinfo; bf16* H;
    __device__ __forceinline__ void operator()(const f32x4 (&acc)[2][2][4][2], const Unit& u, int wr, int wc, int fr, int fq) const {
        const int row0 = u.pm * BM + wr * 64 + fr, col0 = u.pn * 128 + wc * 32 + 8 * fq;
#pragma unroll
        for (int ai = 0; ai < 2; ++ai)
#pragma unroll
            for (int m = 0; m < 4; ++m) { const size_t r = (size_t)(row0 + ai * HALF + m * 16); const float w = __uint_as_float(rowinfo[2 * r + 1]);
                const f32x4 g0 = acc[ai][0][m][0], g1 = acc[ai][0][m][1], u0 = acc[ai][1][m][0], u1 = acc[ai][1][m][1];
                float h[8];
#pragma unroll
                for (int e = 0; e < 4; ++e) { h[e] = g0[e] * sigmoidf_(g0[e]) * u0[e] * w; h[4 + e] = g1[e] * sigmoidf_(g1[e]) * u1[e] * w; }
                u32x4 o; o.x = cvt_pk_bf16(h[0], h[1]); o.y = cvt_pk_bf16(h[2], h[3]); o.z = cvt_pk_bf16(h[4], h[5]); o.w = cvt_pk_bf16(h[6], h[7]);
                *(u32x4*)(H + r * 256 + col0) = o; }
    }
};
struct EpiDown {
    static constexpr bool PERM = true;
    const unsigned* rowinfo; bf16* Y;
    __device__ __forceinline__ void operator()(const f32x4 (&acc)[2][2][4][2], const Unit& u, int wr, int wc, int fr, int fq) const {
        const int row0 = u.pm * BM + wr * 64 + fr, col0 = u.pn * BM + wc * 32 + 8 * fq;
#pragma unroll
        for (int ai = 0; ai < 2; ++ai)
#pragma unroll
            for (int m = 0; m < 4; ++m) { const size_t r = (size_t)(row0 + ai * HALF + m * 16); const int ri = (int)rowinfo[2 * r];
                if (ri >= 0) { bf16* rowp = Y + ((size_t)(ri & 1) * NTOK + (size_t)(ri >> 1)) * 1024 + col0;
#pragma unroll
                    for (int bj = 0; bj < 2; ++bj) { const f32x4 v0 = acc[ai][bj][m][0], v1 = acc[ai][bj][m][1];
                        u32x4 w; w.x = cvt_pk_bf16(v0[0], v0[1]); w.y = cvt_pk_bf16(v0[2], v0[3]); w.z = cvt_pk_bf16(v1[0], v1[1]); w.w = cvt_pk_bf16(v1[2], v1[3]);
                        *(u32x4*)(rowp + bj * HALF) = w; } } }
    }
};
}

struct RowMap { int kind, base, g, off;
    __device__ __forceinline__ int operator()(int n) const {
        if (kind == 0) return base + n;
        if (kind == 1) { const int j = base + n, jj = j & 63, pn = j >> 6; return 3072 + pn * 256 + 128 * (g >> 1) + 32 * (jj >> 4) + 16 * (g & 1) + 4 * ((jj >> 2) & 3) + (jj & 3); }
        const int h = base + n; return (h >> 7) * 256 + off + (h & 127);
    }
};
__device__ __forceinline__ void transpose_item(const float* W, int ldw, int k0, int scol0, int nvalid, bf16* WT, int ldk, const RowMap& rm, LAS float* scr, int lane) {
    const int nn = lane & 31;
#pragma unroll 8
    for (int i = 0; i < 32; ++i) { const int kk = 2 * i + (lane >> 5); scr[kk * 33 + nn] = (nn < nvalid) ? W[(size_t)(k0 + kk) * ldw + scol0 + nn] : 0.f; }
    LDS_WAIT(); asm volatile("" ::: "memory");
    const int c = lane & 7;
#pragma unroll
    for (int j = 0; j < 4; ++j) { const int n = (lane >> 3) + 8 * j; const LAS float* s = scr + (8 * c) * 33 + n;
        u32x4 o; o.x = pk2(s[0 * 33], s[1 * 33]); o.y = pk2(s[2 * 33], s[3 * 33]); o.z = pk2(s[4 * 33], s[5 * 33]); o.w = pk2(s[6 * 33], s[7 * 33]);
        *(u32x4*)(WT + (size_t)rm(n) * ldk + k0 + 8 * c) = o; }
    LDS_WAIT(); asm volatile("" ::: "memory");
}
__device__ __forceinline__ void p0_prologue(const Args& a, LAS unsigned char* lds, int gw, int NGW, int wave, int lane) {
    LAS float* scr = (LAS float*)(lds + wave * 16384);
    constexpr int IPL = 16896;
    for (int it = gw; it < NLAYER * IPL; it += NGW) {
        const int l = it / IPL; int r = it - l * IPL;
        unsigned char* wl = a.ws + WS_W + (size_t)l * WL_SIZE;
        RowMap rm; rm.kind = 0; rm.base = 0; rm.g = 0; rm.off = 0;
        if (r < 1536) { const int nt = r % 96, kt = r / 96, n0 = 32 * nt; int nv = 3000 - n0; nv = nv < 0 ? 0 : (nv > 32 ? 32 : nv); rm.base = n0;
            transpose_item(a.in[2] + (size_t)l * 1024 * IN_W, IN_W, 64 * kt, n0, nv, (bf16*)(wl + WL_IN), 1024, rm, scr, lane); continue; }
        r -= 1536;
        if (r < 2048) { const int nt = r % 128, kt = r / 128, gc0 = 32 * nt; rm.kind = 1; rm.g = gc0 >> 10; rm.base = gc0 & 1023;
            transpose_item(a.in[2] + (size_t)l * 1024 * IN_W, IN_W, 64 * kt, 3000 + gc0, 32, (bf16*)(wl + WL_IN), 1024, rm, scr, lane); continue; }
        r -= 2048;
        if (r < 512) { const int nb = r / 128, rr = r % 128, nt = rr % 32, kt = rr / 32; rm.base = nb * 1024 + 32 * nt;
            if (nb != 1) transpose_item(a.in[19] + (size_t)(l * 4 + nb) * 256 * 1024, 1024, 64 * kt, 32 * nt, 32, (bf16*)(wl + WL_BR), 256, rm, scr, lane); continue; }
        r -= 512;
        if (r < 512) { const int nt = r % 32, kt = r / 32; rm.base = 32 * nt;
            transpose_item(a.in[20] + (size_t)l * 1024 * 1024, 1024, 64 * kt, 32 * nt, 32, (bf16*)(wl + WL_OUT), 1024, rm, scr, lane); continue; }
        r -= 512;
        if (r < 8192) { const int up = r >= 4096; if (up) r -= 4096; const int e = r / 128, rr = r % 128, nt = rr % 8, kt = rr / 8; rm.kind = 2; rm.base = 32 * nt; rm.off = up ? 128 : 0;
            transpose_item(a.in[up ? 28 : 27] + (size_t)(l * 32 + e) * 1024 * 256, 256, 64 * kt, 32 * nt, 32, (bf16*)(wl + WL_GU) + (size_t)e * 512 * 1024, 1024, rm, scr, lane); continue; }
        r -= 8192;
        { const int e = r / 128, rr = r % 128, nt = rr % 32, kt = rr / 32; rm.base = 32 * nt;
            transpose_item(a.in[29] + (size_t)(l * 32 + e) * 256 * 1024, 1024, 64 * kt, 32 * nt, 32, (bf16*)(wl + WL_DN) + (size_t)e * 1024 * 256, 256, rm, scr, lane); }
    }
    { float* WRT = (float*)(a.ws + WS_RT); const int gt = gw * 64 + lane, NT = NGW * 64;
      for (int i = gt; i < NLAYER * 4 * 64 * 1024; i += NT) { const int j = i & 1023, c = (i >> 10) & 63, h = (i >> 16) & 3, l = i >> 18;
          const float* wu = a.in[4] + ((size_t)(l * 4 + h) * 64 + c) * 64; const float* wb = a.in[19] + ((size_t)(l * 4 + 1) * 256 + h * 64) * 1024 + j; float acc = 0.f;
#pragma unroll 8
          for (int d = 0; d < 64; ++d) acc += wu[d] * wb[(size_t)d * 1024];
          ((bf16*)(a.ws + WS_W + (size_t)l * WL_SIZE + WL_BR))[(size_t)(1024 + j) * 256 + h * 64 + c] = (bf16)f2bf(acc); }
      for (int i = gt; i < NLAYER * 36 * 1024; i += NT) { const int k = i & 1023, e = (i >> 10) % 36, l = i / (36 * 1024);
          WRT[i] = e < 4 ? a.in[23][((size_t)l * 1024 + k) * 4 + e] : a.in[25][((size_t)l * 1024 + k) * 32 + (e - 4)]; }
      const f32x4* xs = (const f32x4*)a.in[0]; u32x4* xd = (u32x4*)(a.ws + WS_XB);
      for (int i = gt; i < NTOK * DM / 8; i += NT) { const f32x4 v0 = xs[2 * i], v1 = xs[2 * i + 1]; u32x4 o; o.x = pk2(v0[0], v0[1]); o.y = pk2(v0[2], v0[3]); o.z = pk2(v1[0], v1[1]); o.w = pk2(v1[2], v1[3]); xd[i] = o; } }
}

__device__ __forceinline__ float softplusf_(float x) { return fmaxf(x, 0.f) + __logf(1.f + __expf(-fabsf(x))); }
__device__ __forceinline__ float tanhf_(float x) { const float e = __expf(-2.f * fabsf(x)); const float t = (1.f - e) * __builtin_amdgcn_rcpf(1.f + e); return x < 0.f ? -t : t; }
__device__ __forceinline__ void prep_phase(const Args& a, int l, LAS unsigned char* lds, int tid, int gw, int NGW, int lane, const int pmode = 7) {
    const int wave = __builtin_amdgcn_readfirstlane(tid >> 6);
    const bf16* P = (const bf16*)(a.ws + WS_BIG);
    bf16* CKVN = (bf16*)(a.ws + WS_CKVN); bf16* CQH = (bf16*)(a.ws + WS_CA); bf16* CKT = (bf16*)(a.ws + WS_CA + 16 * MiB); float* CCL = (float*)(a.ws + WS_END); float* BON = (float*)(a.ws + WS_BON);
    bf16* DR = (bf16*)((unsigned char*)a.out + DO_DR); bf16* DKP = (bf16*)((unsigned char*)a.out + DO_DKP); bf16* DV = (bf16*)((unsigned char*)a.out + DO_DV); bf16* DKK = (bf16*)((unsigned char*)a.out + DO_DKK);
    float* DW = (float*)(a.ws + WS_BIG + BIG_DW); bf16* DAI = (bf16*)(a.ws + WS_BIG + BIG_DAI); bf16* DG = (bf16*)(a.ws + WS_BIG + BIG_DG);
    const float* kvg = a.in[3] + l * 64; const float* aup = a.in[5] + l * 16 * 128; const float* abias = a.in[6] + l * 128;
    const float* mu = a.in[8] + l * 832; const float* w0 = a.in[9] + l * 256; const float* w2 = a.in[10] + l * 16 * 256; const float* a0 = a.in[11] + l * 256;
    const float* a2 = a.in[12] + l * 16 * 256; const float* g2 = a.in[13] + l * 32 * 256; const float* kkw = a.in[14] + l * 256; const float* kaw = a.in[15] + l * 256; const float* rkw = a.in[16] + l * 256;
    LAS float* sW2 = (LAS float*)lds; LAS float* sA2 = (LAS float*)(lds + 16384); LAS float* sG2 = (LAS float*)(lds + 32768); LAS float* sUP = (LAS float*)(lds + 65536);
    for (int i = tid; i < 4096; i += NTHR) { sW2[i] = w2[i]; sA2[i] = a2[i]; }
    for (int i = tid; i < 8192; i += NTHR) sG2[i] = g2[i];
    for (int i = tid; i < 2048; i += NTHR) sUP[i] = aup[i];
    __syncthreads();
    float mu_r[13], w0_r[4], a0_r[4], kk_r[4], ka_r[4], rk_r[4];
#pragma unroll
    for (int i = 0; i < 13; ++i) mu_r[i] = mu[64 * i + lane];
#pragma unroll
    for (int i = 0; i < 4; ++i) { const int c = 64 * i + lane; w0_r[i] = w0[c]; a0_r[i] = a0[c]; kk_r[i] = kkw[c]; ka_r[i] = kaw[c]; rk_r[i] = rkw[c]; }
    const float kvg_r = kvg[lane], ab0 = abias[lane], ab1 = abias[64 + lane];
    unsigned short nc[13], np_[13], nckv, nca, nq0, nq1, nk0, nk1;
#define PREP_LOAD(mm) do { const bf16* pr_ = P + (size_t)(mm) * PW; \
        _Pragma("unroll") for (int i = 0; i < 13; ++i) nc[i] = pr_[PC_D + 64 * i + lane]; nckv = pr_[PC_CKV + lane]; nca = pr_[PC_CA + (lane & 15)]; nq0 = pr_[PC_CQ + lane]; nq1 = pr_[PC_CQ + 64 + lane]; nk0 = pr_[PC_CK + lane]; nk1 = pr_[PC_CK + 64 + lane]; } while (0)
    constexpr int NCK = NTOK / 16;
    float* DCL = DW;
#define PREP_LOADP(mm) do { const int tt_ = (mm) & (SEQ - 1); const bf16* pp_ = P + (size_t)(mm) * PW - (tt_ > 0 ? PW : 0); _Pragma("unroll") for (int i = 0; i < 13; ++i) np_[i] = pp_[PC_D + 64 * i + lane]; } while (0)
    if (gw < NCK) { PREP_LOAD(gw * 16); PREP_LOADP(gw * 16); }
    for (int ck = gw; ck < NCK; ck += NGW) {
      float cpr[4] = {1.f, 1.f, 1.f, 1.f}; float cprc0 = 1.f, cprc1 = 1.f;
#pragma unroll 1
      for (int tt = 0; tt < 16; ++tt) {
        const int m = ck * 16 + tt;
        const int t = m & (SEQ - 1);
        unsigned short cc_[13], cp_[13];
#pragma unroll
        for (int i = 0; i < 13; ++i) { cc_[i] = nc[i]; cp_[i] = np_[i]; np_[i] = nc[i]; }
        const unsigned short cckv = nckv, cca = nca, cq0 = nq0, cq1 = nq1, ck0 = nk0, ck1 = nk1;
        if (tt < 15) PREP_LOAD(m + 1); else if (ck + NGW < NCK) { PREP_LOAD((ck + NGW) * 16); PREP_LOADP((ck + NGW) * 16); }
        { const float x = bf2f(cckv); const float ss = wave_sum(x * x); const float rn = rsqrtf(ss * (1.f / 64.f) + 1e-6f); CKVN[(size_t)m * 64 + lane] = (bf16)f2bf(x * rn * kvg_r); }
        { const float cav = (lane < 16) ? bf2f(cca) : 0.f; float z0 = ab0, z1 = ab1;
#pragma unroll
          for (int i = 0; i < 16; ++i) { const float cv = __builtin_bit_cast(float, __builtin_amdgcn_readlane(__builtin_bit_cast(int, cav), i)); z0 += cv * sUP[i * 128 + lane]; z1 += cv * sUP[i * 128 + 64 + lane]; }
          cprc0 *= __expf(log_sigmoidf_(z0) * (1.f / 16.f)); cprc1 *= __expf(log_sigmoidf_(z1) * (1.f / 16.f));
          CQH[(size_t)m * 128 + lane] = (bf16)f2bf(bf2f(cq0) * cprc0); CQH[(size_t)m * 128 + 64 + lane] = (bf16)f2bf(bf2f(cq1) * cprc1);
          CKT[(size_t)m * 128 + lane] = (bf16)f2bf(bf2f(ck0) * __builtin_amdgcn_rcpf(cprc0)); CKT[(size_t)m * 128 + 64 + lane] = (bf16)f2bf(bf2f(ck1) * __builtin_amdgcn_rcpf(cprc1));
          if (tt == 15) { CCL[(size_t)ck * 128 + lane] = cprc0; CCL[(size_t)ck * 128 + 64 + lane] = cprc1; } }
        float xs[13];
#pragma unroll
        for (int i = 0; i < 13; ++i) { const float cur = bf2f(cc_[i]); const float prev = (t > 0) ? bf2f(cp_[i]) : 0.f; xs[i] = cur + (prev - cur) * mu_r[i]; }
        const float low = xs[12], tw = tanhf_(low), sg = sigmoidf_(low);
        float wr_[4], ar_[4], gv_[4];
#pragma unroll
        for (int i = 0; i < 4; ++i) { wr_[i] = w0_r[i]; ar_[i] = a0_r[i]; gv_[i] = 0.f; }
#define RDL(V, J) __builtin_bit_cast(float, __builtin_amdgcn_readlane(__builtin_bit_cast(int, V), (J)))
#pragma unroll 4
        for (int j = 0; j < 16; ++j) { const float tj = RDL(tw, j), aj = RDL(low, 16 + j);
#pragma unroll
            for (int i = 0; i < 4; ++i) { wr_[i] += tj * sW2[j * 256 + 64 * i + lane]; ar_[i] += aj * sA2[j * 256 + 64 * i + lane]; } }
#pragma unroll 4
        for (int j = 0; j < 32; ++j) { const float sj = RDL(sg, 32 + j);
#pragma unroll
            for (int i = 0; i < 4; ++i) gv_[i] += sj * sG2[j * 256 + 64 * i + lane]; }
#undef RDL
#pragma unroll
        for (int i = 0; i < 4; ++i) { const int c = 64 * i + lane;
            const float w_raw = -softplusf_(-wr_[i]) - 0.5f, wdec = __expf(-__expf(w_raw));
            const float av = sigmoidf_(ar_[i]);
            const float kx = xs[4 + i]; float kkv = kx * kk_r[i]; const float nrm = sqrtf(wave_sum(kkv * kkv)); kkv = kkv * __builtin_amdgcn_rcpf(fmaxf(nrm, 1e-12f));
            const float kp = kx * (1.f + (av - 1.f) * ka_r[i]);
            const float rx = xs[i], vx = xs[8 + i];
            const float bon = wave_sum(rx * kp * rk_r[i]);
            const size_t o = (size_t)m * 256 + c;
            const float ahat = -kkv * cpr[i]; cpr[i] *= wdec; const float cinv = __builtin_amdgcn_rcpf(cpr[i]);
            DR[o] = (bf16)f2bf(rx * cpr[i]); DKP[o] = (bf16)f2bf(kp * cinv); DV[o] = (bf16)f2bf(vx); DKK[o] = (bf16)f2bf(ahat); DAI[o] = (bf16)f2bf(kkv * av * cinv); DG[o] = (bf16)f2bf(gv_[i]);
            if (tt == 15) DCL[(size_t)ck * 256 + c] = cpr[i];
            if (lane == 0) BON[(size_t)m * 4 + i] = bon; }
      }
    }
#undef PREP_LOAD
#undef PREP_LOADP
    __syncthreads();
}

typedef float f32x16 __attribute__((ext_vector_type(16)));
typedef short s16x4 __attribute__((ext_vector_type(4)));
typedef short v4i16_t __attribute__((ext_vector_type(4)));
typedef float f32x2_t __attribute__((ext_vector_type(2))); typedef __bf16 bf16x2_t __attribute__((ext_vector_type(2)));
__device__ __forceinline__ unsigned cvtpk_s(float lo, float hi) { f32x2_t v = {lo, hi}; bf16x2_t b = __builtin_convertvector(v, bf16x2_t); return __builtin_bit_cast(unsigned, b); }
__device__ __forceinline__ s16x4 vtr(const LAS unsigned char* p) { return __builtin_bit_cast(s16x4, __builtin_amdgcn_ds_read_tr16_b64_v4i16((LAS v4i16_t*)p)); }
constexpr int ATB_OFF = 102400;
constexpr int AVI_OFF = 3584;
constexpr float LOG2E = 1.4426950408889634f;
__device__ __forceinline__ void mixA_tables(const Args& a, LAS unsigned char* lds, int tid) {
    LAS float* tb = (LAS float*)(lds + ATB_OFF);
    for (int i = tid; i < 3 * 4 * 192; i += NTHR) { const int e = i % 192, h = (i / 192) & 3, f = i / 768; const int dist = 159 - e; const int dl = f == 0 ? 16 : (f == 1 ? 4 : 1);
        float v = -INFINITY;
        if (dist >= 0 && dist <= 128) { int dd = dist * dl; dd = dd > 2047 ? 2047 : dd; v = a.in[1][t5_bucket(dd) * 8 + h] * LOG2E; }
        tb[i] = v; }
}
__device__ __forceinline__ void mixA_task(const Args& a, int task, LAS unsigned char* lds, int wave, int lane_in) {
    int lane = lane_in; asm volatile("" : "+v"(lane));
    const bf16* P = (const bf16*)(a.ws + WS_BIG); bf16* YS = (bf16*)((unsigned char*)a.out + DO_YS);
    const int cc = 3 - (task & 3), r = (task >> 2) & 15, h = (task >> 6) & 3, b = task >> 8;
    const int ql = lane & 31, hh = lane >> 5, n0 = 32 * cc;
    const size_t rowb = (size_t)b * SEQ; const int tq = 16 * (n0 + ql) + r;
    const LAS float* tball = (const LAS float*)(lds + ATB_OFF) + h * 192;
    LAS unsigned char* vimg = lds + AVI_OFF + wave * 12800;
    bf16x8 qf[4];
    { const bf16* qp = P + (rowb + tq) * PW + PC_AQ + h * 64 + 8 * hh;
#pragma unroll
      for (int ks = 0; ks < 4; ++ks) qf[ks] = *(const bf16x8*)(qp + 16 * ks); }
    f32x16 o0, o1;
#pragma unroll
    for (int i = 0; i < 16; ++i) { o0[i] = 0.f; o1[i] = 0.f; }
    float m = -INFINITY, lsum = 0.f;
    const float SC = 0.125f * LOG2E;
    const int vst = (lane >> 1) * 144 + (lane & 1) * 64;
    const int i16 = lane & 15, tq4 = i16 >> 2, tp = i16 & 3, g16 = (lane >> 4) & 1;
    const int vrd = (4 * hh + tq4) * 144 + 32 * g16 + 8 * tp;
#pragma unroll 1
    for (int f = 0; f < 3; ++f) {
        const int dsh = f == 0 ? 4 : (f == 1 ? 2 : 0);
        const int rho = r & ((1 << dsh) - 1);
        const int qpos = (tq - rho) >> dsh;
        const int qmin = (16 * n0 + r - rho) >> dsh, qmax = (16 * (n0 + 31) + r - rho) >> dsh;
        int klo = qmin - 128; klo = klo < 0 ? 0 : klo; klo &= ~31;
        const LAS float* tbf = tball + f * 768;
        bf16x8 kA[4], kB[4]; u32x4 vA0, vA1, vA2, vA3, vB0, vB1, vB2, vB3;
#define A_LOAD(KF, W0, W1, W2, W3, KK0) do { const size_t tk_ = rowb + (((size_t)((KK0) + ql)) << dsh) + rho; const bf16* kp_ = P + tk_ * PW + PC_AK + h * 64 + 8 * hh; \
            _Pragma("unroll") for (int ks = 0; ks < 4; ++ks) KF[ks] = *(const bf16x8*)(kp_ + 16 * ks); \
            const size_t tv_ = rowb + (((size_t)((KK0) + (lane >> 1))) << dsh) + rho; const u32x4* vp_ = (const u32x4*)(P + tv_ * PW + PC_AV + h * 64 + 32 * (lane & 1)); \
            W0 = vp_[0]; W1 = vp_[1]; W2 = vp_[2]; W3 = vp_[3]; } while (0)
#define A_TILE(KF, W0, W1, W2, W3, K0) do { \
            f32x16 st; \
            _Pragma("unroll") for (int i = 0; i < 16; ++i) st[i] = 0.f; \
            _Pragma("unroll") for (int ks = 0; ks < 4; ++ks) st = __builtin_amdgcn_mfma_f32_32x32x16_bf16(KF[ks], qf[ks], st, 0, 0, 0); \
            *(LAS u32x4*)(vimg + vst) = W0; *(LAS u32x4*)(vimg + vst + 16) = W1; *(LAS u32x4*)(vimg + vst + 32) = W2; *(LAS u32x4*)(vimg + vst + 48) = W3; \
            __builtin_amdgcn_sched_barrier(0); \
            if ((K0) - 64 >= klo) A_LOAD(KF, W0, W1, W2, W3, (K0) - 64); \
            __builtin_amdgcn_sched_barrier(0); \
            const int D0 = qpos - (K0) - 4 * hh; const int e0 = (D0 >= 0 && D0 <= 159) ? 159 - D0 : 0; \
            const LAS float* tp_ = tbf + e0; \
            float mx = -INFINITY; \
            _Pragma("unroll") for (int i = 0; i < 16; ++i) { st[i] = st[i] * SC + tp_[(i & 3) + 8 * (i >> 2)]; mx = fmaxf(mx, st[i]); } \
            mx = fmaxf(mx, __shfl_xor(mx, 32)); \
            const float mn = fmaxf(m, mx), alpha = __builtin_amdgcn_exp2f(m - mn); \
            m = mn; float ps = 0.f; \
            _Pragma("unroll") for (int i = 0; i < 16; ++i) { st[i] = __builtin_amdgcn_exp2f(st[i] - mn); ps += st[i]; } \
            lsum = lsum * alpha + ps; \
            _Pragma("unroll") for (int i = 0; i < 16; ++i) { o0[i] *= alpha; o1[i] *= alpha; } \
            bf16x8 pf[2]; \
            _Pragma("unroll") for (int s = 0; s < 2; ++s) { u32x4 w; w.x = cvtpk_s(st[8 * s], st[8 * s + 1]); w.y = cvtpk_s(st[8 * s + 2], st[8 * s + 3]); w.z = cvtpk_s(st[8 * s + 4], st[8 * s + 5]); w.w = cvtpk_s(st[8 * s + 6], st[8 * s + 7]); pf[s] = __builtin_bit_cast(bf16x8, w); } \
            asm volatile("s_waitcnt lgkmcnt(0)" ::: "memory"); \
            _Pragma("unroll") for (int s = 0; s < 2; ++s) { \
                const s16x4 a00 = vtr(vimg + vrd + (16 * s) * 144), a01 = vtr(vimg + vrd + (16 * s + 8) * 144); \
                const s16x4 a10 = vtr(vimg + vrd + (16 * s) * 144 + 64), a11 = vtr(vimg + vrd + (16 * s + 8) * 144 + 64); \
                const bf16x8 A0 = (bf16x8){a00[0], a00[1], a00[2], a00[3], a01[0], a01[1], a01[2], a01[3]}; \
                const bf16x8 A1 = (bf16x8){a10[0], a10[1], a10[2], a10[3], a11[0], a11[1], a11[2], a11[3]}; \
                o0 = __builtin_amdgcn_mfma_f32_32x32x16_bf16(A0, pf[s], o0, 0, 0, 0); \
                o1 = __builtin_amdgcn_mfma_f32_32x32x16_bf16(A1, pf[s], o1, 0, 0, 0); } \
            asm volatile("s_waitcnt lgkmcnt(0)" ::: "memory"); } while (0)
        int k0 = qmax & ~31;
        A_LOAD(kA, vA0, vA1, vA2, vA3, k0);
        if (k0 - 32 >= klo) A_LOAD(kB, vB0, vB1, vB2, vB3, k0 - 32);
#pragma unroll 1
        while (k0 >= klo) {
            A_TILE(kA, vA0, vA1, vA2, vA3, k0);
            k0 -= 32; if (k0 < klo) break;
            A_TILE(kB, vB0, vB1, vB2, vB3, k0);
            k0 -= 32;
        }
#undef A_TILE
#undef A_LOAD
    }
    const float lt = lsum + __shfl_xor(lsum, 32); const float inv = 1.f / lt;
    bf16* yo = YS + (rowb + tq) * 1024 + h * 64 + 4 * hh;
#pragma unroll
    for (int g = 0; g < 4; ++g) {
        u32x2 w; w.x = cvtpk_s(o0[4 * g] * inv, o0[4 * g + 1] * inv); w.y = cvtpk_s(o0[4 * g + 2] * inv, o0[4 * g + 3] * inv); *(u32x2*)(yo + 8 * g) = w;
        u32x2 x; x.x = cvtpk_s(o1[4 * g] * inv, o1[4 * g + 1] * inv); x.y = cvtpk_s(o1[4 * g + 2] * inv, o1[4 * g + 3] * inv); *(u32x2*)(yo + 32 + 8 * g) = x; }
}

__device__ __forceinline__ unsigned fkey(float f) { const unsigned u = __float_as_uint(f); return (u & 0x80000000u) ? ~u : (u | 0x80000000u); }
typedef float f32x4v __attribute__((ext_vector_type(4)));
__device__ __forceinline__ void mixB_attend(const Args& a, int m, const LAS unsigned short* sidx, const LAS unsigned char* sbk, int nsel, LAS unsigned char* lds, LAS unsigned char* img, int lane) {
    const bf16* P = (const bf16*)(a.ws + WS_BIG); const bf16* CKVN = (const bf16*)(a.ws + WS_CKVN); bf16* YS = (bf16*)((unsigned char*)a.out + DO_YS);
    const LAS float* rpb = (const LAS float*)(lds + RPB_OFF);
    const int t = m & (SEQ - 1); const size_t rowb = (size_t)(m - t); const bf16* prow = P + (size_t)m * PW;
    const int hc = lane & 15, g = lane >> 4, hd = lane & 3;
    bf16x8 qB[2];
    { const bf16x8 z = (bf16x8){0, 0, 0, 0, 0, 0, 0, 0}; const bf16* qp = prow + PC_BQ + hd * 64 + 8 * g;
      const bf16x8 q0 = *(const bf16x8*)(qp), q1 = *(const bf16x8*)(qp + 32); qB[0] = hc < 4 ? q0 : z; qB[1] = hc < 4 ? q1 : z; }
    f32x4v oT[4];
#pragma unroll
    for (int mt = 0; mt < 4; ++mt) oT[mt] = (f32x4v){0.f, 0.f, 0.f, 0.f};
    float mrun = -INFINITY, lsum = 0.f;
    const float SC = 0.125f * LOG2E;
    const int i16 = lane & 15, tq4 = i16 >> 2, tp = i16 & 3;
    const int rd_row = (lane & 15) * 144 + 16 * g;
    const int rd_tr = (4 * g + tq4) * 144 + 8 * tp;
    u32x4 g0, g1, g2, g3, g4, g5, g6, g7;
#define BG_LOAD(CH) do { const int kk_ = 64 * (CH) + lane; const int idx_ = (int)sidx[kk_ < nsel ? kk_ : 0] & (SEQ - 1); const u32x4* cp_ = (const u32x4*)(CKVN + (rowb + idx_) * 64); \
        g0 = cp_[0]; g1 = cp_[1]; g2 = cp_[2]; g3 = cp_[3]; g4 = cp_[4]; g5 = cp_[5]; g6 = cp_[6]; g7 = cp_[7]; } while (0)
    BG_LOAD(0);
#pragma unroll 1
    for (int ch = 0; ch < 4; ++ch) {
        if (64 * ch >= nsel) break;
        { LAS u32x4* ip = (LAS u32x4*)(img + lane * 144); ip[0] = g0; ip[1] = g1; ip[2] = g2; ip[3] = g3; ip[4] = g4; ip[5] = g5; ip[6] = g6; ip[7] = g7; }
        if (64 * (ch + 1) < nsel) BG_LOAD(ch + 1);
        asm volatile("s_waitcnt lgkmcnt(0)" ::: "memory");
        f32x4v st[4];
        float mx = -INFINITY;
#pragma unroll
        for (int kt = 0; kt < 4; ++kt) {
            const bf16x8 a0 = *(const LAS bf16x8*)(img + rd_row + (16 * kt) * 144), a1 = *(const LAS bf16x8*)(img + rd_row + (16 * kt) * 144 + 64);
            f32x4v acc = (f32x4v){0.f, 0.f, 0.f, 0.f};
            acc = __builtin_amdgcn_mfma_f32_16x16x32_bf16(a0, qB[0], acc, 0, 0, 0);
            acc = __builtin_amdgcn_mfma_f32_16x16x32_bf16(a1, qB[1], acc, 0, 0, 0);
            const int kb = 64 * ch + 16 * kt + 4 * g;
            const unsigned bk4 = *(const LAS unsigned*)(sbk + kb);
#pragma unroll
            for (int i = 0; i < 4; ++i) { const int bk = (bk4 >> (8 * i)) & 0xff; const float bias = rpb[bk * 8 + 4 + hd] * LOG2E;
                const float v = (kb + i < nsel) ? acc[i] * SC + bias : -INFINITY; acc[i] = v; mx = fmaxf(mx, v); }
            st[kt] = acc; }
        mx = fmaxf(mx, __shfl_xor(mx, 16)); mx = fmaxf(mx, __shfl_xor(mx, 32));
        const float mn = fmaxf(mrun, mx), alpha = __builtin_amdgcn_exp2f(mrun - mn); mrun = mn;
        float ps = 0.f;
#pragma unroll
        for (int kt = 0; kt < 4; ++kt)
#pragma unroll
            for (int i = 0; i < 4; ++i) { st[kt][i] = __builtin_amdgcn_exp2f(st[kt][i] - mn); ps += st[kt][i]; }
        lsum = lsum * alpha + ps;
#pragma unroll
        for (int mt = 0; mt < 4; ++mt) oT[mt] = oT[mt] * alpha;
#pragma unroll
        for (int ks2 = 0; ks2 < 2; ++ks2) {
            u32x4 w; w.x = cvtpk_s(st[2 * ks2][0], st[2 * ks2][1]); w.y = cvtpk_s(st[2 * ks2][2], st[2 * ks2][3]); w.z = cvtpk_s(st[2 * ks2 + 1][0], st[2 * ks2 + 1][1]); w.w = cvtpk_s(st[2 * ks2 + 1][2], st[2 * ks2 + 1][3]);
            const bf16x8 pB = __builtin_bit_cast(bf16x8, w);
#pragma unroll
            for (int mt = 0; mt < 4; ++mt) {
                const s16x4 lo = vtr(img + rd_tr + (32 * ks2) * 144 + 32 * mt), hi = vtr(img + rd_tr + (32 * ks2 + 16) * 144 + 32 * mt);
                const bf16x8 A = (bf16x8){lo[0], lo[1], lo[2], lo[3], hi[0], hi[1], hi[2], hi[3]};
                oT[mt] = __builtin_amdgcn_mfma_f32_16x16x32_bf16(A, pB, oT[mt], 0, 0, 0); } }
        asm volatile("s_waitcnt lgkmcnt(0)" ::: "memory");
    }
#undef BG_LOAD
    float lt = lsum; lt += __shfl_xor(lt, 16); lt += __shfl_xor(lt, 32);
    const float inv = 1.f / lt;
    if (hc < 4) { bf16* yo = YS + (size_t)m * 1024 + 256 + hc * 64 + 4 * g;
#pragma unroll
        for (int mt = 0; mt < 4; ++mt) { u32x2 w; w.x = cvtpk_s(oT[mt][0] * inv, oT[mt][1] * inv); w.y = cvtpk_s(oT[mt][2] * inv, oT[mt][3] * inv); *(u32x2*)(yo + 16 * mt) = w; } }
}
__device__ __forceinline__ void mixB_group(const Args& a, int l, int m0, LAS unsigned char* lds, LAS unsigned char* wscr, int lane_in, const int bmode = 15) {
    int lane = lane_in; asm volatile("" : "+v"(lane));
    const bf16* P = (const bf16*)(a.ws + WS_BIG);
    const int t0 = m0 & (SEQ - 1); const size_t rowb = (size_t)(m0 - t0);
    const int ql = lane & 31, hh = lane >> 5;
    LAS unsigned short* sidx = (LAS unsigned short*)wscr;
    LAS unsigned char* sbk = wscr + 2048;
    LAS unsigned char* img = wscr + 3584;
    const LAS unsigned char* bkt = lds + BKT_OFF;
    bf16x8 qf[2];
    { const int rho = ql, qi = 2 * ((rho >> 2) & 1) + (rho >> 4), hd = 4 * ((rho >> 3) & 1) + (rho & 3);
      const bf16* ip = P + (size_t)(m0 + qi) * PW + PC_IQ + hd * 32 + 8 * hh;
      qf[0] = *(const bf16x8*)(ip); qf[1] = *(const bf16x8*)(ip + 16); }
    float iw[2][8];
#pragma unroll
    for (int qq = 0; qq < 2; ++qq) { const u32x4 w = *(const u32x4*)(P + (size_t)(m0 + 2 * hh + qq) * PW + PC_IW); const float s = 0.0625f;
        iw[qq][0] = bflo(w.x) * s; iw[qq][1] = bfhi(w.x) * s; iw[qq][2] = bflo(w.y) * s; iw[qq][3] = bfhi(w.y) * s; iw[qq][4] = bflo(w.z) * s; iw[qq][5] = bfhi(w.z) * s; iw[qq][6] = bflo(w.w) * s; iw[qq][7] = bfhi(w.w) * s; }
    const int tq0 = t0 + 2 * hh;
    const int ntile = ((t0 + 3) >> 5) + 1;
    unsigned sk[2][64];
#pragma unroll
    for (int kb4 = 0; kb4 < 32; ++kb4) {
        if (2 * kb4 < ntile && (bmode & 1)) {
            bf16x8 kf0[2], kf1[2];
#pragma unroll
            for (int k4 = 0; k4 < 2; ++k4) { const int s = 32 * (2 * kb4 + k4) + ql; const bf16* kp = P + (rowb + s) * PW + PC_IK + 8 * hh; kf0[k4] = *(const bf16x8*)(kp); kf1[k4] = *(const bf16x8*)(kp + 16); }
#pragma unroll
            for (int k4 = 0; k4 < 2; ++k4) { const int kt = 2 * kb4 + k4; const int s = 32 * kt + ql;
                f32x16 acc;
#pragma unroll
                for (int i = 0; i < 16; ++i) acc[i] = 0.f;
                acc = __builtin_amdgcn_mfma_f32_32x32x16_bf16(qf[0], kf0[k4], acc, 0, 0, 0);
                acc = __builtin_amdgcn_mfma_f32_32x32x16_bf16(qf[1], kf1[k4], acc, 0, 0, 0);
                float s0 = 0.f, s1 = 0.f;
#pragma unroll
                for (int i = 0; i < 8; ++i) { s0 += fmaxf(acc[i], 0.f) * iw[0][i]; s1 += fmaxf(acc[8 + i], 0.f) * iw[1][i]; }
                sk[0][kt] = (s <= tq0) ? fkey(s0) : 0x007fffffu; sk[1][kt] = (s <= tq0 + 1) ? fkey(s1) : 0x007fffffu; }
        } else {
#pragma unroll
            for (int k4 = 0; k4 < 2; ++k4) { sk[0][2 * kb4 + k4] = 0x007fffffu; sk[1][2 * kb4 + k4] = 0x007fffffu; }
        }
    }
    const unsigned ltm = (1u << ql) - 1u;
    const int nblk8 = (ntile + 7) >> 3;
#define SK_RED(C) do { C += __builtin_amdgcn_update_dpp(0, C, 0x128, 0xf, 0xf, true); C += __builtin_amdgcn_update_dpp(0, C, 0x124, 0xf, 0xf, true); \
        C += __builtin_amdgcn_update_dpp(0, C, 0x122, 0xf, 0xf, true); C += __builtin_amdgcn_update_dpp(0, C, 0x121, 0xf, 0xf, true); C += __shfl_xor(C, 16); } while (0)
#define SK_COUNT2(OP, R0, R1, C0, C1) do { _Pragma("unroll") for (int kb8 = 0; kb8 < 8; ++kb8) { if (kb8 < nblk8) { _Pragma("unroll") for (int k8 = 0; k8 < 8; ++k8) { \
        C0 += (sk[0][8 * kb8 + k8] OP (R0)) ? 1 : 0; C1 += (sk[1][8 * kb8 + k8] OP (R1)) ? 1 : 0; } } } SK_RED(C0); SK_RED(C1); } while (0)
    unsigned KthA[2] = {0u, 0u}; int needA[2] = {0, 0};
    const bool big0 = (tq0 + 1 > 256), big1 = (tq0 + 2 > 256); bool exact = true;
    if (__any(big0 || big1) && (bmode & 2)) {
        exact = false;
#pragma unroll 1
        for (int bit = 31; bit >= 0; --bit) { const unsigned c0 = KthA[0] | (1u << bit), c1 = KthA[1] | (1u << bit); int n0 = 0, n1 = 0;
            SK_COUNT2(>=, c0, c1, n0, n1);
            if (n0 >= 256) KthA[0] = c0;
            if (n1 >= 256) KthA[1] = c1;
            if (__all((n0 == 256 || !big0) && (n1 == 256 || !big1))) { exact = true; break; }
        }
        if (!exact) { int g0 = 0, g1 = 0; SK_COUNT2(>, KthA[0], KthA[1], g0, g1); needA[0] = 256 - g0; needA[1] = 256 - g1; }
    }
#pragma unroll
    for (int qq = 0; qq < 2; ++qq) {
        if (!(bmode & 4)) break;
        const int tq = tq0 + qq; const bool big = qq ? big1 : big0; const unsigned Kth = KthA[qq]; const int need = needA[qq];
        LAS unsigned short* sx = sidx + (2 * hh + qq) * 256;
        int base = 0, tie_taken = 0; int ql2 = ql; asm volatile("" : "+v"(ql2));
#pragma unroll
        for (int kb8 = 0; kb8 < 8; ++kb8) { if (kb8 < nblk8) {
#pragma unroll
            for (int k8 = 0; k8 < 8; ++k8) { const int kt = 8 * kb8 + k8; const int s = 32 * kt + ql2; const unsigned k = sk[qq][kt]; bool take;
                if (!big) take = (s <= tq);
                else if (exact) take = (k >= Kth);
                else { const bool tie = (k == Kth); const unsigned long long mt = __ballot(tie); const unsigned mt32 = hh ? (unsigned)(mt >> 32) : (unsigned)mt;
                    take = (k > Kth) || (tie && (tie_taken + __popc(mt32 & ltm)) < need); tie_taken += __popc(mt32); }
                const unsigned long long ms = __ballot(take); const unsigned ms32 = hh ? (unsigned)(ms >> 32) : (unsigned)ms;
                if (take) sx[base + __popc(ms32 & ltm)] = (unsigned short)s;
                base += __popc(ms32); } } }
    }
#undef SK_COUNT2
#undef SK_RED
    LDS_WAIT(); asm volatile("" ::: "memory");
#pragma unroll
    for (int qi = 0; qi < 4; ++qi) { const int tq = t0 + qi; const int nsel = (tq + 1 < 256) ? tq + 1 : 256;
#pragma unroll
        for (int j = 0; j < 4; ++j) { const int pos = lane + 64 * j; if (pos < nsel) sbk[qi * 256 + pos] = bkt[tq - (int)sidx[qi * 256 + pos]]; } }
    LDS_WAIT(); asm volatile("" ::: "memory");
#pragma unroll 1
    for (int qi = 0; qi < 4; ++qi) { if (!(bmode & 8)) break; const int tq = t0 + qi; const int nsel = (tq + 1 < 256) ? tq + 1 : 256;
        mixB_attend(a, m0 + qi, sidx + qi * 256, sbk + qi * 256, nsel, lds, img, lane); asm volatile("" ::: "memory"); }
}
constexpr int DM_OFF = 111616;
__device__ __forceinline__ bf16x8 frag2(const LAS unsigned char* p0, const LAS unsigned char* p1) {
    const s16x4 lo = *(const LAS s16x4*)p0, hi = *(const LAS s16x4*)p1; return (bf16x8){lo[0], lo[1], lo[2], lo[3], hi[0], hi[1], hi[2], hi[3]}; }
__device__ __forceinline__ bf16x8 fragtr(const LAS unsigned char* p0, const LAS unsigned char* p1) {
    const s16x4 lo = vtr(p0), hi = vtr(p1); return (bf16x8){lo[0], lo[1], lo[2], lo[3], hi[0], hi[1], hi[2], hi[3]}; }
__device__ __forceinline__ bf16x8 packf(f32x4 lo, f32x4 hi) { u32x4 w; w.x = cvtpk_s(lo[0], lo[1]); w.y = cvtpk_s(lo[2], lo[3]); w.z = cvtpk_s(hi[0], hi[1]); w.w = cvtpk_s(hi[2], hi[3]); return __builtin_bit_cast(bf16x8, w); }
__device__ __forceinline__ void dchunk_wave(const Args& a, int l, int bh, LAS unsigned char* dm, int lane_in) {
    int lane = lane_in; asm volatile("" : "+v"(lane));
    const int b = bh >> 2, h = bh & 3, hc = lane & 15, g = lane >> 4;
    LAS unsigned char* sAT = dm; LAS unsigned char* sBT = dm + 2304; LAS unsigned char* sKT = dm + 4608; LAS unsigned char* sRT = dm + 6912; LAS unsigned char* sVT = dm + 9216; LAS unsigned char* sUT = dm + 11520;
    LAS float* sW1 = (LAS float*)(dm + 13824); LAS float* sMB = (LAS float*)(dm + 17920); LAS float* sCL = (LAS float*)(dm + 18944); LAS float* sBON = (LAS float*)(dm + 19200);
    const bf16* DR = (const bf16*)((unsigned char*)a.out + DO_DR); const bf16* DKP = (const bf16*)((unsigned char*)a.out + DO_DKP); const bf16* DV = (const bf16*)((unsigned char*)a.out + DO_DV); const bf16* DKK = (const bf16*)((unsigned char*)a.out + DO_DKK);
    const float* DCL = (const float*)(a.ws + WS_BIG + BIG_DW); const bf16* DAI = (const bf16*)(a.ws + WS_BIG + BIG_DAI); const bf16* DG = (const bf16*)(a.ws + WS_BIG + BIG_DG);
    const float* BON = (const float*)(a.ws + WS_BON); bf16* YS = (bf16*)((unsigned char*)a.out + DO_YS);
    float gnw[4], gnb[4];
#pragma unroll
    for (int vt = 0; vt < 4; ++vt) { gnw[vt] = a.in[17][l * 256 + h * 64 + 16 * vt + hc]; gnb[vt] = a.in[18][l * 256 + h * 64 + 16 * vt + hc]; }
    const size_t tok0 = (size_t)b * SEQ;
    f32x4v T[4][4];
#pragma unroll
    for (int kt = 0; kt < 4; ++kt)
#pragma unroll
        for (int vt = 0; vt < 4; ++vt) T[kt][vt] = (f32x4v){0.f, 0.f, 0.f, 0.f};
    const int lrow = lane >> 3, lseg = lane & 7;
    u32x4 nA0, nA1, nB0, nB1, nK0, nK1, nR0, nR1, nV0, nV1; float nCL, nBON;
#define DC_LOAD(CH) do { const size_t e0_ = (tok0 + (size_t)(CH) * 16 + lrow) * 256 + h * 64 + 8 * lseg, e1_ = e0_ + 8 * 256; \
        nA0 = *(const u32x4*)(DKK + e0_); nA1 = *(const u32x4*)(DKK + e1_); nB0 = *(const u32x4*)(DAI + e0_); nB1 = *(const u32x4*)(DAI + e1_); nK0 = *(const u32x4*)(DKP + e0_); nK1 = *(const u32x4*)(DKP + e1_); \
        nR0 = *(const u32x4*)(DR + e0_); nR1 = *(const u32x4*)(DR + e1_); nV0 = *(const u32x4*)(DV + e0_); nV1 = *(const u32x4*)(DV + e1_); \
        nCL = DCL[((size_t)b * (SEQ / 16) + (CH)) * 256 + h * 64 + lane]; nBON = BON[(tok0 + (size_t)(CH) * 16 + (lane & 15)) * 4 + h]; } while (0)
    DC_LOAD(0);
    const int st0 = lrow * 144 + lseg * 16, st1 = st0 + 8 * 144;
    const int rdf = hc * 144 + 8 * g;
    const int rdt = (4 * g + (hc >> 2)) * 144 + 8 * (hc & 3);
    __builtin_amdgcn_s_setprio(2);
#pragma unroll 1
    for (int ch = 0; ch < SEQ / 16; ++ch) {
        *(LAS u32x4*)(sAT + st0) = nA0; *(LAS u32x4*)(sAT + st1) = nA1; *(LAS u32x4*)(sBT + st0) = nB0; *(LAS u32x4*)(sBT + st1) = nB1; *(LAS u32x4*)(sKT + st0) = nK0; *(LAS u32x4*)(sKT + st1) = nK1;
        *(LAS u32x4*)(sRT + st0) = nR0; *(LAS u32x4*)(sRT + st1) = nR1; *(LAS u32x4*)(sVT + st0) = nV0; *(LAS u32x4*)(sVT + st1) = nV1; sCL[lane] = nCL; if (lane < 16) sBON[lane] = nBON;
        unsigned short gq[4][4];
#pragma unroll
        for (int vt = 0; vt < 4; ++vt)
#pragma unroll
            for (int i = 0; i < 4; ++i) gq[vt][i] = DG[(tok0 + (size_t)ch * 16 + 4 * g + i) * 256 + h * 64 + 16 * vt + hc];
        asm volatile("s_waitcnt lgkmcnt(0)" ::: "memory");
        bf16x8 fA[2], fR[2], fB[2], fK[2];
#pragma unroll
        for (int ks = 0; ks < 2; ++ks) { fA[ks] = frag2(sAT + rdf + 64 * ks, sAT + rdf + 64 * ks + 32); fR[ks] = frag2(sRT + rdf + 64 * ks, sRT + rdf + 64 * ks + 32);
            fB[ks] = frag2(sBT + rdf + 64 * ks, sBT + rdf + 64 * ks + 32); fK[ks] = frag2(sKT + rdf + 64 * ks, sKT + rdf + 64 * ks + 32); }
        f32x4v U0[4], Y0[4];
#pragma unroll
        for (int vt = 0; vt < 4; ++vt) { const bf16x8 s0 = packf(T[0][vt], T[1][vt]), s1 = packf(T[2][vt], T[3][vt]);
            f32x4v u = (f32x4v){0.f, 0.f, 0.f, 0.f}, y = (f32x4v){0.f, 0.f, 0.f, 0.f};
            u = __builtin_amdgcn_mfma_f32_16x16x32_bf16(fA[0], s0, u, 0, 0, 0); u = __builtin_amdgcn_mfma_f32_16x16x32_bf16(fA[1], s1, u, 0, 0, 0);
            y = __builtin_amdgcn_mfma_f32_16x16x32_bf16(fR[0], s0, y, 0, 0, 0); y = __builtin_amdgcn_mfma_f32_16x16x32_bf16(fR[1], s1, y, 0, 0, 0);
            U0[vt] = u; Y0[vt] = y; }
        f32x4v Mka = (f32x4v){0.f, 0.f, 0.f, 0.f}, Mba = Mka, Mkr = Mka, Mbr = Mka;
#pragma unroll
        for (int ks = 0; ks < 2; ++ks) { Mka = __builtin_amdgcn_mfma_f32_16x16x32_bf16(fK[ks], fA[ks], Mka, 0, 0, 0); Mba = __builtin_amdgcn_mfma_f32_16x16x32_bf16(fB[ks], fA[ks], Mba, 0, 0, 0);
            Mkr = __builtin_amdgcn_mfma_f32_16x16x32_bf16(fK[ks], fR[ks], Mkr, 0, 0, 0); Mbr = __builtin_amdgcn_mfma_f32_16x16x32_bf16(fB[ks], fR[ks], Mbr, 0, 0, 0); }
#pragma unroll
        for (int i = 0; i < 4; ++i) { const int srow = 4 * g + i; if (!(srow < hc)) { Mka[i] = 0.f; Mba[i] = 0.f; } if (!(srow <= hc)) { Mkr[i] = 0.f; Mbr[i] = 0.f; } }
        if (ch + 1 < SEQ / 16) DC_LOAD(ch + 1);
        const f32x4v z4 = (f32x4v){0.f, 0.f, 0.f, 0.f};
        { const bf16x8 aM = packf(Mka, z4);
#pragma unroll
          for (int vt = 0; vt < 4; ++vt) { const s16x4 lo = vtr(sVT + rdt + 32 * vt); const bf16x8 bV = (bf16x8){lo[0], lo[1], lo[2], lo[3], 0, 0, 0, 0};
              U0[vt] = __builtin_amdgcn_mfma_f32_16x16x32_bf16(aM, bV, U0[vt], 0, 0, 0); } }
#pragma unroll
        for (int vt = 0; vt < 4; ++vt)
#pragma unroll
            for (int i = 0; i < 4; ++i) sW1[(4 * g + i) * 64 + 16 * vt + hc] = U0[vt][i];
        *(LAS f32x4v*)(sMB + hc * 16 + 4 * g) = Mba;
        asm volatile("s_waitcnt lgkmcnt(0)" ::: "memory");
        { float u[16];
#pragma unroll
          for (int t = 0; t < 16; ++t) { float acc = sW1[t * 64 + lane];
#pragma unroll
              for (int sq = 0; sq < 4; ++sq) { if (4 * sq < t) { const f32x4v mb = *(const LAS f32x4v*)(sMB + t * 16 + 4 * sq);
#pragma unroll
                  for (int e = 0; e < 4; ++e) if (4 * sq + e < t) acc += mb[e] * u[4 * sq + e]; } }
              u[t] = acc; ((LAS bf16*)sUT)[t * 72 + lane] = (bf16)f2bf(acc); } }
        asm volatile("s_waitcnt lgkmcnt(0)" ::: "memory");
        f32x4v bonv = *(const LAS f32x4v*)(sBON + 4 * g);
        { const bf16x8 aM = packf(Mbr, Mkr);
#pragma unroll
          for (int vt = 0; vt < 4; ++vt) { const bf16x8 bUV = fragtr(sUT + rdt + 32 * vt, sVT + rdt + 32 * vt); Y0[vt] = __builtin_amdgcn_mfma_f32_16x16x32_bf16(aM, bUV, Y0[vt], 0, 0, 0); } }
        { bf16x8 bUV[4];
#pragma unroll
          for (int vt = 0; vt < 4; ++vt) bUV[vt] = fragtr(sUT + rdt + 32 * vt, sVT + rdt + 32 * vt);
#pragma unroll
          for (int kt = 0; kt < 4; ++kt) { const bf16x8 aBK = fragtr(sBT + rdt + 32 * kt, sKT + rdt + 32 * kt); const f32x4v cl = *(const LAS f32x4v*)(sCL + 16 * kt + 4 * g);
#pragma unroll
              for (int vt = 0; vt < 4; ++vt) T[kt][vt] = __builtin_amdgcn_mfma_f32_16x16x32_bf16(aBK, bUV[vt], T[kt][vt], 0, 0, 0) * cl; } }
#pragma unroll
        for (int i = 0; i < 4; ++i) { float sm = (Y0[0][i] + Y0[1][i]) + (Y0[2][i] + Y0[3][i]);
            sm += dppf<0x128>(sm); sm += dppf<0x124>(sm); sm += dppf<0x122>(sm); sm += dppf<0x121>(sm);
            const float mean = sm * (1.f / 64.f); float sq = 0.f;
#pragma unroll
            for (int vt = 0; vt < 4; ++vt) { const float d = Y0[vt][i] - mean; sq += d * d; }
            sq += dppf<0x128>(sq); sq += dppf<0x124>(sq); sq += dppf<0x122>(sq); sq += dppf<0x121>(sq);
            const float rstd = rsqrtf(sq * (1.f / 64.f) + 64e-5f); const int t = 4 * g + i;
#pragma unroll
            for (int vt = 0; vt < 4; ++vt) { const float vv = bf2f(((const LAS bf16*)sVT)[t * 72 + 16 * vt + hc]);
                const float o = ((Y0[vt][i] - mean) * rstd * gnw[vt] + gnb[vt] + bonv[i] * vv) * bf2f(gq[vt][i]);
                YS[(tok0 + (size_t)ch * 16 + t) * 1024 + 768 + h * 64 + 16 * vt + hc] = (bf16)f2bf(o); } }
        asm volatile("s_waitcnt lgkmcnt(0)" ::: "memory");
    }
    __builtin_amdgcn_s_setprio(0);
#undef DC_LOAD
}
__device__ __forceinline__ void cchunk_wave(const Args& a, int l, int bh, LAS unsigned char* dm, int lane_in) {
    int lane = lane_in; asm volatile("" : "+v"(lane));
    const int b = bh >> 2, h = bh & 3, hc = lane & 15, g = lane >> 4;
    LAS unsigned char* sQT = dm; LAS unsigned char* sKT = dm + 1280; LAS unsigned char* sVT = dm + 2560; LAS float* sCL = (LAS float*)(dm + 4864);
    const bf16* P = (const bf16*)(a.ws + WS_BIG); const bf16* CQH = (const bf16*)(a.ws + WS_CA); const bf16* CKT = (const bf16*)(a.ws + WS_CA + 16 * MiB); const float* CCL = (const float*)(a.ws + WS_END);
    bf16* YS = (bf16*)((unsigned char*)a.out + DO_YS);
    float ng[4];
#pragma unroll
    for (int vt = 0; vt < 4; ++vt) ng[vt] = a.in[7][l * 256 + h * 64 + 16 * vt + hc];
    const size_t tok0 = (size_t)b * SEQ;
    f32x4v T[2][4];
#pragma unroll
    for (int kt = 0; kt < 2; ++kt)
#pragma unroll
        for (int vt = 0; vt < 4; ++vt) T[kt][vt] = (f32x4v){0.f, 0.f, 0.f, 0.f};
    const int qrow = lane >> 2, qseg = lane & 3, lrow = lane >> 3, lseg = lane & 7;
    u32x4 nQ, nK, nV0, nV1; float nCL;
#define CC_LOAD(CH) do { const size_t tq_ = tok0 + (size_t)(CH) * 16 + qrow; nQ = *(const u32x4*)(CQH + tq_ * 128 + h * 32 + 8 * qseg); nK = *(const u32x4*)(CKT + tq_ * 128 + h * 32 + 8 * qseg); \
        const size_t tv_ = tok0 + (size_t)(CH) * 16 + lrow; nV0 = *(const u32x4*)(P + tv_ * PW + PC_CV + h * 64 + 8 * lseg); nV1 = *(const u32x4*)(P + (tv_ + 8) * PW + PC_CV + h * 64 + 8 * lseg); \
        nCL = CCL[((size_t)b * (SEQ / 16) + (CH)) * 128 + h * 32 + (lane & 31)]; } while (0)
    CC_LOAD(0);
    const int rdf = hc * 80 + 8 * g;
    const int rdtk = (4 * g + (hc >> 2)) * 80 + 8 * (hc & 3);
    const int rdtv = (4 * g + (hc >> 2)) * 144 + 8 * (hc & 3);
    __builtin_amdgcn_s_setprio(2);
#pragma unroll 1
    for (int ch = 0; ch < SEQ / 16; ++ch) {
        *(LAS u32x4*)(sQT + qrow * 80 + qseg * 16) = nQ; *(LAS u32x4*)(sKT + qrow * 80 + qseg * 16) = nK;
        *(LAS u32x4*)(sVT + lrow * 144 + lseg * 16) = nV0; *(LAS u32x4*)(sVT + (lrow + 8) * 144 + lseg * 16) = nV1; if (lane < 32) sCL[lane] = nCL;
        unsigned short gq[4][4];
#pragma unroll
        for (int vt = 0; vt < 4; ++vt)
#pragma unroll
            for (int i = 0; i < 4; ++i) gq[vt][i] = P[(tok0 + (size_t)ch * 16 + 4 * g + i) * PW + PC_CG + h * 64 + 16 * vt + hc];
        asm volatile("s_waitcnt lgkmcnt(0)" ::: "memory");
        const bf16x8 fQ = frag2(sQT + rdf, sQT + rdf + 32), fK = frag2(sKT + rdf, sKT + rdf + 32);
        f32x4v Y0[4];
#pragma unroll
        for (int vt = 0; vt < 4; ++vt) { const bf16x8 s0 = packf(T[0][vt], T[1][vt]); Y0[vt] = __builtin_amdgcn_mfma_f32_16x16x32_bf16(fQ, s0, (f32x4v){0.f, 0.f, 0.f, 0.f}, 0, 0, 0); }
        f32x4v Mkq = __builtin_amdgcn_mfma_f32_16x16x32_bf16(fK, fQ, (f32x4v){0.f, 0.f, 0.f, 0.f}, 0, 0, 0);
#pragma unroll
        for (int i = 0; i < 4; ++i) if (!(4 * g + i <= hc)) Mkq[i] = 0.f;
        if (ch + 1 < SEQ / 16) CC_LOAD(ch + 1);
        const f32x4v z4 = (f32x4v){0.f, 0.f, 0.f, 0.f};
        bf16x8 bV[4];
#pragma unroll
        for (int vt = 0; vt < 4; ++vt) { const s16x4 lo = vtr(sVT + rdtv + 32 * vt); bV[vt] = (bf16x8){lo[0], lo[1], lo[2], lo[3], 0, 0, 0, 0}; }
        { const bf16x8 aM = packf(Mkq, z4);
#pragma unroll
          for (int vt = 0; vt < 4; ++vt) Y0[vt] = __builtin_amdgcn_mfma_f32_16x16x32_bf16(aM, bV[vt], Y0[vt], 0, 0, 0); }
#pragma unroll
        for (int kt = 0; kt < 2; ++kt) { const s16x4 lo = vtr(sKT + rdtk + 32 * kt); const bf16x8 aK = (bf16x8){lo[0], lo[1], lo[2], lo[3], 0, 0, 0, 0}; const f32x4v cl = *(const LAS f32x4v*)(sCL + 16 * kt + 4 * g);
#pragma unroll
            for (int vt = 0; vt < 4; ++vt) T[kt][vt] = __builtin_amdgcn_mfma_f32_16x16x32_bf16(aK, bV[vt], T[kt][vt], 0, 0, 0) * cl; }
#pragma unroll
        for (int i = 0; i < 4; ++i) { float sq = 0.f;
#pragma unroll
            for (int vt = 0; vt < 4; ++vt) { const float o = Y0[vt][i] * 0.17677669529663687f; Y0[vt][i] = o; sq += o * o; }
            sq += dppf<0x128>(sq); sq += dppf<0x124>(sq); sq += dppf<0x122>(sq); sq += dppf<0x121>(sq);
            const float rn = rsqrtf(sq * (1.f / 64.f) + 1e-6f); const int t = 4 * g + i;
#pragma unroll
            for (int vt = 0; vt < 4; ++vt) { const float gg = bf2f(gq[vt][i]);
                YS[(tok0 + (size_t)ch * 16 + t) * 1024 + 512 + h * 64 + 16 * vt + hc] = (bf16)f2bf(gg * sigmoidf_(gg) * (Y0[vt][i] * rn * ng[vt])); } }
        asm volatile("s_waitcnt lgkmcnt(0)" ::: "memory");
    }
    __builtin_amdgcn_s_setprio(0);
#undef CC_LOAD
}
__device__ __forceinline__ void mixers_phase(const Args& a, int l, LAS unsigned char* lds, int bid, int G, int tid, int wave, int lane, int qsel = 0, int mixmask = 15, const int bmode = 15) {
    unsigned* qh = (unsigned*)(a.ws + WS_CTL) + CW_Q + 64 * l + 16 * qsel;
    LAS unsigned char* wscr = lds + wave * 12800;
    mixA_tables(a, lds, tid); __syncthreads();
    if (wave == 0) for (int it = bid; it < 256; it += G) { if (it < 128) { if (mixmask & 1) dchunk_wave(a, l, it, lds + DM_OFF, lane); } else { if (mixmask & 2) cchunk_wave(a, l, it - 128, lds + DM_OFF, lane); } }
    for (;;) {
        unsigned cq = 0; if (lane == 0) cq = __hip_atomic_fetch_add(qh, 1u, __ATOMIC_RELAXED, __HIP_MEMORY_SCOPE_AGENT);
        cq = (unsigned)__builtin_amdgcn_readfirstlane((int)cq);
        if (cq >= 16384u) break;
        if (cq < 8192u) { if (!(mixmask & 8)) continue; const int tb = 255 - (int)(cq >> 5), b = (int)(cq & 31u); const int m0 = b * SEQ + tb * 8;
#pragma unroll 1
            for (int k = 0; k < 2; ++k) {
#ifndef MIX_NO_B
                mixB_group(a, l, m0 + 4 * k, lds, wscr, lane, bmode);
#endif
            } }
        else { if (!(mixmask & 4)) continue;
#ifndef MIX_NO_A
            mixA_task(a, (int)(cq - 8192u), lds, wave, lane);
#endif
        }
    }
}

constexpr int RREC_OFF = MISC_OFF + 4096, LCNT_OFF = MISC_OFF + 10240, LBASE_OFF = MISC_OFF + 10368;
__device__ __forceinline__ void ln1_route_phase(const Args& a, int l, LAS unsigned char* lds, int bid, int G, int tid, int wave, int lane) {
    bf16* XB = (bf16*)(a.ws + WS_XB); const float* WRT = (const float*)(a.ws + WS_RT) + (size_t)l * 36 * 1024;
    unsigned* tokinfo = (unsigned*)(a.ws + WS_TOK); unsigned* cntg = (unsigned*)(a.ws + WS_CTL) + CW_CNT + (l * 32) * 64;
    const float* lng = a.in[21] + (l * 2 + 0) * 1024; const float* lnb = a.in[22] + (l * 2 + 0) * 1024;
    const float* brg = a.in[24] + l * 4; const float* bre = a.in[26] + l * 32;
    LAS float* sW = (LAS float*)lds;
    LAS unsigned* rrec = (LAS unsigned*)(lds + RREC_OFF); LAS int* lcnt = (LAS int*)(lds + LCNT_OFF); LAS unsigned* lbase = (LAS unsigned*)(lds + LBASE_OFF);
    for (int i = tid; i < 32 * 1024 / 4; i += NTHR) *(LAS f32x4*)(sW + 4 * i) = *(const f32x4*)(WRT + 4 * 1024 + 4 * i);
    f32x4 gam[4], bet[4], wg[4][4];
#pragma unroll
    for (int j = 0; j < 4; ++j) { gam[j] = *(const f32x4*)(lng + 4 * lane + 256 * j); bet[j] = *(const f32x4*)(lnb + 4 * lane + 256 * j);
#pragma unroll
        for (int e = 0; e < 4; ++e) wg[e][j] = *(const f32x4*)(WRT + e * 1024 + 4 * lane + 256 * j); }
    for (int blk = bid; blk < NTOK / 256; blk += G) {
        if (tid < 32) lcnt[tid] = 0;
        __syncthreads();
#pragma unroll 1
        for (int rg = 0; rg < 8; ++rg) {
            const int rl0 = wave * 32 + rg * 4; f32x4 x[4][4];
#pragma unroll
            for (int r = 0; r < 4; ++r) { bf16* xr = XB + (size_t)(blk * 256 + rl0 + r) * 1024; float s = 0.f;
#pragma unroll
                for (int j = 0; j < 4; ++j) { const u32x2 w = *(const u32x2*)(xr + 4 * lane + 256 * j); x[r][j] = (f32x4){bflo(w.x), bfhi(w.x), bflo(w.y), bfhi(w.y)}; s += (x[r][j][0] + x[r][j][1]) + (x[r][j][2] + x[r][j][3]); }
                const float mean = wave_sum(s) * (1.f / 1024.f); float q = 0.f;
#pragma unroll
                for (int j = 0; j < 4; ++j) { x[r][j] = x[r][j] - mean; q += (x[r][j][0] * x[r][j][0] + x[r][j][1] * x[r][j][1]) + (x[r][j][2] * x[r][j][2] + x[r][j][3] * x[r][j][3]); }
                const float rstd = rsqrtf(wave_sum(q) * (1.f / 1024.f) + LN_EPS);
#pragma unroll
                for (int j = 0; j < 4; ++j) { x[r][j] = x[r][j] * rstd * gam[j] + bet[j]; u32x2 w; w.x = pk2(x[r][j][0], x[r][j][1]); w.y = pk2(x[r][j][2], x[r][j][3]); *(u32x2*)(xr + 4 * lane + 256 * j) = w; }
                }
            float gl[4][4];
#pragma unroll
            for (int e = 0; e < 4; ++e)
#pragma unroll
                for (int r = 0; r < 4; ++r) { float d = 0.f;
#pragma unroll
                    for (int j = 0; j < 4; ++j) d += (x[r][j][0] * wg[e][j][0] + x[r][j][1] * wg[e][j][1]) + (x[r][j][2] * wg[e][j][2] + x[r][j][3] * wg[e][j][3]);
                    gl[r][e] = wave_sum(d) + brg[e]; }
#pragma unroll
            for (int r = 0; r < 4; ++r) {
                const float g0 = gl[r][0], g1 = gl[r][1], g2 = gl[r][2], g3 = gl[r][3];
                int gsv = 0; float gm = g0; if (g1 > gm) { gm = g1; gsv = 1; } if (g2 > gm) { gm = g2; gsv = 2; } if (g3 > gm) { gm = g3; gsv = 3; }
                const int gs = __builtin_amdgcn_readfirstlane(gsv);
                const float ptop = 1.f / (__expf(g0 - gm) + __expf(g1 - gm) + __expf(g2 - gm) + __expf(g3 - gm));
                float v0 = -INFINITY, v1 = -INFINITY; int i0 = 0, i1 = 0;
#pragma unroll 2
                for (int jj = 0; jj < 8; ++jj) { const int e = gs * 8 + jj; float d = 0.f;
#pragma unroll
                    for (int j = 0; j < 4; ++j) { const f32x4 w4 = *(const LAS f32x4*)(sW + e * 1024 + 4 * lane + 256 * j); d += (x[r][j][0] * w4[0] + x[r][j][1] * w4[1]) + (x[r][j][2] * w4[2] + x[r][j][3] * w4[3]); }
                    const float le = wave_sum(d) + bre[e];
                    if (le > v0) { v1 = v0; i1 = i0; v0 = le; i0 = jj; } else if (le > v1) { v1 = le; i1 = jj; } }
                const float ex = __expf(v1 - v0), w0 = ptop / (1.f + ex), w1 = ptop * ex / (1.f + ex);
                if (lane == 0) { const int e0 = gs * 8 + i0, e1 = gs * 8 + i1; const int rl = rl0 + r;
                    const int p0 = atomicAdd((int*)&lcnt[e0], 1), p1 = atomicAdd((int*)&lcnt[e1], 1);
                    rrec[rl * 6 + 0] = (unsigned)e0; rrec[rl * 6 + 1] = (unsigned)p0; rrec[rl * 6 + 2] = __float_as_uint(w0); rrec[rl * 6 + 3] = (unsigned)e1; rrec[rl * 6 + 4] = (unsigned)p1; rrec[rl * 6 + 5] = __float_as_uint(w1); } }
        }
        __syncthreads();
        if (tid < 32) lbase[tid] = __hip_atomic_fetch_add(cntg + tid * 64, (unsigned)lcnt[tid], __ATOMIC_RELAXED, __HIP_MEMORY_SCOPE_AGENT);
        __syncthreads();
        if (tid < 256) { const unsigned e0 = rrec[tid * 6 + 0], e1 = rrec[tid * 6 + 3]; unsigned* ti = tokinfo + (size_t)(blk * 256 + tid) * 8;
            u32x4 o0, o1; o0.x = e0; o0.y = lbase[e0] + rrec[tid * 6 + 1]; o0.z = rrec[tid * 6 + 2]; o0.w = e1; o1.x = lbase[e1] + rrec[tid * 6 + 4]; o1.y = rrec[tid * 6 + 5]; o1.z = 0u; o1.w = 0u;
            *(u32x4*)ti = o0; *(u32x4*)(ti + 4) = o1; }
        __syncthreads();
    }
}
__device__ __forceinline__ void moe_table(const Args& a, int l, LAS unsigned char* lds, int tid) {
    LAS int* tstart = (LAS int*)(lds + TST_OFF);
    if (tid < 64) { const unsigned* cntg = (const unsigned*)(a.ws + WS_CTL) + CW_CNT + (l * 32) * 64;
        int v = (tid < 32) ? (int)((__hip_atomic_load(cntg + tid * 64, __ATOMIC_RELAXED, __HIP_MEMORY_SCOPE_AGENT) + 255u) >> 8) : 0; const int mine = v;
#pragma unroll
        for (int o = 1; o < 32; o <<= 1) { const int u = __shfl_up(v, o); if ((tid & 63) >= o) v += u; }
        if (tid < 32) tstart[tid] = v - mine; if (tid == 31) tstart[32] = v; }
    __syncthreads();
}
__device__ __forceinline__ void scatter_phase(const Args& a, int l, LAS unsigned char* lds, int bid, int G, int tid, int gw, int NGW, int lane) {
    const LAS int* tstart = (const LAS int*)(lds + TST_OFF);
    const bf16* XB = (const bf16*)(a.ws + WS_XB); bf16* XS = (bf16*)(a.ws + WS_BIG); unsigned* rowinfo = (unsigned*)(a.ws + WS_ROW); const unsigned* tokinfo = (const unsigned*)(a.ws + WS_TOK);
    const unsigned* cntg = (const unsigned*)(a.ws + WS_CTL) + CW_CNT + (l * 32) * 64;
    for (int e = bid; e < 32; e += G) { const int c = (int)__hip_atomic_load(cntg + e * 64, __ATOMIC_RELAXED, __HIP_MEMORY_SCOPE_AGENT); const int r0 = tstart[e] * 256, r1 = tstart[e + 1] * 256;
        unsigned neg_ = 0xffffffffu, zer_ = 0u; asm volatile("" : "+v"(neg_), "+v"(zer_));
        for (int r = r0 + c + tid; r < r1; r += NTHR) { rowinfo[2 * (size_t)r] = neg_; rowinfo[2 * (size_t)r + 1] = zer_; } }
    u32x4 nt0; u32x2 nt1;
#define SC_LOAD(mm) do { nt0 = *(const u32x4*)(tokinfo + (size_t)(mm) * 8); nt1 = *(const u32x2*)(tokinfo + (size_t)(mm) * 8 + 4); } while (0)
    const int gt = gw * 64 + lane, NT = NGW * 64;
    for (int m = gt; m < NTOK; m += NT) {
        SC_LOAD(m); const u32x4 t0 = nt0; const u32x2 t1 = nt1;
        const size_t r0 = (size_t)tstart[t0.x] * 256 + t0.y, r1 = (size_t)tstart[t0.w] * 256 + t1.x;
        *(u32x2*)(rowinfo + 2 * r0) = (u32x2){(unsigned)(m * 2), t0.z}; *(u32x2*)(rowinfo + 2 * r1) = (u32x2){(unsigned)(m * 2 + 1), t1.y};
    }
#undef SC_LOAD
}
__device__ __forceinline__ void ln2_phase(const Args& a, int l, int gw, int NGW, int lane) {
    bf16* XB = (bf16*)(a.ws + WS_XB); const bf16* Y = (const bf16*)(a.ws + WS_BIG);
    const float* lng = a.in[21] + (l * 2 + 1) * 1024; const float* lnb = a.in[22] + (l * 2 + 1) * 1024;
    f32x4 gam[4], bet[4];
#pragma unroll
    for (int j = 0; j < 4; ++j) { gam[j] = *(const f32x4*)(lng + 4 * lane + 256 * j); bet[j] = *(const f32x4*)(lnb + 4 * lane + 256 * j); }
    for (int m0 = gw; m0 < NTOK; m0 += 4 * NGW) {
        u32x2 cw[4][4], cp2[4][4], cq2[4][4];
#pragma unroll
        for (int r = 0; r < 4; ++r) { const int m = m0 + r * NGW; if (m < NTOK) { const bf16* xr_ = XB + (size_t)m * 1024 + 4 * lane; const bf16* y0_ = Y + (size_t)m * 1024 + 4 * lane; const bf16* y1_ = Y + ((size_t)NTOK + m) * 1024 + 4 * lane;
#pragma unroll
            for (int j = 0; j < 4; ++j) { cw[r][j] = *(const u32x2*)(xr_ + 256 * j); cp2[r][j] = *(const u32x2*)(y0_ + 256 * j); cq2[r][j] = *(const u32x2*)(y1_ + 256 * j); } } }
#pragma unroll
        for (int r = 0; r < 4; ++r) { const int m = m0 + r * NGW; if (m < NTOK) {
            bf16* xr = XB + (size_t)m * 1024;
            f32x4 x[4]; float s = 0.f;
#pragma unroll
            for (int j = 0; j < 4; ++j) { const u32x2 w = cw[r][j], p = cp2[r][j], q = cq2[r][j];
                x[j] = (f32x4){DN_ALPHA * bflo(w.x) + (bflo(p.x) + bflo(q.x)), DN_ALPHA * bfhi(w.x) + (bfhi(p.x) + bfhi(q.x)), DN_ALPHA * bflo(w.y) + (bflo(p.y) + bflo(q.y)), DN_ALPHA * bfhi(w.y) + (bfhi(p.y) + bfhi(q.y))};
                s += (x[j][0] + x[j][1]) + (x[j][2] + x[j][3]); }
            const float mean = wave_sum(s) * (1.f / 1024.f); float q = 0.f;
#pragma unroll
            for (int j = 0; j < 4; ++j) { x[j] = x[j] - mean; q += (x[j][0] * x[j][0] + x[j][1] * x[j][1]) + (x[j][2] * x[j][2] + x[j][3] * x[j][3]); }
            const float rstd = rsqrtf(wave_sum(q) * (1.f / 1024.f) + LN_EPS);
#pragma unroll
            for (int j = 0; j < 4; ++j) { x[j] = x[j] * rstd * gam[j] + bet[j];
                if (l == NLAYER - 1) *(f32x4*)(a.out + (size_t)m * 1024 + 4 * lane + 256 * j) = x[j];
                else { u32x2 w; w.x = pk2(x[j][0], x[j][1]); w.y = pk2(x[j][2], x[j][3]); *(u32x2*)(xr + 4 * lane + 256 * j) = w; } } } }
    }
}

#ifndef MK_MULTI
#define MK_MULTI 0
#endif
constexpr int NPHASE = 12;
__global__ void __launch_bounds__(NTHR, 2) fwd(Args a) {
    extern __shared__ __attribute__((aligned(16))) unsigned char lds_raw[];
    LAS unsigned char* lds = (LAS unsigned char*)lds_raw;
    const int G0 = gridDim.x, bid0 = blockIdx.x, wave0 = __builtin_amdgcn_readfirstlane((int)(threadIdx.x >> 6));
#define PH_IDS unsigned on_ = ~0u; asm volatile("" : "+s"(on_)); int lz_ = (int)__builtin_amdgcn_mbcnt_hi(on_, __builtin_amdgcn_mbcnt_lo(on_, 0u)); int wz_ = wave0, bz_ = bid0, gz_ = G0; asm volatile("" : "+s"(wz_), "+s"(bz_), "+s"(gz_)); \
    const int lane = lz_, wave = wz_, tid = wz_ * 64 + lz_, bid = bz_, G = gz_, NGW = gz_ * NWAVES, gw = bid * NWAVES + wave; (void)lane; (void)gw; (void)wave; (void)tid; (void)NGW;
#define PH_ARGS(LV) const __attribute__((address_space(4))) Args* kp_ = (const __attribute__((address_space(4))) Args*)__builtin_amdgcn_kernarg_segment_ptr(); asm volatile("" : "+s"(kp_)); const Args& b = *(const Args*)kp_; int lq = (LV); asm volatile("" : "+s"(lq)); (void)lq; \
    bf16* XB = (bf16*)(b.ws + WS_XB); bf16* PB = (bf16*)(b.ws + WS_BIG); bf16* YS = (bf16*)((unsigned char*)b.out + DO_YS); bf16* MG = (bf16*)((unsigned char*)b.out + DO_MG); \
    unsigned* rowinfo = (unsigned*)(b.ws + WS_ROW); unsigned char* wl = b.ws + WS_W + (size_t)lq * WL_SIZE; (void)XB; (void)PB; (void)YS; (void)MG; (void)rowinfo; (void)wl;
    unsigned* ctl = (unsigned*)(a.ws + WS_CTL);
    { PH_IDS
    for (int u = tid; u < (LDS_BYTES - MISC_OFF) / 4; u += NTHR) ((LAS unsigned*)(lds + MISC_OFF))[u] = 0u;
    __syncthreads();
    for (int d = tid; d < 2048; d += NTHR) ((LAS unsigned char*)(lds + BKT_OFF))[d] = (unsigned char)t5_bucket(d);
    if (tid < 256) ((LAS float*)(lds + RPB_OFF))[tid] = a.in[1][tid];
    __syncthreads(); }
    XcdBarrier bar; bar.bar = ctl + CW_BAR; bar.x = 0; bar.st = nullptr;
    if (a.use_bar) bar = xcd_barrier_post(ctl + CW_BAR, (volatile LAS unsigned*)(lds + MISC_OFF) + 8);
#define GRID_BAR() do { if (a.use_bar) { const __attribute__((address_space(4))) Args* kq_ = (const __attribute__((address_space(4))) Args*)__builtin_amdgcn_kernarg_segment_ptr(); asm volatile("" : "+s"(kq_)); \
        XcdBarrier bb_ = bar; bb_.bar = (unsigned*)(kq_->ws + WS_CTL) + CW_BAR; xcd_barrier(bb_); } } while (0)
#ifndef PHMASK
#define PHMASK 0xFFF
#endif
#define IN(k) (((PHMASK >> (k)) & 1) && ((phm >> (k)) & 1u))

    unsigned phm = ((1u << a.ph_hi) - 1u) & ~((1u << a.ph_lo) - 1u);
    if (a.l_lo == 0 && IN(0)) { PH_IDS PH_ARGS(0) p0_prologue(b, lds, gw, NGW, wave, lane); GRID_BAR(); }
    for (int l = a.l_lo; l < a.l_hi; ++l) {
        asm volatile("" : "+s"(phm));
        if (IN(1)) { PH_IDS PH_ARGS(l) pg8::Gemm g{XB, (const bf16*)(wl + WL_IN), 1024, 1024, 1024}; pg8::GridOrder S; S.init(NTOK / 256, PW / 256, G, bid);
            pg8::EpiStoreBf16 E{PB, PW}; pg8::gemm_phase(lds, g, S, E, tid); GRID_BAR(); }
        if (IN(2)) { PH_IDS PH_ARGS(l) prep_phase(b, lq, lds, tid, gw, NGW, lane); GRID_BAR(); }
        if (IN(3)) { PH_IDS PH_ARGS(l) mixers_phase(b, lq, lds, bid, G, tid, wave, lane); GRID_BAR(); }
        if (IN(4)) { PH_IDS PH_ARGS(l) pg8::Gemm g{YS, (const bf16*)(wl + WL_BR), 1024, 256, 256}; pg8::GridOrder S; S.init(NTOK / 256, 16, G, bid, 4, 512);
            pg8::EpiStoreBf16 E{PB, 4096}; pg8::gemm_phase(lds, g, S, E, tid); GRID_BAR(); }
        if (IN(5)) { PH_IDS PH_ARGS(l) pg8::Gemm g{XB, (const bf16*)(wl + WL_IN) + (size_t)3072 * 1024, 1024, 1024, 1024}; pg8::GridOrder S; S.init(NTOK / 256, 16, G, bid);
            pg8::EpiGate E{PB, MG}; pg8::gemm_phase(lds, g, S, E, tid); GRID_BAR(); }
        if (IN(6)) { PH_IDS PH_ARGS(l) pg8::Gemm g{MG, (const bf16*)(wl + WL_OUT), 1024, 1024, 1024}; pg8::GridOrder S; S.init(NTOK / 256, 4, G, bid);
            pg8::EpiOut E{XB}; pg8::gemm_phase(lds, g, S, E, tid); GRID_BAR(); }
        if (IN(7)) { PH_IDS PH_ARGS(l) ln1_route_phase(b, lq, lds, bid, G, tid, wave, lane); GRID_BAR(); }
        if (IN(8)) { PH_IDS PH_ARGS(l) moe_table(b, lq, lds, tid); scatter_phase(b, lq, lds, bid, G, tid, gw, NGW, lane); GRID_BAR(); }
        if (IN(9)) { PH_IDS PH_ARGS(l) moe_table(b, lq, lds, tid); pg8::Gemm g{XB, (const bf16*)(wl + WL_GU), 1024, 1024, 1024}; pg8::MoeOrder S{(const LAS int*)(lds + TST_OFF), 1, G, bid};
            pg8::EpiUp E{rowinfo, (bf16*)(b.ws + WS_BIG + BIG_H)}; pg8::gemm_phase<pg8::EpiUp, pg8::MoeOrder, true>(lds, g, S, E, tid, rowinfo); GRID_BAR(); }
        if (IN(10)) { PH_IDS PH_ARGS(l) moe_table(b, lq, lds, tid); pg8::Gemm g{(const bf16*)(b.ws + WS_BIG + BIG_H), (const bf16*)(wl + WL_DN), 256, 256, 256}; pg8::MoeOrder S{(const LAS int*)(lds + TST_OFF), 2, G, bid};
            pg8::EpiDown E{rowinfo, PB}; pg8::gemm_phase(lds, g, S, E, tid); GRID_BAR(); }
        if (IN(11)) { PH_IDS PH_ARGS(l) ln2_phase(b, lq, gw, NGW, lane); if (l + 1 < a.l_hi) GRID_BAR(); }
    }
#undef IN
#undef GRID_BAR
}

extern "C" void kernel_launch(void* const* d_in, const int* in_sizes, int n_in, void* d_out, int out_size, void* d_ws, size_t ws_size, hipStream_t stream) {
    static int grid = 0;
    if (grid == 0) {
        if (n_in != 30 || out_size != NTOK * DM || ws_size < WS_END + 2 * MiB) { fprintf(stderr, "kernel_launch: unexpected shapes (n_in %d out %d ws %zu)\n", n_in, out_size, ws_size); grid = -1; return; }
        int dev = 0, cus = 0, per_cu = 0;
        if (hipGetDevice(&dev) != hipSuccess || hipDeviceGetAttribute(&cus, hipDeviceAttributeMultiprocessorCount, dev) != hipSuccess) { grid = -1; return; }
        if (hipFuncSetAttribute((const void*)fwd, hipFuncAttributeMaxDynamicSharedMemorySize, LDS_BYTES) != hipSuccess) { fprintf(stderr, "kernel_launch: hipFuncSetAttribute failed\n"); grid = -1; return; }
        if (hipOccupancyMaxActiveBlocksPerMultiprocessor(&per_cu, (const void*)fwd, NTHR, LDS_BYTES) != hipSuccess || per_cu < 1) fprintf(stderr, "kernel_launch: occupancy query says %d\n", per_cu);
        (void)hipGetLastError();
        grid = cus;
    }
    if (grid < 0) return;
    (void)hipMemsetAsync((char*)d_ws + WS_CTL, 0, CTL_ZERO_BYTES, stream);
    Args a{};
    for (int i = 0; i < 30; ++i) a.in[i] = (const float*)d_in[i];
    a.out = (float*)d_out; a.ws = (unsigned char*)d_ws; a.pad = 0;
#if MK_MULTI
    a.use_bar = 0;
    for (int l = 0; l < NLAYER; ++l)
        for (int ph = (l == 0 ? 0 : 1); ph < NPHASE; ++ph) { a.l_lo = l; a.l_hi = l + 1; a.ph_lo = ph; a.ph_hi = ph + 1;
            hipLaunchKernelGGL(fwd, dim3(grid), dim3(NTHR), LDS_BYTES, stream, a); }
#else
    a.use_bar = 1; a.l_lo = 0; a.l_hi = NLAYER; a.ph_lo = 0; a.ph_hi = NPHASE;
    hipLaunchKernelGGL(fwd, dim3(grid), dim3(NTHR), LDS_BYTES, stream, a);
#endif
    const hipError_t le = hipPeekAtLastError();
    if (le != hipSuccess) fprintf(stderr, "kernel_launch: launch failed: %s\n", hipGetErrorName(le));
}
```

```cpp
#include <hip/hip_runtime.h>
#include <cstdio>
#include <cstdint>

#define LAS __attribute__((address_space(3)))
#define GAS __attribute__((address_space(1)))
typedef unsigned short bf16;
typedef short bf16x8 __attribute__((ext_vector_type(8)));
typedef float f32x4 __attribute__((ext_vector_type(4)));
typedef float f32x2 __attribute__((ext_vector_type(2)));
typedef unsigned u32x4 __attribute__((ext_vector_type(4)));
typedef unsigned u32x2 __attribute__((ext_vector_type(2)));

namespace pg8 {
constexpr int BM = 256, BK = 64, HALF = 128, HTB = HALF * BK * 2  , STAGE_BYTES = 8 * HTB, NXCD = 8, WGM = 8;

__host__ __device__ __forceinline__ int lds_byte(int r, int c) { const int st = (r >> 4) * 2 + (c >> 5), rr = r & 15, cc = c & 31, ob = rr * 64 + cc * 2; return st * 1024 + (ob ^ (((ob >> 9) & 1) << 5)); }
__host__ __device__ __forceinline__ void stage_rc(int b, int& R, int& C) { const int st = b / 1024, sb = b % 1024, swz = sb ^ (((sb >> 9) & 1) << 5); R = (st >> 1) * 16 + swz / 64; C = (st & 1) * 32 + (swz % 64) / 2; }
__host__ __device__ __forceinline__ int perm32(int rho) { const int n = rho >> 4, i = rho & 15; return 8 * (i >> 2) + 4 * n + (i & 3); }

struct Unit { int pm, pn, pb; unsigned aoff; };
struct Gemm { const bf16* A; const bf16* Bt; int lda, ldb, K; };

struct GridOrder {
    int nM, nN, nwg, G, c, a_grp, a_grp_bytes;
    __device__ void init(int nM_, int nN_, int G_, int c_, int a_grp_ = 0, int a_grp_bytes_ = 0) { nM = nM_; nN = nN_; nwg = nM * nN; G = G_; c = c_; a_grp = a_grp_; a_grp_bytes = a_grp_bytes_; }
    __device__ bool next(int i, Unit& u) const {
        const long L = (long)i * G + c; if (L >= nwg) return false;
        int wgid = (int)L; { const int q = nwg / NXCD, r = nwg % NXCD, xcd = wgid % NXCD, off = wgid / NXCD; wgid = (xcd < r ? xcd * (q + 1) : r * (q + 1) + (xcd - r) * q) + off; }
        const int nig = WGM * nN, gid = wgid / nig, fm = gid * WGM, gsz = (nM - fm) < WGM ? (nM - fm) : WGM;
        u.pm = fm + ((wgid % nig) % gsz); u.pn = (wgid % nig) / gsz; u.pb = u.pn; u.aoff = a_grp ? (unsigned)((u.pn / a_grp) * a_grp_bytes) : 0u; return true;
    }
};
struct MoeOrder {
    const LAS int* tstart; int nsl, G, c;
    __device__ bool next(int i, Unit& u) const {
        const int L = i * G + c, total = tstart[32] << nsl; if (L >= total) return false;
        const int rt = L >> nsl, pn = L & ((1 << nsl) - 1); int e = 0;
        while (e < 31 && rt >= tstart[e + 1]) ++e;
        u.pm = rt; u.pn = pn; u.pb = (e << nsl) + pn; u.aoff = 0u; return true;
    }
};

__device__ __forceinline__ unsigned cvt_pk_bf16(float lo, float hi) { unsigned r; asm volatile("v_cvt_pk_bf16_f32 %0, %1, %2" : "=v"(r) : "v"(lo), "v"(hi)); return r; }

template <class Epi, class Sched, bool GATHER = false>
__device__ __forceinline__ void gemm_phase(LAS unsigned char* lds, const Gemm g, const Sched& S, const Epi& E, const int tid, const unsigned* rowtab = nullptr) {
    const int wid = __builtin_amdgcn_readfirstlane(tid >> 6), lane = tid & 63, wr = wid >> 2, wc = wid & 3, fr = lane & 15, fq = lane >> 4;
    const int K = g.K, nt = K / BK;
    unsigned voffA[2], voffB[2];
#pragma unroll
    for (int i = 0; i < 2; ++i) { int R, C; stage_rc(tid * 16 + i * 8192, R, C); const int Rb = Epi::PERM ? ((R & ~31) + perm32(R & 31)) : R;
        voffA[i] = (unsigned)(R * g.lda + C) * 2u; voffB[i] = (unsigned)(Rb * g.ldb + C) * 2u; }
    const size_t kstep = (size_t)(BK * 2);
    const size_t hstepA = (size_t)HALF * g.lda * 2, hstepB = (size_t)HALF * g.ldb * 2;
    const size_t tstepA = 2 * hstepA, tstepB = 2 * hstepB;
    const unsigned ldsw = (unsigned)wid * 1024u;
    const int aoff = lds_byte(wr * 64 + fr, fq * 8), boff = lds_byte(wc * 32 + fr, fq * 8);
#define PG8_SA(b, h) (((b) * 2 + (h)) * HTB)
#define PG8_SB(b, h) ((4 + (b) * 2 + (h)) * HTB)
#define PG8_STAGE(bufoff, gbase, voff) do { _Pragma("unroll") for (int _i = 0; _i < 2; ++_i) \
        __builtin_amdgcn_global_load_lds((const unsigned*)((const char*)(gbase) + (voff)[_i]), (LAS unsigned*)(lds + (bufoff) + ldsw + _i * 8192), 16, 0, 0); } while (0)
#define PG8_STAGE_A(bufoff, gbase, h) do { if constexpr (GATHER) { PG8_STAGE(bufoff, gbase, vgA[h]); } else { PG8_STAGE(bufoff, (gbase) + (h) * hstepA, voffA); } } while (0)
#define PG8_STAGE_AX(bufoff, gbase, h, useN) do { if constexpr (GATHER) { unsigned vs_[2] = {(useN) ? vgN[h][0] : vgA[h][0], (useN) ? vgN[h][1] : vgA[h][1]}; PG8_STAGE(bufoff, gbase, vs_); } else { PG8_STAGE(bufoff, (gbase) + (h) * hstepA, voffA); } } while (0)
#define PG8_LDA(dst, b, h) do { _Pragma("unroll") for (int m = 0; m < 4; ++m) _Pragma("unroll") for (int k = 0; k < 2; ++k) dst[m][k] = *(const LAS bf16x8*)(lds + PG8_SA(b, h) + aoff + m * 2048 + k * 1024); } while (0)
#define PG8_LDB(dst, b, h) do { _Pragma("unroll") for (int n = 0; n < 2; ++n) _Pragma("unroll") for (int k = 0; k < 2; ++k) dst[n][k] = *(const LAS bf16x8*)(lds + PG8_SB(b, h) + boff + n * 2048 + k * 1024); } while (0)
#define PG8_MMA(ai, bj, At, Bt) do { __builtin_amdgcn_s_setprio(1); _Pragma("unroll") for (int m = 0; m < 4; ++m) _Pragma("unroll") for (int n = 0; n < 2; ++n) _Pragma("unroll") for (int k = 0; k < 2; ++k) \
        acc[ai][bj][m][n] = __builtin_amdgcn_mfma_f32_16x16x32_bf16(Bt[n][k], At[m][k], acc[ai][bj][m][n], 0, 0, 0); __builtin_amdgcn_s_setprio(0); } while (0)
#define PG8_WAIT_V(n) asm volatile("s_waitcnt vmcnt(" #n ")" ::: "memory")
#define PG8_WAIT_L(n) asm volatile("s_waitcnt lgkmcnt(" #n ")" ::: "memory")
#define PG8_BAR __builtin_amdgcn_s_barrier()
#define PG8_SCHED __builtin_amdgcn_sched_barrier(0)
    Unit cur, nxt; int ui = 0; unsigned tch0 = 0u, tch1 = 0u;
    if (!S.next(0, cur)) return;
    unsigned vgA[2][2], vgN[2][2];
    int gR[2], gC[2];
#pragma unroll
    for (int i = 0; i < 2; ++i) stage_rc(tid * 16 + i * 8192, gR[i], gC[i]);
#define PG8_GOFF(DST, PM) do { if constexpr (GATHER) { _Pragma("unroll") for (int h_ = 0; h_ < 2; ++h_) _Pragma("unroll") for (int i_ = 0; i_ < 2; ++i_) { \
        const int ri_ = (int)rowtab[2 * ((size_t)(PM) * BM + h_ * HALF + gR[i_])]; const unsigned tok_ = ri_ < 0 ? 0u : (unsigned)ri_ >> 1; DST[h_][i_] = (tok_ * (unsigned)g.lda + (unsigned)gC[i_]) * 2u; } } } while (0)
    PG8_GOFF(vgA, cur.pm);
    f32x4 acc[2][2][4][2];
#pragma unroll
    for (int a = 0; a < 2; ++a)
#pragma unroll
        for (int b = 0; b < 2; ++b)
#pragma unroll
            for (int m = 0; m < 4; ++m)
#pragma unroll
                for (int n = 0; n < 2; ++n) acc[a][b][m][n] = (f32x4){0.f, 0.f, 0.f, 0.f};
    bf16x8 At[4][2], B0[2][2], B1[2][2];
    const char* cA = GATHER ? (const char*)g.A : (const char*)g.A + (size_t)cur.pm * tstepA + cur.aoff; const char* cB = (const char*)g.Bt + (size_t)cur.pb * tstepB;
    PG8_STAGE(PG8_SB(0, 0), cB, voffB); PG8_STAGE(PG8_SB(0, 1), cB + hstepB, voffB); PG8_STAGE_A(PG8_SA(0, 0), cA, 0); PG8_STAGE_A(PG8_SA(0, 1), cA, 1);
    if (wr == 1) PG8_BAR;
    PG8_WAIT_V(2); PG8_BAR;
    PG8_STAGE(PG8_SB(1, 0), cB + kstep, voffB); PG8_STAGE_A(PG8_SA(1, 0), cA + kstep, 0); PG8_STAGE(PG8_SB(1, 1), cB + hstepB + kstep, voffB);
    PG8_WAIT_V(6); PG8_BAR;
    for (;;) {
        const bool has_next = S.next(ui + 1, nxt);
        if (has_next) PG8_GOFF(vgN, nxt.pm); else { if constexpr (GATHER) { vgN[0][0] = vgA[0][0]; vgN[0][1] = vgA[0][1]; vgN[1][0] = vgA[1][0]; vgN[1][1] = vgA[1][1]; } }
        const char* nA = GATHER ? cA : (has_next ? (const char*)g.A + (size_t)nxt.pm * tstepA + nxt.aoff : cA); const char* nB = has_next ? (const char*)g.Bt + (size_t)nxt.pb * tstepB : cB;
        for (int t = 0; t < nt; t += 2) {
            const bool last = (t == nt - 2);
            if constexpr (Epi::TOUCH) { if (t == nt - 6) E.touch(cur, tid, tch0, tch1); }
            const char* a1 = cA + (size_t)(t + 1) * kstep;
            const char* a2 = last ? nA : cA + (size_t)(t + 2) * kstep; const char* b2 = last ? nB : cB + (size_t)(t + 2) * kstep;
            const char* a3 = a2 + kstep; const char* b3 = b2 + kstep;
            PG8_LDB(B0, 0, 0); PG8_LDB(B1, 0, 1); PG8_SCHED; PG8_LDA(At, 0, 0); PG8_STAGE_AX(PG8_SA(1, 1), a1, 1, false);
            PG8_WAIT_V(8); PG8_WAIT_L(0); PG8_BAR; PG8_MMA(0, 0, At, B0); PG8_MMA(0, 1, At, B1); PG8_BAR; PG8_SCHED;
            PG8_LDA(At, 0, 1); PG8_STAGE(PG8_SB(0, 0), b2, voffB); PG8_STAGE(PG8_SB(0, 1), b2 + hstepB, voffB); PG8_STAGE_AX(PG8_SA(0, 0), a2, 0, last);
            PG8_WAIT_V(8); PG8_WAIT_L(0); PG8_BAR; PG8_MMA(1, 0, At, B0); PG8_MMA(1, 1, At, B1); PG8_BAR; PG8_SCHED;
            PG8_LDB(B0, 1, 0); PG8_LDB(B1, 1, 1); PG8_SCHED; PG8_LDA(At, 1, 0); PG8_STAGE_AX(PG8_SA(0, 1), a2, 1, last);
            PG8_WAIT_V(8); PG8_WAIT_L(0); PG8_BAR; PG8_MMA(0, 0, At, B0); PG8_MMA(0, 1, At, B1); PG8_BAR; PG8_SCHED;
            PG8_LDA(At, 1, 1); PG8_STAGE(PG8_SB(1, 0), b3, voffB); PG8_STAGE(PG8_SB(1, 1), b3 + hstepB, voffB); PG8_STAGE_AX(PG8_SA(1, 0), a3, 0, last);
            PG8_WAIT_V(8); PG8_WAIT_L(0); PG8_BAR; PG8_MMA(1, 0, At, B0); PG8_MMA(1, 1, At, B1); PG8_BAR; PG8_SCHED;
        }
        if (wr == 0) PG8_BAR;
        if constexpr (Epi::TOUCH) asm volatile("" :: "v"(tch0), "v"(tch1));
        { unsigned on_ = ~0u; asm volatile("" : "+s"(on_)); const int lz_ = (int)__builtin_amdgcn_mbcnt_hi(on_, __builtin_amdgcn_mbcnt_lo(on_, 0u));
          E(acc, cur, wr, wc, lz_ & 15, lz_ >> 4); }
        if (!has_next) break;
#pragma unroll
        for (int a = 0; a < 2; ++a)
#pragma unroll
            for (int b = 0; b < 2; ++b)
#pragma unroll
                for (int m = 0; m < 4; ++m)
#pragma unroll
                    for (int n = 0; n < 2; ++n) acc[a][b][m][n] = (f32x4){0.f, 0.f, 0.f, 0.f};
        cur = nxt; cA = nA; cB = nB; ++ui;
        if constexpr (GATHER) { vgA[0][0] = vgN[0][0]; vgA[0][1] = vgN[0][1]; vgA[1][0] = vgN[1][0]; vgA[1][1] = vgN[1][1]; }
        if (wr == 1) PG8_BAR;
    }
    PG8_WAIT_V(0);
    PG8_BAR;
#undef PG8_SA
#undef PG8_STAGE_A
#undef PG8_STAGE_AX
#undef PG8_GOFF
#undef PG8_SB
#undef PG8_STAGE
#undef PG8_LDA
#undef PG8_LDB
#undef PG8_MMA
#undef PG8_WAIT_V
#undef PG8_WAIT_L
#undef PG8_BAR
#undef PG8_SCHED
}
}

constexpr int NTOK = 65536, DM = 1024, SEQ = 2048, NBATCH = 32, NLAYER = 4;
constexpr int PW = 3072;
constexpr int PC_AQ = 0, PC_AK = 256, PC_AV = 512, PC_BQ = 768, PC_CKV = 1024, PC_IQ = 1088, PC_IK = 1344, PC_IW = 1376,
              PC_CQ = 1384, PC_CK = 1512, PC_CV = 1640, PC_CA = 1896, PC_CG = 1912, PC_D = 2168;
constexpr int IN_W = 7096;
constexpr float LN_EPS = 1e-5f;
constexpr float DN_ALPHA = 1.6817928305074292f;
constexpr int NWAVES = 8, NTHR = 512;
constexpr int MOE_ROWS = 2 * NTOK + 32 * 256;

constexpr size_t MiB = 1u << 20;
constexpr size_t WS_CTL = 0, CTL_ZERO_BYTES = 1 * MiB;
constexpr size_t WS_TOK = 1 * MiB;
constexpr size_t WS_ROW = 3 * MiB;
constexpr size_t WS_BON = 5 * MiB;
constexpr size_t WS_RT = 6 * MiB;
constexpr size_t WS_CKVN = 8 * MiB;
constexpr size_t WS_CA = 16 * MiB;
constexpr size_t WS_W = 48 * MiB;
constexpr size_t WL_IN = 0, WL_BR = 14 * MiB, WL_OUT = 16 * MiB, WL_GU = 18 * MiB, WL_DN = 50 * MiB, WL_SIZE = 66 * MiB;
constexpr size_t WS_XB = 312 * MiB;
constexpr size_t WS_BIG = 440 * MiB;
constexpr size_t BIG_DW = 384 * MiB, BIG_DAI = 448 * MiB, BIG_DG = 480 * MiB;
constexpr size_t BIG_H = 272 * MiB;
constexpr size_t WS_END = 952 * MiB;
constexpr size_t DO_YS = 0, DO_MG = 128 * MiB, DO_DR = 128 * MiB, DO_DKP = 160 * MiB, DO_DV = 192 * MiB, DO_DKK = 224 * MiB;

constexpr int CW_TMO = 0, CW_CODE = 1;
constexpr int CW_BAR = 4096;
constexpr int CW_Q = 8192;
constexpr int CW_CNT = 16384;

constexpr int RING_BYTES = 131072;
constexpr int MISC_OFF = RING_BYTES;
constexpr int TST_OFF = MISC_OFF + 512;
constexpr int BKT_OFF = MISC_OFF + 1024;
constexpr int RPB_OFF = MISC_OFF + 3072;
constexpr int LDS_BYTES = 147456;

#define LDS_WAIT() asm volatile("s_waitcnt lgkmcnt(0)" ::: "memory")
#define VM_WAIT() asm volatile("s_waitcnt vmcnt(0)" ::: "memory")
__device__ __forceinline__ float bf2f(unsigned b) { return __uint_as_float(b << 16); }
__device__ __forceinline__ unsigned f2bf(float f) { unsigned u = __float_as_uint(f); return (u + 0x7fffu + ((u >> 16) & 1u)) >> 16; }
__device__ __forceinline__ unsigned pk2(float lo, float hi) { return f2bf(lo) | (f2bf(hi) << 16); }
__device__ __forceinline__ float bflo(unsigned w) { return __uint_as_float(w << 16); }
__device__ __forceinline__ float bfhi(unsigned w) { return __uint_as_float(w & 0xffff0000u); }
template <int CTRL> __device__ __forceinline__ float dppf(float v) {
    return __builtin_bit_cast(float, __builtin_amdgcn_update_dpp(0, __builtin_bit_cast(int, v), CTRL, 0xf, 0xf, true));
}
__device__ __forceinline__ float wave_sum(float v) {
    v += dppf<0x128>(v); v += dppf<0x124>(v); v += dppf<0x122>(v); v += dppf<0x121>(v);
    v += __shfl_xor(v, 16); v += __shfl_xor(v, 32); return v;
}
__device__ __forceinline__ float wave_max(float v) {
#pragma unroll
    for (int o = 1; o < 64; o <<= 1) v = fmaxf(v, __shfl_xor(v, o));
    return v;
}
__device__ __forceinline__ float sum8(float v) { v += dppf<0xB1>(v); v += dppf<0x4E>(v); v += dppf<0x141>(v); return v; }
__device__ __forceinline__ float sigmoidf_(float x) { return __builtin_amdgcn_rcpf(1.f + __expf(-x)); }
__device__ __forceinline__ float log_sigmoidf_(float z) { return fminf(z, 0.f) - __logf(1.f + __expf(-fabsf(z))); }

#define XB_TMO      128
#define XB_XCNT(j)  (256  + 64 * (j))
#define XB_XSUB(j)  (1280 + 64 * (j))
#define XB_XGEN(j)  (2304 + 64 * (j))
#define XB_TOP      3328
#define XB_TOPGEN   3392
#define XCD_BAR_WORDS 3456
#define XB_SPIN_CAP (1u << 22)

__device__ __forceinline__ unsigned xb_ld(unsigned* p)              { return __hip_atomic_load(p, __ATOMIC_RELAXED, __HIP_MEMORY_SCOPE_AGENT); }
__device__ __forceinline__ unsigned xb_add(unsigned* p, unsigned v) { return __hip_atomic_fetch_add(p, v, __ATOMIC_RELAXED, __HIP_MEMORY_SCOPE_AGENT); }
__device__ __forceinline__ unsigned xb_xcc_id() { return (unsigned)__builtin_amdgcn_s_getreg((3 << 11) | 20) & 0xFu; }
#define XB_SPIN(cond, bar) do { unsigned _sp = 0; while (cond) { __builtin_amdgcn_s_sleep(1); \
    if ((++_sp & 255u) == 0u) { if (xb_ld(&(bar)[XB_TMO])) break; if (_sp > XB_SPIN_CAP) { atomicAdd(&(bar)[XB_TMO], 1u); break; } } } } while (0)

struct XcdBarrier { unsigned* bar; unsigned x; volatile LAS unsigned* st; };

__device__ __forceinline__ XcdBarrier xcd_barrier_post(unsigned* bar, volatile LAS unsigned* st) {
    XcdBarrier b; b.bar = bar; b.x = xb_xcc_id(); b.st = st;
    if (threadIdx.x == 0) (void)xb_add(&bar[XB_XCNT(b.x)], 1u);
    return b;
}
__device__ __forceinline__ void xcd_barrier_complete(unsigned* bar, unsigned x, unsigned& nloc, unsigned& nx) {
    const unsigned G = gridDim.x * gridDim.y * gridDim.z;
    unsigned sum, cnt, mine, sp = 0u;
    for (;;) {
        sum = 0u; cnt = 0u; mine = 0u;
#pragma unroll
        for (unsigned j = 0; j < 16; ++j) { const unsigned c = xb_ld(&bar[XB_XCNT(j)]); sum += c; cnt += (c > 0u) ? 1u : 0u; mine = (j == x) ? c : mine; }
        if (sum == G) break;
        __builtin_amdgcn_s_sleep(1);
        if ((++sp & 255u) == 0u) { if (xb_ld(&bar[XB_TMO])) break; if (sp > XB_SPIN_CAP) { atomicAdd(&bar[XB_TMO], 1u); break; } }
    }
    nloc = mine > 0u ? mine : 1u; nx = cnt > 0u ? cnt : 1u;
}
__device__ __forceinline__ void xcd_barrier(const XcdBarrier& b) {
    asm volatile("s_waitcnt vmcnt(0)" ::: "memory");
    __syncthreads();
    if (threadIdx.x == 0) {
        unsigned* bar = b.bar;
        __builtin_amdgcn_s_waitcnt(0);
        unsigned nloc = b.st[0], nx = b.st[1];
        if (nloc == 0u) { xcd_barrier_complete(bar, b.x, nloc, nx); b.st[0] = nloc; b.st[1] = nx; }
        const unsigned old = xb_add(&bar[XB_XSUB(b.x)], 1u);
        const unsigned gen = old / nloc;
        if (old + 1u == (gen + 1u) * nloc) {
            __builtin_amdgcn_fence(__ATOMIC_RELEASE, "agent");
            asm volatile("s_waitcnt vmcnt(0)" ::: "memory");
            const unsigned og = xb_add(&bar[XB_TOP], 1u);
            const unsigned tg = og / nx;
            if (og + 1u == (tg + 1u) * nx) xb_add(&bar[XB_TOPGEN], 1u);
            else XB_SPIN(xb_ld(&bar[XB_TOPGEN]) == tg, bar);
            __builtin_amdgcn_fence(__ATOMIC_ACQUIRE, "agent");
            xb_add(&bar[XB_XGEN(b.x)], 1u);
            asm volatile("s_waitcnt vmcnt(0)" ::: "memory");
        } else {
            XB_SPIN(xb_ld(&bar[XB_XGEN(b.x)]) == gen, bar);
            __builtin_amdgcn_fence(__ATOMIC_ACQUIRE, "agent");
            asm volatile("s_waitcnt vmcnt(0)" ::: "memory");
        }
    }
    __syncthreads();
}

__device__ __forceinline__ int t5_bucket(int d) {
    if (d < 16) return d;
    int b = 16;
    b += (d >= 22) + (d >= 30) + (d >= 40) + (d >= 54) + (d >= 73) + (d >= 99) + (d >= 134) + (d >= 182) + (d >= 246) + (d >= 332) + (d >= 450) + (d >= 609) + (d >= 825) + (d >= 1117) + (d >= 1513);
    return b;
}
struct Args { const float* in[30]; float* out; unsigned char* ws; int l_lo, l_hi, ph_lo, ph_hi, use_bar, pad; };

namespace pg8 {
struct EpiNull {
    static constexpr bool PERM = true; static constexpr bool TOUCH = false;
    unsigned* sink;
    __device__ __forceinline__ void operator()(const f32x4 (&acc)[2][2][4][2], const Unit& u, int wr, int wc, int fr, int fq) const {
        float t = 0.f;
#pragma unroll
        for (int ai = 0; ai < 2; ++ai)
#pragma unroll
            for (int bj = 0; bj < 2; ++bj)
#pragma unroll
                for (int m = 0; m < 4; ++m)
#pragma unroll
                    for (int n = 0; n < 2; ++n) t += (acc[ai][bj][m][n][0] + acc[ai][bj][m][n][1]) + (acc[ai][bj][m][n][2] + acc[ai][bj][m][n][3]);
        if (t == 1.2345e-33f) sink[0] = 1u; }
};
struct EpiStoreBf16 {
    static constexpr bool PERM = true; static constexpr bool TOUCH = false;
    bf16* O; int ldc;
    __device__ __forceinline__ void operator()(const f32x4 (&acc)[2][2][4][2], const Unit& u, int wr, int wc, int fr, int fq) const {
        const int row0 = u.pm * BM + wr * 64 + fr, col0 = u.pn * BM + wc * 32 + 8 * fq;
#pragma unroll
        for (int ai = 0; ai < 2; ++ai)
#pragma unroll
            for (int m = 0; m < 4; ++m) { bf16* rowp = O + (size_t)(row0 + ai * HALF + m * 16) * ldc + col0;
#pragma unroll
                for (int bj = 0; bj < 2; ++bj) { const f32x4 v0 = acc[ai][bj][m][0], v1 = acc[ai][bj][m][1];
                    u32x4 w; w.x = cvt_pk_bf16(v0[0], v0[1]); w.y = cvt_pk_bf16(v0[2], v0[3]); w.z = cvt_pk_bf16(v1[0], v1[1]); w.w = cvt_pk_bf16(v1[2], v1[3]);
                    *(u32x4*)(rowp + bj * HALF) = w; } }
    }
};
struct EpiGate {
    static constexpr bool PERM = false; static constexpr bool TOUCH = true;
    const bf16* BR; bf16* MG;
    __device__ __forceinline__ void touch(const Unit& u, int tid, unsigned& t0, unsigned& t1) const {
        const bf16* p = BR + (size_t)(u.pm * BM + (tid & 255)) * 4096 + (tid >> 8) * 2048 + u.pn * 64; t0 = *(const unsigned*)p; t1 = *(const unsigned*)(p + 1024); }
    __device__ __forceinline__ void operator()(const f32x4 (&acc)[2][2][4][2], const Unit& u, int wr, int wc, int fr, int fq) const {
        const int row0 = u.pm * BM + wr * 64 + fr, j0 = u.pn * 64 + wc * 16 + 4 * fq;
#pragma unroll
        for (int ai = 0; ai < 2; ++ai)
#pragma unroll
            for (int m = 0; m < 4; ++m) { const size_t r = (size_t)(row0 + ai * HALF + m * 16);
                float mg0 = 0.f, mg1 = 0.f, mg2 = 0.f, mg3 = 0.f;
#pragma unroll
                for (int bj = 0; bj < 2; ++bj)
#pragma unroll
                    for (int n = 0; n < 2; ++n) { const int g = 2 * bj + n; const u32x2 b = *(const u32x2*)(BR + r * 4096 + g * 1024 + j0); const f32x4 a = acc[ai][bj][m][n];
                        mg0 += sigmoidf_(a[0]) * bflo(b.x); mg1 += sigmoidf_(a[1]) * bfhi(b.x); mg2 += sigmoidf_(a[2]) * bflo(b.y); mg3 += sigmoidf_(a[3]) * bfhi(b.y); }
                u32x2 w; w.x = cvt_pk_bf16(mg0, mg1); w.y = cvt_pk_bf16(mg2, mg3);
                *(u32x2*)(MG + r * 1024 + j0) = w; }
    }
};
struct EpiOut {
    static constexpr bool PERM = true; static constexpr bool TOUCH = true;
    bf16* XB;
    __device__ __forceinline__ void touch(const Unit& u, int tid, unsigned& t0, unsigned& t1) const {
        const bf16* p = XB + (size_t)(u.pm * BM + (tid & 255)) * 1024 + u.pn * BM + (tid >> 8) * 128; t0 = *(const unsigned*)p; t1 = *(const unsigned*)(p + 64); }
    __device__ __forceinline__ void operator()(const f32x4 (&acc)[2][2][4][2], const Unit& u, int wr, int wc, int fr, int fq) const {
        const int row0 = u.pm * BM + wr * 64 + fr, col0 = u.pn * BM + wc * 32 + 8 * fq;
#pragma unroll
        for (int ai = 0; ai < 2; ++ai)
#pragma unroll
            for (int m = 0; m < 4; ++m) { bf16* rowp = XB + (size_t)(row0 + ai * HALF + m * 16) * 1024 + col0;
#pragma unroll
                for (int bj = 0; bj < 2; ++bj) { const f32x4 v0 = acc[ai][bj][m][0], v1 = acc[ai][bj][m][1]; const u32x4 x = *(const u32x4*)(rowp + bj * HALF);
                    u32x4 w; w.x = cvt_pk_bf16(DN_ALPHA * bflo(x.x) + v0[0], DN_ALPHA * bfhi(x.x) + v0[1]); w.y = cvt_pk_bf16(DN_ALPHA * bflo(x.y) + v0[2], DN_ALPHA * bfhi(x.y) + v0[3]);
                    w.z = cvt_pk_bf16(DN_ALPHA * bflo(x.z) + v1[0], DN_ALPHA * bfhi(x.z) + v1[1]); w.w = cvt_pk_bf16(DN_ALPHA * bflo(x.w) + v1[2], DN_ALPHA * bfhi(x.w) + v1[3]);
                    *(u32x4*)(rowp + bj * HALF) = w; } }
    }
};
struct EpiUp {
    static constexpr bool PERM = true; static constexpr bool TOUCH = false;
    const unsigned* rowinfo; bf16* H;
    __device__ __forceinline__ void operator()(const f32x4 (&acc)[2][2][4][2], const Unit& u, int wr, int wc, int fr, int fq) const {
        const int row0 = u.pm * BM + wr * 64 + fr, col0 = u.pn * 128 + wc * 32 + 8 * fq;
#pragma unroll
        for (int ai = 0; ai < 2; ++ai)
#pragma unroll
            for (int m = 0; m < 4; ++m) { const size_t r = (size_t)(row0 + ai * HALF + m * 16); const float w = __uint_as_float(rowinfo[2 * r + 1]);
                const f32x4 g0 = acc[ai][0][m][0], g1 = acc[ai][0][m][1], u0 = acc[ai][1][m][0], u1 = acc[ai][1][m][1];
                float h[8];
#pragma unroll
                for (int e = 0; e < 4; ++e) { h[e] = g0[e] * sigmoidf_(g0[e]) * u0[e] * w; h[4 + e] = g1[e] * sigmoidf_(g1[e]) * u1[e] * w; }
                u32x4 o; o.x = cvt_pk_bf16(h[0], h[1]); o.y = cvt_pk_bf16(h[2], h[3]); o.z = cvt_pk_bf16(h[4], h[5]); o.w = cvt_pk_bf16(h[6], h[7]);
                *(u32x4*)(H + r * 256 + col0) = o; }
    }
};
struct EpiDown {
    static constexpr bool PERM = true; static constexpr bool TOUCH = false;
    const unsigned* rowinfo; bf16* Y;
    __device__ __forceinline__ void operator()(const f32x4 (&acc)[2][2][4][2], const Unit& u, int wr, int wc, int fr, int fq) const {
        const int row0 = u.pm * BM + wr * 64 + fr, col0 = u.pn * BM + wc * 32 + 8 * fq;
#pragma unroll
        for (int ai = 0; ai < 2; ++ai)
#pragma unroll
            for (int m = 0; m < 4; ++m) { const size_t r = (size_t)(row0 + ai * HALF + m * 16); const int ri = (int)rowinfo[2 * r];
                if (ri >= 0) { bf16* rowp = Y + ((size_t)(ri & 1) * NTOK + (size_t)(ri >> 1)) * 1024 + col0;
#pragma unroll
                    for (int bj = 0; bj < 2; ++bj) { const f32x4 v0 = acc[ai][bj][m][0], v1 = acc[ai][bj][m][1];
                        u32x4 w; w.x = cvt_pk_bf16(v0[0], v0[1]); w.y = cvt_pk_bf16(v0[2], v0[3]); w.z = cvt_pk_bf16(v1[0], v1[1]); w.w = cvt_pk_bf16(v1[2], v1[3]);
                        *(u32x4*)(rowp + bj * HALF) = w; } } }
    }
};
}

struct RowMap { int kind, base, g, off;
    __device__ __forceinline__ int operator()(int n) const {
        if (kind == 0) return base + n;
        if (kind == 1) { const int j = base + n, jj = j & 63, pn = j >> 6; return 3072 + pn * 256 + 128 * (g >> 1) + 32 * (jj >> 4) + 16 * (g & 1) + 4 * ((jj >> 2) & 3) + (jj & 3); }
        const int h = base + n; return (h >> 7) * 256 + off + (h & 127);
    }
};
__device__ __forceinline__ void transpose_item(const float* W, int ldw, int k0, int scol0, int nvalid, bf16* WT, int ldk, const RowMap& rm, LAS float* scr, int lane) {
    const int nn = lane & 31;
#pragma unroll 8
    for (int i = 0; i < 32; ++i) { const int kk = 2 * i + (lane >> 5); scr[kk * 33 + nn] = (nn < nvalid) ? W[(size_t)(k0 + kk) * ldw + scol0 + nn] : 0.f; }
    LDS_WAIT(); asm volatile("" ::: "memory");
    const int c = lane & 7;
#pragma unroll
    for (int j = 0; j < 4; ++j) { const int n = (lane >> 3) + 8 * j; const LAS float* s = scr + (8 * c) * 33 + n;
        u32x4 o; o.x = pk2(s[0 * 33], s[1 * 33]); o.y = pk2(s[2 * 33], s[3 * 33]); o.z = pk2(s[4 * 33], s[5 * 33]); o.w = pk2(s[6 * 33], s[7 * 33]);
        *(u32x4*)(WT + (size_t)rm(n) * ldk + k0 + 8 * c) = o; }
    LDS_WAIT(); asm volatile("" ::: "memory");
}
__device__ __forceinline__ void p0_prologue(const Args& a, LAS unsigned char* lds, int gw, int NGW, int wave, int lane) {
    LAS float* scr = (LAS float*)(lds + wave * 16384);
    constexpr int IPL = 16896;
    for (int it = gw; it < NLAYER * IPL; it += NGW) {
        const int l = it / IPL; int r = it - l * IPL;
        unsigned char* wl = a.ws + WS_W + (size_t)l * WL_SIZE;
        RowMap rm; rm.kind = 0; rm.base = 0; rm.g = 0; rm.off = 0;
        if (r < 1536) { const int nt = r % 96, kt = r / 96, n0 = 32 * nt; int nv = 3000 - n0; nv = nv < 0 ? 0 : (nv > 32 ? 32 : nv); rm.base = n0;
            transpose_item(a.in[2] + (size_t)l * 1024 * IN_W, IN_W, 64 * kt, n0, nv, (bf16*)(wl + WL_IN), 1024, rm, scr, lane); continue; }
        r -= 1536;
        if (r < 2048) { const int nt = r % 128, kt = r / 128, gc0 = 32 * nt; rm.kind = 1; rm.g = gc0 >> 10; rm.base = gc0 & 1023;
            transpose_item(a.in[2] + (size_t)l * 1024 * IN_W, IN_W, 64 * kt, 3000 + gc0, 32, (bf16*)(wl + WL_IN), 1024, rm, scr, lane); continue; }
        r -= 2048;
        if (r < 512) { const int nb = r / 128, rr = r % 128, nt = rr % 32, kt = rr / 32; rm.base = nb * 1024 + 32 * nt;
            if (nb != 1) transpose_item(a.in[19] + (size_t)(l * 4 + nb) * 256 * 1024, 1024, 64 * kt, 32 * nt, 32, (bf16*)(wl + WL_BR), 256, rm, scr, lane); continue; }
        r -= 512;
        if (r < 512) { const int nt = r % 32, kt = r / 32; rm.base = 32 * nt;
            transpose_item(a.in[20] + (size_t)l * 1024 * 1024, 1024, 64 * kt, 32 * nt, 32, (bf16*)(wl + WL_OUT), 1024, rm, scr, lane); continue; }
        r -= 512;
        if (r < 8192) { const int up = r >= 4096; if (up) r -= 4096; const int e = r / 128, rr = r % 128, nt = rr % 8, kt = rr / 8; rm.kind = 2; rm.base = 32 * nt; rm.off = up ? 128 : 0;
            transpose_item(a.in[up ? 28 : 27] + (size_t)(l * 32 + e) * 1024 * 256, 256, 64 * kt, 32 * nt, 32, (bf16*)(wl + WL_GU) + (size_t)e * 512 * 1024, 1024, rm, scr, lane); continue; }
        r -= 8192;
        { const int e = r / 128, rr = r % 128, nt = rr % 32, kt = rr / 32; rm.base = 32 * nt;
            transpose_item(a.in[29] + (size_t)(l * 32 + e) * 256 * 1024, 1024, 64 * kt, 32 * nt, 32, (bf16*)(wl + WL_DN) + (size_t)e * 1024 * 256, 256, rm, scr, lane); }
    }
    { float* WRT = (float*)(a.ws + WS_RT); const int gt = gw * 64 + lane, NT = NGW * 64;
      for (int i = gt; i < NLAYER * 4 * 64 * 1024; i += NT) { const int j = i & 1023, c = (i >> 10) & 63, h = (i >> 16) & 3, l = i >> 18;
          const float* wu = a.in[4] + ((size_t)(l * 4 + h) * 64 + c) * 64; const float* wb = a.in[19] + ((size_t)(l * 4 + 1) * 256 + h * 64) * 1024 + j; float acc = 0.f;
#pragma unroll 8
          for (int d = 0; d < 64; ++d) acc += wu[d] * wb[(size_t)d * 1024];
          ((bf16*)(a.ws + WS_W + (size_t)l * WL_SIZE + WL_BR))[(size_t)(1024 + j) * 256 + h * 64 + c] = (bf16)f2bf(acc); }
      for (int i = gt; i < NLAYER * 36 * 1024; i += NT) { const int k = i & 1023, e = (i >> 10) % 36, l = i / (36 * 1024);
          WRT[i] = e < 4 ? a.in[23][((size_t)l * 1024 + k) * 4 + e] : a.in[25][((size_t)l * 1024 + k) * 32 + (e - 4)]; }
      const f32x4* xs = (const f32x4*)a.in[0]; u32x4* xd = (u32x4*)(a.ws + WS_XB);
      for (int i = gt; i < NTOK * DM / 8; i += NT) { const f32x4 v0 = xs[2 * i], v1 = xs[2 * i + 1]; u32x4 o; o.x = pk2(v0[0], v0[1]); o.y = pk2(v0[2], v0[3]); o.z = pk2(v1[0], v1[1]); o.w = pk2(v1[2], v1[3]); xd[i] = o; } }
}

__device__ __forceinline__ float softplusf_(float x) { return fmaxf(x, 0.f) + __logf(1.f + __expf(-fabsf(x))); }
__device__ __forceinline__ float tanhf_(float x) { const float e = __expf(-2.f * fabsf(x)); const float t = (1.f - e) * __builtin_amdgcn_rcpf(1.f + e); return x < 0.f ? -t : t; }
__device__ __forceinline__ void prep_phase(const Args& a, int l, LAS unsigned char* lds, int tid, int gw, int NGW, int lane, const int pmode = 7) {
    const int wave = __builtin_amdgcn_readfirstlane(tid >> 6);
    const bf16* P = (const bf16*)(a.ws + WS_BIG);
    bf16* CKVN = (bf16*)(a.ws + WS_CKVN); bf16* CQH = (bf16*)(a.ws + WS_CA); bf16* CKT = (bf16*)(a.ws + WS_CA + 16 * MiB); float* CCL = (float*)(a.ws + WS_END); float* BON = (float*)(a.ws + WS_BON);
    bf16* DR = (bf16*)((unsigned char*)a.out + DO_DR); bf16* DKP = (bf16*)((unsigned char*)a.out + DO_DKP); bf16* DV = (bf16*)((unsigned char*)a.out + DO_DV); bf16* DKK = (bf16*)((unsigned char*)a.out + DO_DKK);
    float* DW = (float*)(a.ws + WS_BIG + BIG_DW); bf16* DAI = (bf16*)(a.ws + WS_BIG + BIG_DAI); bf16* DG = (bf16*)(a.ws + WS_BIG + BIG_DG);
    const float* kvg = a.in[3] + l * 64; const float* aup = a.in[5] + l * 16 * 128; const float* abias = a.in[6] + l * 128;
    const float* mu = a.in[8] + l * 832; const float* w0 = a.in[9] + l * 256; const float* w2 = a.in[10] + l * 16 * 256; const float* a0 = a.in[11] + l * 256;
    const float* a2 = a.in[12] + l * 16 * 256; const float* g2 = a.in[13] + l * 32 * 256; const float* kkw = a.in[14] + l * 256; const float* kaw = a.in[15] + l * 256; const float* rkw = a.in[16] + l * 256;
    LAS float* sW2 = (LAS float*)lds; LAS float* sA2 = (LAS float*)(lds + 16384); LAS float* sG2 = (LAS float*)(lds + 32768); LAS float* sUP = (LAS float*)(lds + 65536);
    for (int i = tid; i < 4096; i += NTHR) { sW2[i] = w2[i]; sA2[i] = a2[i]; }
    for (int i = tid; i < 8192; i += NTHR) sG2[i] = g2[i];
    for (int i = tid; i < 2048; i += NTHR) sUP[i] = aup[i];
    __syncthreads();
    float mu_r[13], w0_r[4], a0_r[4], kk_r[4], ka_r[4], rk_r[4];
#pragma unroll
    for (int i = 0; i < 4; ++i) { const int c = 4 * lane + i; mu_r[i] = mu[c]; mu_r[4 + i] = mu[256 + c]; mu_r[8 + i] = mu[512 + c]; w0_r[i] = w0[c]; a0_r[i] = a0[c]; kk_r[i] = kkw[c]; ka_r[i] = kaw[c]; rk_r[i] = rkw[c]; }
    mu_r[12] = mu[768 + lane];
    const float kvg_r = kvg[lane], ab0 = abias[lane], ab1 = abias[64 + lane];
    u32x2 ncr, nck, ncv, npr, npk, npv; unsigned short ncl, npl, nckv, nca, nq0, nq1, nk0, nk1;
#define PREP_LOAD(mm) do { const bf16* pr_ = P + (size_t)(mm) * PW; \
        ncr = *(const u32x2*)(pr_ + PC_D + 4 * lane); nck = *(const u32x2*)(pr_ + PC_D + 256 + 4 * lane); ncv = *(const u32x2*)(pr_ + PC_D + 512 + 4 * lane); ncl = pr_[PC_D + 768 + lane]; nckv = pr_[PC_CKV + lane]; nca = pr_[PC_CA + (lane & 15)]; nq0 = pr_[PC_CQ + lane]; nq1 = pr_[PC_CQ + 64 + lane]; nk0 = pr_[PC_CK + lane]; nk1 = pr_[PC_CK + 64 + lane]; } while (0)
    constexpr int NCK = NTOK / 16;
    float* DCL = DW;
#define PREP_LOADP(mm) do { const int tt_ = (mm) & (SEQ - 1); const bf16* pp_ = P + (size_t)(mm) * PW - (tt_ > 0 ? PW : 0); npr = *(const u32x2*)(pp_ + PC_D + 4 * lane); npk = *(const u32x2*)(pp_ + PC_D + 256 + 4 * lane); npv = *(const u32x2*)(pp_ + PC_D + 512 + 4 * lane); npl = pp_[PC_D + 768 + lane]; } while (0)
    if (gw < NCK) { PREP_LOAD(gw * 16); PREP_LOADP(gw * 16); }
    for (int ck = gw; ck < NCK; ck += NGW) {
      float cpr[4] = {1.f, 1.f, 1.f, 1.f}; float cprc0 = 1.f, cprc1 = 1.f;
#pragma unroll 1
      for (int tt = 0; tt < 16; ++tt) {
        const int m = ck * 16 + tt;
        const int t = m & (SEQ - 1);
        const u32x2 ccr = ncr, cck = nck, ccv = ncv, cpr_ = npr, cpk = npk, cpv = npv; const unsigned short ccl = ncl, cpl = npl;
        npr = ncr; npk = nck; npv = ncv; npl = ncl;
        const unsigned short cckv = nckv, cca = nca, cq0 = nq0, cq1 = nq1, ck0 = nk0, ck1 = nk1;
        if (tt < 15) PREP_LOAD(m + 1); else if (ck + NGW < NCK) { PREP_LOAD((ck + NGW) * 16); PREP_LOADP((ck + NGW) * 16); }
        { const float x = bf2f(cckv); const float ss = wave_sum(x * x); const float rn = rsqrtf(ss * (1.f / 64.f) + 1e-6f); CKVN[(size_t)m * 64 + lane] = (bf16)f2bf(x * rn * kvg_r); }
        { const float cav = (lane < 16) ? bf2f(cca) : 0.f; float z0 = ab0, z1 = ab1;
#pragma unroll
          for (int i = 0; i < 16; ++i) { const float cv = __builtin_bit_cast(float, __builtin_amdgcn_readlane(__builtin_bit_cast(int, cav), i)); z0 += cv * sUP[i * 128 + lane]; z1 += cv * sUP[i * 128 + 64 + lane]; }
          cprc0 *= __expf(log_sigmoidf_(z0) * (1.f / 16.f)); cprc1 *= __expf(log_sigmoidf_(z1) * (1.f / 16.f));
          CQH[(size_t)m * 128 + lane] = (bf16)f2bf(bf2f(cq0) * cprc0); CQH[(size_t)m * 128 + 64 + lane] = (bf16)f2bf(bf2f(cq1) * cprc1);
          CKT[(size_t)m * 128 + lane] = (bf16)f2bf(bf2f(ck0) * __builtin_amdgcn_rcpf(cprc0)); CKT[(size_t)m * 128 + 64 + lane] = (bf16)f2bf(bf2f(ck1) * __builtin_amdgcn_rcpf(cprc1));
          if (tt == 15) { CCL[(size_t)ck * 128 + lane] = cprc0; CCL[(size_t)ck * 128 + 64 + lane] = cprc1; } }
        float xs[13];
        { const float cu[13] = {bflo(ccr.x), bfhi(ccr.x), bflo(ccr.y), bfhi(ccr.y), bflo(cck.x), bfhi(cck.x), bflo(cck.y), bfhi(cck.y), bflo(ccv.x), bfhi(ccv.x), bflo(ccv.y), bfhi(ccv.y), bf2f(ccl)};
          const float pv[13] = {bflo(cpr_.x), bfhi(cpr_.x), bflo(cpr_.y), bfhi(cpr_.y), bflo(cpk.x), bfhi(cpk.x), bflo(cpk.y), bfhi(cpk.y), bflo(cpv.x), bfhi(cpv.x), bflo(cpv.y), bfhi(cpv.y), bf2f(cpl)};
#pragma unroll
          for (int i = 0; i < 13; ++i) { const float prev = (t > 0) ? pv[i] : 0.f; xs[i] = cu[i] + (prev - cu[i]) * mu_r[i]; } }
        const float low = xs[12], tw = tanhf_(low), sg = sigmoidf_(low);
        float wr_[4], ar_[4], gv_[4];
#pragma unroll
        for (int i = 0; i < 4; ++i) { wr_[i] = w0_r[i]; ar_[i] = a0_r[i]; gv_[i] = 0.f; }
#define RDL(V, J) __builtin_bit_cast(float, __builtin_amdgcn_readlane(__builtin_bit_cast(int, V), (J)))
#define FMAS(ACC, S, V) asm("v_fmac_f32 %0, %1, %2" : "+v"(ACC) : "s"(S), "v"(V))
        int l4 = 4 * lane; asm volatile("" : "+v"(l4));
#pragma unroll 4
        for (int j = 0; j < 16; ++j) { const float tj = RDL(tw, j), aj = RDL(low, 16 + j); const f32x4 w4 = *(const LAS f32x4*)(sW2 + j * 256 + l4), a4 = *(const LAS f32x4*)(sA2 + j * 256 + l4);
#pragma unroll
            for (int i = 0; i < 4; ++i) { wr_[i] += tj * w4[i]; ar_[i] += aj * a4[i]; } }
#pragma unroll 4
        for (int j = 0; j < 32; ++j) { const float sj = RDL(sg, 32 + j); const f32x4 g4 = *(const LAS f32x4*)(sG2 + j * 256 + l4);
#pragma unroll
            for (int i = 0; i < 4; ++i) gv_[i] += sj * g4[i]; }
#undef RDL
#undef FMAS
        { float kkv[4], kp[4], av[4]; float n2 = 0.f, bn = 0.f;
#pragma unroll
          for (int i = 0; i < 4; ++i) { av[i] = sigmoidf_(ar_[i]); const float kx = xs[4 + i]; kkv[i] = kx * kk_r[i]; n2 += kkv[i] * kkv[i]; kp[i] = kx * (1.f + (av[i] - 1.f) * ka_r[i]); bn += xs[i] * kp[i] * rk_r[i]; }
          n2 += dppf<0x128>(n2); n2 += dppf<0x124>(n2); n2 += dppf<0x122>(n2); n2 += dppf<0x121>(n2);
          bn += dppf<0x128>(bn); bn += dppf<0x124>(bn); bn += dppf<0x122>(bn); bn += dppf<0x121>(bn);
          const float rnrm = __builtin_amdgcn_rcpf(fmaxf(sqrtf(n2), 1e-12f));
          float o_r[4], o_kp[4], o_kk[4], o_ai[4];
#pragma unroll
          for (int i = 0; i < 4; ++i) { const float w_raw = -softplusf_(-wr_[i]) - 0.5f, wdec = __expf(-__expf(w_raw)); const float kn = kkv[i] * rnrm;
              o_kk[i] = -kn * cpr[i]; cpr[i] *= wdec; const float cinv = __builtin_amdgcn_rcpf(cpr[i]);
              o_r[i] = xs[i] * cpr[i]; o_kp[i] = kp[i] * cinv; o_ai[i] = kn * av[i] * cinv; }
          const size_t o = (size_t)m * 256 + 4 * lane;
          *(u32x2*)(DR + o) = (u32x2){pk2(o_r[0], o_r[1]), pk2(o_r[2], o_r[3])}; *(u32x2*)(DKP + o) = (u32x2){pk2(o_kp[0], o_kp[1]), pk2(o_kp[2], o_kp[3])};
          *(u32x2*)(DV + o) = (u32x2){pk2(xs[8], xs[9]), pk2(xs[10], xs[11])}; *(u32x2*)(DKK + o) = (u32x2){pk2(o_kk[0], o_kk[1]), pk2(o_kk[2], o_kk[3])};
          *(u32x2*)(DAI + o) = (u32x2){pk2(o_ai[0], o_ai[1]), pk2(o_ai[2], o_ai[3])}; *(u32x2*)(DG + o) = (u32x2){pk2(gv_[0], gv_[1]), pk2(gv_[2], gv_[3])};
          if (tt == 15) *(f32x4*)(DCL + (size_t)ck * 256 + 4 * lane) = (f32x4){cpr[0], cpr[1], cpr[2], cpr[3]};
          if ((lane & 15) == 0) BON[(size_t)m * 4 + (lane >> 4)] = bn; }
      }
    }
#undef PREP_LOAD
#undef PREP_LOADP
    __syncthreads();
}

typedef float f32x16 __attribute__((ext_vector_type(16)));
typedef short s16x4 __attribute__((ext_vector_type(4)));
typedef short v4i16_t __attribute__((ext_vector_type(4)));
typedef float f32x2_t __attribute__((ext_vector_type(2))); typedef __bf16 bf16x2_t __attribute__((ext_vector_type(2)));
__device__ __forceinline__ unsigned cvtpk_s(float lo, float hi) { f32x2_t v = {lo, hi}; bf16x2_t b = __builtin_convertvector(v, bf16x2_t); return __builtin_bit_cast(unsigned, b); }
__device__ __forceinline__ s16x4 vtr(const LAS unsigned char* p) { return __builtin_bit_cast(s16x4, __builtin_amdgcn_ds_read_tr16_b64_v4i16((LAS v4i16_t*)p)); }
constexpr int ATB_OFF = 102400;
constexpr int AVI_OFF = 3584;
constexpr float LOG2E = 1.4426950408889634f;
__device__ __forceinline__ void mixA_tables(const Args& a, LAS unsigned char* lds, int tid) {
    LAS float* tb = (LAS float*)(lds + ATB_OFF);
    for (int i = tid; i < 3 * 4 * 192; i += NTHR) { const int e = i % 192, h = (i / 192) & 3, f = i / 768; const int dist = 159 - e; const int dl = f == 0 ? 16 : (f == 1 ? 4 : 1);
        float v = -INFINITY;
        if (dist >= 0 && dist <= 128) { int dd = dist * dl; dd = dd > 2047 ? 2047 : dd; v = a.in[1][t5_bucket(dd) * 8 + h] * LOG2E; }
        tb[i] = v; }
}
__device__ __forceinline__ void mixA_task(const Args& a, int b, int h, int r, int cc, LAS unsigned char* lds, int wave, int lane_in) {
    int lane = lane_in; asm volatile("" : "+v"(lane));
    const bf16* P = (const bf16*)(a.ws + WS_BIG); bf16* YS = (bf16*)((unsigned char*)a.out + DO_YS);
    const int ql = lane & 31, hh = lane >> 5, n0 = 32 * cc;
    const size_t rowb = (size_t)b * SEQ; const int tq = 16 * (n0 + ql) + r;
    const LAS float* tball = (const LAS float*)(lds + ATB_OFF) + h * 192;
    LAS unsigned char* vimg = lds + AVI_OFF + wave * 12800;
    bf16x8 qf[4];
    { const bf16* qp = P + (rowb + tq) * PW + PC_AQ + h * 64 + 8 * hh;
#pragma unroll
      for (int ks = 0; ks < 4; ++ks) qf[ks] = *(const bf16x8*)(qp + 16 * ks); }
    f32x16 o0, o1;
#pragma unroll
    for (int i = 0; i < 16; ++i) { o0[i] = 0.f; o1[i] = 0.f; }
    float m = -INFINITY, lsum = 0.f;
    const float SC = 0.125f * LOG2E;
    const int vst = (lane >> 3) * 144 + (lane & 7) * 16;
    const int i16 = lane & 15, tq4 = i16 >> 2, tp = i16 & 3, g16 = (lane >> 4) & 1;
    const int vrd = (4 * hh + tq4) * 144 + 32 * g16 + 8 * tp;
#pragma unroll 1
    for (int f = 0; f < 3; ++f) {
        const int dsh = f == 0 ? 4 : (f == 1 ? 2 : 0);
        const int rho = r & ((1 << dsh) - 1);
        const int qpos = (tq - rho) >> dsh;
        const int qmin = (16 * n0 + r - rho) >> dsh, qmax = (16 * (n0 + 31) + r - rho) >> dsh;
        int klo = qmin - 128; klo = klo < 0 ? 0 : klo; klo &= ~31;
        const LAS float* tbf = tball + f * 768;
        bf16x8 kA[4], kB[4]; u32x4 vA0, vA1, vA2, vA3, vB0, vB1, vB2, vB3;
#define A_LOAD(KF, W0, W1, W2, W3, KK0) do { const size_t tk_ = rowb + (((size_t)((KK0) + ql)) << dsh) + rho; const bf16* kp_ = P + tk_ * PW + PC_AK + h * 64 + 8 * hh; \
            _Pragma("unroll") for (int ks = 0; ks < 4; ++ks) KF[ks] = *(const bf16x8*)(kp_ + 16 * ks); \
            const bf16* vp_ = P + (rowb + (((size_t)((KK0) + (lane >> 3))) << dsh) + rho) * PW + PC_AV + h * 64 + 8 * (lane & 7); const size_t vs_ = ((size_t)8 << dsh) * PW; \
            W0 = *(const u32x4*)(vp_); W1 = *(const u32x4*)(vp_ + vs_); W2 = *(const u32x4*)(vp_ + 2 * vs_); W3 = *(const u32x4*)(vp_ + 3 * vs_); } while (0)
#define A_TILE(KF, W0, W1, W2, W3, K0) do { \
            f32x16 st; \
            _Pragma("unroll") for (int i = 0; i < 16; ++i) st[i] = 0.f; \
            _Pragma("unroll") for (int ks = 0; ks < 4; ++ks) st = __builtin_amdgcn_mfma_f32_32x32x16_bf16(KF[ks], qf[ks], st, 0, 0, 0); \
            *(LAS u32x4*)(vimg + vst) = W0; *(LAS u32x4*)(vimg + vst + 8 * 144) = W1; *(LAS u32x4*)(vimg + vst + 16 * 144) = W2; *(LAS u32x4*)(vimg + vst + 24 * 144) = W3; \
            __builtin_amdgcn_sched_barrier(0); \
            if ((K0) - 64 >= klo) A_LOAD(KF, W0, W1, W2, W3, (K0) - 64); \
            __builtin_amdgcn_sched_barrier(0); \
            const int D0 = qpos - (K0) - 4 * hh; const int e0 = (D0 >= 0 && D0 <= 159) ? 159 - D0 : 0; \
            const LAS float* tp_ = tbf + e0; \
            float mx = -INFINITY; \
            _Pragma("unroll") for (int i = 0; i < 16; ++i) { st[i] = st[i] * SC + tp_[(i & 3) + 8 * (i >> 2)]; mx = fmaxf(mx, st[i]); } \
            mx = fmaxf(mx, __shfl_xor(mx, 32)); \
            const float mn = fmaxf(m, mx), alpha = __builtin_amdgcn_exp2f(m - mn); \
            m = mn; float ps = 0.f; \
            _Pragma("unroll") for (int i = 0; i < 16; ++i) { st[i] = __builtin_amdgcn_exp2f(st[i] - mn); ps += st[i]; } \
            lsum = lsum * alpha + ps; \
            _Pragma("unroll") for (int i = 0; i < 16; ++i) { o0[i] *= alpha; o1[i] *= alpha; } \
            bf16x8 pf[2]; \
            _Pragma("unroll") for (int s = 0; s < 2; ++s) { u32x4 w; w.x = cvtpk_s(st[8 * s], st[8 * s + 1]); w.y = cvtpk_s(st[8 * s + 2], st[8 * s + 3]); w.z = cvtpk_s(st[8 * s + 4], st[8 * s + 5]); w.w = cvtpk_s(st[8 * s + 6], st[8 * s + 7]); pf[s] = __builtin_bit_cast(bf16x8, w); } \
            asm volatile("s_waitcnt lgkmcnt(0)" ::: "memory"); \
            _Pragma("unroll") for (int s = 0; s < 2; ++s) { \
                const s16x4 a00 = vtr(vimg + vrd + (16 * s) * 144), a01 = vtr(vimg + vrd + (16 * s + 8) * 144); \
                const s16x4 a10 = vtr(vimg + vrd + (16 * s) * 144 + 64), a11 = vtr(vimg + vrd + (16 * s + 8) * 144 + 64); \
                const bf16x8 A0 = (bf16x8){a00[0], a00[1], a00[2], a00[3], a01[0], a01[1], a01[2], a01[3]}; \
                const bf16x8 A1 = (bf16x8){a10[0], a10[1], a10[2], a10[3], a11[0], a11[1], a11[2], a11[3]}; \
                o0 = __builtin_amdgcn_mfma_f32_32x32x16_bf16(A0, pf[s], o0, 0, 0, 0); \
                o1 = __builtin_amdgcn_mfma_f32_32x32x16_bf16(A1, pf[s], o1, 0, 0, 0); } \
            asm volatile("s_waitcnt lgkmcnt(0)" ::: "memory"); } while (0)
        int k0 = qmax & ~31;
        A_LOAD(kA, vA0, vA1, vA2, vA3, k0);
        if (k0 - 32 >= klo) A_LOAD(kB, vB0, vB1, vB2, vB3, k0 - 32);
#pragma unroll 1
        while (k0 >= klo) {
            A_TILE(kA, vA0, vA1, vA2, vA3, k0);
            k0 -= 32; if (k0 < klo) break;
            A_TILE(kB, vB0, vB1, vB2, vB3, k0);
            k0 -= 32;
        }
#undef A_TILE
#undef A_LOAD
    }
    const float lt = lsum + __shfl_xor(lsum, 32); const float inv = 1.f / lt;
    bf16* yo = YS + (rowb + tq) * 1024 + h * 64 + 4 * hh;
#pragma unroll
    for (int g = 0; g < 4; ++g) {
        u32x2 w; w.x = cvtpk_s(o0[4 * g] * inv, o0[4 * g + 1] * inv); w.y = cvtpk_s(o0[4 * g + 2] * inv, o0[4 * g + 3] * inv); *(u32x2*)(yo + 8 * g) = w;
        u32x2 x; x.x = cvtpk_s(o1[4 * g] * inv, o1[4 * g + 1] * inv); x.y = cvtpk_s(o1[4 * g + 2] * inv, o1[4 * g + 3] * inv); *(u32x2*)(yo + 32 + 8 * g) = x; }
}

__device__ __forceinline__ unsigned fkey(float f) { const unsigned u = __float_as_uint(f); return (u & 0x80000000u) ? ~u : (u | 0x80000000u); }
typedef float f32x4v __attribute__((ext_vector_type(4)));
__device__ __forceinline__ float wave_max64(float v) {
    v = fmaxf(v, dppf<0x128>(v)); v = fmaxf(v, dppf<0x124>(v)); v = fmaxf(v, dppf<0x122>(v)); v = fmaxf(v, dppf<0x121>(v));
    v = fmaxf(v, __shfl_xor(v, 16)); v = fmaxf(v, __shfl_xor(v, 32)); return v;
}
__device__ __forceinline__ void mixB_attend4(const Args& a, int m0, const LAS unsigned short* sidx4, const LAS unsigned char* sbk4, LAS unsigned char* lds, LAS unsigned char* img, LAS unsigned char* pT, int lane, const int am = 0) {
    const bf16* P = (const bf16*)(a.ws + WS_BIG); const bf16* CKVN = (const bf16*)(a.ws + WS_CKVN); bf16* YS = (bf16*)((unsigned char*)a.out + DO_YS);
    const LAS float* rpb = (const LAS float*)(lds + RPB_OFF);
    const int t0 = m0 & (SEQ - 1); const size_t rowb = (size_t)(m0 - t0);
    const int hc = lane & 15, g = lane >> 4, hd = lane & 3;
    const float SC = 0.125f * LOG2E;
    const int i16 = lane & 15, tq4 = i16 >> 2, tp = i16 & 3;
    const int rd_tr = (4 * g + tq4) * 144 + 8 * tp;
    const int rd_p = hd * 128 + 8 * g;
    u32x4 g0, g1, g2, g3, g4, g5, g6, g7, nq0, nq1, nq2, nq3, nq4, nq5, nq6, nq7;
#define BG_ROW(QI, NS, CH, I, G) do { const int kk_ = 64 * (CH) + 8 * (I) + (lane >> 3); const int idx_ = (int)sidx4[(QI) * 256 + (kk_ < (NS) ? kk_ : 0)] & (SEQ - 1); \
        G = *(const u32x4*)(CKVN + (rowb + idx_) * 64 + 8 * (lane & 7)); } while (0)
#define BG_LOAD(QI, NS, CH) do { BG_ROW(QI, NS, CH, 0, g0); BG_ROW(QI, NS, CH, 1, g1); BG_ROW(QI, NS, CH, 2, g2); BG_ROW(QI, NS, CH, 3, g3); \
        BG_ROW(QI, NS, CH, 4, g4); BG_ROW(QI, NS, CH, 5, g5); BG_ROW(QI, NS, CH, 6, g6); BG_ROW(QI, NS, CH, 7, g7); } while (0)
#define BQ_LOAD(QI) do { const u32x4* qp_ = (const u32x4*)(P + (size_t)(m0 + (QI)) * PW + PC_BQ + hd * 64); \
        nq0 = qp_[0]; nq1 = qp_[1]; nq2 = qp_[2]; nq3 = qp_[3]; nq4 = qp_[4]; nq5 = qp_[5]; nq6 = qp_[6]; nq7 = qp_[7]; } while (0)
#define B_LO(V) __builtin_bit_cast(s16x4, (u32x2){(V).x, (V).y})
#define B_HI(V) __builtin_bit_cast(s16x4, (u32x2){(V).z, (V).w})
#define B_S2(SA, SB, Q, L) do { SA = __builtin_amdgcn_mfma_f32_4x4x4bf16_1k(B_LO(Q), B_LO(L), SA, 0, 0, 0); SB = __builtin_amdgcn_mfma_f32_4x4x4bf16_1k(B_HI(Q), B_HI(L), SB, 0, 0, 0); } while (0)
    { const int ns0 = (t0 + 1 < 256) ? t0 + 1 : 256; BQ_LOAD(0); BG_LOAD(0, ns0, 0); }
#pragma unroll 1
    for (int qi = 0; qi < 4; ++qi) {
        const int m = m0 + qi, tq = t0 + qi; const int nsel = (tq + 1 < 256) ? tq + 1 : 256; const int nsn = (tq + 2 < 256) ? tq + 2 : 256;
        const LAS unsigned char* sbk = sbk4 + qi * 256;
        const u32x4 q0 = nq0, q1 = nq1, q2 = nq2, q3 = nq3, q4 = nq4, q5 = nq5, q6 = nq6, q7 = nq7;
        if (qi + 1 < 4) BQ_LOAD(qi + 1);
        f32x4v oT[4];
#pragma unroll
        for (int mt = 0; mt < 4; ++mt) oT[mt] = (f32x4v){0.f, 0.f, 0.f, 0.f};
        f32x4v mrun = (f32x4v){-INFINITY, -INFINITY, -INFINITY, -INFINITY}, lsum = (f32x4v){0.f, 0.f, 0.f, 0.f};
#pragma unroll 1
        for (int ch = 0; ch < 4; ++ch) {
            if (64 * ch >= nsel) break;
            { LAS unsigned char* ip = img + (lane >> 3) * 144 + 16 * (lane & 7);
              *(LAS u32x4*)(ip) = g0; *(LAS u32x4*)(ip + 8 * 144) = g1; *(LAS u32x4*)(ip + 16 * 144) = g2; *(LAS u32x4*)(ip + 24 * 144) = g3;
              *(LAS u32x4*)(ip + 32 * 144) = g4; *(LAS u32x4*)(ip + 40 * 144) = g5; *(LAS u32x4*)(ip + 48 * 144) = g6; *(LAS u32x4*)(ip + 56 * 144) = g7; }
            if (64 * (ch + 1) < nsel) BG_LOAD(qi, nsel, ch + 1);
            else if (qi + 1 < 4) BG_LOAD(qi + 1, nsn, 0);
            f32x4v sa = (f32x4v){0.f, 0.f, 0.f, 0.f}, sb = sa, sc = sa, sd = sa;
            { const LAS u32x4* lp = (const LAS u32x4*)(img + lane * 144);
              const u32x4 l0 = lp[0], l1 = lp[1], l2 = lp[2], l3 = lp[3], l4 = lp[4], l5 = lp[5], l6 = lp[6], l7 = lp[7];
              B_S2(sa, sb, q0, l0); B_S2(sc, sd, q1, l1); B_S2(sa, sb, q2, l2); B_S2(sc, sd, q3, l3); B_S2(sa, sb, q4, l4); B_S2(sc, sd, q5, l5); B_S2(sa, sb, q6, l6); B_S2(sc, sd, q7, l7); }
            sa = (sa + sb) + (sc + sd);
            const int kpos = 64 * ch + lane;
            const int bk = (int)sbk[kpos < 256 ? kpos : 255];
            const f32x4v bb = *(const LAS f32x4v*)(rpb + bk * 8 + 4);
            f32x4v v = sa * SC + bb * LOG2E;
            if (kpos >= nsel) v = (f32x4v){-INFINITY, -INFINITY, -INFINITY, -INFINITY};
            const bool over = (v[0] > mrun[0] + 32.f) || (v[1] > mrun[1] + 32.f) || (v[2] > mrun[2] + 32.f) || (v[3] > mrun[3] + 32.f);
            if (__any(over)) {
                f32x4v mn, al;
#pragma unroll
                for (int i = 0; i < 4; ++i) { mn[i] = fmaxf(mrun[i], (am & 2) ? v[i] + 40.f : wave_max64(v[i])); al[i] = __builtin_amdgcn_exp2f(mrun[i] - mn[i]); }
                lsum = lsum * al; mrun = mn;
                const float ah = hd == 0 ? al[0] : hd == 1 ? al[1] : hd == 2 ? al[2] : al[3];
#pragma unroll
                for (int mt = 0; mt < 4; ++mt) oT[mt] = oT[mt] * ah;
            }
            f32x4v p;
#pragma unroll
            for (int i = 0; i < 4; ++i) p[i] = __builtin_amdgcn_exp2f(v[i] - mrun[i]);
            lsum = lsum + p;
            { const unsigned w01 = cvtpk_s(p[0], p[1]), w23 = cvtpk_s(p[2], p[3]); LAS unsigned short* pw = (LAS unsigned short*)pT + lane;
              pw[0] = (unsigned short)w01; pw[64] = (unsigned short)(w01 >> 16); pw[128] = (unsigned short)w23; pw[192] = (unsigned short)(w23 >> 16); }
            asm volatile("s_waitcnt lgkmcnt(0)" ::: "memory");
#pragma unroll
            for (int ks2 = 0; ks2 < 2; ++ks2) { if (am & 4) break;
                const u32x2 pl = *(const LAS u32x2*)(pT + rd_p + 64 * ks2), ph = *(const LAS u32x2*)(pT + rd_p + 64 * ks2 + 32);
                const bf16x8 pB = __builtin_bit_cast(bf16x8, (u32x4){pl.x, pl.y, ph.x, ph.y});
#pragma unroll
                for (int mt = 0; mt < 4; ++mt) {
                    const s16x4 lo = vtr(img + rd_tr + (32 * ks2) * 144 + 32 * mt), hi = vtr(img + rd_tr + (32 * ks2 + 16) * 144 + 32 * mt);
                    const bf16x8 A = (bf16x8){lo[0], lo[1], lo[2], lo[3], hi[0], hi[1], hi[2], hi[3]};
                    oT[mt] = __builtin_amdgcn_mfma_f32_16x16x32_bf16(A, pB, oT[mt], 0, 0, 0); } }
            asm volatile("s_waitcnt lgkmcnt(0)" ::: "memory");
        }
        f32x4v lt;
#pragma unroll
        for (int i = 0; i < 4; ++i) lt[i] = (am & 2) ? lsum[i] : wave_sum(lsum[i]);
        const float inv = 1.f / (hd == 0 ? lt[0] : hd == 1 ? lt[1] : hd == 2 ? lt[2] : lt[3]);
        if (hc < 4) { bf16* yo = YS + (size_t)m * 1024 + 256 + hc * 64 + 4 * g;
#pragma unroll
            for (int mt = 0; mt < 4; ++mt) { u32x2 w; w.x = cvtpk_s(oT[mt][0] * inv, oT[mt][1] * inv); w.y = cvtpk_s(oT[mt][2] * inv, oT[mt][3] * inv); *(u32x2*)(yo + 16 * mt) = w; } }
    }
#undef BG_LOAD
#undef BG_ROW
#undef BQ_LOAD
#undef B_LO
#undef B_HI
#undef B_S2
}
__device__ __forceinline__ void mixB_group(const Args& a, int l, int m0, LAS unsigned char* lds, LAS unsigned char* wscr, int lane_in, const int bmode = 15) {
    int lane = lane_in; asm volatile("" : "+v"(lane));
    const bf16* P = (const bf16*)(a.ws + WS_BIG);
    const int t0 = m0 & (SEQ - 1); const size_t rowb = (size_t)(m0 - t0);
    const int ql = lane & 31, hh = lane >> 5;
    LAS unsigned short* sidx = (LAS unsigned short*)wscr;
    LAS unsigned char* sbk = wscr + 2048;
    LAS unsigned char* img = wscr + 3584;
    const LAS unsigned char* bkt = lds + BKT_OFF;
    bf16x8 qf[2];
    { const int rho = ql, qi = 2 * ((rho >> 2) & 1) + (rho >> 4), hd = 4 * ((rho >> 3) & 1) + (rho & 3);
      const bf16* ip = P + (size_t)(m0 + qi) * PW + PC_IQ + hd * 32 + 8 * hh;
      qf[0] = *(const bf16x8*)(ip); qf[1] = *(const bf16x8*)(ip + 16); }
    float iw[2][8];
#pragma unroll
    for (int qq = 0; qq < 2; ++qq) { const u32x4 w = *(const u32x4*)(P + (size_t)(m0 + 2 * hh + qq) * PW + PC_IW); const float s = 0.0625f;
        iw[qq][0] = bflo(w.x) * s; iw[qq][1] = bfhi(w.x) * s; iw[qq][2] = bflo(w.y) * s; iw[qq][3] = bfhi(w.y) * s; iw[qq][4] = bflo(w.z) * s; iw[qq][5] = bfhi(w.z) * s; iw[qq][6] = bflo(w.w) * s; iw[qq][7] = bfhi(w.w) * s; }
    const int tq0 = t0 + 2 * hh;
    const int ntile = ((t0 + 3) >> 5) + 1;
    unsigned sk[2][64];
#pragma unroll
    for (int kb4 = 0; kb4 < 32; ++kb4) {
        if (2 * kb4 < ntile && (bmode & 1)) {
            bf16x8 kf0[2], kf1[2];
#pragma unroll
            for (int k4 = 0; k4 < 2; ++k4) { const int s = 32 * (2 * kb4 + k4) + ql; const bf16* kp = P + (rowb + s) * PW + PC_IK + 8 * hh; kf0[k4] = *(const bf16x8*)(kp); kf1[k4] = *(const bf16x8*)(kp + 16); }
#pragma unroll
            for (int k4 = 0; k4 < 2; ++k4) { const int kt = 2 * kb4 + k4; const int s = 32 * kt + ql;
                f32x16 acc;
#pragma unroll
                for (int i = 0; i < 16; ++i) acc[i] = 0.f;
                acc = __builtin_amdgcn_mfma_f32_32x32x16_bf16(qf[0], kf0[k4], acc, 0, 0, 0);
                acc = __builtin_amdgcn_mfma_f32_32x32x16_bf16(qf[1], kf1[k4], acc, 0, 0, 0);
                float s0 = 0.f, s1 = 0.f;
#pragma unroll
                for (int i = 0; i < 8; ++i) { s0 += fmaxf(acc[i], 0.f) * iw[0][i]; s1 += fmaxf(acc[8 + i], 0.f) * iw[1][i]; }
                sk[0][kt] = (s <= tq0) ? fkey(s0 + 0.f) : 0x007fffffu; sk[1][kt] = (s <= tq0 + 1) ? fkey(s1 + 0.f) : 0x007fffffu; }
        } else {
#pragma unroll
            for (int k4 = 0; k4 < 2; ++k4) { sk[0][2 * kb4 + k4] = 0x007fffffu; sk[1][2 * kb4 + k4] = 0x007fffffu; }
        }
    }
    const unsigned ltm = (1u << ql) - 1u;
    const int nblk8 = (ntile + 7) >> 3;
#define SK_RED(C) do { C += __builtin_amdgcn_update_dpp(0, C, 0x128, 0xf, 0xf, true); C += __builtin_amdgcn_update_dpp(0, C, 0x124, 0xf, 0xf, true); \
        C += __builtin_amdgcn_update_dpp(0, C, 0x122, 0xf, 0xf, true); C += __builtin_amdgcn_update_dpp(0, C, 0x121, 0xf, 0xf, true); C += __shfl_xor(C, 16); } while (0)
#define SK_CNT4(C, K0, K1, K2, K3, T) do { unsigned long long m0_, m1_, m2_, m3_; asm volatile( \
        "v_cmp_ge_u32_e64 %1, %5, %9\n\tv_cmp_ge_u32_e64 %2, %6, %9\n\tv_cmp_ge_u32_e64 %3, %7, %9\n\tv_cmp_ge_u32_e64 %4, %8, %9\n\t" \
        "v_addc_co_u32_e64 %0, %1, 0, %0, %1\n\tv_addc_co_u32_e64 %0, %2, 0, %0, %2\n\tv_addc_co_u32_e64 %0, %3, 0, %0, %3\n\tv_addc_co_u32_e64 %0, %4, 0, %0, %4" \
        : "+v"(C), "=&s"(m0_), "=&s"(m1_), "=&s"(m2_), "=&s"(m3_) : "v"(K0), "v"(K1), "v"(K2), "v"(K3), "v"(T)); } while (0)
#define SK_COUNT_GE(R0, R1, C0, C1) do { const unsigned r0_ = (R0), r1_ = (R1); _Pragma("unroll") for (int kb8 = 0; kb8 < 8; ++kb8) { if (kb8 < nblk8) { \
        SK_CNT4(C0, sk[0][8 * kb8], sk[0][8 * kb8 + 1], sk[0][8 * kb8 + 2], sk[0][8 * kb8 + 3], r0_); SK_CNT4(C1, sk[1][8 * kb8], sk[1][8 * kb8 + 1], sk[1][8 * kb8 + 2], sk[1][8 * kb8 + 3], r1_); \
        SK_CNT4(C0, sk[0][8 * kb8 + 4], sk[0][8 * kb8 + 5], sk[0][8 * kb8 + 6], sk[0][8 * kb8 + 7], r0_); SK_CNT4(C1, sk[1][8 * kb8 + 4], sk[1][8 * kb8 + 5], sk[1][8 * kb8 + 6], sk[1][8 * kb8 + 7], r1_); } } \
        SK_RED(C0); SK_RED(C1); } while (0)
#define SK_COUNT2(OP, R0, R1, C0, C1) do { _Pragma("unroll") for (int kb8 = 0; kb8 < 8; ++kb8) { if (kb8 < nblk8) { _Pragma("unroll") for (int k8 = 0; k8 < 8; ++k8) { \
        C0 += (sk[0][8 * kb8 + k8] OP (R0)) ? 1 : 0; C1 += (sk[1][8 * kb8 + k8] OP (R1)) ? 1 : 0; } } } SK_RED(C0); SK_RED(C1); } while (0)
#define KEY2F(K) __uint_as_float(((K) & 0x80000000u) ? ((K) & 0x7fffffffu) : ~(K))
#define SK_REDU(C, F) do { unsigned o_; o_ = (unsigned)__builtin_amdgcn_update_dpp(0, (int)C, 0x128, 0xf, 0xf, true); C = F(C, o_); o_ = (unsigned)__builtin_amdgcn_update_dpp(0, (int)C, 0x124, 0xf, 0xf, true); C = F(C, o_); \
        o_ = (unsigned)__builtin_amdgcn_update_dpp(0, (int)C, 0x122, 0xf, 0xf, true); C = F(C, o_); o_ = (unsigned)__builtin_amdgcn_update_dpp(0, (int)C, 0x121, 0xf, 0xf, true); C = F(C, o_); o_ = (unsigned)__shfl_xor((int)C, 16); C = F(C, o_); } while (0)
#define SK_UMIN(A, B) ((A) < (B) ? (A) : (B))
#define SK_UMAX(A, B) ((A) > (B) ? (A) : (B))
    constexpr int SEL_CAP = 12;
    unsigned KthA[2] = {0u, 0u}; int needA[2] = {0, 0};
    const bool big0 = (tq0 + 1 > 256), big1 = (tq0 + 2 > 256); bool exA[2] = {true, true};
    if (__any(big0 || big1) && (bmode & 2)) {
        float c255 = 255.5f, chalf = 0.5f; asm volatile("" : "+v"(c255), "+v"(chalf));
        unsigned klo[2], khi[2]; int chi[2] = {0, 0}; float x1[2], c1[2] = {0.f, 0.f}, x2[2] = {0.f, 0.f}, c2[2] = {0.f, 0.f}; bool done[2] = {!big0, !big1};
#pragma unroll
        for (int qq = 0; qq < 2; ++qq) { unsigned gm[8];
#pragma unroll
            for (int k8 = 0; k8 < 8; ++k8) gm[k8] = sk[qq][k8];
#pragma unroll
            for (int kb8 = 1; kb8 < 8; ++kb8) { if (kb8 < nblk8) {
#pragma unroll
                for (int k8 = 0; k8 < 8; ++k8) gm[k8] = SK_UMAX(gm[k8], sk[qq][8 * kb8 + k8]); } }
            unsigned mn = gm[0], mx = gm[0];
#pragma unroll
            for (int k8 = 1; k8 < 8; ++k8) { mn = SK_UMIN(mn, gm[k8]); mx = SK_UMAX(mx, gm[k8]); }
            SK_REDU(mn, SK_UMIN); SK_REDU(mx, SK_UMAX);
            klo[qq] = mn; khi[qq] = mx + 1u; x1[qq] = KEY2F(mx); exA[qq] = done[qq]; if (khi[qq] - klo[qq] <= 1u) done[qq] = true; }
#pragma unroll 1
        for (int it = 0; it < 64; ++it) {
            unsigned mk[2];
#pragma unroll
            for (int qq = 0; qq < 2; ++qq) { const unsigned lo = klo[qq], hi = khi[qq]; const float xlo = KEY2F(lo), xhi = KEY2F(hi - 1u); const float fmid = chalf * xlo + chalf * xhi;
                const float fs = x2[qq] + (c255 - c2[qq]) * (x2[qq] - x1[qq]) * __builtin_amdgcn_rcpf(c2[qq] - c1[qq]);
                unsigned m = fkey(it == 0 ? fmid : fs);
                if (it >= SEL_CAP || !(m > lo && m < hi)) { m = fkey(fmid); if (it >= SEL_CAP || !(m > lo && m < hi)) m = lo + ((hi - lo) >> 1); }
                mk[qq] = m; }
            int n0 = 0, n1 = 0;
            SK_COUNT_GE(mk[0], mk[1], n0, n1);
#pragma unroll
            for (int qq = 0; qq < 2; ++qq) { const int n = qq ? n1 : n0;
                if (!done[qq]) {
                    if (n >= 256) { klo[qq] = mk[qq]; if (n == 256) { exA[qq] = true; done[qq] = true; } } else { khi[qq] = mk[qq]; chi[qq] = n; }
                    if (it > 0) { x1[qq] = x2[qq]; c1[qq] = c2[qq]; }
                    x2[qq] = KEY2F(mk[qq]); c2[qq] = (float)n;
                    if (khi[qq] - klo[qq] <= 1u) done[qq] = true; } }
            if (__all(done[0] && done[1])) break;
        }
        KthA[0] = klo[0]; KthA[1] = klo[1]; needA[0] = 256 - chi[0]; needA[1] = 256 - chi[1];
    }
    bool sel_bad = false;
    if (bmode & 32) {
        int a0 = 0, a1 = 0, b0 = 0, b1 = 0; SK_COUNT2(>=, KthA[0], KthA[1], a0, a1); SK_COUNT2(>, KthA[0], KthA[1], b0, b1);
        if (big0) sel_bad = sel_bad || (exA[0] ? (a0 != 256) : !(a0 >= 256 && b0 < 256 && needA[0] == 256 - b0));
        if (big1) sel_bad = sel_bad || (exA[1] ? (a1 != 256) : !(a1 >= 256 && b1 < 256 && needA[1] == 256 - b1));
    }
    if (bmode & 16) { sidx[lane] = (unsigned short)(KthA[0] ^ KthA[1] ^ (unsigned)needA[0] ^ (unsigned)needA[1]); }
#pragma unroll
    for (int qq = 0; qq < 2; ++qq) {
        if (!(bmode & 4)) break;
        const int tq = tq0 + qq; const bool big = qq ? big1 : big0; const unsigned Kth = KthA[qq]; const int need = needA[qq]; const bool exact = exA[qq];
        LAS unsigned short* sx = sidx + (2 * hh + qq) * 256;
        int base = 0, tie_taken = 0; int ql2 = ql; asm volatile("" : "+v"(ql2));
#pragma unroll
        for (int kb8 = 0; kb8 < 8; ++kb8) { if (kb8 < nblk8) {
#pragma unroll
            for (int k8 = 0; k8 < 8; ++k8) { const int kt = 8 * kb8 + k8; const int s = 32 * kt + ql2; const unsigned k = sk[qq][kt]; bool take;
                if (!big) take = (s <= tq);
                else if (exact) take = (k >= Kth);
                else { const bool tie = (k == Kth); const unsigned long long mt = __ballot(tie); const unsigned mt32 = hh ? (unsigned)(mt >> 32) : (unsigned)mt;
                    take = (k > Kth) || (tie && (tie_taken + __popc(mt32 & ltm)) < need); tie_taken += __popc(mt32); }
                const unsigned long long ms = __ballot(take); const unsigned ms32 = hh ? (unsigned)(ms >> 32) : (unsigned)ms;
                if (take) sx[base + __popc(ms32 & ltm)] = (unsigned short)s;
                base += __popc(ms32); } } }
    }
#undef SK_COUNT2
#undef SK_COUNT_GE
#undef SK_CNT4
#undef SK_RED
#undef SK_REDU
#undef SK_UMIN
#undef SK_UMAX
#undef KEY2F
    LDS_WAIT(); asm volatile("" ::: "memory");
#pragma unroll
    for (int qi = 0; qi < 4; ++qi) { const int tq = t0 + qi; const int nsel = (tq + 1 < 256) ? tq + 1 : 256;
#pragma unroll
        for (int j = 0; j < 4; ++j) { const int pos = lane + 64 * j; if (pos < nsel) sbk[qi * 256 + pos] = bkt[tq - (int)sidx[qi * 256 + pos]]; } }
    LDS_WAIT(); asm volatile("" ::: "memory");
    if (bmode & 8) mixB_attend4(a, m0, sidx, sbk, lds, img, wscr + 3072, lane, (bmode >> 6) & 7);
    if ((bmode & 32) && __any(sel_bad)) { bf16* YS = (bf16*)((unsigned char*)a.out + DO_YS); for (int qi = 0; qi < 4; ++qi) ((unsigned short*)YS)[(size_t)(m0 + qi) * 1024 + 256 + lane] = 0x7fc0; }
}
constexpr int DM_OFF = 111616;
__device__ __forceinline__ bf16x8 frag2(const LAS unsigned char* p0, const LAS unsigned char* p1) {
    const s16x4 lo = *(const LAS s16x4*)p0, hi = *(const LAS s16x4*)p1; return (bf16x8){lo[0], lo[1], lo[2], lo[3], hi[0], hi[1], hi[2], hi[3]}; }
__device__ __forceinline__ bf16x8 fragtr(const LAS unsigned char* p0, const LAS unsigned char* p1) {
    const s16x4 lo = vtr(p0), hi = vtr(p1); return (bf16x8){lo[0], lo[1], lo[2], lo[3], hi[0], hi[1], hi[2], hi[3]}; }
__device__ __forceinline__ bf16x8 packf(f32x4 lo, f32x4 hi) { u32x4 w; w.x = cvtpk_s(lo[0], lo[1]); w.y = cvtpk_s(lo[2], lo[3]); w.z = cvtpk_s(hi[0], hi[1]); w.w = cvtpk_s(hi[2], hi[3]); return __builtin_bit_cast(bf16x8, w); }
__device__ __forceinline__ void dchunk_wave(const Args& a, int l, int bh, LAS unsigned char* dm, int lane_in) {
    int lane = lane_in; asm volatile("" : "+v"(lane));
    const int b = bh >> 2, h = bh & 3, hc = lane & 15, g = lane >> 4;
    LAS unsigned char* sAT = dm; LAS unsigned char* sBT = dm + 2304; LAS unsigned char* sKT = dm + 4608; LAS unsigned char* sRT = dm + 6912; LAS unsigned char* sVT = dm + 9216; LAS unsigned char* sUT = dm + 11520;
    LAS float* sW1 = (LAS float*)(dm + 13824); LAS float* sMB = (LAS float*)(dm + 17920); LAS float* sCL = (LAS float*)(dm + 18944); LAS float* sBON = (LAS float*)(dm + 19200);
    const bf16* DR = (const bf16*)((unsigned char*)a.out + DO_DR); const bf16* DKP = (const bf16*)((unsigned char*)a.out + DO_DKP); const bf16* DV = (const bf16*)((unsigned char*)a.out + DO_DV); const bf16* DKK = (const bf16*)((unsigned char*)a.out + DO_DKK);
    const float* DCL = (const float*)(a.ws + WS_BIG + BIG_DW); const bf16* DAI = (const bf16*)(a.ws + WS_BIG + BIG_DAI); const bf16* DG = (const bf16*)(a.ws + WS_BIG + BIG_DG);
    const float* BON = (const float*)(a.ws + WS_BON); bf16* YS = (bf16*)((unsigned char*)a.out + DO_YS);
    float gnw[4], gnb[4];
#pragma unroll
    for (int vt = 0; vt < 4; ++vt) { gnw[vt] = a.in[17][l * 256 + h * 64 + 16 * vt + hc]; gnb[vt] = a.in[18][l * 256 + h * 64 + 16 * vt + hc]; }
    const size_t tok0 = (size_t)b * SEQ;
    f32x4v T[4][4];
#pragma unroll
    for (int kt = 0; kt < 4; ++kt)
#pragma unroll
        for (int vt = 0; vt < 4; ++vt) T[kt][vt] = (f32x4v){0.f, 0.f, 0.f, 0.f};
    const int lrow = lane >> 3, lseg = lane & 7;
    u32x4 nA0, nA1, nB0, nB1, nK0, nK1, nR0, nR1, nV0, nV1; float nCL, nBON;
#define DC_LOAD(CH) do { const size_t e0_ = (tok0 + (size_t)(CH) * 16 + lrow) * 256 + h * 64 + 8 * lseg, e1_ = e0_ + 8 * 256; \
        nA0 = *(const u32x4*)(DKK + e0_); nA1 = *(const u32x4*)(DKK + e1_); nB0 = *(const u32x4*)(DAI + e0_); nB1 = *(const u32x4*)(DAI + e1_); nK0 = *(const u32x4*)(DKP + e0_); nK1 = *(const u32x4*)(DKP + e1_); \
        nR0 = *(const u32x4*)(DR + e0_); nR1 = *(const u32x4*)(DR + e1_); nV0 = *(const u32x4*)(DV + e0_); nV1 = *(const u32x4*)(DV + e1_); \
        nCL = DCL[((size_t)b * (SEQ / 16) + (CH)) * 256 + h * 64 + lane]; nBON = BON[(tok0 + (size_t)(CH) * 16 + (lane & 15)) * 4 + h]; } while (0)
    DC_LOAD(0);
    const int st0 = lrow * 144 + lseg * 16, st1 = st0 + 8 * 144;
    const int rdf = hc * 144 + 8 * g;
    const int rdt = (4 * g + (hc >> 2)) * 144 + 8 * (hc & 3);
    __builtin_amdgcn_s_setprio(2);
#pragma unroll 1
    for (int ch = 0; ch < SEQ / 16; ++ch) {
        *(LAS u32x4*)(sAT + st0) = nA0; *(LAS u32x4*)(sAT + st1) = nA1; *(LAS u32x4*)(sBT + st0) = nB0; *(LAS u32x4*)(sBT + st1) = nB1; *(LAS u32x4*)(sKT + st0) = nK0; *(LAS u32x4*)(sKT + st1) = nK1;
        *(LAS u32x4*)(sRT + st0) = nR0; *(LAS u32x4*)(sRT + st1) = nR1; *(LAS u32x4*)(sVT + st0) = nV0; *(LAS u32x4*)(sVT + st1) = nV1; sCL[lane] = nCL; if (lane < 16) sBON[lane] = nBON;
        unsigned short gq[4][4];
#pragma unroll
        for (int vt = 0; vt < 4; ++vt)
#pragma unroll
            for (int i = 0; i < 4; ++i) gq[vt][i] = DG[(tok0 + (size_t)ch * 16 + 4 * g + i) * 256 + h * 64 + 16 * vt + hc];
        asm volatile("s_waitcnt lgkmcnt(0)" ::: "memory");
        bf16x8 fA[2], fR[2], fB[2], fK[2];
#pragma unroll
        for (int ks = 0; ks < 2; ++ks) { fA[ks] = frag2(sAT + rdf + 64 * ks, sAT + rdf + 64 * ks + 32); fR[ks] = frag2(sRT + rdf + 64 * ks, sRT + rdf + 64 * ks + 32);
            fB[ks] = frag2(sBT + rdf + 64 * ks, sBT + rdf + 64 * ks + 32); fK[ks] = frag2(sKT + rdf + 64 * ks, sKT + rdf + 64 * ks + 32); }
        f32x4v U0[4], Y0[4];
#pragma unroll
        for (int vt = 0; vt < 4; ++vt) { const bf16x8 s0 = packf(T[0][vt], T[1][vt]), s1 = packf(T[2][vt], T[3][vt]);
            f32x4v u = (f32x4v){0.f, 0.f, 0.f, 0.f}, y = (f32x4v){0.f, 0.f, 0.f, 0.f};
            u = __builtin_amdgcn_mfma_f32_16x16x32_bf16(fA[0], s0, u, 0, 0, 0); u = __builtin_amdgcn_mfma_f32_16x16x32_bf16(fA[1], s1, u, 0, 0, 0);
            y = __builtin_amdgcn_mfma_f32_16x16x32_bf16(fR[0], s0, y, 0, 0, 0); y = __builtin_amdgcn_mfma_f32_16x16x32_bf16(fR[1], s1, y, 0, 0, 0);
            U0[vt] = u; Y0[vt] = y; }
        f32x4v Mka = (f32x4v){0.f, 0.f, 0.f, 0.f}, Mba = Mka, Mkr = Mka, Mbr = Mka;
#pragma unroll
        for (int ks = 0; ks < 2; ++ks) { Mka = __builtin_amdgcn_mfma_f32_16x16x32_bf16(fK[ks], fA[ks], Mka, 0, 0, 0); Mba = __builtin_amdgcn_mfma_f32_16x16x32_bf16(fB[ks], fA[ks], Mba, 0, 0, 0);
            Mkr = __builtin_amdgcn_mfma_f32_16x16x32_bf16(fK[ks], fR[ks], Mkr, 0, 0, 0); Mbr = __builtin_amdgcn_mfma_f32_16x16x32_bf16(fB[ks], fR[ks], Mbr, 0, 0, 0); }
#pragma unroll
        for (int i = 0; i < 4; ++i) { const int srow = 4 * g + i; if (!(srow < hc)) { Mka[i] = 0.f; Mba[i] = 0.f; } if (!(srow <= hc)) { Mkr[i] = 0.f; Mbr[i] = 0.f; } }
        if (ch + 1 < SEQ / 16) DC_LOAD(ch + 1);
        const f32x4v z4 = (f32x4v){0.f, 0.f, 0.f, 0.f};
        { const bf16x8 aM = packf(Mka, z4);
#pragma unroll
          for (int vt = 0; vt < 4; ++vt) { const s16x4 lo = vtr(sVT + rdt + 32 * vt); const bf16x8 bV = (bf16x8){lo[0], lo[1], lo[2], lo[3], 0, 0, 0, 0};
              U0[vt] = __builtin_amdgcn_mfma_f32_16x16x32_bf16(aM, bV, U0[vt], 0, 0, 0); } }
#pragma unroll
        for (int vt = 0; vt < 4; ++vt)
#pragma unroll
            for (int i = 0; i < 4; ++i) sW1[(4 * g + i) * 64 + 16 * vt + hc] = U0[vt][i];
        *(LAS f32x4v*)(sMB + hc * 16 + 4 * g) = Mba;
        asm volatile("s_waitcnt lgkmcnt(0)" ::: "memory");
        { float u[16];
#pragma unroll
          for (int t = 0; t < 16; ++t) { float acc = sW1[t * 64 + lane];
#pragma unroll
              for (int sq = 0; sq < 4; ++sq) { if (4 * sq < t) { const f32x4v mb = *(const LAS f32x4v*)(sMB + t * 16 + 4 * sq);
#pragma unroll
                  for (int e = 0; e < 4; ++e) if (4 * sq + e < t) acc += mb[e] * u[4 * sq + e]; } }
              u[t] = acc; ((LAS bf16*)sUT)[t * 72 + lane] = (bf16)f2bf(acc); } }
        asm volatile("s_waitcnt lgkmcnt(0)" ::: "memory");
        f32x4v bonv = *(const LAS f32x4v*)(sBON + 4 * g);
        { const bf16x8 aM = packf(Mbr, Mkr);
#pragma unroll
          for (int vt = 0; vt < 4; ++vt) { const bf16x8 bUV = fragtr(sUT + rdt + 32 * vt, sVT + rdt + 32 * vt); Y0[vt] = __builtin_amdgcn_mfma_f32_16x16x32_bf16(aM, bUV, Y0[vt], 0, 0, 0); } }
        { bf16x8 bUV[4];
#pragma unroll
          for (int vt = 0; vt < 4; ++vt) bUV[vt] = fragtr(sUT + rdt + 32 * vt, sVT + rdt + 32 * vt);
#pragma unroll
          for (int kt = 0; kt < 4; ++kt) { const bf16x8 aBK = fragtr(sBT + rdt + 32 * kt, sKT + rdt + 32 * kt); const f32x4v cl = *(const LAS f32x4v*)(sCL + 16 * kt + 4 * g);
#pragma unroll
              for (int vt = 0; vt < 4; ++vt) T[kt][vt] = __builtin_amdgcn_mfma_f32_16x16x32_bf16(aBK, bUV[vt], T[kt][vt], 0, 0, 0) * cl; } }
#pragma unroll
        for (int i = 0; i < 4; ++i) { float sm = (Y0[0][i] + Y0[1][i]) + (Y0[2][i] + Y0[3][i]);
            sm += dppf<0x128>(sm); sm += dppf<0x124>(sm); sm += dppf<0x122>(sm); sm += dppf<0x121>(sm);
            const float mean = sm * (1.f / 64.f); float sq = 0.f;
#pragma unroll
            for (int vt = 0; vt < 4; ++vt) { const float d = Y0[vt][i] - mean; sq += d * d; }
            sq += dppf<0x128>(sq); sq += dppf<0x124>(sq); sq += dppf<0x122>(sq); sq += dppf<0x121>(sq);
            const float rstd = rsqrtf(sq * (1.f / 64.f) + 64e-5f); const int t = 4 * g + i;
#pragma unroll
            for (int vt = 0; vt < 4; ++vt) { const float vv = bf2f(((const LAS bf16*)sVT)[t * 72 + 16 * vt + hc]);
                const float o = ((Y0[vt][i] - mean) * rstd * gnw[vt] + gnb[vt] + bonv[i] * vv) * bf2f(gq[vt][i]);
                YS[(tok0 + (size_t)ch * 16 + t) * 1024 + 768 + h * 64 + 16 * vt + hc] = (bf16)f2bf(o); } }
        asm volatile("s_waitcnt lgkmcnt(0)" ::: "memory");
    }
    __builtin_amdgcn_s_setprio(0);
#undef DC_LOAD
}
__device__ __forceinline__ void cchunk_wave(const Args& a, int l, int bh, LAS unsigned char* dm, int lane_in) {
    int lane = lane_in; asm volatile("" : "+v"(lane));
    const int b = bh >> 2, h = bh & 3, hc = lane & 15, g = lane >> 4;
    LAS unsigned char* sQT = dm; LAS unsigned char* sKT = dm + 1280; LAS unsigned char* sVT = dm + 2560; LAS float* sCL = (LAS float*)(dm + 4864);
    const bf16* P = (const bf16*)(a.ws + WS_BIG); const bf16* CQH = (const bf16*)(a.ws + WS_CA); const bf16* CKT = (const bf16*)(a.ws + WS_CA + 16 * MiB); const float* CCL = (const float*)(a.ws + WS_END);
    bf16* YS = (bf16*)((unsigned char*)a.out + DO_YS);
    float ng[4];
#pragma unroll
    for (int vt = 0; vt < 4; ++vt) ng[vt] = a.in[7][l * 256 + h * 64 + 16 * vt + hc];
    const size_t tok0 = (size_t)b * SEQ;
    f32x4v T[2][4];
#pragma unroll
    for (int kt = 0; kt < 2; ++kt)
#pragma unroll
        for (int vt = 0; vt < 4; ++vt) T[kt][vt] = (f32x4v){0.f, 0.f, 0.f, 0.f};
    const int qrow = lane >> 2, qseg = lane & 3, lrow = lane >> 3, lseg = lane & 7;
    u32x4 nQ, nK, nV0, nV1; float nCL;
#define CC_LOAD(CH) do { const size_t tq_ = tok0 + (size_t)(CH) * 16 + qrow; nQ = *(const u32x4*)(CQH + tq_ * 128 + h * 32 + 8 * qseg); nK = *(const u32x4*)(CKT + tq_ * 128 + h * 32 + 8 * qseg); \
        const size_t tv_ = tok0 + (size_t)(CH) * 16 + lrow; nV0 = *(const u32x4*)(P + tv_ * PW + PC_CV + h * 64 + 8 * lseg); nV1 = *(const u32x4*)(P + (tv_ + 8) * PW + PC_CV + h * 64 + 8 * lseg); \
        nCL = CCL[((size_t)b * (SEQ / 16) + (CH)) * 128 + h * 32 + (lane & 31)]; } while (0)
    CC_LOAD(0);
    const int rdf = hc * 80 + 8 * g;
    const int rdtk = (4 * g + (hc >> 2)) * 80 + 8 * (hc & 3);
    const int rdtv = (4 * g + (hc >> 2)) * 144 + 8 * (hc & 3);
    __builtin_amdgcn_s_setprio(2);
#pragma unroll 1
    for (int ch = 0; ch < SEQ / 16; ++ch) {
        *(LAS u32x4*)(sQT + qrow * 80 + qseg * 16) = nQ; *(LAS u32x4*)(sKT + qrow * 80 + qseg * 16) = nK;
        *(LAS u32x4*)(sVT + lrow * 144 + lseg * 16) = nV0; *(LAS u32x4*)(sVT + (lrow + 8) * 144 + lseg * 16) = nV1; if (lane < 32) sCL[lane] = nCL;
        unsigned short gq[4][4];
#pragma unroll
        for (int vt = 0; vt < 4; ++vt)
#pragma unroll
            for (int i = 0; i < 4; ++i) gq[vt][i] = P[(tok0 + (size_t)ch * 16 + 4 * g + i) * PW + PC_CG + h * 64 + 16 * vt + hc];
        asm volatile("s_waitcnt lgkmcnt(0)" ::: "memory");
        const bf16x8 fQ = frag2(sQT + rdf, sQT + rdf + 32), fK = frag2(sKT + rdf, sKT + rdf + 32);
        f32x4v Y0[4];
#pragma unroll
        for (int vt = 0; vt < 4; ++vt) { const bf16x8 s0 = packf(T[0][vt], T[1][vt]); Y0[vt] = __builtin_amdgcn_mfma_f32_16x16x32_bf16(fQ, s0, (f32x4v){0.f, 0.f, 0.f, 0.f}, 0, 0, 0); }
        f32x4v Mkq = __builtin_amdgcn_mfma_f32_16x16x32_bf16(fK, fQ, (f32x4v){0.f, 0.f, 0.f, 0.f}, 0, 0, 0);
#pragma unroll
        for (int i = 0; i < 4; ++i) if (!(4 * g + i <= hc)) Mkq[i] = 0.f;
        if (ch + 1 < SEQ / 16) CC_LOAD(ch + 1);
        const f32x4v z4 = (f32x4v){0.f, 0.f, 0.f, 0.f};
        bf16x8 bV[4];
#pragma unroll
        for (int vt = 0; vt < 4; ++vt) { const s16x4 lo = vtr(sVT + rdtv + 32 * vt); bV[vt] = (bf16x8){lo[0], lo[1], lo[2], lo[3], 0, 0, 0, 0}; }
        { const bf16x8 aM = packf(Mkq, z4);
#pragma unroll
          for (int vt = 0; vt < 4; ++vt) Y0[vt] = __builtin_amdgcn_mfma_f32_16x16x32_bf16(aM, bV[vt], Y0[vt], 0, 0, 0); }
#pragma unroll
        for (int kt = 0; kt < 2; ++kt) { const s16x4 lo = vtr(sKT + rdtk + 32 * kt); const bf16x8 aK = (bf16x8){lo[0], lo[1], lo[2], lo[3], 0, 0, 0, 0}; const f32x4v cl = *(const LAS f32x4v*)(sCL + 16 * kt + 4 * g);
#pragma unroll
            for (int vt = 0; vt < 4; ++vt) T[kt][vt] = __builtin_amdgcn_mfma_f32_16x16x32_bf16(aK, bV[vt], T[kt][vt], 0, 0, 0) * cl; }
#pragma unroll
        for (int i = 0; i < 4; ++i) { float sq = 0.f;
#pragma unroll
            for (int vt = 0; vt < 4; ++vt) { const float o = Y0[vt][i] * 0.17677669529663687f; Y0[vt][i] = o; sq += o * o; }
            sq += dppf<0x128>(sq); sq += dppf<0x124>(sq); sq += dppf<0x122>(sq); sq += dppf<0x121>(sq);
            const float rn = rsqrtf(sq * (1.f / 64.f) + 1e-6f); const int t = 4 * g + i;
#pragma unroll
            for (int vt = 0; vt < 4; ++vt) { const float gg = bf2f(gq[vt][i]);
                YS[(tok0 + (size_t)ch * 16 + t) * 1024 + 512 + h * 64 + 16 * vt + hc] = (bf16)f2bf(gg * sigmoidf_(gg) * (Y0[vt][i] * rn * ng[vt])); } }
        asm volatile("s_waitcnt lgkmcnt(0)" ::: "memory");
    }
    __builtin_amdgcn_s_setprio(0);
#undef CC_LOAD
}
__device__ __forceinline__ int lane_now() { unsigned on_ = ~0u; asm volatile("" : "+s"(on_)); return (int)__builtin_amdgcn_mbcnt_hi(on_, __builtin_amdgcn_mbcnt_lo(on_, 0u)); }
#define LANE_ARG lane_now()
__device__ __forceinline__ void mixers_phase(const Args& a, int l, LAS unsigned char* lds, int bid, int G, int tid, int wave, int lane, int qsel = 0, int mixmask = 15, const int bmode = 15) {
    LAS unsigned char* wscr = lds + wave * 12800;
    mixA_tables(a, lds, tid); __syncthreads();
    if (wave == 0) for (int it = bid; it < 256; it += G) { if (it < 128) { if (mixmask & 1) dchunk_wave(a, l, it, lds + DM_OFF, LANE_ARG); } else { if (mixmask & 2) cchunk_wave(a, l, it - 128, lds + DM_OFF, LANE_ARG); } }
    unsigned* qbase = (unsigned*)(a.ws + WS_CTL) + CW_Q + 1024 * l + 512 * qsel;
    const int myx = (int)(xb_xcc_id() & 7u);
    int soff = 0;
    for (;;) {
        if (soff >= 8) break;
        const int xq = (myx + soff) & 7;
        unsigned cq = 0; if (LANE_ARG == 0) cq = __hip_atomic_fetch_add(qbase + 64 * xq, 1u, __ATOMIC_RELAXED, __HIP_MEMORY_SCOPE_AGENT);
        cq = (unsigned)__builtin_amdgcn_readfirstlane((int)cq);
        if (cq >= 2048u) { ++soff; continue; }
        int b, tb = -1, at = 0;
        if (cq < 1920u) { const int bl = (int)cq / 480, j = (int)cq - bl * 480; b = 4 * xq + bl; if (j < 224) tb = 255 - j; else at = j - 224; }
        else { const int k = (int)cq - 1920; b = 4 * xq + (k >> 5); tb = 31 - (k & 31); }
        if (tb >= 0) { if (!(mixmask & 8)) continue; const int m0 = b * SEQ + tb * 8;
#pragma unroll 1
            for (int k = 0; k < 2; ++k) {
#ifndef MIX_NO_B
                mixB_group(a, l, m0 + 4 * k, lds, wscr, LANE_ARG, bmode);
#endif
            } }
        else { if (!(mixmask & 4)) continue;
#ifndef MIX_NO_A
            mixA_task(a, b, (at >> 4) & 3, at & 15, 3 - (at >> 6), lds, wave, LANE_ARG);
#endif
        }
    }
}

constexpr int RREC_OFF = MISC_OFF + 4096, LCNT_OFF = MISC_OFF + 10240, LBASE_OFF = MISC_OFF + 10368;
__device__ __forceinline__ void ln1_route_phase(const Args& a, int l, LAS unsigned char* lds, int bid, int G, int tid, int wave, int lane) {
    bf16* XB = (bf16*)(a.ws + WS_XB); const float* WRT = (const float*)(a.ws + WS_RT) + (size_t)l * 36 * 1024;
    unsigned* tokinfo = (unsigned*)(a.ws + WS_TOK); unsigned* cntg = (unsigned*)(a.ws + WS_CTL) + CW_CNT + (l * 32) * 64;
    const float* lng = a.in[21] + (l * 2 + 0) * 1024; const float* lnb = a.in[22] + (l * 2 + 0) * 1024;
    const float* brg = a.in[24] + l * 4; const float* bre = a.in[26] + l * 32;
    LAS float* sW = (LAS float*)lds;
    LAS unsigned* rrec = (LAS unsigned*)(lds + RREC_OFF); LAS int* lcnt = (LAS int*)(lds + LCNT_OFF); LAS unsigned* lbase = (LAS unsigned*)(lds + LBASE_OFF);
    for (int i = tid; i < 32 * 1024 / 4; i += NTHR) *(LAS f32x4*)(sW + 4 * i) = *(const f32x4*)(WRT + 4 * 1024 + 4 * i);
    f32x4 gam[4], bet[4], wg[4][4];
#pragma unroll
    for (int j = 0; j < 4; ++j) { gam[j] = *(const f32x4*)(lng + 4 * lane + 256 * j); bet[j] = *(const f32x4*)(lnb + 4 * lane + 256 * j);
#pragma unroll
        for (int e = 0; e < 4; ++e) wg[e][j] = *(const f32x4*)(WRT + e * 1024 + 4 * lane + 256 * j); }
    for (int blk = bid; blk < NTOK / 256; blk += G) {
        if (tid < 32) lcnt[tid] = 0;
        __syncthreads();
#pragma unroll 1
        for (int rg = 0; rg < 8; ++rg) {
            const int rl0 = wave * 32 + rg * 4; f32x4 x[4][4];
#pragma unroll
            for (int r = 0; r < 4; ++r) { bf16* xr = XB + (size_t)(blk * 256 + rl0 + r) * 1024; float s = 0.f;
#pragma unroll
                for (int j = 0; j < 4; ++j) { const u32x2 w = *(const u32x2*)(xr + 4 * lane + 256 * j); x[r][j] = (f32x4){bflo(w.x), bfhi(w.x), bflo(w.y), bfhi(w.y)}; s += (x[r][j][0] + x[r][j][1]) + (x[r][j][2] + x[r][j][3]); }
                const float mean = wave_sum(s) * (1.f / 1024.f); float q = 0.f;
#pragma unroll
                for (int j = 0; j < 4; ++j) { x[r][j] = x[r][j] - mean; q += (x[r][j][0] * x[r][j][0] + x[r][j][1] * x[r][j][1]) + (x[r][j][2] * x[r][j][2] + x[r][j][3] * x[r][j][3]); }
                const float rstd = rsqrtf(wave_sum(q) * (1.f / 1024.f) + LN_EPS);
#pragma unroll
                for (int j = 0; j < 4; ++j) { x[r][j] = x[r][j] * rstd * gam[j] + bet[j]; u32x2 w; w.x = pk2(x[r][j][0], x[r][j][1]); w.y = pk2(x[r][j][2], x[r][j][3]); *(u32x2*)(xr + 4 * lane + 256 * j) = w; }
                }
            float gl[4][4];
#pragma unroll
            for (int e = 0; e < 4; ++e)
#pragma unroll
                for (int r = 0; r < 4; ++r) { float d = 0.f;
#pragma unroll
                    for (int j = 0; j < 4; ++j) d += (x[r][j][0] * wg[e][j][0] + x[r][j][1] * wg[e][j][1]) + (x[r][j][2] * wg[e][j][2] + x[r][j][3] * wg[e][j][3]);
                    gl[r][e] = wave_sum(d) + brg[e]; }
#pragma unroll
            for (int r = 0; r < 4; ++r) {
                const float g0 = gl[r][0], g1 = gl[r][1], g2 = gl[r][2], g3 = gl[r][3];
                int gsv = 0; float gm = g0; if (g1 > gm) { gm = g1; gsv = 1; } if (g2 > gm) { gm = g2; gsv = 2; } if (g3 > gm) { gm = g3; gsv = 3; }
                const int gs = __builtin_amdgcn_readfirstlane(gsv);
                const float ptop = 1.f / (__expf(g0 - gm) + __expf(g1 - gm) + __expf(g2 - gm) + __expf(g3 - gm));
                float v0 = -INFINITY, v1 = -INFINITY; int i0 = 0, i1 = 0;
#pragma unroll 2
                for (int jj = 0; jj < 8; ++jj) { const int e = gs * 8 + jj; float d = 0.f;
#pragma unroll
                    for (int j = 0; j < 4; ++j) { const f32x4 w4 = *(const LAS f32x4*)(sW + e * 1024 + 4 * lane + 256 * j); d += (x[r][j][0] * w4[0] + x[r][j][1] * w4[1]) + (x[r][j][2] * w4[2] + x[r][j][3] * w4[3]); }
                    const float le = wave_sum(d) + bre[e];
                    if (le > v0) { v1 = v0; i1 = i0; v0 = le; i0 = jj; } else if (le > v1) { v1 = le; i1 = jj; } }
                const float ex = __expf(v1 - v0), w0 = ptop / (1.f + ex), w1 = ptop * ex / (1.f + ex);
                if (lane == 0) { const int e0 = gs * 8 + i0, e1 = gs * 8 + i1; const int rl = rl0 + r;
                    const int p0 = atomicAdd((int*)&lcnt[e0], 1), p1 = atomicAdd((int*)&lcnt[e1], 1);
                    rrec[rl * 6 + 0] = (unsigned)e0; rrec[rl * 6 + 1] = (unsigned)p0; rrec[rl * 6 + 2] = __float_as_uint(w0); rrec[rl * 6 + 3] = (unsigned)e1; rrec[rl * 6 + 4] = (unsigned)p1; rrec[rl * 6 + 5] = __float_as_uint(w1); } }
        }
        __syncthreads();
        if (tid < 32) lbase[tid] = __hip_atomic_fetch_add(cntg + tid * 64, (unsigned)lcnt[tid], __ATOMIC_RELAXED, __HIP_MEMORY_SCOPE_AGENT);
        __syncthreads();
        if (tid < 256) { const unsigned e0 = rrec[tid * 6 + 0], e1 = rrec[tid * 6 + 3]; unsigned* ti = tokinfo + (size_t)(blk * 256 + tid) * 8;
            u32x4 o0, o1; o0.x = e0; o0.y = lbase[e0] + rrec[tid * 6 + 1]; o0.z = rrec[tid * 6 + 2]; o0.w = e1; o1.x = lbase[e1] + rrec[tid * 6 + 4]; o1.y = rrec[tid * 6 + 5]; o1.z = 0u; o1.w = 0u;
            *(u32x4*)ti = o0; *(u32x4*)(ti + 4) = o1; }
        __syncthreads();
    }
}
__device__ __forceinline__ void moe_table(const Args& a, int l, LAS unsigned char* lds, int tid) {
    LAS int* tstart = (LAS int*)(lds + TST_OFF);
    if (tid < 64) { const unsigned* cntg = (const unsigned*)(a.ws + WS_CTL) + CW_CNT + (l * 32) * 64;
        int v = (tid < 32) ? (int)((__hip_atomic_load(cntg + tid * 64, __ATOMIC_RELAXED, __HIP_MEMORY_SCOPE_AGENT) + 255u) >> 8) : 0; const int mine = v;
#pragma unroll
        for (int o = 1; o < 32; o <<= 1) { const int u = __shfl_up(v, o); if ((tid & 63) >= o) v += u; }
        if (tid < 32) tstart[tid] = v - mine; if (tid == 31) tstart[32] = v; }
    __syncthreads();
}
__device__ __forceinline__ void scatter_phase(const Args& a, int l, LAS unsigned char* lds, int bid, int G, int tid, int gw, int NGW, int lane) {
    const LAS int* tstart = (const LAS int*)(lds + TST_OFF);
    const bf16* XB = (const bf16*)(a.ws + WS_XB); bf16* XS = (bf16*)(a.ws + WS_BIG); unsigned* rowinfo = (unsigned*)(a.ws + WS_ROW); const unsigned* tokinfo = (const unsigned*)(a.ws + WS_TOK);
    const unsigned* cntg = (const unsigned*)(a.ws + WS_CTL) + CW_CNT + (l * 32) * 64;
    for (int e = bid; e < 32; e += G) { const int c = (int)__hip_atomic_load(cntg + e * 64, __ATOMIC_RELAXED, __HIP_MEMORY_SCOPE_AGENT); const int r0 = tstart[e] * 256, r1 = tstart[e + 1] * 256;
        unsigned neg_ = 0xffffffffu, zer_ = 0u; asm volatile("" : "+v"(neg_), "+v"(zer_));
        for (int r = r0 + c + tid; r < r1; r += NTHR) { rowinfo[2 * (size_t)r] = neg_; rowinfo[2 * (size_t)r + 1] = zer_; } }
    u32x4 nt0; u32x2 nt1;
#define SC_LOAD(mm) do { nt0 = *(const u32x4*)(tokinfo + (size_t)(mm) * 8); nt1 = *(const u32x2*)(tokinfo + (size_t)(mm) * 8 + 4); } while (0)
    const int gt = gw * 64 + lane, NT = NGW * 64;
    for (int m = gt; m < NTOK; m += NT) {
        SC_LOAD(m); const u32x4 t0 = nt0; const u32x2 t1 = nt1;
        const size_t r0 = (size_t)tstart[t0.x] * 256 + t0.y, r1 = (size_t)tstart[t0.w] * 256 + t1.x;
        *(u32x2*)(rowinfo + 2 * r0) = (u32x2){(unsigned)(m * 2), t0.z}; *(u32x2*)(rowinfo + 2 * r1) = (u32x2){(unsigned)(m * 2 + 1), t1.y};
    }
#undef SC_LOAD
}
__device__ __forceinline__ void ln2_phase(const Args& a, int l, int gw, int NGW, int lane) {
    bf16* XB = (bf16*)(a.ws + WS_XB); const bf16* Y = (const bf16*)(a.ws + WS_BIG);
    const float* lng = a.in[21] + (l * 2 + 1) * 1024; const float* lnb = a.in[22] + (l * 2 + 1) * 1024;
    f32x4 gam[4], bet[4];
#pragma unroll
    for (int j = 0; j < 4; ++j) { gam[j] = *(const f32x4*)(lng + 4 * lane + 256 * j); bet[j] = *(const f32x4*)(lnb + 4 * lane + 256 * j); }
    for (int m0 = gw; m0 < NTOK; m0 += 4 * NGW) {
        u32x2 cw[4][4], cp2[4][4], cq2[4][4];
#pragma unroll
        for (int r = 0; r < 4; ++r) { const int m = m0 + r * NGW; if (m < NTOK) { const bf16* xr_ = XB + (size_t)m * 1024 + 4 * lane; const bf16* y0_ = Y + (size_t)m * 1024 + 4 * lane; const bf16* y1_ = Y + ((size_t)NTOK + m) * 1024 + 4 * lane;
#pragma unroll
            for (int j = 0; j < 4; ++j) { cw[r][j] = *(const u32x2*)(xr_ + 256 * j); cp2[r][j] = *(const u32x2*)(y0_ + 256 * j); cq2[r][j] = *(const u32x2*)(y1_ + 256 * j); } } }
#pragma unroll
        for (int r = 0; r < 4; ++r) { const int m = m0 + r * NGW; if (m < NTOK) {
            bf16* xr = XB + (size_t)m * 1024;
            f32x4 x[4]; float s = 0.f;
#pragma unroll
            for (int j = 0; j < 4; ++j) { const u32x2 w = cw[r][j], p = cp2[r][j], q = cq2[r][j];
                x[j] = (f32x4){DN_ALPHA * bflo(w.x) + (bflo(p.x) + bflo(q.x)), DN_ALPHA * bfhi(w.x) + (bfhi(p.x) + bfhi(q.x)), DN_ALPHA * bflo(w.y) + (bflo(p.y) + bflo(q.y)), DN_ALPHA * bfhi(w.y) + (bfhi(p.y) + bfhi(q.y))};
                s += (x[j][0] + x[j][1]) + (x[j][2] + x[j][3]); }
            const float mean = wave_sum(s) * (1.f / 1024.f); float q = 0.f;
#pragma unroll
            for (int j = 0; j < 4; ++j) { x[j] = x[j] - mean; q += (x[j][0] * x[j][0] + x[j][1] * x[j][1]) + (x[j][2] * x[j][2] + x[j][3] * x[j][3]); }
            const float rstd = rsqrtf(wave_sum(q) * (1.f / 1024.f) + LN_EPS);
#pragma unroll
            for (int j = 0; j < 4; ++j) { x[j] = x[j] * rstd * gam[j] + bet[j];
                if (l == NLAYER - 1) *(f32x4*)(a.out + (size_t)m * 1024 + 4 * lane + 256 * j) = x[j];
                else { u32x2 w; w.x = pk2(x[j][0], x[j][1]); w.y = pk2(x[j][2], x[j][3]); *(u32x2*)(xr + 4 * lane + 256 * j) = w; } } } }
    }
}

#ifndef MK_MULTI
#define MK_MULTI 0
#endif
constexpr int NPHASE = 12;
__global__ void __launch_bounds__(NTHR, 2) fwd(Args a) {
    extern __shared__ __attribute__((aligned(16))) unsigned char lds_raw[];
    LAS unsigned char* lds = (LAS unsigned char*)lds_raw;
    const int G0 = gridDim.x, bid0 = blockIdx.x, wave0 = __builtin_amdgcn_readfirstlane((int)(threadIdx.x >> 6));
#define PH_IDS unsigned on_ = ~0u; asm volatile("" : "+s"(on_)); int lz_ = (int)__builtin_amdgcn_mbcnt_hi(on_, __builtin_amdgcn_mbcnt_lo(on_, 0u)); int wz_ = wave0, bz_ = bid0, gz_ = G0; asm volatile("" : "+s"(wz_), "+s"(bz_), "+s"(gz_)); \
    const int lane = lz_, wave = wz_, tid = wz_ * 64 + lz_, bid = bz_, G = gz_, NGW = gz_ * NWAVES, gw = bid * NWAVES + wave; (void)lane; (void)gw; (void)wave; (void)tid; (void)NGW;
#define PH_ARGS(LV) const __attribute__((address_space(4))) Args* kp_ = (const __attribute__((address_space(4))) Args*)__builtin_amdgcn_kernarg_segment_ptr(); asm volatile("" : "+s"(kp_)); const Args& b = *(const Args*)kp_; int lq = (LV); asm volatile("" : "+s"(lq)); (void)lq; \
    bf16* XB = (bf16*)(b.ws + WS_XB); bf16* PB = (bf16*)(b.ws + WS_BIG); bf16* YS = (bf16*)((unsigned char*)b.out + DO_YS); bf16* MG = (bf16*)((unsigned char*)b.out + DO_MG); \
    unsigned* rowinfo = (unsigned*)(b.ws + WS_ROW); unsigned char* wl = b.ws + WS_W + (size_t)lq * WL_SIZE; (void)XB; (void)PB; (void)YS; (void)MG; (void)rowinfo; (void)wl;
    unsigned* ctl = (unsigned*)(a.ws + WS_CTL);
    { PH_IDS
    for (int u = tid; u < (LDS_BYTES - MISC_OFF) / 4; u += NTHR) ((LAS unsigned*)(lds + MISC_OFF))[u] = 0u;
    __syncthreads();
    for (int d = tid; d < 2048; d += NTHR) ((LAS unsigned char*)(lds + BKT_OFF))[d] = (unsigned char)t5_bucket(d);
    if (tid < 256) ((LAS float*)(lds + RPB_OFF))[tid] = a.in[1][tid];
    __syncthreads(); }
    XcdBarrier bar; bar.bar = ctl + CW_BAR; bar.x = 0; bar.st = nullptr;
    if (a.use_bar) bar = xcd_barrier_post(ctl + CW_BAR, (volatile LAS unsigned*)(lds + MISC_OFF) + 8);
#define GRID_BAR() do { if (a.use_bar) { const __attribute__((address_space(4))) Args* kq_ = (const __attribute__((address_space(4))) Args*)__builtin_amdgcn_kernarg_segment_ptr(); asm volatile("" : "+s"(kq_)); \
        XcdBarrier bb_ = bar; bb_.bar = (unsigned*)(kq_->ws + WS_CTL) + CW_BAR; xcd_barrier(bb_); } } while (0)
#ifndef PHMASK
#define PHMASK 0xFFF
#endif
#define IN(k) (((PHMASK >> (k)) & 1) && ((phm >> (k)) & 1u))

    unsigned phm = ((1u << a.ph_hi) - 1u) & ~((1u << a.ph_lo) - 1u);
    if (a.l_lo == 0 && IN(0)) { PH_IDS PH_ARGS(0) p0_prologue(b, lds, gw, NGW, wave, lane); GRID_BAR(); }
    for (int l = a.l_lo; l < a.l_hi; ++l) {
        asm volatile("" : "+s"(phm));
        if (IN(1)) { PH_IDS PH_ARGS(l) pg8::Gemm g{XB, (const bf16*)(wl + WL_IN), 1024, 1024, 1024}; pg8::GridOrder S; S.init(NTOK / 256, PW / 256, G, bid);
            pg8::EpiStoreBf16 E{PB, PW}; pg8::gemm_phase(lds, g, S, E, tid); GRID_BAR(); }
        if (IN(2)) { PH_IDS PH_ARGS(l) prep_phase(b, lq, lds, tid, gw, NGW, lane); GRID_BAR(); }
        if (IN(3)) { PH_IDS PH_ARGS(l) mixers_phase(b, lq, lds, bid, G, tid, wave, lane); GRID_BAR(); }
        if (IN(4)) { PH_IDS PH_ARGS(l) pg8::Gemm g{YS, (const bf16*)(wl + WL_BR), 1024, 256, 256}; pg8::GridOrder S; S.init(NTOK / 256, 16, G, bid, 4, 512);
            pg8::EpiStoreBf16 E{PB, 4096}; pg8::gemm_phase(lds, g, S, E, tid); GRID_BAR(); }
        if (IN(5)) { PH_IDS PH_ARGS(l) pg8::Gemm g{XB, (const bf16*)(wl + WL_IN) + (size_t)3072 * 1024, 1024, 1024, 1024}; pg8::GridOrder S; S.init(NTOK / 256, 16, G, bid);
            pg8::EpiGate E{PB, MG}; pg8::gemm_phase(lds, g, S, E, tid); GRID_BAR(); }
        if (IN(6)) { PH_IDS PH_ARGS(l) pg8::Gemm g{MG, (const bf16*)(wl + WL_OUT), 1024, 1024, 1024}; pg8::GridOrder S; S.init(NTOK / 256, 4, G, bid);
            pg8::EpiOut E{XB}; pg8::gemm_phase(lds, g, S, E, tid); GRID_BAR(); }
        if (IN(7)) { PH_IDS PH_ARGS(l) ln1_route_phase(b, lq, lds, bid, G, tid, wave, lane); GRID_BAR(); }
        if (IN(8)) { PH_IDS PH_ARGS(l) moe_table(b, lq, lds, tid); scatter_phase(b, lq, lds, bid, G, tid, gw, NGW, lane); GRID_BAR(); }
        if (IN(9)) { PH_IDS PH_ARGS(l) moe_table(b, lq, lds, tid); pg8::Gemm g{XB, (const bf16*)(wl + WL_GU), 1024, 1024, 1024}; pg8::MoeOrder S{(const LAS int*)(lds + TST_OFF), 1, G, bid};
            pg8::EpiUp E{rowinfo, (bf16*)(b.ws + WS_BIG + BIG_H)}; pg8::gemm_phase<pg8::EpiUp, pg8::MoeOrder, true>(lds, g, S, E, tid, rowinfo); GRID_BAR(); }
        if (IN(10)) { PH_IDS PH_ARGS(l) moe_table(b, lq, lds, tid); pg8::Gemm g{(const bf16*)(b.ws + WS_BIG + BIG_H), (const bf16*)(wl + WL_DN), 256, 256, 256}; pg8::MoeOrder S{(const LAS int*)(lds + TST_OFF), 2, G, bid};
            pg8::EpiDown E{rowinfo, PB}; pg8::gemm_phase(lds, g, S, E, tid); GRID_BAR(); }
        if (IN(11)) { PH_IDS PH_ARGS(l) ln2_phase(b, lq, gw, NGW, lane); if (l + 1 < a.l_hi) GRID_BAR(); }
    }
#undef IN
#undef GRID_BAR
}

extern "C" void kernel_launch(void* const* d_in, const int* in_sizes, int n_in, void* d_out, int out_size, void* d_ws, size_t ws_size, hipStream_t stream) {
    static int grid = 0;
    if (grid == 0) {
        if (n_in != 30 || out_size != NTOK * DM || ws_size < WS_END + 2 * MiB) { fprintf(stderr, "kernel_launch: unexpected shapes (n_in %d out %d ws %zu)\n", n_in, out_size, ws_size); grid = -1; return; }
        int dev = 0, cus = 0, per_cu = 0;
        if (hipGetDevice(&dev) != hipSuccess || hipDeviceGetAttribute(&cus, hipDeviceAttributeMultiprocessorCount, dev) != hipSuccess) { grid = -1; return; }
        if (hipFuncSetAttribute((const void*)fwd, hipFuncAttributeMaxDynamicSharedMemorySize, LDS_BYTES) != hipSuccess) { fprintf(stderr, "kernel_launch: hipFuncSetAttribute failed\n"); grid = -1; return; }
        if (hipOccupancyMaxActiveBlocksPerMultiprocessor(&per_cu, (const void*)fwd, NTHR, LDS_BYTES) != hipSuccess || per_cu < 1) fprintf(stderr, "kernel_launch: occupancy query says %d\n", per_cu);
        (void)hipGetLastError();
        grid = cus;
    }
    if (grid < 0) return;
    (void)hipMemsetAsync((char*)d_ws + WS_CTL, 0, CTL_ZERO_BYTES, stream);
    Args a{};
    for (int i = 0; i < 30; ++i) a.in[i] = (const float*)d_in[i];
    a.out = (float*)d_out; a.ws = (unsigned char*)d_ws; a.pad = 0;
#if MK_MULTI
    a.use_bar = 0;
    for (int l = 0; l < NLAYER; ++l)
        for (int ph = (l == 0 ? 0 : 1); ph < NPHASE; ++ph) { a.l_lo = l; a.l_hi = l + 1; a.ph_lo = ph; a.ph_hi = ph + 1;
            hipLaunchKernelGGL(fwd, dim3(grid), dim3(NTHR), LDS_BYTES, stream, a); }
#else
    a.use_bar = 1; a.l_lo = 0; a.l_hi = NLAYER; a.ph_lo = 0; a.ph_hi = NPHASE;
    hipLaunchKernelGGL(fwd, dim3(grid), dim3(NTHR), LDS_BYTES, stream, a);
#endif
    const hipError_t le = hipPeekAtLastError();
    if (le != hipSuccess) fprintf(stderr, "kernel_launch: launch failed: %s\n", hipGetErrorName(le));
}
```

```cpp
#include <hip/hip_runtime.h>
#include <cstdio>
#include <cstdint>

#define LAS __attribute__((address_space(3)))
#define GAS __attribute__((address_space(1)))
typedef unsigned short bf16;
typedef short bf16x8 __attribute__((ext_vector_type(8)));
typedef float f32x4 __attribute__((ext_vector_type(4)));
typedef float f32x2 __attribute__((ext_vector_type(2)));
typedef unsigned u32x4 __attribute__((ext_vector_type(4)));
typedef unsigned u32x2 __attribute__((ext_vector_type(2)));

namespace pg8 {
constexpr int BM = 256, BK = 64, HALF = 128, HTB = HALF * BK * 2  , STAGE_BYTES = 8 * HTB, NXCD = 8, WGM = 8;

__host__ __device__ __forceinline__ int lds_byte(int r, int c) { const int st = (r >> 4) * 2 + (c >> 5), rr = r & 15, cc = c & 31, ob = rr * 64 + cc * 2; return st * 1024 + (ob ^ (((ob >> 9) & 1) << 5)); }
__host__ __device__ __forceinline__ void stage_rc(int b, int& R, int& C) { const int st = b / 1024, sb = b % 1024, swz = sb ^ (((sb >> 9) & 1) << 5); R = (st >> 1) * 16 + swz / 64; C = (st & 1) * 32 + (swz % 64) / 2; }
__host__ __device__ __forceinline__ int perm32(int rho) { const int n = rho >> 4, i = rho & 15; return 8 * (i >> 2) + 4 * n + (i & 3); }

struct Unit { int pm, pn, pb; unsigned aoff; };
struct Gemm { const bf16* A; const bf16* Bt; int lda, ldb, K; };

struct GridOrder {
    int nM, nN, nwg, G, c, a_grp, a_grp_bytes;
    __device__ void init(int nM_, int nN_, int G_, int c_, int a_grp_ = 0, int a_grp_bytes_ = 0) { nM = nM_; nN = nN_; nwg = nM * nN; G = G_; c = c_; a_grp = a_grp_; a_grp_bytes = a_grp_bytes_; }
    __device__ bool next(int i, Unit& u) const {
        const long L = (long)i * G + c; if (L >= nwg) return false;
        int wgid = (int)L; { const int q = nwg / NXCD, r = nwg % NXCD, xcd = wgid % NXCD, off = wgid / NXCD; wgid = (xcd < r ? xcd * (q + 1) : r * (q + 1) + (xcd - r) * q) + off; }
        const int nig = WGM * nN, gid = wgid / nig, fm = gid * WGM, gsz = (nM - fm) < WGM ? (nM - fm) : WGM;
        u.pm = fm + ((wgid % nig) % gsz); u.pn = (wgid % nig) / gsz; u.pb = u.pn; u.aoff = a_grp ? (unsigned)((u.pn / a_grp) * a_grp_bytes) : 0u; return true;
    }
};
struct MoeOrder {
    const LAS int* tstart; int nsl, G, c;
    __device__ bool next(int i, Unit& u) const {
        const int L = i * G + c, total = tstart[32] << nsl; if (L >= total) return false;
        const int rt = L >> nsl, pn = L & ((1 << nsl) - 1); int e = 0;
        while (e < 31 && rt >= tstart[e + 1]) ++e;
        u.pm = rt; u.pn = pn; u.pb = (e << nsl) + pn; u.aoff = 0u; return true;
    }
};

__device__ __forceinline__ unsigned cvt_pk_bf16(float lo, float hi) { unsigned r; asm volatile("v_cvt_pk_bf16_f32 %0, %1, %2" : "=v"(r) : "v"(lo), "v"(hi)); return r; }

template <class Epi, class Sched, bool GATHER = false>
__device__ __forceinline__ void gemm_phase(LAS unsigned char* lds, const Gemm g, const Sched& S, const Epi& E, const int tid, const unsigned* rowtab = nullptr) {
    const int wid = __builtin_amdgcn_readfirstlane(tid >> 6), lane = tid & 63, wr = wid >> 2, wc = wid & 3, fr = lane & 15, fq = lane >> 4;
    const int K = g.K, nt = K / BK;
    unsigned voffA[2], voffB[2];
#pragma unroll
    for (int i = 0; i < 2; ++i) { int R, C; stage_rc(tid * 16 + i * 8192, R, C); const int Rb = Epi::PERM ? ((R & ~31) + perm32(R & 31)) : R;
        voffA[i] = (unsigned)(R * g.lda + C) * 2u; voffB[i] = (unsigned)(Rb * g.ldb + C) * 2u; }
    const size_t kstep = (size_t)(BK * 2);
    const size_t hstepA = (size_t)HALF * g.lda * 2, hstepB = (size_t)HALF * g.ldb * 2;
    const size_t tstepA = 2 * hstepA, tstepB = 2 * hstepB;
    const unsigned ldsw = (unsigned)wid * 1024u;
    const int aoff = lds_byte(wr * 64 + fr, fq * 8), boff = lds_byte(wc * 32 + fr, fq * 8);
#define PG8_SA(b, h) (((b) * 2 + (h)) * HTB)
#define PG8_SB(b, h) ((4 + (b) * 2 + (h)) * HTB)
#define PG8_STAGE(bufoff, gbase, voff) do { _Pragma("unroll") for (int _i = 0; _i < 2; ++_i) \
        __builtin_amdgcn_global_load_lds((const unsigned*)((const char*)(gbase) + (voff)[_i]), (LAS unsigned*)(lds + (bufoff) + ldsw + _i * 8192), 16, 0, 0); } while (0)
#define PG8_STAGE_A(bufoff, gbase, h) do { if constexpr (GATHER) { PG8_STAGE(bufoff, gbase, vgA[h]); } else { PG8_STAGE(bufoff, (gbase) + (h) * hstepA, voffA); } } while (0)
#define PG8_STAGE_AX(bufoff, gbase, h, useN) do { if constexpr (GATHER) { unsigned vs_[2] = {(useN) ? vgN[h][0] : vgA[h][0], (useN) ? vgN[h][1] : vgA[h][1]}; PG8_STAGE(bufoff, gbase, vs_); } else { PG8_STAGE(bufoff, (gbase) + (h) * hstepA, voffA); } } while (0)
#define PG8_LDA(dst, b, h) do { _Pragma("unroll") for (int m = 0; m < 4; ++m) _Pragma("unroll") for (int k = 0; k < 2; ++k) dst[m][k] = *(const LAS bf16x8*)(lds + PG8_SA(b, h) + aoff + m * 2048 + k * 1024); } while (0)
#define PG8_LDB(dst, b, h) do { _Pragma("unroll") for (int n = 0; n < 2; ++n) _Pragma("unroll") for (int k = 0; k < 2; ++k) dst[n][k] = *(const LAS bf16x8*)(lds + PG8_SB(b, h) + boff + n * 2048 + k * 1024); } while (0)
#define PG8_MMA(ai, bj, At, Bt) do { __builtin_amdgcn_s_setprio(1); _Pragma("unroll") for (int m = 0; m < 4; ++m) _Pragma("unroll") for (int n = 0; n < 2; ++n) _Pragma("unroll") for (int k = 0; k < 2; ++k) \
        acc[ai][bj][m][n] = __builtin_amdgcn_mfma_f32_16x16x32_bf16(Bt[n][k], At[m][k], acc[ai][bj][m][n], 0, 0, 0); __builtin_amdgcn_s_setprio(0); } while (0)
#define PG8_WAIT_V(n) asm volatile("s_waitcnt vmcnt(" #n ")" ::: "memory")
#define PG8_WAIT_L(n) asm volatile("s_waitcnt lgkmcnt(" #n ")" ::: "memory")
#define PG8_BAR __builtin_amdgcn_s_barrier()
#define PG8_SCHED __builtin_amdgcn_sched_barrier(0)
    Unit cur, nxt; int ui = 0;
    if (!S.next(0, cur)) return;
    unsigned vgA[2][2], vgN[2][2];
    int gR[2], gC[2];
#pragma unroll
    for (int i = 0; i < 2; ++i) stage_rc(tid * 16 + i * 8192, gR[i], gC[i]);
#define PG8_GOFF(DST, PM) do { if constexpr (GATHER) { _Pragma("unroll") for (int h_ = 0; h_ < 2; ++h_) _Pragma("unroll") for (int i_ = 0; i_ < 2; ++i_) { \
        const int ri_ = (int)rowtab[2 * ((size_t)(PM) * BM + h_ * HALF + gR[i_])]; const unsigned tok_ = ri_ < 0 ? 0u : (unsigned)ri_ >> 1; DST[h_][i_] = (tok_ * (unsigned)g.lda + (unsigned)gC[i_]) * 2u; } } } while (0)
    PG8_GOFF(vgA, cur.pm);
    f32x4 acc[2][2][4][2];
#pragma unroll
    for (int a = 0; a < 2; ++a)
#pragma unroll
        for (int b = 0; b < 2; ++b)
#pragma unroll
            for (int m = 0; m < 4; ++m)
#pragma unroll
                for (int n = 0; n < 2; ++n) acc[a][b][m][n] = (f32x4){0.f, 0.f, 0.f, 0.f};
    bf16x8 At[4][2], B0[2][2], B1[2][2];
    const char* cA = GATHER ? (const char*)g.A : (const char*)g.A + (size_t)cur.pm * tstepA + cur.aoff; const char* cB = (const char*)g.Bt + (size_t)cur.pb * tstepB;
    PG8_STAGE(PG8_SB(0, 0), cB, voffB); PG8_STAGE(PG8_SB(0, 1), cB + hstepB, voffB); PG8_STAGE_A(PG8_SA(0, 0), cA, 0); PG8_STAGE_A(PG8_SA(0, 1), cA, 1);
    if (wr == 1) PG8_BAR;
    PG8_WAIT_V(2); PG8_BAR;
    PG8_STAGE(PG8_SB(1, 0), cB + kstep, voffB); PG8_STAGE_A(PG8_SA(1, 0), cA + kstep, 0); PG8_STAGE(PG8_SB(1, 1), cB + hstepB + kstep, voffB);
    PG8_WAIT_V(6); PG8_BAR;
    for (;;) {
        const bool has_next = S.next(ui + 1, nxt);
        if (has_next) PG8_GOFF(vgN, nxt.pm); else { if constexpr (GATHER) { vgN[0][0] = vgA[0][0]; vgN[0][1] = vgA[0][1]; vgN[1][0] = vgA[1][0]; vgN[1][1] = vgA[1][1]; } }
        const char* nA = GATHER ? cA : (has_next ? (const char*)g.A + (size_t)nxt.pm * tstepA + nxt.aoff : cA); const char* nB = has_next ? (const char*)g.Bt + (size_t)nxt.pb * tstepB : cB;
        for (int t = 0; t < nt; t += 2) {
            const bool last = (t == nt - 2);
            const char* a1 = cA + (size_t)(t + 1) * kstep;
            const char* a2 = last ? nA : cA + (size_t)(t + 2) * kstep; const char* b2 = last ? nB : cB + (size_t)(t + 2) * kstep;
            const char* a3 = a2 + kstep; const char* b3 = b2 + kstep;
            PG8_LDB(B0, 0, 0); PG8_LDB(B1, 0, 1); PG8_SCHED; PG8_LDA(At, 0, 0); PG8_STAGE_AX(PG8_SA(1, 1), a1, 1, false);
            PG8_WAIT_V(8); PG8_WAIT_L(0); PG8_BAR; PG8_MMA(0, 0, At, B0); PG8_MMA(0, 1, At, B1); PG8_BAR; PG8_SCHED;
            PG8_LDA(At, 0, 1); PG8_STAGE(PG8_SB(0, 0), b2, voffB); PG8_STAGE(PG8_SB(0, 1), b2 + hstepB, voffB); PG8_STAGE_AX(PG8_SA(0, 0), a2, 0, last);
            PG8_WAIT_V(8); PG8_WAIT_L(0); PG8_BAR; PG8_MMA(1, 0, At, B0); PG8_MMA(1, 1, At, B1); PG8_BAR; PG8_SCHED;
            PG8_LDB(B0, 1, 0); PG8_LDB(B1, 1, 1); PG8_SCHED; PG8_LDA(At, 1, 0); PG8_STAGE_AX(PG8_SA(0, 1), a2, 1, last);
            PG8_WAIT_V(8); PG8_WAIT_L(0); PG8_BAR; PG8_MMA(0, 0, At, B0); PG8_MMA(0, 1, At, B1); PG8_BAR; PG8_SCHED;
            PG8_LDA(At, 1, 1); PG8_STAGE(PG8_SB(1, 0), b3, voffB); PG8_STAGE(PG8_SB(1, 1), b3 + hstepB, voffB); PG8_STAGE_AX(PG8_SA(1, 0), a3, 0, last);
            PG8_WAIT_V(8); PG8_WAIT_L(0); PG8_BAR; PG8_MMA(1, 0, At, B0); PG8_MMA(1, 1, At, B1); PG8_BAR; PG8_SCHED;
        }
        if (wr == 0) PG8_BAR;
        { unsigned on_ = ~0u; asm volatile("" : "+s"(on_)); const int lz_ = (int)__builtin_amdgcn_mbcnt_hi(on_, __builtin_amdgcn_mbcnt_lo(on_, 0u));
          E(acc, cur, wr, wc, lz_ & 15, lz_ >> 4); }
        if (!has_next) break;
#pragma unroll
        for (int a = 0; a < 2; ++a)
#pragma unroll
            for (int b = 0; b < 2; ++b)
#pragma unroll
                for (int m = 0; m < 4; ++m)
#pragma unroll
                    for (int n = 0; n < 2; ++n) acc[a][b][m][n] = (f32x4){0.f, 0.f, 0.f, 0.f};
        cur = nxt; cA = nA; cB = nB; ++ui;
        if constexpr (GATHER) { vgA[0][0] = vgN[0][0]; vgA[0][1] = vgN[0][1]; vgA[1][0] = vgN[1][0]; vgA[1][1] = vgN[1][1]; }
        if (wr == 1) PG8_BAR;
    }
    PG8_WAIT_V(0);
    PG8_BAR;
#undef PG8_SA
#undef PG8_STAGE_A
#undef PG8_STAGE_AX
#undef PG8_GOFF
#undef PG8_SB
#undef PG8_STAGE
#undef PG8_LDA
#undef PG8_LDB
#undef PG8_MMA
#undef PG8_WAIT_V
#undef PG8_WAIT_L
#undef PG8_BAR
#undef PG8_SCHED
}
}

constexpr int NTOK = 65536, DM = 1024, SEQ = 2048, NBATCH = 32, NLAYER = 4;
constexpr int PW = 3072;
constexpr int PC_AQ = 0, PC_AK = 256, PC_AV = 512, PC_BQ = 768, PC_CKV = 1024, PC_IQ = 1088, PC_IK = 1344, PC_IW = 1376,
              PC_CQ = 1384, PC_CK = 1512, PC_CV = 1640, PC_CA = 1896, PC_CG = 1912, PC_D = 2168;
constexpr int IN_W = 7096;
constexpr float LN_EPS = 1e-5f;
constexpr float DN_ALPHA = 1.6817928305074292f;
constexpr int NWAVES = 8, NTHR = 512;
constexpr int MOE_ROWS = 2 * NTOK + 32 * 256;

constexpr size_t MiB = 1u << 20;
constexpr size_t WS_CTL = 0, CTL_ZERO_BYTES = 1 * MiB;
constexpr size_t WS_TOK = 1 * MiB;
constexpr size_t WS_ROW = 3 * MiB;
constexpr size_t WS_BON = 5 * MiB;
constexpr size_t WS_RT = 6 * MiB;
constexpr size_t WS_CKVN = 8 * MiB;
constexpr size_t WS_CA = 16 * MiB;
constexpr size_t WS_W = 48 * MiB;
constexpr size_t WL_IN = 0, WL_BR = 14 * MiB, WL_OUT = 16 * MiB, WL_GU = 18 * MiB, WL_DN = 50 * MiB, WL_SIZE = 66 * MiB;
constexpr size_t WS_XB = 312 * MiB;
constexpr size_t WS_BIG = 440 * MiB;
constexpr size_t BIG_DW = 384 * MiB, BIG_DAI = 448 * MiB, BIG_DG = 480 * MiB;
constexpr size_t BIG_H = 272 * MiB;
constexpr size_t WS_END = 952 * MiB;
constexpr size_t DO_YS = 0, DO_MG = 128 * MiB, DO_DR = 128 * MiB, DO_DKP = 160 * MiB, DO_DV = 192 * MiB, DO_DKK = 224 * MiB;

constexpr int CW_TMO = 0, CW_CODE = 1;
constexpr int CW_BAR = 4096;
constexpr int CW_Q = 8192;
constexpr int CW_CNT = 16384;

constexpr int RING_BYTES = 131072;
constexpr int MISC_OFF = RING_BYTES;
constexpr int TST_OFF = MISC_OFF + 512;
constexpr int BKT_OFF = MISC_OFF + 1024;
constexpr int RPB_OFF = MISC_OFF + 3072;
constexpr int LDS_BYTES = 147456;

#define LDS_WAIT() asm volatile("s_waitcnt lgkmcnt(0)" ::: "memory")
#define VM_WAIT() asm volatile("s_waitcnt vmcnt(0)" ::: "memory")
__device__ __forceinline__ float bf2f(unsigned b) { return __uint_as_float(b << 16); }
__device__ __forceinline__ unsigned f2bf(float f) { unsigned u = __float_as_uint(f); return (u + 0x7fffu + ((u >> 16) & 1u)) >> 16; }
__device__ __forceinline__ unsigned pk2(float lo, float hi) { return f2bf(lo) | (f2bf(hi) << 16); }
__device__ __forceinline__ float bflo(unsigned w) { return __uint_as_float(w << 16); }
__device__ __forceinline__ float bfhi(unsigned w) { return __uint_as_float(w & 0xffff0000u); }
template <int CTRL> __device__ __forceinline__ float dppf(float v) {
    return __builtin_bit_cast(float, __builtin_amdgcn_update_dpp(0, __builtin_bit_cast(int, v), CTRL, 0xf, 0xf, true));
}
__device__ __forceinline__ float wave_sum(float v) {
    v += dppf<0x128>(v); v += dppf<0x124>(v); v += dppf<0x122>(v); v += dppf<0x121>(v);
    v += __shfl_xor(v, 16); v += __shfl_xor(v, 32); return v;
}
__device__ __forceinline__ float wave_max(float v) {
#pragma unroll
    for (int o = 1; o < 64; o <<= 1) v = fmaxf(v, __shfl_xor(v, o));
    return v;
}
__device__ __forceinline__ float sum8(float v) { v += dppf<0xB1>(v); v += dppf<0x4E>(v); v += dppf<0x141>(v); return v; }
__device__ __forceinline__ float sigmoidf_(float x) { return __builtin_amdgcn_rcpf(1.f + __expf(-x)); }
__device__ __forceinline__ float log_sigmoidf_(float z) { return fminf(z, 0.f) - __logf(1.f + __expf(-fabsf(z))); }

#define XB_TMO      128
#define XB_XCNT(j)  (256  + 64 * (j))
#define XB_XSUB(j)  (1280 + 64 * (j))
#define XB_XGEN(j)  (2304 + 64 * (j))
#define XB_TOP      3328
#define XB_TOPGEN   3392
#define XCD_BAR_WORDS 3456
#define XB_SPIN_CAP (1u << 22)

__device__ __forceinline__ unsigned xb_ld(unsigned* p)              { return __hip_atomic_load(p, __ATOMIC_RELAXED, __HIP_MEMORY_SCOPE_AGENT); }
__device__ __forceinline__ unsigned xb_add(unsigned* p, unsigned v) { return __hip_atomic_fetch_add(p, v, __ATOMIC_RELAXED, __HIP_MEMORY_SCOPE_AGENT); }
__device__ __forceinline__ unsigned xb_xcc_id() { return (unsigned)__builtin_amdgcn_s_getreg((3 << 11) | 20) & 0xFu; }
#define XB_SPIN(cond, bar) do { unsigned _sp = 0; while (cond) { __builtin_amdgcn_s_sleep(1); \
    if ((++_sp & 255u) == 0u) { if (xb_ld(&(bar)[XB_TMO])) break; if (_sp > XB_SPIN_CAP) { atomicAdd(&(bar)[XB_TMO], 1u); break; } } } } while (0)

struct XcdBarrier { unsigned* bar; unsigned x; volatile LAS unsigned* st; };

__device__ __forceinline__ XcdBarrier xcd_barrier_post(unsigned* bar, volatile LAS unsigned* st) {
    XcdBarrier b; b.bar = bar; b.x = xb_xcc_id(); b.st = st;
    if (threadIdx.x == 0) (void)xb_add(&bar[XB_XCNT(b.x)], 1u);
    return b;
}
__device__ __forceinline__ void xcd_barrier_complete(unsigned* bar, unsigned x, unsigned& nloc, unsigned& nx) {
    const unsigned G = gridDim.x * gridDim.y * gridDim.z;
    unsigned sum, cnt, mine, sp = 0u;
    for (;;) {
        sum = 0u; cnt = 0u; mine = 0u;
#pragma unroll
        for (unsigned j = 0; j < 16; ++j) { const unsigned c = xb_ld(&bar[XB_XCNT(j)]); sum += c; cnt += (c > 0u) ? 1u : 0u; mine = (j == x) ? c : mine; }
        if (sum == G) break;
        __builtin_amdgcn_s_sleep(1);
        if ((++sp & 255u) == 0u) { if (xb_ld(&bar[XB_TMO])) break; if (sp > XB_SPIN_CAP) { atomicAdd(&bar[XB_TMO], 1u); break; } }
    }
    nloc = mine > 0u ? mine : 1u; nx = cnt > 0u ? cnt : 1u;
}
__device__ __forceinline__ void xcd_barrier(const XcdBarrier& b) {
    asm volatile("s_waitcnt vmcnt(0)" ::: "memory");
    __syncthreads();
    if (threadIdx.x == 0) {
        unsigned* bar = b.bar;
        __builtin_amdgcn_s_waitcnt(0);
        unsigned nloc = b.st[0], nx = b.st[1];
        if (nloc == 0u) { xcd_barrier_complete(bar, b.x, nloc, nx); b.st[0] = nloc; b.st[1] = nx; }
        const unsigned old = xb_add(&bar[XB_XSUB(b.x)], 1u);
        const unsigned gen = old / nloc;
        if (old + 1u == (gen + 1u) * nloc) {
            __builtin_amdgcn_fence(__ATOMIC_RELEASE, "agent");
            asm volatile("s_waitcnt vmcnt(0)" ::: "memory");
            const unsigned og = xb_add(&bar[XB_TOP], 1u);
            const unsigned tg = og / nx;
            if (og + 1u == (tg + 1u) * nx) xb_add(&bar[XB_TOPGEN], 1u);
            else XB_SPIN(xb_ld(&bar[XB_TOPGEN]) == tg, bar);
            __builtin_amdgcn_fence(__ATOMIC_ACQUIRE, "agent");
            xb_add(&bar[XB_XGEN(b.x)], 1u);
            asm volatile("s_waitcnt vmcnt(0)" ::: "memory");
        } else {
            XB_SPIN(xb_ld(&bar[XB_XGEN(b.x)]) == gen, bar);
            __builtin_amdgcn_fence(__ATOMIC_ACQUIRE, "agent");
            asm volatile("s_waitcnt vmcnt(0)" ::: "memory");
        }
    }
    __syncthreads();
}

__device__ __forceinline__ int t5_bucket(int d) {
    if (d < 16) return d;
    int b = 16;
    b += (d >= 22) + (d >= 30) + (d >= 40) + (d >= 54) + (d >= 73) + (d >= 99) + (d >= 134) + (d >= 182) + (d >= 246) + (d >= 332) + (d >= 450) + (d >= 609) + (d >= 825) + (d >= 1117) + (d >= 1513);
    return b;
}
struct Args { const float* in[30]; float* out; unsigned char* ws; int l_lo, l_hi, ph_lo, ph_hi, use_bar, pad; };

namespace pg8 {
struct EpiNull {
    static constexpr bool PERM = true;
    unsigned* sink;
    __device__ __forceinline__ void operator()(const f32x4 (&acc)[2][2][4][2], const Unit& u, int wr, int wc, int fr, int fq) const {
        float t = 0.f;
#pragma unroll
        for (int ai = 0; ai < 2; ++ai)
#pragma unroll
            for (int bj = 0; bj < 2; ++bj)
#pragma unroll
                for (int m = 0; m < 4; ++m)
#pragma unroll
                    for (int n = 0; n < 2; ++n) t += (acc[ai][bj][m][n][0] + acc[ai][bj][m][n][1]) + (acc[ai][bj][m][n][2] + acc[ai][bj][m][n][3]);
        if (t == 1.2345e-33f) sink[0] = 1u; }
};
struct EpiStoreBf16 {
    static constexpr bool PERM = true;
    bf16* O; int ldc;
    __device__ __forceinline__ void operator()(const f32x4 (&acc)[2][2][4][2], const Unit& u, int wr, int wc, int fr, int fq) const {
        const int row0 = u.pm * BM + wr * 64 + fr, col0 = u.pn * BM + wc * 32 + 8 * fq;
#pragma unroll
        for (int ai = 0; ai < 2; ++ai)
#pragma unroll
            for (int m = 0; m < 4; ++m) { bf16* rowp = O + (size_t)(row0 + ai * HALF + m * 16) * ldc + col0;
#pragma unroll
                for (int bj = 0; bj < 2; ++bj) { const f32x4 v0 = acc[ai][bj][m][0], v1 = acc[ai][bj][m][1];
                    u32x4 w; w.x = cvt_pk_bf16(v0[0], v0[1]); w.y = cvt_pk_bf16(v0[2], v0[3]); w.z = cvt_pk_bf16(v1[0], v1[1]); w.w = cvt_pk_bf16(v1[2], v1[3]);
                    __builtin_nontemporal_store(w, (u32x4*)(rowp + bj * HALF)); } }
    }
};
struct EpiGate {
    static constexpr bool PERM = false;
    const bf16* BR; bf16* MG;
    __device__ __forceinline__ void operator()(const f32x4 (&acc)[2][2][4][2], const Unit& u, int wr, int wc, int fr, int fq) const {
        const int row0 = u.pm * BM + wr * 64 + fr, j0 = u.pn * 64 + wc * 16 + 4 * fq;
#pragma unroll
        for (int ai = 0; ai < 2; ++ai)
#pragma unroll
            for (int m = 0; m < 4; ++m) { const size_t r = (size_t)(row0 + ai * HALF + m * 16);
                float mg0 = 0.f, mg1 = 0.f, mg2 = 0.f, mg3 = 0.f;
#pragma unroll
                for (int bj = 0; bj < 2; ++bj)
#pragma unroll
                    for (int n = 0; n < 2; ++n) { const int g = 2 * bj + n; const u32x2 b = *(const u32x2*)(BR + r * 4096 + g * 1024 + j0); const f32x4 a = acc[ai][bj][m][n];
                        mg0 += sigmoidf_(a[0]) * bflo(b.x); mg1 += sigmoidf_(a[1]) * bfhi(b.x); mg2 += sigmoidf_(a[2]) * bflo(b.y); mg3 += sigmoidf_(a[3]) * bfhi(b.y); }
                u32x2 w; w.x = cvt_pk_bf16(mg0, mg1); w.y = cvt_pk_bf16(mg2, mg3);
                *(u32x2*)(MG + r * 1024 + j0) = w; }
    }
};
struct EpiOut {
    static constexpr bool PERM = true;
    bf16* XB;
    __device__ __forceinline__ void operator()(const f32x4 (&acc)[2][2][4][2], const Unit& u, int wr, int wc, int fr, int fq) const {
        const int row0 = u.pm * BM + wr * 64 + fr, col0 = u.pn * BM + wc * 32 + 8 * fq;
#pragma unroll
        for (int ai = 0; ai < 2; ++ai)
#pragma unroll
            for (int m = 0; m < 4; ++m) { bf16* rowp = XB + (size_t)(row0 + ai * HALF + m * 16) * 1024 + col0;
#pragma unroll
                for (int bj = 0; bj < 2; ++bj) { const f32x4 v0 = acc[ai][bj][m][0], v1 = acc[ai][bj][m][1]; const u32x4 x = *(const u32x4*)(rowp + bj * HALF);
                    u32x4 w; w.x = cvt_pk_bf16(DN_ALPHA * bflo(x.x) + v0[0], DN_ALPHA * bfhi(x.x) + v0[1]); w.y = cvt_pk_bf16(DN_ALPHA * bflo(x.y) + v0[2], DN_ALPHA * bfhi(x.y) + v0[3]);
                    w.z = cvt_pk_bf16(DN_ALPHA * bflo(x.z) + v1[0], DN_ALPHA * bfhi(x.z) + v1[1]); w.w = cvt_pk_bf16(DN_ALPHA * bflo(x.w) + v1[2], DN_ALPHA * bfhi(x.w) + v1[3]);
                    *(u32x4*)(rowp + bj * HALF) = w; } }
    }
};
struct EpiUp {
    static constexpr bool PERM = true;
    const unsigned* rowinfo; bf16* H;
    __device__ __forceinline__ void operator()(const f32x4 (&acc)[2][2][4][2], const Unit& u, int wr, int wc, int fr, int fq) const {
        const int row0 = u.pm * BM + wr * 64 + fr, col0 = u.pn * 128 + wc * 32 + 8 * fq;
#pragma unroll
        for (int ai = 0; ai < 2; ++ai)
#pragma unroll
            for (int m = 0; m < 4; ++m) { const size_t r = (size_t)(row0 + ai * HALF + m * 16); const float w = __uint_as_float(rowinfo[2 * r + 1]);
                const f32x4 g0 = acc[ai][0][m][0], g1 = acc[ai][0][m][1], u0 = acc[ai][1][m][0], u1 = acc[ai][1][m][1];
                float h[8];
#pragma unroll
                for (int e = 0; e < 4; ++e) { h[e] = g0[e] * sigmoidf_(g0[e]) * u0[e] * w; h[4 + e] = g1[e] * sigmoidf_(g1[e]) * u1[e] * w; }
                u32x4 o; o.x = cvt_pk_bf16(h[0], h[1]); o.y = cvt_pk_bf16(h[2], h[3]); o.z = cvt_pk_bf16(h[4], h[5]); o.w = cvt_pk_bf16(h[6], h[7]);
                *(u32x4*)(H + r * 256 + col0) = o; }
    }
};
struct EpiDown {
    static constexpr bool PERM = true;
    const unsigned* rowinfo; bf16* Y;
    __device__ __forceinline__ void operator()(const f32x4 (&acc)[2][2][4][2], const Unit& u, int wr, int wc, int fr, int fq) const {
        const int row0 = u.pm * BM + wr * 64 + fr, col0 = u.pn * BM + wc * 32 + 8 * fq;
#pragma unroll
        for (int ai = 0; ai < 2; ++ai)
#pragma unroll
            for (int m = 0; m < 4; ++m) { const size_t r = (size_t)(row0 + ai * HALF + m * 16); const int ri = (int)rowinfo[2 * r];
                if (ri >= 0) { bf16* rowp = Y + ((size_t)(ri & 1) * NTOK + (size_t)(ri >> 1)) * 1024 + col0;
#pragma unroll
                    for (int bj = 0; bj < 2; ++bj) { const f32x4 v0 = acc[ai][bj][m][0], v1 = acc[ai][bj][m][1];
                        u32x4 w; w.x = cvt_pk_bf16(v0[0], v0[1]); w.y = cvt_pk_bf16(v0[2], v0[3]); w.z = cvt_pk_bf16(v1[0], v1[1]); w.w = cvt_pk_bf16(v1[2], v1[3]);
                        *(u32x4*)(rowp + bj * HALF) = w; } } }
    }
};
}

struct RowMap { int kind, base, g, off;
    __device__ __forceinline__ int operator()(int n) const {
        if (kind == 0) return base + n;
        if (kind == 1) { const int j = base + n, jj = j & 63, pn = j >> 6; return 3072 + pn * 256 + 128 * (g >> 1) + 32 * (jj >> 4) + 16 * (g & 1) + 4 * ((jj >> 2) & 3) + (jj & 3); }
        const int h = base + n; return (h >> 7) * 256 + off + (h & 127);
    }
};
__device__ __forceinline__ void transpose_item(const float* W, int ldw, int k0, int scol0, int nvalid, bf16* WT, int ldk, const RowMap& rm, LAS float* scr, int lane) {
    const int nn = lane & 31;
#pragma unroll 8
    for (int i = 0; i < 32; ++i) { const int kk = 2 * i + (lane >> 5); scr[kk * 33 + nn] = (nn < nvalid) ? W[(size_t)(k0 + kk) * ldw + scol0 + nn] : 0.f; }
    LDS_WAIT(); asm volatile("" ::: "memory");
    const int c = lane & 7;
#pragma unroll
    for (int j = 0; j < 4; ++j) { const int n = (lane >> 3) + 8 * j; const LAS float* s = scr + (8 * c) * 33 + n;
        u32x4 o; o.x = pk2(s[0 * 33], s[1 * 33]); o.y = pk2(s[2 * 33], s[3 * 33]); o.z = pk2(s[4 * 33], s[5 * 33]); o.w = pk2(s[6 * 33], s[7 * 33]);
        *(u32x4*)(WT + (size_t)rm(n) * ldk + k0 + 8 * c) = o; }
    LDS_WAIT(); asm volatile("" ::: "memory");
}
__device__ __forceinline__ void p0_prologue(const Args& a, LAS unsigned char* lds, int gw, int NGW, int wave, int lane) {
    LAS float* scr = (LAS float*)(lds + wave * 16384);
    constexpr int IPL = 16896;
    for (int it = gw; it < NLAYER * IPL; it += NGW) {
        const int l = it / IPL; int r = it - l * IPL;
        unsigned char* wl = a.ws + WS_W + (size_t)l * WL_SIZE;
        RowMap rm; rm.kind = 0; rm.base = 0; rm.g = 0; rm.off = 0;
        if (r < 1536) { const int nt = r % 96, kt = r / 96, n0 = 32 * nt; int nv = 3000 - n0; nv = nv < 0 ? 0 : (nv > 32 ? 32 : nv); rm.base = n0;
            transpose_item(a.in[2] + (size_t)l * 1024 * IN_W, IN_W, 64 * kt, n0, nv, (bf16*)(wl + WL_IN), 1024, rm, scr, lane); continue; }
        r -= 1536;
        if (r < 2048) { const int nt = r % 128, kt = r / 128, gc0 = 32 * nt; rm.kind = 1; rm.g = gc0 >> 10; rm.base = gc0 & 1023;
            transpose_item(a.in[2] + (size_t)l * 1024 * IN_W, IN_W, 64 * kt, 3000 + gc0, 32, (bf16*)(wl + WL_IN), 1024, rm, scr, lane); continue; }
        r -= 2048;
        if (r < 512) { const int nb = r / 128, rr = r % 128, nt = rr % 32, kt = rr / 32; rm.base = nb * 1024 + 32 * nt;
            if (nb != 1) transpose_item(a.in[19] + (size_t)(l * 4 + nb) * 256 * 1024, 1024, 64 * kt, 32 * nt, 32, (bf16*)(wl + WL_BR), 256, rm, scr, lane); continue; }
        r -= 512;
        if (r < 512) { const int nt = r % 32, kt = r / 32; rm.base = 32 * nt;
            transpose_item(a.in[20] + (size_t)l * 1024 * 1024, 1024, 64 * kt, 32 * nt, 32, (bf16*)(wl + WL_OUT), 1024, rm, scr, lane); continue; }
        r -= 512;
        if (r < 8192) { const int up = r >= 4096; if (up) r -= 4096; const int e = r / 128, rr = r % 128, nt = rr % 8, kt = rr / 8; rm.kind = 2; rm.base = 32 * nt; rm.off = up ? 128 : 0;
            transpose_item(a.in[up ? 28 : 27] + (size_t)(l * 32 + e) * 1024 * 256, 256, 64 * kt, 32 * nt, 32, (bf16*)(wl + WL_GU) + (size_t)e * 512 * 1024, 1024, rm, scr, lane); continue; }
        r -= 8192;
        { const int e = r / 128, rr = r % 128, nt = rr % 32, kt = rr / 32; rm.base = 32 * nt;
            transpose_item(a.in[29] + (size_t)(l * 32 + e) * 256 * 1024, 1024, 64 * kt, 32 * nt, 32, (bf16*)(wl + WL_DN) + (size_t)e * 1024 * 256, 256, rm, scr, lane); }
    }
    { float* WRT = (float*)(a.ws + WS_RT); const int gt = gw * 64 + lane, NT = NGW * 64;
      for (int i = gt; i < NLAYER * 4 * 64 * 1024; i += NT) { const int j = i & 1023, c = (i >> 10) & 63, h = (i >> 16) & 3, l = i >> 18;
          const float* wu = a.in[4] + ((size_t)(l * 4 + h) * 64 + c) * 64; const float* wb = a.in[19] + ((size_t)(l * 4 + 1) * 256 + h * 64) * 1024 + j; float acc = 0.f;
#pragma unroll 8
          for (int d = 0; d < 64; ++d) acc += wu[d] * wb[(size_t)d * 1024];
          ((bf16*)(a.ws + WS_W + (size_t)l * WL_SIZE + WL_BR))[(size_t)(1024 + j) * 256 + h * 64 + c] = (bf16)f2bf(acc); }
      for (int i = gt; i < NLAYER * 36 * 1024; i += NT) { const int k = i & 1023, e = (i >> 10) % 36, l = i / (36 * 1024);
          WRT[i] = e < 4 ? a.in[23][((size_t)l * 1024 + k) * 4 + e] : a.in[25][((size_t)l * 1024 + k) * 32 + (e - 4)]; }
      const f32x4* xs = (const f32x4*)a.in[0]; u32x4* xd = (u32x4*)(a.ws + WS_XB);
      for (int i = gt; i < NTOK * DM / 8; i += NT) { const f32x4 v0 = xs[2 * i], v1 = xs[2 * i + 1]; u32x4 o; o.x = pk2(v0[0], v0[1]); o.y = pk2(v0[2], v0[3]); o.z = pk2(v1[0], v1[1]); o.w = pk2(v1[2], v1[3]); xd[i] = o; } }
}

__device__ __forceinline__ float softplusf_(float x) { return fmaxf(x, 0.f) + __logf(1.f + __expf(-fabsf(x))); }
__device__ __forceinline__ float tanhf_(float x) { const float e = __expf(-2.f * fabsf(x)); const float t = (1.f - e) * __builtin_amdgcn_rcpf(1.f + e); return x < 0.f ? -t : t; }
__device__ __forceinline__ void prep_phase(const Args& a, int l, LAS unsigned char* lds, int tid, int gw, int NGW, int lane, const int pmode = 7) {
    const int wave = __builtin_amdgcn_readfirstlane(tid >> 6);
    const bf16* P = (const bf16*)(a.ws + WS_BIG);
    bf16* CKVN = (bf16*)(a.ws + WS_CKVN); bf16* CQH = (bf16*)(a.ws + WS_CA); bf16* CKT = (bf16*)(a.ws + WS_CA + 16 * MiB); float* CCL = (float*)(a.ws + WS_END); float* BON = (float*)(a.ws + WS_BON);
    bf16* DR = (bf16*)((unsigned char*)a.out + DO_DR); bf16* DKP = (bf16*)((unsigned char*)a.out + DO_DKP); bf16* DV = (bf16*)((unsigned char*)a.out + DO_DV); bf16* DKK = (bf16*)((unsigned char*)a.out + DO_DKK);
    float* DW = (float*)(a.ws + WS_BIG + BIG_DW); bf16* DAI = (bf16*)(a.ws + WS_BIG + BIG_DAI); bf16* DG = (bf16*)(a.ws + WS_BIG + BIG_DG);
    const float* kvg = a.in[3] + l * 64; const float* aup = a.in[5] + l * 16 * 128; const float* abias = a.in[6] + l * 128;
    const float* mu = a.in[8] + l * 832; const float* w0 = a.in[9] + l * 256; const float* w2 = a.in[10] + l * 16 * 256; const float* a0 = a.in[11] + l * 256;
    const float* a2 = a.in[12] + l * 16 * 256; const float* g2 = a.in[13] + l * 32 * 256; const float* kkw = a.in[14] + l * 256; const float* kaw = a.in[15] + l * 256; const float* rkw = a.in[16] + l * 256;
    LAS float* sW2 = (LAS float*)lds; LAS float* sA2 = (LAS float*)(lds + 16384); LAS float* sG2 = (LAS float*)(lds + 32768); LAS float* sUP = (LAS float*)(lds + 65536);
    for (int i = tid; i < 4096; i += NTHR) { sW2[i] = w2[i]; sA2[i] = a2[i]; }
    for (int i = tid; i < 8192; i += NTHR) sG2[i] = g2[i];
    for (int i = tid; i < 2048; i += NTHR) sUP[i] = aup[i];
    __syncthreads();
    float mu_r[13], w0_r[4], a0_r[4], kk_r[4], ka_r[4], rk_r[4];
#pragma unroll
    for (int i = 0; i < 4; ++i) { const int c = 4 * lane + i; mu_r[i] = mu[c]; mu_r[4 + i] = mu[256 + c]; mu_r[8 + i] = mu[512 + c]; w0_r[i] = w0[c]; a0_r[i] = a0[c]; kk_r[i] = kkw[c]; ka_r[i] = kaw[c]; rk_r[i] = rkw[c]; }
    mu_r[12] = mu[768 + lane];
    const float kvg_r = kvg[lane], ab0 = abias[lane], ab1 = abias[64 + lane];
    u32x2 ncr, nck, ncv, npr, npk, npv; unsigned short ncl, npl, nckv, nca, nq0, nq1, nk0, nk1;
#define PREP_LOAD(mm) do { const bf16* pr_ = P + (size_t)(mm) * PW; \
        ncr = *(const u32x2*)(pr_ + PC_D + 4 * lane); nck = *(const u32x2*)(pr_ + PC_D + 256 + 4 * lane); ncv = *(const u32x2*)(pr_ + PC_D + 512 + 4 * lane); ncl = pr_[PC_D + 768 + lane]; nckv = pr_[PC_CKV + lane]; nca = pr_[PC_CA + (lane & 15)]; nq0 = pr_[PC_CQ + lane]; nq1 = pr_[PC_CQ + 64 + lane]; nk0 = pr_[PC_CK + lane]; nk1 = pr_[PC_CK + 64 + lane]; } while (0)
    constexpr int NCK = NTOK / 16;
    float* DCL = DW;
#define PREP_LOADP(mm) do { const int tt_ = (mm) & (SEQ - 1); const bf16* pp_ = P + (size_t)(mm) * PW - (tt_ > 0 ? PW : 0); npr = *(const u32x2*)(pp_ + PC_D + 4 * lane); npk = *(const u32x2*)(pp_ + PC_D + 256 + 4 * lane); npv = *(const u32x2*)(pp_ + PC_D + 512 + 4 * lane); npl = pp_[PC_D + 768 + lane]; } while (0)
    if (gw < NCK) { PREP_LOAD(gw * 16); PREP_LOADP(gw * 16); }
    for (int ck = gw; ck < NCK; ck += NGW) {
      float cpr[4] = {1.f, 1.f, 1.f, 1.f}; float cprc0 = 1.f, cprc1 = 1.f;
#pragma unroll 1
      for (int tt = 0; tt < 16; ++tt) {
        const int m = ck * 16 + tt;
        const int t = m & (SEQ - 1);
        const u32x2 ccr = ncr, cck = nck, ccv = ncv, cpr_ = npr, cpk = npk, cpv = npv; const unsigned short ccl = ncl, cpl = npl;
        npr = ncr; npk = nck; npv = ncv; npl = ncl;
        const unsigned short cckv = nckv, cca = nca, cq0 = nq0, cq1 = nq1, ck0 = nk0, ck1 = nk1;
        if (tt < 15) PREP_LOAD(m + 1); else if (ck + NGW < NCK) { PREP_LOAD((ck + NGW) * 16); PREP_LOADP((ck + NGW) * 16); }
        { const float x = bf2f(cckv); const float ss = wave_sum(x * x); const float rn = rsqrtf(ss * (1.f / 64.f) + 1e-6f); CKVN[(size_t)m * 64 + lane] = (bf16)f2bf(x * rn * kvg_r); }
        { const float cav = (lane < 16) ? bf2f(cca) : 0.f; float z0 = ab0, z1 = ab1;
#pragma unroll
          for (int i = 0; i < 16; ++i) { const float cv = __builtin_bit_cast(float, __builtin_amdgcn_readlane(__builtin_bit_cast(int, cav), i)); z0 += cv * sUP[i * 128 + lane]; z1 += cv * sUP[i * 128 + 64 + lane]; }
          cprc0 *= __expf(log_sigmoidf_(z0) * (1.f / 16.f)); cprc1 *= __expf(log_sigmoidf_(z1) * (1.f / 16.f));
          CQH[(size_t)m * 128 + lane] = (bf16)f2bf(bf2f(cq0) * cprc0); CQH[(size_t)m * 128 + 64 + lane] = (bf16)f2bf(bf2f(cq1) * cprc1);
          CKT[(size_t)m * 128 + lane] = (bf16)f2bf(bf2f(ck0) * __builtin_amdgcn_rcpf(cprc0)); CKT[(size_t)m * 128 + 64 + lane] = (bf16)f2bf(bf2f(ck1) * __builtin_amdgcn_rcpf(cprc1));
          if (tt == 15) { CCL[(size_t)ck * 128 + lane] = cprc0; CCL[(size_t)ck * 128 + 64 + lane] = cprc1; } }
        float xs[13];
        { const float cu[13] = {bflo(ccr.x), bfhi(ccr.x), bflo(ccr.y), bfhi(ccr.y), bflo(cck.x), bfhi(cck.x), bflo(cck.y), bfhi(cck.y), bflo(ccv.x), bfhi(ccv.x), bflo(ccv.y), bfhi(ccv.y), bf2f(ccl)};
          const float pv[13] = {bflo(cpr_.x), bfhi(cpr_.x), bflo(cpr_.y), bfhi(cpr_.y), bflo(cpk.x), bfhi(cpk.x), bflo(cpk.y), bfhi(cpk.y), bflo(cpv.x), bfhi(cpv.x), bflo(cpv.y), bfhi(cpv.y), bf2f(cpl)};
#pragma unroll
          for (int i = 0; i < 13; ++i) { const float prev = (t > 0) ? pv[i] : 0.f; xs[i] = cu[i] + (prev - cu[i]) * mu_r[i]; } }
        const float low = xs[12], tw = tanhf_(low), sg = sigmoidf_(low);
        float wr_[4], ar_[4], gv_[4];
#pragma unroll
        for (int i = 0; i < 4; ++i) { wr_[i] = w0_r[i]; ar_[i] = a0_r[i]; gv_[i] = 0.f; }
#define RDL(V, J) __builtin_bit_cast(float, __builtin_amdgcn_readlane(__builtin_bit_cast(int, V), (J)))
#define FMAS(ACC, S, V) asm("v_fmac_f32 %0, %1, %2" : "+v"(ACC) : "s"(S), "v"(V))
        int l4 = 4 * lane; asm volatile("" : "+v"(l4));
#pragma unroll 4
        for (int j = 0; j < 16; ++j) { const float tj = RDL(tw, j), aj = RDL(low, 16 + j); const f32x4 w4 = *(const LAS f32x4*)(sW2 + j * 256 + l4), a4 = *(const LAS f32x4*)(sA2 + j * 256 + l4);
#pragma unroll
            for (int i = 0; i < 4; ++i) { wr_[i] += tj * w4[i]; ar_[i] += aj * a4[i]; } }
#pragma unroll 4
        for (int j = 0; j < 32; ++j) { const float sj = RDL(sg, 32 + j); const f32x4 g4 = *(const LAS f32x4*)(sG2 + j * 256 + l4);
#pragma unroll
            for (int i = 0; i < 4; ++i) gv_[i] += sj * g4[i]; }
#undef RDL
#undef FMAS
        { float kkv[4], kp[4], av[4]; float n2 = 0.f, bn = 0.f;
#pragma unroll
          for (int i = 0; i < 4; ++i) { av[i] = sigmoidf_(ar_[i]); const float kx = xs[4 + i]; kkv[i] = kx * kk_r[i]; n2 += kkv[i] * kkv[i]; kp[i] = kx * (1.f + (av[i] - 1.f) * ka_r[i]); bn += xs[i] * kp[i] * rk_r[i]; }
          n2 += dppf<0x128>(n2); n2 += dppf<0x124>(n2); n2 += dppf<0x122>(n2); n2 += dppf<0x121>(n2);
          bn += dppf<0x128>(bn); bn += dppf<0x124>(bn); bn += dppf<0x122>(bn); bn += dppf<0x121>(bn);
          const float rnrm = __builtin_amdgcn_rcpf(fmaxf(sqrtf(n2), 1e-12f));
          float o_r[4], o_kp[4], o_kk[4], o_ai[4];
#pragma unroll
          for (int i = 0; i < 4; ++i) { const float w_raw = -softplusf_(-wr_[i]) - 0.5f, wdec = __expf(-__expf(w_raw)); const float kn = kkv[i] * rnrm;
              o_kk[i] = -kn * cpr[i]; cpr[i] *= wdec; const float cinv = __builtin_amdgcn_rcpf(cpr[i]);
              o_r[i] = xs[i] * cpr[i]; o_kp[i] = kp[i] * cinv; o_ai[i] = kn * av[i] * cinv; }
          const size_t o = (size_t)m * 256 + 4 * lane;
          *(u32x2*)(DR + o) = (u32x2){pk2(o_r[0], o_r[1]), pk2(o_r[2], o_r[3])}; *(u32x2*)(DKP + o) = (u32x2){pk2(o_kp[0], o_kp[1]), pk2(o_kp[2], o_kp[3])};
          *(u32x2*)(DV + o) = (u32x2){pk2(xs[8], xs[9]), pk2(xs[10], xs[11])}; *(u32x2*)(DKK + o) = (u32x2){pk2(o_kk[0], o_kk[1]), pk2(o_kk[2], o_kk[3])};
          *(u32x2*)(DAI + o) = (u32x2){pk2(o_ai[0], o_ai[1]), pk2(o_ai[2], o_ai[3])}; *(u32x2*)(DG + o) = (u32x2){pk2(gv_[0], gv_[1]), pk2(gv_[2], gv_[3])};
          if (tt == 15) *(f32x4*)(DCL + (size_t)ck * 256 + 4 * lane) = (f32x4){cpr[0], cpr[1], cpr[2], cpr[3]};
          if ((lane & 15) == 0) BON[(size_t)m * 4 + (lane >> 4)] = bn; }
      }
    }
#undef PREP_LOAD
#undef PREP_LOADP
    __syncthreads();
}

typedef float f32x16 __attribute__((ext_vector_type(16)));
typedef short s16x4 __attribute__((ext_vector_type(4)));
typedef short v4i16_t __attribute__((ext_vector_type(4)));
typedef float f32x2_t __attribute__((ext_vector_type(2))); typedef __bf16 bf16x2_t __attribute__((ext_vector_type(2)));
__device__ __forceinline__ unsigned cvtpk_s(float lo, float hi) { f32x2_t v = {lo, hi}; bf16x2_t b = __builtin_convertvector(v, bf16x2_t); return __builtin_bit_cast(unsigned, b); }
__device__ __forceinline__ s16x4 vtr(const LAS unsigned char* p) { return __builtin_bit_cast(s16x4, __builtin_amdgcn_ds_read_tr16_b64_v4i16((LAS v4i16_t*)p)); }
constexpr int ATB_OFF = 102400;
constexpr int AVI_OFF = 3584;
constexpr float LOG2E = 1.4426950408889634f;
__device__ __forceinline__ void mixA_tables(const Args& a, LAS unsigned char* lds, int tid) {
    LAS float* tb = (LAS float*)(lds + ATB_OFF);
    for (int i = tid; i < 3 * 4 * 192; i += NTHR) { const int e = i % 192, h = (i / 192) & 3, f = i / 768; const int dist = 159 - e; const int dl = f == 0 ? 16 : (f == 1 ? 4 : 1);
        float v = -INFINITY;
        if (dist >= 0 && dist <= 128) { int dd = dist * dl; dd = dd > 2047 ? 2047 : dd; v = a.in[1][t5_bucket(dd) * 8 + h] * LOG2E; }
        tb[i] = v; }
}
__device__ __forceinline__ void mixA_task(const Args& a, int b, int h, int r, int cc, LAS unsigned char* lds, int wave, int lane_in) {
    int lane = lane_in; asm volatile("" : "+v"(lane));
    const bf16* P = (const bf16*)(a.ws + WS_BIG); bf16* YS = (bf16*)((unsigned char*)a.out + DO_YS);
    const int ql = lane & 31, hh = lane >> 5, n0 = 32 * cc;
    const size_t rowb = (size_t)b * SEQ; const int tq = 16 * (n0 + ql) + r;
    const LAS float* tball = (const LAS float*)(lds + ATB_OFF) + h * 192;
    LAS unsigned char* vimg = lds + AVI_OFF + wave * 12800;
    bf16x8 qf[4];
    { const bf16* qp = P + (rowb + tq) * PW + PC_AQ + h * 64 + 8 * hh;
#pragma unroll
      for (int ks = 0; ks < 4; ++ks) qf[ks] = *(const bf16x8*)(qp + 16 * ks); }
    f32x16 o0, o1;
#pragma unroll
    for (int i = 0; i < 16; ++i) { o0[i] = 0.f; o1[i] = 0.f; }
    float m = -INFINITY, lsum = 0.f;
    const float SC = 0.125f * LOG2E;
    const int vst = (lane >> 3) * 144 + (lane & 7) * 16;
    const int i16 = lane & 15, tq4 = i16 >> 2, tp = i16 & 3, g16 = (lane >> 4) & 1;
    const int vrd = (4 * hh + tq4) * 144 + 32 * g16 + 8 * tp;
#pragma unroll 1
    for (int f = 0; f < 3; ++f) {
        const int dsh = f == 0 ? 4 : (f == 1 ? 2 : 0);
        const int rho = r & ((1 << dsh) - 1);
        const int qpos = (tq - rho) >> dsh;
        const int qmin = (16 * n0 + r - rho) >> dsh, qmax = (16 * (n0 + 31) + r - rho) >> dsh;
        int klo = qmin - 128; klo = klo < 0 ? 0 : klo; klo &= ~31;
        const LAS float* tbf = tball + f * 768;
        bf16x8 kA[4], kB[4]; u32x4 vA0, vA1, vA2, vA3, vB0, vB1, vB2, vB3;
#define A_LOAD(KF, W0, W1, W2, W3, KK0) do { const size_t tk_ = rowb + (((size_t)((KK0) + ql)) << dsh) + rho; const bf16* kp_ = P + tk_ * PW + PC_AK + h * 64 + 8 * hh; \
            _Pragma("unroll") for (int ks = 0; ks < 4; ++ks) KF[ks] = *(const bf16x8*)(kp_ + 16 * ks); \
            const bf16* vp_ = P + (rowb + (((size_t)((KK0) + (lane >> 3))) << dsh) + rho) * PW + PC_AV + h * 64 + 8 * (lane & 7); const size_t vs_ = ((size_t)8 << dsh) * PW; \
            W0 = *(const u32x4*)(vp_); W1 = *(const u32x4*)(vp_ + vs_); W2 = *(const u32x4*)(vp_ + 2 * vs_); W3 = *(const u32x4*)(vp_ + 3 * vs_); } while (0)
#define A_TILE(KF, W0, W1, W2, W3, K0) do { \
            f32x16 st; \
            _Pragma("unroll") for (int i = 0; i < 16; ++i) st[i] = 0.f; \
            _Pragma("unroll") for (int ks = 0; ks < 4; ++ks) st = __builtin_amdgcn_mfma_f32_32x32x16_bf16(KF[ks], qf[ks], st, 0, 0, 0); \
            *(LAS u32x4*)(vimg + vst) = W0; *(LAS u32x4*)(vimg + vst + 8 * 144) = W1; *(LAS u32x4*)(vimg + vst + 16 * 144) = W2; *(LAS u32x4*)(vimg + vst + 24 * 144) = W3; \
            __builtin_amdgcn_sched_barrier(0); \
            if ((K0) - 64 >= klo) A_LOAD(KF, W0, W1, W2, W3, (K0) - 64); \
            __builtin_amdgcn_sched_barrier(0); \
            const int D0 = qpos - (K0) - 4 * hh; const int e0 = (D0 >= 0 && D0 <= 159) ? 159 - D0 : 0; \
            const LAS float* tp_ = tbf + e0; \
            float mx = -INFINITY; \
            _Pragma("unroll") for (int i = 0; i < 16; ++i) { st[i] = st[i] * SC + tp_[(i & 3) + 8 * (i >> 2)]; mx = fmaxf(mx, st[i]); } \
            mx = fmaxf(mx, __shfl_xor(mx, 32)); \
            const float mn = fmaxf(m, mx), alpha = __builtin_amdgcn_exp2f(m - mn); \
            m = mn; float ps = 0.f; \
            _Pragma("unroll") for (int i = 0; i < 16; ++i) { st[i] = __builtin_amdgcn_exp2f(st[i] - mn); ps += st[i]; } \
            lsum = lsum * alpha + ps; \
            _Pragma("unroll") for (int i = 0; i < 16; ++i) { o0[i] *= alpha; o1[i] *= alpha; } \
            bf16x8 pf[2]; \
            _Pragma("unroll") for (int s = 0; s < 2; ++s) { u32x4 w; w.x = cvtpk_s(st[8 * s], st[8 * s + 1]); w.y = cvtpk_s(st[8 * s + 2], st[8 * s + 3]); w.z = cvtpk_s(st[8 * s + 4], st[8 * s + 5]); w.w = cvtpk_s(st[8 * s + 6], st[8 * s + 7]); pf[s] = __builtin_bit_cast(bf16x8, w); } \
            asm volatile("s_waitcnt lgkmcnt(0)" ::: "memory"); \
            _Pragma("unroll") for (int s = 0; s < 2; ++s) { \
                const s16x4 a00 = vtr(vimg + vrd + (16 * s) * 144), a01 = vtr(vimg + vrd + (16 * s + 8) * 144); \
                const s16x4 a10 = vtr(vimg + vrd + (16 * s) * 144 + 64), a11 = vtr(vimg + vrd + (16 * s + 8) * 144 + 64); \
                const bf16x8 A0 = (bf16x8){a00[0], a00[1], a00[2], a00[3], a01[0], a01[1], a01[2], a01[3]}; \
                const bf16x8 A1 = (bf16x8){a10[0], a10[1], a10[2], a10[3], a11[0], a11[1], a11[2], a11[3]}; \
                o0 = __builtin_amdgcn_mfma_f32_32x32x16_bf16(A0, pf[s], o0, 0, 0, 0); \
                o1 = __builtin_amdgcn_mfma_f32_32x32x16_bf16(A1, pf[s], o1, 0, 0, 0); } \
            asm volatile("s_waitcnt lgkmcnt(0)" ::: "memory"); } while (0)
        int k0 = qmax & ~31;
        A_LOAD(kA, vA0, vA1, vA2, vA3, k0);
        if (k0 - 32 >= klo) A_LOAD(kB, vB0, vB1, vB2, vB3, k0 - 32);
#pragma unroll 1
        while (k0 >= klo) {
            A_TILE(kA, vA0, vA1, vA2, vA3, k0);
            k0 -= 32; if (k0 < klo) break;
            A_TILE(kB, vB0, vB1, vB2, vB3, k0);
            k0 -= 32;
        }
#undef A_TILE
#undef A_LOAD
    }
    const float lt = lsum + __shfl_xor(lsum, 32); const float inv = 1.f / lt;
    bf16* yo = YS + (rowb + tq) * 1024 + h * 64 + 4 * hh;
#pragma unroll
    for (int g = 0; g < 4; ++g) {
        u32x2 w; w.x = cvtpk_s(o0[4 * g] * inv, o0[4 * g + 1] * inv); w.y = cvtpk_s(o0[4 * g + 2] * inv, o0[4 * g + 3] * inv); *(u32x2*)(yo + 8 * g) = w;
        u32x2 x; x.x = cvtpk_s(o1[4 * g] * inv, o1[4 * g + 1] * inv); x.y = cvtpk_s(o1[4 * g + 2] * inv, o1[4 * g + 3] * inv); *(u32x2*)(yo + 32 + 8 * g) = x; }
}

__device__ __forceinline__ unsigned fkey(float f) { const unsigned u = __float_as_uint(f); return (u & 0x80000000u) ? ~u : (u | 0x80000000u); }
typedef float f32x4v __attribute__((ext_vector_type(4)));
__device__ __forceinline__ float wave_max64(float v) {
    v = fmaxf(v, dppf<0x128>(v)); v = fmaxf(v, dppf<0x124>(v)); v = fmaxf(v, dppf<0x122>(v)); v = fmaxf(v, dppf<0x121>(v));
    v = fmaxf(v, __shfl_xor(v, 16)); v = fmaxf(v, __shfl_xor(v, 32)); return v;
}
__device__ __forceinline__ void mixB_attend4(const Args& a, int m0, const LAS unsigned short* sidx4, const LAS unsigned char* sbk4, LAS unsigned char* lds, LAS unsigned char* img, LAS unsigned char* pT, int lane, const int am = 0) {
    const bf16* P = (const bf16*)(a.ws + WS_BIG); const bf16* CKVN = (const bf16*)(a.ws + WS_CKVN); bf16* YS = (bf16*)((unsigned char*)a.out + DO_YS);
    const LAS float* rpb = (const LAS float*)(lds + RPB_OFF);
    const int t0 = m0 & (SEQ - 1); const size_t rowb = (size_t)(m0 - t0);
    const int hc = lane & 15, g = lane >> 4, hd = lane & 3;
    const float SC = 0.125f * LOG2E;
    const int i16 = lane & 15, tq4 = i16 >> 2, tp = i16 & 3;
    const int rd_tr = (4 * g + tq4) * 144 + 8 * tp;
    const int rd_p = hd * 128 + 8 * g;
    u32x4 g0, g1, g2, g3, g4, g5, g6, g7, nq0, nq1, nq2, nq3, nq4, nq5, nq6, nq7;
#define BG_ROW(QI, NS, CH, I, G) do { const int kk_ = 64 * (CH) + 8 * (I) + (lane >> 3); const int idx_ = (int)sidx4[(QI) * 256 + (kk_ < (NS) ? kk_ : 0)] & (SEQ - 1); \
        G = *(const u32x4*)(CKVN + (rowb + idx_) * 64 + 8 * (lane & 7)); } while (0)
#define BG_LOAD(QI, NS, CH) do { BG_ROW(QI, NS, CH, 0, g0); BG_ROW(QI, NS, CH, 1, g1); BG_ROW(QI, NS, CH, 2, g2); BG_ROW(QI, NS, CH, 3, g3); \
        BG_ROW(QI, NS, CH, 4, g4); BG_ROW(QI, NS, CH, 5, g5); BG_ROW(QI, NS, CH, 6, g6); BG_ROW(QI, NS, CH, 7, g7); } while (0)
#define BQ_LOAD(QI) do { const u32x4* qp_ = (const u32x4*)(P + (size_t)(m0 + (QI)) * PW + PC_BQ + hd * 64); \
        nq0 = qp_[0]; nq1 = qp_[1]; nq2 = qp_[2]; nq3 = qp_[3]; nq4 = qp_[4]; nq5 = qp_[5]; nq6 = qp_[6]; nq7 = qp_[7]; } while (0)
#define B_LO(V) __builtin_bit_cast(s16x4, (u32x2){(V).x, (V).y})
#define B_HI(V) __builtin_bit_cast(s16x4, (u32x2){(V).z, (V).w})
#define B_S2(SA, SB, Q, L) do { SA = __builtin_amdgcn_mfma_f32_4x4x4bf16_1k(B_LO(Q), B_LO(L), SA, 0, 0, 0); SB = __builtin_amdgcn_mfma_f32_4x4x4bf16_1k(B_HI(Q), B_HI(L), SB, 0, 0, 0); } while (0)
    { const int ns0 = (t0 + 1 < 256) ? t0 + 1 : 256; BQ_LOAD(0); BG_LOAD(0, ns0, 0); }
#pragma unroll 1
    for (int qi = 0; qi < 4; ++qi) {
        const int m = m0 + qi, tq = t0 + qi; const int nsel = (tq + 1 < 256) ? tq + 1 : 256; const int nsn = (tq + 2 < 256) ? tq + 2 : 256;
        const LAS unsigned char* sbk = sbk4 + qi * 256;
        const u32x4 q0 = nq0, q1 = nq1, q2 = nq2, q3 = nq3, q4 = nq4, q5 = nq5, q6 = nq6, q7 = nq7;
        if (qi + 1 < 4) BQ_LOAD(qi + 1);
        f32x4v oT[4];
#pragma unroll
        for (int mt = 0; mt < 4; ++mt) oT[mt] = (f32x4v){0.f, 0.f, 0.f, 0.f};
        f32x4v mrun = (f32x4v){-INFINITY, -INFINITY, -INFINITY, -INFINITY}, lsum = (f32x4v){0.f, 0.f, 0.f, 0.f};
#pragma unroll 1
        for (int ch = 0; ch < 4; ++ch) {
            if (64 * ch >= nsel) break;
            { LAS unsigned char* ip = img + (lane >> 3) * 144 + 16 * (lane & 7);
              *(LAS u32x4*)(ip) = g0; *(LAS u32x4*)(ip + 8 * 144) = g1; *(LAS u32x4*)(ip + 16 * 144) = g2; *(LAS u32x4*)(ip + 24 * 144) = g3;
              *(LAS u32x4*)(ip + 32 * 144) = g4; *(LAS u32x4*)(ip + 40 * 144) = g5; *(LAS u32x4*)(ip + 48 * 144) = g6; *(LAS u32x4*)(ip + 56 * 144) = g7; }
            if (64 * (ch + 1) < nsel) BG_LOAD(qi, nsel, ch + 1);
            else if (qi + 1 < 4) BG_LOAD(qi + 1, nsn, 0);
            f32x4v sa = (f32x4v){0.f, 0.f, 0.f, 0.f}, sb = sa, sc = sa, sd = sa;
            { const LAS u32x4* lp = (const LAS u32x4*)(img + lane * 144);
              const u32x4 l0 = lp[0], l1 = lp[1], l2 = lp[2], l3 = lp[3], l4 = lp[4], l5 = lp[5], l6 = lp[6], l7 = lp[7];
              B_S2(sa, sb, q0, l0); B_S2(sc, sd, q1, l1); B_S2(sa, sb, q2, l2); B_S2(sc, sd, q3, l3); B_S2(sa, sb, q4, l4); B_S2(sc, sd, q5, l5); B_S2(sa, sb, q6, l6); B_S2(sc, sd, q7, l7); }
            sa = (sa + sb) + (sc + sd);
            const int kpos = 64 * ch + lane;
            const int bk = (int)sbk[kpos < 256 ? kpos : 255];
            const f32x4v bb = *(const LAS f32x4v*)(rpb + bk * 8 + 4);
            f32x4v v = sa * SC + bb * LOG2E;
            if (kpos >= nsel) v = (f32x4v){-INFINITY, -INFINITY, -INFINITY, -INFINITY};
            const bool over = (v[0] > mrun[0] + 32.f) || (v[1] > mrun[1] + 32.f) || (v[2] > mrun[2] + 32.f) || (v[3] > mrun[3] + 32.f);
            if (__any(over)) {
                f32x4v mn, al;
#pragma unroll
                for (int i = 0; i < 4; ++i) { mn[i] = fmaxf(mrun[i], (am & 2) ? v[i] + 40.f : wave_max64(v[i])); al[i] = __builtin_amdgcn_exp2f(mrun[i] - mn[i]); }
                lsum = lsum * al; mrun = mn;
                const float ah = hd == 0 ? al[0] : hd == 1 ? al[1] : hd == 2 ? al[2] : al[3];
#pragma unroll
                for (int mt = 0; mt < 4; ++mt) oT[mt] = oT[mt] * ah;
            }
            f32x4v p;
#pragma unroll
            for (int i = 0; i < 4; ++i) p[i] = __builtin_amdgcn_exp2f(v[i] - mrun[i]);
            lsum = lsum + p;
            { const unsigned w01 = cvtpk_s(p[0], p[1]), w23 = cvtpk_s(p[2], p[3]); LAS unsigned short* pw = (LAS unsigned short*)pT + lane;
              pw[0] = (unsigned short)w01; pw[64] = (unsigned short)(w01 >> 16); pw[128] = (unsigned short)w23; pw[192] = (unsigned short)(w23 >> 16); }
            asm volatile("s_waitcnt lgkmcnt(0)" ::: "memory");
#pragma unroll
            for (int ks2 = 0; ks2 < 2; ++ks2) { if (am & 4) break;
                const u32x2 pl = *(const LAS u32x2*)(pT + rd_p + 64 * ks2), ph = *(const LAS u32x2*)(pT + rd_p + 64 * ks2 + 32);
                const bf16x8 pB = __builtin_bit_cast(bf16x8, (u32x4){pl.x, pl.y, ph.x, ph.y});
#pragma unroll
                for (int mt = 0; mt < 4; ++mt) {
                    const s16x4 lo = vtr(img + rd_tr + (32 * ks2) * 144 + 32 * mt), hi = vtr(img + rd_tr + (32 * ks2 + 16) * 144 + 32 * mt);
                    const bf16x8 A = (bf16x8){lo[0], lo[1], lo[2], lo[3], hi[0], hi[1], hi[2], hi[3]};
                    oT[mt] = __builtin_amdgcn_mfma_f32_16x16x32_bf16(A, pB, oT[mt], 0, 0, 0); } }
            asm volatile("s_waitcnt lgkmcnt(0)" ::: "memory");
        }
        f32x4v lt;
#pragma unroll
        for (int i = 0; i < 4; ++i) lt[i] = (am & 2) ? lsum[i] : wave_sum(lsum[i]);
        const float inv = 1.f / (hd == 0 ? lt[0] : hd == 1 ? lt[1] : hd == 2 ? lt[2] : lt[3]);
        if (hc < 4) { bf16* yo = YS + (size_t)m * 1024 + 256 + hc * 64 + 4 * g;
#pragma unroll
            for (int mt = 0; mt < 4; ++mt) { u32x2 w; w.x = cvtpk_s(oT[mt][0] * inv, oT[mt][1] * inv); w.y = cvtpk_s(oT[mt][2] * inv, oT[mt][3] * inv); *(u32x2*)(yo + 16 * mt) = w; } }
    }
#undef BG_LOAD
#undef BG_ROW
#undef BQ_LOAD
#undef B_LO
#undef B_HI
#undef B_S2
}
__device__ __forceinline__ void mixB_group(const Args& a, int l, int m0, LAS unsigned char* lds, LAS unsigned char* wscr, int lane_in, const int bmode = 15) {
    int lane = lane_in; asm volatile("" : "+v"(lane));
    const bf16* P = (const bf16*)(a.ws + WS_BIG);
    const int t0 = m0 & (SEQ - 1); const size_t rowb = (size_t)(m0 - t0);
    const int ql = lane & 31, hh = lane >> 5;
    LAS unsigned short* sidx = (LAS unsigned short*)wscr;
    LAS unsigned char* sbk = wscr + 2048;
    LAS unsigned char* img = wscr + 3584;
    const LAS unsigned char* bkt = lds + BKT_OFF;
    bf16x8 qf[2];
    { const int rho = ql, qi = 2 * ((rho >> 2) & 1) + (rho >> 4), hd = 4 * ((rho >> 3) & 1) + (rho & 3);
      const bf16* ip = P + (size_t)(m0 + qi) * PW + PC_IQ + hd * 32 + 8 * hh;
      qf[0] = *(const bf16x8*)(ip); qf[1] = *(const bf16x8*)(ip + 16); }
    float iw[2][8];
#pragma unroll
    for (int qq = 0; qq < 2; ++qq) { const u32x4 w = *(const u32x4*)(P + (size_t)(m0 + 2 * hh + qq) * PW + PC_IW); const float s = 0.0625f;
        iw[qq][0] = bflo(w.x) * s; iw[qq][1] = bfhi(w.x) * s; iw[qq][2] = bflo(w.y) * s; iw[qq][3] = bfhi(w.y) * s; iw[qq][4] = bflo(w.z) * s; iw[qq][5] = bfhi(w.z) * s; iw[qq][6] = bflo(w.w) * s; iw[qq][7] = bfhi(w.w) * s; }
    const int tq0 = t0 + 2 * hh;
    const int ntile = ((t0 + 3) >> 5) + 1;
    unsigned sk[2][64];
#pragma unroll
    for (int kb4 = 0; kb4 < 32; ++kb4) {
        if (2 * kb4 < ntile && (bmode & 1)) {
            bf16x8 kf0[2], kf1[2];
#pragma unroll
            for (int k4 = 0; k4 < 2; ++k4) { const int s = 32 * (2 * kb4 + k4) + ql; const bf16* kp = P + (rowb + s) * PW + PC_IK + 8 * hh; kf0[k4] = *(const bf16x8*)(kp); kf1[k4] = *(const bf16x8*)(kp + 16); }
#pragma unroll
            for (int k4 = 0; k4 < 2; ++k4) { const int kt = 2 * kb4 + k4; const int s = 32 * kt + ql;
                f32x16 acc;
#pragma unroll
                for (int i = 0; i < 16; ++i) acc[i] = 0.f;
                acc = __builtin_amdgcn_mfma_f32_32x32x16_bf16(qf[0], kf0[k4], acc, 0, 0, 0);
                acc = __builtin_amdgcn_mfma_f32_32x32x16_bf16(qf[1], kf1[k4], acc, 0, 0, 0);
                float s0 = 0.f, s1 = 0.f;
#pragma unroll
                for (int i = 0; i < 8; ++i) { s0 += fmaxf(acc[i], 0.f) * iw[0][i]; s1 += fmaxf(acc[8 + i], 0.f) * iw[1][i]; }
                sk[0][kt] = (s <= tq0) ? fkey(s0 + 0.f) : 0x007fffffu; sk[1][kt] = (s <= tq0 + 1) ? fkey(s1 + 0.f) : 0x007fffffu; }
        } else {
#pragma unroll
            for (int k4 = 0; k4 < 2; ++k4) { sk[0][2 * kb4 + k4] = 0x007fffffu; sk[1][2 * kb4 + k4] = 0x007fffffu; }
        }
    }
    const unsigned ltm = (1u << ql) - 1u;
    const int nblk8 = (ntile + 7) >> 3;
#define SK_RED(C) do { C += __builtin_amdgcn_update_dpp(0, C, 0x128, 0xf, 0xf, true); C += __builtin_amdgcn_update_dpp(0, C, 0x124, 0xf, 0xf, true); \
        C += __builtin_amdgcn_update_dpp(0, C, 0x122, 0xf, 0xf, true); C += __builtin_amdgcn_update_dpp(0, C, 0x121, 0xf, 0xf, true); C += __shfl_xor(C, 16); } while (0)
#define SK_CNT4(C, K0, K1, K2, K3, T) do { unsigned long long m0_, m1_, m2_, m3_; asm volatile( \
        "v_cmp_ge_u32_e64 %1, %5, %9\n\tv_cmp_ge_u32_e64 %2, %6, %9\n\tv_cmp_ge_u32_e64 %3, %7, %9\n\tv_cmp_ge_u32_e64 %4, %8, %9\n\t" \
        "v_addc_co_u32_e64 %0, %1, 0, %0, %1\n\tv_addc_co_u32_e64 %0, %2, 0, %0, %2\n\tv_addc_co_u32_e64 %0, %3, 0, %0, %3\n\tv_addc_co_u32_e64 %0, %4, 0, %0, %4" \
        : "+v"(C), "=&s"(m0_), "=&s"(m1_), "=&s"(m2_), "=&s"(m3_) : "v"(K0), "v"(K1), "v"(K2), "v"(K3), "v"(T)); } while (0)
#define SK_COUNT_GE(R0, R1, C0, C1) do { const unsigned r0_ = (R0), r1_ = (R1); _Pragma("unroll") for (int kb8 = 0; kb8 < 8; ++kb8) { if (kb8 < nblk8) { \
        SK_CNT4(C0, sk[0][8 * kb8], sk[0][8 * kb8 + 1], sk[0][8 * kb8 + 2], sk[0][8 * kb8 + 3], r0_); SK_CNT4(C1, sk[1][8 * kb8], sk[1][8 * kb8 + 1], sk[1][8 * kb8 + 2], sk[1][8 * kb8 + 3], r1_); \
        SK_CNT4(C0, sk[0][8 * kb8 + 4], sk[0][8 * kb8 + 5], sk[0][8 * kb8 + 6], sk[0][8 * kb8 + 7], r0_); SK_CNT4(C1, sk[1][8 * kb8 + 4], sk[1][8 * kb8 + 5], sk[1][8 * kb8 + 6], sk[1][8 * kb8 + 7], r1_); } } \
        SK_RED(C0); SK_RED(C1); } while (0)
#define SK_COUNT2(OP, R0, R1, C0, C1) do { _Pragma("unroll") for (int kb8 = 0; kb8 < 8; ++kb8) { if (kb8 < nblk8) { _Pragma("unroll") for (int k8 = 0; k8 < 8; ++k8) { \
        C0 += (sk[0][8 * kb8 + k8] OP (R0)) ? 1 : 0; C1 += (sk[1][8 * kb8 + k8] OP (R1)) ? 1 : 0; } } } SK_RED(C0); SK_RED(C1); } while (0)
#define KEY2F(K) __uint_as_float(((K) & 0x80000000u) ? ((K) & 0x7fffffffu) : ~(K))
#define SK_REDU(C, F) do { unsigned o_; o_ = (unsigned)__builtin_amdgcn_update_dpp(0, (int)C, 0x128, 0xf, 0xf, true); C = F(C, o_); o_ = (unsigned)__builtin_amdgcn_update_dpp(0, (int)C, 0x124, 0xf, 0xf, true); C = F(C, o_); \
        o_ = (unsigned)__builtin_amdgcn_update_dpp(0, (int)C, 0x122, 0xf, 0xf, true); C = F(C, o_); o_ = (unsigned)__builtin_amdgcn_update_dpp(0, (int)C, 0x121, 0xf, 0xf, true); C = F(C, o_); o_ = (unsigned)__shfl_xor((int)C, 16); C = F(C, o_); } while (0)
#define SK_UMIN(A, B) ((A) < (B) ? (A) : (B))
#define SK_UMAX(A, B) ((A) > (B) ? (A) : (B))
    constexpr int SEL_CAP = 12;
    unsigned KthA[2] = {0u, 0u}; int needA[2] = {0, 0};
    const bool big0 = (tq0 + 1 > 256), big1 = (tq0 + 2 > 256); bool exA[2] = {true, true};
    if (__any(big0 || big1) && (bmode & 2)) {
        float c255 = 255.5f, chalf = 0.5f; asm volatile("" : "+v"(c255), "+v"(chalf));
        unsigned klo[2], khi[2]; int chi[2] = {0, 0}; float x1[2], c1[2] = {0.f, 0.f}, x2[2] = {0.f, 0.f}, c2[2] = {0.f, 0.f}; bool done[2] = {!big0, !big1};
#pragma unroll
        for (int qq = 0; qq < 2; ++qq) { unsigned gm[8];
#pragma unroll
            for (int k8 = 0; k8 < 8; ++k8) gm[k8] = sk[qq][k8];
#pragma unroll
            for (int kb8 = 1; kb8 < 8; ++kb8) { if (kb8 < nblk8) {
#pragma unroll
                for (int k8 = 0; k8 < 8; ++k8) gm[k8] = SK_UMAX(gm[k8], sk[qq][8 * kb8 + k8]); } }
            unsigned mn = gm[0], mx = gm[0];
#pragma unroll
            for (int k8 = 1; k8 < 8; ++k8) { mn = SK_UMIN(mn, gm[k8]); mx = SK_UMAX(mx, gm[k8]); }
            SK_REDU(mn, SK_UMIN); SK_REDU(mx, SK_UMAX);
            klo[qq] = mn; khi[qq] = mx + 1u; x1[qq] = KEY2F(mx); exA[qq] = done[qq]; if (khi[qq] - klo[qq] <= 1u) done[qq] = true; }
#pragma unroll 1
        for (int it = 0; it < 64; ++it) {
            unsigned mk[2];
#pragma unroll
            for (int qq = 0; qq < 2; ++qq) { const unsigned lo = klo[qq], hi = khi[qq]; const float xlo = KEY2F(lo), xhi = KEY2F(hi - 1u); const float fmid = chalf * xlo + chalf * xhi;
                const float fs = x2[qq] + (c255 - c2[qq]) * (x2[qq] - x1[qq]) * __builtin_amdgcn_rcpf(c2[qq] - c1[qq]);
                unsigned m = fkey(it == 0 ? fmid : fs);
                if (it >= SEL_CAP || !(m > lo && m < hi)) { m = fkey(fmid); if (it >= SEL_CAP || !(m > lo && m < hi)) m = lo + ((hi - lo) >> 1); }
                mk[qq] = m; }
            int n0 = 0, n1 = 0;
            SK_COUNT_GE(mk[0], mk[1], n0, n1);
#pragma unroll
            for (int qq = 0; qq < 2; ++qq) { const int n = qq ? n1 : n0;
                if (!done[qq]) {
                    if (n >= 256) { klo[qq] = mk[qq]; if (n == 256) { exA[qq] = true; done[qq] = true; } } else { khi[qq] = mk[qq]; chi[qq] = n; }
                    if (it > 0) { x1[qq] = x2[qq]; c1[qq] = c2[qq]; }
                    x2[qq] = KEY2F(mk[qq]); c2[qq] = (float)n;
                    if (khi[qq] - klo[qq] <= 1u) done[qq] = true; } }
            if (__all(done[0] && done[1])) break;
        }
        KthA[0] = klo[0]; KthA[1] = klo[1]; needA[0] = 256 - chi[0]; needA[1] = 256 - chi[1];
    }
    bool sel_bad = false;
    if (bmode & 32) {
        int a0 = 0, a1 = 0, b0 = 0, b1 = 0; SK_COUNT2(>=, KthA[0], KthA[1], a0, a1); SK_COUNT2(>, KthA[0], KthA[1], b0, b1);
        if (big0) sel_bad = sel_bad || (exA[0] ? (a0 != 256) : !(a0 >= 256 && b0 < 256 && needA[0] == 256 - b0));
        if (big1) sel_bad = sel_bad || (exA[1] ? (a1 != 256) : !(a1 >= 256 && b1 < 256 && needA[1] == 256 - b1));
    }
    if (bmode & 16) { sidx[lane] = (unsigned short)(KthA[0] ^ KthA[1] ^ (unsigned)needA[0] ^ (unsigned)needA[1]); }
#pragma unroll
    for (int qq = 0; qq < 2; ++qq) {
        if (!(bmode & 4)) break;
        const int tq = tq0 + qq; const bool big = qq ? big1 : big0; const unsigned Kth = KthA[qq]; const int need = needA[qq]; const bool exact = exA[qq];
        LAS unsigned short* sx = sidx + (2 * hh + qq) * 256;
        int base = 0, tie_taken = 0; int ql2 = ql; asm volatile("" : "+v"(ql2));
#pragma unroll
        for (int kb8 = 0; kb8 < 8; ++kb8) { if (kb8 < nblk8) {
#pragma unroll
            for (int k8 = 0; k8 < 8; ++k8) { const int kt = 8 * kb8 + k8; const int s = 32 * kt + ql2; const unsigned k = sk[qq][kt]; bool take;
                if (!big) take = (s <= tq);
                else if (exact) take = (k >= Kth);
                else { const bool tie = (k == Kth); const unsigned long long mt = __ballot(tie); const unsigned mt32 = hh ? (unsigned)(mt >> 32) : (unsigned)mt;
                    take = (k > Kth) || (tie && (tie_taken + __popc(mt32 & ltm)) < need); tie_taken += __popc(mt32); }
                const unsigned long long ms = __ballot(take); const unsigned ms32 = hh ? (unsigned)(ms >> 32) : (unsigned)ms;
                if (take) sx[base + __popc(ms32 & ltm)] = (unsigned short)s;
                base += __popc(ms32); } } }
    }
#undef SK_COUNT2
#undef SK_COUNT_GE
#undef SK_CNT4
#undef SK_RED
#undef SK_REDU
#undef SK_UMIN
#undef SK_UMAX
#undef KEY2F
    LDS_WAIT(); asm volatile("" ::: "memory");
#pragma unroll
    for (int qi = 0; qi < 4; ++qi) { const int tq = t0 + qi; const int nsel = (tq + 1 < 256) ? tq + 1 : 256;
#pragma unroll
        for (int j = 0; j < 4; ++j) { const int pos = lane + 64 * j; if (pos < nsel) sbk[qi * 256 + pos] = bkt[tq - (int)sidx[qi * 256 + pos]]; } }
    LDS_WAIT(); asm volatile("" ::: "memory");
    if (bmode & 8) mixB_attend4(a, m0, sidx, sbk, lds, img, wscr + 3072, lane, (bmode >> 6) & 7);
    if ((bmode & 32) && __any(sel_bad)) { bf16* YS = (bf16*)((unsigned char*)a.out + DO_YS); for (int qi = 0; qi < 4; ++qi) ((unsigned short*)YS)[(size_t)(m0 + qi) * 1024 + 256 + lane] = 0x7fc0; }
}
constexpr int DM_OFF = 111616;
__device__ __forceinline__ bf16x8 frag2(const LAS unsigned char* p0, const LAS unsigned char* p1) {
    const s16x4 lo = *(const LAS s16x4*)p0, hi = *(const LAS s16x4*)p1; return (bf16x8){lo[0], lo[1], lo[2], lo[3], hi[0], hi[1], hi[2], hi[3]}; }
__device__ __forceinline__ bf16x8 fragtr(const LAS unsigned char* p0, const LAS unsigned char* p1) {
    const s16x4 lo = vtr(p0), hi = vtr(p1); return (bf16x8){lo[0], lo[1], lo[2], lo[3], hi[0], hi[1], hi[2], hi[3]}; }
__device__ __forceinline__ bf16x8 packf(f32x4 lo, f32x4 hi) { u32x4 w; w.x = cvtpk_s(lo[0], lo[1]); w.y = cvtpk_s(lo[2], lo[3]); w.z = cvtpk_s(hi[0], hi[1]); w.w = cvtpk_s(hi[2], hi[3]); return __builtin_bit_cast(bf16x8, w); }
__device__ __forceinline__ void dchunk_wave(const Args& a, int l, int bh, LAS unsigned char* dm, int lane_in) {
    int lane = lane_in; asm volatile("" : "+v"(lane));
    const int b = bh >> 2, h = bh & 3, hc = lane & 15, g = lane >> 4;
    LAS unsigned char* sAT = dm; LAS unsigned char* sBT = dm + 2304; LAS unsigned char* sKT = dm + 4608; LAS unsigned char* sRT = dm + 6912; LAS unsigned char* sVT = dm + 9216; LAS unsigned char* sUT = dm + 11520;
    LAS float* sW1 = (LAS float*)(dm + 13824); LAS float* sMB = (LAS float*)(dm + 17920); LAS float* sCL = (LAS float*)(dm + 18944); LAS float* sBON = (LAS float*)(dm + 19200);
    const bf16* DR = (const bf16*)((unsigned char*)a.out + DO_DR); const bf16* DKP = (const bf16*)((unsigned char*)a.out + DO_DKP); const bf16* DV = (const bf16*)((unsigned char*)a.out + DO_DV); const bf16* DKK = (const bf16*)((unsigned char*)a.out + DO_DKK);
    const float* DCL = (const float*)(a.ws + WS_BIG + BIG_DW); const bf16* DAI = (const bf16*)(a.ws + WS_BIG + BIG_DAI); const bf16* DG = (const bf16*)(a.ws + WS_BIG + BIG_DG);
    const float* BON = (const float*)(a.ws + WS_BON); bf16* YS = (bf16*)((unsigned char*)a.out + DO_YS);
    float gnw[4], gnb[4];
#pragma unroll
    for (int vt = 0; vt < 4; ++vt) { gnw[vt] = a.in[17][l * 256 + h * 64 + 16 * vt + hc]; gnb[vt] = a.in[18][l * 256 + h * 64 + 16 * vt + hc]; }
    const size_t tok0 = (size_t)b * SEQ;
    f32x4v T[4][4];
#pragma unroll
    for (int kt = 0; kt < 4; ++kt)
#pragma unroll
        for (int vt = 0; vt < 4; ++vt) T[kt][vt] = (f32x4v){0.f, 0.f, 0.f, 0.f};
    const int lrow = lane >> 3, lseg = lane & 7;
    u32x4 nA0, nA1, nB0, nB1, nK0, nK1, nR0, nR1, nV0, nV1; float nCL, nBON;
#define DC_LOAD(CH) do { const size_t e0_ = (tok0 + (size_t)(CH) * 16 + lrow) * 256 + h * 64 + 8 * lseg, e1_ = e0_ + 8 * 256; \
        nA0 = *(const u32x4*)(DKK + e0_); nA1 = *(const u32x4*)(DKK + e1_); nB0 = *(const u32x4*)(DAI + e0_); nB1 = *(const u32x4*)(DAI + e1_); nK0 = *(const u32x4*)(DKP + e0_); nK1 = *(const u32x4*)(DKP + e1_); \
        nR0 = *(const u32x4*)(DR + e0_); nR1 = *(const u32x4*)(DR + e1_); nV0 = *(const u32x4*)(DV + e0_); nV1 = *(const u32x4*)(DV + e1_); \
        nCL = DCL[((size_t)b * (SEQ / 16) + (CH)) * 256 + h * 64 + lane]; nBON = BON[(tok0 + (size_t)(CH) * 16 + (lane & 15)) * 4 + h]; } while (0)
    DC_LOAD(0);
    const int st0 = lrow * 144 + lseg * 16, st1 = st0 + 8 * 144;
    const int rdf = hc * 144 + 8 * g;
    const int rdt = (4 * g + (hc >> 2)) * 144 + 8 * (hc & 3);
    __builtin_amdgcn_s_setprio(2);
#pragma unroll 1
    for (int ch = 0; ch < SEQ / 16; ++ch) {
        *(LAS u32x4*)(sAT + st0) = nA0; *(LAS u32x4*)(sAT + st1) = nA1; *(LAS u32x4*)(sBT + st0) = nB0; *(LAS u32x4*)(sBT + st1) = nB1; *(LAS u32x4*)(sKT + st0) = nK0; *(LAS u32x4*)(sKT + st1) = nK1;
        *(LAS u32x4*)(sRT + st0) = nR0; *(LAS u32x4*)(sRT + st1) = nR1; *(LAS u32x4*)(sVT + st0) = nV0; *(LAS u32x4*)(sVT + st1) = nV1; sCL[lane] = nCL; if (lane < 16) sBON[lane] = nBON;
        unsigned short gq[4][4];
#pragma unroll
        for (int vt = 0; vt < 4; ++vt)
#pragma unroll
            for (int i = 0; i < 4; ++i) gq[vt][i] = DG[(tok0 + (size_t)ch * 16 + 4 * g + i) * 256 + h * 64 + 16 * vt + hc];
        asm volatile("s_waitcnt lgkmcnt(0)" ::: "memory");
        bf16x8 fA[2], fR[2], fB[2], fK[2];
#pragma unroll
        for (int ks = 0; ks < 2; ++ks) { fA[ks] = frag2(sAT + rdf + 64 * ks, sAT + rdf + 64 * ks + 32); fR[ks] = frag2(sRT + rdf + 64 * ks, sRT + rdf + 64 * ks + 32);
            fB[ks] = frag2(sBT + rdf + 64 * ks, sBT + rdf + 64 * ks + 32); fK[ks] = frag2(sKT + rdf + 64 * ks, sKT + rdf + 64 * ks + 32); }
        f32x4v U0[4], Y0[4];
#pragma unroll
        for (int vt = 0; vt < 4; ++vt) { const bf16x8 s0 = packf(T[0][vt], T[1][vt]), s1 = packf(T[2][vt], T[3][vt]);
            f32x4v u = (f32x4v){0.f, 0.f, 0.f, 0.f}, y = (f32x4v){0.f, 0.f, 0.f, 0.f};
            u = __builtin_amdgcn_mfma_f32_16x16x32_bf16(fA[0], s0, u, 0, 0, 0); u = __builtin_amdgcn_mfma_f32_16x16x32_bf16(fA[1], s1, u, 0, 0, 0);
            y = __builtin_amdgcn_mfma_f32_16x16x32_bf16(fR[0], s0, y, 0, 0, 0); y = __builtin_amdgcn_mfma_f32_16x16x32_bf16(fR[1], s1, y, 0, 0, 0);
            U0[vt] = u; Y0[vt] = y; }
        f32x4v Mka = (f32x4v){0.f, 0.f, 0.f, 0.f}, Mba = Mka, Mkr = Mka, Mbr = Mka;
#pragma unroll
        for (int ks = 0; ks < 2; ++ks) { Mka = __builtin_amdgcn_mfma_f32_16x16x32_bf16(fK[ks], fA[ks], Mka, 0, 0, 0); Mba = __builtin_amdgcn_mfma_f32_16x16x32_bf16(fB[ks], fA[ks], Mba, 0, 0, 0);
            Mkr = __builtin_amdgcn_mfma_f32_16x16x32_bf16(fK[ks], fR[ks], Mkr, 0, 0, 0); Mbr = __builtin_amdgcn_mfma_f32_16x16x32_bf16(fB[ks], fR[ks], Mbr, 0, 0, 0); }
#pragma unroll
        for (int i = 0; i < 4; ++i) { const int srow = 4 * g + i; if (!(srow < hc)) { Mka[i] = 0.f; Mba[i] = 0.f; } if (!(srow <= hc)) { Mkr[i] = 0.f; Mbr[i] = 0.f; } }
        if (ch + 1 < SEQ / 16) DC_LOAD(ch + 1);
        const f32x4v z4 = (f32x4v){0.f, 0.f, 0.f, 0.f};
        { const bf16x8 aM = packf(Mka, z4);
#pragma unroll
          for (int vt = 0; vt < 4; ++vt) { const s16x4 lo = vtr(sVT + rdt + 32 * vt); const bf16x8 bV = (bf16x8){lo[0], lo[1], lo[2], lo[3], 0, 0, 0, 0};
              U0[vt] = __builtin_amdgcn_mfma_f32_16x16x32_bf16(aM, bV, U0[vt], 0, 0, 0); } }
#pragma unroll
        for (int vt = 0; vt < 4; ++vt)
#pragma unroll
            for (int i = 0; i < 4; ++i) sW1[(4 * g + i) * 64 + 16 * vt + hc] = U0[vt][i];
        *(LAS f32x4v*)(sMB + hc * 16 + 4 * g) = Mba;
        asm volatile("s_waitcnt lgkmcnt(0)" ::: "memory");
        { float u[16];
#pragma unroll
          for (int t = 0; t < 16; ++t) { float acc = sW1[t * 64 + lane];
#pragma unroll
              for (int sq = 0; sq < 4; ++sq) { if (4 * sq < t) { const f32x4v mb = *(const LAS f32x4v*)(sMB + t * 16 + 4 * sq);
#pragma unroll
                  for (int e = 0; e < 4; ++e) if (4 * sq + e < t) acc += mb[e] * u[4 * sq + e]; } }
              u[t] = acc; ((LAS bf16*)sUT)[t * 72 + lane] = (bf16)f2bf(acc); } }
        asm volatile("s_waitcnt lgkmcnt(0)" ::: "memory");
        f32x4v bonv = *(const LAS f32x4v*)(sBON + 4 * g);
        { const bf16x8 aM = packf(Mbr, Mkr);
#pragma unroll
          for (int vt = 0; vt < 4; ++vt) { const bf16x8 bUV = fragtr(sUT + rdt + 32 * vt, sVT + rdt + 32 * vt); Y0[vt] = __builtin_amdgcn_mfma_f32_16x16x32_bf16(aM, bUV, Y0[vt], 0, 0, 0); } }
        { bf16x8 bUV[4];
#pragma unroll
          for (int vt = 0; vt < 4; ++vt) bUV[vt] = fragtr(sUT + rdt + 32 * vt, sVT + rdt + 32 * vt);
#pragma unroll
          for (int kt = 0; kt < 4; ++kt) { const bf16x8 aBK = fragtr(sBT + rdt + 32 * kt, sKT + rdt + 32 * kt); const f32x4v cl = *(const LAS f32x4v*)(sCL + 16 * kt + 4 * g);
#pragma unroll
              for (int vt = 0; vt < 4; ++vt) T[kt][vt] = __builtin_amdgcn_mfma_f32_16x16x32_bf16(aBK, bUV[vt], T[kt][vt], 0, 0, 0) * cl; } }
#pragma unroll
        for (int i = 0; i < 4; ++i) { float sm = (Y0[0][i] + Y0[1][i]) + (Y0[2][i] + Y0[3][i]);
            sm += dppf<0x128>(sm); sm += dppf<0x124>(sm); sm += dppf<0x122>(sm); sm += dppf<0x121>(sm);
            const float mean = sm * (1.f / 64.f); float sq = 0.f;
#pragma unroll
            for (int vt = 0; vt < 4; ++vt) { const float d = Y0[vt][i] - mean; sq += d * d; }
            sq += dppf<0x128>(sq); sq += dppf<0x124>(sq); sq += dppf<0x122>(sq); sq += dppf<0x121>(sq);
            const float rstd = rsqrtf(sq * (1.f / 64.f) + 64e-5f); const int t = 4 * g + i;
#pragma unroll
            for (int vt = 0; vt < 4; ++vt) { const float vv = bf2f(((const LAS bf16*)sVT)[t * 72 + 16 * vt + hc]);
                const float o = ((Y0[vt][i] - mean) * rstd * gnw[vt] + gnb[vt] + bonv[i] * vv) * bf2f(gq[vt][i]);
                YS[(tok0 + (size_t)ch * 16 + t) * 1024 + 768 + h * 64 + 16 * vt + hc] = (bf16)f2bf(o); } }
        asm volatile("s_waitcnt lgkmcnt(0)" ::: "memory");
    }
    __builtin_amdgcn_s_setprio(0);
#undef DC_LOAD
}
__device__ __forceinline__ void cchunk_wave(const Args& a, int l, int bh, LAS unsigned char* dm, int lane_in) {
    int lane = lane_in; asm volatile("" : "+v"(lane));
    const int b = bh >> 2, h = bh & 3, hc = lane & 15, g = lane >> 4;
    LAS unsigned char* sQT = dm; LAS unsigned char* sKT = dm + 1280; LAS unsigned char* sVT = dm + 2560; LAS float* sCL = (LAS float*)(dm + 4864);
    const bf16* P = (const bf16*)(a.ws + WS_BIG); const bf16* CQH = (const bf16*)(a.ws + WS_CA); const bf16* CKT = (const bf16*)(a.ws + WS_CA + 16 * MiB); const float* CCL = (const float*)(a.ws + WS_END);
    bf16* YS = (bf16*)((unsigned char*)a.out + DO_YS);
    float ng[4];
#pragma unroll
    for (int vt = 0; vt < 4; ++vt) ng[vt] = a.in[7][l * 256 + h * 64 + 16 * vt + hc];
    const size_t tok0 = (size_t)b * SEQ;
    f32x4v T[2][4];
#pragma unroll
    for (int kt = 0; kt < 2; ++kt)
#pragma unroll
        for (int vt = 0; vt < 4; ++vt) T[kt][vt] = (f32x4v){0.f, 0.f, 0.f, 0.f};
    const int qrow = lane >> 2, qseg = lane & 3, lrow = lane >> 3, lseg = lane & 7;
    u32x4 nQ, nK, nV0, nV1; float nCL;
#define CC_LOAD(CH) do { const size_t tq_ = tok0 + (size_t)(CH) * 16 + qrow; nQ = *(const u32x4*)(CQH + tq_ * 128 + h * 32 + 8 * qseg); nK = *(const u32x4*)(CKT + tq_ * 128 + h * 32 + 8 * qseg); \
        const size_t tv_ = tok0 + (size_t)(CH) * 16 + lrow; nV0 = *(const u32x4*)(P + tv_ * PW + PC_CV + h * 64 + 8 * lseg); nV1 = *(const u32x4*)(P + (tv_ + 8) * PW + PC_CV + h * 64 + 8 * lseg); \
        nCL = CCL[((size_t)b * (SEQ / 16) + (CH)) * 128 + h * 32 + (lane & 31)]; } while (0)
    CC_LOAD(0);
    const int rdf = hc * 80 + 8 * g;
    const int rdtk = (4 * g + (hc >> 2)) * 80 + 8 * (hc & 3);
    const int rdtv = (4 * g + (hc >> 2)) * 144 + 8 * (hc & 3);
    __builtin_amdgcn_s_setprio(2);
#pragma unroll 1
    for (int ch = 0; ch < SEQ / 16; ++ch) {
        *(LAS u32x4*)(sQT + qrow * 80 + qseg * 16) = nQ; *(LAS u32x4*)(sKT + qrow * 80 + qseg * 16) = nK;
        *(LAS u32x4*)(sVT + lrow * 144 + lseg * 16) = nV0; *(LAS u32x4*)(sVT + (lrow + 8) * 144 + lseg * 16) = nV1; if (lane < 32) sCL[lane] = nCL;
        unsigned short gq[4][4];
#pragma unroll
        for (int vt = 0; vt < 4; ++vt)
#pragma unroll
            for (int i = 0; i < 4; ++i) gq[vt][i] = P[(tok0 + (size_t)ch * 16 + 4 * g + i) * PW + PC_CG + h * 64 + 16 * vt + hc];
        asm volatile("s_waitcnt lgkmcnt(0)" ::: "memory");
        const bf16x8 fQ = frag2(sQT + rdf, sQT + rdf + 32), fK = frag2(sKT + rdf, sKT + rdf + 32);
        f32x4v Y0[4];
#pragma unroll
        for (int vt = 0; vt < 4; ++vt) { const bf16x8 s0 = packf(T[0][vt], T[1][vt]); Y0[vt] = __builtin_amdgcn_mfma_f32_16x16x32_bf16(fQ, s0, (f32x4v){0.f, 0.f, 0.f, 0.f}, 0, 0, 0); }
        f32x4v Mkq = __builtin_amdgcn_mfma_f32_16x16x32_bf16(fK, fQ, (f32x4v){0.f, 0.f, 0.f, 0.f}, 0, 0, 0);
#pragma unroll
        for (int i = 0; i < 4; ++i) if (!(4 * g + i <= hc)) Mkq[i] = 0.f;
        if (ch + 1 < SEQ / 16) CC_LOAD(ch + 1);
        const f32x4v z4 = (f32x4v){0.f, 0.f, 0.f, 0.f};
        bf16x8 bV[4];
#pragma unroll
        for (int vt = 0; vt < 4; ++vt) { const s16x4 lo = vtr(sVT + rdtv + 32 * vt); bV[vt] = (bf16x8){lo[0], lo[1], lo[2], lo[3], 0, 0, 0, 0}; }
        { const bf16x8 aM = packf(Mkq, z4);
#pragma unroll
          for (int vt = 0; vt < 4; ++vt) Y0[vt] = __builtin_amdgcn_mfma_f32_16x16x32_bf16(aM, bV[vt], Y0[vt], 0, 0, 0); }
#pragma unroll
        for (int kt = 0; kt < 2; ++kt) { const s16x4 lo = vtr(sKT + rdtk + 32 * kt); const bf16x8 aK = (bf16x8){lo[0], lo[1], lo[2], lo[3], 0, 0, 0, 0}; const f32x4v cl = *(const LAS f32x4v*)(sCL + 16 * kt + 4 * g);
#pragma unroll
            for (int vt = 0; vt < 4; ++vt) T[kt][vt] = __builtin_amdgcn_mfma_f32_16x16x32_bf16(aK, bV[vt], T[kt][vt], 0, 0, 0) * cl; }
#pragma unroll
        for (int i = 0; i < 4; ++i) { float sq = 0.f;
#pragma unroll
            for (int vt = 0; vt < 4; ++vt) { const float o = Y0[vt][i] * 0.17677669529663687f; Y0[vt][i] = o; sq += o * o; }
            sq += dppf<0x128>(sq); sq += dppf<0x124>(sq); sq += dppf<0x122>(sq); sq += dppf<0x121>(sq);
            const float rn = rsqrtf(sq * (1.f / 64.f) + 1e-6f); const int t = 4 * g + i;
#pragma unroll
            for (int vt = 0; vt < 4; ++vt) { const float gg = bf2f(gq[vt][i]);
                YS[(tok0 + (size_t)ch * 16 + t) * 1024 + 512 + h * 64 + 16 * vt + hc] = (bf16)f2bf(gg * sigmoidf_(gg) * (Y0[vt][i] * rn * ng[vt])); } }
        asm volatile("s_waitcnt lgkmcnt(0)" ::: "memory");
    }
    __builtin_amdgcn_s_setprio(0);
#undef CC_LOAD
}
__device__ __forceinline__ int lane_now() { unsigned on_ = ~0u; asm volatile("" : "+s"(on_)); return (int)__builtin_amdgcn_mbcnt_hi(on_, __builtin_amdgcn_mbcnt_lo(on_, 0u)); }
#define LANE_ARG lane_now()
__device__ __forceinline__ void mixers_phase(const Args& a, int l, LAS unsigned char* lds, int bid, int G, int tid, int wave, int lane, int qsel = 0, int mixmask = 15, const int bmode = 15) {
    LAS unsigned char* wscr = lds + wave * 12800;
    mixA_tables(a, lds, tid); __syncthreads();
    if (wave == 0) for (int it = bid; it < 256; it += G) { if (it < 128) { if (mixmask & 1) dchunk_wave(a, l, it, lds + DM_OFF, LANE_ARG); } else { if (mixmask & 2) cchunk_wave(a, l, it - 128, lds + DM_OFF, LANE_ARG); } }
    unsigned* qbase = (unsigned*)(a.ws + WS_CTL) + CW_Q + 1024 * l + 512 * qsel;
    const int myx = (int)(xb_xcc_id() & 7u);
    int soff = 0;
    for (;;) {
        if (soff >= 8) break;
        const int xq = (myx + soff) & 7;
        unsigned cq = 0; if (LANE_ARG == 0) cq = __hip_atomic_fetch_add(qbase + 64 * xq, 1u, __ATOMIC_RELAXED, __HIP_MEMORY_SCOPE_AGENT);
        cq = (unsigned)__builtin_amdgcn_readfirstlane((int)cq);
        if (cq >= 2048u) { ++soff; continue; }
        int b, tb = -1, at = 0;
        if (cq < 1920u) { const int bl = (int)cq / 480, j = (int)cq - bl * 480; b = 4 * xq + bl; if (j < 224) tb = 255 - j; else at = j - 224; }
        else { const int k = (int)cq - 1920; b = 4 * xq + (k >> 5); tb = 31 - (k & 31); }
        if (tb >= 0) { if (!(mixmask & 8)) continue; const int m0 = b * SEQ + tb * 8;
#pragma unroll 1
            for (int k = 0; k < 2; ++k) {
#ifndef MIX_NO_B
                mixB_group(a, l, m0 + 4 * k, lds, wscr, LANE_ARG, bmode);
#endif
            } }
        else { if (!(mixmask & 4)) continue;
#ifndef MIX_NO_A
            mixA_task(a, b, (at >> 4) & 3, at & 15, 3 - (at >> 6), lds, wave, LANE_ARG);
#endif
        }
    }
}

constexpr int RREC_OFF = MISC_OFF + 4096, LCNT_OFF = MISC_OFF + 10240, LBASE_OFF = MISC_OFF + 10368;
__device__ __forceinline__ void ln1_route_phase(const Args& a, int l, LAS unsigned char* lds, int bid, int G, int tid, int wave, int lane) {
    bf16* XB = (bf16*)(a.ws + WS_XB); const float* WRT = (const float*)(a.ws + WS_RT) + (size_t)l * 36 * 1024;
    unsigned* tokinfo = (unsigned*)(a.ws + WS_TOK); unsigned* cntg = (unsigned*)(a.ws + WS_CTL) + CW_CNT + (l * 32) * 64;
    const float* lng = a.in[21] + (l * 2 + 0) * 1024; const float* lnb = a.in[22] + (l * 2 + 0) * 1024;
    const float* brg = a.in[24] + l * 4; const float* bre = a.in[26] + l * 32;
    LAS float* sW = (LAS float*)lds;
    LAS unsigned* rrec = (LAS unsigned*)(lds + RREC_OFF); LAS int* lcnt = (LAS int*)(lds + LCNT_OFF); LAS unsigned* lbase = (LAS unsigned*)(lds + LBASE_OFF);
    for (int i = tid; i < 32 * 1024 / 4; i += NTHR) *(LAS f32x4*)(sW + 4 * i) = *(const f32x4*)(WRT + 4 * 1024 + 4 * i);
    f32x4 gam[4], bet[4], wg[4][4];
#pragma unroll
    for (int j = 0; j < 4; ++j) { gam[j] = *(const f32x4*)(lng + 4 * lane + 256 * j); bet[j] = *(const f32x4*)(lnb + 4 * lane + 256 * j);
#pragma unroll
        for (int e = 0; e < 4; ++e) wg[e][j] = *(const f32x4*)(WRT + e * 1024 + 4 * lane + 256 * j); }
    for (int blk = bid; blk < NTOK / 256; blk += G) {
        if (tid < 32) lcnt[tid] = 0;
        __syncthreads();
#pragma unroll 1
        for (int rg = 0; rg < 8; ++rg) {
            const int rl0 = wave * 32 + rg * 4; f32x4 x[4][4];
#pragma unroll
            for (int r = 0; r < 4; ++r) { bf16* xr = XB + (size_t)(blk * 256 + rl0 + r) * 1024; float s = 0.f;
#pragma unroll
                for (int j = 0; j < 4; ++j) { const u32x2 w = *(const u32x2*)(xr + 4 * lane + 256 * j); x[r][j] = (f32x4){bflo(w.x), bfhi(w.x), bflo(w.y), bfhi(w.y)}; s += (x[r][j][0] + x[r][j][1]) + (x[r][j][2] + x[r][j][3]); }
                const float mean = wave_sum(s) * (1.f / 1024.f); float q = 0.f;
#pragma unroll
                for (int j = 0; j < 4; ++j) { x[r][j] = x[r][j] - mean; q += (x[r][j][0] * x[r][j][0] + x[r][j][1] * x[r][j][1]) + (x[r][j][2] * x[r][j][2] + x[r][j][3] * x[r][j][3]); }
                const float rstd = rsqrtf(wave_sum(q) * (1.f / 1024.f) + LN_EPS);
#pragma unroll
                for (int j = 0; j < 4; ++j) { x[r][j] = x[r][j] * rstd * gam[j] + bet[j]; u32x2 w; w.x = pk2(x[r][j][0], x[r][j][1]); w.y = pk2(x[r][j][2], x[r][j][3]); *(u32x2*)(xr + 4 * lane + 256 * j) = w; }
                }
            float gl[4][4];
#pragma unroll
            for (int e = 0; e < 4; ++e)
#pragma unroll
                for (int r = 0; r < 4; ++r) { float d = 0.f;
#pragma unroll
                    for (int j = 0; j < 4; ++j) d += (x[r][j][0] * wg[e][j][0] + x[r][j][1] * wg[e][j][1]) + (x[r][j][2] * wg[e][j][2] + x[r][j][3] * wg[e][j][3]);
                    gl[r][e] = wave_sum(d) + brg[e]; }
#pragma unroll
            for (int r = 0; r < 4; ++r) {
                const float g0 = gl[r][0], g1 = gl[r][1], g2 = gl[r][2], g3 = gl[r][3];
                int gsv = 0; float gm = g0; if (g1 > gm) { gm = g1; gsv = 1; } if (g2 > gm) { gm = g2; gsv = 2; } if (g3 > gm) { gm = g3; gsv = 3; }
                const int gs = __builtin_amdgcn_readfirstlane(gsv);
                const float ptop = 1.f / (__expf(g0 - gm) + __expf(g1 - gm) + __expf(g2 - gm) + __expf(g3 - gm));
                float v0 = -INFINITY, v1 = -INFINITY; int i0 = 0, i1 = 0;
#pragma unroll 2
                for (int jj = 0; jj < 8; ++jj) { const int e = gs * 8 + jj; float d = 0.f;
#pragma unroll
                    for (int j = 0; j < 4; ++j) { const f32x4 w4 = *(const LAS f32x4*)(sW + e * 1024 + 4 * lane + 256 * j); d += (x[r][j][0] * w4[0] + x[r][j][1] * w4[1]) + (x[r][j][2] * w4[2] + x[r][j][3] * w4[3]); }
                    const float le = wave_sum(d) + bre[e];
                    if (le > v0) { v1 = v0; i1 = i0; v0 = le; i0 = jj; } else if (le > v1) { v1 = le; i1 = jj; } }
                const float ex = __expf(v1 - v0), w0 = ptop / (1.f + ex), w1 = ptop * ex / (1.f + ex);
                if (lane == 0) { const int e0 = gs * 8 + i0, e1 = gs * 8 + i1; const int rl = rl0 + r;
                    const int p0 = atomicAdd((int*)&lcnt[e0], 1), p1 = atomicAdd((int*)&lcnt[e1], 1);
                    rrec[rl * 6 + 0] = (unsigned)e0; rrec[rl * 6 + 1] = (unsigned)p0; rrec[rl * 6 + 2] = __float_as_uint(w0); rrec[rl * 6 + 3] = (unsigned)e1; rrec[rl * 6 + 4] = (unsigned)p1; rrec[rl * 6 + 5] = __float_as_uint(w1); } }
        }
        __syncthreads();
        if (tid < 32) lbase[tid] = __hip_atomic_fetch_add(cntg + tid * 64, (unsigned)lcnt[tid], __ATOMIC_RELAXED, __HIP_MEMORY_SCOPE_AGENT);
        __syncthreads();
        if (tid < 256) { const unsigned e0 = rrec[tid * 6 + 0], e1 = rrec[tid * 6 + 3]; unsigned* ti = tokinfo + (size_t)(blk * 256 + tid) * 8;
            u32x4 o0, o1; o0.x = e0; o0.y = lbase[e0] + rrec[tid * 6 + 1]; o0.z = rrec[tid * 6 + 2]; o0.w = e1; o1.x = lbase[e1] + rrec[tid * 6 + 4]; o1.y = rrec[tid * 6 + 5]; o1.z = 0u; o1.w = 0u;
            *(u32x4*)ti = o0; *(u32x4*)(ti + 4) = o1; }
        __syncthreads();
    }
}
__device__ __forceinline__ void moe_table(const Args& a, int l, LAS unsigned char* lds, int tid) {
    LAS int* tstart = (LAS int*)(lds + TST_OFF);
    if (tid < 64) { const unsigned* cntg = (const unsigned*)(a.ws + WS_CTL) + CW_CNT + (l * 32) * 64;
        int v = (tid < 32) ? (int)((__hip_atomic_load(cntg + tid * 64, __ATOMIC_RELAXED, __HIP_MEMORY_SCOPE_AGENT) + 255u) >> 8) : 0; const int mine = v;
#pragma unroll
        for (int o = 1; o < 32; o <<= 1) { const int u = __shfl_up(v, o); if ((tid & 63) >= o) v += u; }
        if (tid < 32) tstart[tid] = v - mine; if (tid == 31) tstart[32] = v; }
    __syncthreads();
}
__device__ __forceinline__ void scatter_phase(const Args& a, int l, LAS unsigned char* lds, int bid, int G, int tid, int gw, int NGW, int lane) {
    const LAS int* tstart = (const LAS int*)(lds + TST_OFF);
    const bf16* XB = (const bf16*)(a.ws + WS_XB); bf16* XS = (bf16*)(a.ws + WS_BIG); unsigned* rowinfo = (unsigned*)(a.ws + WS_ROW); const unsigned* tokinfo = (const unsigned*)(a.ws + WS_TOK);
    const unsigned* cntg = (const unsigned*)(a.ws + WS_CTL) + CW_CNT + (l * 32) * 64;
    for (int e = bid; e < 32; e += G) { const int c = (int)__hip_atomic_load(cntg + e * 64, __ATOMIC_RELAXED, __HIP_MEMORY_SCOPE_AGENT); const int r0 = tstart[e] * 256, r1 = tstart[e + 1] * 256;
        unsigned neg_ = 0xffffffffu, zer_ = 0u; asm volatile("" : "+v"(neg_), "+v"(zer_));
        for (int r = r0 + c + tid; r < r1; r += NTHR) { rowinfo[2 * (size_t)r] = neg_; rowinfo[2 * (size_t)r + 1] = zer_; } }
    u32x4 nt0; u32x2 nt1;
#define SC_LOAD(mm) do { nt0 = *(const u32x4*)(tokinfo + (size_t)(mm) * 8); nt1 = *(const u32x2*)(tokinfo + (size_t)(mm) * 8 + 4); } while (0)
    const int gt = gw * 64 + lane, NT = NGW * 64;
    for (int m = gt; m < NTOK; m += NT) {
        SC_LOAD(m); const u32x4 t0 = nt0; const u32x2 t1 = nt1;
        const size_t r0 = (size_t)tstart[t0.x] * 256 + t0.y, r1 = (size_t)tstart[t0.w] * 256 + t1.x;
        *(u32x2*)(rowinfo + 2 * r0) = (u32x2){(unsigned)(m * 2), t0.z}; *(u32x2*)(rowinfo + 2 * r1) = (u32x2){(unsigned)(m * 2 + 1), t1.y};
    }
#undef SC_LOAD
}
__device__ __forceinline__ void ln2_phase(const Args& a, int l, int gw, int NGW, int lane) {
    bf16* XB = (bf16*)(a.ws + WS_XB); const bf16* Y = (const bf16*)(a.ws + WS_BIG);
    const float* lng = a.in[21] + (l * 2 + 1) * 1024; const float* lnb = a.in[22] + (l * 2 + 1) * 1024;
    f32x4 gam[4], bet[4];
#pragma unroll
    for (int j = 0; j < 4; ++j) { gam[j] = *(const f32x4*)(lng + 4 * lane + 256 * j); bet[j] = *(const f32x4*)(lnb + 4 * lane + 256 * j); }
    for (int m0 = gw; m0 < NTOK; m0 += 4 * NGW) {
        u32x2 cw[4][4], cp2[4][4], cq2[4][4];
#pragma unroll
        for (int r = 0; r < 4; ++r) { const int m = m0 + r * NGW; if (m < NTOK) { const bf16* xr_ = XB + (size_t)m * 1024 + 4 * lane; const bf16* y0_ = Y + (size_t)m * 1024 + 4 * lane; const bf16* y1_ = Y + ((size_t)NTOK + m) * 1024 + 4 * lane;
#pragma unroll
            for (int j = 0; j < 4; ++j) { cw[r][j] = *(const u32x2*)(xr_ + 256 * j); cp2[r][j] = *(const u32x2*)(y0_ + 256 * j); cq2[r][j] = *(const u32x2*)(y1_ + 256 * j); } } }
#pragma unroll
        for (int r = 0; r < 4; ++r) { const int m = m0 + r * NGW; if (m < NTOK) {
            bf16* xr = XB + (size_t)m * 1024;
            f32x4 x[4]; float s = 0.f;
#pragma unroll
            for (int j = 0; j < 4; ++j) { const u32x2 w = cw[r][j], p = cp2[r][j], q = cq2[r][j];
                x[j] = (f32x4){DN_ALPHA * bflo(w.x) + (bflo(p.x) + bflo(q.x)), DN_ALPHA * bfhi(w.x) + (bfhi(p.x) + bfhi(q.x)), DN_ALPHA * bflo(w.y) + (bflo(p.y) + bflo(q.y)), DN_ALPHA * bfhi(w.y) + (bfhi(p.y) + bfhi(q.y))};
                s += (x[j][0] + x[j][1]) + (x[j][2] + x[j][3]); }
            const float mean = wave_sum(s) * (1.f / 1024.f); float q = 0.f;
#pragma unroll
            for (int j = 0; j < 4; ++j) { x[j] = x[j] - mean; q += (x[j][0] * x[j][0] + x[j][1] * x[j][1]) + (x[j][2] * x[j][2] + x[j][3] * x[j][3]); }
            const float rstd = rsqrtf(wave_sum(q) * (1.f / 1024.f) + LN_EPS);
#pragma unroll
            for (int j = 0; j < 4; ++j) { x[j] = x[j] * rstd * gam[j] + bet[j];
                if (l == NLAYER - 1) *(f32x4*)(a.out + (size_t)m * 1024 + 4 * lane + 256 * j) = x[j];
                else { u32x2 w; w.x = pk2(x[j][0], x[j][1]); w.y = pk2(x[j][2], x[j][3]); *(u32x2*)(xr + 4 * lane + 256 * j) = w; } } } }
    }
}

#ifndef MK_MULTI
#define MK_MULTI 0
#endif
constexpr int NPHASE = 12;
__global__ void __launch_bounds__(NTHR, 2) fwd(Args a) {
    extern __shared__ __attribute__((aligned(16))) unsigned char lds_raw[];
    LAS unsigned char* lds = (LAS unsigned char*)lds_raw;
    const int G0 = gridDim.x, bid0 = blockIdx.x, wave0 = __builtin_amdgcn_readfirstlane((int)(threadIdx.x >> 6));
#define PH_IDS unsigned on_ = ~0u; asm volatile("" : "+s"(on_)); int lz_ = (int)__builtin_amdgcn_mbcnt_hi(on_, __builtin_amdgcn_mbcnt_lo(on_, 0u)); int wz_ = wave0, bz_ = bid0, gz_ = G0; asm volatile("" : "+s"(wz_), "+s"(bz_), "+s"(gz_)); \
    const int lane = lz_, wave = wz_, tid = wz_ * 64 + lz_, bid = bz_, G = gz_, NGW = gz_ * NWAVES, gw = bid * NWAVES + wave; (void)lane; (void)gw; (void)wave; (void)tid; (void)NGW;
#define PH_ARGS(LV) const __attribute__((address_space(4))) Args* kp_ = (const __attribute__((address_space(4))) Args*)__builtin_amdgcn_kernarg_segment_ptr(); asm volatile("" : "+s"(kp_)); const Args& b = *(const Args*)kp_; int lq = (LV); asm volatile("" : "+s"(lq)); (void)lq; \
    bf16* XB = (bf16*)(b.ws + WS_XB); bf16* PB = (bf16*)(b.ws + WS_BIG); bf16* YS = (bf16*)((unsigned char*)b.out + DO_YS); bf16* MG = (bf16*)((unsigned char*)b.out + DO_MG); \
    unsigned* rowinfo = (unsigned*)(b.ws + WS_ROW); unsigned char* wl = b.ws + WS_W + (size_t)lq * WL_SIZE; (void)XB; (void)PB; (void)YS; (void)MG; (void)rowinfo; (void)wl;
    unsigned* ctl = (unsigned*)(a.ws + WS_CTL);
    { PH_IDS
    for (int u = tid; u < (LDS_BYTES - MISC_OFF) / 4; u += NTHR) ((LAS unsigned*)(lds + MISC_OFF))[u] = 0u;
    __syncthreads();
    for (int d = tid; d < 2048; d += NTHR) ((LAS unsigned char*)(lds + BKT_OFF))[d] = (unsigned char)t5_bucket(d);
    if (tid < 256) ((LAS float*)(lds + RPB_OFF))[tid] = a.in[1][tid];
    __syncthreads(); }
    XcdBarrier bar; bar.bar = ctl + CW_BAR; bar.x = 0; bar.st = nullptr;
    if (a.use_bar) bar = xcd_barrier_post(ctl + CW_BAR, (volatile LAS unsigned*)(lds + MISC_OFF) + 8);
#define GRID_BAR() do { if (a.use_bar) { const __attribute__((address_space(4))) Args* kq_ = (const __attribute__((address_space(4))) Args*)__builtin_amdgcn_kernarg_segment_ptr(); asm volatile("" : "+s"(kq_)); \
        XcdBarrier bb_ = bar; bb_.bar = (unsigned*)(kq_->ws + WS_CTL) + CW_BAR; xcd_barrier(bb_); } } while (0)
#ifndef PHMASK
#define PHMASK 0xFFF
#endif
#define IN(k) (((PHMASK >> (k)) & 1) && ((phm >> (k)) & 1u))

    unsigned phm = ((1u << a.ph_hi) - 1u) & ~((1u << a.ph_lo) - 1u);
    if (a.l_lo == 0 && IN(0)) { PH_IDS PH_ARGS(0) p0_prologue(b, lds, gw, NGW, wave, lane); GRID_BAR(); }
    for (int l = a.l_lo; l < a.l_hi; ++l) {
        asm volatile("" : "+s"(phm));
        if (IN(1)) { PH_IDS PH_ARGS(l) pg8::Gemm g{XB, (const bf16*)(wl + WL_IN), 1024, 1024, 1024}; pg8::GridOrder S; S.init(NTOK / 256, PW / 256, G, bid);
            pg8::EpiStoreBf16 E{PB, PW}; pg8::gemm_phase(lds, g, S, E, tid); GRID_BAR(); }
        if (IN(2)) { PH_IDS PH_ARGS(l) prep_phase(b, lq, lds, tid, gw, NGW, lane); GRID_BAR(); }
        if (IN(3)) { PH_IDS PH_ARGS(l) mixers_phase(b, lq, lds, bid, G, tid, wave, lane); GRID_BAR(); }
        if (IN(4)) { PH_IDS PH_ARGS(l) pg8::Gemm g{YS, (const bf16*)(wl + WL_BR), 1024, 256, 256}; pg8::GridOrder S; S.init(NTOK / 256, 16, G, bid, 4, 512);
            pg8::EpiStoreBf16 E{PB, 4096}; pg8::gemm_phase(lds, g, S, E, tid); GRID_BAR(); }
        if (IN(5)) { PH_IDS PH_ARGS(l) pg8::Gemm g{XB, (const bf16*)(wl + WL_IN) + (size_t)3072 * 1024, 1024, 1024, 1024}; pg8::GridOrder S; S.init(NTOK / 256, 16, G, bid);
            pg8::EpiGate E{PB, MG}; pg8::gemm_phase(lds, g, S, E, tid); GRID_BAR(); }
        if (IN(6)) { PH_IDS PH_ARGS(l) pg8::Gemm g{MG, (const bf16*)(wl + WL_OUT), 1024, 1024, 1024}; pg8::GridOrder S; S.init(NTOK / 256, 4, G, bid);
            pg8::EpiOut E{XB}; pg8::gemm_phase(lds, g, S, E, tid); GRID_BAR(); }
        if (IN(7)) { PH_IDS PH_ARGS(l) ln1_route_phase(b, lq, lds, bid, G, tid, wave, lane); GRID_BAR(); }
        if (IN(8)) { PH_IDS PH_ARGS(l) moe_table(b, lq, lds, tid); scatter_phase(b, lq, lds, bid, G, tid, gw, NGW, lane); GRID_BAR(); }
        if (IN(9)) { PH_IDS PH_ARGS(l) moe_table(b, lq, lds, tid); pg8::Gemm g{XB, (const bf16*)(wl + WL_GU), 1024, 1024, 1024}; pg8::MoeOrder S{(const LAS int*)(lds + TST_OFF), 1, G, bid};
            pg8::EpiUp E{rowinfo, (bf16*)(b.ws + WS_BIG + BIG_H)}; pg8::gemm_phase<pg8::EpiUp, pg8::MoeOrder, true>(lds, g, S, E, tid, rowinfo); GRID_BAR(); }
        if (IN(10)) { PH_IDS PH_ARGS(l) moe_table(b, lq, lds, tid); pg8::Gemm g{(const bf16*)(b.ws + WS_BIG + BIG_H), (const bf16*)(wl + WL_DN), 256, 256, 256}; pg8::MoeOrder S{(const LAS int*)(lds + TST_OFF), 2, G, bid};
            pg8::EpiDown E{rowinfo, PB}; pg8::gemm_phase(lds, g, S, E, tid); GRID_BAR(); }
        if (IN(11)) { PH_IDS PH_ARGS(l) ln2_phase(b, lq, gw, NGW, lane); if (l + 1 < a.l_hi) GRID_BAR(); }
    }
#undef IN
#undef GRID_BAR
}

extern "C" void kernel_launch(void* const* d_in, const int* in_sizes, int n_in, void* d_out, int out_size, void* d_ws, size_t ws_size, hipStream_t stream) {
    static int grid = 0;
    if (grid == 0) {
        if (n_in != 30 || out_size != NTOK * DM || ws_size < WS_END + 2 * MiB) { fprintf(stderr, "kernel_launch: unexpected shapes (n_in %d out %d ws %zu)\n", n_in, out_size, ws_size); grid = -1; return; }
        int dev = 0, cus = 0, per_cu = 0;
        if (hipGetDevice(&dev) != hipSuccess || hipDeviceGetAttribute(&cus, hipDeviceAttributeMultiprocessorCount, dev) != hipSuccess) { grid = -1; return; }
        if (hipFuncSetAttribute((const void*)fwd, hipFuncAttributeMaxDynamicSharedMemorySize, LDS_BYTES) != hipSuccess) { fprintf(stderr, "kernel_launch: hipFuncSetAttribute failed\n"); grid = -1; return; }
        if (hipOccupancyMaxActiveBlocksPerMultiprocessor(&per_cu, (const void*)fwd, NTHR, LDS_BYTES) != hipSuccess || per_cu < 1) fprintf(stderr, "kernel_launch: occupancy query says %d\n", per_cu);
        (void)hipGetLastError();
        grid = cus;
    }
    if (grid < 0) return;
    (void)hipMemsetAsync((char*)d_ws + WS_CTL, 0, CTL_ZERO_BYTES, stream);
    Args a{};
    for (int i = 0; i < 30; ++i) a.in[i] = (const float*)d_in[i];
    a.out = (float*)d_out; a.ws = (unsigned char*)d_ws; a.pad = 0;
#if MK_MULTI
    a.use_bar = 0;
    for (int l = 0; l < NLAYER; ++l)
        for (int ph = (l == 0 ? 0 : 1); ph < NPHASE; ++ph) { a.l_lo = l; a.l_hi = l + 1; a.ph_lo = ph; a.ph_hi = ph + 1;
            hipLaunchKernelGGL(fwd, dim3(grid), dim3(NTHR), LDS_BYTES, stream, a); }
#else
    a.use_bar = 1; a.l_lo = 0; a.l_hi = NLAYER; a.ph_lo = 0; a.ph_hi = NPHASE;
    hipLaunchKernelGGL(fwd, dim3(grid), dim3(NTHR), LDS_BYTES, stream, a);
#endif
    const hipError_t le = hipPeekAtLastError();
    if (le != hipSuccess) fprintf(stderr, "kernel_launch: launch failed: %s\n", hipGetErrorName(le));
}
```

```cpp
#include <hip/hip_runtime.h>
#include <cstdio>
#include <cstdint>

#define LAS __attribute__((address_space(3)))
#define GAS __attribute__((address_space(1)))
typedef unsigned short bf16;
typedef short bf16x8 __attribute__((ext_vector_type(8)));
typedef float f32x4 __attribute__((ext_vector_type(4)));
typedef float f32x2 __attribute__((ext_vector_type(2)));
typedef unsigned u32x4 __attribute__((ext_vector_type(4)));
typedef unsigned u32x2 __attribute__((ext_vector_type(2)));

namespace pg8 {
constexpr int BM = 256, BK = 64, HALF = 128, HTB = HALF * BK * 2  , STAGE_BYTES = 8 * HTB, NXCD = 8, WGM = 8;

__host__ __device__ __forceinline__ int lds_byte(int r, int c) { const int st = (r >> 4) * 2 + (c >> 5), rr = r & 15, cc = c & 31, ob = rr * 64 + cc * 2; return st * 1024 + (ob ^ (((ob >> 9) & 1) << 5)); }
__host__ __device__ __forceinline__ void stage_rc(int b, int& R, int& C) { const int st = b / 1024, sb = b % 1024, swz = sb ^ (((sb >> 9) & 1) << 5); R = (st >> 1) * 16 + swz / 64; C = (st & 1) * 32 + (swz % 64) / 2; }
__host__ __device__ __forceinline__ int perm32(int rho) { const int n = rho >> 4, i = rho & 15; return 8 * (i >> 2) + 4 * n + (i & 3); }

struct Unit { int pm, pn, pb; unsigned aoff; };
struct Gemm { const bf16* A; const bf16* Bt; int lda, ldb, K; };

struct GridOrder {
    int nM, nN, nwg, G, c, a_grp, a_grp_bytes, rev;
    __device__ void init(int nM_, int nN_, int G_, int c_, int a_grp_ = 0, int a_grp_bytes_ = 0, int rev_ = 0) { nM = nM_; nN = nN_; nwg = nM * nN; G = G_; c = c_; a_grp = a_grp_; a_grp_bytes = a_grp_bytes_; rev = rev_; }
    __device__ bool next(int i, Unit& u) const {
        const int mine = c < nwg ? (nwg - c + G - 1) / G : 0; if (i >= mine) return false;
        const long L = (long)(rev ? mine - 1 - i : i) * G + c;
        int wgid = (int)L; { const int q = nwg / NXCD, r = nwg % NXCD, xcd = wgid % NXCD, off = wgid / NXCD; wgid = (xcd < r ? xcd * (q + 1) : r * (q + 1) + (xcd - r) * q) + off; }
        const int nig = WGM * nN, gid = wgid / nig, fm = gid * WGM, gsz = (nM - fm) < WGM ? (nM - fm) : WGM;
        u.pm = fm + ((wgid % nig) % gsz); u.pn = (wgid % nig) / gsz; u.pb = u.pn; u.aoff = a_grp ? (unsigned)((u.pn / a_grp) * a_grp_bytes) : 0u; return true;
    }
};
struct MoeOrder {
    const LAS int* tstart; int nsl, G, c, rev;
    __device__ bool next(int i, Unit& u) const {
        const int total = tstart[32] << nsl, mine = c < total ? (total - c + G - 1) / G : 0; if (i >= mine) return false;
        const int L = (rev ? mine - 1 - i : i) * G + c;
        const int rt = L >> nsl, pn = L & ((1 << nsl) - 1); int e = 0;
        while (e < 31 && rt >= tstart[e + 1]) ++e;
        u.pm = rt; u.pn = pn; u.pb = (e << nsl) + pn; u.aoff = 0u; return true;
    }
};

__device__ __forceinline__ unsigned cvt_pk_bf16(float lo, float hi) { unsigned r; asm volatile("v_cvt_pk_bf16_f32 %0, %1, %2" : "=v"(r) : "v"(lo), "v"(hi)); return r; }

template <class Epi, class Sched, bool GATHER = false>
__device__ __forceinline__ void gemm_phase(LAS unsigned char* lds, const Gemm g, const Sched& S, const Epi& E, const int tid, const unsigned* rowtab = nullptr) {
    const int wid = __builtin_amdgcn_readfirstlane(tid >> 6), lane = tid & 63, wr = wid >> 2, wc = wid & 3, fr = lane & 15, fq = lane >> 4;
    const int K = g.K, nt = K / BK;
    unsigned voffA[2], voffB[2];
#pragma unroll
    for (int i = 0; i < 2; ++i) { int R, C; stage_rc(tid * 16 + i * 8192, R, C); const int Rb = Epi::PERM ? ((R & ~31) + perm32(R & 31)) : R;
        voffA[i] = (unsigned)(R * g.lda + C) * 2u; voffB[i] = (unsigned)(Rb * g.ldb + C) * 2u; }
    const size_t kstep = (size_t)(BK * 2);
    const size_t hstepA = (size_t)HALF * g.lda * 2, hstepB = (size_t)HALF * g.ldb * 2;
    const size_t tstepA = 2 * hstepA, tstepB = 2 * hstepB;
    const unsigned ldsw = (unsigned)wid * 1024u;
    const int aoff = lds_byte(wr * 64 + fr, fq * 8), boff = lds_byte(wc * 32 + fr, fq * 8);
#define PG8_SA(b, h) (((b) * 2 + (h)) * HTB)
#define PG8_SB(b, h) ((4 + (b) * 2 + (h)) * HTB)
#define PG8_STAGE(bufoff, gbase, voff) do { _Pragma("unroll") for (int _i = 0; _i < 2; ++_i) \
        __builtin_amdgcn_global_load_lds((const unsigned*)((const char*)(gbase) + (voff)[_i]), (LAS unsigned*)(lds + (bufoff) + ldsw + _i * 8192), 16, 0, 0); } while (0)
#define PG8_STAGE_A(bufoff, gbase, h) do { if constexpr (GATHER) { PG8_STAGE(bufoff, gbase, vgA[h]); } else { PG8_STAGE(bufoff, (gbase) + (h) * hstepA, voffA); } } while (0)
#define PG8_STAGE_AX(bufoff, gbase, h, useN) do { if constexpr (GATHER) { unsigned vs_[2] = {(useN) ? vgN[h][0] : vgA[h][0], (useN) ? vgN[h][1] : vgA[h][1]}; PG8_STAGE(bufoff, gbase, vs_); } else { PG8_STAGE(bufoff, (gbase) + (h) * hstepA, voffA); } } while (0)
#define PG8_LDA(dst, b, h) do { _Pragma("unroll") for (int m = 0; m < 4; ++m) _Pragma("unroll") for (int k = 0; k < 2; ++k) dst[m][k] = *(const LAS bf16x8*)(lds + PG8_SA(b, h) + aoff + m * 2048 + k * 1024); } while (0)
#define PG8_LDB(dst, b, h) do { _Pragma("unroll") for (int n = 0; n < 2; ++n) _Pragma("unroll") for (int k = 0; k < 2; ++k) dst[n][k] = *(const LAS bf16x8*)(lds + PG8_SB(b, h) + boff + n * 2048 + k * 1024); } while (0)
#define PG8_MMA(ai, bj, At, Bt) do { __builtin_amdgcn_s_setprio(1); _Pragma("unroll") for (int m = 0; m < 4; ++m) _Pragma("unroll") for (int n = 0; n < 2; ++n) _Pragma("unroll") for (int k = 0; k < 2; ++k) \
        acc[ai][bj][m][n] = __builtin_amdgcn_mfma_f32_16x16x32_bf16(Bt[n][k], At[m][k], acc[ai][bj][m][n], 0, 0, 0); __builtin_amdgcn_s_setprio(0); } while (0)
#define PG8_WAIT_V(n) asm volatile("s_waitcnt vmcnt(" #n ")" ::: "memory")
#define PG8_WAIT_L(n) asm volatile("s_waitcnt lgkmcnt(" #n ")" ::: "memory")
#define PG8_BAR __builtin_amdgcn_s_barrier()
#define PG8_SCHED __builtin_amdgcn_sched_barrier(0)
    Unit cur, nxt; int ui = 0;
    if (!S.next(0, cur)) return;
    unsigned vgA[2][2], vgN[2][2];
    int gR[2], gC[2];
#pragma unroll
    for (int i = 0; i < 2; ++i) stage_rc(tid * 16 + i * 8192, gR[i], gC[i]);
#define PG8_GOFF(DST, PM) do { if constexpr (GATHER) { _Pragma("unroll") for (int h_ = 0; h_ < 2; ++h_) _Pragma("unroll") for (int i_ = 0; i_ < 2; ++i_) { \
        const int ri_ = (int)rowtab[2 * ((size_t)(PM) * BM + h_ * HALF + gR[i_])]; const unsigned tok_ = ri_ < 0 ? 0u : (unsigned)ri_ >> 1; DST[h_][i_] = (tok_ * (unsigned)g.lda + (unsigned)gC[i_]) * 2u; } } } while (0)
    PG8_GOFF(vgA, cur.pm);
    f32x4 acc[2][2][4][2];
#pragma unroll
    for (int a = 0; a < 2; ++a)
#pragma unroll
        for (int b = 0; b < 2; ++b)
#pragma unroll
            for (int m = 0; m < 4; ++m)
#pragma unroll
                for (int n = 0; n < 2; ++n) acc[a][b][m][n] = (f32x4){0.f, 0.f, 0.f, 0.f};
    bf16x8 At[4][2], B0[2][2], B1[2][2];
    const char* cA = GATHER ? (const char*)g.A : (const char*)g.A + (size_t)cur.pm * tstepA + cur.aoff; const char* cB = (const char*)g.Bt + (size_t)cur.pb * tstepB;
    PG8_STAGE(PG8_SB(0, 0), cB, voffB); PG8_STAGE(PG8_SB(0, 1), cB + hstepB, voffB); PG8_STAGE_A(PG8_SA(0, 0), cA, 0); PG8_STAGE_A(PG8_SA(0, 1), cA, 1);
    if (wr == 1) PG8_BAR;
    PG8_WAIT_V(2); PG8_BAR;
    PG8_STAGE(PG8_SB(1, 0), cB + kstep, voffB); PG8_STAGE_A(PG8_SA(1, 0), cA + kstep, 0); PG8_STAGE(PG8_SB(1, 1), cB + hstepB + kstep, voffB);
    PG8_WAIT_V(6); PG8_BAR;
    for (;;) {
        const bool has_next = S.next(ui + 1, nxt);
        if (has_next) PG8_GOFF(vgN, nxt.pm); else { if constexpr (GATHER) { vgN[0][0] = vgA[0][0]; vgN[0][1] = vgA[0][1]; vgN[1][0] = vgA[1][0]; vgN[1][1] = vgA[1][1]; } }
        const char* nA = GATHER ? cA : (has_next ? (const char*)g.A + (size_t)nxt.pm * tstepA + nxt.aoff : cA); const char* nB = has_next ? (const char*)g.Bt + (size_t)nxt.pb * tstepB : cB;
        for (int t = 0; t < nt; t += 2) {
            const bool last = (t == nt - 2);
            const char* a1 = cA + (size_t)(t + 1) * kstep;
            const char* a2 = last ? nA : cA + (size_t)(t + 2) * kstep; const char* b2 = last ? nB : cB + (size_t)(t + 2) * kstep;
            const char* a3 = a2 + kstep; const char* b3 = b2 + kstep;
            PG8_LDB(B0, 0, 0); PG8_LDB(B1, 0, 1); PG8_SCHED; PG8_LDA(At, 0, 0); PG8_STAGE_AX(PG8_SA(1, 1), a1, 1, false);
            PG8_WAIT_V(8); PG8_WAIT_L(0); PG8_BAR; PG8_MMA(0, 0, At, B0); PG8_MMA(0, 1, At, B1); PG8_BAR; PG8_SCHED;
            PG8_LDA(At, 0, 1); PG8_STAGE(PG8_SB(0, 0), b2, voffB); PG8_STAGE(PG8_SB(0, 1), b2 + hstepB, voffB); PG8_STAGE_AX(PG8_SA(0, 0), a2, 0, last);
            PG8_WAIT_V(8); PG8_WAIT_L(0); PG8_BAR; PG8_MMA(1, 0, At, B0); PG8_MMA(1, 1, At, B1); PG8_BAR; PG8_SCHED;
            PG8_LDB(B0, 1, 0); PG8_LDB(B1, 1, 1); PG8_SCHED; PG8_LDA(At, 1, 0); PG8_STAGE_AX(PG8_SA(0, 1), a2, 1, last);
            PG8_WAIT_V(8); PG8_WAIT_L(0); PG8_BAR; PG8_MMA(0, 0, At, B0); PG8_MMA(0, 1, At, B1); PG8_BAR; PG8_SCHED;
            PG8_LDA(At, 1, 1); PG8_STAGE(PG8_SB(1, 0), b3, voffB); PG8_STAGE(PG8_SB(1, 1), b3 + hstepB, voffB); PG8_STAGE_AX(PG8_SA(1, 0), a3, 0, last);
            PG8_WAIT_V(8); PG8_WAIT_L(0); PG8_BAR; PG8_MMA(1, 0, At, B0); PG8_MMA(1, 1, At, B1); PG8_BAR; PG8_SCHED;
        }
        if (wr == 0) PG8_BAR;
        { unsigned on_ = ~0u; asm volatile("" : "+s"(on_)); const int lz_ = (int)__builtin_amdgcn_mbcnt_hi(on_, __builtin_amdgcn_mbcnt_lo(on_, 0u));
          E(acc, cur, wr, wc, lz_ & 15, lz_ >> 4); }
        if (!has_next) break;
#pragma unroll
        for (int a = 0; a < 2; ++a)
#pragma unroll
            for (int b = 0; b < 2; ++b)
#pragma unroll
                for (int m = 0; m < 4; ++m)
#pragma unroll
                    for (int n = 0; n < 2; ++n) acc[a][b][m][n] = (f32x4){0.f, 0.f, 0.f, 0.f};
        cur = nxt; cA = nA; cB = nB; ++ui;
        if constexpr (GATHER) { vgA[0][0] = vgN[0][0]; vgA[0][1] = vgN[0][1]; vgA[1][0] = vgN[1][0]; vgA[1][1] = vgN[1][1]; }
        if (wr == 1) PG8_BAR;
    }
    PG8_WAIT_V(0);
    PG8_BAR;
#undef PG8_SA
#undef PG8_STAGE_A
#undef PG8_STAGE_AX
#undef PG8_GOFF
#undef PG8_SB
#undef PG8_STAGE
#undef PG8_LDA
#undef PG8_LDB
#undef PG8_MMA
#undef PG8_WAIT_V
#undef PG8_WAIT_L
#undef PG8_BAR
#undef PG8_SCHED
}
}

constexpr int NTOK = 65536, DM = 1024, SEQ = 2048, NBATCH = 32, NLAYER = 4;
constexpr int PW = 3072;
constexpr int PC_AQ = 0, PC_AK = 256, PC_AV = 512, PC_BQ = 768, PC_CKV = 1024, PC_IQ = 1088, PC_IK = 1344, PC_IW = 1376,
              PC_CQ = 1384, PC_CK = 1512, PC_CV = 1640, PC_CA = 1896, PC_CG = 1912, PC_D = 2168;
constexpr int IN_W = 7096;
constexpr float LN_EPS = 1e-5f;
constexpr float DN_ALPHA = 1.6817928305074292f;
constexpr int NWAVES = 8, NTHR = 512;
constexpr int MOE_ROWS = 2 * NTOK + 32 * 256;

constexpr size_t MiB = 1u << 20;
constexpr size_t WS_CTL = 0, CTL_ZERO_BYTES = 1 * MiB;
constexpr size_t WS_TOK = 1 * MiB;
constexpr size_t WS_ROW = 3 * MiB;
constexpr size_t WS_BON = 5 * MiB;
constexpr size_t WS_RT = 6 * MiB;
constexpr size_t WS_CKVN = 8 * MiB;
constexpr size_t WS_CA = 16 * MiB;
constexpr size_t WS_W = 48 * MiB;
constexpr size_t WL_IN = 0, WL_BR = 14 * MiB, WL_OUT = 16 * MiB, WL_GU = 18 * MiB, WL_DN = 50 * MiB, WL_SIZE = 66 * MiB;
constexpr size_t WS_XB = 312 * MiB;
constexpr size_t WS_BIG = 440 * MiB;
constexpr size_t BIG_DW = 384 * MiB, BIG_DAI = 448 * MiB, BIG_DG = 480 * MiB;
constexpr size_t BIG_H = 272 * MiB;
constexpr size_t WS_END = 952 * MiB;
constexpr size_t DO_YS = 0, DO_MG = 128 * MiB, DO_DR = 128 * MiB, DO_DKP = 160 * MiB, DO_DV = 192 * MiB, DO_DKK = 224 * MiB;

constexpr int CW_TMO = 0, CW_CODE = 1;
constexpr int CW_BAR = 4096;
constexpr int CW_Q = 8192;
constexpr int CW_CNT = 16384;

constexpr int RING_BYTES = 131072;
constexpr int MISC_OFF = RING_BYTES;
constexpr int TST_OFF = MISC_OFF + 512;
constexpr int BKT_OFF = MISC_OFF + 1024;
constexpr int RPB_OFF = MISC_OFF + 3072;
constexpr int LDS_BYTES = 147456;

#define LDS_WAIT() asm volatile("s_waitcnt lgkmcnt(0)" ::: "memory")
#define VM_WAIT() asm volatile("s_waitcnt vmcnt(0)" ::: "memory")
__device__ __forceinline__ float bf2f(unsigned b) { return __uint_as_float(b << 16); }
__device__ __forceinline__ unsigned f2bf(float f) { unsigned u = __float_as_uint(f); return (u + 0x7fffu + ((u >> 16) & 1u)) >> 16; }
__device__ __forceinline__ unsigned pk2(float lo, float hi) { return f2bf(lo) | (f2bf(hi) << 16); }
__device__ __forceinline__ float bflo(unsigned w) { return __uint_as_float(w << 16); }
__device__ __forceinline__ float bfhi(unsigned w) { return __uint_as_float(w & 0xffff0000u); }
template <int CTRL> __device__ __forceinline__ float dppf(float v) {
    return __builtin_bit_cast(float, __builtin_amdgcn_update_dpp(0, __builtin_bit_cast(int, v), CTRL, 0xf, 0xf, true));
}
__device__ __forceinline__ float wave_sum(float v) {
    v += dppf<0x128>(v); v += dppf<0x124>(v); v += dppf<0x122>(v); v += dppf<0x121>(v);
    v += __shfl_xor(v, 16); v += __shfl_xor(v, 32); return v;
}
__device__ __forceinline__ float wave_max(float v) {
#pragma unroll
    for (int o = 1; o < 64; o <<= 1) v = fmaxf(v, __shfl_xor(v, o));
    return v;
}
__device__ __forceinline__ float sum8(float v) { v += dppf<0xB1>(v); v += dppf<0x4E>(v); v += dppf<0x141>(v); return v; }
__device__ __forceinline__ float sigmoidf_(float x) { return __builtin_amdgcn_rcpf(1.f + __expf(-x)); }
__device__ __forceinline__ float log_sigmoidf_(float z) { return fminf(z, 0.f) - __logf(1.f + __expf(-fabsf(z))); }

#define XB_TMO      128
#define XB_XCNT(j)  (256  + 64 * (j))
#define XB_XSUB(j)  (1280 + 64 * (j))
#define XB_XGEN(j)  (2304 + 64 * (j))
#define XB_TOP      3328
#define XB_TOPGEN   3392
#define XCD_BAR_WORDS 3456
#define XB_SPIN_CAP (1u << 22)

__device__ __forceinline__ unsigned xb_ld(unsigned* p)              { return __hip_atomic_load(p, __ATOMIC_RELAXED, __HIP_MEMORY_SCOPE_AGENT); }
__device__ __forceinline__ unsigned xb_add(unsigned* p, unsigned v) { return __hip_atomic_fetch_add(p, v, __ATOMIC_RELAXED, __HIP_MEMORY_SCOPE_AGENT); }
__device__ __forceinline__ unsigned xb_xcc_id() { return (unsigned)__builtin_amdgcn_s_getreg((3 << 11) | 20) & 0xFu; }
#define XB_SPIN(cond, bar) do { unsigned _sp = 0; while (cond) { __builtin_amdgcn_s_sleep(1); \
    if ((++_sp & 255u) == 0u) { if (xb_ld(&(bar)[XB_TMO])) break; if (_sp > XB_SPIN_CAP) { atomicAdd(&(bar)[XB_TMO], 1u); break; } } } } while (0)

struct XcdBarrier { unsigned* bar; unsigned x; volatile LAS unsigned* st; };

__device__ __forceinline__ XcdBarrier xcd_barrier_post(unsigned* bar, volatile LAS unsigned* st) {
    XcdBarrier b; b.bar = bar; b.x = xb_xcc_id(); b.st = st;
    if (threadIdx.x == 0) (void)xb_add(&bar[XB_XCNT(b.x)], 1u);
    return b;
}
__device__ __forceinline__ void xcd_barrier_complete(unsigned* bar, unsigned x, unsigned& nloc, unsigned& nx) {
    const unsigned G = gridDim.x * gridDim.y * gridDim.z;
    unsigned sum, cnt, mine, sp = 0u;
    for (;;) {
        sum = 0u; cnt = 0u; mine = 0u;
#pragma unroll
        for (unsigned j = 0; j < 16; ++j) { const unsigned c = xb_ld(&bar[XB_XCNT(j)]); sum += c; cnt += (c > 0u) ? 1u : 0u; mine = (j == x) ? c : mine; }
        if (sum == G) break;
        __builtin_amdgcn_s_sleep(1);
        if ((++sp & 255u) == 0u) { if (xb_ld(&bar[XB_TMO])) break; if (sp > XB_SPIN_CAP) { atomicAdd(&bar[XB_TMO], 1u); break; } }
    }
    nloc = mine > 0u ? mine : 1u; nx = cnt > 0u ? cnt : 1u;
}
__device__ __forceinline__ void xcd_barrier(const XcdBarrier& b) {
    asm volatile("s_waitcnt vmcnt(0)" ::: "memory");
    __syncthreads();
    if (threadIdx.x == 0) {
        unsigned* bar = b.bar;
        __builtin_amdgcn_s_waitcnt(0);
        unsigned nloc = b.st[0], nx = b.st[1];
        if (nloc == 0u) { xcd_barrier_complete(bar, b.x, nloc, nx); b.st[0] = nloc; b.st[1] = nx; }
        const unsigned old = xb_add(&bar[XB_XSUB(b.x)], 1u);
        const unsigned gen = old / nloc;
        if (old + 1u == (gen + 1u) * nloc) {
            __builtin_amdgcn_fence(__ATOMIC_RELEASE, "agent");
            asm volatile("s_waitcnt vmcnt(0)" ::: "memory");
            const unsigned og = xb_add(&bar[XB_TOP], 1u);
            const unsigned tg = og / nx;
            if (og + 1u == (tg + 1u) * nx) xb_add(&bar[XB_TOPGEN], 1u);
            else XB_SPIN(xb_ld(&bar[XB_TOPGEN]) == tg, bar);
            __builtin_amdgcn_fence(__ATOMIC_ACQUIRE, "agent");
            xb_add(&bar[XB_XGEN(b.x)], 1u);
            asm volatile("s_waitcnt vmcnt(0)" ::: "memory");
        } else {
            XB_SPIN(xb_ld(&bar[XB_XGEN(b.x)]) == gen, bar);
            __builtin_amdgcn_fence(__ATOMIC_ACQUIRE, "agent");
            asm volatile("s_waitcnt vmcnt(0)" ::: "memory");
        }
    }
    __syncthreads();
}

__device__ __forceinline__ int t5_bucket(int d) {
    if (d < 16) return d;
    int b = 16;
    b += (d >= 22) + (d >= 30) + (d >= 40) + (d >= 54) + (d >= 73) + (d >= 99) + (d >= 134) + (d >= 182) + (d >= 246) + (d >= 332) + (d >= 450) + (d >= 609) + (d >= 825) + (d >= 1117) + (d >= 1513);
    return b;
}
struct Args { const float* in[30]; float* out; unsigned char* ws; int l_lo, l_hi, ph_lo, ph_hi, use_bar, pad; };

namespace pg8 {
struct EpiNull {
    static constexpr bool PERM = true;
    unsigned* sink;
    __device__ __forceinline__ void operator()(const f32x4 (&acc)[2][2][4][2], const Unit& u, int wr, int wc, int fr, int fq) const {
        float t = 0.f;
#pragma unroll
        for (int ai = 0; ai < 2; ++ai)
#pragma unroll
            for (int bj = 0; bj < 2; ++bj)
#pragma unroll
                for (int m = 0; m < 4; ++m)
#pragma unroll
                    for (int n = 0; n < 2; ++n) t += (acc[ai][bj][m][n][0] + acc[ai][bj][m][n][1]) + (acc[ai][bj][m][n][2] + acc[ai][bj][m][n][3]);
        if (t == 1.2345e-33f) sink[0] = 1u; }
};
struct EpiStoreBf16 {
    static constexpr bool PERM = true;
    bf16* O; int ldc;
    __device__ __forceinline__ void operator()(const f32x4 (&acc)[2][2][4][2], const Unit& u, int wr, int wc, int fr, int fq) const {
        const int row0 = u.pm * BM + wr * 64 + fr, col0 = u.pn * BM + wc * 32 + 8 * fq;
#pragma unroll
        for (int ai = 0; ai < 2; ++ai)
#pragma unroll
            for (int m = 0; m < 4; ++m) { bf16* rowp = O + (size_t)(row0 + ai * HALF + m * 16) * ldc + col0;
#pragma unroll
                for (int bj = 0; bj < 2; ++bj) { const f32x4 v0 = acc[ai][bj][m][0], v1 = acc[ai][bj][m][1];
                    u32x4 w; w.x = cvt_pk_bf16(v0[0], v0[1]); w.y = cvt_pk_bf16(v0[2], v0[3]); w.z = cvt_pk_bf16(v1[0], v1[1]); w.w = cvt_pk_bf16(v1[2], v1[3]);
                    *(u32x4*)(rowp + bj * HALF) = w; } }
    }
};
struct EpiGate {
    static constexpr bool PERM = false;
    const bf16* BR; bf16* MG;
    __device__ __forceinline__ void operator()(const f32x4 (&acc)[2][2][4][2], const Unit& u, int wr, int wc, int fr, int fq) const {
        const int row0 = u.pm * BM + wr * 64 + fr, j0 = u.pn * 64 + wc * 16 + 4 * fq;
#pragma unroll
        for (int ai = 0; ai < 2; ++ai)
#pragma unroll
            for (int m = 0; m < 4; ++m) { const size_t r = (size_t)(row0 + ai * HALF + m * 16);
                float mg0 = 0.f, mg1 = 0.f, mg2 = 0.f, mg3 = 0.f;
#pragma unroll
                for (int bj = 0; bj < 2; ++bj)
#pragma unroll
                    for (int n = 0; n < 2; ++n) { const int g = 2 * bj + n; const u32x2 b = *(const u32x2*)(BR + r * 4096 + g * 1024 + j0); const f32x4 a = acc[ai][bj][m][n];
                        mg0 += sigmoidf_(a[0]) * bflo(b.x); mg1 += sigmoidf_(a[1]) * bfhi(b.x); mg2 += sigmoidf_(a[2]) * bflo(b.y); mg3 += sigmoidf_(a[3]) * bfhi(b.y); }
                u32x2 w; w.x = cvt_pk_bf16(mg0, mg1); w.y = cvt_pk_bf16(mg2, mg3);
                *(u32x2*)(MG + r * 1024 + j0) = w; }
    }
};
struct EpiOut {
    static constexpr bool PERM = true;
    bf16* XB;
    __device__ __forceinline__ void operator()(const f32x4 (&acc)[2][2][4][2], const Unit& u, int wr, int wc, int fr, int fq) const {
        const int row0 = u.pm * BM + wr * 64 + fr, col0 = u.pn * BM + wc * 32 + 8 * fq;
#pragma unroll
        for (int ai = 0; ai < 2; ++ai)
#pragma unroll
            for (int m = 0; m < 4; ++m) { bf16* rowp = XB + (size_t)(row0 + ai * HALF + m * 16) * 1024 + col0;
#pragma unroll
                for (int bj = 0; bj < 2; ++bj) { const f32x4 v0 = acc[ai][bj][m][0], v1 = acc[ai][bj][m][1]; const u32x4 x = *(const u32x4*)(rowp + bj * HALF);
                    u32x4 w; w.x = cvt_pk_bf16(DN_ALPHA * bflo(x.x) + v0[0], DN_ALPHA * bfhi(x.x) + v0[1]); w.y = cvt_pk_bf16(DN_ALPHA * bflo(x.y) + v0[2], DN_ALPHA * bfhi(x.y) + v0[3]);
                    w.z = cvt_pk_bf16(DN_ALPHA * bflo(x.z) + v1[0], DN_ALPHA * bfhi(x.z) + v1[1]); w.w = cvt_pk_bf16(DN_ALPHA * bflo(x.w) + v1[2], DN_ALPHA * bfhi(x.w) + v1[3]);
                    *(u32x4*)(rowp + bj * HALF) = w; } }
    }
};
struct EpiUp {
    static constexpr bool PERM = true;
    const unsigned* rowinfo; bf16* H;
    __device__ __forceinline__ void operator()(const f32x4 (&acc)[2][2][4][2], const Unit& u, int wr, int wc, int fr, int fq) const {
        const int row0 = u.pm * BM + wr * 64 + fr, col0 = u.pn * 128 + wc * 32 + 8 * fq;
#pragma unroll
        for (int ai = 0; ai < 2; ++ai)
#pragma unroll
            for (int m = 0; m < 4; ++m) { const size_t r = (size_t)(row0 + ai * HALF + m * 16); const float w = __uint_as_float(rowinfo[2 * r + 1]);
                const f32x4 g0 = acc[ai][0][m][0], g1 = acc[ai][0][m][1], u0 = acc[ai][1][m][0], u1 = acc[ai][1][m][1];
                float h[8];
#pragma unroll
                for (int e = 0; e < 4; ++e) { h[e] = g0[e] * sigmoidf_(g0[e]) * u0[e] * w; h[4 + e] = g1[e] * sigmoidf_(g1[e]) * u1[e] * w; }
                u32x4 o; o.x = cvt_pk_bf16(h[0], h[1]); o.y = cvt_pk_bf16(h[2], h[3]); o.z = cvt_pk_bf16(h[4], h[5]); o.w = cvt_pk_bf16(h[6], h[7]);
                *(u32x4*)(H + r * 256 + col0) = o; }
    }
};
struct EpiDown {
    static constexpr bool PERM = true;
    const unsigned* rowinfo; bf16* Y;
    __device__ __forceinline__ void operator()(const f32x4 (&acc)[2][2][4][2], const Unit& u, int wr, int wc, int fr, int fq) const {
        const int row0 = u.pm * BM + wr * 64 + fr, col0 = u.pn * BM + wc * 32 + 8 * fq;
#pragma unroll
        for (int ai = 0; ai < 2; ++ai)
#pragma unroll
            for (int m = 0; m < 4; ++m) { const size_t r = (size_t)(row0 + ai * HALF + m * 16); const int ri = (int)rowinfo[2 * r];
                if (ri >= 0) { bf16* rowp = Y + ((size_t)(ri & 1) * NTOK + (size_t)(ri >> 1)) * 1024 + col0;
#pragma unroll
                    for (int bj = 0; bj < 2; ++bj) { const f32x4 v0 = acc[ai][bj][m][0], v1 = acc[ai][bj][m][1];
                        u32x4 w; w.x = cvt_pk_bf16(v0[0], v0[1]); w.y = cvt_pk_bf16(v0[2], v0[3]); w.z = cvt_pk_bf16(v1[0], v1[1]); w.w = cvt_pk_bf16(v1[2], v1[3]);
                        *(u32x4*)(rowp + bj * HALF) = w; } } }
    }
};
}

struct RowMap { int kind, base, g, off;
    __device__ __forceinline__ int operator()(int n) const {
        if (kind == 0) return base + n;
        if (kind == 1) { const int j = base + n, jj = j & 63, pn = j >> 6; return 3072 + pn * 256 + 128 * (g >> 1) + 32 * (jj >> 4) + 16 * (g & 1) + 4 * ((jj >> 2) & 3) + (jj & 3); }
        const int h = base + n; return (h >> 7) * 256 + off + (h & 127);
    }
};
__device__ __forceinline__ void transpose_item(const float* W, int ldw, int k0, int scol0, int nvalid, bf16* WT, int ldk, const RowMap& rm, LAS float* scr, int lane) {
    const int nn = lane & 31;
#pragma unroll 8
    for (int i = 0; i < 32; ++i) { const int kk = 2 * i + (lane >> 5); scr[kk * 33 + nn] = (nn < nvalid) ? W[(size_t)(k0 + kk) * ldw + scol0 + nn] : 0.f; }
    LDS_WAIT(); asm volatile("" ::: "memory");
    const int c = lane & 7;
#pragma unroll
    for (int j = 0; j < 4; ++j) { const int n = (lane >> 3) + 8 * j; const LAS float* s = scr + (8 * c) * 33 + n;
        u32x4 o; o.x = pk2(s[0 * 33], s[1 * 33]); o.y = pk2(s[2 * 33], s[3 * 33]); o.z = pk2(s[4 * 33], s[5 * 33]); o.w = pk2(s[6 * 33], s[7 * 33]);
        *(u32x4*)(WT + (size_t)rm(n) * ldk + k0 + 8 * c) = o; }
    LDS_WAIT(); asm volatile("" ::: "memory");
}
__device__ __forceinline__ void p0_prologue(const Args& a, LAS unsigned char* lds, int gw, int NGW, int wave, int lane) {
    LAS float* scr = (LAS float*)(lds + wave * 16384);
    constexpr int IPL = 16896;
    for (int it = gw; it < NLAYER * IPL; it += NGW) {
        const int l = it / IPL; int r = it - l * IPL;
        unsigned char* wl = a.ws + WS_W + (size_t)l * WL_SIZE;
        RowMap rm; rm.kind = 0; rm.base = 0; rm.g = 0; rm.off = 0;
        if (r < 1536) { const int nt = r % 96, kt = r / 96, n0 = 32 * nt; int nv = 3000 - n0; nv = nv < 0 ? 0 : (nv > 32 ? 32 : nv); rm.base = n0;
            transpose_item(a.in[2] + (size_t)l * 1024 * IN_W, IN_W, 64 * kt, n0, nv, (bf16*)(wl + WL_IN), 1024, rm, scr, lane); continue; }
        r -= 1536;
        if (r < 2048) { const int nt = r % 128, kt = r / 128, gc0 = 32 * nt; rm.kind = 1; rm.g = gc0 >> 10; rm.base = gc0 & 1023;
            transpose_item(a.in[2] + (size_t)l * 1024 * IN_W, IN_W, 64 * kt, 3000 + gc0, 32, (bf16*)(wl + WL_IN), 1024, rm, scr, lane); continue; }
        r -= 2048;
        if (r < 512) { const int nb = r / 128, rr = r % 128, nt = rr % 32, kt = rr / 32; rm.base = nb * 1024 + 32 * nt;
            if (nb != 1) transpose_item(a.in[19] + (size_t)(l * 4 + nb) * 256 * 1024, 1024, 64 * kt, 32 * nt, 32, (bf16*)(wl + WL_BR), 256, rm, scr, lane); continue; }
        r -= 512;
        if (r < 512) { const int nt = r % 32, kt = r / 32; rm.base = 32 * nt;
            transpose_item(a.in[20] + (size_t)l * 1024 * 1024, 1024, 64 * kt, 32 * nt, 32, (bf16*)(wl + WL_OUT), 1024, rm, scr, lane); continue; }
        r -= 512;
        if (r < 8192) { const int up = r >= 4096; if (up) r -= 4096; const int e = r / 128, rr = r % 128, nt = rr % 8, kt = rr / 8; rm.kind = 2; rm.base = 32 * nt; rm.off = up ? 128 : 0;
            transpose_item(a.in[up ? 28 : 27] + (size_t)(l * 32 + e) * 1024 * 256, 256, 64 * kt, 32 * nt, 32, (bf16*)(wl + WL_GU) + (size_t)e * 512 * 1024, 1024, rm, scr, lane); continue; }
        r -= 8192;
        { const int e = r / 128, rr = r % 128, nt = rr % 32, kt = rr / 32; rm.base = 32 * nt;
            transpose_item(a.in[29] + (size_t)(l * 32 + e) * 256 * 1024, 1024, 64 * kt, 32 * nt, 32, (bf16*)(wl + WL_DN) + (size_t)e * 1024 * 256, 256, rm, scr, lane); }
    }
    { float* WRT = (float*)(a.ws + WS_RT); const int gt = gw * 64 + lane, NT = NGW * 64;
      for (int i = gt; i < NLAYER * 4 * 64 * 1024; i += NT) { const int j = i & 1023, c = (i >> 10) & 63, h = (i >> 16) & 3, l = i >> 18;
          const float* wu = a.in[4] + ((size_t)(l * 4 + h) * 64 + c) * 64; const float* wb = a.in[19] + ((size_t)(l * 4 + 1) * 256 + h * 64) * 1024 + j; float acc = 0.f;
#pragma unroll 8
          for (int d = 0; d < 64; ++d) acc += wu[d] * wb[(size_t)d * 1024];
          ((bf16*)(a.ws + WS_W + (size_t)l * WL_SIZE + WL_BR))[(size_t)(1024 + j) * 256 + h * 64 + c] = (bf16)f2bf(acc); }
      for (int i = gt; i < NLAYER * 36 * 1024; i += NT) { const int k = i & 1023, e = (i >> 10) % 36, l = i / (36 * 1024);
          WRT[i] = e < 4 ? a.in[23][((size_t)l * 1024 + k) * 4 + e] : a.in[25][((size_t)l * 1024 + k) * 32 + (e - 4)]; }
      const f32x4* xs = (const f32x4*)a.in[0]; u32x4* xd = (u32x4*)(a.ws + WS_XB);
      for (int i = gt; i < NTOK * DM / 8; i += NT) { const f32x4 v0 = xs[2 * i], v1 = xs[2 * i + 1]; u32x4 o; o.x = pk2(v0[0], v0[1]); o.y = pk2(v0[2], v0[3]); o.z = pk2(v1[0], v1[1]); o.w = pk2(v1[2], v1[3]); xd[i] = o; } }
}

__device__ __forceinline__ float softplusf_(float x) { return fmaxf(x, 0.f) + __logf(1.f + __expf(-fabsf(x))); }
__device__ __forceinline__ float tanhf_(float x) { const float e = __expf(-2.f * fabsf(x)); const float t = (1.f - e) * __builtin_amdgcn_rcpf(1.f + e); return x < 0.f ? -t : t; }
__device__ __forceinline__ void prep_phase(const Args& a, int l, LAS unsigned char* lds, int tid, int gw, int NGW, int lane, const int pmode = 7) {
    const int wave = __builtin_amdgcn_readfirstlane(tid >> 6);
    const bf16* P = (const bf16*)(a.ws + WS_BIG);
    bf16* CKVN = (bf16*)(a.ws + WS_CKVN); bf16* CQH = (bf16*)(a.ws + WS_CA); bf16* CKT = (bf16*)(a.ws + WS_CA + 16 * MiB); float* CCL = (float*)(a.ws + WS_END); float* BON = (float*)(a.ws + WS_BON);
    bf16* DR = (bf16*)((unsigned char*)a.out + DO_DR); bf16* DKP = (bf16*)((unsigned char*)a.out + DO_DKP); bf16* DV = (bf16*)((unsigned char*)a.out + DO_DV); bf16* DKK = (bf16*)((unsigned char*)a.out + DO_DKK);
    float* DW = (float*)(a.ws + WS_BIG + BIG_DW); bf16* DAI = (bf16*)(a.ws + WS_BIG + BIG_DAI); bf16* DG = (bf16*)(a.ws + WS_BIG + BIG_DG);
    const float* kvg = a.in[3] + l * 64; const float* aup = a.in[5] + l * 16 * 128; const float* abias = a.in[6] + l * 128;
    const float* mu = a.in[8] + l * 832; const float* w0 = a.in[9] + l * 256; const float* w2 = a.in[10] + l * 16 * 256; const float* a0 = a.in[11] + l * 256;
    const float* a2 = a.in[12] + l * 16 * 256; const float* g2 = a.in[13] + l * 32 * 256; const float* kkw = a.in[14] + l * 256; const float* kaw = a.in[15] + l * 256; const float* rkw = a.in[16] + l * 256;
    LAS float* sW2 = (LAS float*)lds; LAS float* sA2 = (LAS float*)(lds + 16384); LAS float* sG2 = (LAS float*)(lds + 32768); LAS float* sUP = (LAS float*)(lds + 65536);
    for (int i = tid; i < 4096; i += NTHR) { sW2[i] = w2[i]; sA2[i] = a2[i]; }
    for (int i = tid; i < 8192; i += NTHR) sG2[i] = g2[i];
    for (int i = tid; i < 2048; i += NTHR) sUP[i] = aup[i];
    __syncthreads();
    float mu_r[13], w0_r[4], a0_r[4], kk_r[4], ka_r[4], rk_r[4];
#pragma unroll
    for (int i = 0; i < 4; ++i) { const int c = 4 * lane + i; mu_r[i] = mu[c]; mu_r[4 + i] = mu[256 + c]; mu_r[8 + i] = mu[512 + c]; w0_r[i] = w0[c]; a0_r[i] = a0[c]; kk_r[i] = kkw[c]; ka_r[i] = kaw[c]; rk_r[i] = rkw[c]; }
    mu_r[12] = mu[768 + lane];
    const float kvg_r = kvg[lane], ab0 = abias[lane], ab1 = abias[64 + lane];
    u32x2 ncr, nck, ncv, npr, npk, npv; unsigned short ncl, npl, nckv, nca, nq0, nq1, nk0, nk1;
#define PREP_LOAD(mm) do { const bf16* pr_ = P + (size_t)(mm) * PW; \
        ncr = *(const u32x2*)(pr_ + PC_D + 4 * lane); nck = *(const u32x2*)(pr_ + PC_D + 256 + 4 * lane); ncv = *(const u32x2*)(pr_ + PC_D + 512 + 4 * lane); ncl = pr_[PC_D + 768 + lane]; nckv = pr_[PC_CKV + lane]; nca = pr_[PC_CA + (lane & 15)]; nq0 = pr_[PC_CQ + lane]; nq1 = pr_[PC_CQ + 64 + lane]; nk0 = pr_[PC_CK + lane]; nk1 = pr_[PC_CK + 64 + lane]; } while (0)
    constexpr int NCK = NTOK / 16;
    float* DCL = DW;
#define PREP_LOADP(mm) do { const int tt_ = (mm) & (SEQ - 1); const bf16* pp_ = P + (size_t)(mm) * PW - (tt_ > 0 ? PW : 0); npr = *(const u32x2*)(pp_ + PC_D + 4 * lane); npk = *(const u32x2*)(pp_ + PC_D + 256 + 4 * lane); npv = *(const u32x2*)(pp_ + PC_D + 512 + 4 * lane); npl = pp_[PC_D + 768 + lane]; } while (0)
    if (gw < NCK) { PREP_LOAD(gw * 16); PREP_LOADP(gw * 16); }
    for (int ck = gw; ck < NCK; ck += NGW) {
      float cpr[4] = {1.f, 1.f, 1.f, 1.f}; float cprc0 = 1.f, cprc1 = 1.f;
#pragma unroll 1
      for (int tt = 0; tt < 16; ++tt) {
        const int m = ck * 16 + tt;
        const int t = m & (SEQ - 1);
        const u32x2 ccr = ncr, cck = nck, ccv = ncv, cpr_ = npr, cpk = npk, cpv = npv; const unsigned short ccl = ncl, cpl = npl;
        npr = ncr; npk = nck; npv = ncv; npl = ncl;
        const unsigned short cckv = nckv, cca = nca, cq0 = nq0, cq1 = nq1, ck0 = nk0, ck1 = nk1;
        if (tt < 15) PREP_LOAD(m + 1); else if (ck + NGW < NCK) { PREP_LOAD((ck + NGW) * 16); PREP_LOADP((ck + NGW) * 16); }
        { const float x = bf2f(cckv); const float ss = wave_sum(x * x); const float rn = rsqrtf(ss * (1.f / 64.f) + 1e-6f); CKVN[(size_t)m * 64 + lane] = (bf16)f2bf(x * rn * kvg_r); }
        { const float cav = (lane < 16) ? bf2f(cca) : 0.f; float z0 = ab0, z1 = ab1;
#pragma unroll
          for (int i = 0; i < 16; ++i) { const float cv = __builtin_bit_cast(float, __builtin_amdgcn_readlane(__builtin_bit_cast(int, cav), i)); z0 += cv * sUP[i * 128 + lane]; z1 += cv * sUP[i * 128 + 64 + lane]; }
          cprc0 *= __expf(log_sigmoidf_(z0) * (1.f / 16.f)); cprc1 *= __expf(log_sigmoidf_(z1) * (1.f / 16.f));
          CQH[(size_t)m * 128 + lane] = (bf16)f2bf(bf2f(cq0) * cprc0); CQH[(size_t)m * 128 + 64 + lane] = (bf16)f2bf(bf2f(cq1) * cprc1);
          CKT[(size_t)m * 128 + lane] = (bf16)f2bf(bf2f(ck0) * __builtin_amdgcn_rcpf(cprc0)); CKT[(size_t)m * 128 + 64 + lane] = (bf16)f2bf(bf2f(ck1) * __builtin_amdgcn_rcpf(cprc1));
          if (tt == 15) { CCL[(size_t)ck * 128 + lane] = cprc0; CCL[(size_t)ck * 128 + 64 + lane] = cprc1; } }
        float xs[13];
        { const float cu[13] = {bflo(ccr.x), bfhi(ccr.x), bflo(ccr.y), bfhi(ccr.y), bflo(cck.x), bfhi(cck.x), bflo(cck.y), bfhi(cck.y), bflo(ccv.x), bfhi(ccv.x), bflo(ccv.y), bfhi(ccv.y), bf2f(ccl)};
          const float pv[13] = {bflo(cpr_.x), bfhi(cpr_.x), bflo(cpr_.y), bfhi(cpr_.y), bflo(cpk.x), bfhi(cpk.x), bflo(cpk.y), bfhi(cpk.y), bflo(cpv.x), bfhi(cpv.x), bflo(cpv.y), bfhi(cpv.y), bf2f(cpl)};
#pragma unroll
          for (int i = 0; i < 13; ++i) { const float prev = (t > 0) ? pv[i] : 0.f; xs[i] = cu[i] + (prev - cu[i]) * mu_r[i]; } }
        const float low = xs[12], tw = tanhf_(low), sg = sigmoidf_(low);
        float wr_[4], ar_[4], gv_[4];
#pragma unroll
        for (int i = 0; i < 4; ++i) { wr_[i] = w0_r[i]; ar_[i] = a0_r[i]; gv_[i] = 0.f; }
#define RDL(V, J) __builtin_bit_cast(float, __builtin_amdgcn_readlane(__builtin_bit_cast(int, V), (J)))
#define FMAS(ACC, S, V) asm("v_fmac_f32 %0, %1, %2" : "+v"(ACC) : "s"(S), "v"(V))
        int l4 = 4 * lane; asm volatile("" : "+v"(l4));
#pragma unroll 4
        for (int j = 0; j < 16; ++j) { const float tj = RDL(tw, j), aj = RDL(low, 16 + j); const f32x4 w4 = *(const LAS f32x4*)(sW2 + j * 256 + l4), a4 = *(const LAS f32x4*)(sA2 + j * 256 + l4);
#pragma unroll
            for (int i = 0; i < 4; ++i) { wr_[i] += tj * w4[i]; ar_[i] += aj * a4[i]; } }
#pragma unroll 4
        for (int j = 0; j < 32; ++j) { const float sj = RDL(sg, 32 + j); const f32x4 g4 = *(const LAS f32x4*)(sG2 + j * 256 + l4);
#pragma unroll
            for (int i = 0; i < 4; ++i) gv_[i] += sj * g4[i]; }
#undef RDL
#undef FMAS
        { float kkv[4], kp[4], av[4]; float n2 = 0.f, bn = 0.f;
#pragma unroll
          for (int i = 0; i < 4; ++i) { av[i] = sigmoidf_(ar_[i]); const float kx = xs[4 + i]; kkv[i] = kx * kk_r[i]; n2 += kkv[i] * kkv[i]; kp[i] = kx * (1.f + (av[i] - 1.f) * ka_r[i]); bn += xs[i] * kp[i] * rk_r[i]; }
          n2 += dppf<0x128>(n2); n2 += dppf<0x124>(n2); n2 += dppf<0x122>(n2); n2 += dppf<0x121>(n2);
          bn += dppf<0x128>(bn); bn += dppf<0x124>(bn); bn += dppf<0x122>(bn); bn += dppf<0x121>(bn);
          const float rnrm = __builtin_amdgcn_rcpf(fmaxf(sqrtf(n2), 1e-12f));
          float o_r[4], o_kp[4], o_kk[4], o_ai[4];
#pragma unroll
          for (int i = 0; i < 4; ++i) { const float w_raw = -softplusf_(-wr_[i]) - 0.5f, wdec = __expf(-__expf(w_raw)); const float kn = kkv[i] * rnrm;
              o_kk[i] = -kn * cpr[i]; cpr[i] *= wdec; const float cinv = __builtin_amdgcn_rcpf(cpr[i]);
              o_r[i] = xs[i] * cpr[i]; o_kp[i] = kp[i] * cinv; o_ai[i] = kn * av[i] * cinv; }
          const size_t o = (size_t)m * 256 + 4 * lane;
          *(u32x2*)(DR + o) = (u32x2){pk2(o_r[0], o_r[1]), pk2(o_r[2], o_r[3])}; *(u32x2*)(DKP + o) = (u32x2){pk2(o_kp[0], o_kp[1]), pk2(o_kp[2], o_kp[3])};
          *(u32x2*)(DV + o) = (u32x2){pk2(xs[8], xs[9]), pk2(xs[10], xs[11])}; *(u32x2*)(DKK + o) = (u32x2){pk2(o_kk[0], o_kk[1]), pk2(o_kk[2], o_kk[3])};
          *(u32x2*)(DAI + o) = (u32x2){pk2(o_ai[0], o_ai[1]), pk2(o_ai[2], o_ai[3])}; *(u32x2*)(DG + o) = (u32x2){pk2(gv_[0], gv_[1]), pk2(gv_[2], gv_[3])};
          if (tt == 15) *(f32x4*)(DCL + (size_t)ck * 256 + 4 * lane) = (f32x4){cpr[0], cpr[1], cpr[2], cpr[3]};
          if ((lane & 15) == 0) BON[(size_t)m * 4 + (lane >> 4)] = bn; }
      }
    }
#undef PREP_LOAD
#undef PREP_LOADP
    __syncthreads();
}

typedef float f32x16 __attribute__((ext_vector_type(16)));
typedef short s16x4 __attribute__((ext_vector_type(4)));
typedef short v4i16_t __attribute__((ext_vector_type(4)));
typedef float f32x2_t __attribute__((ext_vector_type(2))); typedef __bf16 bf16x2_t __attribute__((ext_vector_type(2)));
__device__ __forceinline__ unsigned cvtpk_s(float lo, float hi) { f32x2_t v = {lo, hi}; bf16x2_t b = __builtin_convertvector(v, bf16x2_t); return __builtin_bit_cast(unsigned, b); }
__device__ __forceinline__ s16x4 vtr(const LAS unsigned char* p) { return __builtin_bit_cast(s16x4, __builtin_amdgcn_ds_read_tr16_b64_v4i16((LAS v4i16_t*)p)); }
constexpr int ATB_OFF = 102400;
constexpr int AVI_OFF = 3584;
constexpr float LOG2E = 1.4426950408889634f;
__device__ __forceinline__ void mixA_tables(const Args& a, LAS unsigned char* lds, int tid) {
    LAS float* tb = (LAS float*)(lds + ATB_OFF);
    for (int i = tid; i < 3 * 4 * 192; i += NTHR) { const int e = i % 192, h = (i / 192) & 3, f = i / 768; const int dist = 159 - e; const int dl = f == 0 ? 16 : (f == 1 ? 4 : 1);
        float v = -INFINITY;
        if (dist >= 0 && dist <= 128) { int dd = dist * dl; dd = dd > 2047 ? 2047 : dd; v = a.in[1][t5_bucket(dd) * 8 + h] * LOG2E; }
        tb[i] = v; }
}
__device__ __forceinline__ void mixA_task(const Args& a, int b, int h, int r, int cc, LAS unsigned char* lds, int wave, int lane_in) {
    int lane = lane_in; asm volatile("" : "+v"(lane));
    const bf16* P = (const bf16*)(a.ws + WS_BIG); bf16* YS = (bf16*)((unsigned char*)a.out + DO_YS);
    const int ql = lane & 31, hh = lane >> 5, n0 = 32 * cc;
    const size_t rowb = (size_t)b * SEQ; const int tq = 16 * (n0 + ql) + r;
    const LAS float* tball = (const LAS float*)(lds + ATB_OFF) + h * 192;
    LAS unsigned char* vimg = lds + AVI_OFF + wave * 12800;
    bf16x8 qf[4];
    { const bf16* qp = P + (rowb + tq) * PW + PC_AQ + h * 64 + 8 * hh;
#pragma unroll
      for (int ks = 0; ks < 4; ++ks) qf[ks] = *(const bf16x8*)(qp + 16 * ks); }
    f32x16 o0, o1;
#pragma unroll
    for (int i = 0; i < 16; ++i) { o0[i] = 0.f; o1[i] = 0.f; }
    float m = -INFINITY, lsum = 0.f;
    const float SC = 0.125f * LOG2E;
    const int vst = (lane >> 3) * 144 + (lane & 7) * 16;
    const int i16 = lane & 15, tq4 = i16 >> 2, tp = i16 & 3, g16 = (lane >> 4) & 1;
    const int vrd = (4 * hh + tq4) * 144 + 32 * g16 + 8 * tp;
#pragma unroll 1
    for (int f = 0; f < 3; ++f) {
        const int dsh = f == 0 ? 4 : (f == 1 ? 2 : 0);
        const int rho = r & ((1 << dsh) - 1);
        const int qpos = (tq - rho) >> dsh;
        const int qmin = (16 * n0 + r - rho) >> dsh, qmax = (16 * (n0 + 31) + r - rho) >> dsh;
        int klo = qmin - 128; klo = klo < 0 ? 0 : klo; klo &= ~31;
        const LAS float* tbf = tball + f * 768;
        bf16x8 kA[4], kB[4]; u32x4 vA0, vA1, vA2, vA3, vB0, vB1, vB2, vB3;
#define A_LOAD(KF, W0, W1, W2, W3, KK0) do { const size_t tk_ = rowb + (((size_t)((KK0) + ql)) << dsh) + rho; const bf16* kp_ = P + tk_ * PW + PC_AK + h * 64 + 8 * hh; \
            _Pragma("unroll") for (int ks = 0; ks < 4; ++ks) KF[ks] = *(const bf16x8*)(kp_ + 16 * ks); \
            const bf16* vp_ = P + (rowb + (((size_t)((KK0) + (lane >> 3))) << dsh) + rho) * PW + PC_AV + h * 64 + 8 * (lane & 7); const size_t vs_ = ((size_t)8 << dsh) * PW; \
            W0 = *(const u32x4*)(vp_); W1 = *(const u32x4*)(vp_ + vs_); W2 = *(const u32x4*)(vp_ + 2 * vs_); W3 = *(const u32x4*)(vp_ + 3 * vs_); } while (0)
#define A_TILE(KF, W0, W1, W2, W3, K0) do { \
            f32x16 st; \
            _Pragma("unroll") for (int i = 0; i < 16; ++i) st[i] = 0.f; \
            _Pragma("unroll") for (int ks = 0; ks < 4; ++ks) st = __builtin_amdgcn_mfma_f32_32x32x16_bf16(KF[ks], qf[ks], st, 0, 0, 0); \
            *(LAS u32x4*)(vimg + vst) = W0; *(LAS u32x4*)(vimg + vst + 8 * 144) = W1; *(LAS u32x4*)(vimg + vst + 16 * 144) = W2; *(LAS u32x4*)(vimg + vst + 24 * 144) = W3; \
            __builtin_amdgcn_sched_barrier(0); \
            if ((K0) - 64 >= klo) A_LOAD(KF, W0, W1, W2, W3, (K0) - 64); \
            __builtin_amdgcn_sched_barrier(0); \
            const int D0 = qpos - (K0) - 4 * hh; const int e0 = (D0 >= 0 && D0 <= 159) ? 159 - D0 : 0; \
            const LAS float* tp_ = tbf + e0; \
            float mx = -INFINITY; \
            _Pragma("unroll") for (int i = 0; i < 16; ++i) { st[i] = st[i] * SC + tp_[(i & 3) + 8 * (i >> 2)]; mx = fmaxf(mx, st[i]); } \
            mx = fmaxf(mx, __shfl_xor(mx, 32)); \
            const float mn = fmaxf(m, mx), alpha = __builtin_amdgcn_exp2f(m - mn); \
            m = mn; float ps = 0.f; \
            _Pragma("unroll") for (int i = 0; i < 16; ++i) { st[i] = __builtin_amdgcn_exp2f(st[i] - mn); ps += st[i]; } \
            lsum = lsum * alpha + ps; \
            _Pragma("unroll") for (int i = 0; i < 16; ++i) { o0[i] *= alpha; o1[i] *= alpha; } \
            bf16x8 pf[2]; \
            _Pragma("unroll") for (int s = 0; s < 2; ++s) { u32x4 w; w.x = cvtpk_s(st[8 * s], st[8 * s + 1]); w.y = cvtpk_s(st[8 * s + 2], st[8 * s + 3]); w.z = cvtpk_s(st[8 * s + 4], st[8 * s + 5]); w.w = cvtpk_s(st[8 * s + 6], st[8 * s + 7]); pf[s] = __builtin_bit_cast(bf16x8, w); } \
            asm volatile("s_waitcnt lgkmcnt(0)" ::: "memory"); \
            _Pragma("unroll") for (int s = 0; s < 2; ++s) { \
                const s16x4 a00 = vtr(vimg + vrd + (16 * s) * 144), a01 = vtr(vimg + vrd + (16 * s + 8) * 144); \
                const s16x4 a10 = vtr(vimg + vrd + (16 * s) * 144 + 64), a11 = vtr(vimg + vrd + (16 * s + 8) * 144 + 64); \
                const bf16x8 A0 = (bf16x8){a00[0], a00[1], a00[2], a00[3], a01[0], a01[1], a01[2], a01[3]}; \
                const bf16x8 A1 = (bf16x8){a10[0], a10[1], a10[2], a10[3], a11[0], a11[1], a11[2], a11[3]}; \
                o0 = __builtin_amdgcn_mfma_f32_32x32x16_bf16(A0, pf[s], o0, 0, 0, 0); \
                o1 = __builtin_amdgcn_mfma_f32_32x32x16_bf16(A1, pf[s], o1, 0, 0, 0); } \
            asm volatile("s_waitcnt lgkmcnt(0)" ::: "memory"); } while (0)
        int k0 = qmax & ~31;
        A_LOAD(kA, vA0, vA1, vA2, vA3, k0);
        if (k0 - 32 >= klo) A_LOAD(kB, vB0, vB1, vB2, vB3, k0 - 32);
#pragma unroll 1
        while (k0 >= klo) {
            A_TILE(kA, vA0, vA1, vA2, vA3, k0);
            k0 -= 32; if (k0 < klo) break;
            A_TILE(kB, vB0, vB1, vB2, vB3, k0);
            k0 -= 32;
        }
#undef A_TILE
#undef A_LOAD
    }
    const float lt = lsum + __shfl_xor(lsum, 32); const float inv = 1.f / lt;
    bf16* yo = YS + (rowb + tq) * 1024 + h * 64 + 4 * hh;
#pragma unroll
    for (int g = 0; g < 4; ++g) {
        u32x2 w; w.x = cvtpk_s(o0[4 * g] * inv, o0[4 * g + 1] * inv); w.y = cvtpk_s(o0[4 * g + 2] * inv, o0[4 * g + 3] * inv); *(u32x2*)(yo + 8 * g) = w;
        u32x2 x; x.x = cvtpk_s(o1[4 * g] * inv, o1[4 * g + 1] * inv); x.y = cvtpk_s(o1[4 * g + 2] * inv, o1[4 * g + 3] * inv); *(u32x2*)(yo + 32 + 8 * g) = x; }
}

__device__ __forceinline__ unsigned fkey(float f) { const unsigned u = __float_as_uint(f); return (u & 0x80000000u) ? ~u : (u | 0x80000000u); }
typedef float f32x4v __attribute__((ext_vector_type(4)));
__device__ __forceinline__ float wave_max64(float v) {
    v = fmaxf(v, dppf<0x128>(v)); v = fmaxf(v, dppf<0x124>(v)); v = fmaxf(v, dppf<0x122>(v)); v = fmaxf(v, dppf<0x121>(v));
    v = fmaxf(v, __shfl_xor(v, 16)); v = fmaxf(v, __shfl_xor(v, 32)); return v;
}
__device__ __forceinline__ void mixB_attend4(const Args& a, int m0, const LAS unsigned short* sidx4, const LAS unsigned char* sbk4, LAS unsigned char* lds, LAS unsigned char* img, LAS unsigned char* pT, int lane, const int am = 0) {
    const bf16* P = (const bf16*)(a.ws + WS_BIG); const bf16* CKVN = (const bf16*)(a.ws + WS_CKVN); bf16* YS = (bf16*)((unsigned char*)a.out + DO_YS);
    const LAS float* rpb = (const LAS float*)(lds + RPB_OFF);
    const int t0 = m0 & (SEQ - 1); const size_t rowb = (size_t)(m0 - t0);
    const int hc = lane & 15, g = lane >> 4, hd = lane & 3;
    const float SC = 0.125f * LOG2E;
    const int i16 = lane & 15, tq4 = i16 >> 2, tp = i16 & 3;
    const int rd_tr = (4 * g + tq4) * 144 + 8 * tp;
    const int rd_p = hd * 128 + 8 * g;
    u32x4 g0, g1, g2, g3, g4, g5, g6, g7, nq0, nq1, nq2, nq3, nq4, nq5, nq6, nq7;
#define BG_ROW(QI, NS, CH, I, G) do { const int kk_ = 64 * (CH) + 8 * (I) + (lane >> 3); const int idx_ = (int)sidx4[(QI) * 256 + (kk_ < (NS) ? kk_ : 0)] & (SEQ - 1); \
        G = *(const u32x4*)(CKVN + (rowb + idx_) * 64 + 8 * (lane & 7)); } while (0)
#define BG_LOAD(QI, NS, CH) do { BG_ROW(QI, NS, CH, 0, g0); BG_ROW(QI, NS, CH, 1, g1); BG_ROW(QI, NS, CH, 2, g2); BG_ROW(QI, NS, CH, 3, g3); \
        BG_ROW(QI, NS, CH, 4, g4); BG_ROW(QI, NS, CH, 5, g5); BG_ROW(QI, NS, CH, 6, g6); BG_ROW(QI, NS, CH, 7, g7); } while (0)
#define BQ_LOAD(QI) do { const u32x4* qp_ = (const u32x4*)(P + (size_t)(m0 + (QI)) * PW + PC_BQ + hd * 64); \
        nq0 = qp_[0]; nq1 = qp_[1]; nq2 = qp_[2]; nq3 = qp_[3]; nq4 = qp_[4]; nq5 = qp_[5]; nq6 = qp_[6]; nq7 = qp_[7]; } while (0)
#define B_LO(V) __builtin_bit_cast(s16x4, (u32x2){(V).x, (V).y})
#define B_HI(V) __builtin_bit_cast(s16x4, (u32x2){(V).z, (V).w})
#define B_S2(SA, SB, Q, L) do { SA = __builtin_amdgcn_mfma_f32_4x4x4bf16_1k(B_LO(Q), B_LO(L), SA, 0, 0, 0); SB = __builtin_amdgcn_mfma_f32_4x4x4bf16_1k(B_HI(Q), B_HI(L), SB, 0, 0, 0); } while (0)
    { const int ns0 = (t0 + 1 < 256) ? t0 + 1 : 256; BQ_LOAD(0); BG_LOAD(0, ns0, 0); }
#pragma unroll 1
    for (int qi = 0; qi < 4; ++qi) {
        const int m = m0 + qi, tq = t0 + qi; const int nsel = (tq + 1 < 256) ? tq + 1 : 256; const int nsn = (tq + 2 < 256) ? tq + 2 : 256;
        const LAS unsigned char* sbk = sbk4 + qi * 256;
        const u32x4 q0 = nq0, q1 = nq1, q2 = nq2, q3 = nq3, q4 = nq4, q5 = nq5, q6 = nq6, q7 = nq7;
        if (qi + 1 < 4) BQ_LOAD(qi + 1);
        f32x4v oT[4];
#pragma unroll
        for (int mt = 0; mt < 4; ++mt) oT[mt] = (f32x4v){0.f, 0.f, 0.f, 0.f};
        f32x4v mrun = (f32x4v){-INFINITY, -INFINITY, -INFINITY, -INFINITY}, lsum = (f32x4v){0.f, 0.f, 0.f, 0.f};
#pragma unroll 1
        for (int ch = 0; ch < 4; ++ch) {
            if (64 * ch >= nsel) break;
            { LAS unsigned char* ip = img + (lane >> 3) * 144 + 16 * (lane & 7);
              *(LAS u32x4*)(ip) = g0; *(LAS u32x4*)(ip + 8 * 144) = g1; *(LAS u32x4*)(ip + 16 * 144) = g2; *(LAS u32x4*)(ip + 24 * 144) = g3;
              *(LAS u32x4*)(ip + 32 * 144) = g4; *(LAS u32x4*)(ip + 40 * 144) = g5; *(LAS u32x4*)(ip + 48 * 144) = g6; *(LAS u32x4*)(ip + 56 * 144) = g7; }
            if (64 * (ch + 1) < nsel) BG_LOAD(qi, nsel, ch + 1);
            else if (qi + 1 < 4) BG_LOAD(qi + 1, nsn, 0);
            f32x4v sa = (f32x4v){0.f, 0.f, 0.f, 0.f}, sb = sa, sc = sa, sd = sa;
            { const LAS u32x4* lp = (const LAS u32x4*)(img + lane * 144);
              const u32x4 l0 = lp[0], l1 = lp[1], l2 = lp[2], l3 = lp[3], l4 = lp[4], l5 = lp[5], l6 = lp[6], l7 = lp[7];
              B_S2(sa, sb, q0, l0); B_S2(sc, sd, q1, l1); B_S2(sa, sb, q2, l2); B_S2(sc, sd, q3, l3); B_S2(sa, sb, q4, l4); B_S2(sc, sd, q5, l5); B_S2(sa, sb, q6, l6); B_S2(sc, sd, q7, l7); }
            sa = (sa + sb) + (sc + sd);
            const int kpos = 64 * ch + lane;
            const int bk = (int)sbk[kpos < 256 ? kpos : 255];
            const f32x4v bb = *(const LAS f32x4v*)(rpb + bk * 8 + 4);
            f32x4v v = sa * SC + bb * LOG2E;
            if (kpos >= nsel) v = (f32x4v){-INFINITY, -INFINITY, -INFINITY, -INFINITY};
            const bool over = (v[0] > mrun[0] + 32.f) || (v[1] > mrun[1] + 32.f) || (v[2] > mrun[2] + 32.f) || (v[3] > mrun[3] + 32.f);
            if (__any(over)) {
                f32x4v mn, al;
#pragma unroll
                for (int i = 0; i < 4; ++i) { mn[i] = fmaxf(mrun[i], (am & 2) ? v[i] + 40.f : wave_max64(v[i])); al[i] = __builtin_amdgcn_exp2f(mrun[i] - mn[i]); }
                lsum = lsum * al; mrun = mn;
                const float ah = hd == 0 ? al[0] : hd == 1 ? al[1] : hd == 2 ? al[2] : al[3];
#pragma unroll
                for (int mt = 0; mt < 4; ++mt) oT[mt] = oT[mt] * ah;
            }
            f32x4v p;
#pragma unroll
            for (int i = 0; i < 4; ++i) p[i] = __builtin_amdgcn_exp2f(v[i] - mrun[i]);
            lsum = lsum + p;
            { const unsigned w01 = cvtpk_s(p[0], p[1]), w23 = cvtpk_s(p[2], p[3]); LAS unsigned short* pw = (LAS unsigned short*)pT + lane;
              pw[0] = (unsigned short)w01; pw[64] = (unsigned short)(w01 >> 16); pw[128] = (unsigned short)w23; pw[192] = (unsigned short)(w23 >> 16); }
            asm volatile("s_waitcnt lgkmcnt(0)" ::: "memory");
#pragma unroll
            for (int ks2 = 0; ks2 < 2; ++ks2) { if (am & 4) break;
                const u32x2 pl = *(const LAS u32x2*)(pT + rd_p + 64 * ks2), ph = *(const LAS u32x2*)(pT + rd_p + 64 * ks2 + 32);
                const bf16x8 pB = __builtin_bit_cast(bf16x8, (u32x4){pl.x, pl.y, ph.x, ph.y});
#pragma unroll
                for (int mt = 0; mt < 4; ++mt) {
                    const s16x4 lo = vtr(img + rd_tr + (32 * ks2) * 144 + 32 * mt), hi = vtr(img + rd_tr + (32 * ks2 + 16) * 144 + 32 * mt);
                    const bf16x8 A = (bf16x8){lo[0], lo[1], lo[2], lo[3], hi[0], hi[1], hi[2], hi[3]};
                    oT[mt] = __builtin_amdgcn_mfma_f32_16x16x32_bf16(A, pB, oT[mt], 0, 0, 0); } }
            asm volatile("s_waitcnt lgkmcnt(0)" ::: "memory");
        }
        f32x4v lt;
#pragma unroll
        for (int i = 0; i < 4; ++i) lt[i] = (am & 2) ? lsum[i] : wave_sum(lsum[i]);
        const float inv = 1.f / (hd == 0 ? lt[0] : hd == 1 ? lt[1] : hd == 2 ? lt[2] : lt[3]);
        if (hc < 4) { bf16* yo = YS + (size_t)m * 1024 + 256 + hc * 64 + 4 * g;
#pragma unroll
            for (int mt = 0; mt < 4; ++mt) { u32x2 w; w.x = cvtpk_s(oT[mt][0] * inv, oT[mt][1] * inv); w.y = cvtpk_s(oT[mt][2] * inv, oT[mt][3] * inv); *(u32x2*)(yo + 16 * mt) = w; } }
    }
#undef BG_LOAD
#undef BG_ROW
#undef BQ_LOAD
#undef B_LO
#undef B_HI
#undef B_S2
}
__device__ __forceinline__ void mixB_group(const Args& a, int l, int m0, LAS unsigned char* lds, LAS unsigned char* wscr, int lane_in, const int bmode = 15) {
    int lane = lane_in; asm volatile("" : "+v"(lane));
    const bf16* P = (const bf16*)(a.ws + WS_BIG);
    const int t0 = m0 & (SEQ - 1); const size_t rowb = (size_t)(m0 - t0);
    const int ql = lane & 31, hh = lane >> 5;
    LAS unsigned short* sidx = (LAS unsigned short*)wscr;
    LAS unsigned char* sbk = wscr + 2048;
    LAS unsigned char* img = wscr + 3584;
    const LAS unsigned char* bkt = lds + BKT_OFF;
    bf16x8 qf[2];
    { const int rho = ql, qi = 2 * ((rho >> 2) & 1) + (rho >> 4), hd = 4 * ((rho >> 3) & 1) + (rho & 3);
      const bf16* ip = P + (size_t)(m0 + qi) * PW + PC_IQ + hd * 32 + 8 * hh;
      qf[0] = *(const bf16x8*)(ip); qf[1] = *(const bf16x8*)(ip + 16); }
    float iw[2][8];
#pragma unroll
    for (int qq = 0; qq < 2; ++qq) { const u32x4 w = *(const u32x4*)(P + (size_t)(m0 + 2 * hh + qq) * PW + PC_IW); const float s = 0.0625f;
        iw[qq][0] = bflo(w.x) * s; iw[qq][1] = bfhi(w.x) * s; iw[qq][2] = bflo(w.y) * s; iw[qq][3] = bfhi(w.y) * s; iw[qq][4] = bflo(w.z) * s; iw[qq][5] = bfhi(w.z) * s; iw[qq][6] = bflo(w.w) * s; iw[qq][7] = bfhi(w.w) * s; }
    const int tq0 = t0 + 2 * hh;
    const int ntile = ((t0 + 3) >> 5) + 1;
    unsigned sk[2][64];
#pragma unroll
    for (int kb4 = 0; kb4 < 32; ++kb4) {
        if (2 * kb4 < ntile && (bmode & 1)) {
            bf16x8 kf0[2], kf1[2];
#pragma unroll
            for (int k4 = 0; k4 < 2; ++k4) { const int s = 32 * (2 * kb4 + k4) + ql; const bf16* kp = P + (rowb + s) * PW + PC_IK + 8 * hh; kf0[k4] = *(const bf16x8*)(kp); kf1[k4] = *(const bf16x8*)(kp + 16); }
#pragma unroll
            for (int k4 = 0; k4 < 2; ++k4) { const int kt = 2 * kb4 + k4; const int s = 32 * kt + ql;
                f32x16 acc;
#pragma unroll
                for (int i = 0; i < 16; ++i) acc[i] = 0.f;
                acc = __builtin_amdgcn_mfma_f32_32x32x16_bf16(qf[0], kf0[k4], acc, 0, 0, 0);
                acc = __builtin_amdgcn_mfma_f32_32x32x16_bf16(qf[1], kf1[k4], acc, 0, 0, 0);
                float s0 = 0.f, s1 = 0.f;
#pragma unroll
                for (int i = 0; i < 8; ++i) { s0 += fmaxf(acc[i], 0.f) * iw[0][i]; s1 += fmaxf(acc[8 + i], 0.f) * iw[1][i]; asm("" : "+v"(s0), "+v"(s1)); }
                sk[0][kt] = (s <= tq0) ? fkey(s0 + 0.f) : 0x007fffffu; sk[1][kt] = (s <= tq0 + 1) ? fkey(s1 + 0.f) : 0x007fffffu; }
        } else {
#pragma unroll
            for (int k4 = 0; k4 < 2; ++k4) { sk[0][2 * kb4 + k4] = 0x007fffffu; sk[1][2 * kb4 + k4] = 0x007fffffu; }
        }
    }
    const unsigned ltm = (1u << ql) - 1u;
    const int nblk8 = (ntile + 7) >> 3;
#define SK_RED(C) do { C += __builtin_amdgcn_update_dpp(0, C, 0x128, 0xf, 0xf, true); C += __builtin_amdgcn_update_dpp(0, C, 0x124, 0xf, 0xf, true); \
        C += __builtin_amdgcn_update_dpp(0, C, 0x122, 0xf, 0xf, true); C += __builtin_amdgcn_update_dpp(0, C, 0x121, 0xf, 0xf, true); C += __shfl_xor(C, 16); } while (0)
#define SK_CNT4(C, K0, K1, K2, K3, T) do { unsigned long long m0_, m1_, m2_, m3_; asm volatile( \
        "v_cmp_ge_u32_e64 %1, %5, %9\n\tv_cmp_ge_u32_e64 %2, %6, %9\n\tv_cmp_ge_u32_e64 %3, %7, %9\n\tv_cmp_ge_u32_e64 %4, %8, %9\n\t" \
        "v_addc_co_u32_e64 %0, %1, 0, %0, %1\n\tv_addc_co_u32_e64 %0, %2, 0, %0, %2\n\tv_addc_co_u32_e64 %0, %3, 0, %0, %3\n\tv_addc_co_u32_e64 %0, %4, 0, %0, %4" \
        : "+v"(C), "=&s"(m0_), "=&s"(m1_), "=&s"(m2_), "=&s"(m3_) : "v"(K0), "v"(K1), "v"(K2), "v"(K3), "v"(T)); } while (0)
#define SK_COUNT_GE(R0, R1, C0, C1) do { const unsigned r0_ = (R0), r1_ = (R1); _Pragma("unroll") for (int kb8 = 0; kb8 < 8; ++kb8) { if (kb8 < nblk8) { \
        SK_CNT4(C0, sk[0][8 * kb8], sk[0][8 * kb8 + 1], sk[0][8 * kb8 + 2], sk[0][8 * kb8 + 3], r0_); SK_CNT4(C1, sk[1][8 * kb8], sk[1][8 * kb8 + 1], sk[1][8 * kb8 + 2], sk[1][8 * kb8 + 3], r1_); \
        SK_CNT4(C0, sk[0][8 * kb8 + 4], sk[0][8 * kb8 + 5], sk[0][8 * kb8 + 6], sk[0][8 * kb8 + 7], r0_); SK_CNT4(C1, sk[1][8 * kb8 + 4], sk[1][8 * kb8 + 5], sk[1][8 * kb8 + 6], sk[1][8 * kb8 + 7], r1_); } } \
        SK_RED(C0); SK_RED(C1); } while (0)
#define SK_COUNT2(OP, R0, R1, C0, C1) do { _Pragma("unroll") for (int kb8 = 0; kb8 < 8; ++kb8) { if (kb8 < nblk8) { _Pragma("unroll") for (int k8 = 0; k8 < 8; ++k8) { \
        C0 += (sk[0][8 * kb8 + k8] OP (R0)) ? 1 : 0; C1 += (sk[1][8 * kb8 + k8] OP (R1)) ? 1 : 0; } } } SK_RED(C0); SK_RED(C1); } while (0)
#define KEY2F(K) __uint_as_float(((K) & 0x80000000u) ? ((K) & 0x7fffffffu) : ~(K))
#define SK_REDU(C, F) do { unsigned o_; o_ = (unsigned)__builtin_amdgcn_update_dpp(0, (int)C, 0x128, 0xf, 0xf, true); C = F(C, o_); o_ = (unsigned)__builtin_amdgcn_update_dpp(0, (int)C, 0x124, 0xf, 0xf, true); C = F(C, o_); \
        o_ = (unsigned)__builtin_amdgcn_update_dpp(0, (int)C, 0x122, 0xf, 0xf, true); C = F(C, o_); o_ = (unsigned)__builtin_amdgcn_update_dpp(0, (int)C, 0x121, 0xf, 0xf, true); C = F(C, o_); o_ = (unsigned)__shfl_xor((int)C, 16); C = F(C, o_); } while (0)
#define SK_UMIN(A, B) ((A) < (B) ? (A) : (B))
#define SK_UMAX(A, B) ((A) > (B) ? (A) : (B))
    constexpr int SEL_CAP = 12;
    unsigned KthA[2] = {0u, 0u}; int needA[2] = {0, 0};
    const bool big0 = (tq0 + 1 > 256), big1 = (tq0 + 2 > 256); bool exA[2] = {true, true};
    if (__any(big0 || big1) && (bmode & 2)) {
        float c255 = 255.5f, chalf = 0.5f; asm volatile("" : "+v"(c255), "+v"(chalf));
        unsigned klo[2], khi[2]; int chi[2] = {0, 0}; float x1[2], c1[2] = {0.f, 0.f}, x2[2] = {0.f, 0.f}, c2[2] = {0.f, 0.f}; bool done[2] = {!big0, !big1};
#pragma unroll
        for (int qq = 0; qq < 2; ++qq) { unsigned gm[8];
#pragma unroll
            for (int k8 = 0; k8 < 8; ++k8) gm[k8] = sk[qq][k8];
#pragma unroll
            for (int kb8 = 1; kb8 < 8; ++kb8) { if (kb8 < nblk8) {
#pragma unroll
                for (int k8 = 0; k8 < 8; ++k8) gm[k8] = SK_UMAX(gm[k8], sk[qq][8 * kb8 + k8]); } }
            unsigned mn = gm[0], mx = gm[0];
#pragma unroll
            for (int k8 = 1; k8 < 8; ++k8) { mn = SK_UMIN(mn, gm[k8]); mx = SK_UMAX(mx, gm[k8]); }
            SK_REDU(mn, SK_UMIN); SK_REDU(mx, SK_UMAX);
            klo[qq] = mn; khi[qq] = mx + 1u; x1[qq] = KEY2F(mx); exA[qq] = done[qq]; if (khi[qq] - klo[qq] <= 1u) done[qq] = true; }
#pragma unroll 1
        for (int it = 0; it < 64; ++it) {
            unsigned mk[2];
#pragma unroll
            for (int qq = 0; qq < 2; ++qq) { const unsigned lo = klo[qq], hi = khi[qq]; const float xlo = KEY2F(lo), xhi = KEY2F(hi - 1u); const float fmid = chalf * xlo + chalf * xhi;
                const float fs = x2[qq] + (c255 - c2[qq]) * (x2[qq] - x1[qq]) * __builtin_amdgcn_rcpf(c2[qq] - c1[qq]);
                unsigned m = fkey(it == 0 ? fmid : fs);
                if (it >= SEL_CAP || !(m > lo && m < hi)) { m = fkey(fmid); if (it >= SEL_CAP || !(m > lo && m < hi)) m = lo + ((hi - lo) >> 1); }
                mk[qq] = m; }
            int n0 = 0, n1 = 0;
            SK_COUNT_GE(mk[0], mk[1], n0, n1);
#pragma unroll
            for (int qq = 0; qq < 2; ++qq) { const int n = qq ? n1 : n0;
                if (!done[qq]) {
                    if (n >= 256) { klo[qq] = mk[qq]; if (n == 256) { exA[qq] = true; done[qq] = true; } } else { khi[qq] = mk[qq]; chi[qq] = n; }
                    if (it > 0) { x1[qq] = x2[qq]; c1[qq] = c2[qq]; }
                    x2[qq] = KEY2F(mk[qq]); c2[qq] = (float)n;
                    if (khi[qq] - klo[qq] <= 1u) done[qq] = true; } }
            if (__all(done[0] && done[1])) break;
        }
        KthA[0] = klo[0]; KthA[1] = klo[1]; needA[0] = 256 - chi[0]; needA[1] = 256 - chi[1];
    }
    bool sel_bad = false;
    if (bmode & 32) {
        int a0 = 0, a1 = 0, b0 = 0, b1 = 0; SK_COUNT2(>=, KthA[0], KthA[1], a0, a1); SK_COUNT2(>, KthA[0], KthA[1], b0, b1);
        if (big0) sel_bad = sel_bad || (exA[0] ? (a0 != 256) : !(a0 >= 256 && b0 < 256 && needA[0] == 256 - b0));
        if (big1) sel_bad = sel_bad || (exA[1] ? (a1 != 256) : !(a1 >= 256 && b1 < 256 && needA[1] == 256 - b1));
    }
    if (bmode & 16) { sidx[lane] = (unsigned short)(KthA[0] ^ KthA[1] ^ (unsigned)needA[0] ^ (unsigned)needA[1]); }
#pragma unroll
    for (int qq = 0; qq < 2; ++qq) {
        if (!(bmode & 4)) break;
        const int tq = tq0 + qq; const bool big = qq ? big1 : big0; const unsigned Kth = KthA[qq]; const int need = needA[qq]; const bool exact = exA[qq];
        LAS unsigned short* sx = sidx + (2 * hh + qq) * 256;
        int base = 0, tie_taken = 0; int ql2 = ql; asm volatile("" : "+v"(ql2));
#pragma unroll
        for (int kb8 = 0; kb8 < 8; ++kb8) { if (kb8 < nblk8) {
#pragma unroll
            for (int k8 = 0; k8 < 8; ++k8) { const int kt = 8 * kb8 + k8; const int s = 32 * kt + ql2; const unsigned k = sk[qq][kt]; bool take;
                if (!big) take = (s <= tq);
                else if (exact) take = (k >= Kth);
                else { const bool tie = (k == Kth); const unsigned long long mt = __ballot(tie); const unsigned mt32 = hh ? (unsigned)(mt >> 32) : (unsigned)mt;
                    take = (k > Kth) || (tie && (tie_taken + __popc(mt32 & ltm)) < need); tie_taken += __popc(mt32); }
                const unsigned long long ms = __ballot(take); const unsigned ms32 = hh ? (unsigned)(ms >> 32) : (unsigned)ms;
                if (take) sx[base + __popc(ms32 & ltm)] = (unsigned short)s;
                base += __popc(ms32); } } }
    }
#undef SK_COUNT2
#undef SK_COUNT_GE
#undef SK_CNT4
#undef SK_RED
#undef SK_REDU
#undef SK_UMIN
#undef SK_UMAX
#undef KEY2F
    LDS_WAIT(); asm volatile("" ::: "memory");
#pragma unroll
    for (int qi = 0; qi < 4; ++qi) { const int tq = t0 + qi; const int nsel = (tq + 1 < 256) ? tq + 1 : 256;
#pragma unroll
        for (int j = 0; j < 4; ++j) { const int pos = lane + 64 * j; if (pos < nsel) sbk[qi * 256 + pos] = bkt[tq - (int)sidx[qi * 256 + pos]]; } }
    LDS_WAIT(); asm volatile("" ::: "memory");
    if (bmode & 8) mixB_attend4(a, m0, sidx, sbk, lds, img, wscr + 3072, lane, (bmode >> 6) & 7);
    if ((bmode & 32) && __any(sel_bad)) { bf16* YS = (bf16*)((unsigned char*)a.out + DO_YS); for (int qi = 0; qi < 4; ++qi) ((unsigned short*)YS)[(size_t)(m0 + qi) * 1024 + 256 + lane] = 0x7fc0; }
}
constexpr int DM_OFF = 111616;
__device__ __forceinline__ bf16x8 frag2(const LAS unsigned char* p0, const LAS unsigned char* p1) {
    const s16x4 lo = *(const LAS s16x4*)p0, hi = *(const LAS s16x4*)p1; return (bf16x8){lo[0], lo[1], lo[2], lo[3], hi[0], hi[1], hi[2], hi[3]}; }
__device__ __forceinline__ bf16x8 fragtr(const LAS unsigned char* p0, const LAS unsigned char* p1) {
    const s16x4 lo = vtr(p0), hi = vtr(p1); return (bf16x8){lo[0], lo[1], lo[2], lo[3], hi[0], hi[1], hi[2], hi[3]}; }
__device__ __forceinline__ bf16x8 packf(f32x4 lo, f32x4 hi) { u32x4 w; w.x = cvtpk_s(lo[0], lo[1]); w.y = cvtpk_s(lo[2], lo[3]); w.z = cvtpk_s(hi[0], hi[1]); w.w = cvtpk_s(hi[2], hi[3]); return __builtin_bit_cast(bf16x8, w); }
__device__ __forceinline__ void dchunk_wave(const Args& a, int l, int bh, LAS unsigned char* dm, int lane_in) {
    int lane = lane_in; asm volatile("" : "+v"(lane));
    const int b = bh >> 2, h = bh & 3, hc = lane & 15, g = lane >> 4;
    LAS unsigned char* sAT = dm; LAS unsigned char* sBT = dm + 2304; LAS unsigned char* sKT = dm + 4608; LAS unsigned char* sRT = dm + 6912; LAS unsigned char* sVT = dm + 9216; LAS unsigned char* sUT = dm + 11520;
    LAS float* sW1 = (LAS float*)(dm + 13824); LAS float* sMB = (LAS float*)(dm + 17920); LAS float* sCL = (LAS float*)(dm + 18944); LAS float* sBON = (LAS float*)(dm + 19200);
    const bf16* DR = (const bf16*)((unsigned char*)a.out + DO_DR); const bf16* DKP = (const bf16*)((unsigned char*)a.out + DO_DKP); const bf16* DV = (const bf16*)((unsigned char*)a.out + DO_DV); const bf16* DKK = (const bf16*)((unsigned char*)a.out + DO_DKK);
    const float* DCL = (const float*)(a.ws + WS_BIG + BIG_DW); const bf16* DAI = (const bf16*)(a.ws + WS_BIG + BIG_DAI); const bf16* DG = (const bf16*)(a.ws + WS_BIG + BIG_DG);
    const float* BON = (const float*)(a.ws + WS_BON); bf16* YS = (bf16*)((unsigned char*)a.out + DO_YS);
    float gnw[4], gnb[4];
#pragma unroll
    for (int vt = 0; vt < 4; ++vt) { gnw[vt] = a.in[17][l * 256 + h * 64 + 16 * vt + hc]; gnb[vt] = a.in[18][l * 256 + h * 64 + 16 * vt + hc]; }
    const size_t tok0 = (size_t)b * SEQ;
    f32x4v T[4][4];
#pragma unroll
    for (int kt = 0; kt < 4; ++kt)
#pragma unroll
        for (int vt = 0; vt < 4; ++vt) T[kt][vt] = (f32x4v){0.f, 0.f, 0.f, 0.f};
    const int lrow = lane >> 3, lseg = lane & 7;
    u32x4 nA0, nA1, nB0, nB1, nK0, nK1, nR0, nR1, nV0, nV1; float nCL, nBON;
#define DC_LOAD(CH) do { const size_t e0_ = (tok0 + (size_t)(CH) * 16 + lrow) * 256 + h * 64 + 8 * lseg, e1_ = e0_ + 8 * 256; \
        nA0 = *(const u32x4*)(DKK + e0_); nA1 = *(const u32x4*)(DKK + e1_); nB0 = *(const u32x4*)(DAI + e0_); nB1 = *(const u32x4*)(DAI + e1_); nK0 = *(const u32x4*)(DKP + e0_); nK1 = *(const u32x4*)(DKP + e1_); \
        nR0 = *(const u32x4*)(DR + e0_); nR1 = *(const u32x4*)(DR + e1_); nV0 = *(const u32x4*)(DV + e0_); nV1 = *(const u32x4*)(DV + e1_); \
        nCL = DCL[((size_t)b * (SEQ / 16) + (CH)) * 256 + h * 64 + lane]; nBON = BON[(tok0 + (size_t)(CH) * 16 + (lane & 15)) * 4 + h]; } while (0)
    DC_LOAD(0);
    const int st0 = lrow * 144 + lseg * 16, st1 = st0 + 8 * 144;
    const int rdf = hc * 144 + 8 * g;
    const int rdt = (4 * g + (hc >> 2)) * 144 + 8 * (hc & 3);
    __builtin_amdgcn_s_setprio(2);
#pragma unroll 1
    for (int ch = 0; ch < SEQ / 16; ++ch) {
        *(LAS u32x4*)(sAT + st0) = nA0; *(LAS u32x4*)(sAT + st1) = nA1; *(LAS u32x4*)(sBT + st0) = nB0; *(LAS u32x4*)(sBT + st1) = nB1; *(LAS u32x4*)(sKT + st0) = nK0; *(LAS u32x4*)(sKT + st1) = nK1;
        *(LAS u32x4*)(sRT + st0) = nR0; *(LAS u32x4*)(sRT + st1) = nR1; *(LAS u32x4*)(sVT + st0) = nV0; *(LAS u32x4*)(sVT + st1) = nV1; sCL[lane] = nCL; if (lane < 16) sBON[lane] = nBON;
        unsigned short gq[4][4];
#pragma unroll
        for (int vt = 0; vt < 4; ++vt)
#pragma unroll
            for (int i = 0; i < 4; ++i) gq[vt][i] = DG[(tok0 + (size_t)ch * 16 + 4 * g + i) * 256 + h * 64 + 16 * vt + hc];
        asm volatile("s_waitcnt lgkmcnt(0)" ::: "memory");
        bf16x8 fA[2], fR[2], fB[2], fK[2];
#pragma unroll
        for (int ks = 0; ks < 2; ++ks) { fA[ks] = frag2(sAT + rdf + 64 * ks, sAT + rdf + 64 * ks + 32); fR[ks] = frag2(sRT + rdf + 64 * ks, sRT + rdf + 64 * ks + 32);
            fB[ks] = frag2(sBT + rdf + 64 * ks, sBT + rdf + 64 * ks + 32); fK[ks] = frag2(sKT + rdf + 64 * ks, sKT + rdf + 64 * ks + 32); }
        f32x4v U0[4], Y0[4];
#pragma unroll
        for (int vt = 0; vt < 4; ++vt) { const bf16x8 s0 = packf(T[0][vt], T[1][vt]), s1 = packf(T[2][vt], T[3][vt]);
            f32x4v u = (f32x4v){0.f, 0.f, 0.f, 0.f}, y = (f32x4v){0.f, 0.f, 0.f, 0.f};
            u = __builtin_amdgcn_mfma_f32_16x16x32_bf16(fA[0], s0, u, 0, 0, 0); u = __builtin_amdgcn_mfma_f32_16x16x32_bf16(fA[1], s1, u, 0, 0, 0);
            y = __builtin_amdgcn_mfma_f32_16x16x32_bf16(fR[0], s0, y, 0, 0, 0); y = __builtin_amdgcn_mfma_f32_16x16x32_bf16(fR[1], s1, y, 0, 0, 0);
            U0[vt] = u; Y0[vt] = y; }
        f32x4v Mka = (f32x4v){0.f, 0.f, 0.f, 0.f}, Mba = Mka, Mkr = Mka, Mbr = Mka;
#pragma unroll
        for (int ks = 0; ks < 2; ++ks) { Mka = __builtin_amdgcn_mfma_f32_16x16x32_bf16(fK[ks], fA[ks], Mka, 0, 0, 0); Mba = __builtin_amdgcn_mfma_f32_16x16x32_bf16(fB[ks], fA[ks], Mba, 0, 0, 0);
            Mkr = __builtin_amdgcn_mfma_f32_16x16x32_bf16(fK[ks], fR[ks], Mkr, 0, 0, 0); Mbr = __builtin_amdgcn_mfma_f32_16x16x32_bf16(fB[ks], fR[ks], Mbr, 0, 0, 0); }
#pragma unroll
        for (int i = 0; i < 4; ++i) { const int srow = 4 * g + i; if (!(srow < hc)) { Mka[i] = 0.f; Mba[i] = 0.f; } if (!(srow <= hc)) { Mkr[i] = 0.f; Mbr[i] = 0.f; } }
        if (ch + 1 < SEQ / 16) DC_LOAD(ch + 1);
        const f32x4v z4 = (f32x4v){0.f, 0.f, 0.f, 0.f};
        { const bf16x8 aM = packf(Mka, z4);
#pragma unroll
          for (int vt = 0; vt < 4; ++vt) { const s16x4 lo = vtr(sVT + rdt + 32 * vt); const bf16x8 bV = (bf16x8){lo[0], lo[1], lo[2], lo[3], 0, 0, 0, 0};
              U0[vt] = __builtin_amdgcn_mfma_f32_16x16x32_bf16(aM, bV, U0[vt], 0, 0, 0); } }
#pragma unroll
        for (int vt = 0; vt < 4; ++vt)
#pragma unroll
            for (int i = 0; i < 4; ++i) sW1[(4 * g + i) * 64 + 16 * vt + hc] = U0[vt][i];
        *(LAS f32x4v*)(sMB + hc * 16 + 4 * g) = Mba;
        asm volatile("s_waitcnt lgkmcnt(0)" ::: "memory");
        { float u[16];
#pragma unroll
          for (int t = 0; t < 16; ++t) { float acc = sW1[t * 64 + lane];
#pragma unroll
              for (int sq = 0; sq < 4; ++sq) { if (4 * sq < t) { const f32x4v mb = *(const LAS f32x4v*)(sMB + t * 16 + 4 * sq);
#pragma unroll
                  for (int e = 0; e < 4; ++e) if (4 * sq + e < t) acc += mb[e] * u[4 * sq + e]; } }
              u[t] = acc; ((LAS bf16*)sUT)[t * 72 + lane] = (bf16)f2bf(acc); } }
        asm volatile("s_waitcnt lgkmcnt(0)" ::: "memory");
        f32x4v bonv = *(const LAS f32x4v*)(sBON + 4 * g);
        { const bf16x8 aM = packf(Mbr, Mkr);
#pragma unroll
          for (int vt = 0; vt < 4; ++vt) { const bf16x8 bUV = fragtr(sUT + rdt + 32 * vt, sVT + rdt + 32 * vt); Y0[vt] = __builtin_amdgcn_mfma_f32_16x16x32_bf16(aM, bUV, Y0[vt], 0, 0, 0); } }
        { bf16x8 bUV[4];
#pragma unroll
          for (int vt = 0; vt < 4; ++vt) bUV[vt] = fragtr(sUT + rdt + 32 * vt, sVT + rdt + 32 * vt);
#pragma unroll
          for (int kt = 0; kt < 4; ++kt) { const bf16x8 aBK = fragtr(sBT + rdt + 32 * kt, sKT + rdt + 32 * kt); const f32x4v cl = *(const LAS f32x4v*)(sCL + 16 * kt + 4 * g);
#pragma unroll
              for (int vt = 0; vt < 4; ++vt) T[kt][vt] = __builtin_amdgcn_mfma_f32_16x16x32_bf16(aBK, bUV[vt], T[kt][vt], 0, 0, 0) * cl; } }
#pragma unroll
        for (int i = 0; i < 4; ++i) { float sm = (Y0[0][i] + Y0[1][i]) + (Y0[2][i] + Y0[3][i]);
            sm += dppf<0x128>(sm); sm += dppf<0x124>(sm); sm += dppf<0x122>(sm); sm += dppf<0x121>(sm);
            const float mean = sm * (1.f / 64.f); float sq = 0.f;
#pragma unroll
            for (int vt = 0; vt < 4; ++vt) { const float d = Y0[vt][i] - mean; sq += d * d; }
            sq += dppf<0x128>(sq); sq += dppf<0x124>(sq); sq += dppf<0x122>(sq); sq += dppf<0x121>(sq);
            const float rstd = rsqrtf(sq * (1.f / 64.f) + 64e-5f); const int t = 4 * g + i;
#pragma unroll
            for (int vt = 0; vt < 4; ++vt) { const float vv = bf2f(((const LAS bf16*)sVT)[t * 72 + 16 * vt + hc]);
                const float o = ((Y0[vt][i] - mean) * rstd * gnw[vt] + gnb[vt] + bonv[i] * vv) * bf2f(gq[vt][i]);
                YS[(tok0 + (size_t)ch * 16 + t) * 1024 + 768 + h * 64 + 16 * vt + hc] = (bf16)f2bf(o); } }
        asm volatile("s_waitcnt lgkmcnt(0)" ::: "memory");
    }
    __builtin_amdgcn_s_setprio(0);
#undef DC_LOAD
}
__device__ __forceinline__ void cchunk_wave(const Args& a, int l, int bh, LAS unsigned char* dm, int lane_in) {
    int lane = lane_in; asm volatile("" : "+v"(lane));
    const int b = bh >> 2, h = bh & 3, hc = lane & 15, g = lane >> 4;
    LAS unsigned char* sQT = dm; LAS unsigned char* sKT = dm + 1280; LAS unsigned char* sVT = dm + 2560; LAS float* sCL = (LAS float*)(dm + 4864);
    const bf16* P = (const bf16*)(a.ws + WS_BIG); const bf16* CQH = (const bf16*)(a.ws + WS_CA); const bf16* CKT = (const bf16*)(a.ws + WS_CA + 16 * MiB); const float* CCL = (const float*)(a.ws + WS_END);
    bf16* YS = (bf16*)((unsigned char*)a.out + DO_YS);
    float ng[4];
#pragma unroll
    for (int vt = 0; vt < 4; ++vt) ng[vt] = a.in[7][l * 256 + h * 64 + 16 * vt + hc];
    const size_t tok0 = (size_t)b * SEQ;
    f32x4v T[2][4];
#pragma unroll
    for (int kt = 0; kt < 2; ++kt)
#pragma unroll
        for (int vt = 0; vt < 4; ++vt) T[kt][vt] = (f32x4v){0.f, 0.f, 0.f, 0.f};
    const int qrow = lane >> 2, qseg = lane & 3, lrow = lane >> 3, lseg = lane & 7;
    u32x4 nQ, nK, nV0, nV1; float nCL;
#define CC_LOAD(CH) do { const size_t tq_ = tok0 + (size_t)(CH) * 16 + qrow; nQ = *(const u32x4*)(CQH + tq_ * 128 + h * 32 + 8 * qseg); nK = *(const u32x4*)(CKT + tq_ * 128 + h * 32 + 8 * qseg); \
        const size_t tv_ = tok0 + (size_t)(CH) * 16 + lrow; nV0 = *(const u32x4*)(P + tv_ * PW + PC_CV + h * 64 + 8 * lseg); nV1 = *(const u32x4*)(P + (tv_ + 8) * PW + PC_CV + h * 64 + 8 * lseg); \
        nCL = CCL[((size_t)b * (SEQ / 16) + (CH)) * 128 + h * 32 + (lane & 31)]; } while (0)
    CC_LOAD(0);
    const int rdf = hc * 80 + 8 * g;
    const int rdtk = (4 * g + (hc >> 2)) * 80 + 8 * (hc & 3);
    const int rdtv = (4 * g + (hc >> 2)) * 144 + 8 * (hc & 3);
    __builtin_amdgcn_s_setprio(2);
#pragma unroll 1
    for (int ch = 0; ch < SEQ / 16; ++ch) {
        *(LAS u32x4*)(sQT + qrow * 80 + qseg * 16) = nQ; *(LAS u32x4*)(sKT + qrow * 80 + qseg * 16) = nK;
        *(LAS u32x4*)(sVT + lrow * 144 + lseg * 16) = nV0; *(LAS u32x4*)(sVT + (lrow + 8) * 144 + lseg * 16) = nV1; if (lane < 32) sCL[lane] = nCL;
        unsigned short gq[4][4];
#pragma unroll
        for (int vt = 0; vt < 4; ++vt)
#pragma unroll
            for (int i = 0; i < 4; ++i) gq[vt][i] = P[(tok0 + (size_t)ch * 16 + 4 * g + i) * PW + PC_CG + h * 64 + 16 * vt + hc];
        asm volatile("s_waitcnt lgkmcnt(0)" ::: "memory");
        const bf16x8 fQ = frag2(sQT + rdf, sQT + rdf + 32), fK = frag2(sKT + rdf, sKT + rdf + 32);
        f32x4v Y0[4];
#pragma unroll
        for (int vt = 0; vt < 4; ++vt) { const bf16x8 s0 = packf(T[0][vt], T[1][vt]); Y0[vt] = __builtin_amdgcn_mfma_f32_16x16x32_bf16(fQ, s0, (f32x4v){0.f, 0.f, 0.f, 0.f}, 0, 0, 0); }
        f32x4v Mkq = __builtin_amdgcn_mfma_f32_16x16x32_bf16(fK, fQ, (f32x4v){0.f, 0.f, 0.f, 0.f}, 0, 0, 0);
#pragma unroll
        for (int i = 0; i < 4; ++i) if (!(4 * g + i <= hc)) Mkq[i] = 0.f;
        if (ch + 1 < SEQ / 16) CC_LOAD(ch + 1);
        const f32x4v z4 = (f32x4v){0.f, 0.f, 0.f, 0.f};
        bf16x8 bV[4];
#pragma unroll
        for (int vt = 0; vt < 4; ++vt) { const s16x4 lo = vtr(sVT + rdtv + 32 * vt); bV[vt] = (bf16x8){lo[0], lo[1], lo[2], lo[3], 0, 0, 0, 0}; }
        { const bf16x8 aM = packf(Mkq, z4);
#pragma unroll
          for (int vt = 0; vt < 4; ++vt) Y0[vt] = __builtin_amdgcn_mfma_f32_16x16x32_bf16(aM, bV[vt], Y0[vt], 0, 0, 0); }
#pragma unroll
        for (int kt = 0; kt < 2; ++kt) { const s16x4 lo = vtr(sKT + rdtk + 32 * kt); const bf16x8 aK = (bf16x8){lo[0], lo[1], lo[2], lo[3], 0, 0, 0, 0}; const f32x4v cl = *(const LAS f32x4v*)(sCL + 16 * kt + 4 * g);
#pragma unroll
            for (int vt = 0; vt < 4; ++vt) T[kt][vt] = __builtin_amdgcn_mfma_f32_16x16x32_bf16(aK, bV[vt], T[kt][vt], 0, 0, 0) * cl; }
#pragma unroll
        for (int i = 0; i < 4; ++i) { float sq = 0.f;
#pragma unroll
            for (int vt = 0; vt < 4; ++vt) { const float o = Y0[vt][i] * 0.17677669529663687f; Y0[vt][i] = o; sq += o * o; }
            sq += dppf<0x128>(sq); sq += dppf<0x124>(sq); sq += dppf<0x122>(sq); sq += dppf<0x121>(sq);
            const float rn = rsqrtf(sq * (1.f / 64.f) + 1e-6f); const int t = 4 * g + i;
#pragma unroll
            for (int vt = 0; vt < 4; ++vt) { const float gg = bf2f(gq[vt][i]);
                YS[(tok0 + (size_t)ch * 16 + t) * 1024 + 512 + h * 64 + 16 * vt + hc] = (bf16)f2bf(gg * sigmoidf_(gg) * (Y0[vt][i] * rn * ng[vt])); } }
        asm volatile("s_waitcnt lgkmcnt(0)" ::: "memory");
    }
    __builtin_amdgcn_s_setprio(0);
#undef CC_LOAD
}
__device__ __forceinline__ int lane_now() { unsigned on_ = ~0u; asm volatile("" : "+s"(on_)); return (int)__builtin_amdgcn_mbcnt_hi(on_, __builtin_amdgcn_mbcnt_lo(on_, 0u)); }
#define LANE_ARG lane_now()
__device__ __forceinline__ void mixers_phase(const Args& a, int l, LAS unsigned char* lds, int bid, int G, int tid, int wave, int lane, int qsel = 0, int mixmask = 15, const int bmode = 15) {
    LAS unsigned char* wscr = lds + wave * 12800;
    mixA_tables(a, lds, tid); __syncthreads();
    if (wave == 0) for (int it = bid; it < 256; it += G) { if (it < 128) { if (mixmask & 1) dchunk_wave(a, l, it, lds + DM_OFF, LANE_ARG); } else { if (mixmask & 2) cchunk_wave(a, l, it - 128, lds + DM_OFF, LANE_ARG); } }
    unsigned* qbase = (unsigned*)(a.ws + WS_CTL) + CW_Q + 1024 * l + 512 * qsel;
    const int myx = (int)(xb_xcc_id() & 7u);
    int soff = 0;
    for (;;) {
        if (soff >= 8) break;
        const int xq = (myx + soff) & 7;
        unsigned cq = 0; if (LANE_ARG == 0) cq = __hip_atomic_fetch_add(qbase + 64 * xq, 1u, __ATOMIC_RELAXED, __HIP_MEMORY_SCOPE_AGENT);
        cq = (unsigned)__builtin_amdgcn_readfirstlane((int)cq);
        if (cq >= 2048u) { ++soff; continue; }
        int b, tb = -1, at = 0;
        if (cq < 1920u) { const int bl = (int)cq / 480, j = (int)cq - bl * 480; b = 4 * xq + bl; if (j < 224) tb = 255 - j; else at = j - 224; }
        else { const int k = (int)cq - 1920; b = 4 * xq + (k >> 5); tb = 31 - (k & 31); }
        if (tb >= 0) { if (!(mixmask & 8)) continue; const int m0 = b * SEQ + tb * 8;
#pragma unroll 1
            for (int k = 0; k < 2; ++k) {
#ifndef MIX_NO_B
                mixB_group(a, l, m0 + 4 * k, lds, wscr, LANE_ARG, bmode);
#endif
            } }
        else { if (!(mixmask & 4)) continue;
#ifndef MIX_NO_A
            mixA_task(a, b, (at >> 4) & 3, at & 15, 3 - (at >> 6), lds, wave, LANE_ARG);
#endif
        }
    }
}

constexpr int RREC_OFF = MISC_OFF + 4096, LCNT_OFF = MISC_OFF + 10240, LBASE_OFF = MISC_OFF + 10368;
__device__ __forceinline__ void ln1_route_phase(const Args& a, int l, LAS unsigned char* lds, int bid, int G, int tid, int wave, int lane) {
    bf16* XB = (bf16*)(a.ws + WS_XB); const float* WRT = (const float*)(a.ws + WS_RT) + (size_t)l * 36 * 1024;
    unsigned* tokinfo = (unsigned*)(a.ws + WS_TOK); unsigned* cntg = (unsigned*)(a.ws + WS_CTL) + CW_CNT + (l * 32) * 64;
    const float* lng = a.in[21] + (l * 2 + 0) * 1024; const float* lnb = a.in[22] + (l * 2 + 0) * 1024;
    const float* brg = a.in[24] + l * 4; const float* bre = a.in[26] + l * 32;
    LAS float* sW = (LAS float*)lds;
    LAS unsigned* rrec = (LAS unsigned*)(lds + RREC_OFF); LAS int* lcnt = (LAS int*)(lds + LCNT_OFF); LAS unsigned* lbase = (LAS unsigned*)(lds + LBASE_OFF);
    for (int i = tid; i < 32 * 1024 / 4; i += NTHR) *(LAS f32x4*)(sW + 4 * i) = *(const f32x4*)(WRT + 4 * 1024 + 4 * i);
    f32x4 gam[4], bet[4], wg[4][4];
#pragma unroll
    for (int j = 0; j < 4; ++j) { gam[j] = *(const f32x4*)(lng + 4 * lane + 256 * j); bet[j] = *(const f32x4*)(lnb + 4 * lane + 256 * j);
#pragma unroll
        for (int e = 0; e < 4; ++e) wg[e][j] = *(const f32x4*)(WRT + e * 1024 + 4 * lane + 256 * j); }
    for (int blk = bid; blk < NTOK / 256; blk += G) {
        if (tid < 32) lcnt[tid] = 0;
        __syncthreads();
#pragma unroll 1
        for (int rg = 0; rg < 8; ++rg) {
            const int rl0 = wave * 32 + rg * 4; f32x4 x[4][4];
#pragma unroll
            for (int r = 0; r < 4; ++r) { bf16* xr = XB + (size_t)(blk * 256 + rl0 + r) * 1024; float s = 0.f;
#pragma unroll
                for (int j = 0; j < 4; ++j) { const u32x2 w = *(const u32x2*)(xr + 4 * lane + 256 * j); x[r][j] = (f32x4){bflo(w.x), bfhi(w.x), bflo(w.y), bfhi(w.y)}; s += (x[r][j][0] + x[r][j][1]) + (x[r][j][2] + x[r][j][3]); }
                const float mean = wave_sum(s) * (1.f / 1024.f); float q = 0.f;
#pragma unroll
                for (int j = 0; j < 4; ++j) { x[r][j] = x[r][j] - mean; q += (x[r][j][0] * x[r][j][0] + x[r][j][1] * x[r][j][1]) + (x[r][j][2] * x[r][j][2] + x[r][j][3] * x[r][j][3]); }
                const float rstd = rsqrtf(wave_sum(q) * (1.f / 1024.f) + LN_EPS);
#pragma unroll
                for (int j = 0; j < 4; ++j) { x[r][j] = x[r][j] * rstd * gam[j] + bet[j]; u32x2 w; w.x = pk2(x[r][j][0], x[r][j][1]); w.y = pk2(x[r][j][2], x[r][j][3]); *(u32x2*)(xr + 4 * lane + 256 * j) = w; }
                }
            float gl[4][4];
#pragma unroll
            for (int e = 0; e < 4; ++e)
#pragma unroll
                for (int r = 0; r < 4; ++r) { float d = 0.f;
#pragma unroll
                    for (int j = 0; j < 4; ++j) d += (x[r][j][0] * wg[e][j][0] + x[r][j][1] * wg[e][j][1]) + (x[r][j][2] * wg[e][j][2] + x[r][j][3] * wg[e][j][3]);
                    gl[r][e] = wave_sum(d) + brg[e]; }
#pragma unroll
            for (int r = 0; r < 4; ++r) {
                const float g0 = gl[r][0], g1 = gl[r][1], g2 = gl[r][2], g3 = gl[r][3];
                int gsv = 0; float gm = g0; if (g1 > gm) { gm = g1; gsv = 1; } if (g2 > gm) { gm = g2; gsv = 2; } if (g3 > gm) { gm = g3; gsv = 3; }
                const int gs = __builtin_amdgcn_readfirstlane(gsv);
                const float ptop = 1.f / (__expf(g0 - gm) + __expf(g1 - gm) + __expf(g2 - gm) + __expf(g3 - gm));
                float v0 = -INFINITY, v1 = -INFINITY; int i0 = 0, i1 = 0;
#pragma unroll 2
                for (int jj = 0; jj < 8; ++jj) { const int e = gs * 8 + jj; float d = 0.f;
#pragma unroll
                    for (int j = 0; j < 4; ++j) { const f32x4 w4 = *(const LAS f32x4*)(sW + e * 1024 + 4 * lane + 256 * j); d += (x[r][j][0] * w4[0] + x[r][j][1] * w4[1]) + (x[r][j][2] * w4[2] + x[r][j][3] * w4[3]); }
                    const float le = wave_sum(d) + bre[e];
                    if (le > v0) { v1 = v0; i1 = i0; v0 = le; i0 = jj; } else if (le > v1) { v1 = le; i1 = jj; } }
                const float ex = __expf(v1 - v0), w0 = ptop / (1.f + ex), w1 = ptop * ex / (1.f + ex);
                if (lane == 0) { const int e0 = gs * 8 + i0, e1 = gs * 8 + i1; const int rl = rl0 + r;
                    const int p0 = atomicAdd((int*)&lcnt[e0], 1), p1 = atomicAdd((int*)&lcnt[e1], 1);
                    rrec[rl * 6 + 0] = (unsigned)e0; rrec[rl * 6 + 1] = (unsigned)p0; rrec[rl * 6 + 2] = __float_as_uint(w0); rrec[rl * 6 + 3] = (unsigned)e1; rrec[rl * 6 + 4] = (unsigned)p1; rrec[rl * 6 + 5] = __float_as_uint(w1); } }
        }
        __syncthreads();
        if (tid < 32) lbase[tid] = __hip_atomic_fetch_add(cntg + tid * 64, (unsigned)lcnt[tid], __ATOMIC_RELAXED, __HIP_MEMORY_SCOPE_AGENT);
        __syncthreads();
        if (tid < 256) { const unsigned e0 = rrec[tid * 6 + 0], e1 = rrec[tid * 6 + 3]; unsigned* ti = tokinfo + (size_t)(blk * 256 + tid) * 8;
            u32x4 o0, o1; o0.x = e0; o0.y = lbase[e0] + rrec[tid * 6 + 1]; o0.z = rrec[tid * 6 + 2]; o0.w = e1; o1.x = lbase[e1] + rrec[tid * 6 + 4]; o1.y = rrec[tid * 6 + 5]; o1.z = 0u; o1.w = 0u;
            *(u32x4*)ti = o0; *(u32x4*)(ti + 4) = o1; }
        __syncthreads();
    }
}
__device__ __forceinline__ void moe_table(const Args& a, int l, LAS unsigned char* lds, int tid) {
    LAS int* tstart = (LAS int*)(lds + TST_OFF);
    if (tid < 64) { const unsigned* cntg = (const unsigned*)(a.ws + WS_CTL) + CW_CNT + (l * 32) * 64;
        int v = (tid < 32) ? (int)((__hip_atomic_load(cntg + tid * 64, __ATOMIC_RELAXED, __HIP_MEMORY_SCOPE_AGENT) + 255u) >> 8) : 0; const int mine = v;
#pragma unroll
        for (int o = 1; o < 32; o <<= 1) { const int u = __shfl_up(v, o); if ((tid & 63) >= o) v += u; }
        if (tid < 32) tstart[tid] = v - mine; if (tid == 31) tstart[32] = v; }
    __syncthreads();
}
__device__ __forceinline__ void scatter_phase(const Args& a, int l, LAS unsigned char* lds, int bid, int G, int tid, int gw, int NGW, int lane) {
    const LAS int* tstart = (const LAS int*)(lds + TST_OFF);
    const bf16* XB = (const bf16*)(a.ws + WS_XB); bf16* XS = (bf16*)(a.ws + WS_BIG); unsigned* rowinfo = (unsigned*)(a.ws + WS_ROW); const unsigned* tokinfo = (const unsigned*)(a.ws + WS_TOK);
    const unsigned* cntg = (const unsigned*)(a.ws + WS_CTL) + CW_CNT + (l * 32) * 64;
    for (int e = bid; e < 32; e += G) { const int c = (int)__hip_atomic_load(cntg + e * 64, __ATOMIC_RELAXED, __HIP_MEMORY_SCOPE_AGENT); const int r0 = tstart[e] * 256, r1 = tstart[e + 1] * 256;
        unsigned neg_ = 0xffffffffu, zer_ = 0u; asm volatile("" : "+v"(neg_), "+v"(zer_));
        for (int r = r0 + c + tid; r < r1; r += NTHR) { rowinfo[2 * (size_t)r] = neg_; rowinfo[2 * (size_t)r + 1] = zer_; } }
    u32x4 nt0; u32x2 nt1;
#define SC_LOAD(mm) do { nt0 = *(const u32x4*)(tokinfo + (size_t)(mm) * 8); nt1 = *(const u32x2*)(tokinfo + (size_t)(mm) * 8 + 4); } while (0)
    const int gt = gw * 64 + lane, NT = NGW * 64;
    for (int m = gt; m < NTOK; m += NT) {
        SC_LOAD(m); const u32x4 t0 = nt0; const u32x2 t1 = nt1;
        const size_t r0 = (size_t)tstart[t0.x] * 256 + t0.y, r1 = (size_t)tstart[t0.w] * 256 + t1.x;
        *(u32x2*)(rowinfo + 2 * r0) = (u32x2){(unsigned)(m * 2), t0.z}; *(u32x2*)(rowinfo + 2 * r1) = (u32x2){(unsigned)(m * 2 + 1), t1.y};
    }
#undef SC_LOAD
}
__device__ __forceinline__ void ln2_phase(const Args& a, int l, int gw, int NGW, int lane) {
    bf16* XB = (bf16*)(a.ws + WS_XB); const bf16* Y = (const bf16*)(a.ws + WS_BIG);
    const float* lng = a.in[21] + (l * 2 + 1) * 1024; const float* lnb = a.in[22] + (l * 2 + 1) * 1024;
    f32x4 gam[4], bet[4];
#pragma unroll
    for (int j = 0; j < 4; ++j) { gam[j] = *(const f32x4*)(lng + 4 * lane + 256 * j); bet[j] = *(const f32x4*)(lnb + 4 * lane + 256 * j); }
    for (int m0 = gw; m0 < NTOK; m0 += 4 * NGW) {
        u32x2 cw[4][4], cp2[4][4], cq2[4][4];
#pragma unroll
        for (int r = 0; r < 4; ++r) { const int m = m0 + r * NGW; if (m < NTOK) { const bf16* xr_ = XB + (size_t)m * 1024 + 4 * lane; const bf16* y0_ = Y + (size_t)m * 1024 + 4 * lane; const bf16* y1_ = Y + ((size_t)NTOK + m) * 1024 + 4 * lane;
#pragma unroll
            for (int j = 0; j < 4; ++j) { cw[r][j] = *(const u32x2*)(xr_ + 256 * j); cp2[r][j] = *(const u32x2*)(y0_ + 256 * j); cq2[r][j] = *(const u32x2*)(y1_ + 256 * j); } } }
#pragma unroll
        for (int r = 0; r < 4; ++r) { const int m = m0 + r * NGW; if (m < NTOK) {
            bf16* xr = XB + (size_t)m * 1024;
            f32x4 x[4]; float s = 0.f;
#pragma unroll
            for (int j = 0; j < 4; ++j) { const u32x2 w = cw[r][j], p = cp2[r][j], q = cq2[r][j];
                x[j] = (f32x4){DN_ALPHA * bflo(w.x) + (bflo(p.x) + bflo(q.x)), DN_ALPHA * bfhi(w.x) + (bfhi(p.x) + bfhi(q.x)), DN_ALPHA * bflo(w.y) + (bflo(p.y) + bflo(q.y)), DN_ALPHA * bfhi(w.y) + (bfhi(p.y) + bfhi(q.y))};
                s += (x[j][0] + x[j][1]) + (x[j][2] + x[j][3]); }
            const float mean = wave_sum(s) * (1.f / 1024.f); float q = 0.f;
#pragma unroll
            for (int j = 0; j < 4; ++j) { x[j] = x[j] - mean; q += (x[j][0] * x[j][0] + x[j][1] * x[j][1]) + (x[j][2] * x[j][2] + x[j][3] * x[j][3]); }
            const float rstd = rsqrtf(wave_sum(q) * (1.f / 1024.f) + LN_EPS);
#pragma unroll
            for (int j = 0; j < 4; ++j) { x[j] = x[j] * rstd * gam[j] + bet[j];
                if (l == NLAYER - 1) *(f32x4*)(a.out + (size_t)m * 1024 + 4 * lane + 256 * j) = x[j];
                else { u32x2 w; w.x = pk2(x[j][0], x[j][1]); w.y = pk2(x[j][2], x[j][3]); *(u32x2*)(xr + 4 * lane + 256 * j) = w; } } } }
    }
}

#ifndef MK_MULTI
#define MK_MULTI 0
#endif
constexpr int NPHASE = 12;
__global__ void __launch_bounds__(NTHR, 2) fwd(Args a) {
    extern __shared__ __attribute__((aligned(16))) unsigned char lds_raw[];
    LAS unsigned char* lds = (LAS unsigned char*)lds_raw;
    const int G0 = gridDim.x, bid0 = blockIdx.x, wave0 = __builtin_amdgcn_readfirstlane((int)(threadIdx.x >> 6));
#define PH_IDS unsigned on_ = ~0u; asm volatile("" : "+s"(on_)); int lz_ = (int)__builtin_amdgcn_mbcnt_hi(on_, __builtin_amdgcn_mbcnt_lo(on_, 0u)); int wz_ = wave0, bz_ = bid0, gz_ = G0; asm volatile("" : "+s"(wz_), "+s"(bz_), "+s"(gz_)); \
    const int lane = lz_, wave = wz_, tid = wz_ * 64 + lz_, bid = bz_, G = gz_, NGW = gz_ * NWAVES, gw = bid * NWAVES + wave; (void)lane; (void)gw; (void)wave; (void)tid; (void)NGW;
#define PH_ARGS(LV) const __attribute__((address_space(4))) Args* kp_ = (const __attribute__((address_space(4))) Args*)__builtin_amdgcn_kernarg_segment_ptr(); asm volatile("" : "+s"(kp_)); const Args& b = *(const Args*)kp_; int lq = (LV); asm volatile("" : "+s"(lq)); (void)lq; \
    bf16* XB = (bf16*)(b.ws + WS_XB); bf16* PB = (bf16*)(b.ws + WS_BIG); bf16* YS = (bf16*)((unsigned char*)b.out + DO_YS); bf16* MG = (bf16*)((unsigned char*)b.out + DO_MG); \
    unsigned* rowinfo = (unsigned*)(b.ws + WS_ROW); unsigned char* wl = b.ws + WS_W + (size_t)lq * WL_SIZE; (void)XB; (void)PB; (void)YS; (void)MG; (void)rowinfo; (void)wl;
    unsigned* ctl = (unsigned*)(a.ws + WS_CTL);
    { PH_IDS
    for (int u = tid; u < (LDS_BYTES - MISC_OFF) / 4; u += NTHR) ((LAS unsigned*)(lds + MISC_OFF))[u] = 0u;
    __syncthreads();
    for (int d = tid; d < 2048; d += NTHR) ((LAS unsigned char*)(lds + BKT_OFF))[d] = (unsigned char)t5_bucket(d);
    if (tid < 256) ((LAS float*)(lds + RPB_OFF))[tid] = a.in[1][tid];
    __syncthreads(); }
    XcdBarrier bar; bar.bar = ctl + CW_BAR; bar.x = 0; bar.st = nullptr;
    if (a.use_bar) bar = xcd_barrier_post(ctl + CW_BAR, (volatile LAS unsigned*)(lds + MISC_OFF) + 8);
#define GRID_BAR() do { if (a.use_bar) { const __attribute__((address_space(4))) Args* kq_ = (const __attribute__((address_space(4))) Args*)__builtin_amdgcn_kernarg_segment_ptr(); asm volatile("" : "+s"(kq_)); \
        XcdBarrier bb_ = bar; bb_.bar = (unsigned*)(kq_->ws + WS_CTL) + CW_BAR; xcd_barrier(bb_); } } while (0)
#ifndef PHMASK
#define PHMASK 0xFFF
#endif
#define IN(k) (((PHMASK >> (k)) & 1) && ((phm >> (k)) & 1u))

    unsigned phm = ((1u << a.ph_hi) - 1u) & ~((1u << a.ph_lo) - 1u);
    if (a.l_lo == 0 && IN(0)) { PH_IDS PH_ARGS(0) p0_prologue(b, lds, gw, NGW, wave, lane); GRID_BAR(); }
    for (int l = a.l_lo; l < a.l_hi; ++l) {
        asm volatile("" : "+s"(phm));
        if (IN(1)) { PH_IDS PH_ARGS(l) pg8::Gemm g{XB, (const bf16*)(wl + WL_IN), 1024, 1024, 1024}; pg8::GridOrder S; S.init(NTOK / 256, PW / 256, G, bid, 0, 0, 1);
            pg8::EpiStoreBf16 E{PB, PW}; pg8::gemm_phase(lds, g, S, E, tid); GRID_BAR(); }
        if (IN(2)) { PH_IDS PH_ARGS(l) prep_phase(b, lq, lds, tid, gw, NGW, lane); GRID_BAR(); }
        if (IN(3)) { PH_IDS PH_ARGS(l) mixers_phase(b, lq, lds, bid, G, tid, wave, lane); GRID_BAR(); }
        if (IN(4)) { PH_IDS PH_ARGS(l) pg8::Gemm g{YS, (const bf16*)(wl + WL_BR), 1024, 256, 256}; pg8::GridOrder S; S.init(NTOK / 256, 16, G, bid, 4, 512);
            pg8::EpiStoreBf16 E{PB, 4096}; pg8::gemm_phase(lds, g, S, E, tid); GRID_BAR(); }
        if (IN(5)) { PH_IDS PH_ARGS(l) pg8::Gemm g{XB, (const bf16*)(wl + WL_IN) + (size_t)3072 * 1024, 1024, 1024, 1024}; pg8::GridOrder S; S.init(NTOK / 256, 16, G, bid, 0, 0, 1);
            pg8::EpiGate E{PB, MG}; pg8::gemm_phase(lds, g, S, E, tid); GRID_BAR(); }
        if (IN(6)) { PH_IDS PH_ARGS(l) pg8::Gemm g{MG, (const bf16*)(wl + WL_OUT), 1024, 1024, 1024}; pg8::GridOrder S; S.init(NTOK / 256, 4, G, bid);
            pg8::EpiOut E{XB}; pg8::gemm_phase(lds, g, S, E, tid); GRID_BAR(); }
        if (IN(7)) { PH_IDS PH_ARGS(l) ln1_route_phase(b, lq, lds, bid, G, tid, wave, lane); GRID_BAR(); }
        if (IN(8)) { PH_IDS PH_ARGS(l) moe_table(b, lq, lds, tid); scatter_phase(b, lq, lds, bid, G, tid, gw, NGW, lane); GRID_BAR(); }
        if (IN(9)) { PH_IDS PH_ARGS(l) moe_table(b, lq, lds, tid); pg8::Gemm g{XB, (const bf16*)(wl + WL_GU), 1024, 1024, 1024}; pg8::MoeOrder S{(const LAS int*)(lds + TST_OFF), 1, G, bid, 0};
            pg8::EpiUp E{rowinfo, (bf16*)(b.ws + WS_BIG + BIG_H)}; pg8::gemm_phase<pg8::EpiUp, pg8::MoeOrder, true>(lds, g, S, E, tid, rowinfo); GRID_BAR(); }
        if (IN(10)) { PH_IDS PH_ARGS(l) moe_table(b, lq, lds, tid); pg8::Gemm g{(const bf16*)(b.ws + WS_BIG + BIG_H), (const bf16*)(wl + WL_DN), 256, 256, 256}; pg8::MoeOrder S{(const LAS int*)(lds + TST_OFF), 2, G, bid, 1};
            pg8::EpiDown E{rowinfo, PB}; pg8::gemm_phase(lds, g, S, E, tid); GRID_BAR(); }
        if (IN(11)) { PH_IDS PH_ARGS(l) ln2_phase(b, lq, gw, NGW, lane); if (l + 1 < a.l_hi) GRID_BAR(); }
    }
#undef IN
#undef GRID_BAR
}

extern "C" void kernel_launch(void* const* d_in, const int* in_sizes, int n_in, void* d_out, int out_size, void* d_ws, size_t ws_size, hipStream_t stream) {
    static int grid = 0;
    if (grid == 0) {
        if (n_in != 30 || out_size != NTOK * DM || ws_size < WS_END + 2 * MiB) { fprintf(stderr, "kernel_launch: unexpected shapes (n_in %d out %d ws %zu)\n", n_in, out_size, ws_size); grid = -1; return; }
        int dev = 0, cus = 0, per_cu = 0;
        if (hipGetDevice(&dev) != hipSuccess || hipDeviceGetAttribute(&cus, hipDeviceAttributeMultiprocessorCount, dev) != hipSuccess) { grid = -1; return; }
        if (hipFuncSetAttribute((const void*)fwd, hipFuncAttributeMaxDynamicSharedMemorySize, LDS_BYTES) != hipSuccess) { fprintf(stderr, "kernel_launch: hipFuncSetAttribute failed\n"); grid = -1; return; }
        if (hipOccupancyMaxActiveBlocksPerMultiprocessor(&per_cu, (const void*)fwd, NTHR, LDS_BYTES) != hipSuccess || per_cu < 1) fprintf(stderr, "kernel_launch: occupancy query says %d\n", per_cu);
        (void)hipGetLastError();
        grid = cus;
    }
    if (grid < 0) return;
    (void)hipMemsetAsync((char*)d_ws + WS_CTL, 0, CTL_ZERO_BYTES, stream);
    Args a{};
    for (int i = 0; i < 30; ++i) a.in[i] = (const float*)d_in[i];
    a.out = (float*)d_out; a.ws = (unsigned char*)d_ws; a.pad = 0;
#if MK_MULTI
    a.use_bar = 0;
    for (int l = 0; l < NLAYER; ++l)
        for (int ph = (l == 0 ? 0 : 1); ph < NPHASE; ++ph) { a.l_lo = l; a.l_hi = l + 1; a.ph_lo = ph; a.ph_hi = ph + 1;
            hipLaunchKernelGGL(fwd, dim3(grid), dim3(NTHR), LDS_BYTES, stream, a); }
#else
    a.use_bar = 1; a.l_lo = 0; a.l_hi = NLAYER; a.ph_lo = 0; a.ph_hi = NPHASE;
    hipLaunchKernelGGL(fwd, dim3(grid), dim3(NTHR), LDS_BYTES, stream, a);
#endif
    const hipError_t le = hipPeekAtLastError();
    if (le != hipSuccess) fprintf(stderr, "kernel_launch: launch failed: %s\n", hipGetErrorName(le));
}
```

```cpp
#include <hip/hip_runtime.h>
#include <cstdio>
#include <cstdint>

#define LAS __attribute__((address_space(3)))
#define GAS __attribute__((address_space(1)))
typedef unsigned short bf16;
typedef short bf16x8 __attribute__((ext_vector_type(8)));
typedef float f32x4 __attribute__((ext_vector_type(4)));
typedef float f32x2 __attribute__((ext_vector_type(2)));
typedef unsigned u32x4 __attribute__((ext_vector_type(4)));
typedef unsigned u32x2 __attribute__((ext_vector_type(2)));

namespace pg8 {
constexpr int BM = 256, BK = 64, HALF = 128, HTB = HALF * BK * 2  , STAGE_BYTES = 8 * HTB, NXCD = 8, WGM = 8;

__host__ __device__ __forceinline__ int lds_byte(int r, int c) { const int st = (r >> 4) * 2 + (c >> 5), rr = r & 15, cc = c & 31, ob = rr * 64 + cc * 2; return st * 1024 + (ob ^ (((ob >> 9) & 1) << 5)); }
__host__ __device__ __forceinline__ void stage_rc(int b, int& R, int& C) { const int st = b / 1024, sb = b % 1024, swz = sb ^ (((sb >> 9) & 1) << 5); R = (st >> 1) * 16 + swz / 64; C = (st & 1) * 32 + (swz % 64) / 2; }
__host__ __device__ __forceinline__ int perm32(int rho) { const int n = rho >> 4, i = rho & 15; return 8 * (i >> 2) + 4 * n + (i & 3); }

struct Unit { int pm, pn, pb; unsigned aoff; };
struct Gemm { const bf16* A; const bf16* Bt; int lda, ldb, K; };

struct GridOrder {
    int nM, nN, nwg, G, c, a_grp, a_grp_bytes, rev;
    __device__ void init(int nM_, int nN_, int G_, int c_, int a_grp_ = 0, int a_grp_bytes_ = 0, int rev_ = 0) { nM = nM_; nN = nN_; nwg = nM * nN; G = G_; c = c_; a_grp = a_grp_; a_grp_bytes = a_grp_bytes_; rev = rev_; }
    __device__ bool next(int i, Unit& u) const {
        const int mine = c < nwg ? (nwg - c + G - 1) / G : 0; if (i >= mine) return false;
        const long L = (long)(rev ? mine - 1 - i : i) * G + c;
        int wgid = (int)L; { const int q = nwg / NXCD, r = nwg % NXCD, xcd = wgid % NXCD, off = wgid / NXCD; wgid = (xcd < r ? xcd * (q + 1) : r * (q + 1) + (xcd - r) * q) + off; }
        const int nig = WGM * nN, gid = wgid / nig, fm = gid * WGM, gsz = (nM - fm) < WGM ? (nM - fm) : WGM;
        u.pm = fm + ((wgid % nig) % gsz); u.pn = (wgid % nig) / gsz; u.pb = u.pn; u.aoff = a_grp ? (unsigned)((u.pn / a_grp) * a_grp_bytes) : 0u; return true;
    }
};
struct MoeOrder {
    const LAS int* tstart; int nsl, G, c, rev;
    __device__ bool next(int i, Unit& u) const {
        const int total = tstart[32] << nsl, mine = c < total ? (total - c + G - 1) / G : 0; if (i >= mine) return false;
        const int L = (rev ? mine - 1 - i : i) * G + c;
        const int rt = L >> nsl, pn = L & ((1 << nsl) - 1); int e = 0;
        while (e < 31 && rt >= tstart[e + 1]) ++e;
        u.pm = rt; u.pn = pn; u.pb = (e << nsl) + pn; u.aoff = 0u; return true;
    }
};

__device__ __forceinline__ unsigned cvt_pk_bf16(float lo, float hi) { unsigned r; asm volatile("v_cvt_pk_bf16_f32 %0, %1, %2" : "=v"(r) : "v"(lo), "v"(hi)); return r; }

template <class Epi, class Sched, bool GATHER = false>
__device__ __forceinline__ void gemm_phase(LAS unsigned char* lds, const Gemm g, const Sched& S, const Epi& E, const int tid, const unsigned* rowtab = nullptr) {
    const int wid = __builtin_amdgcn_readfirstlane(tid >> 6), lane = tid & 63, wr = wid >> 2, wc = wid & 3, fr = lane & 15, fq = lane >> 4;
    const int K = g.K, nt = K / BK;
    unsigned voffA[2], voffB[2];
#pragma unroll
    for (int i = 0; i < 2; ++i) { int R, C; stage_rc(tid * 16 + i * 8192, R, C); const int Rb = Epi::PERM ? ((R & ~31) + perm32(R & 31)) : R;
        voffA[i] = (unsigned)(R * g.lda + C) * 2u; voffB[i] = (unsigned)(Rb * g.ldb + C) * 2u; }
    const size_t kstep = (size_t)(BK * 2);
    const size_t hstepA = (size_t)HALF * g.lda * 2, hstepB = (size_t)HALF * g.ldb * 2;
    const size_t tstepA = 2 * hstepA, tstepB = 2 * hstepB;
    const unsigned ldsw = (unsigned)wid * 1024u;
    const int aoff = lds_byte(wr * 64 + fr, fq * 8), boff = lds_byte(wc * 32 + fr, fq * 8);
#define PG8_SA(b, h) (((b) * 2 + (h)) * HTB)
#define PG8_SB(b, h) ((4 + (b) * 2 + (h)) * HTB)
#define PG8_STAGE(bufoff, gbase, voff) do { _Pragma("unroll") for (int _i = 0; _i < 2; ++_i) \
        __builtin_amdgcn_global_load_lds((const unsigned*)((const char*)(gbase) + (voff)[_i]), (LAS unsigned*)(lds + (bufoff) + ldsw + _i * 8192), 16, 0, 0); } while (0)
#define PG8_STAGE_A(bufoff, gbase, h) do { if constexpr (GATHER) { PG8_STAGE(bufoff, gbase, vgA[h]); } else { PG8_STAGE(bufoff, (gbase) + (h) * hstepA, voffA); } } while (0)
#define PG8_STAGE_AX(bufoff, gbase, h, useN) do { if constexpr (GATHER) { unsigned vs_[2] = {(useN) ? vgN[h][0] : vgA[h][0], (useN) ? vgN[h][1] : vgA[h][1]}; PG8_STAGE(bufoff, gbase, vs_); } else { PG8_STAGE(bufoff, (gbase) + (h) * hstepA, voffA); } } while (0)
#define PG8_LDA(dst, b, h) do { _Pragma("unroll") for (int m = 0; m < 4; ++m) _Pragma("unroll") for (int k = 0; k < 2; ++k) dst[m][k] = *(const LAS bf16x8*)(lds + PG8_SA(b, h) + aoff + m * 2048 + k * 1024); } while (0)
#define PG8_LDB(dst, b, h) do { _Pragma("unroll") for (int n = 0; n < 2; ++n) _Pragma("unroll") for (int k = 0; k < 2; ++k) dst[n][k] = *(const LAS bf16x8*)(lds + PG8_SB(b, h) + boff + n * 2048 + k * 1024); } while (0)
#define PG8_MMA(ai, bj, At, Bt) do { __builtin_amdgcn_s_setprio(1); _Pragma("unroll") for (int m = 0; m < 4; ++m) _Pragma("unroll") for (int n = 0; n < 2; ++n) _Pragma("unroll") for (int k = 0; k < 2; ++k) \
        acc[ai][bj][m][n] = __builtin_amdgcn_mfma_f32_16x16x32_bf16(Bt[n][k], At[m][k], acc[ai][bj][m][n], 0, 0, 0); __builtin_amdgcn_s_setprio(0); } while (0)
#define PG8_WAIT_V(n) asm volatile("s_waitcnt vmcnt(" #n ")" ::: "memory")
#define PG8_WAIT_L(n) asm volatile("s_waitcnt lgkmcnt(" #n ")" ::: "memory")
#define PG8_BAR __builtin_amdgcn_s_barrier()
#define PG8_SCHED __builtin_amdgcn_sched_barrier(0)
    Unit cur, nxt; int ui = 0;
    if (!S.next(0, cur)) return;
    unsigned vgA[2][2], vgN[2][2];
    int gR[2], gC[2];
#pragma unroll
    for (int i = 0; i < 2; ++i) stage_rc(tid * 16 + i * 8192, gR[i], gC[i]);
#define PG8_GOFF(DST, PM) do { if constexpr (GATHER) { _Pragma("unroll") for (int h_ = 0; h_ < 2; ++h_) _Pragma("unroll") for (int i_ = 0; i_ < 2; ++i_) { \
        const int ri_ = (int)rowtab[2 * ((size_t)(PM) * BM + h_ * HALF + gR[i_])]; const unsigned tok_ = ri_ < 0 ? 0u : (unsigned)ri_ >> 1; DST[h_][i_] = (tok_ * (unsigned)g.lda + (unsigned)gC[i_]) * 2u; } } } while (0)
    PG8_GOFF(vgA, cur.pm);
    f32x4 acc[2][2][4][2];
#pragma unroll
    for (int a = 0; a < 2; ++a)
#pragma unroll
        for (int b = 0; b < 2; ++b)
#pragma unroll
            for (int m = 0; m < 4; ++m)
#pragma unroll
                for (int n = 0; n < 2; ++n) acc[a][b][m][n] = (f32x4){0.f, 0.f, 0.f, 0.f};
    bf16x8 At[4][2], B0[2][2], B1[2][2];
    const char* cA = GATHER ? (const char*)g.A : (const char*)g.A + (size_t)cur.pm * tstepA + cur.aoff; const char* cB = (const char*)g.Bt + (size_t)cur.pb * tstepB;
    PG8_STAGE(PG8_SB(0, 0), cB, voffB); PG8_STAGE(PG8_SB(0, 1), cB + hstepB, voffB); PG8_STAGE_A(PG8_SA(0, 0), cA, 0); PG8_STAGE_A(PG8_SA(0, 1), cA, 1);
    if (wr == 1) PG8_BAR;
    PG8_WAIT_V(2); PG8_BAR;
    PG8_STAGE(PG8_SB(1, 0), cB + kstep, voffB); PG8_STAGE_A(PG8_SA(1, 0), cA + kstep, 0); PG8_STAGE(PG8_SB(1, 1), cB + hstepB + kstep, voffB);
    PG8_WAIT_V(6); PG8_BAR;
    for (;;) {
        const bool has_next = S.next(ui + 1, nxt);
        if (has_next) PG8_GOFF(vgN, nxt.pm); else { if constexpr (GATHER) { vgN[0][0] = vgA[0][0]; vgN[0][1] = vgA[0][1]; vgN[1][0] = vgA[1][0]; vgN[1][1] = vgA[1][1]; } }
        const char* nA = GATHER ? cA : (has_next ? (const char*)g.A + (size_t)nxt.pm * tstepA + nxt.aoff : cA); const char* nB = has_next ? (const char*)g.Bt + (size_t)nxt.pb * tstepB : cB;
        for (int t = 0; t < nt; t += 2) {
            const bool last = (t == nt - 2);
            const char* a1 = cA + (size_t)(t + 1) * kstep;
            const char* a2 = last ? nA : cA + (size_t)(t + 2) * kstep; const char* b2 = last ? nB : cB + (size_t)(t + 2) * kstep;
            const char* a3 = a2 + kstep; const char* b3 = b2 + kstep;
            PG8_LDB(B0, 0, 0); PG8_LDB(B1, 0, 1); PG8_SCHED; PG8_LDA(At, 0, 0); PG8_STAGE_AX(PG8_SA(1, 1), a1, 1, false);
            PG8_WAIT_V(8); PG8_WAIT_L(0); PG8_BAR; PG8_MMA(0, 0, At, B0); PG8_MMA(0, 1, At, B1); PG8_BAR; PG8_SCHED;
            PG8_LDA(At, 0, 1); PG8_STAGE(PG8_SB(0, 0), b2, voffB); PG8_STAGE(PG8_SB(0, 1), b2 + hstepB, voffB); PG8_STAGE_AX(PG8_SA(0, 0), a2, 0, last);
            PG8_WAIT_V(8); PG8_WAIT_L(0); PG8_BAR; PG8_MMA(1, 0, At, B0); PG8_MMA(1, 1, At, B1); PG8_BAR; PG8_SCHED;
            PG8_LDB(B0, 1, 0); PG8_LDB(B1, 1, 1); PG8_SCHED; PG8_LDA(At, 1, 0); PG8_STAGE_AX(PG8_SA(0, 1), a2, 1, last);
            PG8_WAIT_V(8); PG8_WAIT_L(0); PG8_BAR; PG8_MMA(0, 0, At, B0); PG8_MMA(0, 1, At, B1); PG8_BAR; PG8_SCHED;
            PG8_LDA(At, 1, 1); PG8_STAGE(PG8_SB(1, 0), b3, voffB); PG8_STAGE(PG8_SB(1, 1), b3 + hstepB, voffB); PG8_STAGE_AX(PG8_SA(1, 0), a3, 0, last);
            PG8_WAIT_V(8); PG8_WAIT_L(0); PG8_BAR; PG8_MMA(1, 0, At, B0); PG8_MMA(1, 1, At, B1); PG8_BAR; PG8_SCHED;
        }
        if (wr == 0) PG8_BAR;
        { unsigned on_ = ~0u; asm volatile("" : "+s"(on_)); const int lz_ = (int)__builtin_amdgcn_mbcnt_hi(on_, __builtin_amdgcn_mbcnt_lo(on_, 0u));
          E(acc, cur, wr, wc, lz_ & 15, lz_ >> 4); }
        if (!has_next) break;
#pragma unroll
        for (int a = 0; a < 2; ++a)
#pragma unroll
            for (int b = 0; b < 2; ++b)
#pragma unroll
                for (int m = 0; m < 4; ++m)
#pragma unroll
                    for (int n = 0; n < 2; ++n) acc[a][b][m][n] = (f32x4){0.f, 0.f, 0.f, 0.f};
        cur = nxt; cA = nA; cB = nB; ++ui;
        if constexpr (GATHER) { vgA[0][0] = vgN[0][0]; vgA[0][1] = vgN[0][1]; vgA[1][0] = vgN[1][0]; vgA[1][1] = vgN[1][1]; }
        if (wr == 1) PG8_BAR;
    }
    PG8_WAIT_V(0);
    PG8_BAR;
#undef PG8_SA
#undef PG8_STAGE_A
#undef PG8_STAGE_AX
#undef PG8_GOFF
#undef PG8_SB
#undef PG8_STAGE
#undef PG8_LDA
#undef PG8_LDB
#undef PG8_MMA
#undef PG8_WAIT_V
#undef PG8_WAIT_L
#undef PG8_BAR
#undef PG8_SCHED
}
}

constexpr int NTOK = 65536, DM = 1024, SEQ = 2048, NBATCH = 32, NLAYER = 4;
constexpr int PW = 3072;
constexpr int PC_AQ = 0, PC_AK = 256, PC_AV = 512, PC_BQ = 768, PC_CKV = 1024, PC_IQ = 1088, PC_IK = 1344, PC_IW = 1376,
              PC_CQ = 1384, PC_CK = 1512, PC_CV = 1640, PC_CA = 1896, PC_CG = 1912, PC_D = 2168;
constexpr int IN_W = 7096;
constexpr float LN_EPS = 1e-5f;
constexpr float DN_ALPHA = 1.6817928305074292f;
constexpr int NWAVES = 8, NTHR = 512;
constexpr int MOE_ROWS = 2 * NTOK + 32 * 256;

constexpr size_t MiB = 1u << 20;
constexpr size_t WS_CTL = 0, CTL_ZERO_BYTES = 128 * 1024;
constexpr size_t WS_TOK = 1 * MiB;
constexpr size_t WS_ROW = 3 * MiB;
constexpr size_t WS_BON = 5 * MiB;
constexpr size_t WS_RT = 6 * MiB;
constexpr size_t WS_CKVN = 8 * MiB;
constexpr size_t WS_CA = 16 * MiB;
constexpr size_t WS_W = 48 * MiB;
constexpr size_t WL_IN = 0, WL_BR = 14 * MiB, WL_OUT = 16 * MiB, WL_GU = 18 * MiB, WL_DN = 50 * MiB, WL_SIZE = 66 * MiB;
constexpr size_t WS_XB = 312 * MiB;
constexpr size_t WS_BIG = 440 * MiB;
constexpr size_t BIG_DW = 384 * MiB, BIG_DAI = 448 * MiB, BIG_DG = 480 * MiB;
constexpr size_t BIG_H = 272 * MiB;
constexpr size_t WS_END = 952 * MiB;
constexpr size_t DO_YS = 0, DO_MG = 128 * MiB, DO_DR = 128 * MiB, DO_DKP = 160 * MiB, DO_DV = 192 * MiB, DO_DKK = 224 * MiB;

constexpr int CW_TMO = 0, CW_CODE = 1;
constexpr int CW_BAR = 4096;
constexpr int CW_Q = 8192;
constexpr int CW_CNT = 16384;

constexpr int RING_BYTES = 131072;
constexpr int MISC_OFF = RING_BYTES;
constexpr int TST_OFF = MISC_OFF + 512;
constexpr int BKT_OFF = MISC_OFF + 1024;
constexpr int RPB_OFF = MISC_OFF + 3072;
constexpr int LDS_BYTES = 147456;

#define LDS_WAIT() asm volatile("s_waitcnt lgkmcnt(0)" ::: "memory")
#define VM_WAIT() asm volatile("s_waitcnt vmcnt(0)" ::: "memory")
__device__ __forceinline__ float bf2f(unsigned b) { return __uint_as_float(b << 16); }
__device__ __forceinline__ unsigned f2bf(float f) { unsigned u = __float_as_uint(f); return (u + 0x7fffu + ((u >> 16) & 1u)) >> 16; }
__device__ __forceinline__ unsigned pk2(float lo, float hi) { return f2bf(lo) | (f2bf(hi) << 16); }
__device__ __forceinline__ float bflo(unsigned w) { return __uint_as_float(w << 16); }
__device__ __forceinline__ float bfhi(unsigned w) { return __uint_as_float(w & 0xffff0000u); }
template <int CTRL> __device__ __forceinline__ float dppf(float v) {
    return __builtin_bit_cast(float, __builtin_amdgcn_update_dpp(0, __builtin_bit_cast(int, v), CTRL, 0xf, 0xf, true));
}
__device__ __forceinline__ float wave_sum(float v) {
    v += dppf<0x128>(v); v += dppf<0x124>(v); v += dppf<0x122>(v); v += dppf<0x121>(v);
    v += __builtin_bit_cast(float, __builtin_amdgcn_update_dpp(0, __builtin_bit_cast(int, v), 0x142, 0xa, 0xf, false));
    v += __builtin_bit_cast(float, __builtin_amdgcn_update_dpp(0, __builtin_bit_cast(int, v), 0x143, 0xc, 0xf, false));
    return __builtin_bit_cast(float, __builtin_amdgcn_readlane(__builtin_bit_cast(int, v), 63));
}
__device__ __forceinline__ float wave_max(float v) {
#pragma unroll
    for (int o = 1; o < 64; o <<= 1) v = fmaxf(v, __shfl_xor(v, o));
    return v;
}
__device__ __forceinline__ float sum8(float v) { v += dppf<0xB1>(v); v += dppf<0x4E>(v); v += dppf<0x141>(v); return v; }
__device__ __forceinline__ float sigmoidf_(float x) { return __builtin_amdgcn_rcpf(1.f + __expf(-x)); }
__device__ __forceinline__ float log_sigmoidf_(float z) { return fminf(z, 0.f) - __logf(1.f + __expf(-fabsf(z))); }

#define XB_TMO      128
#define XB_XCNT(j)  (256  + 64 * (j))
#define XB_XSUB(j)  (1280 + 64 * (j))
#define XB_XGEN(j)  (2304 + 64 * (j))
#define XB_TOP      3328
#define XB_TOPGEN   3392
#define XCD_BAR_WORDS 3456
#define XB_SPIN_CAP (1u << 22)

__device__ __forceinline__ unsigned xb_ld(unsigned* p)              { return __hip_atomic_load(p, __ATOMIC_RELAXED, __HIP_MEMORY_SCOPE_AGENT); }
__device__ __forceinline__ unsigned xb_add(unsigned* p, unsigned v) { return __hip_atomic_fetch_add(p, v, __ATOMIC_RELAXED, __HIP_MEMORY_SCOPE_AGENT); }
__device__ __forceinline__ unsigned xb_xcc_id() { return (unsigned)__builtin_amdgcn_s_getreg((3 << 11) | 20) & 0xFu; }
#define XB_SPIN(cond, bar) do { unsigned _sp = 0; while (cond) { __builtin_amdgcn_s_sleep(1); \
    if ((++_sp & 255u) == 0u) { if (xb_ld(&(bar)[XB_TMO])) break; if (_sp > XB_SPIN_CAP) { atomicAdd(&(bar)[XB_TMO], 1u); break; } } } } while (0)

struct XcdBarrier { unsigned* bar; unsigned x; volatile LAS unsigned* st; };

__device__ __forceinline__ XcdBarrier xcd_barrier_post(unsigned* bar, volatile LAS unsigned* st) {
    XcdBarrier b; b.bar = bar; b.x = xb_xcc_id(); b.st = st;
    if (threadIdx.x == 0) (void)xb_add(&bar[XB_XCNT(b.x)], 1u);
    return b;
}
__device__ __forceinline__ void xcd_barrier_complete(unsigned* bar, unsigned x, unsigned& nloc, unsigned& nx) {
    const unsigned G = gridDim.x * gridDim.y * gridDim.z;
    unsigned sum, cnt, mine, sp = 0u;
    for (;;) {
        sum = 0u; cnt = 0u; mine = 0u;
#pragma unroll
        for (unsigned j = 0; j < 16; ++j) { const unsigned c = xb_ld(&bar[XB_XCNT(j)]); sum += c; cnt += (c > 0u) ? 1u : 0u; mine = (j == x) ? c : mine; }
        if (sum == G) break;
        __builtin_amdgcn_s_sleep(1);
        if ((++sp & 255u) == 0u) { if (xb_ld(&bar[XB_TMO])) break; if (sp > XB_SPIN_CAP) { atomicAdd(&bar[XB_TMO], 1u); break; } }
    }
    nloc = mine > 0u ? mine : 1u; nx = cnt > 0u ? cnt : 1u;
}
__device__ __forceinline__ void xcd_barrier(const XcdBarrier& b) {
    asm volatile("s_waitcnt vmcnt(0)" ::: "memory");
    __syncthreads();
    if (threadIdx.x == 0) {
        unsigned* bar = b.bar;
        __builtin_amdgcn_s_waitcnt(0);
        unsigned nloc = b.st[0], nx = b.st[1];
        if (nloc == 0u) { xcd_barrier_complete(bar, b.x, nloc, nx); b.st[0] = nloc; b.st[1] = nx; }
        const unsigned old = xb_add(&bar[XB_XSUB(b.x)], 1u);
        const unsigned gen = old / nloc;
        if (old + 1u == (gen + 1u) * nloc) {
            __builtin_amdgcn_fence(__ATOMIC_RELEASE, "agent");
            asm volatile("s_waitcnt vmcnt(0)" ::: "memory");
            const unsigned og = xb_add(&bar[XB_TOP], 1u);
            const unsigned tg = og / nx;
            if (og + 1u == (tg + 1u) * nx) xb_add(&bar[XB_TOPGEN], 1u);
            else XB_SPIN(xb_ld(&bar[XB_TOPGEN]) == tg, bar);
            __builtin_amdgcn_fence(__ATOMIC_ACQUIRE, "agent");
            xb_add(&bar[XB_XGEN(b.x)], 1u);
            asm volatile("s_waitcnt vmcnt(0)" ::: "memory");
        } else {
            XB_SPIN(xb_ld(&bar[XB_XGEN(b.x)]) == gen, bar);
            __builtin_amdgcn_fence(__ATOMIC_ACQUIRE, "agent");
            asm volatile("s_waitcnt vmcnt(0)" ::: "memory");
        }
    }
    __syncthreads();
}

__device__ __forceinline__ int t5_bucket(int d) {
    if (d < 16) return d;
    int b = 16;
    b += (d >= 22) + (d >= 30) + (d >= 40) + (d >= 54) + (d >= 73) + (d >= 99) + (d >= 134) + (d >= 182) + (d >= 246) + (d >= 332) + (d >= 450) + (d >= 609) + (d >= 825) + (d >= 1117) + (d >= 1513);
    return b;
}
struct Args { const float* in[30]; float* out; unsigned char* ws; int l_lo, l_hi, ph_lo, ph_hi, use_bar, pad; };

namespace pg8 {
struct EpiNull {
    static constexpr bool PERM = true;
    unsigned* sink;
    __device__ __forceinline__ void operator()(const f32x4 (&acc)[2][2][4][2], const Unit& u, int wr, int wc, int fr, int fq) const {
        float t = 0.f;
#pragma unroll
        for (int ai = 0; ai < 2; ++ai)
#pragma unroll
            for (int bj = 0; bj < 2; ++bj)
#pragma unroll
                for (int m = 0; m < 4; ++m)
#pragma unroll
                    for (int n = 0; n < 2; ++n) t += (acc[ai][bj][m][n][0] + acc[ai][bj][m][n][1]) + (acc[ai][bj][m][n][2] + acc[ai][bj][m][n][3]);
        if (t == 1.2345e-33f) sink[0] = 1u; }
};
struct EpiStoreBf16 {
    static constexpr bool PERM = true;
    bf16* O; int ldc; int nt_pn = 0, nt_pm = 0;
    __device__ __forceinline__ void operator()(const f32x4 (&acc)[2][2][4][2], const Unit& u, int wr, int wc, int fr, int fq) const {
        const int row0 = u.pm * BM + wr * 64 + fr, col0 = u.pn * BM + wc * 32 + 8 * fq;
#pragma unroll
        for (int ai = 0; ai < 2; ++ai)
#pragma unroll
            for (int m = 0; m < 4; ++m) { bf16* rowp = O + (size_t)(row0 + ai * HALF + m * 16) * ldc + col0;
#pragma unroll
                for (int bj = 0; bj < 2; ++bj) { const f32x4 v0 = acc[ai][bj][m][0], v1 = acc[ai][bj][m][1];
                    u32x4 w; w.x = cvt_pk_bf16(v0[0], v0[1]); w.y = cvt_pk_bf16(v0[2], v0[3]); w.z = cvt_pk_bf16(v1[0], v1[1]); w.w = cvt_pk_bf16(v1[2], v1[3]);
                    if (u.pn < nt_pn || (u.pm & 31) < nt_pm) __builtin_nontemporal_store(w, (u32x4*)(rowp + bj * HALF)); else *(u32x4*)(rowp + bj * HALF) = w; } }
    }
};
struct EpiGate {
    static constexpr bool PERM = false;
    const bf16* BR; bf16* MG;
    __device__ __forceinline__ void operator()(const f32x4 (&acc)[2][2][4][2], const Unit& u, int wr, int wc, int fr, int fq) const {
        const int row0 = u.pm * BM + wr * 64 + fr, j0 = u.pn * 64 + wc * 16 + 4 * fq;
#pragma unroll
        for (int ai = 0; ai < 2; ++ai)
#pragma unroll
            for (int m = 0; m < 4; ++m) { const size_t r = (size_t)(row0 + ai * HALF + m * 16);
                float mg0 = 0.f, mg1 = 0.f, mg2 = 0.f, mg3 = 0.f;
#pragma unroll
                for (int bj = 0; bj < 2; ++bj)
#pragma unroll
                    for (int n = 0; n < 2; ++n) { const int g = 2 * bj + n; const u32x2 b = *(const u32x2*)(BR + r * 4096 + g * 1024 + j0); const f32x4 a = acc[ai][bj][m][n];
                        mg0 += sigmoidf_(a[0]) * bflo(b.x); mg1 += sigmoidf_(a[1]) * bfhi(b.x); mg2 += sigmoidf_(a[2]) * bflo(b.y); mg3 += sigmoidf_(a[3]) * bfhi(b.y); }
                u32x2 w; w.x = cvt_pk_bf16(mg0, mg1); w.y = cvt_pk_bf16(mg2, mg3);
                *(u32x2*)(MG + r * 1024 + j0) = w; }
    }
};
struct EpiOut {
    static constexpr bool PERM = true;
    bf16* XB;
    __device__ __forceinline__ void operator()(const f32x4 (&acc)[2][2][4][2], const Unit& u, int wr, int wc, int fr, int fq) const {
        const int row0 = u.pm * BM + wr * 64 + fr, col0 = u.pn * BM + wc * 32 + 8 * fq;
#pragma unroll
        for (int ai = 0; ai < 2; ++ai)
#pragma unroll
            for (int m = 0; m < 4; ++m) { bf16* rowp = XB + (size_t)(row0 + ai * HALF + m * 16) * 1024 + col0;
#pragma unroll
                for (int bj = 0; bj < 2; ++bj) { const f32x4 v0 = acc[ai][bj][m][0], v1 = acc[ai][bj][m][1]; const u32x4 x = *(const u32x4*)(rowp + bj * HALF);
                    u32x4 w; w.x = cvt_pk_bf16(DN_ALPHA * bflo(x.x) + v0[0], DN_ALPHA * bfhi(x.x) + v0[1]); w.y = cvt_pk_bf16(DN_ALPHA * bflo(x.y) + v0[2], DN_ALPHA * bfhi(x.y) + v0[3]);
                    w.z = cvt_pk_bf16(DN_ALPHA * bflo(x.z) + v1[0], DN_ALPHA * bfhi(x.z) + v1[1]); w.w = cvt_pk_bf16(DN_ALPHA * bflo(x.w) + v1[2], DN_ALPHA * bfhi(x.w) + v1[3]);
                    *(u32x4*)(rowp + bj * HALF) = w; } }
    }
};
struct EpiUp {
    static constexpr bool PERM = true;
    const unsigned* rowinfo; bf16* H;
    __device__ __forceinline__ void operator()(const f32x4 (&acc)[2][2][4][2], const Unit& u, int wr, int wc, int fr, int fq) const {
        const int row0 = u.pm * BM + wr * 64 + fr, col0 = u.pn * 128 + wc * 32 + 8 * fq;
#pragma unroll
        for (int ai = 0; ai < 2; ++ai)
#pragma unroll
            for (int m = 0; m < 4; ++m) { const size_t r = (size_t)(row0 + ai * HALF + m * 16); const float w = __uint_as_float(rowinfo[2 * r + 1]);
                const f32x4 g0 = acc[ai][0][m][0], g1 = acc[ai][0][m][1], u0 = acc[ai][1][m][0], u1 = acc[ai][1][m][1];
                float h[8];
#pragma unroll
                for (int e = 0; e < 4; ++e) { h[e] = g0[e] * sigmoidf_(g0[e]) * u0[e] * w; h[4 + e] = g1[e] * sigmoidf_(g1[e]) * u1[e] * w; }
                u32x4 o; o.x = cvt_pk_bf16(h[0], h[1]); o.y = cvt_pk_bf16(h[2], h[3]); o.z = cvt_pk_bf16(h[4], h[5]); o.w = cvt_pk_bf16(h[6], h[7]);
                *(u32x4*)(H + r * 256 + col0) = o; }
    }
};
struct EpiDown {
    static constexpr bool PERM = true;
    const unsigned* rowinfo; bf16* Y;
    __device__ __forceinline__ void operator()(const f32x4 (&acc)[2][2][4][2], const Unit& u, int wr, int wc, int fr, int fq) const {
        const int row0 = u.pm * BM + wr * 64 + fr, col0 = u.pn * BM + wc * 32 + 8 * fq;
#pragma unroll
        for (int ai = 0; ai < 2; ++ai)
#pragma unroll
            for (int m = 0; m < 4; ++m) { const size_t r = (size_t)(row0 + ai * HALF + m * 16); const int ri = (int)rowinfo[2 * r];
                if (ri >= 0) { bf16* rowp = Y + ((size_t)(ri & 1) * NTOK + (size_t)(ri >> 1)) * 1024 + col0;
#pragma unroll
                    for (int bj = 0; bj < 2; ++bj) { const f32x4 v0 = acc[ai][bj][m][0], v1 = acc[ai][bj][m][1];
                        u32x4 w; w.x = cvt_pk_bf16(v0[0], v0[1]); w.y = cvt_pk_bf16(v0[2], v0[3]); w.z = cvt_pk_bf16(v1[0], v1[1]); w.w = cvt_pk_bf16(v1[2], v1[3]);
                        *(u32x4*)(rowp + bj * HALF) = w; } } }
    }
};
}

struct RowMap { int kind, base, g, off;
    __device__ __forceinline__ int operator()(int n) const {
        if (kind == 0) return base + n;
        if (kind == 1) { const int j = base + n, jj = j & 63, pn = j >> 6; return 3072 + pn * 256 + 128 * (g >> 1) + 32 * (jj >> 4) + 16 * (g & 1) + 4 * ((jj >> 2) & 3) + (jj & 3); }
        const int h = base + n; return (h >> 7) * 256 + off + (h & 127);
    }
};
__device__ __forceinline__ void transpose_item(const float* W, int ldw, int k0, int scol0, int nvalid, bf16* WT, int ldk, const RowMap& rm, LAS float* scr, int lane) {
    const int nn = lane & 31;
    float wv[32];
#pragma unroll
    for (int i = 0; i < 32; ++i) { const int kk = 2 * i + (lane >> 5); wv[i] = (nn < nvalid) ? W[(size_t)(k0 + kk) * ldw + scol0 + nn] : 0.f; }
#pragma unroll
    for (int i = 0; i < 32; ++i) { const int kk = 2 * i + (lane >> 5); scr[kk * 33 + nn] = wv[i]; }
    LDS_WAIT(); asm volatile("" ::: "memory");
    const int c = lane & 7;
#pragma unroll
    for (int j = 0; j < 4; ++j) { const int n = (lane >> 3) + 8 * j; const LAS float* s = scr + (8 * c) * 33 + n;
        u32x4 o; o.x = pk2(s[0 * 33], s[1 * 33]); o.y = pk2(s[2 * 33], s[3 * 33]); o.z = pk2(s[4 * 33], s[5 * 33]); o.w = pk2(s[6 * 33], s[7 * 33]);
        *(u32x4*)(WT + (size_t)rm(n) * ldk + k0 + 8 * c) = o; }
    LDS_WAIT(); asm volatile("" ::: "memory");
}
__device__ __forceinline__ void p0_prologue(const Args& a, LAS unsigned char* lds, int gw, int NGW, int wave, int lane) {
    LAS float* scr = (LAS float*)(lds + wave * 16384);
    constexpr int IPL = 16896;
    for (int it = gw; it < NLAYER * IPL; it += NGW) {
        const int l = it / IPL; int r = it - l * IPL;
        unsigned char* wl = a.ws + WS_W + (size_t)l * WL_SIZE;
        RowMap rm; rm.kind = 0; rm.base = 0; rm.g = 0; rm.off = 0;
        if (r < 1536) { const int nt = r % 96, kt = r / 96, n0 = 32 * nt; int nv = 3000 - n0; nv = nv < 0 ? 0 : (nv > 32 ? 32 : nv); rm.base = n0;
            transpose_item(a.in[2] + (size_t)l * 1024 * IN_W, IN_W, 64 * kt, n0, nv, (bf16*)(wl + WL_IN), 1024, rm, scr, lane); continue; }
        r -= 1536;
        if (r < 2048) { const int nt = r % 128, kt = r / 128, gc0 = 32 * nt; rm.kind = 1; rm.g = gc0 >> 10; rm.base = gc0 & 1023;
            transpose_item(a.in[2] + (size_t)l * 1024 * IN_W, IN_W, 64 * kt, 3000 + gc0, 32, (bf16*)(wl + WL_IN), 1024, rm, scr, lane); continue; }
        r -= 2048;
        if (r < 512) { const int nb = r / 128, rr = r % 128, nt = rr % 32, kt = rr / 32; rm.base = nb * 1024 + 32 * nt;
            if (nb != 1) transpose_item(a.in[19] + (size_t)(l * 4 + nb) * 256 * 1024, 1024, 64 * kt, 32 * nt, 32, (bf16*)(wl + WL_BR), 256, rm, scr, lane); continue; }
        r -= 512;
        if (r < 512) { const int nt = r % 32, kt = r / 32; rm.base = 32 * nt;
            transpose_item(a.in[20] + (size_t)l * 1024 * 1024, 1024, 64 * kt, 32 * nt, 32, (bf16*)(wl + WL_OUT), 1024, rm, scr, lane); continue; }
        r -= 512;
        if (r < 8192) { const int up = r >= 4096; if (up) r -= 4096; const int e = r / 128, rr = r % 128, nt = rr % 8, kt = rr / 8; rm.kind = 2; rm.base = 32 * nt; rm.off = up ? 128 : 0;
            transpose_item(a.in[up ? 28 : 27] + (size_t)(l * 32 + e) * 1024 * 256, 256, 64 * kt, 32 * nt, 32, (bf16*)(wl + WL_GU) + (size_t)e * 512 * 1024, 1024, rm, scr, lane); continue; }
        r -= 8192;
        { const int e = r / 128, rr = r % 128, nt = rr % 32, kt = rr / 32; rm.base = 32 * nt;
            transpose_item(a.in[29] + (size_t)(l * 32 + e) * 256 * 1024, 1024, 64 * kt, 32 * nt, 32, (bf16*)(wl + WL_DN) + (size_t)e * 1024 * 256, 256, rm, scr, lane); }
    }
    { float* WRT = (float*)(a.ws + WS_RT); const int gt = gw * 64 + lane, NT = NGW * 64;
      for (int i = gt; i < NLAYER * 4 * 64 * 1024; i += NT) { const int j = i & 1023, c = (i >> 10) & 63, h = (i >> 16) & 3, l = i >> 18;
          const float* wu = a.in[4] + ((size_t)(l * 4 + h) * 64 + c) * 64; const float* wb = a.in[19] + ((size_t)(l * 4 + 1) * 256 + h * 64) * 1024 + j; float acc = 0.f;
#pragma unroll 8
          for (int d = 0; d < 64; ++d) acc += wu[d] * wb[(size_t)d * 1024];
          ((bf16*)(a.ws + WS_W + (size_t)l * WL_SIZE + WL_BR))[(size_t)(1024 + j) * 256 + h * 64 + c] = (bf16)f2bf(acc); }
      for (int i = gt; i < NLAYER * 36 * 1024; i += NT) { const int k = i & 1023, e = (i >> 10) % 36, l = i / (36 * 1024);
          WRT[i] = e < 4 ? a.in[23][((size_t)l * 1024 + k) * 4 + e] : a.in[25][((size_t)l * 1024 + k) * 32 + (e - 4)]; }
      const f32x4* xs = (const f32x4*)a.in[0]; u32x4* xd = (u32x4*)(a.ws + WS_XB);
      for (int i = gt; i < NTOK * DM / 8; i += NT) { const f32x4 v0 = xs[2 * i], v1 = xs[2 * i + 1]; u32x4 o; o.x = pk2(v0[0], v0[1]); o.y = pk2(v0[2], v0[3]); o.z = pk2(v1[0], v1[1]); o.w = pk2(v1[2], v1[3]); xd[i] = o; } }
}

__device__ __forceinline__ float softplusf_(float x) { return fmaxf(x, 0.f) + __logf(1.f + __expf(-fabsf(x))); }
__device__ __forceinline__ float tanhf_(float x) { const float e = __expf(-2.f * fabsf(x)); const float t = (1.f - e) * __builtin_amdgcn_rcpf(1.f + e); return x < 0.f ? -t : t; }
__device__ __forceinline__ void prep_phase(const Args& a, int l, LAS unsigned char* lds, int tid, int gw, int NGW, int lane, const int pmode = 7) {
    const int wave = __builtin_amdgcn_readfirstlane(tid >> 6);
    const bf16* P = (const bf16*)(a.ws + WS_BIG);
    bf16* CKVN = (bf16*)(a.ws + WS_CKVN); bf16* CQH = (bf16*)(a.ws + WS_CA); bf16* CKT = (bf16*)(a.ws + WS_CA + 16 * MiB); float* CCL = (float*)(a.ws + WS_END); float* BON = (float*)(a.ws + WS_BON);
    bf16* DR = (bf16*)((unsigned char*)a.out + DO_DR); bf16* DKP = (bf16*)((unsigned char*)a.out + DO_DKP); bf16* DV = (bf16*)((unsigned char*)a.out + DO_DV); bf16* DKK = (bf16*)((unsigned char*)a.out + DO_DKK);
    float* DW = (float*)(a.ws + WS_BIG + BIG_DW); bf16* DAI = (bf16*)(a.ws + WS_BIG + BIG_DAI); bf16* DG = (bf16*)(a.ws + WS_BIG + BIG_DG);
    const float* kvg = a.in[3] + l * 64; const float* aup = a.in[5] + l * 16 * 128; const float* abias = a.in[6] + l * 128;
    const float* mu = a.in[8] + l * 832; const float* w0 = a.in[9] + l * 256; const float* w2 = a.in[10] + l * 16 * 256; const float* a0 = a.in[11] + l * 256;
    const float* a2 = a.in[12] + l * 16 * 256; const float* g2 = a.in[13] + l * 32 * 256; const float* kkw = a.in[14] + l * 256; const float* kaw = a.in[15] + l * 256; const float* rkw = a.in[16] + l * 256;
    LAS float* sW2 = (LAS float*)lds; LAS float* sA2 = (LAS float*)(lds + 16384); LAS float* sG2 = (LAS float*)(lds + 32768); LAS float* sUP = (LAS float*)(lds + 65536);
    {
      const f32x4 t0 = ((const f32x4*)w2)[tid], t1 = ((const f32x4*)w2)[tid + NTHR], t2 = ((const f32x4*)a2)[tid], t3 = ((const f32x4*)a2)[tid + NTHR];
      const f32x4 t4 = ((const f32x4*)g2)[tid], t5 = ((const f32x4*)g2)[tid + NTHR], t6 = ((const f32x4*)g2)[tid + 2 * NTHR], t7 = ((const f32x4*)g2)[tid + 3 * NTHR], t8 = ((const f32x4*)aup)[tid];
      ((LAS f32x4*)sW2)[tid] = t0; ((LAS f32x4*)sW2)[tid + NTHR] = t1; ((LAS f32x4*)sA2)[tid] = t2; ((LAS f32x4*)sA2)[tid + NTHR] = t3;
      ((LAS f32x4*)sG2)[tid] = t4; ((LAS f32x4*)sG2)[tid + NTHR] = t5; ((LAS f32x4*)sG2)[tid + 2 * NTHR] = t6; ((LAS f32x4*)sG2)[tid + 3 * NTHR] = t7; ((LAS f32x4*)sUP)[tid] = t8; }
    __syncthreads();
    float mu_r[13], w0_r[4], a0_r[4], kk_r[4], ka_r[4], rk_r[4];
#pragma unroll
    for (int i = 0; i < 4; ++i) { const int c = 4 * lane + i; mu_r[i] = mu[c]; mu_r[4 + i] = mu[256 + c]; mu_r[8 + i] = mu[512 + c]; w0_r[i] = w0[c]; a0_r[i] = a0[c]; kk_r[i] = kkw[c]; ka_r[i] = kaw[c]; rk_r[i] = rkw[c]; }
    mu_r[12] = mu[768 + lane];
    const float kvg_r = kvg[lane], ab0 = abias[lane], ab1 = abias[64 + lane];
    u32x2 ncr, nck, ncv, npr, npk, npv; unsigned short ncl, npl, nckv, nca, nq0, nq1, nk0, nk1;
#define PREP_LOAD(mm) do { const bf16* pr_ = P + (size_t)(mm) * PW; \
        ncr = *(const u32x2*)(pr_ + PC_D + 4 * lane); nck = *(const u32x2*)(pr_ + PC_D + 256 + 4 * lane); ncv = *(const u32x2*)(pr_ + PC_D + 512 + 4 * lane); ncl = pr_[PC_D + 768 + lane]; nckv = pr_[PC_CKV + lane]; nca = pr_[PC_CA + (lane & 15)]; nq0 = pr_[PC_CQ + lane]; nq1 = pr_[PC_CQ + 64 + lane]; nk0 = pr_[PC_CK + lane]; nk1 = pr_[PC_CK + 64 + lane]; } while (0)
    constexpr int NCK = NTOK / 16;
    float* DCL = DW;
#define PREP_LOADP(mm) do { const int tt_ = (mm) & (SEQ - 1); const bf16* pp_ = P + (size_t)(mm) * PW - (tt_ > 0 ? PW : 0); npr = *(const u32x2*)(pp_ + PC_D + 4 * lane); npk = *(const u32x2*)(pp_ + PC_D + 256 + 4 * lane); npv = *(const u32x2*)(pp_ + PC_D + 512 + 4 * lane); npl = pp_[PC_D + 768 + lane]; } while (0)
    if (gw < NCK) { PREP_LOAD(gw * 16); PREP_LOADP(gw * 16); }
    for (int ck = gw; ck < NCK; ck += NGW) {
      float cpr[4] = {1.f, 1.f, 1.f, 1.f}; float cprc0 = 1.f, cprc1 = 1.f;
#pragma unroll 1
      for (int tt = 0; tt < 16; ++tt) {
        const int m = ck * 16 + tt;
        const int t = m & (SEQ - 1);
        const u32x2 ccr = ncr, cck = nck, ccv = ncv, cpr_ = npr, cpk = npk, cpv = npv; const unsigned short ccl = ncl, cpl = npl;
        npr = ncr; npk = nck; npv = ncv; npl = ncl;
        const unsigned short cckv = nckv, cca = nca, cq0 = nq0, cq1 = nq1, ck0 = nk0, ck1 = nk1;
        if (tt < 15) PREP_LOAD(m + 1); else if (ck + NGW < NCK) { PREP_LOAD((ck + NGW) * 16); PREP_LOADP((ck + NGW) * 16); }
        { const float x = bf2f(cckv); const float ss = wave_sum(x * x); const float rn = rsqrtf(ss * (1.f / 64.f) + 1e-6f); CKVN[(size_t)m * 64 + lane] = (bf16)f2bf(x * rn * kvg_r); }
        { const float cav = (lane < 16) ? bf2f(cca) : 0.f; float z0 = ab0, z1 = ab1;
#pragma unroll
          for (int i = 0; i < 16; ++i) { const float cv = __builtin_bit_cast(float, __builtin_amdgcn_readlane(__builtin_bit_cast(int, cav), i)); z0 += cv * sUP[i * 128 + lane]; z1 += cv * sUP[i * 128 + 64 + lane]; }
          cprc0 *= __expf(log_sigmoidf_(z0) * (1.f / 16.f)); cprc1 *= __expf(log_sigmoidf_(z1) * (1.f / 16.f));
          CQH[(size_t)m * 128 + lane] = (bf16)f2bf(bf2f(cq0) * cprc0); CQH[(size_t)m * 128 + 64 + lane] = (bf16)f2bf(bf2f(cq1) * cprc1);
          CKT[(size_t)m * 128 + lane] = (bf16)f2bf(bf2f(ck0) * __builtin_amdgcn_rcpf(cprc0)); CKT[(size_t)m * 128 + 64 + lane] = (bf16)f2bf(bf2f(ck1) * __builtin_amdgcn_rcpf(cprc1));
          if (tt == 15) { CCL[(size_t)ck * 128 + lane] = cprc0; CCL[(size_t)ck * 128 + 64 + lane] = cprc1; } }
        float xs[13];
        { const float cu[13] = {bflo(ccr.x), bfhi(ccr.x), bflo(ccr.y), bfhi(ccr.y), bflo(cck.x), bfhi(cck.x), bflo(cck.y), bfhi(cck.y), bflo(ccv.x), bfhi(ccv.x), bflo(ccv.y), bfhi(ccv.y), bf2f(ccl)};
          const float pv[13] = {bflo(cpr_.x), bfhi(cpr_.x), bflo(cpr_.y), bfhi(cpr_.y), bflo(cpk.x), bfhi(cpk.x), bflo(cpk.y), bfhi(cpk.y), bflo(cpv.x), bfhi(cpv.x), bflo(cpv.y), bfhi(cpv.y), bf2f(cpl)};
#pragma unroll
          for (int i = 0; i < 13; ++i) { const float prev = (t > 0) ? pv[i] : 0.f; xs[i] = cu[i] + (prev - cu[i]) * mu_r[i]; } }
        const float low = xs[12], tw = tanhf_(low), sg = sigmoidf_(low);
        float wr_[4], ar_[4], gv_[4];
#pragma unroll
        for (int i = 0; i < 4; ++i) { wr_[i] = w0_r[i]; ar_[i] = a0_r[i]; gv_[i] = 0.f; }
#define RDL(V, J) __builtin_bit_cast(float, __builtin_amdgcn_readlane(__builtin_bit_cast(int, V), (J)))
#define FMAS(ACC, S, V) asm("v_fmac_f32 %0, %1, %2" : "+v"(ACC) : "s"(S), "v"(V))
        int l4 = 4 * lane; asm volatile("" : "+v"(l4));
#pragma unroll 4
        for (int j = 0; j < 16; ++j) { const float tj = RDL(tw, j), aj = RDL(low, 16 + j); const f32x4 w4 = *(const LAS f32x4*)(sW2 + j * 256 + l4), a4 = *(const LAS f32x4*)(sA2 + j * 256 + l4);
#pragma unroll
            for (int i = 0; i < 4; ++i) { wr_[i] += tj * w4[i]; ar_[i] += aj * a4[i]; } }
#pragma unroll 4
        for (int j = 0; j < 32; ++j) { const float sj = RDL(sg, 32 + j); const f32x4 g4 = *(const LAS f32x4*)(sG2 + j * 256 + l4);
#pragma unroll
            for (int i = 0; i < 4; ++i) gv_[i] += sj * g4[i]; }
#undef RDL
#undef FMAS
        { float kkv[4], kp[4], av[4]; float n2 = 0.f, bn = 0.f;
#pragma unroll
          for (int i = 0; i < 4; ++i) { av[i] = sigmoidf_(ar_[i]); const float kx = xs[4 + i]; kkv[i] = kx * kk_r[i]; n2 += kkv[i] * kkv[i]; kp[i] = kx * (1.f + (av[i] - 1.f) * ka_r[i]); bn += xs[i] * kp[i] * rk_r[i]; }
          n2 += dppf<0x128>(n2); n2 += dppf<0x124>(n2); n2 += dppf<0x122>(n2); n2 += dppf<0x121>(n2);
          bn += dppf<0x128>(bn); bn += dppf<0x124>(bn); bn += dppf<0x122>(bn); bn += dppf<0x121>(bn);
          const float rnrm = __builtin_amdgcn_rcpf(fmaxf(sqrtf(n2), 1e-12f));
          float o_r[4], o_kp[4], o_kk[4], o_ai[4];
#pragma unroll
          for (int i = 0; i < 4; ++i) { const float w_raw = -softplusf_(-wr_[i]) - 0.5f, wdec = __expf(-__expf(w_raw)); const float kn = kkv[i] * rnrm;
              o_kk[i] = -kn * cpr[i]; cpr[i] *= wdec; const float cinv = __builtin_amdgcn_rcpf(cpr[i]);
              o_r[i] = xs[i] * cpr[i]; o_kp[i] = kp[i] * cinv; o_ai[i] = kn * av[i] * cinv; }
          const size_t o = (size_t)m * 256 + 4 * lane;
          *(u32x2*)(DR + o) = (u32x2){pk2(o_r[0], o_r[1]), pk2(o_r[2], o_r[3])}; *(u32x2*)(DKP + o) = (u32x2){pk2(o_kp[0], o_kp[1]), pk2(o_kp[2], o_kp[3])};
          *(u32x2*)(DV + o) = (u32x2){pk2(xs[8], xs[9]), pk2(xs[10], xs[11])}; *(u32x2*)(DKK + o) = (u32x2){pk2(o_kk[0], o_kk[1]), pk2(o_kk[2], o_kk[3])};
          *(u32x2*)(DAI + o) = (u32x2){pk2(o_ai[0], o_ai[1]), pk2(o_ai[2], o_ai[3])}; *(u32x2*)(DG + o) = (u32x2){pk2(gv_[0], gv_[1]), pk2(gv_[2], gv_[3])};
          if (tt == 15) *(f32x4*)(DCL + (size_t)ck * 256 + 4 * lane) = (f32x4){cpr[0], cpr[1], cpr[2], cpr[3]};
          if ((lane & 15) == 0) BON[(size_t)m * 4 + (lane >> 4)] = bn; }
      }
    }
#undef PREP_LOAD
#undef PREP_LOADP
    __syncthreads();
}

typedef float f32x16 __attribute__((ext_vector_type(16)));
typedef short s16x4 __attribute__((ext_vector_type(4)));
typedef short v4i16_t __attribute__((ext_vector_type(4)));
typedef float f32x2_t __attribute__((ext_vector_type(2))); typedef __bf16 bf16x2_t __attribute__((ext_vector_type(2)));
__device__ __forceinline__ unsigned cvtpk_s(float lo, float hi) { f32x2_t v = {lo, hi}; bf16x2_t b = __builtin_convertvector(v, bf16x2_t); return __builtin_bit_cast(unsigned, b); }
__device__ __forceinline__ s16x4 vtr(const LAS unsigned char* p) { return __builtin_bit_cast(s16x4, __builtin_amdgcn_ds_read_tr16_b64_v4i16((LAS v4i16_t*)p)); }
constexpr int ATB_OFF = 102400;
constexpr int AVI_OFF = 3584;
constexpr float LOG2E = 1.4426950408889634f;
__device__ __forceinline__ void mixA_tables(const Args& a, LAS unsigned char* lds, int tid) {
    LAS float* tb = (LAS float*)(lds + ATB_OFF);
    for (int i = tid; i < 3 * 4 * 192; i += NTHR) { const int e = i % 192, h = (i / 192) & 3, f = i / 768; const int dist = 159 - e; const int dl = f == 0 ? 16 : (f == 1 ? 4 : 1);
        float v = -INFINITY;
        if (dist >= 0 && dist <= 128) { int dd = dist * dl; dd = dd > 2047 ? 2047 : dd; v = ((const LAS float*)(lds + RPB_OFF))[((const LAS unsigned char*)(lds + BKT_OFF))[dd] * 8 + h] * LOG2E; }
        tb[i] = v; }
}
__device__ __forceinline__ void mixA_task(const Args& a, int b, int h, int r, int cc, LAS unsigned char* lds, int wave, int lane_in) {
    int lane = lane_in; asm volatile("" : "+v"(lane));
    const bf16* P = (const bf16*)(a.ws + WS_BIG); bf16* YS = (bf16*)((unsigned char*)a.out + DO_YS);
    const int ql = lane & 31, hh = lane >> 5, n0 = 32 * cc;
    const size_t rowb = (size_t)b * SEQ; const int tq = 16 * (n0 + ql) + r;
    const LAS float* tball = (const LAS float*)(lds + ATB_OFF) + h * 192;
    LAS unsigned char* vimg = lds + AVI_OFF + wave * 12800;
    bf16x8 qf[4];
    { const bf16* qp = P + (rowb + tq) * PW + PC_AQ + h * 64 + 8 * hh;
#pragma unroll
      for (int ks = 0; ks < 4; ++ks) qf[ks] = *(const bf16x8*)(qp + 16 * ks); }
    f32x16 o0, o1;
#pragma unroll
    for (int i = 0; i < 16; ++i) { o0[i] = 0.f; o1[i] = 0.f; }
    float m = -INFINITY, lsum = 0.f;
    const float SC = 0.125f * LOG2E;
    const int vst = (lane >> 3) * 144 + (lane & 7) * 16;
    const int i16 = lane & 15, tq4 = i16 >> 2, tp = i16 & 3, g16 = (lane >> 4) & 1;
    const int vrd = (4 * hh + tq4) * 144 + 32 * g16 + 8 * tp;
#pragma unroll 1
    for (int f = 0; f < 3; ++f) {
        const int dsh = f == 0 ? 4 : (f == 1 ? 2 : 0);
        const int rho = r & ((1 << dsh) - 1);
        const int qpos = (tq - rho) >> dsh;
        const int qmin = (16 * n0 + r - rho) >> dsh, qmax = (16 * (n0 + 31) + r - rho) >> dsh;
        int klo = qmin - 128; klo = klo < 0 ? 0 : klo; klo &= ~31;
        const LAS float* tbf = tball + f * 768;
        bf16x8 kA[4], kB[4]; u32x4 vA0, vA1, vA2, vA3, vB0, vB1, vB2, vB3;
#define A_LOAD(KF, W0, W1, W2, W3, KK0) do { const size_t tk_ = rowb + (((size_t)((KK0) + ql)) << dsh) + rho; const bf16* kp_ = P + tk_ * PW + PC_AK + h * 64 + 8 * hh; \
            _Pragma("unroll") for (int ks = 0; ks < 4; ++ks) KF[ks] = *(const bf16x8*)(kp_ + 16 * ks); \
            const bf16* vp_ = P + (rowb + (((size_t)((KK0) + (lane >> 3))) << dsh) + rho) * PW + PC_AV + h * 64 + 8 * (lane & 7); const size_t vs_ = ((size_t)8 << dsh) * PW; \
            W0 = *(const u32x4*)(vp_); W1 = *(const u32x4*)(vp_ + vs_); W2 = *(const u32x4*)(vp_ + 2 * vs_); W3 = *(const u32x4*)(vp_ + 3 * vs_); } while (0)
#define A_TILE(KF, W0, W1, W2, W3, K0) do { \
            f32x16 st; \
            _Pragma("unroll") for (int i = 0; i < 16; ++i) st[i] = 0.f; \
            _Pragma("unroll") for (int ks = 0; ks < 4; ++ks) st = __builtin_amdgcn_mfma_f32_32x32x16_bf16(KF[ks], qf[ks], st, 0, 0, 0); \
            *(LAS u32x4*)(vimg + vst) = W0; *(LAS u32x4*)(vimg + vst + 8 * 144) = W1; *(LAS u32x4*)(vimg + vst + 16 * 144) = W2; *(LAS u32x4*)(vimg + vst + 24 * 144) = W3; \
            __builtin_amdgcn_sched_barrier(0); \
            if ((K0) - 64 >= klo) A_LOAD(KF, W0, W1, W2, W3, (K0) - 64); \
            __builtin_amdgcn_sched_barrier(0); \
            const int D0 = qpos - (K0) - 4 * hh; const int e0 = (D0 >= 0 && D0 <= 159) ? 159 - D0 : 0; \
            const LAS float* tp_ = tbf + e0; \
            float mx = -INFINITY; \
            _Pragma("unroll") for (int i = 0; i < 16; ++i) { st[i] = st[i] * SC + tp_[(i & 3) + 8 * (i >> 2)]; mx = fmaxf(mx, st[i]); } \
            mx = fmaxf(mx, __shfl_xor(mx, 32)); \
            const float mn = fmaxf(m, mx), alpha = __builtin_amdgcn_exp2f(m - mn); \
            m = mn; float ps = 0.f; \
            _Pragma("unroll") for (int i = 0; i < 16; ++i) { st[i] = __builtin_amdgcn_exp2f(st[i] - mn); ps += st[i]; } \
            lsum = lsum * alpha + ps; \
            _Pragma("unroll") for (int i = 0; i < 16; ++i) { o0[i] *= alpha; o1[i] *= alpha; } \
            bf16x8 pf[2]; \
            _Pragma("unroll") for (int s = 0; s < 2; ++s) { u32x4 w; w.x = cvtpk_s(st[8 * s], st[8 * s + 1]); w.y = cvtpk_s(st[8 * s + 2], st[8 * s + 3]); w.z = cvtpk_s(st[8 * s + 4], st[8 * s + 5]); w.w = cvtpk_s(st[8 * s + 6], st[8 * s + 7]); pf[s] = __builtin_bit_cast(bf16x8, w); } \
            asm volatile("s_waitcnt lgkmcnt(0)" ::: "memory"); \
            _Pragma("unroll") for (int s = 0; s < 2; ++s) { \
                const s16x4 a00 = vtr(vimg + vrd + (16 * s) * 144), a01 = vtr(vimg + vrd + (16 * s + 8) * 144); \
                const s16x4 a10 = vtr(vimg + vrd + (16 * s) * 144 + 64), a11 = vtr(vimg + vrd + (16 * s + 8) * 144 + 64); \
                const bf16x8 A0 = (bf16x8){a00[0], a00[1], a00[2], a00[3], a01[0], a01[1], a01[2], a01[3]}; \
                const bf16x8 A1 = (bf16x8){a10[0], a10[1], a10[2], a10[3], a11[0], a11[1], a11[2], a11[3]}; \
                o0 = __builtin_amdgcn_mfma_f32_32x32x16_bf16(A0, pf[s], o0, 0, 0, 0); \
                o1 = __builtin_amdgcn_mfma_f32_32x32x16_bf16(A1, pf[s], o1, 0, 0, 0); } \
            asm volatile("s_waitcnt lgkmcnt(0)" ::: "memory"); } while (0)
        int k0 = qmax & ~31;
        A_LOAD(kA, vA0, vA1, vA2, vA3, k0);
        if (k0 - 32 >= klo) A_LOAD(kB, vB0, vB1, vB2, vB3, k0 - 32);
#pragma unroll 1
        while (k0 >= klo) {
            A_TILE(kA, vA0, vA1, vA2, vA3, k0);
            k0 -= 32; if (k0 < klo) break;
            A_TILE(kB, vB0, vB1, vB2, vB3, k0);
            k0 -= 32;
        }
#undef A_TILE
#undef A_LOAD
    }
    const float lt = lsum + __shfl_xor(lsum, 32); const float inv = 1.f / lt;
    bf16* yo = YS + (rowb + tq) * 1024 + h * 64 + 4 * hh;
#pragma unroll
    for (int g = 0; g < 4; ++g) {
        u32x2 w; w.x = cvtpk_s(o0[4 * g] * inv, o0[4 * g + 1] * inv); w.y = cvtpk_s(o0[4 * g + 2] * inv, o0[4 * g + 3] * inv); *(u32x2*)(yo + 8 * g) = w;
        u32x2 x; x.x = cvtpk_s(o1[4 * g] * inv, o1[4 * g + 1] * inv); x.y = cvtpk_s(o1[4 * g + 2] * inv, o1[4 * g + 3] * inv); *(u32x2*)(yo + 32 + 8 * g) = x; }
}

__device__ __forceinline__ unsigned fkey(float f) { const unsigned u = __float_as_uint(f); return (u & 0x80000000u) ? ~u : (u | 0x80000000u); }
typedef float f32x4v __attribute__((ext_vector_type(4)));
__device__ __forceinline__ float wave_max64(float v) {
    v = fmaxf(v, dppf<0x128>(v)); v = fmaxf(v, dppf<0x124>(v)); v = fmaxf(v, dppf<0x122>(v)); v = fmaxf(v, dppf<0x121>(v));
    v = fmaxf(v, __builtin_bit_cast(float, __builtin_amdgcn_update_dpp(__builtin_bit_cast(int, v), __builtin_bit_cast(int, v), 0x142, 0xa, 0xf, false)));
    v = fmaxf(v, __builtin_bit_cast(float, __builtin_amdgcn_update_dpp(__builtin_bit_cast(int, v), __builtin_bit_cast(int, v), 0x143, 0xc, 0xf, false)));
    return __builtin_bit_cast(float, __builtin_amdgcn_readlane(__builtin_bit_cast(int, v), 63));
}
__device__ __forceinline__ void mixB_attend4(const Args& a, int m0, const LAS unsigned short* sidx4, const LAS unsigned char* sbk4, LAS unsigned char* lds, LAS unsigned char* img, LAS unsigned char* pT, int lane, const int am = 0) {
    const bf16* P = (const bf16*)(a.ws + WS_BIG); const bf16* CKVN = (const bf16*)(a.ws + WS_CKVN); bf16* YS = (bf16*)((unsigned char*)a.out + DO_YS);
    const LAS float* rpb = (const LAS float*)(lds + RPB_OFF);
    const int t0 = m0 & (SEQ - 1); const size_t rowb = (size_t)(m0 - t0);
    const int hc = lane & 15, g = lane >> 4, hd = lane & 3;
    const float SC = 0.125f * LOG2E;
    const int i16 = lane & 15, tq4 = i16 >> 2, tp = i16 & 3;
    const int rd_tr = (4 * g + tq4) * 144 + 8 * tp;
    const int rd_p = hd * 128 + 8 * g;
    u32x4 g0, g1, g2, g3, g4, g5, g6, g7, nq0, nq1, nq2, nq3, nq4, nq5, nq6, nq7;
#define BG_ROW(QI, NS, CH, I, G) do { const int kk_ = 64 * (CH) + 8 * (I) + (lane >> 3); const int idx_ = (int)sidx4[(QI) * 256 + (kk_ < (NS) ? kk_ : 0)] & (SEQ - 1); \
        G = *(const u32x4*)(CKVN + (rowb + idx_) * 64 + 8 * (lane & 7)); } while (0)
#define BG_LOAD(QI, NS, CH) do { BG_ROW(QI, NS, CH, 0, g0); BG_ROW(QI, NS, CH, 1, g1); BG_ROW(QI, NS, CH, 2, g2); BG_ROW(QI, NS, CH, 3, g3); \
        BG_ROW(QI, NS, CH, 4, g4); BG_ROW(QI, NS, CH, 5, g5); BG_ROW(QI, NS, CH, 6, g6); BG_ROW(QI, NS, CH, 7, g7); } while (0)
#define BQ_LOAD(QI) do { const u32x4* qp_ = (const u32x4*)(P + (size_t)(m0 + (QI)) * PW + PC_BQ + hd * 64); \
        nq0 = qp_[0]; nq1 = qp_[1]; nq2 = qp_[2]; nq3 = qp_[3]; nq4 = qp_[4]; nq5 = qp_[5]; nq6 = qp_[6]; nq7 = qp_[7]; } while (0)
#define B_LO(V) __builtin_bit_cast(s16x4, (u32x2){(V).x, (V).y})
#define B_HI(V) __builtin_bit_cast(s16x4, (u32x2){(V).z, (V).w})
#define B_S2(SA, SB, Q, L) do { SA = __builtin_amdgcn_mfma_f32_4x4x4bf16_1k(B_LO(Q), B_LO(L), SA, 0, 0, 0); SB = __builtin_amdgcn_mfma_f32_4x4x4bf16_1k(B_HI(Q), B_HI(L), SB, 0, 0, 0); } while (0)
    { const int ns0 = (t0 + 1 < 256) ? t0 + 1 : 256; BQ_LOAD(0); BG_LOAD(0, ns0, 0); }
#pragma unroll 1
    for (int qi = 0; qi < 4; ++qi) {
        const int m = m0 + qi, tq = t0 + qi; const int nsel = (tq + 1 < 256) ? tq + 1 : 256; const int nsn = (tq + 2 < 256) ? tq + 2 : 256;
        const LAS unsigned char* sbk = sbk4 + qi * 256;
        const u32x4 q0 = nq0, q1 = nq1, q2 = nq2, q3 = nq3, q4 = nq4, q5 = nq5, q6 = nq6, q7 = nq7;
        if (qi + 1 < 4) BQ_LOAD(qi + 1);
        f32x4v oT[4];
#pragma unroll
        for (int mt = 0; mt < 4; ++mt) oT[mt] = (f32x4v){0.f, 0.f, 0.f, 0.f};
        f32x4v mrun = (f32x4v){-INFINITY, -INFINITY, -INFINITY, -INFINITY}, lsum = (f32x4v){0.f, 0.f, 0.f, 0.f};
#pragma unroll 1
        for (int ch = 0; ch < 4; ++ch) {
            if (64 * ch >= nsel) break;
            { LAS unsigned char* ip = img + (lane >> 3) * 144 + 16 * (lane & 7);
              *(LAS u32x4*)(ip) = g0; *(LAS u32x4*)(ip + 8 * 144) = g1; *(LAS u32x4*)(ip + 16 * 144) = g2; *(LAS u32x4*)(ip + 24 * 144) = g3;
              *(LAS u32x4*)(ip + 32 * 144) = g4; *(LAS u32x4*)(ip + 40 * 144) = g5; *(LAS u32x4*)(ip + 48 * 144) = g6; *(LAS u32x4*)(ip + 56 * 144) = g7; }
            if (64 * (ch + 1) < nsel) BG_LOAD(qi, nsel, ch + 1);
            else if (qi + 1 < 4) BG_LOAD(qi + 1, nsn, 0);
            f32x4v sa = (f32x4v){0.f, 0.f, 0.f, 0.f}, sb = sa, sc = sa, sd = sa;
            { const LAS u32x4* lp = (const LAS u32x4*)(img + lane * 144);
              const u32x4 l0 = lp[0], l1 = lp[1], l2 = lp[2], l3 = lp[3], l4 = lp[4], l5 = lp[5], l6 = lp[6], l7 = lp[7];
              B_S2(sa, sb, q0, l0); B_S2(sc, sd, q1, l1); B_S2(sa, sb, q2, l2); B_S2(sc, sd, q3, l3); B_S2(sa, sb, q4, l4); B_S2(sc, sd, q5, l5); B_S2(sa, sb, q6, l6); B_S2(sc, sd, q7, l7); }
            sa = (sa + sb) + (sc + sd);
            const int kpos = 64 * ch + lane;
            const int bk = (int)sbk[kpos < 256 ? kpos : 255];
            const f32x4v bb = *(const LAS f32x4v*)(rpb + bk * 8 + 4);
            f32x4v v = sa * SC + bb * LOG2E;
            if (kpos >= nsel) v = (f32x4v){-INFINITY, -INFINITY, -INFINITY, -INFINITY};
            const bool over = (v[0] > mrun[0] + 32.f) || (v[1] > mrun[1] + 32.f) || (v[2] > mrun[2] + 32.f) || (v[3] > mrun[3] + 32.f);
            if (__any(over)) {
                f32x4v mn, al;
#pragma unroll
                for (int i = 0; i < 4; ++i) { mn[i] = fmaxf(mrun[i], (am & 2) ? v[i] + 40.f : wave_max64(v[i])); al[i] = __builtin_amdgcn_exp2f(mrun[i] - mn[i]); }
                lsum = lsum * al; mrun = mn;
                const float ah = hd == 0 ? al[0] : hd == 1 ? al[1] : hd == 2 ? al[2] : al[3];
#pragma unroll
                for (int mt = 0; mt < 4; ++mt) oT[mt] = oT[mt] * ah;
            }
            f32x4v p;
#pragma unroll
            for (int i = 0; i < 4; ++i) p[i] = __builtin_amdgcn_exp2f(v[i] - mrun[i]);
            lsum = lsum + p;
            { const unsigned w01 = cvtpk_s(p[0], p[1]), w23 = cvtpk_s(p[2], p[3]); LAS unsigned short* pw = (LAS unsigned short*)pT + lane;
              pw[0] = (unsigned short)w01; pw[64] = (unsigned short)(w01 >> 16); pw[128] = (unsigned short)w23; pw[192] = (unsigned short)(w23 >> 16); }
            asm volatile("s_waitcnt lgkmcnt(0)" ::: "memory");
#pragma unroll
            for (int ks2 = 0; ks2 < 2; ++ks2) { if (am & 4) break;
                const u32x2 pl = *(const LAS u32x2*)(pT + rd_p + 64 * ks2), ph = *(const LAS u32x2*)(pT + rd_p + 64 * ks2 + 32);
                const bf16x8 pB = __builtin_bit_cast(bf16x8, (u32x4){pl.x, pl.y, ph.x, ph.y});
#pragma unroll
                for (int mt = 0; mt < 4; ++mt) {
                    const s16x4 lo = vtr(img + rd_tr + (32 * ks2) * 144 + 32 * mt), hi = vtr(img + rd_tr + (32 * ks2 + 16) * 144 + 32 * mt);
                    const bf16x8 A = (bf16x8){lo[0], lo[1], lo[2], lo[3], hi[0], hi[1], hi[2], hi[3]};
                    oT[mt] = __builtin_amdgcn_mfma_f32_16x16x32_bf16(A, pB, oT[mt], 0, 0, 0); } }
            asm volatile("s_waitcnt lgkmcnt(0)" ::: "memory");
        }
        f32x4v lt;
#pragma unroll
        for (int i = 0; i < 4; ++i) lt[i] = (am & 2) ? lsum[i] : wave_sum(lsum[i]);
        const float inv = 1.f / (hd == 0 ? lt[0] : hd == 1 ? lt[1] : hd == 2 ? lt[2] : lt[3]);
        if (hc < 4) { bf16* yo = YS + (size_t)m * 1024 + 256 + hc * 64 + 4 * g;
#pragma unroll
            for (int mt = 0; mt < 4; ++mt) { u32x2 w; w.x = cvtpk_s(oT[mt][0] * inv, oT[mt][1] * inv); w.y = cvtpk_s(oT[mt][2] * inv, oT[mt][3] * inv); *(u32x2*)(yo + 16 * mt) = w; } }
    }
#undef BG_LOAD
#undef BG_ROW
#undef BQ_LOAD
#undef B_LO
#undef B_HI
#undef B_S2
}
__device__ __forceinline__ void mixB_group(const Args& a, int l, int m0, LAS unsigned char* lds, LAS unsigned char* wscr, int lane_in, const int bmode = 15) {
    int lane = lane_in; asm volatile("" : "+v"(lane));
    const bf16* P = (const bf16*)(a.ws + WS_BIG);
    const int t0 = m0 & (SEQ - 1); const size_t rowb = (size_t)(m0 - t0);
    const int ql = lane & 31, hh = lane >> 5;
    LAS unsigned short* sidx = (LAS unsigned short*)wscr;
    LAS unsigned char* sbk = wscr + 2048;
    LAS unsigned char* img = wscr + 3584;
    const LAS unsigned char* bkt = lds + BKT_OFF;
    bf16x8 qf[2];
    { const int rho = ql, qi = 2 * ((rho >> 2) & 1) + (rho >> 4), hd = 4 * ((rho >> 3) & 1) + (rho & 3);
      const bf16* ip = P + (size_t)(m0 + qi) * PW + PC_IQ + hd * 32 + 8 * hh;
      qf[0] = *(const bf16x8*)(ip); qf[1] = *(const bf16x8*)(ip + 16); }
    float iw[2][8];
#pragma unroll
    for (int qq = 0; qq < 2; ++qq) { const u32x4 w = *(const u32x4*)(P + (size_t)(m0 + 2 * hh + qq) * PW + PC_IW); const float s = 0.0625f;
        iw[qq][0] = bflo(w.x) * s; iw[qq][1] = bfhi(w.x) * s; iw[qq][2] = bflo(w.y) * s; iw[qq][3] = bfhi(w.y) * s; iw[qq][4] = bflo(w.z) * s; iw[qq][5] = bfhi(w.z) * s; iw[qq][6] = bflo(w.w) * s; iw[qq][7] = bfhi(w.w) * s; }
    const int tq0 = t0 + 2 * hh;
    const int ntile = ((t0 + 3) >> 5) + 1;
    unsigned sk[2][64];
#pragma unroll
    for (int kb4 = 0; kb4 < 32; ++kb4) {
        if (2 * kb4 < ntile && (bmode & 1)) {
            bf16x8 kf0[2], kf1[2];
#pragma unroll
            for (int k4 = 0; k4 < 2; ++k4) { const int s = 32 * (2 * kb4 + k4) + ql; const bf16* kp = P + (rowb + s) * PW + PC_IK + 8 * hh; kf0[k4] = *(const bf16x8*)(kp); kf1[k4] = *(const bf16x8*)(kp + 16); }
#pragma unroll
            for (int k4 = 0; k4 < 2; ++k4) { const int kt = 2 * kb4 + k4; const int s = 32 * kt + ql;
                f32x16 acc;
#pragma unroll
                for (int i = 0; i < 16; ++i) acc[i] = 0.f;
                acc = __builtin_amdgcn_mfma_f32_32x32x16_bf16(qf[0], kf0[k4], acc, 0, 0, 0);
                acc = __builtin_amdgcn_mfma_f32_32x32x16_bf16(qf[1], kf1[k4], acc, 0, 0, 0);
                float s0 = 0.f, s1 = 0.f;
#pragma unroll
                for (int i = 0; i < 8; ++i) { s0 += fmaxf(acc[i], 0.f) * iw[0][i]; s1 += fmaxf(acc[8 + i], 0.f) * iw[1][i]; asm("" : "+v"(s0), "+v"(s1)); }
                sk[0][kt] = (s <= tq0) ? fkey(s0 + 0.f) : 0x007fffffu; sk[1][kt] = (s <= tq0 + 1) ? fkey(s1 + 0.f) : 0x007fffffu; }
        } else {
#pragma unroll
            for (int k4 = 0; k4 < 2; ++k4) { sk[0][2 * kb4 + k4] = 0x007fffffu; sk[1][2 * kb4 + k4] = 0x007fffffu; }
        }
    }
    const unsigned ltm = (1u << ql) - 1u;
    const int nblk8 = (ntile + 7) >> 3;
#define SK_RED(C) do { C += __builtin_amdgcn_update_dpp(0, C, 0x128, 0xf, 0xf, true); C += __builtin_amdgcn_update_dpp(0, C, 0x124, 0xf, 0xf, true); \
        C += __builtin_amdgcn_update_dpp(0, C, 0x122, 0xf, 0xf, true); C += __builtin_amdgcn_update_dpp(0, C, 0x121, 0xf, 0xf, true); \
        C += __builtin_amdgcn_update_dpp(0, C, 0x142, 0xa, 0xf, false);     \
        { const int lo_ = __builtin_amdgcn_readlane(C, 31), hi_ = __builtin_amdgcn_readlane(C, 63); C = hh ? hi_ : lo_; } } while (0)
#define SK_CNT4(C, K0, K1, K2, K3, T) do { unsigned long long m0_, m1_, m2_, m3_; asm volatile( \
        "v_cmp_ge_u32_e64 %1, %5, %9\n\tv_cmp_ge_u32_e64 %2, %6, %9\n\tv_cmp_ge_u32_e64 %3, %7, %9\n\tv_cmp_ge_u32_e64 %4, %8, %9\n\t" \
        "v_addc_co_u32_e64 %0, %1, 0, %0, %1\n\tv_addc_co_u32_e64 %0, %2, 0, %0, %2\n\tv_addc_co_u32_e64 %0, %3, 0, %0, %3\n\tv_addc_co_u32_e64 %0, %4, 0, %0, %4" \
        : "+v"(C), "=&s"(m0_), "=&s"(m1_), "=&s"(m2_), "=&s"(m3_) : "v"(K0), "v"(K1), "v"(K2), "v"(K3), "v"(T)); } while (0)
#define SK_COUNT_GE(R0, R1, C0, C1) do { const unsigned r0_ = (R0), r1_ = (R1); _Pragma("unroll") for (int kb8 = 0; kb8 < 8; ++kb8) { if (kb8 < nblk8) { \
        SK_CNT4(C0, sk[0][8 * kb8], sk[0][8 * kb8 + 1], sk[0][8 * kb8 + 2], sk[0][8 * kb8 + 3], r0_); SK_CNT4(C1, sk[1][8 * kb8], sk[1][8 * kb8 + 1], sk[1][8 * kb8 + 2], sk[1][8 * kb8 + 3], r1_); \
        SK_CNT4(C0, sk[0][8 * kb8 + 4], sk[0][8 * kb8 + 5], sk[0][8 * kb8 + 6], sk[0][8 * kb8 + 7], r0_); SK_CNT4(C1, sk[1][8 * kb8 + 4], sk[1][8 * kb8 + 5], sk[1][8 * kb8 + 6], sk[1][8 * kb8 + 7], r1_); } } \
        SK_RED(C0); SK_RED(C1); } while (0)
#define SK_COUNT2(OP, R0, R1, C0, C1) do { _Pragma("unroll") for (int kb8 = 0; kb8 < 8; ++kb8) { if (kb8 < nblk8) { _Pragma("unroll") for (int k8 = 0; k8 < 8; ++k8) { \
        C0 += (sk[0][8 * kb8 + k8] OP (R0)) ? 1 : 0; C1 += (sk[1][8 * kb8 + k8] OP (R1)) ? 1 : 0; } } } SK_RED(C0); SK_RED(C1); } while (0)
#define KEY2F(K) __uint_as_float(((K) & 0x80000000u) ? ((K) & 0x7fffffffu) : ~(K))
#define SK_REDU(C, F) do { unsigned o_; o_ = (unsigned)__builtin_amdgcn_update_dpp(0, (int)C, 0x128, 0xf, 0xf, true); C = F(C, o_); o_ = (unsigned)__builtin_amdgcn_update_dpp(0, (int)C, 0x124, 0xf, 0xf, true); C = F(C, o_); \
        o_ = (unsigned)__builtin_amdgcn_update_dpp(0, (int)C, 0x122, 0xf, 0xf, true); C = F(C, o_); o_ = (unsigned)__builtin_amdgcn_update_dpp(0, (int)C, 0x121, 0xf, 0xf, true); C = F(C, o_); o_ = (unsigned)__shfl_xor((int)C, 16); C = F(C, o_); } while (0)
#define SK_UMIN(A, B) ((A) < (B) ? (A) : (B))
#define SK_UMAX(A, B) ((A) > (B) ? (A) : (B))
    constexpr int SEL_CAP = 12;
    unsigned KthA[2] = {0u, 0u}; int needA[2] = {0, 0};
    const bool big0 = (tq0 + 1 > 256), big1 = (tq0 + 2 > 256); bool exA[2] = {true, true};
    if (__any(big0 || big1) && (bmode & 2)) {
        float c255 = 255.5f, chalf = 0.5f; asm volatile("" : "+v"(c255), "+v"(chalf));
        unsigned klo[2], khi[2]; int chi[2] = {0, 0}; float x1[2], c1[2] = {0.f, 0.f}, x2[2] = {0.f, 0.f}, c2[2] = {0.f, 0.f}; bool done[2] = {!big0, !big1};
#pragma unroll
        for (int qq = 0; qq < 2; ++qq) { unsigned gm[8];
#pragma unroll
            for (int k8 = 0; k8 < 8; ++k8) gm[k8] = sk[qq][k8];
#pragma unroll
            for (int kb8 = 1; kb8 < 8; ++kb8) { if (kb8 < nblk8) {
#pragma unroll
                for (int k8 = 0; k8 < 8; ++k8) gm[k8] = SK_UMAX(gm[k8], sk[qq][8 * kb8 + k8]); } }
            unsigned mn = gm[0], mx = gm[0];
#pragma unroll
            for (int k8 = 1; k8 < 8; ++k8) { mn = SK_UMIN(mn, gm[k8]); mx = SK_UMAX(mx, gm[k8]); }
            SK_REDU(mn, SK_UMIN); SK_REDU(mx, SK_UMAX);
            klo[qq] = mn; khi[qq] = mx + 1u; x1[qq] = KEY2F(mx); exA[qq] = done[qq]; if (khi[qq] - klo[qq] <= 1u) done[qq] = true; }
#pragma unroll 1
        for (int it = 0; it < 64; ++it) {
            unsigned mk[2];
#pragma unroll
            for (int qq = 0; qq < 2; ++qq) { const unsigned lo = klo[qq], hi = khi[qq]; const float xlo = KEY2F(lo), xhi = KEY2F(hi - 1u); const float fmid = chalf * xlo + chalf * xhi;
                const float fs = x2[qq] + (c255 - c2[qq]) * (x2[qq] - x1[qq]) * __builtin_amdgcn_rcpf(c2[qq] - c1[qq]);
                unsigned m = fkey(it == 0 ? fmid : fs);
                if (it >= SEL_CAP || !(m > lo && m < hi)) { m = fkey(fmid); if (it >= SEL_CAP || !(m > lo && m < hi)) m = lo + ((hi - lo) >> 1); }
                mk[qq] = m; }
            int n0 = 0, n1 = 0;
            SK_COUNT_GE(mk[0], mk[1], n0, n1);
#pragma unroll
            for (int qq = 0; qq < 2; ++qq) { const int n = qq ? n1 : n0;
                if (!done[qq]) {
                    if (n >= 256) { klo[qq] = mk[qq]; if (n == 256) { exA[qq] = true; done[qq] = true; } } else { khi[qq] = mk[qq]; chi[qq] = n; }
                    if (it > 0) { x1[qq] = x2[qq]; c1[qq] = c2[qq]; }
                    x2[qq] = KEY2F(mk[qq]); c2[qq] = (float)n;
                    if (khi[qq] - klo[qq] <= 1u) done[qq] = true; } }
            if (__all(done[0] && done[1])) break;
        }
        KthA[0] = klo[0]; KthA[1] = klo[1]; needA[0] = 256 - chi[0]; needA[1] = 256 - chi[1];
    }
    bool sel_bad = false;
    if (bmode & 32) {
        int a0 = 0, a1 = 0, b0 = 0, b1 = 0; SK_COUNT2(>=, KthA[0], KthA[1], a0, a1); SK_COUNT2(>, KthA[0], KthA[1], b0, b1);
        if (big0) sel_bad = sel_bad || (exA[0] ? (a0 != 256) : !(a0 >= 256 && b0 < 256 && needA[0] == 256 - b0));
        if (big1) sel_bad = sel_bad || (exA[1] ? (a1 != 256) : !(a1 >= 256 && b1 < 256 && needA[1] == 256 - b1));
    }
    if (bmode & 16) { sidx[lane] = (unsigned short)(KthA[0] ^ KthA[1] ^ (unsigned)needA[0] ^ (unsigned)needA[1]); }
#pragma unroll
    for (int qq = 0; qq < 2; ++qq) {
        if (!(bmode & 4)) break;
        const int tq = tq0 + qq; const bool big = qq ? big1 : big0; const unsigned Kth = KthA[qq]; const int need = needA[qq]; const bool exact = exA[qq];
        LAS unsigned short* sx = sidx + (2 * hh + qq) * 256;
        int base = 0, tie_taken = 0; int ql2 = ql; asm volatile("" : "+v"(ql2));
#pragma unroll
        for (int kb8 = 0; kb8 < 8; ++kb8) { if (kb8 < nblk8) {
#pragma unroll
            for (int k8 = 0; k8 < 8; ++k8) { const int kt = 8 * kb8 + k8; const int s = 32 * kt + ql2; const unsigned k = sk[qq][kt]; bool take;
                if (!big) take = (s <= tq);
                else if (exact) take = (k >= Kth);
                else { const bool tie = (k == Kth); const unsigned long long mt = __ballot(tie); const unsigned mt32 = hh ? (unsigned)(mt >> 32) : (unsigned)mt;
                    take = (k > Kth) || (tie && (tie_taken + __popc(mt32 & ltm)) < need); tie_taken += __popc(mt32); }
                const unsigned long long ms = __ballot(take); const unsigned ms32 = hh ? (unsigned)(ms >> 32) : (unsigned)ms;
                if (take) sx[base + __popc(ms32 & ltm)] = (unsigned short)s;
                base += __popc(ms32); } } }
    }
#undef SK_COUNT2
#undef SK_COUNT_GE
#undef SK_CNT4
#undef SK_RED
#undef SK_REDU
#undef SK_UMIN
#undef SK_UMAX
#undef KEY2F
    LDS_WAIT(); asm volatile("" ::: "memory");
#pragma unroll
    for (int qi = 0; qi < 4; ++qi) { const int tq = t0 + qi; const int nsel = (tq + 1 < 256) ? tq + 1 : 256;
#pragma unroll
        for (int j = 0; j < 4; ++j) { const int pos = lane + 64 * j; if (pos < nsel) sbk[qi * 256 + pos] = bkt[tq - (int)sidx[qi * 256 + pos]]; } }
    LDS_WAIT(); asm volatile("" ::: "memory");
    if (bmode & 8) mixB_attend4(a, m0, sidx, sbk, lds, img, wscr + 3072, lane, (bmode >> 6) & 7);
    if ((bmode & 32) && __any(sel_bad)) { bf16* YS = (bf16*)((unsigned char*)a.out + DO_YS); for (int qi = 0; qi < 4; ++qi) ((unsigned short*)YS)[(size_t)(m0 + qi) * 1024 + 256 + lane] = 0x7fc0; }
}
constexpr int DM_OFF = 111616;
__device__ __forceinline__ bf16x8 frag2(const LAS unsigned char* p0, const LAS unsigned char* p1) {
    const s16x4 lo = *(const LAS s16x4*)p0, hi = *(const LAS s16x4*)p1; return (bf16x8){lo[0], lo[1], lo[2], lo[3], hi[0], hi[1], hi[2], hi[3]}; }
__device__ __forceinline__ bf16x8 fragtr(const LAS unsigned char* p0, const LAS unsigned char* p1) {
    const s16x4 lo = vtr(p0), hi = vtr(p1); return (bf16x8){lo[0], lo[1], lo[2], lo[3], hi[0], hi[1], hi[2], hi[3]}; }
__device__ __forceinline__ bf16x8 packf(f32x4 lo, f32x4 hi) { u32x4 w; w.x = cvtpk_s(lo[0], lo[1]); w.y = cvtpk_s(lo[2], lo[3]); w.z = cvtpk_s(hi[0], hi[1]); w.w = cvtpk_s(hi[2], hi[3]); return __builtin_bit_cast(bf16x8, w); }
__device__ __forceinline__ void dchunk_wave(const Args& a, int l, int bh, LAS unsigned char* dm, int lane_in) {
    int lane = lane_in; asm volatile("" : "+v"(lane));
    const int b = bh >> 2, h = bh & 3, hc = lane & 15, g = lane >> 4;
    LAS unsigned char* sAT = dm; LAS unsigned char* sBT = dm + 2304; LAS unsigned char* sKT = dm + 4608; LAS unsigned char* sRT = dm + 6912; LAS unsigned char* sVT = dm + 9216; LAS unsigned char* sUT = dm + 11520;
    LAS float* sW1 = (LAS float*)(dm + 13824); LAS float* sMB = (LAS float*)(dm + 17920); LAS float* sCL = (LAS float*)(dm + 18944); LAS float* sBON = (LAS float*)(dm + 19200);
    const bf16* DR = (const bf16*)((unsigned char*)a.out + DO_DR); const bf16* DKP = (const bf16*)((unsigned char*)a.out + DO_DKP); const bf16* DV = (const bf16*)((unsigned char*)a.out + DO_DV); const bf16* DKK = (const bf16*)((unsigned char*)a.out + DO_DKK);
    const float* DCL = (const float*)(a.ws + WS_BIG + BIG_DW); const bf16* DAI = (const bf16*)(a.ws + WS_BIG + BIG_DAI); const bf16* DG = (const bf16*)(a.ws + WS_BIG + BIG_DG);
    const float* BON = (const float*)(a.ws + WS_BON); bf16* YS = (bf16*)((unsigned char*)a.out + DO_YS);
    float gnw[4], gnb[4];
#pragma unroll
    for (int vt = 0; vt < 4; ++vt) { gnw[vt] = a.in[17][l * 256 + h * 64 + 16 * vt + hc]; gnb[vt] = a.in[18][l * 256 + h * 64 + 16 * vt + hc]; }
    const size_t tok0 = (size_t)b * SEQ;
    f32x4v T[4][4];
#pragma unroll
    for (int kt = 0; kt < 4; ++kt)
#pragma unroll
        for (int vt = 0; vt < 4; ++vt) T[kt][vt] = (f32x4v){0.f, 0.f, 0.f, 0.f};
    const int lrow = lane >> 3, lseg = lane & 7;
    u32x4 nA0, nA1, nB0, nB1, nK0, nK1, nR0, nR1, nV0, nV1; float nCL, nBON;
#define DC_LOAD(CH) do { const size_t e0_ = (tok0 + (size_t)(CH) * 16 + lrow) * 256 + h * 64 + 8 * lseg, e1_ = e0_ + 8 * 256; \
        nA0 = *(const u32x4*)(DKK + e0_); nA1 = *(const u32x4*)(DKK + e1_); nB0 = *(const u32x4*)(DAI + e0_); nB1 = *(const u32x4*)(DAI + e1_); nK0 = *(const u32x4*)(DKP + e0_); nK1 = *(const u32x4*)(DKP + e1_); \
        nR0 = *(const u32x4*)(DR + e0_); nR1 = *(const u32x4*)(DR + e1_); nV0 = *(const u32x4*)(DV + e0_); nV1 = *(const u32x4*)(DV + e1_); \
        nCL = DCL[((size_t)b * (SEQ / 16) + (CH)) * 256 + h * 64 + lane]; nBON = BON[(tok0 + (size_t)(CH) * 16 + (lane & 15)) * 4 + h]; } while (0)
    DC_LOAD(0);
    const int st0 = lrow * 144 + lseg * 16, st1 = st0 + 8 * 144;
    const int rdf = hc * 144 + 8 * g;
    const int rdt = (4 * g + (hc >> 2)) * 144 + 8 * (hc & 3);
    __builtin_amdgcn_s_setprio(2);
#pragma unroll 1
    for (int ch = 0; ch < SEQ / 16; ++ch) {
        *(LAS u32x4*)(sAT + st0) = nA0; *(LAS u32x4*)(sAT + st1) = nA1; *(LAS u32x4*)(sBT + st0) = nB0; *(LAS u32x4*)(sBT + st1) = nB1; *(LAS u32x4*)(sKT + st0) = nK0; *(LAS u32x4*)(sKT + st1) = nK1;
        *(LAS u32x4*)(sRT + st0) = nR0; *(LAS u32x4*)(sRT + st1) = nR1; *(LAS u32x4*)(sVT + st0) = nV0; *(LAS u32x4*)(sVT + st1) = nV1; sCL[lane] = nCL; if (lane < 16) sBON[lane] = nBON;
        unsigned short gq[4][4];
#pragma unroll
        for (int vt = 0; vt < 4; ++vt)
#pragma unroll
            for (int i = 0; i < 4; ++i) gq[vt][i] = DG[(tok0 + (size_t)ch * 16 + 4 * g + i) * 256 + h * 64 + 16 * vt + hc];
        asm volatile("s_waitcnt lgkmcnt(0)" ::: "memory");
        bf16x8 fA[2], fR[2], fB[2], fK[2];
#pragma unroll
        for (int ks = 0; ks < 2; ++ks) { fA[ks] = frag2(sAT + rdf + 64 * ks, sAT + rdf + 64 * ks + 32); fR[ks] = frag2(sRT + rdf + 64 * ks, sRT + rdf + 64 * ks + 32);
            fB[ks] = frag2(sBT + rdf + 64 * ks, sBT + rdf + 64 * ks + 32); fK[ks] = frag2(sKT + rdf + 64 * ks, sKT + rdf + 64 * ks + 32); }
        f32x4v U0[4], Y0[4];
#pragma unroll
        for (int vt = 0; vt < 4; ++vt) { const bf16x8 s0 = packf(T[0][vt], T[1][vt]), s1 = packf(T[2][vt], T[3][vt]);
            f32x4v u = (f32x4v){0.f, 0.f, 0.f, 0.f}, y = (f32x4v){0.f, 0.f, 0.f, 0.f};
            u = __builtin_amdgcn_mfma_f32_16x16x32_bf16(fA[0], s0, u, 0, 0, 0); u = __builtin_amdgcn_mfma_f32_16x16x32_bf16(fA[1], s1, u, 0, 0, 0);
            y = __builtin_amdgcn_mfma_f32_16x16x32_bf16(fR[0], s0, y, 0, 0, 0); y = __builtin_amdgcn_mfma_f32_16x16x32_bf16(fR[1], s1, y, 0, 0, 0);
            U0[vt] = u; Y0[vt] = y; }
        f32x4v Mka = (f32x4v){0.f, 0.f, 0.f, 0.f}, Mba = Mka, Mkr = Mka, Mbr = Mka;
#pragma unroll
        for (int ks = 0; ks < 2; ++ks) { Mka = __builtin_amdgcn_mfma_f32_16x16x32_bf16(fK[ks], fA[ks], Mka, 0, 0, 0); Mba = __builtin_amdgcn_mfma_f32_16x16x32_bf16(fB[ks], fA[ks], Mba, 0, 0, 0);
            Mkr = __builtin_amdgcn_mfma_f32_16x16x32_bf16(fK[ks], fR[ks], Mkr, 0, 0, 0); Mbr = __builtin_amdgcn_mfma_f32_16x16x32_bf16(fB[ks], fR[ks], Mbr, 0, 0, 0); }
#pragma unroll
        for (int i = 0; i < 4; ++i) { const int srow = 4 * g + i; if (!(srow < hc)) { Mka[i] = 0.f; Mba[i] = 0.f; } if (!(srow <= hc)) { Mkr[i] = 0.f; Mbr[i] = 0.f; } }
        if (ch + 1 < SEQ / 16) DC_LOAD(ch + 1);
        const f32x4v z4 = (f32x4v){0.f, 0.f, 0.f, 0.f};
        { const bf16x8 aM = packf(Mka, z4);
#pragma unroll
          for (int vt = 0; vt < 4; ++vt) { const s16x4 lo = vtr(sVT + rdt + 32 * vt); const bf16x8 bV = (bf16x8){lo[0], lo[1], lo[2], lo[3], 0, 0, 0, 0};
              U0[vt] = __builtin_amdgcn_mfma_f32_16x16x32_bf16(aM, bV, U0[vt], 0, 0, 0); } }
#pragma unroll
        for (int vt = 0; vt < 4; ++vt)
#pragma unroll
            for (int i = 0; i < 4; ++i) sW1[(4 * g + i) * 64 + 16 * vt + hc] = U0[vt][i];
        *(LAS f32x4v*)(sMB + hc * 16 + 4 * g) = Mba;
        asm volatile("s_waitcnt lgkmcnt(0)" ::: "memory");
        { float u[16];
#pragma unroll
          for (int t = 0; t < 16; ++t) { float acc = sW1[t * 64 + lane];
#pragma unroll
              for (int sq = 0; sq < 4; ++sq) { if (4 * sq < t) { const f32x4v mb = *(const LAS f32x4v*)(sMB + t * 16 + 4 * sq);
#pragma unroll
                  for (int e = 0; e < 4; ++e) if (4 * sq + e < t) acc += mb[e] * u[4 * sq + e]; } }
              u[t] = acc; ((LAS bf16*)sUT)[t * 72 + lane] = (bf16)f2bf(acc); } }
        asm volatile("s_waitcnt lgkmcnt(0)" ::: "memory");
        f32x4v bonv = *(const LAS f32x4v*)(sBON + 4 * g);
        { const bf16x8 aM = packf(Mbr, Mkr);
#pragma unroll
          for (int vt = 0; vt < 4; ++vt) { const bf16x8 bUV = fragtr(sUT + rdt + 32 * vt, sVT + rdt + 32 * vt); Y0[vt] = __builtin_amdgcn_mfma_f32_16x16x32_bf16(aM, bUV, Y0[vt], 0, 0, 0); } }
        { bf16x8 bUV[4];
#pragma unroll
          for (int vt = 0; vt < 4; ++vt) bUV[vt] = fragtr(sUT + rdt + 32 * vt, sVT + rdt + 32 * vt);
#pragma unroll
          for (int kt = 0; kt < 4; ++kt) { const bf16x8 aBK = fragtr(sBT + rdt + 32 * kt, sKT + rdt + 32 * kt); const f32x4v cl = *(const LAS f32x4v*)(sCL + 16 * kt + 4 * g);
#pragma unroll
              for (int vt = 0; vt < 4; ++vt) T[kt][vt] = __builtin_amdgcn_mfma_f32_16x16x32_bf16(aBK, bUV[vt], T[kt][vt], 0, 0, 0) * cl; } }
#pragma unroll
        for (int i = 0; i < 4; ++i) { float sm = (Y0[0][i] + Y0[1][i]) + (Y0[2][i] + Y0[3][i]);
            sm += dppf<0x128>(sm); sm += dppf<0x124>(sm); sm += dppf<0x122>(sm); sm += dppf<0x121>(sm);
            const float mean = sm * (1.f / 64.f); float sq = 0.f;
#pragma unroll
            for (int vt = 0; vt < 4; ++vt) { const float d = Y0[vt][i] - mean; sq += d * d; }
            sq += dppf<0x128>(sq); sq += dppf<0x124>(sq); sq += dppf<0x122>(sq); sq += dppf<0x121>(sq);
            const float rstd = rsqrtf(sq * (1.f / 64.f) + 64e-5f); const int t = 4 * g + i;
#pragma unroll
            for (int vt = 0; vt < 4; ++vt) { const float vv = bf2f(((const LAS bf16*)sVT)[t * 72 + 16 * vt + hc]);
                const float o = ((Y0[vt][i] - mean) * rstd * gnw[vt] + gnb[vt] + bonv[i] * vv) * bf2f(gq[vt][i]);
                YS[(tok0 + (size_t)ch * 16 + t) * 1024 + 768 + h * 64 + 16 * vt + hc] = (bf16)f2bf(o); } }
        asm volatile("s_waitcnt lgkmcnt(0)" ::: "memory");
    }
    __builtin_amdgcn_s_setprio(0);
#undef DC_LOAD
}
__device__ __forceinline__ void cchunk_wave(const Args& a, int l, int bh, LAS unsigned char* dm, int lane_in) {
    int lane = lane_in; asm volatile("" : "+v"(lane));
    const int b = bh >> 2, h = bh & 3, hc = lane & 15, g = lane >> 4;
    LAS unsigned char* sQT = dm; LAS unsigned char* sKT = dm + 1280; LAS unsigned char* sVT = dm + 2560; LAS float* sCL = (LAS float*)(dm + 4864);
    const bf16* P = (const bf16*)(a.ws + WS_BIG); const bf16* CQH = (const bf16*)(a.ws + WS_CA); const bf16* CKT = (const bf16*)(a.ws + WS_CA + 16 * MiB); const float* CCL = (const float*)(a.ws + WS_END);
    bf16* YS = (bf16*)((unsigned char*)a.out + DO_YS);
    float ng[4];
#pragma unroll
    for (int vt = 0; vt < 4; ++vt) ng[vt] = a.in[7][l * 256 + h * 64 + 16 * vt + hc];
    const size_t tok0 = (size_t)b * SEQ;
    f32x4v T[2][4];
#pragma unroll
    for (int kt = 0; kt < 2; ++kt)
#pragma unroll
        for (int vt = 0; vt < 4; ++vt) T[kt][vt] = (f32x4v){0.f, 0.f, 0.f, 0.f};
    const int qrow = lane >> 2, qseg = lane & 3, lrow = lane >> 3, lseg = lane & 7;
    u32x4 nQ, nK, nV0, nV1; float nCL;
#define CC_LOAD(CH) do { const size_t tq_ = tok0 + (size_t)(CH) * 16 + qrow; nQ = *(const u32x4*)(CQH + tq_ * 128 + h * 32 + 8 * qseg); nK = *(const u32x4*)(CKT + tq_ * 128 + h * 32 + 8 * qseg); \
        const size_t tv_ = tok0 + (size_t)(CH) * 16 + lrow; nV0 = *(const u32x4*)(P + tv_ * PW + PC_CV + h * 64 + 8 * lseg); nV1 = *(const u32x4*)(P + (tv_ + 8) * PW + PC_CV + h * 64 + 8 * lseg); \
        nCL = CCL[((size_t)b * (SEQ / 16) + (CH)) * 128 + h * 32 + (lane & 31)]; } while (0)
    CC_LOAD(0);
    const int rdf = hc * 80 + 8 * g;
    const int rdtk = (4 * g + (hc >> 2)) * 80 + 8 * (hc & 3);
    const int rdtv = (4 * g + (hc >> 2)) * 144 + 8 * (hc & 3);
    __builtin_amdgcn_s_setprio(2);
#pragma unroll 1
    for (int ch = 0; ch < SEQ / 16; ++ch) {
        *(LAS u32x4*)(sQT + qrow * 80 + qseg * 16) = nQ; *(LAS u32x4*)(sKT + qrow * 80 + qseg * 16) = nK;
        *(LAS u32x4*)(sVT + lrow * 144 + lseg * 16) = nV0; *(LAS u32x4*)(sVT + (lrow + 8) * 144 + lseg * 16) = nV1; if (lane < 32) sCL[lane] = nCL;
        unsigned short gq[4][4];
#pragma unroll
        for (int vt = 0; vt < 4; ++vt)
#pragma unroll
            for (int i = 0; i < 4; ++i) gq[vt][i] = P[(tok0 + (size_t)ch * 16 + 4 * g + i) * PW + PC_CG + h * 64 + 16 * vt + hc];
        asm volatile("s_waitcnt lgkmcnt(0)" ::: "memory");
        const bf16x8 fQ = frag2(sQT + rdf, sQT + rdf + 32), fK = frag2(sKT + rdf, sKT + rdf + 32);
        f32x4v Y0[4];
#pragma unroll
        for (int vt = 0; vt < 4; ++vt) { const bf16x8 s0 = packf(T[0][vt], T[1][vt]); Y0[vt] = __builtin_amdgcn_mfma_f32_16x16x32_bf16(fQ, s0, (f32x4v){0.f, 0.f, 0.f, 0.f}, 0, 0, 0); }
        f32x4v Mkq = __builtin_amdgcn_mfma_f32_16x16x32_bf16(fK, fQ, (f32x4v){0.f, 0.f, 0.f, 0.f}, 0, 0, 0);
#pragma unroll
        for (int i = 0; i < 4; ++i) if (!(4 * g + i <= hc)) Mkq[i] = 0.f;
        if (ch + 1 < SEQ / 16) CC_LOAD(ch + 1);
        const f32x4v z4 = (f32x4v){0.f, 0.f, 0.f, 0.f};
        bf16x8 bV[4];
#pragma unroll
        for (int vt = 0; vt < 4; ++vt) { const s16x4 lo = vtr(sVT + rdtv + 32 * vt); bV[vt] = (bf16x8){lo[0], lo[1], lo[2], lo[3], 0, 0, 0, 0}; }
        { const bf16x8 aM = packf(Mkq, z4);
#pragma unroll
          for (int vt = 0; vt < 4; ++vt) Y0[vt] = __builtin_amdgcn_mfma_f32_16x16x32_bf16(aM, bV[vt], Y0[vt], 0, 0, 0); }
#pragma unroll
        for (int kt = 0; kt < 2; ++kt) { const s16x4 lo = vtr(sKT + rdtk + 32 * kt); const bf16x8 aK = (bf16x8){lo[0], lo[1], lo[2], lo[3], 0, 0, 0, 0}; const f32x4v cl = *(const LAS f32x4v*)(sCL + 16 * kt + 4 * g);
#pragma unroll
            for (int vt = 0; vt < 4; ++vt) T[kt][vt] = __builtin_amdgcn_mfma_f32_16x16x32_bf16(aK, bV[vt], T[kt][vt], 0, 0, 0) * cl; }
#pragma unroll
        for (int i = 0; i < 4; ++i) { float sq = 0.f;
#pragma unroll
            for (int vt = 0; vt < 4; ++vt) { const float o = Y0[vt][i] * 0.17677669529663687f; Y0[vt][i] = o; sq += o * o; }
            sq += dppf<0x128>(sq); sq += dppf<0x124>(sq); sq += dppf<0x122>(sq); sq += dppf<0x121>(sq);
            const float rn = rsqrtf(sq * (1.f / 64.f) + 1e-6f); const int t = 4 * g + i;
#pragma unroll
            for (int vt = 0; vt < 4; ++vt) { const float gg = bf2f(gq[vt][i]);
                YS[(tok0 + (size_t)ch * 16 + t) * 1024 + 512 + h * 64 + 16 * vt + hc] = (bf16)f2bf(gg * sigmoidf_(gg) * (Y0[vt][i] * rn * ng[vt])); } }
        asm volatile("s_waitcnt lgkmcnt(0)" ::: "memory");
    }
    __builtin_amdgcn_s_setprio(0);
#undef CC_LOAD
}
__device__ __forceinline__ int lane_now() { unsigned on_ = ~0u; asm volatile("" : "+s"(on_)); return (int)__builtin_amdgcn_mbcnt_hi(on_, __builtin_amdgcn_mbcnt_lo(on_, 0u)); }
#define LANE_ARG lane_now()
__device__ __forceinline__ void mixers_phase(const Args& a, int l, LAS unsigned char* lds, int bid, int G, int tid, int wave, int lane, int qsel = 0, int mixmask = 15, const int bmode = 15) {
    LAS unsigned char* wscr = lds + wave * 12800;
    mixA_tables(a, lds, tid); __syncthreads();
    if (wave == 0) for (int it = bid; it < 256; it += G) { if (it < 128) { if (mixmask & 1) dchunk_wave(a, l, it, lds + DM_OFF, LANE_ARG); } else { if (mixmask & 2) cchunk_wave(a, l, it - 128, lds + DM_OFF, LANE_ARG); } }
    unsigned* qbase = (unsigned*)(a.ws + WS_CTL) + CW_Q + 1024 * l + 512 * qsel;
    const int myx = (int)(xb_xcc_id() & 7u);
    int soff = 0;
    for (;;) {
        if (soff >= 8) break;
        const int xq = (myx + soff) & 7;
        unsigned cq = 0; if (LANE_ARG == 0) cq = __hip_atomic_fetch_add(qbase + 64 * xq, 1u, __ATOMIC_RELAXED, __HIP_MEMORY_SCOPE_AGENT);
        cq = (unsigned)__builtin_amdgcn_readfirstlane((int)cq);
        if (cq >= 2048u) { ++soff; continue; }
        int b, tb = -1, at = 0;
        if (cq < 1920u) { const int bl = (int)cq / 480, j = (int)cq - bl * 480; b = 4 * xq + bl; if (j < 448) { if (j & 1) at = j >> 1; else tb = 255 - (j >> 1); } else at = j - 224; }
        else { const int k = (int)cq - 1920; b = 4 * xq + (k >> 5); tb = 31 - (k & 31); }
        if (tb >= 0) { if (!(mixmask & 8)) continue; const int m0 = b * SEQ + tb * 8;
#pragma unroll 1
            for (int k = 0; k < 2; ++k) {
#ifndef MIX_NO_B
                mixB_group(a, l, m0 + 4 * k, lds, wscr, LANE_ARG, bmode);
#endif
            } }
        else { if (!(mixmask & 4)) continue;
#ifndef MIX_NO_A
            mixA_task(a, b, (at >> 4) & 3, at & 15, 3 - (at >> 6), lds, wave, LANE_ARG);
#endif
        }
    }
}

constexpr int RREC_OFF = MISC_OFF + 4096, LCNT_OFF = MISC_OFF + 10240, LBASE_OFF = MISC_OFF + 10368;
__device__ __forceinline__ void ln1_route_phase(const Args& a, int l, LAS unsigned char* lds, int bid, int G, int tid, int wave, int lane) {
    bf16* XB = (bf16*)(a.ws + WS_XB); const float* WRT = (const float*)(a.ws + WS_RT) + (size_t)l * 36 * 1024;
    unsigned* tokinfo = (unsigned*)(a.ws + WS_TOK); unsigned* cntg = (unsigned*)(a.ws + WS_CTL) + CW_CNT + (l * 32) * 64;
    const float* lng = a.in[21] + (l * 2 + 0) * 1024; const float* lnb = a.in[22] + (l * 2 + 0) * 1024;
    const float* brg = a.in[24] + l * 4; const float* bre = a.in[26] + l * 32;
    LAS float* sW = (LAS float*)lds;
    LAS unsigned* rrec = (LAS unsigned*)(lds + RREC_OFF); LAS int* lcnt = (LAS int*)(lds + LCNT_OFF); LAS unsigned* lbase = (LAS unsigned*)(lds + LBASE_OFF);
    { f32x4 tw[16];
#pragma unroll
      for (int k = 0; k < 16; ++k) tw[k] = *(const f32x4*)(WRT + 4 * 1024 + 4 * (tid + k * NTHR));
#pragma unroll
      for (int k = 0; k < 16; ++k) *(LAS f32x4*)(sW + 4 * (tid + k * NTHR)) = tw[k]; }
    f32x4 gam[4], bet[4], wg[4][4];
#pragma unroll
    for (int j = 0; j < 4; ++j) { gam[j] = *(const f32x4*)(lng + 4 * lane + 256 * j); bet[j] = *(const f32x4*)(lnb + 4 * lane + 256 * j);
#pragma unroll
        for (int e = 0; e < 4; ++e) wg[e][j] = *(const f32x4*)(WRT + e * 1024 + 4 * lane + 256 * j); }
    for (int blk = bid; blk < NTOK / 256; blk += G) {
        if (tid < 32) lcnt[tid] = 0;
        __syncthreads();
#pragma unroll 1
        for (int rg = 0; rg < 8; ++rg) {
            const int rl0 = wave * 32 + rg * 4; f32x4 x[4][4];
#pragma unroll
            for (int r = 0; r < 4; ++r) { bf16* xr = XB + (size_t)(blk * 256 + rl0 + r) * 1024; float s = 0.f;
#pragma unroll
                for (int j = 0; j < 4; ++j) { const u32x2 w = *(const u32x2*)(xr + 4 * lane + 256 * j); x[r][j] = (f32x4){bflo(w.x), bfhi(w.x), bflo(w.y), bfhi(w.y)}; s += (x[r][j][0] + x[r][j][1]) + (x[r][j][2] + x[r][j][3]); }
                const float mean = wave_sum(s) * (1.f / 1024.f); float q = 0.f;
#pragma unroll
                for (int j = 0; j < 4; ++j) { x[r][j] = x[r][j] - mean; q += (x[r][j][0] * x[r][j][0] + x[r][j][1] * x[r][j][1]) + (x[r][j][2] * x[r][j][2] + x[r][j][3] * x[r][j][3]); }
                const float rstd = rsqrtf(wave_sum(q) * (1.f / 1024.f) + LN_EPS);
#pragma unroll
                for (int j = 0; j < 4; ++j) { x[r][j] = x[r][j] * rstd * gam[j] + bet[j]; u32x2 w; w.x = pk2(x[r][j][0], x[r][j][1]); w.y = pk2(x[r][j][2], x[r][j][3]); *(u32x2*)(xr + 4 * lane + 256 * j) = w; }
                }
            float gl[4][4];
#pragma unroll
            for (int e = 0; e < 4; ++e)
#pragma unroll
                for (int r = 0; r < 4; ++r) { float d = 0.f;
#pragma unroll
                    for (int j = 0; j < 4; ++j) d += (x[r][j][0] * wg[e][j][0] + x[r][j][1] * wg[e][j][1]) + (x[r][j][2] * wg[e][j][2] + x[r][j][3] * wg[e][j][3]);
                    gl[r][e] = wave_sum(d) + brg[e]; }
#pragma unroll
            for (int r = 0; r < 4; ++r) {
                const float g0 = gl[r][0], g1 = gl[r][1], g2 = gl[r][2], g3 = gl[r][3];
                int gsv = 0; float gm = g0; if (g1 > gm) { gm = g1; gsv = 1; } if (g2 > gm) { gm = g2; gsv = 2; } if (g3 > gm) { gm = g3; gsv = 3; }
                const int gs = __builtin_amdgcn_readfirstlane(gsv);
                const float ptop = 1.f / (__expf(g0 - gm) + __expf(g1 - gm) + __expf(g2 - gm) + __expf(g3 - gm));
                float v0 = -INFINITY, v1 = -INFINITY; int i0 = 0, i1 = 0;
#pragma unroll 2
                for (int jj = 0; jj < 8; ++jj) { const int e = gs * 8 + jj; float d = 0.f;
#pragma unroll
                    for (int j = 0; j < 4; ++j) { const f32x4 w4 = *(const LAS f32x4*)(sW + e * 1024 + 4 * lane + 256 * j); d += (x[r][j][0] * w4[0] + x[r][j][1] * w4[1]) + (x[r][j][2] * w4[2] + x[r][j][3] * w4[3]); }
                    const float le = wave_sum(d) + bre[e];
                    if (le > v0) { v1 = v0; i1 = i0; v0 = le; i0 = jj; } else if (le > v1) { v1 = le; i1 = jj; } }
                const float ex = __expf(v1 - v0), w0 = ptop / (1.f + ex), w1 = ptop * ex / (1.f + ex);
                if (lane == 0) { const int e0 = gs * 8 + i0, e1 = gs * 8 + i1; const int rl = rl0 + r;
                    const int p0 = atomicAdd((int*)&lcnt[e0], 1), p1 = atomicAdd((int*)&lcnt[e1], 1);
                    rrec[rl * 6 + 0] = (unsigned)e0; rrec[rl * 6 + 1] = (unsigned)p0; rrec[rl * 6 + 2] = __float_as_uint(w0); rrec[rl * 6 + 3] = (unsigned)e1; rrec[rl * 6 + 4] = (unsigned)p1; rrec[rl * 6 + 5] = __float_as_uint(w1); } }
        }
        __syncthreads();
        if (tid < 32) lbase[tid] = __hip_atomic_fetch_add(cntg + tid * 64, (unsigned)lcnt[tid], __ATOMIC_RELAXED, __HIP_MEMORY_SCOPE_AGENT);
        __syncthreads();
        if (tid < 256) { const unsigned e0 = rrec[tid * 6 + 0], e1 = rrec[tid * 6 + 3]; unsigned* ti = tokinfo + (size_t)(blk * 256 + tid) * 8;
            u32x4 o0, o1; o0.x = e0; o0.y = lbase[e0] + rrec[tid * 6 + 1]; o0.z = rrec[tid * 6 + 2]; o0.w = e1; o1.x = lbase[e1] + rrec[tid * 6 + 4]; o1.y = rrec[tid * 6 + 5]; o1.z = 0u; o1.w = 0u;
            *(u32x4*)ti = o0; *(u32x4*)(ti + 4) = o1; }
        __syncthreads();
    }
}
__device__ __forceinline__ void moe_table(const Args& a, int l, LAS unsigned char* lds, int tid) {
    LAS int* tstart = (LAS int*)(lds + TST_OFF);
    if (tid < 64) { const unsigned* cntg = (const unsigned*)(a.ws + WS_CTL) + CW_CNT + (l * 32) * 64;
        int v = (tid < 32) ? (int)((__hip_atomic_load(cntg + tid * 64, __ATOMIC_RELAXED, __HIP_MEMORY_SCOPE_AGENT) + 255u) >> 8) : 0; const int mine = v;
#pragma unroll
        for (int o = 1; o < 32; o <<= 1) { const int u = __shfl_up(v, o); if ((tid & 63) >= o) v += u; }
        if (tid < 32) tstart[tid] = v - mine; if (tid == 31) tstart[32] = v; }
    __syncthreads();
}
__device__ __forceinline__ void scatter_phase(const Args& a, int l, LAS unsigned char* lds, int bid, int G, int tid, int gw, int NGW, int lane) {
    const LAS int* tstart = (const LAS int*)(lds + TST_OFF);
    const bf16* XB = (const bf16*)(a.ws + WS_XB); bf16* XS = (bf16*)(a.ws + WS_BIG); unsigned* rowinfo = (unsigned*)(a.ws + WS_ROW); const unsigned* tokinfo = (const unsigned*)(a.ws + WS_TOK);
    const unsigned* cntg = (const unsigned*)(a.ws + WS_CTL) + CW_CNT + (l * 32) * 64;
    for (int e = bid; e < 32; e += G) { const int c = (int)__hip_atomic_load(cntg + e * 64, __ATOMIC_RELAXED, __HIP_MEMORY_SCOPE_AGENT); const int r0 = tstart[e] * 256, r1 = tstart[e + 1] * 256;
        unsigned neg_ = 0xffffffffu, zer_ = 0u; asm volatile("" : "+v"(neg_), "+v"(zer_));
        for (int r = r0 + c + tid; r < r1; r += NTHR) { rowinfo[2 * (size_t)r] = neg_; rowinfo[2 * (size_t)r + 1] = zer_; } }
    u32x4 nt0; u32x2 nt1;
#define SC_LOAD(mm) do { nt0 = *(const u32x4*)(tokinfo + (size_t)(mm) * 8); nt1 = *(const u32x2*)(tokinfo + (size_t)(mm) * 8 + 4); } while (0)
    const int gt = gw * 64 + lane, NT = NGW * 64;
    for (int m = gt; m < NTOK; m += NT) {
        SC_LOAD(m); const u32x4 t0 = nt0; const u32x2 t1 = nt1;
        const size_t r0 = (size_t)tstart[t0.x] * 256 + t0.y, r1 = (size_t)tstart[t0.w] * 256 + t1.x;
        *(u32x2*)(rowinfo + 2 * r0) = (u32x2){(unsigned)(m * 2), t0.z}; *(u32x2*)(rowinfo + 2 * r1) = (u32x2){(unsigned)(m * 2 + 1), t1.y};
    }
#undef SC_LOAD
}
__device__ __forceinline__ void ln2_phase(const Args& a, int l, int gw, int NGW, int lane) {
    bf16* XB = (bf16*)(a.ws + WS_XB); const bf16* Y = (const bf16*)(a.ws + WS_BIG);
    const float* lng = a.in[21] + (l * 2 + 1) * 1024; const float* lnb = a.in[22] + (l * 2 + 1) * 1024;
    f32x4 gam[4], bet[4];
#pragma unroll
    for (int j = 0; j < 4; ++j) { gam[j] = *(const f32x4*)(lng + 4 * lane + 256 * j); bet[j] = *(const f32x4*)(lnb + 4 * lane + 256 * j); }
    for (int m0 = gw; m0 < NTOK; m0 += 4 * NGW) {
        u32x2 cw[4][4], cp2[4][4], cq2[4][4];
#pragma unroll
        for (int r = 0; r < 4; ++r) { const int m = m0 + r * NGW; if (m < NTOK) { const bf16* xr_ = XB + (size_t)m * 1024 + 4 * lane; const bf16* y0_ = Y + (size_t)m * 1024 + 4 * lane; const bf16* y1_ = Y + ((size_t)NTOK + m) * 1024 + 4 * lane;
#pragma unroll
            for (int j = 0; j < 4; ++j) { cw[r][j] = *(const u32x2*)(xr_ + 256 * j); cp2[r][j] = *(const u32x2*)(y0_ + 256 * j); cq2[r][j] = *(const u32x2*)(y1_ + 256 * j); } } }
#pragma unroll
        for (int r = 0; r < 4; ++r) { const int m = m0 + r * NGW; if (m < NTOK) {
            bf16* xr = XB + (size_t)m * 1024;
            f32x4 x[4]; float s = 0.f;
#pragma unroll
            for (int j = 0; j < 4; ++j) { const u32x2 w = cw[r][j], p = cp2[r][j], q = cq2[r][j];
                x[j] = (f32x4){DN_ALPHA * bflo(w.x) + (bflo(p.x) + bflo(q.x)), DN_ALPHA * bfhi(w.x) + (bfhi(p.x) + bfhi(q.x)), DN_ALPHA * bflo(w.y) + (bflo(p.y) + bflo(q.y)), DN_ALPHA * bfhi(w.y) + (bfhi(p.y) + bfhi(q.y))};
                s += (x[j][0] + x[j][1]) + (x[j][2] + x[j][3]); }
            const float mean = wave_sum(s) * (1.f / 1024.f); float q = 0.f;
#pragma unroll
            for (int j = 0; j < 4; ++j) { x[j] = x[j] - mean; q += (x[j][0] * x[j][0] + x[j][1] * x[j][1]) + (x[j][2] * x[j][2] + x[j][3] * x[j][3]); }
            const float rstd = rsqrtf(wave_sum(q) * (1.f / 1024.f) + LN_EPS);
#pragma unroll
            for (int j = 0; j < 4; ++j) { x[j] = x[j] * rstd * gam[j] + bet[j];
                if (l == NLAYER - 1) *(f32x4*)(a.out + (size_t)m * 1024 + 4 * lane + 256 * j) = x[j];
                else { u32x2 w; w.x = pk2(x[j][0], x[j][1]); w.y = pk2(x[j][2], x[j][3]); *(u32x2*)(xr + 4 * lane + 256 * j) = w; } } } }
    }
}

#ifndef MK_MULTI
#define MK_MULTI 0
#endif
constexpr int NPHASE = 12;
__global__ void __launch_bounds__(NTHR, 2) fwd(Args a) {
    extern __shared__ __attribute__((aligned(16))) unsigned char lds_raw[];
    LAS unsigned char* lds = (LAS unsigned char*)lds_raw;
    const int G0 = gridDim.x, bid0 = blockIdx.x, wave0 = __builtin_amdgcn_readfirstlane((int)(threadIdx.x >> 6));
#define PH_IDS unsigned on_ = ~0u; asm volatile("" : "+s"(on_)); int lz_ = (int)__builtin_amdgcn_mbcnt_hi(on_, __builtin_amdgcn_mbcnt_lo(on_, 0u)); int wz_ = wave0, bz_ = bid0, gz_ = G0; asm volatile("" : "+s"(wz_), "+s"(bz_), "+s"(gz_)); \
    const int lane = lz_, wave = wz_, tid = wz_ * 64 + lz_, bid = bz_, G = gz_, NGW = gz_ * NWAVES, gw = bid * NWAVES + wave; (void)lane; (void)gw; (void)wave; (void)tid; (void)NGW;
#define PH_ARGS(LV) const __attribute__((address_space(4))) Args* kp_ = (const __attribute__((address_space(4))) Args*)__builtin_amdgcn_kernarg_segment_ptr(); asm volatile("" : "+s"(kp_)); const Args& b = *(const Args*)kp_; int lq = (LV); asm volatile("" : "+s"(lq)); (void)lq; \
    bf16* XB = (bf16*)(b.ws + WS_XB); bf16* PB = (bf16*)(b.ws + WS_BIG); bf16* YS = (bf16*)((unsigned char*)b.out + DO_YS); bf16* MG = (bf16*)((unsigned char*)b.out + DO_MG); \
    unsigned* rowinfo = (unsigned*)(b.ws + WS_ROW); unsigned char* wl = b.ws + WS_W + (size_t)lq * WL_SIZE; (void)XB; (void)PB; (void)YS; (void)MG; (void)rowinfo; (void)wl;
    unsigned* ctl = (unsigned*)(a.ws + WS_CTL);
    { PH_IDS
    for (int u = tid; u < (LDS_BYTES - MISC_OFF) / 4; u += NTHR) ((LAS unsigned*)(lds + MISC_OFF))[u] = 0u;
    __syncthreads();
    for (int d = tid; d < 2048; d += NTHR) ((LAS unsigned char*)(lds + BKT_OFF))[d] = (unsigned char)t5_bucket(d);
    if (tid < 256) ((LAS float*)(lds + RPB_OFF))[tid] = a.in[1][tid];
    __syncthreads(); }
    XcdBarrier bar; bar.bar = ctl + CW_BAR; bar.x = 0; bar.st = nullptr;
    if (a.use_bar) bar = xcd_barrier_post(ctl + CW_BAR, (volatile LAS unsigned*)(lds + MISC_OFF) + 8);
#define GRID_BAR() do { if (a.use_bar) { const __attribute__((address_space(4))) Args* kq_ = (const __attribute__((address_space(4))) Args*)__builtin_amdgcn_kernarg_segment_ptr(); asm volatile("" : "+s"(kq_)); \
        XcdBarrier bb_ = bar; bb_.bar = (unsigned*)(kq_->ws + WS_CTL) + CW_BAR; xcd_barrier(bb_); } } while (0)
#ifndef PHMASK
#define PHMASK 0xFFF
#endif
#define IN(k) (((PHMASK >> (k)) & 1) && ((phm >> (k)) & 1u))

    unsigned phm = ((1u << a.ph_hi) - 1u) & ~((1u << a.ph_lo) - 1u);
    if (a.l_lo == 0 && IN(0)) { PH_IDS PH_ARGS(0) p0_prologue(b, lds, gw, NGW, wave, lane); GRID_BAR(); }
    for (int l = a.l_lo; l < a.l_hi; ++l) {
        asm volatile("" : "+s"(phm));
        if (IN(1)) { PH_IDS PH_ARGS(l) pg8::Gemm g{XB, (const bf16*)(wl + WL_IN), 1024, 1024, 1024}; pg8::GridOrder S; S.init(NTOK / 256, PW / 256, G, bid, 0, 0, 1);
            pg8::EpiStoreBf16 E{PB, PW, 8}; pg8::gemm_phase(lds, g, S, E, tid); GRID_BAR(); }
        if (IN(2)) { PH_IDS PH_ARGS(l) prep_phase(b, lq, lds, tid, gw, NGW, lane); GRID_BAR(); }
        if (IN(3)) { PH_IDS PH_ARGS(l) mixers_phase(b, lq, lds, bid, G, tid, wave, lane); GRID_BAR(); }
        if (IN(4)) { PH_IDS PH_ARGS(l) pg8::Gemm g{YS, (const bf16*)(wl + WL_BR), 1024, 256, 256}; pg8::GridOrder S; S.init(NTOK / 256, 16, G, bid, 4, 512);
            pg8::EpiStoreBf16 E{PB, 4096, 0, 16}; pg8::gemm_phase(lds, g, S, E, tid); GRID_BAR(); }
        if (IN(5)) { PH_IDS PH_ARGS(l) pg8::Gemm g{XB, (const bf16*)(wl + WL_IN) + (size_t)3072 * 1024, 1024, 1024, 1024}; pg8::GridOrder S; S.init(NTOK / 256, 16, G, bid, 0, 0, 1);
            pg8::EpiGate E{PB, MG}; pg8::gemm_phase(lds, g, S, E, tid); GRID_BAR(); }
        if (IN(6)) { PH_IDS PH_ARGS(l) pg8::Gemm g{MG, (const bf16*)(wl + WL_OUT), 1024, 1024, 1024}; pg8::GridOrder S; S.init(NTOK / 256, 4, G, bid);
            pg8::EpiOut E{XB}; pg8::gemm_phase(lds, g, S, E, tid); GRID_BAR(); }
        if (IN(7)) { PH_IDS PH_ARGS(l) ln1_route_phase(b, lq, lds, bid, G, tid, wave, lane); GRID_BAR(); }
        if (IN(8)) { PH_IDS PH_ARGS(l) moe_table(b, lq, lds, tid); scatter_phase(b, lq, lds, bid, G, tid, gw, NGW, lane); GRID_BAR(); }
        if (IN(9)) { PH_IDS PH_ARGS(l) if (!a.use_bar) moe_table(b, lq, lds, tid);
            pg8::Gemm g{XB, (const bf16*)(wl + WL_GU), 1024, 1024, 1024}; pg8::MoeOrder S{(const LAS int*)(lds + TST_OFF), 1, G, bid, 0};
            pg8::EpiUp E{rowinfo, (bf16*)(b.ws + WS_BIG + BIG_H)}; pg8::gemm_phase<pg8::EpiUp, pg8::MoeOrder, true>(lds, g, S, E, tid, rowinfo); GRID_BAR(); }
        if (IN(10)) { PH_IDS PH_ARGS(l) if (!a.use_bar) moe_table(b, lq, lds, tid);
            pg8::Gemm g{(const bf16*)(b.ws + WS_BIG + BIG_H), (const bf16*)(wl + WL_DN), 256, 256, 256}; pg8::MoeOrder S{(const LAS int*)(lds + TST_OFF), 2, G, bid, 1};
            pg8::EpiDown E{rowinfo, PB}; pg8::gemm_phase(lds, g, S, E, tid); GRID_BAR(); }
        if (IN(11)) { PH_IDS PH_ARGS(l) ln2_phase(b, lq, gw, NGW, lane); if (l + 1 < a.l_hi) GRID_BAR(); }
    }
#undef IN
#undef GRID_BAR
}

extern "C" void kernel_launch(void* const* d_in, const int* in_sizes, int n_in, void* d_out, int out_size, void* d_ws, size_t ws_size, hipStream_t stream) {
    static int grid = 0;
    if (grid == 0) {
        if (n_in != 30 || out_size != NTOK * DM || ws_size < WS_END + 2 * MiB) { fprintf(stderr, "kernel_launch: unexpected shapes (n_in %d out %d ws %zu)\n", n_in, out_size, ws_size); grid = -1; return; }
        int dev = 0, cus = 0, per_cu = 0;
        if (hipGetDevice(&dev) != hipSuccess || hipDeviceGetAttribute(&cus, hipDeviceAttributeMultiprocessorCount, dev) != hipSuccess) { grid = -1; return; }
        if (hipFuncSetAttribute((const void*)fwd, hipFuncAttributeMaxDynamicSharedMemorySize, LDS_BYTES) != hipSuccess) { fprintf(stderr, "kernel_launch: hipFuncSetAttribute failed\n"); grid = -1; return; }
        if (hipOccupancyMaxActiveBlocksPerMultiprocessor(&per_cu, (const void*)fwd, NTHR, LDS_BYTES) != hipSuccess || per_cu < 1) fprintf(stderr, "kernel_launch: occupancy query says %d\n", per_cu);
        (void)hipGetLastError();
        grid = cus;
    }
    if (grid < 0) return;
    (void)hipMemsetAsync((char*)d_ws + WS_CTL, 0, CTL_ZERO_BYTES, stream);
    Args a{};
    for (int i = 0; i < 30; ++i) a.in[i] = (const float*)d_in[i];
    a.out = (float*)d_out; a.ws = (unsigned char*)d_ws; a.pad = 0;
#if MK_MULTI
    a.use_bar = 0;
    for (int l = 0; l < NLAYER; ++l)
        for (int ph = (l == 0 ? 0 : 1); ph < NPHASE; ++ph) { a.l_lo = l; a.l_hi = l + 1; a.ph_lo = ph; a.ph_hi = ph + 1;
            hipLaunchKernelGGL(fwd, dim3(grid), dim3(NTHR), LDS_BYTES, stream, a); }
#else
    a.use_bar = 1; a.l_lo = 0; a.l_hi = NLAYER; a.ph_lo = 0; a.ph_hi = NPHASE;
    hipLaunchKernelGGL(fwd, dim3(grid), dim3(NTHR), LDS_BYTES, stream, a);
#endif
    const hipError_t le = hipPeekAtLastError();
    if (le != hipSuccess) fprintf(stderr, "kernel_launch: launch failed: %s\n", hipGetErrorName(le));
}
```
